# Optimizing an MI355X kernel written in HIP

```python
import math
import jax, jax.numpy as jnp
from jax import lax
import numpy as np

D_MODEL = 1024
BATCH = 8
SEQ = 2048
DEPTH = 1

CHUNK = 64
Q_BLOCK = 128

DN_HEADS = 4
DN_HEAD_DIM = 128
DN_WIDTH = DN_HEADS * DN_HEAD_DIM
CONV_WIDTH = 4

SB_HEADS = 8
SB_HEAD_DIM = 64
SB_WIDTH = SB_HEADS * SB_HEAD_DIM

N_EXPERTS = 256
TOP_K = 8
N_GROUPS = 8
TOP_GROUPS = 4
EXPERT_FF = 256
SHARED_FF = 256
ROUTED_SCALE = 2.5
EXPERT_BLOCK = 128

DEEPNORM_ALPHA = (2 * DEPTH) ** 0.25
DEEPNORM_BETA = (8 * DEPTH) ** -0.25

LN_EPS = 1e-5
NORM_EPS = 1e-6

PROJ_SPLITS = (DN_WIDTH, DN_WIDTH, DN_WIDTH, DN_WIDTH, DN_HEADS, DN_HEADS,
               SB_WIDTH, SB_WIDTH, SB_WIDTH, D_MODEL, D_MODEL)
PROJ_WIDTH = sum(PROJ_SPLITS)

kernel_name = "hybrid_deltanet_stickbreaking_moe_deepnorm"


def layer_norm(x, g, b):
    xf = x.astype(jnp.float32)
    mu = jnp.mean(xf, -1, keepdims=True)
    var = jnp.mean(jnp.square(xf - mu), -1, keepdims=True)
    return ((xf - mu) * lax.rsqrt(var + LN_EPS) * g.astype(jnp.float32)
            + b.astype(jnp.float32)).astype(x.dtype)


def rms_norm(u, g):
    uf = u.astype(jnp.float32)
    return uf * lax.rsqrt(jnp.mean(uf * uf, -1, keepdims=True) + NORM_EPS) * g.astype(jnp.float32)


def l2_normalize(u):
    return u * lax.rsqrt(jnp.sum(u * u, -1, keepdims=True) + NORM_EPS)


def causal_depthwise_conv(u, w):
    S = u.shape[1]
    up = jnp.pad(u, ((0, 0), (CONV_WIDTH - 1, 0), (0, 0)))
    out = up[:, 0:S] * w[0]
    for tap in range(1, CONV_WIDTH):
        out = out + up[:, tap:tap + S] * w[tap]
    return out


def split_heads(t, n_heads):
    B, S, _ = t.shape
    return t.reshape(B, S, n_heads, -1).transpose(0, 2, 1, 3)


def gated_delta_rule(q, k, v, g, beta):
    B, H, S, dk = q.shape
    dv = v.shape[-1]
    N = S // CHUNK
    q = q * (dk ** -0.5)
    q = q.reshape(B, H, N, CHUNK, dk)
    k = k.reshape(B, H, N, CHUNK, dk)
    v = v.reshape(B, H, N, CHUNK, dv)
    g = g.reshape(B, H, N, CHUNK)
    beta = beta.reshape(B, H, N, CHUNK)
    G = jnp.cumsum(g, -1)
    pos = jnp.arange(CHUNK)
    incl = pos[:, None] >= pos[None, :]
    strict = pos[:, None] > pos[None, :]
    diff = G[..., :, None] - G[..., None, :]
    decay = jnp.where(incl, jnp.exp(jnp.where(incl, diff, 0.0)), 0.0)
    k_beta = k * beta[..., None]
    v_beta = v * beta[..., None]
    m = jnp.where(strict, jnp.einsum('bhnid,bhnjd->bhnij', k_beta, k) * decay, 0.0)
    eye = jnp.eye(CHUNK, dtype=q.dtype)
    rhs = jnp.concatenate([v_beta, k_beta * jnp.exp(G)[..., None]], -1)
    sol = lax.linalg.triangular_solve(eye + m, rhs, left_side=True, lower=True,
                                      unit_diagonal=True)
    u, w = sol[..., :dv], sol[..., dv:]
    attn = jnp.einsum('bhnid,bhnjd->bhnij', q, k) * decay
    q_dec = q * jnp.exp(G)[..., None]
    k_dec = k * jnp.exp(G[..., -1:] - G)[..., None]
    last = jnp.exp(G[..., -1])

    def step(state, inp):
        u_c, w_c, attn_c, qd_c, kd_c, last_c = inp
        v_new = u_c - jnp.einsum('bhcd,bhde->bhce', w_c, state)
        o = (jnp.einsum('bhcd,bhde->bhce', qd_c, state)
             + jnp.einsum('bhij,bhje->bhie', attn_c, v_new))
        state = state * last_c[..., None, None] + jnp.einsum('bhcd,bhce->bhde', kd_c, v_new)
        return state, o

    xs = (jnp.moveaxis(u, 2, 0), jnp.moveaxis(w, 2, 0), jnp.moveaxis(attn, 2, 0),
          jnp.moveaxis(q_dec, 2, 0), jnp.moveaxis(k_dec, 2, 0), jnp.moveaxis(last, 2, 0))
    s0 = jnp.zeros((B, H, dk, dv), jnp.float32)
    _, o = lax.scan(step, s0, xs)
    return jnp.moveaxis(o, 0, 2).reshape(B, H, S, dv)


def stick_breaking_attention(q, k, v):
    S = q.shape[2]
    scale = q.shape[-1] ** -0.5
    outs = []
    for blk in range(S // Q_BLOCK):
        q0 = blk * Q_BLOCK
        L = q0 + Q_BLOCK
        qb = q[:, :, q0:L].astype(jnp.float32)
        kb = k[:, :, :L].astype(jnp.float32)
        vb = v[:, :, :L].astype(jnp.float32)
        z = jnp.einsum('bhqd,bhkd->bhqk', qb, kb) * scale
        qpos = q0 + jnp.arange(Q_BLOCK)
        kpos = jnp.arange(L)
        mask = kpos[None, :] < qpos[:, None]
        log_beta = jax.nn.log_sigmoid(z)
        log_rest = jnp.where(mask, jax.nn.log_sigmoid(-z), 0.0)
        between = lax.cumsum(log_rest, axis=3, reverse=True) - log_rest
        a = jnp.where(mask, jnp.exp(log_beta + between), 0.0)
        outs.append(jnp.einsum('bhqk,bhkd->bhqd', a, vb))
    return jnp.concatenate(outs, 2)


def swiglu(u, w_up, w_down):
    gate, up = jnp.split(u @ w_up, 2, -1)
    return (jax.nn.silu(gate) * up) @ w_down


def route(h, w_router, router_bias):
    T = h.shape[0]
    scores = jax.nn.sigmoid((h @ w_router).astype(jnp.float32))
    sel = scores + router_bias.astype(jnp.float32)
    grouped = sel.reshape(T, N_GROUPS, N_EXPERTS // N_GROUPS)
    group_score = jnp.sum(lax.top_k(grouped, 2)[0], -1)
    _, top_groups = lax.top_k(group_score, TOP_GROUPS)
    group_mask = jnp.any(top_groups[:, :, None] == jnp.arange(N_GROUPS)[None, None, :], axis=1)
    expert_mask = jnp.repeat(group_mask, N_EXPERTS // N_GROUPS, axis=1)
    _, idx = lax.top_k(jnp.where(expert_mask, sel, -jnp.inf), TOP_K)
    w = jnp.take_along_axis(scores, idx, -1)
    w = w / jnp.sum(w, -1, keepdims=True) * ROUTED_SCALE
    return idx, w


def routed_experts(h, idx, gate, w_up, w_down):
    T, D = h.shape
    M = T * TOP_K
    flat_e = idx.reshape(M).astype(jnp.int32)
    flat_tok = jnp.arange(M, dtype=jnp.int32) // TOP_K
    flat_gate = gate.reshape(M)
    order = jnp.argsort(flat_e)
    se, stok, sgate = flat_e[order], flat_tok[order], flat_gate[order]
    counts = jnp.zeros((N_EXPERTS,), jnp.int32).at[flat_e].add(1)
    start = jnp.cumsum(counts) - counts
    padded = (counts + EXPERT_BLOCK - 1) // EXPERT_BLOCK * EXPERT_BLOCK
    pend = jnp.cumsum(padded)
    pstart = pend - padded
    dest = pstart[se] + jnp.arange(M, dtype=jnp.int32) - start[se]
    n_blocks = -(-(M + N_EXPERTS * (EXPERT_BLOCK - 1)) // EXPERT_BLOCK)
    P = n_blocks * EXPERT_BLOCK
    pad_tok = jnp.full((P,), T, jnp.int32).at[dest].set(stok)
    pad_gate = jnp.zeros((P,), jnp.float32).at[dest].set(sgate)
    block_start = jnp.arange(n_blocks, dtype=jnp.int32) * EXPERT_BLOCK
    block_e = jnp.minimum(jnp.sum(pend[None, :] <= block_start[:, None], 1), N_EXPERTS - 1)
    h_pad = jnp.concatenate([h, jnp.zeros((1, D), h.dtype)], 0)

    def run_block(args):
        tok, e = args
        return swiglu(h_pad[tok], w_up[e], w_down[e])

    y = lax.map(run_block, (pad_tok.reshape(n_blocks, EXPERT_BLOCK), block_e))
    y = y.reshape(P, D).astype(jnp.float32) * pad_gate[:, None]
    return jax.ops.segment_sum(y, pad_tok, num_segments=T + 1)[:T].astype(h.dtype)


def hybrid_layer(x, w_in, conv_w, dn_a_log, dn_dt_bias, dn_norm_g, w_proj_a, w_proj_b,
                 w_out, ln1_g, ln1_b, w_router, router_bias, w_shared_up, w_shared_down,
                 w_expert_up, w_expert_down, ln2_g, ln2_b):
    B, S, D = x.shape
    proj = x @ w_in
    cuts = [int(c) for c in np.cumsum(PROJ_SPLITS)[:-1]]
    dq, dk, dv, dz, dbeta, da, sq, sk, sv, gate_a, gate_b = jnp.split(proj, cuts, axis=-1)

    qkv = jax.nn.silu(causal_depthwise_conv(jnp.concatenate([dq, dk, dv], -1), conv_w))
    dq, dk, dv = jnp.split(qkv.astype(jnp.float32), 3, -1)
    q_a = l2_normalize(split_heads(dq, DN_HEADS))
    k_a = l2_normalize(split_heads(dk, DN_HEADS))
    v_a = split_heads(dv, DN_HEADS)
    log_decay = (-jnp.exp(dn_a_log.astype(jnp.float32))
                 * jax.nn.softplus(da.astype(jnp.float32) + dn_dt_bias.astype(jnp.float32)))
    beta = jax.nn.sigmoid(dbeta.astype(jnp.float32))
    o_a = gated_delta_rule(q_a, k_a, v_a, log_decay.transpose(0, 2, 1), beta.transpose(0, 2, 1))
    o_a = o_a.transpose(0, 2, 1, 3)
    o_a = rms_norm(o_a, dn_norm_g) * jax.nn.silu(
        dz.astype(jnp.float32).reshape(B, S, DN_HEADS, DN_HEAD_DIM))
    y_a = o_a.reshape(B, S, DN_WIDTH).astype(x.dtype) @ w_proj_a

    o_b = stick_breaking_attention(split_heads(sq, SB_HEADS), split_heads(sk, SB_HEADS),
                                   split_heads(sv, SB_HEADS))
    y_b = o_b.transpose(0, 2, 1, 3).reshape(B, S, SB_WIDTH).astype(x.dtype) @ w_proj_b

    merged = jax.nn.sigmoid(gate_a) * y_a + jax.nn.sigmoid(gate_b) * y_b
    h = layer_norm(DEEPNORM_ALPHA * x + merged @ w_out, ln1_g, ln1_b)

    hf = h.reshape(B * S, D)
    idx, gates = route(hf, w_router, router_bias)
    f = swiglu(hf, w_shared_up, w_shared_down) + routed_experts(hf, idx, gates, w_expert_up,
                                                                w_expert_down)
    return layer_norm(DEEPNORM_ALPHA * h + f.reshape(B, S, D), ln2_g, ln2_b)


def setup_inputs(seed: int = 0) -> dict:
    key = jax.random.key(seed)
    ks = jax.random.split(key, 20)
    f32 = jnp.float32
    nrm = lambda k, shape, scale: jax.random.normal(k, shape, f32) * scale
    dt = jnp.exp(jax.random.uniform(ks[4], (DEPTH, DN_HEADS), f32, math.log(1e-3), math.log(1e-1)))
    return {
        "x": nrm(ks[0], (BATCH, SEQ, D_MODEL), 1.0),
        "w_in": nrm(ks[1], (DEPTH, D_MODEL, PROJ_WIDTH), D_MODEL ** -0.5),
        "conv_w": nrm(ks[2], (DEPTH, CONV_WIDTH, 3 * DN_WIDTH), CONV_WIDTH ** -0.5),
        "dn_a_log": jnp.log(jax.random.uniform(ks[3], (DEPTH, DN_HEADS), f32, 1.0, 16.0)),
        "dn_dt_bias": dt + jnp.log(-jnp.expm1(-dt)),
        "dn_norm_g": 1.0 + nrm(ks[5], (DEPTH, DN_HEAD_DIM), 0.02),
        "w_proj_a": nrm(ks[6], (DEPTH, DN_WIDTH, D_MODEL), DN_WIDTH ** -0.5),
        "w_proj_b": nrm(ks[7], (DEPTH, SB_WIDTH, D_MODEL), SB_WIDTH ** -0.5),
        "w_out": nrm(ks[8], (DEPTH, D_MODEL, D_MODEL), D_MODEL ** -0.5 * DEEPNORM_BETA),
        "ln1_g": 1.0 + nrm(ks[9], (DEPTH, D_MODEL), 0.02),
        "ln1_b": nrm(ks[10], (DEPTH, D_MODEL), 0.02),
        "w_router": nrm(ks[11], (DEPTH, D_MODEL, N_EXPERTS), D_MODEL ** -0.5),
        "router_bias": nrm(ks[12], (DEPTH, N_EXPERTS), 0.01),
        "w_shared_up": nrm(ks[13], (DEPTH, D_MODEL, 2 * SHARED_FF), D_MODEL ** -0.5),
        "w_shared_down": nrm(ks[14], (DEPTH, SHARED_FF, D_MODEL), SHARED_FF ** -0.5 * DEEPNORM_BETA),
        "w_expert_up": nrm(ks[15], (DEPTH, N_EXPERTS, D_MODEL, 2 * EXPERT_FF), D_MODEL ** -0.5),
        "w_expert_down": nrm(ks[16], (DEPTH, N_EXPERTS, EXPERT_FF, D_MODEL),
                             EXPERT_FF ** -0.5 * DEEPNORM_BETA),
        "ln2_g": 1.0 + nrm(ks[17], (DEPTH, D_MODEL), 0.02),
        "ln2_b": nrm(ks[18], (DEPTH, D_MODEL), 0.02),
    }


def reference(x, w_in, conv_w, dn_a_log, dn_dt_bias, dn_norm_g, w_proj_a, w_proj_b, w_out,
              ln1_g, ln1_b, w_router, router_bias, w_shared_up, w_shared_down, w_expert_up,
              w_expert_down, ln2_g, ln2_b):
    for layer in range(DEPTH):
        x = hybrid_layer(x, w_in[layer], conv_w[layer], dn_a_log[layer], dn_dt_bias[layer],
                         dn_norm_g[layer], w_proj_a[layer], w_proj_b[layer], w_out[layer],
                         ln1_g[layer], ln1_b[layer], w_router[layer], router_bias[layer],
                         w_shared_up[layer], w_shared_down[layer], w_expert_up[layer],
                         w_expert_down[layer], ln2_g[layer], ln2_b[layer])
    return x
```

```cpp
#include <hip/hip_runtime.h>
#include <hip/hip_cooperative_groups.h>
#include <cstdio>
#include <cstdint>
namespace cg = cooperative_groups;

constexpr int D = 1024, NB = 8, SEQ = 2048, T = NB * SEQ;
constexpr int DNH = 4, DND = 128, DNW = 512;
constexpr int SBH = 8, SBD = 64, SBW = 512;
constexpr int NE = 256, TOPK = 8, NG = 8, TOPG = 4, EFF = 256, SFF = 256;
constexpr int PW = 5640;
constexpr int C_DQ = 0, C_DK = 512, C_DV = 1024, C_DZ = 1536, C_DBETA = 2048, C_DA = 2052, C_SQ = 2056, C_SK = 2568,
              C_SV = 3080, C_GA = 3592, C_GB = 4616;
constexpr int NPAIR = T * TOPK;
constexpr int NBLK = (NPAIR + NE * 127 + 127) / 128;
constexpr int PROWS = NBLK * 128;
constexpr float ALPHA = 1.189207115002721f;
constexpr float LN_EPS = 1e-5f, NORM_EPS = 1e-6f;
constexpr int NT = 512;

struct Params {
    const float *x, *w_in, *conv_w, *a_log, *dt_bias, *norm_g, *w_pa, *w_pb, *w_out, *ln1_g, *ln1_b, *w_router,
        *router_bias, *w_su, *w_sd, *w_eu, *w_ed, *ln2_g, *ln2_b;
    float* out;
    float *proj, *qa, *ka, *va, *gl, *bt, *oraw, *oa, *ob, *m1, *m2, *pre1, *h, *scores, *gate, *U, *Ush, *ypair, *ysh;
    int *idx, *counts, *cursor, *padpair;
};

__device__ __forceinline__ float sigmoidf_(float v) { return 1.f / (1.f + expf(-v)); }
__device__ __forceinline__ float siluf_(float v) { return v / (1.f + expf(-v)); }
__device__ __forceinline__ float wave_sum(float v) {
#pragma unroll
    for (int o = 32; o > 0; o >>= 1) v += __shfl_xor(v, o);
    return v;
}

template <class AF, class TF, class BF, class EF>
__device__ __forceinline__ void gemm_naive(int M, int N, int K, AF af, TF tf, BF bf, EF ef, float* smem) {
    float(*As)[68] = (float(*)[68])smem;
    float(*Bs)[132] = (float(*)[132])(smem + 16 * 68);
    const int tid = threadIdx.x, tx = tid & 31, ty = tid >> 5;
    const int mt = M / 64, nt = (N + 127) / 128;
    for (int tile = blockIdx.x; tile < mt * nt; tile += gridDim.x) {
        const int tm = tile / nt, tn = tile % nt;
        const int ctx = tf(tm);
        float acc[4][4];
#pragma unroll
        for (int i = 0; i < 4; ++i)
#pragma unroll
            for (int j = 0; j < 4; ++j) acc[i][j] = 0.f;
        for (int k0 = 0; k0 < K; k0 += 16) {
#pragma unroll
            for (int i = 0; i < 2; ++i) {
                const int e = tid + i * 512, r = e >> 4, kk = e & 15;
                As[kk][r] = af(tm * 64 + r, k0 + kk);
            }
#pragma unroll
            for (int i = 0; i < 4; ++i) {
                const int e = tid + i * 512, kk = e >> 7, c = e & 127;
                const int col = tn * 128 + c;
                Bs[kk][c] = (col < N) ? bf(ctx, k0 + kk, col) : 0.f;
            }
            __syncthreads();
#pragma unroll
            for (int kk = 0; kk < 16; ++kk) {
                const float4 a = *(const float4*)&As[kk][ty * 4];
                const float4 b = *(const float4*)&Bs[kk][tx * 4];
                const float av[4] = {a.x, a.y, a.z, a.w}, bv[4] = {b.x, b.y, b.z, b.w};
#pragma unroll
                for (int i = 0; i < 4; ++i)
#pragma unroll
                    for (int j = 0; j < 4; ++j) acc[i][j] = fmaf(av[i], bv[j], acc[i][j]);
            }
            __syncthreads();
        }
#pragma unroll
        for (int i = 0; i < 4; ++i)
#pragma unroll
            for (int j = 0; j < 4; ++j) {
                const int r = tm * 64 + ty * 4 + i, c = tn * 128 + tx * 4 + j;
                if (c < N) ef(r, c, acc[i][j]);
            }
    }
}

__device__ void phase_init(const Params& p) {
    const int gtid = blockIdx.x * NT + threadIdx.x, gsz = gridDim.x * NT;
    for (int i = gtid; i < NE; i += gsz) { p.counts[i] = 0; p.cursor[i] = 0; }
    for (int i = gtid; i < PROWS; i += gsz) p.padpair[i] = -1;
}

__device__ void phase_dn_prep(const Params& p) {
    const int lane = threadIdx.x & 63, wave = (blockIdx.x * NT + threadIdx.x) >> 6, nw = (gridDim.x * NT) >> 6;
    for (int item = wave; item < T * 12; item += nw) {
        const int t = item / 12, j = item % 12, type = j >> 2, hh = j & 3;
        const int s = t & (SEQ - 1);
        float v[2];
#pragma unroll
        for (int u = 0; u < 2; ++u) {
            const int col = type * 512 + hh * 128 + lane * 2 + u;
            float acc = 0.f;
#pragma unroll
            for (int tap = 0; tap < 4; ++tap) {
                const int ds = s + tap - 3;
                if (ds >= 0) acc += p.proj[(size_t)(t + tap - 3) * PW + col] * p.conv_w[tap * 1536 + col];
            }
            v[u] = siluf_(acc);
        }
        if (type < 2) {
            const float ss = wave_sum(v[0] * v[0] + v[1] * v[1]);
            float r = rsqrtf(ss + NORM_EPS);
            if (type == 0) r *= 0.08838834764831845f;
            v[0] *= r; v[1] *= r;
        }
        float* dst = (type == 0 ? p.qa : type == 1 ? p.ka : p.va) + (size_t)t * DNW + hh * 128 + lane * 2;
        dst[0] = v[0]; dst[1] = v[1];
    }
    const int gtid = blockIdx.x * NT + threadIdx.x, gsz = gridDim.x * NT;
    for (int i = gtid; i < T * 4; i += gsz) {
        const int t = i >> 2, hh = i & 3;
        const float da = p.proj[(size_t)t * PW + C_DA + hh] + p.dt_bias[hh];
        const float sp = (da > 20.f) ? da : log1pf(expf(da));
        p.gl[i] = -expf(p.a_log[hh]) * sp;
        p.bt[i] = sigmoidf_(p.proj[(size_t)t * PW + C_DBETA + hh]);
    }
}

__device__ void deltanet_naive(const Params& p, int b, float* smem) {
    const int tid = threadIdx.x, hh = tid >> 7, e = tid & 127;
    float* ks = smem;
    float* qs = smem + 8 * 512;
    float* vs = smem + 16 * 512;
    float* gs = smem + 24 * 512;
    float* bs = gs + 32;
    float S[128];
#pragma unroll
    for (int d = 0; d < 128; ++d) S[d] = 0.f;
    for (int t0 = 0; t0 < SEQ; t0 += 8) {
        const size_t base = (size_t)(b * SEQ + t0) * DNW;
        for (int i = tid; i < 8 * 512; i += NT) { ks[i] = p.ka[base + i]; qs[i] = p.qa[base + i]; vs[i] = p.va[base + i]; }
        if (tid < 32) { gs[tid] = p.gl[(size_t)(b * SEQ + t0) * 4 + tid]; bs[tid] = p.bt[(size_t)(b * SEQ + t0) * 4 + tid]; }
        __syncthreads();
        for (int tt = 0; tt < 8; ++tt) {
            const float* kk = ks + tt * 512 + hh * 128;
            const float* qq = qs + tt * 512 + hh * 128;
            float kS = 0.f;
#pragma unroll
            for (int d = 0; d < 128; ++d) { kS = fmaf(kk[d], S[d], kS); if ((d & 15) == 15) asm volatile("" ::: "memory"); }
            const float eg = expf(gs[tt * 4 + hh]), be = bs[tt * 4 + hh], ve = vs[tt * 512 + tid];
            const float c = be * (ve - eg * kS);
            float o = 0.f;
#pragma unroll
            for (int d = 0; d < 128; ++d) { S[d] = fmaf(kk[d], c, eg * S[d]); o = fmaf(qq[d], S[d], o); if ((d & 15) == 15) asm volatile("" ::: "memory"); }
            p.oraw[(size_t)(b * SEQ + t0 + tt) * DNW + tid] = o;
        }
        __syncthreads();
    }
}

__device__ void sb_attn_naive(const Params& p, int item, float* smem) {
    const int tid = threadIdx.x;
    const int bh = item >> 2, chunk = item & 3, b = bh >> 3, hh = bh & 7;
    const int qbase = chunk * 512, tq = qbase + tid;
    float* Ks = smem;
    float* Vs = smem + 64 * 64;
    float q[64], o[64];
    const float* qp = p.proj + (size_t)(b * SEQ + tq) * PW + C_SQ + hh * 64;
#pragma unroll
    for (int d = 0; d < 64; ++d) { q[d] = qp[d] * 0.125f; o[d] = 0.f; }
    float run = 0.f;
    for (int s0 = qbase + 448; s0 >= 0; s0 -= 64) {
        for (int i = tid; i < 64 * 64; i += NT) {
            const int r = i >> 6, c = i & 63;
            const size_t rowoff = (size_t)(b * SEQ + s0 + r) * PW + hh * 64 + c;
            Ks[i] = p.proj[rowoff + C_SK];
            Vs[i] = p.proj[rowoff + C_SV];
        }
        __syncthreads();
        for (int ss = 63; ss >= 0; --ss) {
            const int s = s0 + ss;
            if (s < tq) {
                float z = 0.f;
#pragma unroll
                for (int d = 0; d < 64; ++d) z = fmaf(q[d], Ks[ss * 64 + d], z);
                const float lb = fminf(z, 0.f) - log1pf(expf(-fabsf(z)));
                const float a = expf(lb + run);
                run += lb - z;
#pragma unroll
                for (int d = 0; d < 64; ++d) o[d] = fmaf(a, Vs[ss * 64 + d], o[d]);
            }
        }
        __syncthreads();
    }
    float* op = p.ob + (size_t)(b * SEQ + tq) * SBW + hh * 64;
#pragma unroll
    for (int d = 0; d < 64; ++d) op[d] = o[d];
}

__device__ void phase_mixers(const Params& p, float* smem) {
    for (int item = blockIdx.x; item < 8 + 256; item += gridDim.x) {
#ifndef NO_DN
        if (item < 8) deltanet_naive(p, item, smem);
#endif
#ifndef NO_ATTN
        if (item >= 8) sb_attn_naive(p, item - 8, smem);
#endif
    }
}

__device__ void phase_gated_norm(const Params& p) {
    const int lane = threadIdx.x & 63, wave = (blockIdx.x * NT + threadIdx.x) >> 6, nw = (gridDim.x * NT) >> 6;
    for (int item = wave; item < T * 4; item += nw) {
        const int t = item >> 2, hh = item & 3;
        const size_t off = (size_t)t * DNW + hh * 128 + lane * 2;
        const float v0 = p.oraw[off], v1 = p.oraw[off + 1];
        const float ss = wave_sum(v0 * v0 + v1 * v1);
        const float r = rsqrtf(ss * (1.f / 128.f) + NORM_EPS);
        const float z0 = p.proj[(size_t)t * PW + C_DZ + hh * 128 + lane * 2], z1 = p.proj[(size_t)t * PW + C_DZ + hh * 128 + lane * 2 + 1];
        p.oa[off] = v0 * r * p.norm_g[lane * 2] * siluf_(z0);
        p.oa[off + 1] = v1 * r * p.norm_g[lane * 2 + 1] * siluf_(z1);
    }
}

template <class SF>
__device__ __forceinline__ void layer_norm_rows(SF sf, const float* g, const float* bb, float* dst) {
    const int lane = threadIdx.x & 63, wave = (blockIdx.x * NT + threadIdx.x) >> 6, nw = (gridDim.x * NT) >> 6;
    for (int t = wave; t < T; t += nw) {
        float v[16];
        float s = 0.f;
#pragma unroll
        for (int i = 0; i < 16; ++i) { v[i] = sf(t, lane + i * 64); s += v[i]; }
        const float mu = wave_sum(s) * (1.f / 1024.f);
        float q = 0.f;
#pragma unroll
        for (int i = 0; i < 16; ++i) { const float d = v[i] - mu; q += d * d; }
        const float rstd = rsqrtf(wave_sum(q) * (1.f / 1024.f) + LN_EPS);
#pragma unroll
        for (int i = 0; i < 16; ++i) { const int c = lane + i * 64; dst[(size_t)t * D + c] = (v[i] - mu) * rstd * g[c] + bb[c]; }
    }
}

__device__ void phase_route(const Params& p) {
    const int gtid = blockIdx.x * NT + threadIdx.x, gsz = gridDim.x * NT;
    for (int t = gtid; t < T; t += gsz) {
        const float* sc = p.scores + (size_t)t * NE;
        float gscore[NG];
        for (int g = 0; g < NG; ++g) {
            float m1 = -INFINITY, m2 = -INFINITY;
            for (int i = 0; i < 32; ++i) {
                const float v = sc[g * 32 + i] + p.router_bias[g * 32 + i];
                if (v > m1) { m2 = m1; m1 = v; } else if (v > m2) m2 = v;
            }
            gscore[g] = m1 + m2;
        }
        unsigned gmask = 0;
        for (int it = 0; it < TOPG; ++it) {
            int best = -1; float bv = -INFINITY;
            for (int g = 0; g < NG; ++g)
                if (!((gmask >> g) & 1u) && (best < 0 || gscore[g] > bv)) { best = g; bv = gscore[g]; }
            gmask |= 1u << best;
        }
        int chosen[TOPK]; float cw[TOPK]; float wsum = 0.f;
        float last = INFINITY; int lasti = -1;
        for (int it = 0; it < TOPK; ++it) {
            int best = -1; float bv = -INFINITY;
            for (int g = 0; g < NG; ++g) {
                if (!((gmask >> g) & 1u)) continue;
                for (int i = 0; i < 32; ++i) {
                    const int e = g * 32 + i;
                    const float v = sc[e] + p.router_bias[e];
                    const bool after = (v < last) || (v == last && e > lasti);
                    if (after && (best < 0 || v > bv)) { best = e; bv = v; }
                }
            }
            chosen[it] = best; cw[it] = sc[best]; wsum += cw[it]; last = bv; lasti = best;
        }
        for (int it = 0; it < TOPK; ++it) {
            p.idx[t * TOPK + it] = chosen[it];
            p.gate[t * TOPK + it] = cw[it] / wsum * 2.5f;
            atomicAdd(&p.counts[chosen[it]], 1);
        }
    }
}

__device__ void compute_pend(const Params& p, int* pend) {
    if (threadIdx.x == 0) {
        int acc = 0;
        for (int e = 0; e < NE; ++e) { const int c = p.counts[e]; acc += (c + 127) / 128 * 128; pend[e] = acc; }
    }
    __syncthreads();
}

__device__ void phase_scatter(const Params& p, int* pend) {
    compute_pend(p, pend);
    const int gtid = blockIdx.x * NT + threadIdx.x, gsz = gridDim.x * NT;
    for (int pr = gtid; pr < NPAIR; pr += gsz) {
        const int e = p.idx[pr];
        const int pstart = (e == 0) ? 0 : pend[e - 1];
        const int pos = pstart + atomicAdd(&p.cursor[e], 1);
        p.padpair[pos] = pr;
    }
}

__device__ __forceinline__ int expert_of_row(const int* pend, int row) {
    int lo = 0, hi = NE - 1;
    while (lo < hi) { const int mid = (lo + hi) >> 1; if (pend[mid] > row) hi = mid; else lo = mid + 1; }
    return lo;
}

__global__ void __launch_bounds__(NT) fwd_megakernel(Params p) {
    cg::grid_group grid = cg::this_grid();
    __shared__ __attribute__((aligned(16))) float smem[16 * 1024];
    __shared__ int pend[NE];

    phase_init(p);
    gemm_naive(T, PW, D,
        [&](int r, int k) { return p.x[(size_t)r * D + k]; },
        [&](int) { return 0; },
        [&](int, int k, int c) { return p.w_in[(size_t)k * PW + c]; },
        [&](int r, int c, float v) { p.proj[(size_t)r * PW + c] = v; }, smem);
    grid.sync();
    phase_dn_prep(p);
    grid.sync();
    phase_mixers(p, smem);
    grid.sync();
    phase_gated_norm(p);
    grid.sync();
    gemm_naive(T, D, DNW,
        [&](int r, int k) { return p.oa[(size_t)r * DNW + k]; },
        [&](int) { return 0; },
        [&](int, int k, int c) { return p.w_pa[(size_t)k * D + c]; },
        [&](int r, int c, float v) { p.m1[(size_t)r * D + c] = v * sigmoidf_(p.proj[(size_t)r * PW + C_GA + c]); }, smem);
    gemm_naive(T, D, SBW,
        [&](int r, int k) { return p.ob[(size_t)r * SBW + k]; },
        [&](int) { return 0; },
        [&](int, int k, int c) { return p.w_pb[(size_t)k * D + c]; },
        [&](int r, int c, float v) { p.m2[(size_t)r * D + c] = v * sigmoidf_(p.proj[(size_t)r * PW + C_GB + c]); }, smem);
    grid.sync();
    gemm_naive(T, D, D,
        [&](int r, int k) { return p.m1[(size_t)r * D + k] + p.m2[(size_t)r * D + k]; },
        [&](int) { return 0; },
        [&](int, int k, int c) { return p.w_out[(size_t)k * D + c]; },
        [&](int r, int c, float v) { p.pre1[(size_t)r * D + c] = v + ALPHA * p.x[(size_t)r * D + c]; }, smem);
    grid.sync();
    layer_norm_rows([&](int t, int c) { return p.pre1[(size_t)t * D + c]; }, p.ln1_g, p.ln1_b, p.h);
    grid.sync();
    gemm_naive(T, NE, D,
        [&](int r, int k) { return p.h[(size_t)r * D + k]; },
        [&](int) { return 0; },
        [&](int, int k, int c) { return p.w_router[(size_t)k * NE + c]; },
        [&](int r, int c, float v) { p.scores[(size_t)r * NE + c] = sigmoidf_(v); }, smem);
    gemm_naive(T, 2 * SFF, D,
        [&](int r, int k) { return p.h[(size_t)r * D + k]; },
        [&](int) { return 0; },
        [&](int, int k, int c) { return p.w_su[(size_t)k * 2 * SFF + c]; },
        [&](int r, int c, float v) { p.Ush[(size_t)r * 2 * SFF + c] = v; }, smem);
    grid.sync();
    phase_route(p);
    grid.sync();
    phase_scatter(p, pend);
    grid.sync();
    {
        const int used = pend[NE - 1];
        gemm_naive(used, 2 * EFF, D,
            [&](int r, int k) { const int pr = p.padpair[r]; return pr >= 0 ? p.h[(size_t)(pr >> 3) * D + k] : 0.f; },
            [&](int tm) { return expert_of_row(pend, tm * 64); },
            [&](int e, int k, int c) { return p.w_eu[((size_t)e * D + k) * (2 * EFF) + c]; },
            [&](int r, int c, float v) { p.U[(size_t)r * (2 * EFF) + c] = v; }, smem);
        gemm_naive(T, D, SFF,
            [&](int r, int k) { const float g = p.Ush[(size_t)r * 2 * SFF + k], u = p.Ush[(size_t)r * 2 * SFF + SFF + k]; return siluf_(g) * u; },
            [&](int) { return 0; },
        [&](int, int k, int c) { return p.w_sd[(size_t)k * D + c]; },
            [&](int r, int c, float v) { p.ysh[(size_t)r * D + c] = v; }, smem);
        grid.sync();
        gemm_naive(used, D, EFF,
            [&](int r, int k) { const float g = p.U[(size_t)r * (2 * EFF) + k], u = p.U[(size_t)r * (2 * EFF) + EFF + k]; return siluf_(g) * u; },
            [&](int tm) { return expert_of_row(pend, tm * 64); },
            [&](int e, int k, int c) { return p.w_ed[((size_t)e * EFF + k) * D + c]; },
            [&](int r, int c, float v) { const int pr = p.padpair[r]; if (pr >= 0) p.ypair[(size_t)pr * D + c] = v * p.gate[pr]; }, smem);
    }
    grid.sync();
    layer_norm_rows([&](int t, int c) {
            float f = p.ysh[(size_t)t * D + c];
#pragma unroll
            for (int k = 0; k < TOPK; ++k) f += p.ypair[((size_t)t * TOPK + k) * D + c];
            return ALPHA * p.h[(size_t)t * D + c] + f; },
        p.ln2_g, p.ln2_b, p.out);
}

extern "C" void kernel_launch(void* const* d_in, const int* in_sizes, int n_in, void* d_out, int out_size, void* d_ws,
                              size_t ws_size, hipStream_t stream) {
    static int grid_blocks = 0;
    if (!grid_blocks) {
        int dev = 0, cus = 0, per_cu = 0;
        hipGetDevice(&dev);
        hipDeviceGetAttribute(&cus, hipDeviceAttributeMultiprocessorCount, dev);
        hipOccupancyMaxActiveBlocksPerMultiprocessor(&per_cu, fwd_megakernel, NT, 0);
        if (per_cu > 1) per_cu = 1;
        grid_blocks = cus * per_cu;
    }
    Params p{};
    const float* const* in = (const float* const*)d_in;
    p.x = in[0]; p.w_in = in[1]; p.conv_w = in[2]; p.a_log = in[3]; p.dt_bias = in[4]; p.norm_g = in[5]; p.w_pa = in[6];
    p.w_pb = in[7]; p.w_out = in[8]; p.ln1_g = in[9]; p.ln1_b = in[10]; p.w_router = in[11]; p.router_bias = in[12];
    p.w_su = in[13]; p.w_sd = in[14]; p.w_eu = in[15]; p.w_ed = in[16]; p.ln2_g = in[17]; p.ln2_b = in[18];
    p.out = (float*)d_out;
    char* w = (char*)d_ws;
    size_t off = 0;
    auto take = [&](size_t bytes) { char* r = w + off; off += (bytes + 255) & ~(size_t)255; return r; };
    p.proj = (float*)take((size_t)PROWS * 512 * 4 > (size_t)T * PW * 4 ? (size_t)PROWS * 512 * 4 : (size_t)T * PW * 4);
    p.U = p.proj;
    p.qa = (float*)take((size_t)T * DNW * 4); p.ka = (float*)take((size_t)T * DNW * 4); p.va = (float*)take((size_t)T * DNW * 4);
    p.gl = (float*)take((size_t)T * 4 * 4); p.bt = (float*)take((size_t)T * 4 * 4);
    p.oraw = (float*)take((size_t)T * DNW * 4); p.oa = (float*)take((size_t)T * DNW * 4); p.ob = (float*)take((size_t)T * SBW * 4);
    p.m1 = (float*)take((size_t)T * D * 4); p.m2 = (float*)take((size_t)T * D * 4);
    p.pre1 = (float*)take((size_t)T * D * 4); p.h = (float*)take((size_t)T * D * 4);
    p.scores = (float*)take((size_t)T * NE * 4); p.gate = (float*)take((size_t)NPAIR * 4);
    p.Ush = (float*)take((size_t)T * 2 * SFF * 4);
    p.ypair = (float*)take((size_t)NPAIR * D * 4); p.ysh = (float*)take((size_t)T * D * 4);
    p.idx = (int*)take((size_t)NPAIR * 4); p.counts = (int*)take(NE * 4); p.cursor = (int*)take(NE * 4);
    p.padpair = (int*)take((size_t)PROWS * 4);
    if (off > ws_size) { fprintf(stderr, "workspace too small: need %zu have %zu\n", off, ws_size); return; }
    void* args[] = {&p};
    hipError_t e = hipLaunchCooperativeKernel((void*)fwd_megakernel, dim3(grid_blocks), dim3(NT), args, 0, stream);
    if (e != hipSuccess) fprintf(stderr, "cooperative launch failed: %s (grid %d)\n", hipGetErrorString(e), grid_blocks);
}
```

```cpp
#include <hip/hip_runtime.h>
#include <hip/hip_cooperative_groups.h>
#include <cstdio>
#include <cstdint>
namespace cg = cooperative_groups;

constexpr int D = 1024, NB = 8, SEQ = 2048, T = NB * SEQ;
constexpr int DNH = 4, DND = 128, DNW = 512;
constexpr int SBH = 8, SBD = 64, SBW = 512;
constexpr int NE = 256, TOPK = 8, NG = 8, TOPG = 4, EFF = 256, SFF = 256;
constexpr int PW = 5640;
constexpr int C_DQ = 0, C_DK = 512, C_DV = 1024, C_DZ = 1536, C_DBETA = 2048, C_DA = 2052, C_SQ = 2056, C_SK = 2568,
              C_SV = 3080, C_GA = 3592, C_GB = 4616;
constexpr int NPAIR = T * TOPK;
constexpr int NBLK = (NPAIR + NE * 127 + 127) / 128;
constexpr int PROWS = NBLK * 128;
constexpr float ALPHA = 1.189207115002721f;
constexpr float LN_EPS = 1e-5f, NORM_EPS = 1e-6f;
constexpr int NT = 512;

struct Params {
    const float *x, *w_in, *conv_w, *a_log, *dt_bias, *norm_g, *w_pa, *w_pb, *w_out, *ln1_g, *ln1_b, *w_router,
        *router_bias, *w_su, *w_sd, *w_eu, *w_ed, *ln2_g, *ln2_b;
    float* out;
    float *proj, *qa, *ka, *va, *gl, *bt, *oraw, *oa, *ob, *m1, *m2, *pre1, *h, *scores, *gate, *U, *Ush, *ypair, *ysh;
    int *idx, *counts, *cursor, *padpair;
    unsigned short *xb, *w_in_t, *projb, *w_pa_t, *w_pb_t, *w_out_t, *w_router_t, *w_su_t, *w_sd_t, *oab, *obb, *mergedb, *hb, *actsh, *actr, *ypairb;
};

__device__ __forceinline__ float sigmoidf_(float v) { return 1.f / (1.f + expf(-v)); }
__device__ __forceinline__ float siluf_(float v) { return v / (1.f + expf(-v)); }
__device__ __forceinline__ float wave_sum(float v) {
#pragma unroll
    for (int o = 32; o > 0; o >>= 1) v += __shfl_xor(v, o);
    return v;
}

template <class AF, class TF, class BF, class EF>
__device__ __forceinline__ void gemm_naive(int M, int N, int K, AF af, TF tf, BF bf, EF ef, float* smem) {
    float(*As)[68] = (float(*)[68])smem;
    float(*Bs)[132] = (float(*)[132])(smem + 16 * 68);
    const int tid = threadIdx.x, tx = tid & 31, ty = tid >> 5;
    const int mt = M / 64, nt = (N + 127) / 128;
    for (int tile = blockIdx.x; tile < mt * nt; tile += gridDim.x) {
        const int tm = tile / nt, tn = tile % nt;
        const int ctx = tf(tm);
        float acc[4][4];
#pragma unroll
        for (int i = 0; i < 4; ++i)
#pragma unroll
            for (int j = 0; j < 4; ++j) acc[i][j] = 0.f;
        for (int k0 = 0; k0 < K; k0 += 16) {
#pragma unroll
            for (int i = 0; i < 2; ++i) {
                const int e = tid + i * 512, r = e >> 4, kk = e & 15;
                As[kk][r] = af(tm * 64 + r, k0 + kk);
            }
#pragma unroll
            for (int i = 0; i < 4; ++i) {
                const int e = tid + i * 512, kk = e >> 7, c = e & 127;
                const int col = tn * 128 + c;
                Bs[kk][c] = (col < N) ? bf(ctx, k0 + kk, col) : 0.f;
            }
            __syncthreads();
#pragma unroll
            for (int kk = 0; kk < 16; ++kk) {
                const float4 a = *(const float4*)&As[kk][ty * 4];
                const float4 b = *(const float4*)&Bs[kk][tx * 4];
                const float av[4] = {a.x, a.y, a.z, a.w}, bv[4] = {b.x, b.y, b.z, b.w};
#pragma unroll
                for (int i = 0; i < 4; ++i)
#pragma unroll
                    for (int j = 0; j < 4; ++j) acc[i][j] = fmaf(av[i], bv[j], acc[i][j]);
            }
            __syncthreads();
        }
#pragma unroll
        for (int i = 0; i < 4; ++i)
#pragma unroll
            for (int j = 0; j < 4; ++j) {
                const int r = tm * 64 + ty * 4 + i, c = tn * 128 + tx * 4 + j;
                if (c < N) ef(r, c, acc[i][j]);
            }
    }
}


typedef unsigned short bf16_t;
typedef short bf16x8 __attribute__((ext_vector_type(8)));
typedef float f32x16 __attribute__((ext_vector_type(16)));
typedef float f32x4 __attribute__((ext_vector_type(4)));
__device__ __forceinline__ unsigned pk_bf16(float a, float b) {
    typedef __bf16 bf2 __attribute__((ext_vector_type(2)));
    typedef float f2 __attribute__((ext_vector_type(2)));
    f2 v = {a, b};
    bf2 r = __builtin_convertvector(v, bf2);
    return __builtin_bit_cast(unsigned, r);
}
__device__ __forceinline__ bf16_t to_bf16(float a) { return (bf16_t)(pk_bf16(a, 0.f) & 0xffffu); }
__device__ __forceinline__ float bf2f(bf16_t v) { return __uint_as_float((unsigned)v << 16); }

__device__ __forceinline__ int opaque_tid() { int t = threadIdx.x; asm volatile("" : "+v"(t)); return t; }
constexpr int LROW = 128;
__device__ __forceinline__ int swz(int r) { return ((r >> 2) & 7) ^ ((r >> 1) & 1); }

template <int ROWS, bool MAYBE_NULL = false> struct LoadRowsBf16 {
    static constexpr int NCH = ROWS * 8 / NT;
    const bf16_t* base; int tid;
    unsigned off[NCH];
    uint4 regs[NCH];
    template <class RF> __device__ __forceinline__ void init(const bf16_t* base_, int ld, RF rowfn) {
        base = base_; tid = opaque_tid();
#pragma unroll
        for (int i = 0; i < NCH; ++i) {
            const int c = tid + i * NT, r = c >> 3, ch = c & 7;
            const long long src = rowfn(r);
            off[i] = (!MAYBE_NULL || src >= 0) ? (unsigned)(src * ld + ch * 8) : 0xffffffffu;
        }
    }
    __device__ __forceinline__ void load(int k0) {
#pragma unroll
        for (int i = 0; i < NCH; ++i)
            regs[i] = (!MAYBE_NULL || off[i] != 0xffffffffu) ? *(const uint4*)(base + (size_t)off[i] + k0) : make_uint4(0, 0, 0, 0);
    }
    __device__ __forceinline__ void store(unsigned char* lds) const {
#pragma unroll
        for (int i = 0; i < NCH; ++i) {
            const int c = tid + i * NT, r = c >> 3, ch = c & 7;
            *(uint4*)(lds + r * LROW + ((ch ^ swz(r)) << 4)) = regs[i];
        }
    }
};

struct LoadKNF32 {
    const float* base; int ld, kq, nq;
    f32x4 regs[8];
    template <class CF> __device__ __forceinline__ void init(const float* w, int ld_, CF colfn) {
        const int tid = opaque_tid(); kq = tid >> 6; nq = tid & 63; ld = ld_;
        base = w + (size_t)(kq * 8) * ld_ + colfn(nq * 4);
    }
    __device__ __forceinline__ void load(int k0) {
#pragma unroll
        for (int j = 0; j < 8; ++j) regs[j] = *(const f32x4*)(base + (size_t)(k0 + j) * ld);
    }
    __device__ __forceinline__ void store1(unsigned char* lds, int nn, float a0, float a1, float a2, float a3, float a4, float a5, float a6, float a7) const {
        uint4 o; o.x = pk_bf16(a0, a1); o.y = pk_bf16(a2, a3); o.z = pk_bf16(a4, a5); o.w = pk_bf16(a6, a7);
        const int row = nq * 4 + nn;
        *(uint4*)(lds + row * LROW + ((kq ^ swz(row)) << 4)) = o;
    }
    __device__ __forceinline__ void store(unsigned char* lds) const {
        store1(lds, 0, regs[0].x, regs[1].x, regs[2].x, regs[3].x, regs[4].x, regs[5].x, regs[6].x, regs[7].x);
        store1(lds, 1, regs[0].y, regs[1].y, regs[2].y, regs[3].y, regs[4].y, regs[5].y, regs[6].y, regs[7].y);
        store1(lds, 2, regs[0].z, regs[1].z, regs[2].z, regs[3].z, regs[4].z, regs[5].z, regs[6].z, regs[7].z);
        store1(lds, 3, regs[0].w, regs[1].w, regs[2].w, regs[3].w, regs[4].w, regs[5].w, regs[6].w, regs[7].w);
    }
};

template <int BM_, int BN_, int WM_, int WN_> struct GemmCfg {
    static constexpr int BM = BM_, BN = BN_, WM = WM_, WN = WN_;
    static constexpr int TM = BM / WM, TN = BN / WN, MI = TM / 32, NI = TN / 32;
    static constexpr int A_BYTES = BM * LROW, B_BYTES = BN * LROW, STAGE = A_BYTES + B_BYTES;
    static_assert(WM * WN == 8, "8 waves");
};

template <class CFG, class AL, class BL>
__device__ __forceinline__ void gemm_mainloop(AL& al, BL& bl, int nk, f32x16 (&acc)[CFG::MI][CFG::NI], unsigned char* lds) {
    constexpr int MI = CFG::MI, NI = CFG::NI;
    const int tid = opaque_tid(), lane = tid & 63, wid = tid >> 6;
    const int wm = wid / CFG::WN, wn = wid % CFG::WN;
    const int l31 = lane & 31, lh = lane >> 5;
    al.load(0); bl.load(0);
    const int a_off = (wm * CFG::TM + l31) * LROW;
    const int b_off = CFG::A_BYTES + (wn * CFG::TN + l31) * LROW;
    const int fsw = swz(l31);
    for (int kt = 0; kt < nk; ++kt) {
        unsigned char* st = lds + (kt & 1) * CFG::STAGE;
        al.store(st); bl.store(st + CFG::A_BYTES);
        __syncthreads();
        if (kt + 1 < nk) { al.load((kt + 1) * 64); bl.load((kt + 1) * 64); }
#pragma unroll
        for (int kk = 0; kk < 4; ++kk) {
            bf16x8 a[MI], b[NI];
#pragma unroll
            for (int mi = 0; mi < MI; ++mi) a[mi] = *(const bf16x8*)(st + a_off + mi * 32 * LROW + (((kk * 2 + lh) ^ fsw) << 4));
#pragma unroll
            for (int ni = 0; ni < NI; ++ni) b[ni] = *(const bf16x8*)(st + b_off + ni * 32 * LROW + (((kk * 2 + lh) ^ fsw) << 4));
#pragma unroll
            for (int mi = 0; mi < MI; ++mi)
#pragma unroll
                for (int ni = 0; ni < NI; ++ni)
                    acc[mi][ni] = __builtin_amdgcn_mfma_f32_32x32x16_bf16(a[mi], b[ni], acc[mi][ni], 0, 0, 0);
        }
    }
    __syncthreads();
}
template <class CFG> __device__ __forceinline__ void acc_zero(f32x16 (&acc)[CFG::MI][CFG::NI]) {
#pragma unroll
    for (int mi = 0; mi < CFG::MI; ++mi)
#pragma unroll
        for (int ni = 0; ni < CFG::NI; ++ni)
#pragma unroll
            for (int r = 0; r < 16; ++r) acc[mi][ni][r] = 0.f;
}
template <class CFG, class F> __device__ __forceinline__ void acc_foreach(f32x16 (&acc)[CFG::MI][CFG::NI], F f) {
    const int tid = opaque_tid(), lane = tid & 63, wid = tid >> 6;
    const int wm = wid / CFG::WN, wn = wid % CFG::WN;
#pragma unroll
    for (int mi = 0; mi < CFG::MI; ++mi)
#pragma unroll
        for (int ni = 0; ni < CFG::NI; ++ni) {
            asm volatile("" ::: "memory");
#pragma unroll
            for (int r = 0; r < 16; ++r)
                acc[mi][ni][r] = f(wm * CFG::TM + mi * 32 + (r & 3) + 8 * (r >> 2) + 4 * (lane >> 5), wn * CFG::TN + ni * 32 + (lane & 31), acc[mi][ni][r], mi, ni, r);
        }
}

struct TileMap {
    int ntm, ntn, npm, npn, rounds; bool patched;
    int pm, pn;
    __device__ __forceinline__ void init(int ntm_, int ntn_, int pn_ = 8) {
        ntm = ntm_; ntn = ntn_; patched = (gridDim.x == 256); pn = pn_; pm = 32 / pn_;
        if (patched) { npm = (ntm + pm - 1) / pm; npn = (ntn + pn - 1) / pn; rounds = (npm * npn + 7) / 8; }
        else { npm = npn = 0; rounds = (ntm * ntn + gridDim.x - 1) / gridDim.x; }
    }
    __device__ __forceinline__ bool get(int round, int& tm, int& tn) const {
        const int b = blockIdx.x;
        if (patched) {
            const int patch = round * 8 + (b & 7), slot = b >> 3;
            if (patch >= npm * npn) return false;
            tm = (patch / npn) * pm + slot / pn; tn = (patch % npn) * pn + slot % pn;
            return tm < ntm && tn < ntn;
        }
        const int t = round * gridDim.x + b;
        if (t >= ntm * ntn) return false;
        tm = t / ntn; tn = t % ntn; return true;
    }
};

__device__ void transpose_convert(const float* W, int K, int N, int NP, bf16_t* Wt, float* sm) {
    const int tid = threadIdx.x, ntk = K / 64, ntn = NP / 64;
    for (int tile = blockIdx.x; tile < ntk * ntn; tile += gridDim.x) {
        const int tk = tile % ntk, tn = tile / ntk;
#pragma unroll
        for (int i = 0; i < 8; ++i) {
            const int e = tid + i * NT, kk = e >> 6, nn = e & 63, col = tn * 64 + nn;
            sm[nn * 65 + kk] = col < N ? W[(size_t)(tk * 64 + kk) * N + col] : 0.f;
        }
        __syncthreads();
        const int n = tid >> 3, kc = tid & 7;
        const float* r = sm + n * 65 + kc * 8;
        uint4 o; o.x = pk_bf16(r[0], r[1]); o.y = pk_bf16(r[2], r[3]); o.z = pk_bf16(r[4], r[5]); o.w = pk_bf16(r[6], r[7]);
        *(uint4*)(Wt + (size_t)(tn * 64 + n) * K + tk * 64 + kc * 8) = o;
        __syncthreads();
    }
}
__device__ void convert_bf16(const float* src, bf16_t* dst, size_t n) {
    const size_t gtid = (size_t)blockIdx.x * NT + threadIdx.x, gsz = (size_t)gridDim.x * NT;
    for (size_t i = gtid; i < n / 8; i += gsz) {
        const float4 a = ((const float4*)src)[2 * i], b = ((const float4*)src)[2 * i + 1];
        uint4 o; o.x = pk_bf16(a.x, a.y); o.y = pk_bf16(a.z, a.w); o.z = pk_bf16(b.x, b.y); o.w = pk_bf16(b.z, b.w);
        ((uint4*)dst)[i] = o;
    }
}

constexpr int PWP = 5888;
__device__ void phase_inproj(const Params& p, unsigned char* lds) {
    typedef GemmCfg<256, 256, 2, 4> CFG;
    TileMap tmap; tmap.init(T / 256, PWP / 256);
    for (int round = 0; round < tmap.rounds; ++round) {
        int tm, tn;
        if (!tmap.get(round, tm, tn)) continue;
        LoadRowsBf16<256> al, bl;
        al.init(p.xb, D, [&](int r) { return (long long)(tm * 256 + r); });
        bl.init(p.w_in_t, D, [&](int r) { return (long long)(tn * 256 + r); });
        f32x16 acc[CFG::MI][CFG::NI];
        acc_zero<CFG>(acc);
        gemm_mainloop<CFG>(al, bl, D / 64, acc, lds);
        asm volatile("" : "+s"(tm), "+s"(tn));
        acc_foreach<CFG>(acc, [&](int r, int c, float v, int, int, int) {
            const int row = tm * 256 + r, col = tn * 256 + c;
            if (col < PW) p.projb[(size_t)row * PW + col] = to_bf16(v);
            return v;
        });
    }
}

__device__ void phase_merge(const Params& p, unsigned char* lds) {
    typedef GemmCfg<128, 256, 2, 4> CFG;
    TileMap tmap; tmap.init(T / 128, D / 256);
    for (int round = 0; round < tmap.rounds; ++round) {
        int tm, tn;
        if (!tmap.get(round, tm, tn)) continue;
        f32x16 acc[CFG::MI][CFG::NI];
        {
            LoadRowsBf16<128> al; LoadRowsBf16<256> bl;
            al.init(p.oab, DNW, [&](int r) { return (long long)(tm * 128 + r); });
            bl.init(p.w_pa_t, DNW, [&](int r) { return (long long)(tn * 256 + r); });
            acc_zero<CFG>(acc);
            gemm_mainloop<CFG>(al, bl, DNW / 64, acc, lds);
            asm volatile("" : "+s"(tm), "+s"(tn));
        }
        acc_foreach<CFG>(acc, [&](int r, int c, float v, int, int, int) {
            const bf16_t* g = p.projb + (size_t)(tm * 128 + r) * PW + tn * 256 + c;
            const float ga = sigmoidf_(bf2f(g[C_GA])), gb = fmaxf(sigmoidf_(bf2f(g[C_GB])), 1e-30f);
            return v * (ga / gb);
        });
        {
            LoadRowsBf16<128> al; LoadRowsBf16<256> bl;
            al.init(p.obb, SBW, [&](int r) { return (long long)(tm * 128 + r); });
            bl.init(p.w_pb_t, SBW, [&](int r) { return (long long)(tn * 256 + r); });
            gemm_mainloop<CFG>(al, bl, SBW / 64, acc, lds);
            asm volatile("" : "+s"(tm), "+s"(tn));
        }
        acc_foreach<CFG>(acc, [&](int r, int c, float v, int, int, int) {
            const int row = tm * 128 + r, col = tn * 256 + c;
            const float gb = fmaxf(sigmoidf_(bf2f(p.projb[(size_t)row * PW + C_GB + col])), 1e-30f);
            p.mergedb[(size_t)row * D + col] = to_bf16(v * gb);
            return v;
        });
    }
}

__device__ void phase_outproj(const Params& p, unsigned char* lds) {
    typedef GemmCfg<256, 256, 2, 4> CFG;
    TileMap tmap; tmap.init(T / 256, D / 256);
    for (int round = 0; round < tmap.rounds; ++round) {
        int tm, tn;
        if (!tmap.get(round, tm, tn)) continue;
        LoadRowsBf16<256> al, bl;
        al.init(p.mergedb, D, [&](int r) { return (long long)(tm * 256 + r); });
        bl.init(p.w_out_t, D, [&](int r) { return (long long)(tn * 256 + r); });
        f32x16 acc[CFG::MI][CFG::NI];
        acc_zero<CFG>(acc);
        gemm_mainloop<CFG>(al, bl, D / 64, acc, lds);
        asm volatile("" : "+s"(tm), "+s"(tn));
        acc_foreach<CFG>(acc, [&](int r, int c, float v, int, int, int) {
            const size_t o = (size_t)(tm * 256 + r) * D + tn * 256 + c;
            p.pre1[o] = v + ALPHA * p.x[o];
            return v;
        });
    }
}

__device__ void phase_router_shared_up(const Params& p, unsigned char* lds) {
    {
        typedef GemmCfg<128, 128, 4, 2> CFG;
        TileMap tmap; tmap.init(T / 128, NE / 128);
        for (int round = 0; round < tmap.rounds; ++round) {
            int tm, tn;
            if (!tmap.get(round, tm, tn)) continue;
            LoadRowsBf16<128> al, bl;
            al.init(p.hb, D, [&](int r) { return (long long)(tm * 128 + r); });
            bl.init(p.w_router_t, D, [&](int r) { return (long long)(tn * 128 + r); });
            f32x16 acc[CFG::MI][CFG::NI];
            acc_zero<CFG>(acc);
            gemm_mainloop<CFG>(al, bl, D / 64, acc, lds);
            asm volatile("" : "+s"(tm), "+s"(tn));
            acc_foreach<CFG>(acc, [&](int r, int c, float v, int, int, int) {
                p.scores[(size_t)(tm * 128 + r) * NE + tn * 128 + c] = sigmoidf_(v);
                return v;
            });
        }
    }
    {
        typedef GemmCfg<128, 256, 2, 4> CFG;
        TileMap tmap; tmap.init(T / 128, SFF / 128);
        for (int round = 0; round < tmap.rounds; ++round) {
            int tm, tn;
            if (!tmap.get(round, tm, tn)) continue;
            LoadRowsBf16<128> al; LoadRowsBf16<256> bl;
            al.init(p.hb, D, [&](int r) { return (long long)(tm * 128 + r); });
            bl.init(p.w_su_t, D, [&](int r) { return (long long)(((r >> 5) & 1) * SFF + tn * 128 + (r >> 6) * 32 + (r & 31)); });
            f32x16 acc[CFG::MI][CFG::NI];
            acc_zero<CFG>(acc);
            gemm_mainloop<CFG>(al, bl, D / 64, acc, lds);
            asm volatile("" : "+s"(tm), "+s"(tn));
            const int tid = opaque_tid(), lane = tid & 63, wid = tid >> 6, wm = wid / CFG::WN, wn = wid % CFG::WN;
#pragma unroll
            for (int mi = 0; mi < CFG::MI; ++mi)
#pragma unroll
                for (int r = 0; r < 16; ++r) {
                    const int row = tm * 128 + wm * CFG::TM + mi * 32 + (r & 3) + 8 * (r >> 2) + 4 * (lane >> 5);
                    const int j = tn * 128 + wn * 32 + (lane & 31);
                    const float g = acc[mi][0][r], u = acc[mi][1][r];
                    p.actsh[(size_t)row * SFF + j] = to_bf16(siluf_(g) * u);
                }
        }
    }
}

__device__ void phase_shared_down(const Params& p, unsigned char* lds) {
    typedef GemmCfg<256, 256, 2, 4> CFG;
    TileMap tmap; tmap.init(T / 256, D / 256);
    for (int round = 0; round < tmap.rounds; ++round) {
        int tm, tn;
        if (!tmap.get(round, tm, tn)) continue;
        LoadRowsBf16<256> al, bl;
        al.init(p.actsh, SFF, [&](int r) { return (long long)(tm * 256 + r); });
        bl.init(p.w_sd_t, SFF, [&](int r) { return (long long)(tn * 256 + r); });
        f32x16 acc[CFG::MI][CFG::NI];
        acc_zero<CFG>(acc);
        gemm_mainloop<CFG>(al, bl, SFF / 64, acc, lds);
        asm volatile("" : "+s"(tm), "+s"(tn));
        acc_foreach<CFG>(acc, [&](int r, int c, float v, int, int, int) {
            p.ysh[(size_t)(tm * 256 + r) * D + tn * 256 + c] = v;
            return v;
        });
    }
}

__device__ void phase_init(const Params& p) {
    const int gtid = blockIdx.x * NT + threadIdx.x, gsz = gridDim.x * NT;
    for (int i = gtid; i < NE; i += gsz) { p.counts[i] = 0; p.cursor[i] = 0; }
    for (int i = gtid; i < PROWS; i += gsz) p.padpair[i] = -1;
}

__device__ void phase_dn_prep(const Params& p) {
    const int lane = threadIdx.x & 63, wave = (blockIdx.x * NT + threadIdx.x) >> 6, nw = (gridDim.x * NT) >> 6;
    for (int item = wave; item < T * 12; item += nw) {
        const int t = item / 12, j = item % 12, type = j >> 2, hh = j & 3;
        const int s = t & (SEQ - 1);
        float v[2];
#pragma unroll
        for (int u = 0; u < 2; ++u) {
            const int col = type * 512 + hh * 128 + lane * 2 + u;
            float acc = 0.f;
#pragma unroll
            for (int tap = 0; tap < 4; ++tap) {
                const int ds = s + tap - 3;
                if (ds >= 0) acc += bf2f(p.projb[(size_t)(t + tap - 3) * PW + col]) * p.conv_w[tap * 1536 + col];
            }
            v[u] = siluf_(acc);
        }
        if (type < 2) {
            const float ss = wave_sum(v[0] * v[0] + v[1] * v[1]);
            float r = rsqrtf(ss + NORM_EPS);
            if (type == 0) r *= 0.08838834764831845f;
            v[0] *= r; v[1] *= r;
        }
        float* dst = (type == 0 ? p.qa : type == 1 ? p.ka : p.va) + (size_t)t * DNW + hh * 128 + lane * 2;
        dst[0] = v[0]; dst[1] = v[1];
    }
    const int gtid = blockIdx.x * NT + threadIdx.x, gsz = gridDim.x * NT;
    for (int i = gtid; i < T * 4; i += gsz) {
        const int t = i >> 2, hh = i & 3;
        const float da = bf2f(p.projb[(size_t)t * PW + C_DA + hh]) + p.dt_bias[hh];
        const float sp = (da > 20.f) ? da : log1pf(expf(da));
        p.gl[i] = -expf(p.a_log[hh]) * sp;
        p.bt[i] = sigmoidf_(bf2f(p.projb[(size_t)t * PW + C_DBETA + hh]));
    }
}

__device__ void deltanet_naive(const Params& p, int b, float* smem) {
    const int tid = threadIdx.x, hh = tid >> 7, e = tid & 127;
    float* ks = smem;
    float* qs = smem + 8 * 512;
    float* vs = smem + 16 * 512;
    float* gs = smem + 24 * 512;
    float* bs = gs + 32;
    float S[128];
#pragma unroll
    for (int d = 0; d < 128; ++d) S[d] = 0.f;
    for (int t0 = 0; t0 < SEQ; t0 += 8) {
        const size_t base = (size_t)(b * SEQ + t0) * DNW;
        for (int i = tid; i < 8 * 512; i += NT) { ks[i] = p.ka[base + i]; qs[i] = p.qa[base + i]; vs[i] = p.va[base + i]; }
        if (tid < 32) { gs[tid] = p.gl[(size_t)(b * SEQ + t0) * 4 + tid]; bs[tid] = p.bt[(size_t)(b * SEQ + t0) * 4 + tid]; }
        __syncthreads();
        for (int tt = 0; tt < 8; ++tt) {
            const float* kk = ks + tt * 512 + hh * 128;
            const float* qq = qs + tt * 512 + hh * 128;
            float kS = 0.f;
#pragma unroll
            for (int d = 0; d < 128; ++d) { kS = fmaf(kk[d], S[d], kS); if ((d & 15) == 15) asm volatile("" ::: "memory"); }
            const float eg = expf(gs[tt * 4 + hh]), be = bs[tt * 4 + hh], ve = vs[tt * 512 + tid];
            const float c = be * (ve - eg * kS);
            float o = 0.f;
#pragma unroll
            for (int d = 0; d < 128; ++d) { S[d] = fmaf(kk[d], c, eg * S[d]); o = fmaf(qq[d], S[d], o); if ((d & 15) == 15) asm volatile("" ::: "memory"); }
            p.oraw[(size_t)(b * SEQ + t0 + tt) * DNW + tid] = o;
        }
        __syncthreads();
    }
}

__device__ void sb_attn_naive(const Params& p, int item, float* smem) {
    const int tid = threadIdx.x;
    const int bh = item >> 2, chunk = item & 3, b = bh >> 3, hh = bh & 7;
    const int qbase = chunk * 512, tq = qbase + tid;
    float* Ks = smem;
    float* Vs = smem + 64 * 64;
    float q[64], o[64];
    const bf16_t* qp = p.projb + (size_t)(b * SEQ + tq) * PW + C_SQ + hh * 64;
#pragma unroll
    for (int d = 0; d < 64; ++d) { q[d] = bf2f(qp[d]) * 0.125f; o[d] = 0.f; }
    float run = 0.f;
    for (int s0 = qbase + 448; s0 >= 0; s0 -= 64) {
        for (int i = tid; i < 64 * 64; i += NT) {
            const int r = i >> 6, c = i & 63;
            const size_t rowoff = (size_t)(b * SEQ + s0 + r) * PW + hh * 64 + c;
            Ks[i] = bf2f(p.projb[rowoff + C_SK]);
            Vs[i] = bf2f(p.projb[rowoff + C_SV]);
        }
        __syncthreads();
        for (int ss = 63; ss >= 0; --ss) {
            const int s = s0 + ss;
            if (s < tq) {
                float z = 0.f;
#pragma unroll
                for (int d = 0; d < 64; ++d) z = fmaf(q[d], Ks[ss * 64 + d], z);
                const float lb = fminf(z, 0.f) - log1pf(expf(-fabsf(z)));
                const float a = expf(lb + run);
                run += lb - z;
#pragma unroll
                for (int d = 0; d < 64; ++d) o[d] = fmaf(a, Vs[ss * 64 + d], o[d]);
            }
        }
        __syncthreads();
    }
    bf16_t* op = p.obb + (size_t)(b * SEQ + tq) * SBW + hh * 64;
#pragma unroll
    for (int d = 0; d < 64; ++d) op[d] = to_bf16(o[d]);
}

__device__ void phase_mixers(const Params& p, float* smem) {
    for (int item = blockIdx.x; item < 8 + 256; item += gridDim.x) {
#ifndef NO_DN
        if (item < 8) deltanet_naive(p, item, smem);
#endif
#ifndef NO_ATTN
        if (item >= 8) sb_attn_naive(p, item - 8, smem);
#endif
    }
}

__device__ void phase_gated_norm(const Params& p) {
    const int lane = threadIdx.x & 63, wave = (blockIdx.x * NT + threadIdx.x) >> 6, nw = (gridDim.x * NT) >> 6;
    for (int item = wave; item < T * 4; item += nw) {
        const int t = item >> 2, hh = item & 3;
        const size_t off = (size_t)t * DNW + hh * 128 + lane * 2;
        const float v0 = p.oraw[off], v1 = p.oraw[off + 1];
        const float ss = wave_sum(v0 * v0 + v1 * v1);
        const float r = rsqrtf(ss * (1.f / 128.f) + NORM_EPS);
        const float z0 = bf2f(p.projb[(size_t)t * PW + C_DZ + hh * 128 + lane * 2]), z1 = bf2f(p.projb[(size_t)t * PW + C_DZ + hh * 128 + lane * 2 + 1]);
        p.oab[off] = to_bf16(v0 * r * p.norm_g[lane * 2] * siluf_(z0));
        p.oab[off + 1] = to_bf16(v1 * r * p.norm_g[lane * 2 + 1] * siluf_(z1));
    }
}

template <class SF>
__device__ __forceinline__ void layer_norm_rows(SF sf, const float* g, const float* bb, float* dst, bf16_t* dstb) {
    const int lane = threadIdx.x & 63, wave = (blockIdx.x * NT + threadIdx.x) >> 6, nw = (gridDim.x * NT) >> 6;
    for (int t = wave; t < T; t += nw) {
        float v[16];
        float s = 0.f;
#pragma unroll
        for (int i = 0; i < 16; ++i) { v[i] = sf(t, lane + i * 64); s += v[i]; }
        const float mu = wave_sum(s) * (1.f / 1024.f);
        float q = 0.f;
#pragma unroll
        for (int i = 0; i < 16; ++i) { const float d = v[i] - mu; q += d * d; }
        const float rstd = rsqrtf(wave_sum(q) * (1.f / 1024.f) + LN_EPS);
#pragma unroll
        for (int i = 0; i < 16; ++i) { const int c = lane + i * 64; const float y = (v[i] - mu) * rstd * g[c] + bb[c]; dst[(size_t)t * D + c] = y; if (dstb) dstb[(size_t)t * D + c] = to_bf16(y); }
    }
}

__device__ void phase_route(const Params& p) {
    const int gtid = blockIdx.x * NT + threadIdx.x, gsz = gridDim.x * NT;
    for (int t = gtid; t < T; t += gsz) {
        const float* sc = p.scores + (size_t)t * NE;
        float gscore[NG];
        for (int g = 0; g < NG; ++g) {
            float m1 = -INFINITY, m2 = -INFINITY;
            for (int i = 0; i < 32; ++i) {
                const float v = sc[g * 32 + i] + p.router_bias[g * 32 + i];
                if (v > m1) { m2 = m1; m1 = v; } else if (v > m2) m2 = v;
            }
            gscore[g] = m1 + m2;
        }
        unsigned gmask = 0;
        for (int it = 0; it < TOPG; ++it) {
            int best = -1; float bv = -INFINITY;
            for (int g = 0; g < NG; ++g)
                if (!((gmask >> g) & 1u) && (best < 0 || gscore[g] > bv)) { best = g; bv = gscore[g]; }
            gmask |= 1u << best;
        }
        int chosen[TOPK]; float cw[TOPK]; float wsum = 0.f;
        float last = INFINITY; int lasti = -1;
        for (int it = 0; it < TOPK; ++it) {
            int best = -1; float bv = -INFINITY;
            for (int g = 0; g < NG; ++g) {
                if (!((gmask >> g) & 1u)) continue;
                for (int i = 0; i < 32; ++i) {
                    const int e = g * 32 + i;
                    const float v = sc[e] + p.router_bias[e];
                    const bool after = (v < last) || (v == last && e > lasti);
                    if (after && (best < 0 || v > bv)) { best = e; bv = v; }
                }
            }
            chosen[it] = best; cw[it] = sc[best]; wsum += cw[it]; last = bv; lasti = best;
        }
        for (int it = 0; it < TOPK; ++it) {
            p.idx[t * TOPK + it] = chosen[it];
            p.gate[t * TOPK + it] = cw[it] / wsum * 2.5f;
            atomicAdd(&p.counts[chosen[it]], 1);
        }
    }
}

__device__ void compute_pend(const Params& p, int* pend) {
    if (threadIdx.x == 0) {
        int acc = 0;
        for (int e = 0; e < NE; ++e) { const int c = p.counts[e]; acc += (c + 127) / 128 * 128; pend[e] = acc; }
    }
    __syncthreads();
}

__device__ void phase_scatter(const Params& p, int* pend) {
    compute_pend(p, pend);
    const int gtid = blockIdx.x * NT + threadIdx.x, gsz = gridDim.x * NT;
    for (int pr = gtid; pr < NPAIR; pr += gsz) {
        const int e = p.idx[pr];
        const int pstart = (e == 0) ? 0 : pend[e - 1];
        const int pos = pstart + atomicAdd(&p.cursor[e], 1);
        p.padpair[pos] = pr;
    }
}

__device__ __forceinline__ int expert_of_row(const int* pend, int row) {
    int lo = 0, hi = NE - 1;
    while (lo < hi) { const int mid = (lo + hi) >> 1; if (pend[mid] > row) hi = mid; else lo = mid + 1; }
    return lo;
}

__device__ void phase_routed_up(const Params& p, const int* pend, unsigned char* lds) {
    typedef GemmCfg<128, 256, 2, 4> CFG;
    TileMap tmap; tmap.init(pend[NE - 1] / 128, EFF / 128, 2);
    for (int round = 0; round < tmap.rounds; ++round) {
        int tm, tn;
        if (!tmap.get(round, tm, tn)) continue;
        const int e = expert_of_row(pend, tm * 128);
        LoadRowsBf16<128, true> al; LoadKNF32 bl;
        al.init(p.hb, D, [&](int r) { const int pr = p.padpair[tm * 128 + r]; return pr >= 0 ? (long long)(pr >> 3) : -1LL; });
        bl.init(p.w_eu + (size_t)e * D * (2 * EFF), 2 * EFF, [&](int r) { return ((r >> 5) & 1) * EFF + tn * 128 + (r >> 6) * 32 + (r & 31); });
        f32x16 acc[CFG::MI][CFG::NI];
        acc_zero<CFG>(acc);
        gemm_mainloop<CFG>(al, bl, D / 64, acc, lds);
        asm volatile("" : "+s"(tm), "+s"(tn));
        const int tid = opaque_tid(), lane = tid & 63, wid = tid >> 6, wm = wid / CFG::WN, wn = wid % CFG::WN;
#pragma unroll
        for (int mi = 0; mi < CFG::MI; ++mi)
#pragma unroll
            for (int r = 0; r < 16; ++r) {
                const int row = tm * 128 + wm * CFG::TM + mi * 32 + (r & 3) + 8 * (r >> 2) + 4 * (lane >> 5);
                const int j = tn * 128 + wn * 32 + (lane & 31);
                const float g = acc[mi][0][r], u = acc[mi][1][r];
                p.actr[(size_t)row * EFF + j] = to_bf16(siluf_(g) * u);
            }
    }
}

__device__ void phase_routed_down(const Params& p, const int* pend, unsigned char* lds) {
    typedef GemmCfg<128, 256, 2, 4> CFG;
    TileMap tmap; tmap.init(pend[NE - 1] / 128, D / 256, 4);
    for (int round = 0; round < tmap.rounds; ++round) {
        int tm, tn;
        if (!tmap.get(round, tm, tn)) continue;
        const int e = expert_of_row(pend, tm * 128);
        LoadRowsBf16<128> al; LoadKNF32 bl;
        al.init(p.actr, EFF, [&](int r) { return (long long)(tm * 128 + r); });
        bl.init(p.w_ed + (size_t)e * EFF * D, D, [&](int r) { return tn * 256 + r; });
        f32x16 acc[CFG::MI][CFG::NI];
        acc_zero<CFG>(acc);
        gemm_mainloop<CFG>(al, bl, EFF / 64, acc, lds);
        asm volatile("" : "+s"(tm), "+s"(tn));
        acc_foreach<CFG>(acc, [&](int r, int c, float v, int, int, int) {
            const int pr = p.padpair[tm * 128 + r];
            if (pr >= 0) p.ypairb[(size_t)pr * D + tn * 256 + c] = to_bf16(v * p.gate[pr]);
            return v;
        });
    }
}

__global__ void __launch_bounds__(NT) fwd_megakernel(Params p) {
    cg::grid_group grid = cg::this_grid();
    __shared__ __attribute__((aligned(16))) unsigned char lds[2 * (256 + 256) * LROW + NE * 4];
    float* smem = (float*)lds;
    int* pend = (int*)(lds + 2 * (256 + 256) * LROW);

    phase_init(p);
    convert_bf16(p.x, p.xb, (size_t)T * D);
    transpose_convert(p.w_in, D, PW, PWP, p.w_in_t, smem);
    transpose_convert(p.w_pa, DNW, D, D, p.w_pa_t, smem);
    transpose_convert(p.w_pb, SBW, D, D, p.w_pb_t, smem);
    transpose_convert(p.w_out, D, D, D, p.w_out_t, smem);
    transpose_convert(p.w_router, D, NE, NE, p.w_router_t, smem);
    transpose_convert(p.w_su, D, 2 * SFF, 2 * SFF, p.w_su_t, smem);
    transpose_convert(p.w_sd, SFF, D, D, p.w_sd_t, smem);
    grid.sync();
#ifndef SKIP_PHASE_INPROJ
    phase_inproj(p, lds);
#endif
    grid.sync();
    phase_dn_prep(p);
    grid.sync();
#ifndef SKIP_PHASE_MIXERS
    phase_mixers(p, smem);
#endif
    grid.sync();
    phase_gated_norm(p);
    grid.sync();
#ifndef SKIP_PHASE_MERGE
    phase_merge(p, lds);
#endif
    grid.sync();
#ifndef SKIP_PHASE_OUTPROJ
    phase_outproj(p, lds);
#endif
    grid.sync();
    layer_norm_rows([&](int t, int c) { return p.pre1[(size_t)t * D + c]; }, p.ln1_g, p.ln1_b, p.h, p.hb);
    grid.sync();
#ifndef SKIP_PHASE_ROUTER_SHARED_UP
    phase_router_shared_up(p, lds);
#endif
    grid.sync();
    phase_route(p);
    grid.sync();
    phase_scatter(p, pend);
    grid.sync();
#ifndef SKIP_RUP
    phase_routed_up(p, pend, lds);
#endif
#ifndef SKIP_PHASE_SHARED_DOWN
    phase_shared_down(p, lds);
#endif
    grid.sync();
#ifndef SKIP_RDOWN
    phase_routed_down(p, pend, lds);
#endif
    grid.sync();
    layer_norm_rows([&](int t, int c) {
            float f = p.ysh[(size_t)t * D + c];
#pragma unroll
            for (int k = 0; k < TOPK; ++k) f += bf2f(p.ypairb[((size_t)t * TOPK + k) * D + c]);
            return ALPHA * p.h[(size_t)t * D + c] + f; },
        p.ln2_g, p.ln2_b, p.out, nullptr);
}

extern "C" void kernel_launch(void* const* d_in, const int* in_sizes, int n_in, void* d_out, int out_size, void* d_ws,
                              size_t ws_size, hipStream_t stream) {
    static int grid_blocks = 0;
    if (!grid_blocks) {
        int dev = 0, cus = 0, per_cu = 0;
        hipGetDevice(&dev);
        hipDeviceGetAttribute(&cus, hipDeviceAttributeMultiprocessorCount, dev);
        hipOccupancyMaxActiveBlocksPerMultiprocessor(&per_cu, fwd_megakernel, NT, 0);
        if (per_cu > 1) per_cu = 1;
        grid_blocks = cus * per_cu;
    }
    Params p{};
    const float* const* in = (const float* const*)d_in;
    p.x = in[0]; p.w_in = in[1]; p.conv_w = in[2]; p.a_log = in[3]; p.dt_bias = in[4]; p.norm_g = in[5]; p.w_pa = in[6];
    p.w_pb = in[7]; p.w_out = in[8]; p.ln1_g = in[9]; p.ln1_b = in[10]; p.w_router = in[11]; p.router_bias = in[12];
    p.w_su = in[13]; p.w_sd = in[14]; p.w_eu = in[15]; p.w_ed = in[16]; p.ln2_g = in[17]; p.ln2_b = in[18];
    p.out = (float*)d_out;
    char* w = (char*)d_ws;
    size_t off = 0;
    auto take = [&](size_t bytes) { char* r = w + off; off += (bytes + 255) & ~(size_t)255; return r; };
    p.U = nullptr;
    p.proj = nullptr;
    p.xb = (unsigned short*)take((size_t)T * D * 2);
    p.w_in_t = (unsigned short*)take((size_t)PWP * D * 2);
    p.projb = (unsigned short*)take((size_t)T * PW * 2);
    p.w_pa_t = (unsigned short*)take((size_t)D * DNW * 2); p.w_pb_t = (unsigned short*)take((size_t)D * SBW * 2);
    p.w_out_t = (unsigned short*)take((size_t)D * D * 2); p.w_router_t = (unsigned short*)take((size_t)NE * D * 2);
    p.w_su_t = (unsigned short*)take((size_t)2 * SFF * D * 2); p.w_sd_t = (unsigned short*)take((size_t)D * SFF * 2);
    p.oab = (unsigned short*)take((size_t)T * DNW * 2); p.obb = (unsigned short*)take((size_t)T * SBW * 2);
    p.mergedb = (unsigned short*)take((size_t)T * D * 2); p.hb = (unsigned short*)take((size_t)T * D * 2);
    p.actsh = (unsigned short*)take((size_t)T * SFF * 2);
    p.actr = (unsigned short*)take((size_t)PROWS * EFF * 2); p.ypairb = (unsigned short*)take((size_t)NPAIR * D * 2);
    p.qa = (float*)take((size_t)T * DNW * 4); p.ka = (float*)take((size_t)T * DNW * 4); p.va = (float*)take((size_t)T * DNW * 4);
    p.gl = (float*)take((size_t)T * 4 * 4); p.bt = (float*)take((size_t)T * 4 * 4);
    p.oraw = (float*)take((size_t)T * DNW * 4); p.oa = nullptr; p.ob = nullptr;
    p.m1 = nullptr; p.m2 = nullptr;
    p.pre1 = (float*)take((size_t)T * D * 4); p.h = (float*)take((size_t)T * D * 4);
    p.scores = (float*)take((size_t)T * NE * 4); p.gate = (float*)take((size_t)NPAIR * 4);
    p.Ush = nullptr;
    p.ypair = nullptr; p.ysh = (float*)take((size_t)T * D * 4);
    p.idx = (int*)take((size_t)NPAIR * 4); p.counts = (int*)take(NE * 4); p.cursor = (int*)take(NE * 4);
    p.padpair = (int*)take((size_t)PROWS * 4);
    if (off > ws_size) { fprintf(stderr, "workspace too small: need %zu have %zu\n", off, ws_size); return; }
    void* args[] = {&p};
    hipError_t e = hipLaunchCooperativeKernel((void*)fwd_megakernel, dim3(grid_blocks), dim3(NT), args, 0, stream);
    if (e != hipSuccess) fprintf(stderr, "cooperative launch failed: %s (grid %d)\n", hipGetErrorString(e), grid_blocks);
}
```

```cpp
#include <hip/hip_runtime.h>
#include <hip/hip_cooperative_groups.h>
#include <cstdio>
#include <cstdint>
namespace cg = cooperative_groups;

constexpr int D = 1024, NB = 8, SEQ = 2048, T = NB * SEQ;
constexpr int DNH = 4, DND = 128, DNW = 512;
constexpr int SBH = 8, SBD = 64, SBW = 512;
constexpr int NE = 256, TOPK = 8, NG = 8, TOPG = 4, EFF = 256, SFF = 256;
constexpr int PW = 5640;
constexpr int C_DQ = 0, C_DK = 512, C_DV = 1024, C_DZ = 1536, C_DBETA = 2048, C_DA = 2052, C_SQ = 2056, C_SK = 2568,
              C_SV = 3080, C_GA = 3592, C_GB = 4616;
constexpr int NPAIR = T * TOPK;
constexpr int NBLK = (NPAIR + NE * 127 + 127) / 128;
constexpr int PROWS = NBLK * 128;
constexpr float ALPHA = 1.189207115002721f;
constexpr float LN_EPS = 1e-5f, NORM_EPS = 1e-6f;
constexpr int NT = 512;

struct Params {
    const float *x, *w_in, *conv_w, *a_log, *dt_bias, *norm_g, *w_pa, *w_pb, *w_out, *ln1_g, *ln1_b, *w_router,
        *router_bias, *w_su, *w_sd, *w_eu, *w_ed, *ln2_g, *ln2_b;
    float* out;
    float *proj, *qa, *ka, *va, *gl, *bt, *oraw, *oa, *ob, *m1, *m2, *pre1, *h, *scores, *gate, *U, *Ush, *ypair, *ysh;
    int *idx, *counts, *cursor, *padpair;
    unsigned short *xb, *w_in_t, *projb, *w_pa_t, *w_pb_t, *w_out_t, *w_router_t, *w_su_t, *w_sd_t, *oab, *obb, *mergedb, *hb, *actsh, *actr, *ypairb;
    unsigned short *qkvraw, *dzb, *sq, *sk, *vT, *gab, *gbb;
    float* small;
    unsigned short* dnblob; float *dnu, *dnlast;
};

__device__ __forceinline__ float sigmoidf_(float v) { return 1.f / (1.f + expf(-v)); }
__device__ __forceinline__ float siluf_(float v) { return v / (1.f + expf(-v)); }
__device__ __forceinline__ float wave_sum(float v) {
#pragma unroll
    for (int o = 32; o > 0; o >>= 1) v += __shfl_xor(v, o);
    return v;
}

template <class AF, class TF, class BF, class EF>
__device__ __forceinline__ void gemm_naive(int M, int N, int K, AF af, TF tf, BF bf, EF ef, float* smem) {
    float(*As)[68] = (float(*)[68])smem;
    float(*Bs)[132] = (float(*)[132])(smem + 16 * 68);
    const int tid = threadIdx.x, tx = tid & 31, ty = tid >> 5;
    const int mt = M / 64, nt = (N + 127) / 128;
    for (int tile = blockIdx.x; tile < mt * nt; tile += gridDim.x) {
        const int tm = tile / nt, tn = tile % nt;
        const int ctx = tf(tm);
        float acc[4][4];
#pragma unroll
        for (int i = 0; i < 4; ++i)
#pragma unroll
            for (int j = 0; j < 4; ++j) acc[i][j] = 0.f;
        for (int k0 = 0; k0 < K; k0 += 16) {
#pragma unroll
            for (int i = 0; i < 2; ++i) {
                const int e = tid + i * 512, r = e >> 4, kk = e & 15;
                As[kk][r] = af(tm * 64 + r, k0 + kk);
            }
#pragma unroll
            for (int i = 0; i < 4; ++i) {
                const int e = tid + i * 512, kk = e >> 7, c = e & 127;
                const int col = tn * 128 + c;
                Bs[kk][c] = (col < N) ? bf(ctx, k0 + kk, col) : 0.f;
            }
            __syncthreads();
#pragma unroll
            for (int kk = 0; kk < 16; ++kk) {
                const float4 a = *(const float4*)&As[kk][ty * 4];
                const float4 b = *(const float4*)&Bs[kk][tx * 4];
                const float av[4] = {a.x, a.y, a.z, a.w}, bv[4] = {b.x, b.y, b.z, b.w};
#pragma unroll
                for (int i = 0; i < 4; ++i)
#pragma unroll
                    for (int j = 0; j < 4; ++j) acc[i][j] = fmaf(av[i], bv[j], acc[i][j]);
            }
            __syncthreads();
        }
#pragma unroll
        for (int i = 0; i < 4; ++i)
#pragma unroll
            for (int j = 0; j < 4; ++j) {
                const int r = tm * 64 + ty * 4 + i, c = tn * 128 + tx * 4 + j;
                if (c < N) ef(r, c, acc[i][j]);
            }
    }
}


typedef unsigned short bf16_t;
typedef short bf16x8 __attribute__((ext_vector_type(8)));
typedef float f32x16 __attribute__((ext_vector_type(16)));
typedef float f32x4 __attribute__((ext_vector_type(4)));
__device__ __forceinline__ unsigned pk_bf16(float a, float b) {
    typedef __bf16 bf2 __attribute__((ext_vector_type(2)));
    typedef float f2 __attribute__((ext_vector_type(2)));
    f2 v = {a, b};
    bf2 r = __builtin_convertvector(v, bf2);
    return __builtin_bit_cast(unsigned, r);
}
__device__ __forceinline__ bf16_t to_bf16(float a) { return (bf16_t)(pk_bf16(a, 0.f) & 0xffffu); }
__device__ __forceinline__ float bf2f(bf16_t v) { return __uint_as_float((unsigned)v << 16); }

__device__ __forceinline__ int opaque_tid() { int t = threadIdx.x; asm volatile("" : "+v"(t)); return t; }
constexpr int LROW = 128;
__device__ __forceinline__ int swz(int r) { return ((r >> 2) & 7) ^ ((r >> 1) & 1); }

template <int ROWS, bool MAYBE_NULL = false> struct LoadRowsBf16 {
    static constexpr int NCH = ROWS * 8 / NT;
    const bf16_t* base; int tid;
    unsigned off[NCH];
    uint4 regs[NCH];
    template <class RF> __device__ __forceinline__ void init(const bf16_t* base_, int ld, RF rowfn) {
        base = base_; tid = opaque_tid();
#pragma unroll
        for (int i = 0; i < NCH; ++i) {
            const int c = tid + i * NT, r = c >> 3, ch = c & 7;
            const long long src = rowfn(r);
            off[i] = (!MAYBE_NULL || src >= 0) ? (unsigned)(src * ld + ch * 8) : 0xffffffffu;
        }
    }
    __device__ __forceinline__ void load(int k0) {
#pragma unroll
        for (int i = 0; i < NCH; ++i)
            regs[i] = (!MAYBE_NULL || off[i] != 0xffffffffu) ? *(const uint4*)(base + (size_t)off[i] + k0) : make_uint4(0, 0, 0, 0);
    }
    __device__ __forceinline__ void store(unsigned char* lds) const {
#pragma unroll
        for (int i = 0; i < NCH; ++i) {
            const int c = tid + i * NT, r = c >> 3, ch = c & 7;
            *(uint4*)(lds + r * LROW + ((ch ^ swz(r)) << 4)) = regs[i];
        }
    }
};

struct LoadKNF32 {
    const float* base; int ld, kq, nq;
    f32x4 regs[8];
    template <class CF> __device__ __forceinline__ void init(const float* w, int ld_, CF colfn) {
        const int tid = opaque_tid(); kq = tid >> 6; nq = tid & 63; ld = ld_;
        base = w + (size_t)(kq * 8) * ld_ + colfn(nq * 4);
    }
    __device__ __forceinline__ void load(int k0) {
#pragma unroll
        for (int j = 0; j < 8; ++j) regs[j] = *(const f32x4*)(base + (size_t)(k0 + j) * ld);
    }
    __device__ __forceinline__ void store1(unsigned char* lds, int nn, float a0, float a1, float a2, float a3, float a4, float a5, float a6, float a7) const {
        uint4 o; o.x = pk_bf16(a0, a1); o.y = pk_bf16(a2, a3); o.z = pk_bf16(a4, a5); o.w = pk_bf16(a6, a7);
        const int row = nq * 4 + nn;
        *(uint4*)(lds + row * LROW + ((kq ^ swz(row)) << 4)) = o;
    }
    __device__ __forceinline__ void store(unsigned char* lds) const {
        store1(lds, 0, regs[0].x, regs[1].x, regs[2].x, regs[3].x, regs[4].x, regs[5].x, regs[6].x, regs[7].x);
        store1(lds, 1, regs[0].y, regs[1].y, regs[2].y, regs[3].y, regs[4].y, regs[5].y, regs[6].y, regs[7].y);
        store1(lds, 2, regs[0].z, regs[1].z, regs[2].z, regs[3].z, regs[4].z, regs[5].z, regs[6].z, regs[7].z);
        store1(lds, 3, regs[0].w, regs[1].w, regs[2].w, regs[3].w, regs[4].w, regs[5].w, regs[6].w, regs[7].w);
    }
};

template <int BM_, int BN_, int WM_, int WN_> struct GemmCfg {
    static constexpr int BM = BM_, BN = BN_, WM = WM_, WN = WN_;
    static constexpr int TM = BM / WM, TN = BN / WN, MI = TM / 32, NI = TN / 32;
    static constexpr int A_BYTES = BM * LROW, B_BYTES = BN * LROW, STAGE = A_BYTES + B_BYTES;
    static_assert(WM * WN == 8, "8 waves");
};

template <class CFG, class AL, class BL>
__device__ __forceinline__ void gemm_mainloop(AL& al, BL& bl, int nk, f32x16 (&acc)[CFG::MI][CFG::NI], unsigned char* lds) {
    constexpr int MI = CFG::MI, NI = CFG::NI;
    const int tid = opaque_tid(), lane = tid & 63, wid = tid >> 6;
    const int wm = wid / CFG::WN, wn = wid % CFG::WN;
    const int l31 = lane & 31, lh = lane >> 5;
    al.load(0); bl.load(0);
    const int a_off = (wm * CFG::TM + l31) * LROW;
    const int b_off = CFG::A_BYTES + (wn * CFG::TN + l31) * LROW;
    const int fsw = swz(l31);
    for (int kt = 0; kt < nk; ++kt) {
        unsigned char* st = lds + (kt & 1) * CFG::STAGE;
        al.store(st); bl.store(st + CFG::A_BYTES);
        __syncthreads();
        if (kt + 1 < nk) { al.load((kt + 1) * 64); bl.load((kt + 1) * 64); }
#pragma unroll
        for (int kk = 0; kk < 4; ++kk) {
            bf16x8 a[MI], b[NI];
#pragma unroll
            for (int mi = 0; mi < MI; ++mi) a[mi] = *(const bf16x8*)(st + a_off + mi * 32 * LROW + (((kk * 2 + lh) ^ fsw) << 4));
#pragma unroll
            for (int ni = 0; ni < NI; ++ni) b[ni] = *(const bf16x8*)(st + b_off + ni * 32 * LROW + (((kk * 2 + lh) ^ fsw) << 4));
#pragma unroll
            for (int mi = 0; mi < MI; ++mi)
#pragma unroll
                for (int ni = 0; ni < NI; ++ni)
                    acc[mi][ni] = __builtin_amdgcn_mfma_f32_32x32x16_bf16(a[mi], b[ni], acc[mi][ni], 0, 0, 0);
        }
    }
    __syncthreads();
}
template <class CFG> __device__ __forceinline__ void acc_zero(f32x16 (&acc)[CFG::MI][CFG::NI]) {
#pragma unroll
    for (int mi = 0; mi < CFG::MI; ++mi)
#pragma unroll
        for (int ni = 0; ni < CFG::NI; ++ni)
#pragma unroll
            for (int r = 0; r < 16; ++r) acc[mi][ni][r] = 0.f;
}
template <class CFG, class F> __device__ __forceinline__ void acc_foreach(f32x16 (&acc)[CFG::MI][CFG::NI], F f) {
    const int tid = opaque_tid(), lane = tid & 63, wid = tid >> 6;
    const int wm = wid / CFG::WN, wn = wid % CFG::WN;
#pragma unroll
    for (int mi = 0; mi < CFG::MI; ++mi)
#pragma unroll
        for (int ni = 0; ni < CFG::NI; ++ni) {
            asm volatile("" ::: "memory");
#pragma unroll
            for (int r = 0; r < 16; ++r)
                acc[mi][ni][r] = f(wm * CFG::TM + mi * 32 + (r & 3) + 8 * (r >> 2) + 4 * (lane >> 5), wn * CFG::TN + ni * 32 + (lane & 31), acc[mi][ni][r], mi, ni, r);
        }
}

struct TileMap {
    int ntm, ntn, npm, npn, rounds; bool patched;
    int pm, pn;
    __device__ __forceinline__ void init(int ntm_, int ntn_, int pn_ = 8) {
        ntm = ntm_; ntn = ntn_; patched = (gridDim.x == 256); pn = pn_; pm = 32 / pn_;
        if (patched) { npm = (ntm + pm - 1) / pm; npn = (ntn + pn - 1) / pn; rounds = (npm * npn + 7) / 8; }
        else { int G = gridDim.x; asm volatile("" : "+s"(G)); npm = npn = 0; rounds = (ntm * ntn + G - 1) / G; }
    }
    __device__ __forceinline__ bool get(int round, int& tm, int& tn) const {
        const int b = blockIdx.x;
        if (patched) {
            const int patch = round * 8 + (b & 7), slot = b >> 3;
            if (patch >= npm * npn) return false;
            tm = (patch / npn) * pm + slot / pn; tn = (patch % npn) * pn + slot % pn;
            return tm < ntm && tn < ntn;
        }
        const int t = round * gridDim.x + b;
        if (t >= ntm * ntn) return false;
        tm = t / ntn; tn = t % ntn; return true;
    }
};

template <class CM>
__device__ __forceinline__ void transpose_convert(const float* W, int K, int N, int NP, bf16_t* Wt, float* sm, CM cmap) {
    const int tid = threadIdx.x, ntk = K / 64, ntn = NP / 64;
    for (int tile = blockIdx.x; tile < ntk * ntn; tile += gridDim.x) {
        const int tk = tile % ntk, tn = tile / ntk;
#pragma unroll
        for (int i = 0; i < 8; ++i) {
            const int e = tid + i * NT, kk = e >> 6, nn = e & 63, col = cmap(tn * 64 + nn);
            sm[nn * 65 + kk] = col >= 0 ? W[(size_t)(tk * 64 + kk) * N + col] : 0.f;
        }
        __syncthreads();
        const int n = tid >> 3, kc = tid & 7;
        const float* r = sm + n * 65 + kc * 8;
        uint4 o; o.x = pk_bf16(r[0], r[1]); o.y = pk_bf16(r[2], r[3]); o.z = pk_bf16(r[4], r[5]); o.w = pk_bf16(r[6], r[7]);
        *(uint4*)(Wt + (size_t)(tn * 64 + n) * K + tk * 64 + kc * 8) = o;
        __syncthreads();
    }
}
__device__ void convert_bf16(const float* src, bf16_t* dst, size_t n) {
    const size_t gtid = (size_t)blockIdx.x * NT + threadIdx.x, gsz = (size_t)gridDim.x * NT;
    for (size_t i = gtid; i < n / 8; i += gsz) {
        const float4 a = ((const float4*)src)[2 * i], b = ((const float4*)src)[2 * i + 1];
        uint4 o; o.x = pk_bf16(a.x, a.y); o.y = pk_bf16(a.z, a.w); o.z = pk_bf16(b.x, b.y); o.w = pk_bf16(b.z, b.w);
        ((uint4*)dst)[i] = o;
    }
}

constexpr int PWP = 5888;
__device__ void phase_inproj(const Params& p, unsigned char* lds) {
    typedef GemmCfg<256, 256, 2, 4> CFG;
    TileMap tmap; tmap.init(T / 256, PWP / 256);
    for (int round = 0; round < tmap.rounds; ++round) {
        int tm, tn;
        if (!tmap.get(round, tm, tn)) continue;
        LoadRowsBf16<256> al, bl;
        al.init(p.xb, D, [&](int r) { return (long long)(tm * 256 + r); });
        bl.init(p.w_in_t, D, [&](int r) { return (long long)(tn * 256 + r); });
        f32x16 acc[CFG::MI][CFG::NI];
        acc_zero<CFG>(acc);
        gemm_mainloop<CFG>(al, bl, D / 64, acc, lds);
        asm volatile("" : "+s"(tm), "+s"(tn));
        if (tn == 12 || tn == 13) {
            const int tid = opaque_tid(), lane = tid & 63, wid = tid >> 6, wm = wid / CFG::WN, wn = wid % CFG::WN, l31 = lane & 31, lh = lane >> 5;
#pragma unroll
            for (int mi = 0; mi < CFG::MI; ++mi)
#pragma unroll
                for (int ni = 0; ni < CFG::NI; ++ni) {
                    const int svcol = (tn - 12) * 256 + wn * CFG::TN + ni * 32 + l31, hh = svcol >> 6, d = svcol & 63;
                    const int tok0 = tm * 256 + wm * CFG::TM + mi * 32, bb = tok0 >> 11, key0 = tok0 & (SEQ - 1);
                    bf16_t* dst = p.vT + ((size_t)((bb * 8 + hh) * 64 + d)) * SEQ + key0;
#pragma unroll
                    for (int g = 0; g < 4; ++g) {
                        uint2 o; o.x = pk_bf16(acc[mi][ni][4 * g], acc[mi][ni][4 * g + 1]); o.y = pk_bf16(acc[mi][ni][4 * g + 2], acc[mi][ni][4 * g + 3]);
                        *(uint2*)(dst + 16 * (g >> 1) + 8 * lh + 4 * (g & 1)) = o;
                    }
                }
        } else if (tn == 22) {
            acc_foreach<CFG>(acc, [&](int r, int c, float v, int, int, int) {
                if (c < 8) p.small[(size_t)(tm * 256 + r) * 8 + c] = v;
                return v;
            });
        } else {
            bf16_t* dst; int ld, c0; float sc = 1.f;
            if (tn < 6) { dst = p.qkvraw; ld = 1536; c0 = tn * 256; }
            else if (tn < 8) { dst = p.dzb; ld = 512; c0 = (tn - 6) * 256; }
            else if (tn < 10) { dst = p.sq; ld = 512; c0 = (tn - 8) * 256; sc = 0.125f * 1.4426950408889634f; }
            else if (tn < 12) { dst = p.sk; ld = 512; c0 = (tn - 10) * 256; }
            else if (tn < 18) { dst = p.gab; ld = 1024; c0 = (tn - 14) * 256; }
            else { dst = p.gbb; ld = 1024; c0 = (tn - 18) * 256; }
            acc_foreach<CFG>(acc, [&](int r, int c, float v, int, int, int) {
                dst[(size_t)(tm * 256 + r) * ld + c0 + c] = to_bf16(v * sc);
                return v;
            });
        }
    }
}

__device__ void phase_merge(const Params& p, unsigned char* lds) {
    typedef GemmCfg<128, 256, 2, 4> CFG;
    TileMap tmap; tmap.init(T / 128, D / 256);
    for (int round = 0; round < tmap.rounds; ++round) {
        int tm, tn;
        if (!tmap.get(round, tm, tn)) continue;
        f32x16 acc[CFG::MI][CFG::NI];
        {
            LoadRowsBf16<128> al; LoadRowsBf16<256> bl;
            al.init(p.oab, DNW, [&](int r) { return (long long)(tm * 128 + r); });
            bl.init(p.w_pa_t, DNW, [&](int r) { return (long long)(tn * 256 + r); });
            acc_zero<CFG>(acc);
            gemm_mainloop<CFG>(al, bl, DNW / 64, acc, lds);
            asm volatile("" : "+s"(tm), "+s"(tn));
        }
        acc_foreach<CFG>(acc, [&](int r, int c, float v, int, int, int) {
            const size_t gi = (size_t)(tm * 128 + r) * D + tn * 256 + c;
            const float ga = sigmoidf_(bf2f(p.gab[gi])), gb = fmaxf(sigmoidf_(bf2f(p.gbb[gi])), 1e-30f);
            return v * (ga / gb);
        });
        {
            LoadRowsBf16<128> al; LoadRowsBf16<256> bl;
            al.init(p.obb, SBW, [&](int r) { return (long long)(tm * 128 + r); });
            bl.init(p.w_pb_t, SBW, [&](int r) { return (long long)(tn * 256 + r); });
            gemm_mainloop<CFG>(al, bl, SBW / 64, acc, lds);
            asm volatile("" : "+s"(tm), "+s"(tn));
        }
        acc_foreach<CFG>(acc, [&](int r, int c, float v, int, int, int) {
            const int row = tm * 128 + r, col = tn * 256 + c;
            const float gb = fmaxf(sigmoidf_(bf2f(p.gbb[(size_t)row * D + col])), 1e-30f);
            p.mergedb[(size_t)row * D + col] = to_bf16(v * gb);
            return v;
        });
    }
}

__device__ void phase_outproj(const Params& p, unsigned char* lds) {
    typedef GemmCfg<256, 256, 2, 4> CFG;
    TileMap tmap; tmap.init(T / 256, D / 256);
    for (int round = 0; round < tmap.rounds; ++round) {
        int tm, tn;
        if (!tmap.get(round, tm, tn)) continue;
        LoadRowsBf16<256> al, bl;
        al.init(p.mergedb, D, [&](int r) { return (long long)(tm * 256 + r); });
        bl.init(p.w_out_t, D, [&](int r) { return (long long)(tn * 256 + r); });
        f32x16 acc[CFG::MI][CFG::NI];
        acc_zero<CFG>(acc);
        gemm_mainloop<CFG>(al, bl, D / 64, acc, lds);
        asm volatile("" : "+s"(tm), "+s"(tn));
        acc_foreach<CFG>(acc, [&](int r, int c, float v, int, int, int) {
            const size_t o = (size_t)(tm * 256 + r) * D + tn * 256 + c;
            p.pre1[o] = v + ALPHA * p.x[o];
            return v;
        });
    }
}

__device__ void phase_router_shared_up(const Params& p, unsigned char* lds) {
    {
        typedef GemmCfg<128, 128, 4, 2> CFG;
        TileMap tmap; tmap.init(T / 128, NE / 128);
        for (int round = 0; round < tmap.rounds; ++round) {
            int tm, tn;
            if (!tmap.get(round, tm, tn)) continue;
            LoadRowsBf16<128> al, bl;
            al.init(p.hb, D, [&](int r) { return (long long)(tm * 128 + r); });
            bl.init(p.w_router_t, D, [&](int r) { return (long long)(tn * 128 + r); });
            f32x16 acc[CFG::MI][CFG::NI];
            acc_zero<CFG>(acc);
            gemm_mainloop<CFG>(al, bl, D / 64, acc, lds);
            asm volatile("" : "+s"(tm), "+s"(tn));
            acc_foreach<CFG>(acc, [&](int r, int c, float v, int, int, int) {
                p.scores[(size_t)(tm * 128 + r) * NE + tn * 128 + c] = sigmoidf_(v);
                return v;
            });
        }
    }
    {
        typedef GemmCfg<128, 256, 2, 4> CFG;
        TileMap tmap; tmap.init(T / 128, SFF / 128);
        for (int round = 0; round < tmap.rounds; ++round) {
            int tm, tn;
            if (!tmap.get(round, tm, tn)) continue;
            LoadRowsBf16<128> al; LoadRowsBf16<256> bl;
            al.init(p.hb, D, [&](int r) { return (long long)(tm * 128 + r); });
            bl.init(p.w_su_t, D, [&](int r) { return (long long)(((r >> 5) & 1) * SFF + tn * 128 + (r >> 6) * 32 + (r & 31)); });
            f32x16 acc[CFG::MI][CFG::NI];
            acc_zero<CFG>(acc);
            gemm_mainloop<CFG>(al, bl, D / 64, acc, lds);
            asm volatile("" : "+s"(tm), "+s"(tn));
            const int tid = opaque_tid(), lane = tid & 63, wid = tid >> 6, wm = wid / CFG::WN, wn = wid % CFG::WN;
#pragma unroll
            for (int mi = 0; mi < CFG::MI; ++mi)
#pragma unroll
                for (int r = 0; r < 16; ++r) {
                    const int row = tm * 128 + wm * CFG::TM + mi * 32 + (r & 3) + 8 * (r >> 2) + 4 * (lane >> 5);
                    const int j = tn * 128 + wn * 32 + (lane & 31);
                    const float g = acc[mi][0][r], u = acc[mi][1][r];
                    p.actsh[(size_t)row * SFF + j] = to_bf16(siluf_(g) * u);
                }
        }
    }
}

__device__ void phase_shared_down(const Params& p, unsigned char* lds) {
    typedef GemmCfg<256, 256, 2, 4> CFG;
    TileMap tmap; tmap.init(T / 256, D / 256);
    for (int round = 0; round < tmap.rounds; ++round) {
        int tm, tn;
        if (!tmap.get(round, tm, tn)) continue;
        LoadRowsBf16<256> al, bl;
        al.init(p.actsh, SFF, [&](int r) { return (long long)(tm * 256 + r); });
        bl.init(p.w_sd_t, SFF, [&](int r) { return (long long)(tn * 256 + r); });
        f32x16 acc[CFG::MI][CFG::NI];
        acc_zero<CFG>(acc);
        gemm_mainloop<CFG>(al, bl, SFF / 64, acc, lds);
        asm volatile("" : "+s"(tm), "+s"(tn));
        acc_foreach<CFG>(acc, [&](int r, int c, float v, int, int, int) {
            p.ysh[(size_t)(tm * 256 + r) * D + tn * 256 + c] = v;
            return v;
        });
    }
}

__device__ void phase_init(const Params& p) {
    const int gtid = blockIdx.x * NT + threadIdx.x, gsz = gridDim.x * NT;
    for (int i = gtid; i < NE; i += gsz) { p.counts[i] = 0; p.cursor[i] = 0; }
    for (int i = gtid; i < PROWS; i += gsz) p.padpair[i] = -1;
}

__device__ void phase_dn_prep(const Params& p) {
    const int lane = threadIdx.x & 63, wave = (blockIdx.x * NT + threadIdx.x) >> 6, nw = (gridDim.x * NT) >> 6;
    for (int item = wave; item < T * 12; item += nw) {
        const int t = item / 12, j = item % 12, type = j >> 2, hh = j & 3;
        const int s = t & (SEQ - 1);
        float v[2];
#pragma unroll
        for (int u = 0; u < 2; ++u) {
            const int col = type * 512 + hh * 128 + lane * 2 + u;
            float acc = 0.f;
#pragma unroll
            for (int tap = 0; tap < 4; ++tap) {
                const int ds = s + tap - 3;
                if (ds >= 0) acc += bf2f(p.qkvraw[(size_t)(t + tap - 3) * 1536 + col]) * p.conv_w[tap * 1536 + col];
            }
            v[u] = siluf_(acc);
        }
        if (type < 2) {
            const float ss = wave_sum(v[0] * v[0] + v[1] * v[1]);
            float r = rsqrtf(ss + NORM_EPS);
            if (type == 0) r *= 0.08838834764831845f;
            v[0] *= r; v[1] *= r;
        }
        float* dst = (type == 0 ? p.qa : type == 1 ? p.ka : p.va) + (size_t)t * DNW + hh * 128 + lane * 2;
        dst[0] = v[0]; dst[1] = v[1];
    }
    const int gtid = blockIdx.x * NT + threadIdx.x, gsz = gridDim.x * NT;
    for (int i = gtid; i < T * 4; i += gsz) {
        const int t = i >> 2, hh = i & 3;
        const float da = p.small[(size_t)t * 8 + 4 + hh] + p.dt_bias[hh];
        const float sp = (da > 20.f) ? da : log1pf(expf(da));
        p.gl[i] = -expf(p.a_log[hh]) * sp;
        p.bt[i] = sigmoidf_(p.small[(size_t)t * 8 + hh]);
    }
}

__device__ void deltanet_naive(const Params& p, int b, float* smem) {
    const int tid = threadIdx.x, hh = tid >> 7, e = tid & 127;
    float* ks = smem;
    float* qs = smem + 8 * 512;
    float* vs = smem + 16 * 512;
    float* gs = smem + 24 * 512;
    float* bs = gs + 32;
    float S[128];
#pragma unroll
    for (int d = 0; d < 128; ++d) S[d] = 0.f;
    for (int t0 = 0; t0 < SEQ; t0 += 8) {
        const size_t base = (size_t)(b * SEQ + t0) * DNW;
        for (int i = tid; i < 8 * 512; i += NT) { ks[i] = p.ka[base + i]; qs[i] = p.qa[base + i]; vs[i] = p.va[base + i]; }
        if (tid < 32) { gs[tid] = p.gl[(size_t)(b * SEQ + t0) * 4 + tid]; bs[tid] = p.bt[(size_t)(b * SEQ + t0) * 4 + tid]; }
        __syncthreads();
        for (int tt = 0; tt < 8; ++tt) {
            const float* kk = ks + tt * 512 + hh * 128;
            const float* qq = qs + tt * 512 + hh * 128;
            float kS = 0.f;
#pragma unroll
            for (int d = 0; d < 128; ++d) { kS = fmaf(kk[d], S[d], kS); if ((d & 15) == 15) asm volatile("" ::: "memory"); }
            const float eg = expf(gs[tt * 4 + hh]), be = bs[tt * 4 + hh], ve = vs[tt * 512 + tid];
            const float c = be * (ve - eg * kS);
            float o = 0.f;
#pragma unroll
            for (int d = 0; d < 128; ++d) { S[d] = fmaf(kk[d], c, eg * S[d]); o = fmaf(qq[d], S[d], o); if ((d & 15) == 15) asm volatile("" ::: "memory"); }
            p.oraw[(size_t)(b * SEQ + t0 + tt) * DNW + tid] = o;
        }
        __syncthreads();
    }
}

__device__ void sb_attn_wave(const Params& p, int bh, int qt) {
    const int lane = opaque_tid() & 63, l31 = lane & 31, lh = lane >> 5;
    const int b = bh >> 3, hh = bh & 7;
    bf16x8 qf[4];
    {
        const bf16_t* qrow = p.sq + (size_t)(b * SEQ + qt * 32 + l31) * SBW + hh * 64 + lh * 8;
#pragma unroll
        for (int ks = 0; ks < 4; ++ks) qf[ks] = *(const bf16x8*)(qrow + ks * 16);
    }
    f32x16 o0, o1;
#pragma unroll
    for (int r = 0; r < 16; ++r) { o0[r] = 0.f; o1[r] = 0.f; }
    float run = 0.f;
    const bf16_t* vbase = p.vT + ((size_t)(bh * 64 + l31)) * SEQ + lh * 8;
    for (int kt = qt; kt >= 0; --kt) {
        const bf16_t* krow = p.sk + (size_t)(b * SEQ + kt * 32 + l31) * SBW + hh * 64 + lh * 8;
        bf16x8 kf[4];
#pragma unroll
        for (int ks = 0; ks < 4; ++ks) kf[ks] = *(const bf16x8*)(krow + ks * 16);
        bf16x8 vf[2][2];
#pragma unroll
        for (int md = 0; md < 2; ++md)
#pragma unroll
            for (int ss = 0; ss < 2; ++ss) vf[md][ss] = *(const bf16x8*)(vbase + (size_t)md * 32 * SEQ + kt * 32 + ss * 16);
        f32x16 sc;
#pragma unroll
        for (int r = 0; r < 16; ++r) sc[r] = 0.f;
#pragma unroll
        for (int ks = 0; ks < 4; ++ks) sc = __builtin_amdgcn_mfma_f32_32x32x16_bf16(kf[ks], qf[ks], sc, 0, 0, 0);
        float lb[16], lr[16];
        const bool diag = (kt == qt);
#pragma unroll
        for (int r = 0; r < 16; ++r) {
            const float z = sc[r];
            const float l = __builtin_amdgcn_logf(1.f + __builtin_amdgcn_exp2f(-fabsf(z)));
            float b_ = fminf(z, 0.f) - l, r_ = b_ - z;
            if (diag) { const bool valid = ((r & 3) + 8 * (r >> 2) + 4 * lh) < l31; r_ = valid ? r_ : 0.f; b_ = valid ? b_ : -INFINITY; }
            lb[r] = b_; lr[r] = r_;
        }
        float ex[16], B[4];
#pragma unroll
        for (int g = 0; g < 4; ++g) {
            ex[4 * g + 3] = 0.f;
            ex[4 * g + 2] = lr[4 * g + 3];
            ex[4 * g + 1] = ex[4 * g + 2] + lr[4 * g + 2];
            ex[4 * g + 0] = ex[4 * g + 1] + lr[4 * g + 1];
            B[g] = ex[4 * g + 0] + lr[4 * g + 0];
        }
        float P[4];
#pragma unroll
        for (int g = 0; g < 4; ++g) P[g] = __shfl_xor(B[g], 32);
        float off[4];
        {
            const float p3 = P[3], p2 = P[2] + p3, p1 = P[1] + p2, p0 = P[0] + p1;
            const float b3 = 0.f, b2 = B[3], b1 = B[2] + b2, b0 = B[1] + b1;
            off[0] = b0 + (lh ? p1 : p0);
            off[1] = b1 + (lh ? p2 : p1);
            off[2] = b2 + (lh ? p3 : p2);
            off[3] = b3 + (lh ? 0.f : p3);
            const float total = (B[0] + b0) + p0;
#pragma unroll
            for (int g = 0; g < 4; ++g) off[g] += run;
            run += total;
        }
        float a[16];
#pragma unroll
        for (int r = 0; r < 16; ++r) a[r] = __builtin_amdgcn_exp2f(lb[r] + ex[r] + off[r >> 2]);
        bf16x8 pf[2];
#pragma unroll
        for (int ss = 0; ss < 2; ++ss) {
            typedef unsigned u32x4 __attribute__((ext_vector_type(4)));
            u32x4 w;
            w[0] = pk_bf16(a[8 * ss + 0], a[8 * ss + 1]); w[1] = pk_bf16(a[8 * ss + 2], a[8 * ss + 3]);
            w[2] = pk_bf16(a[8 * ss + 4], a[8 * ss + 5]); w[3] = pk_bf16(a[8 * ss + 6], a[8 * ss + 7]);
            pf[ss] = __builtin_bit_cast(bf16x8, w);
        }
#pragma unroll
        for (int ss = 0; ss < 2; ++ss) {
            o0 = __builtin_amdgcn_mfma_f32_32x32x16_bf16(vf[0][ss], pf[ss], o0, 0, 0, 0);
            o1 = __builtin_amdgcn_mfma_f32_32x32x16_bf16(vf[1][ss], pf[ss], o1, 0, 0, 0);
        }
        if (__all(run < -160.f)) break;
    }
    bf16_t* orow = p.obb + (size_t)(b * SEQ + qt * 32 + l31) * SBW + hh * 64 + 4 * lh;
#pragma unroll
    for (int g = 0; g < 4; ++g) {
        uint2 w0, w1;
        w0.x = pk_bf16(o0[4 * g], o0[4 * g + 1]); w0.y = pk_bf16(o0[4 * g + 2], o0[4 * g + 3]);
        w1.x = pk_bf16(o1[4 * g], o1[4 * g + 1]); w1.y = pk_bf16(o1[4 * g + 2], o1[4 * g + 3]);
        *(uint2*)(orow + 8 * g) = w0;
        *(uint2*)(orow + 32 + 8 * g) = w1;
    }
}


constexpr int DN_RW = 0, DN_RQ = 128, DN_RAT = 256, DN_RKD = 320, DN_ROWS = 448, DN_BLOB = DN_ROWS * 64;
constexpr float LOG2E = 1.4426950408889634f;
__device__ __forceinline__ int pi16(int x) { return (x & ~12) | ((x & 4) << 1) | ((x & 8) >> 1); }
__device__ __forceinline__ uint4 pack8(const float* v) { uint4 o; o.x = pk_bf16(v[0], v[1]); o.y = pk_bf16(v[2], v[3]); o.z = pk_bf16(v[4], v[5]); o.w = pk_bf16(v[6], v[7]); return o; }

__device__ void dn_chunk_item(const Params& p, int item, unsigned char* lds) {
    const int tid = opaque_tid(), lane = tid & 63, wid = tid >> 6;
    const int bh = item >> 5, n = item & 31, b = bh >> 2, hh = bh & 3;
    const int t0 = b * SEQ + n * 64;
    unsigned char* Kimg = lds; unsigned char* KBimg = lds + 16384; unsigned char* Qimg = lds + 32768;
    float* Vf = (float*)(lds + 49152); float* KBGf = (float*)(lds + 81920); float* MT = (float*)(lds + 114688);
    float* G2s = (float*)(lds + 114688 + 17408); float* betas = G2s + 64;
    bf16_t* blob = p.dnblob + (size_t)item * DN_BLOB;
    if (wid == 0) {
        const int t = t0 + lane;
        const float da = p.small[(size_t)t * 8 + 4 + hh] + p.dt_bias[hh];
        const float sp = da > 20.f ? da : log1pf(expf(da));
        float g2 = -expf(p.a_log[hh]) * sp * LOG2E;
#pragma unroll
        for (int off = 1; off < 64; off <<= 1) { const float v = __shfl_up(g2, off); if (lane >= off) g2 += v; }
        G2s[lane] = g2; betas[lane] = sigmoidf_(p.small[(size_t)t * 8 + hh]);
        if (lane == 63) p.dnlast[item] = exp2f(g2);
    }
    __syncthreads();
    {
        const int c8 = tid & 15, tq = tid >> 4, j0 = tq * 2;
        const float G0 = G2s[j0], G1 = G2s[j0 + 1], GL = G2s[63];
        const float be[2] = {betas[j0], betas[j0 + 1]};
        const float eg[2] = {exp2f(G0), exp2f(G1)}, el[2] = {exp2f(GL - G0), exp2f(GL - G1)};
        const int half = c8 >> 3, ch = c8 & 7;
#pragma unroll
        for (int type = 0; type < 3; ++type) {
            float o[2][8];
            {
                const bf16_t* src = p.qkvraw + (size_t)(t0 + j0 - 3) * 1536 + type * 512 + hh * 128 + c8 * 8;
                float x[5][8];
#pragma unroll
                for (int r = 0; r < 5; ++r) {
                    uint4 raw = make_uint4(0, 0, 0, 0);
                    if (n > 0 || j0 - 3 + r >= 0) raw = *(const uint4*)(src + (size_t)r * 1536);
                    const unsigned u[4] = {raw.x, raw.y, raw.z, raw.w};
#pragma unroll
                    for (int i = 0; i < 4; ++i) { x[r][2 * i] = __uint_as_float(u[i] << 16); x[r][2 * i + 1] = __uint_as_float(u[i] & 0xffff0000u); }
                }
                const float* wp = p.conv_w + type * 512 + hh * 128 + c8 * 8;
#pragma unroll
                for (int i = 0; i < 8; ++i) {
                    float a0 = 0.f, a1 = 0.f;
#pragma unroll
                    for (int tap = 0; tap < 4; ++tap) { const float w = wp[tap * 1536 + i]; a0 = fmaf(x[tap][i], w, a0); a1 = fmaf(x[tap + 1][i], w, a1); }
                    o[0][i] = siluf_(a0); o[1][i] = siluf_(a1);
                }
            }
            if (type < 2) {
#pragma unroll
                for (int tk = 0; tk < 2; ++tk) {
                    float ss = 0.f;
#pragma unroll
                    for (int i = 0; i < 8; ++i) ss = fmaf(o[tk][i], o[tk][i], ss);
                    ss += __shfl_xor(ss, 1); ss += __shfl_xor(ss, 2); ss += __shfl_xor(ss, 4); ss += __shfl_xor(ss, 8);
                    float r = rsqrtf(ss + NORM_EPS);
                    if (type == 0) r *= 0.08838834764831845f;
#pragma unroll
                    for (int i = 0; i < 8; ++i) o[tk][i] *= r;
                }
            }
#pragma unroll
            for (int tk = 0; tk < 2; ++tk) {
                const int j = j0 + tk;
                const int ioff = half * 8192 + j * 128 + ((ch ^ swz(j)) << 4);
                if (type == 0) {
                    *(uint4*)(Qimg + ioff) = pack8(o[tk]);
                    float qd[8];
#pragma unroll
                    for (int i = 0; i < 8; ++i) qd[i] = o[tk][i] * eg[tk];
                    bf16_t* qrow = blob + (size_t)(DN_RQ + half * 64 + j) * 64 + ((c8 >> 1) & 3) * 16 + 4 * (c8 & 1);
                    uint2 w0, w1; w0.x = pk_bf16(qd[0], qd[1]); w0.y = pk_bf16(qd[2], qd[3]); w1.x = pk_bf16(qd[4], qd[5]); w1.y = pk_bf16(qd[6], qd[7]);
                    *(uint2*)qrow = w0; *(uint2*)(qrow + 8) = w1;
                } else if (type == 1) {
                    float kb[8], kbg[8];
#pragma unroll
                    for (int i = 0; i < 8; ++i) { kb[i] = o[tk][i] * be[tk]; kbg[i] = kb[i] * eg[tk]; }
                    *(uint4*)(Kimg + ioff) = pack8(o[tk]);
                    *(uint4*)(KBimg + ioff) = pack8(kb);
                    f32x4* kd = (f32x4*)(KBGf + j * 128 + c8 * 8); kd[0] = (f32x4){kbg[0], kbg[1], kbg[2], kbg[3]}; kd[1] = (f32x4){kbg[4], kbg[5], kbg[6], kbg[7]};
                } else {
                    float vb[8];
#pragma unroll
                    for (int i = 0; i < 8; ++i) vb[i] = o[tk][i] * be[tk];
                    f32x4* vd = (f32x4*)(Vf + j * 128 + c8 * 8); vd[0] = (f32x4){vb[0], vb[1], vb[2], vb[3]}; vd[1] = (f32x4){vb[4], vb[5], vb[6], vb[7]};
                }
            }
            if (type == 1) {
                const int jp = (j0 & 48) | pi16(j0 & 15);
#pragma unroll
                for (int i = 0; i < 8; ++i)
                    *(unsigned*)(blob + (size_t)(DN_RKD + c8 * 8 + i) * 64 + jp) = pk_bf16(o[0][i] * el[0], o[1][i] * el[1]);
            }
            asm volatile("" ::: "memory");
        }
    }
    __syncthreads();
    {
        const int which = wid >> 2, ti = (wid >> 1) & 1, tj = wid & 1, l31 = lane & 31, lh = lane >> 5;
        if (!(ti == 0 && tj == 1)) {
            const unsigned char* Ab = (which == 0 ? KBimg : Qimg) + (ti * 32 + l31) * 128;
            const unsigned char* Bb = Kimg + (tj * 32 + l31) * 128;
            const int fsw = swz(l31);
            f32x16 acc;
#pragma unroll
            for (int r = 0; r < 16; ++r) acc[r] = 0.f;
#pragma unroll
            for (int ks = 0; ks < 8; ++ks) {
                const int off = (ks >> 2) * 8192 + ((((ks & 3) * 2 + lh) ^ fsw) << 4);
                acc = __builtin_amdgcn_mfma_f32_32x32x16_bf16(*(const bf16x8*)(Ab + off), *(const bf16x8*)(Bb + off), acc, 0, 0, 0);
            }
            const int j = tj * 32 + l31;
            const float Gj = G2s[j];
#pragma unroll
            for (int r = 0; r < 16; ++r) {
                const int i = ti * 32 + (r & 3) + 8 * (r >> 2) + 4 * lh;
                const float v = acc[r] * exp2f(G2s[i] - Gj);
                if (which == 0) MT[j * 68 + i] = (i > j) ? v : 0.f;
                else blob[(size_t)(DN_RAT + i) * 64 + ((j & 48) | pi16(j & 15))] = to_bf16((i >= j) ? v : 0.f);
            }
        }
    }
    __syncthreads();
#ifndef NO_SOLVE
    if (tid < 256) {
        const int c = tid & 127;
        const float* rhs = (tid < 128 ? Vf : KBGf) + c;
        float y[64];
#pragma unroll
        for (int j = 0; j < 64; ++j) y[j] = rhs[j * 128];
#pragma unroll
        for (int j = 0; j < 63; ++j) {
            const float yj = y[j];
#pragma unroll
            for (int i4 = (j + 1) & ~3; i4 < 64; i4 += 4) {
                const f32x4 m = *(const f32x4*)(MT + j * 68 + i4);
#pragma unroll
                for (int u = 0; u < 4; ++u) if (i4 + u > j) y[i4 + u] = fmaf(-m[u], yj, y[i4 + u]);
            }
            asm volatile("" ::: "memory");
        }
        if (tid < 128) {
#pragma unroll
            for (int mi = 0; mi < 2; ++mi)
#pragma unroll
                for (int h = 0; h < 2; ++h) {
                    f32x4* dst = (f32x4*)(p.dnu + ((((size_t)item * 2 + mi) * 4 + (c >> 5)) * 64 + h * 32 + (c & 31)) * 16);
#pragma unroll
                    for (int g = 0; g < 4; ++g)
                        dst[g] = (f32x4){y[mi * 32 + 8 * g + 4 * h], y[mi * 32 + 8 * g + 4 * h + 1], y[mi * 32 + 8 * g + 4 * h + 2], y[mi * 32 + 8 * g + 4 * h + 3]};
                }
        } else {
            bf16_t* dst = blob + (size_t)(DN_RW + (c >> 6) * 64) * 64 + ((c & 48) | pi16(c & 15));
#pragma unroll
            for (int i = 0; i < 64; ++i) dst[(size_t)i * 64] = to_bf16(-y[i]);
        }
    }
#endif
    __syncthreads();
}

__device__ void phase_dn_chunks(const Params& p, unsigned char* lds) {
    for (int item = blockIdx.x; item < NB * DNH * 32; item += gridDim.x) dn_chunk_item(p, item, lds);
}

__device__ void dn_scan(const Params& p, int bh, unsigned char* lds) {
    const int tid = opaque_tid(), lane = tid & 63, wid = tid >> 6, l31 = lane & 31, lh = lane >> 5;
    const int b = bh >> 2, hh = bh & 3;
    const int fsw = swz(l31);
    auto copy_blob = [&](int n, unsigned char* dst) {
        const uint4* src = (const uint4*)(p.dnblob + (size_t)(bh * 32 + n) * DN_BLOB);
        const int lt = tid - 256;
#pragma unroll
        for (int k = 0; k < 14; ++k) {
            const int c = lt + k * 256, row = c >> 3, ch = c & 7;
            *(uint4*)(dst + row * 128 + ((ch ^ swz(row)) << 4)) = src[c];
        }
    };
    if (wid >= 4) copy_blob(0, lds);
    __syncthreads();
    f32x16 S[4];
#pragma unroll
    for (int t = 0; t < 4; ++t)
#pragma unroll
        for (int r = 0; r < 16; ++r) S[t][r] = 0.f;
    for (int n = 0; n < 32; ++n) {
        if (wid >= 4) {
            if (n + 1 < 32) copy_blob(n + 1, lds + ((n + 1) & 1) * (DN_ROWS * 128));
        } else {
            const unsigned char* buf = lds + (n & 1) * (DN_ROWS * 128);
            const int item = bh * 32 + n;
            f32x16 vn[2], oa[2];
#pragma unroll
            for (int mi = 0; mi < 2; ++mi) {
                vn[mi] = *(const f32x16*)(p.dnu + ((((size_t)item * 2 + mi) * 4 + wid) * 64 + lane) * 16);
#pragma unroll
                for (int r = 0; r < 16; ++r) oa[mi][r] = 0.f;
            }
            const float last = p.dnlast[item];
            typedef unsigned u32x4 __attribute__((ext_vector_type(4)));
            bf16x8 sb[4][2];
#pragma unroll
            for (int t = 0; t < 4; ++t)
#pragma unroll
                for (int ss = 0; ss < 2; ++ss) {
                    u32x4 w;
#pragma unroll
                    for (int q = 0; q < 4; ++q) w[q] = pk_bf16(S[t][8 * ss + 2 * q], S[t][8 * ss + 2 * q + 1]);
                    sb[t][ss] = __builtin_bit_cast(bf16x8, w);
                }
#pragma unroll
            for (int mi = 0; mi < 2; ++mi)
#pragma unroll
                for (int ks = 0; ks < 8; ++ks) {
                    const int off = ((ks >> 2) * 64 + mi * 32 + l31) * 128 + ((((ks & 3) * 2 + lh) ^ fsw) << 4);
                    vn[mi] = __builtin_amdgcn_mfma_f32_32x32x16_bf16(*(const bf16x8*)(buf + DN_RW * 128 + off), sb[ks >> 1][ks & 1], vn[mi], 0, 0, 0);
                    oa[mi] = __builtin_amdgcn_mfma_f32_32x32x16_bf16(*(const bf16x8*)(buf + DN_RQ * 128 + off), sb[ks >> 1][ks & 1], oa[mi], 0, 0, 0);
                }
            bf16x8 vb[2][2];
#pragma unroll
            for (int mj = 0; mj < 2; ++mj)
#pragma unroll
                for (int ss = 0; ss < 2; ++ss) {
                    u32x4 w;
#pragma unroll
                    for (int q = 0; q < 4; ++q) w[q] = pk_bf16(vn[mj][8 * ss + 2 * q], vn[mj][8 * ss + 2 * q + 1]);
                    vb[mj][ss] = __builtin_bit_cast(bf16x8, w);
                }
#pragma unroll
            for (int mi = 0; mi < 2; ++mi)
#pragma unroll
                for (int kj = 0; kj < 4; ++kj)
                    if ((kj >> 1) <= mi) {
                        const int off = (DN_RAT + mi * 32 + l31) * 128 + (((kj * 2 + lh) ^ fsw) << 4);
                        oa[mi] = __builtin_amdgcn_mfma_f32_32x32x16_bf16(*(const bf16x8*)(buf + off), vb[kj >> 1][kj & 1], oa[mi], 0, 0, 0);
                    }
#pragma unroll
            for (int t = 0; t < 4; ++t) {
#pragma unroll
                for (int r = 0; r < 16; ++r) S[t][r] *= last;
#pragma unroll
                for (int kj = 0; kj < 4; ++kj) {
                    const int off = (DN_RKD + t * 32 + l31) * 128 + (((kj * 2 + lh) ^ fsw) << 4);
                    S[t] = __builtin_amdgcn_mfma_f32_32x32x16_bf16(*(const bf16x8*)(buf + off), vb[kj >> 1][kj & 1], S[t], 0, 0, 0);
                }
            }
            float* orow = p.oraw + (size_t)(b * SEQ + n * 64) * DNW + hh * 128 + wid * 32 + l31;
#pragma unroll
            for (int mi = 0; mi < 2; ++mi)
#pragma unroll
                for (int r = 0; r < 16; ++r) orow[(size_t)(mi * 32 + (r & 3) + 8 * (r >> 2) + 4 * lh) * DNW] = oa[mi][r];
        }
        __syncthreads();
    }
}

__device__ void phase_mixers(const Params& p, float* smem) {
    const int nscan = NB * DNH;
    if (gridDim.x >= 2 * nscan) {
#ifndef SKIP_SCAN
        if ((int)blockIdx.x < nscan) dn_scan(p, blockIdx.x, (unsigned char*)smem);
#endif
        if ((int)blockIdx.x < nscan) {}
        else
            for (int it = blockIdx.x - nscan; it < 512; it += gridDim.x - nscan) sb_attn_wave(p, it >> 3, (it & 7) * 8 + (threadIdx.x >> 6));
    } else {
#ifndef SKIP_SCAN
        for (int bh = blockIdx.x; bh < nscan; bh += gridDim.x) dn_scan(p, bh, (unsigned char*)smem);
#endif
        for (int it = blockIdx.x; it < 512; it += gridDim.x) sb_attn_wave(p, it >> 3, (it & 7) * 8 + (threadIdx.x >> 6));
    }
}

__device__ void phase_gated_norm(const Params& p) {
    const int lane = threadIdx.x & 63, wave = (blockIdx.x * NT + threadIdx.x) >> 6, nw = (gridDim.x * NT) >> 6;
    for (int item = wave; item < T * 4; item += nw) {
        const int t = item >> 2, hh = item & 3;
        const size_t off = (size_t)t * DNW + hh * 128 + lane * 2;
        const float v0 = p.oraw[off], v1 = p.oraw[off + 1];
        const float ss = wave_sum(v0 * v0 + v1 * v1);
        const float r = rsqrtf(ss * (1.f / 128.f) + NORM_EPS);
        const float z0 = bf2f(p.dzb[(size_t)t * 512 + hh * 128 + lane * 2]), z1 = bf2f(p.dzb[(size_t)t * 512 + hh * 128 + lane * 2 + 1]);
        p.oab[off] = to_bf16(v0 * r * p.norm_g[lane * 2] * siluf_(z0));
        p.oab[off + 1] = to_bf16(v1 * r * p.norm_g[lane * 2 + 1] * siluf_(z1));
    }
}

template <class SF>
__device__ __forceinline__ void layer_norm_rows(SF sf, const float* g, const float* bb, float* dst, bf16_t* dstb) {
    const int lane = threadIdx.x & 63, wave = (blockIdx.x * NT + threadIdx.x) >> 6, nw = (gridDim.x * NT) >> 6;
    for (int t = wave; t < T; t += nw) {
        float v[16];
        float s = 0.f;
#pragma unroll
        for (int i = 0; i < 16; ++i) { v[i] = sf(t, lane + i * 64); s += v[i]; }
        const float mu = wave_sum(s) * (1.f / 1024.f);
        float q = 0.f;
#pragma unroll
        for (int i = 0; i < 16; ++i) { const float d = v[i] - mu; q += d * d; }
        const float rstd = rsqrtf(wave_sum(q) * (1.f / 1024.f) + LN_EPS);
#pragma unroll
        for (int i = 0; i < 16; ++i) { const int c = lane + i * 64; const float y = (v[i] - mu) * rstd * g[c] + bb[c]; dst[(size_t)t * D + c] = y; if (dstb) dstb[(size_t)t * D + c] = to_bf16(y); }
    }
}

__device__ void phase_route(const Params& p) {
    const int gtid = blockIdx.x * NT + threadIdx.x, gsz = gridDim.x * NT;
    for (int t = gtid; t < T; t += gsz) {
        const float* sc = p.scores + (size_t)t * NE;
        float gscore[NG];
        for (int g = 0; g < NG; ++g) {
            float m1 = -INFINITY, m2 = -INFINITY;
            for (int i = 0; i < 32; ++i) {
                const float v = sc[g * 32 + i] + p.router_bias[g * 32 + i];
                if (v > m1) { m2 = m1; m1 = v; } else if (v > m2) m2 = v;
            }
            gscore[g] = m1 + m2;
        }
        unsigned gmask = 0;
        for (int it = 0; it < TOPG; ++it) {
            int best = -1; float bv = -INFINITY;
            for (int g = 0; g < NG; ++g)
                if (!((gmask >> g) & 1u) && (best < 0 || gscore[g] > bv)) { best = g; bv = gscore[g]; }
            gmask |= 1u << best;
        }
        int chosen[TOPK]; float cw[TOPK]; float wsum = 0.f;
        float last = INFINITY; int lasti = -1;
        for (int it = 0; it < TOPK; ++it) {
            int best = -1; float bv = -INFINITY;
            for (int g = 0; g < NG; ++g) {
                if (!((gmask >> g) & 1u)) continue;
                for (int i = 0; i < 32; ++i) {
                    const int e = g * 32 + i;
                    const float v = sc[e] + p.router_bias[e];
                    const bool after = (v < last) || (v == last && e > lasti);
                    if (after && (best < 0 || v > bv)) { best = e; bv = v; }
                }
            }
            chosen[it] = best; cw[it] = sc[best]; wsum += cw[it]; last = bv; lasti = best;
        }
        for (int it = 0; it < TOPK; ++it) {
            p.idx[t * TOPK + it] = chosen[it];
            p.gate[t * TOPK + it] = cw[it] / wsum * 2.5f;
            atomicAdd(&p.counts[chosen[it]], 1);
        }
    }
}

__device__ void compute_pend(const Params& p, int* pend) {
    if (threadIdx.x == 0) {
        int acc = 0;
        for (int e = 0; e < NE; ++e) { const int c = p.counts[e]; acc += (c + 127) / 128 * 128; pend[e] = acc; }
    }
    __syncthreads();
}

__device__ void phase_scatter(const Params& p, int* pend) {
    compute_pend(p, pend);
    const int gtid = blockIdx.x * NT + threadIdx.x, gsz = gridDim.x * NT;
    for (int pr = gtid; pr < NPAIR; pr += gsz) {
        const int e = p.idx[pr];
        const int pstart = (e == 0) ? 0 : pend[e - 1];
        const int pos = pstart + atomicAdd(&p.cursor[e], 1);
        p.padpair[pos] = pr;
    }
}

__device__ __forceinline__ int expert_of_row(const int* pend, int row) {
    int lo = 0, hi = NE - 1;
    while (lo < hi) { const int mid = (lo + hi) >> 1; if (pend[mid] > row) hi = mid; else lo = mid + 1; }
    return lo;
}

__device__ void phase_routed_up(const Params& p, const int* pend, unsigned char* lds) {
    typedef GemmCfg<128, 256, 2, 4> CFG;
    TileMap tmap; tmap.init(pend[NE - 1] / 128, EFF / 128, 2);
    for (int round = 0; round < tmap.rounds; ++round) {
        int tm, tn;
        if (!tmap.get(round, tm, tn)) continue;
        const int e = expert_of_row(pend, tm * 128);
        LoadRowsBf16<128, true> al; LoadKNF32 bl;
        al.init(p.hb, D, [&](int r) { const int pr = p.padpair[tm * 128 + r]; return pr >= 0 ? (long long)(pr >> 3) : -1LL; });
        bl.init(p.w_eu + (size_t)e * D * (2 * EFF), 2 * EFF, [&](int r) { return ((r >> 5) & 1) * EFF + tn * 128 + (r >> 6) * 32 + (r & 31); });
        f32x16 acc[CFG::MI][CFG::NI];
        acc_zero<CFG>(acc);
        gemm_mainloop<CFG>(al, bl, D / 64, acc, lds);
        asm volatile("" : "+s"(tm), "+s"(tn));
        const int tid = opaque_tid(), lane = tid & 63, wid = tid >> 6, wm = wid / CFG::WN, wn = wid % CFG::WN;
#pragma unroll
        for (int mi = 0; mi < CFG::MI; ++mi)
#pragma unroll
            for (int r = 0; r < 16; ++r) {
                const int row = tm * 128 + wm * CFG::TM + mi * 32 + (r & 3) + 8 * (r >> 2) + 4 * (lane >> 5);
                const int j = tn * 128 + wn * 32 + (lane & 31);
                const float g = acc[mi][0][r], u = acc[mi][1][r];
                p.actr[(size_t)row * EFF + j] = to_bf16(siluf_(g) * u);
            }
    }
}

__device__ void phase_routed_down(const Params& p, const int* pend, unsigned char* lds) {
    typedef GemmCfg<128, 256, 2, 4> CFG;
    TileMap tmap; tmap.init(pend[NE - 1] / 128, D / 256, 4);
    for (int round = 0; round < tmap.rounds; ++round) {
        int tm, tn;
        if (!tmap.get(round, tm, tn)) continue;
        const int e = expert_of_row(pend, tm * 128);
        LoadRowsBf16<128> al; LoadKNF32 bl;
        al.init(p.actr, EFF, [&](int r) { return (long long)(tm * 128 + r); });
        bl.init(p.w_ed + (size_t)e * EFF * D, D, [&](int r) { return tn * 256 + r; });
        f32x16 acc[CFG::MI][CFG::NI];
        acc_zero<CFG>(acc);
        gemm_mainloop<CFG>(al, bl, EFF / 64, acc, lds);
        asm volatile("" : "+s"(tm), "+s"(tn));
        acc_foreach<CFG>(acc, [&](int r, int c, float v, int, int, int) {
            const int pr = p.padpair[tm * 128 + r];
            if (pr >= 0) p.ypairb[(size_t)pr * D + tn * 256 + c] = to_bf16(v * p.gate[pr]);
            return v;
        });
    }
}

constexpr int LDS_MAIN = 133120;
__global__ void __launch_bounds__(NT) fwd_megakernel(Params p) {
    cg::grid_group grid = cg::this_grid();
    __shared__ __attribute__((aligned(16))) unsigned char lds[LDS_MAIN + NE * 4];
    float* smem = (float*)lds;
    int* pend = (int*)(lds + LDS_MAIN);

    phase_init(p);
    convert_bf16(p.x, p.xb, (size_t)T * D);
    transpose_convert(p.w_in, D, PW, PWP, p.w_in_t, smem, [](int n) { return n < 2048 ? n : n < 5632 ? n + 8 : n < 5640 ? n - 5632 + 2048 : -1; });
    transpose_convert(p.w_pa, DNW, D, D, p.w_pa_t, smem, [](int n) { return n; });
    transpose_convert(p.w_pb, SBW, D, D, p.w_pb_t, smem, [](int n) { return n; });
    transpose_convert(p.w_out, D, D, D, p.w_out_t, smem, [](int n) { return n; });
    transpose_convert(p.w_router, D, NE, NE, p.w_router_t, smem, [](int n) { return n; });
    transpose_convert(p.w_su, D, 2 * SFF, 2 * SFF, p.w_su_t, smem, [](int n) { return n; });
    transpose_convert(p.w_sd, SFF, D, D, p.w_sd_t, smem, [](int n) { return n; });
    grid.sync();
#ifndef SKIP_PHASE_INPROJ
    phase_inproj(p, lds);
#endif
    grid.sync();
#ifndef SKIP_DNCH
    phase_dn_chunks(p, lds);
#endif
    grid.sync();
#ifndef SKIP_PHASE_MIXERS
    phase_mixers(p, smem);
#endif
    grid.sync();
    phase_gated_norm(p);
    grid.sync();
#ifndef SKIP_PHASE_MERGE
    phase_merge(p, lds);
#endif
    grid.sync();
#ifndef SKIP_PHASE_OUTPROJ
    phase_outproj(p, lds);
#endif
    grid.sync();
    layer_norm_rows([&](int t, int c) { return p.pre1[(size_t)t * D + c]; }, p.ln1_g, p.ln1_b, p.h, p.hb);
    grid.sync();
#ifndef SKIP_PHASE_ROUTER_SHARED_UP
    phase_router_shared_up(p, lds);
#endif
    grid.sync();
    phase_route(p);
    grid.sync();
    phase_scatter(p, pend);
    grid.sync();
#ifndef SKIP_RUP
    phase_routed_up(p, pend, lds);
#endif
#ifndef SKIP_PHASE_SHARED_DOWN
    phase_shared_down(p, lds);
#endif
    grid.sync();
#ifndef SKIP_RDOWN
    phase_routed_down(p, pend, lds);
#endif
    grid.sync();
    layer_norm_rows([&](int t, int c) {
            float f = p.ysh[(size_t)t * D + c];
#pragma unroll
            for (int k = 0; k < TOPK; ++k) f += bf2f(p.ypairb[((size_t)t * TOPK + k) * D + c]);
            return ALPHA * p.h[(size_t)t * D + c] + f; },
        p.ln2_g, p.ln2_b, p.out, nullptr);
}

extern "C" void kernel_launch(void* const* d_in, const int* in_sizes, int n_in, void* d_out, int out_size, void* d_ws,
                              size_t ws_size, hipStream_t stream) {
    static int grid_blocks = 0;
    if (!grid_blocks) {
        int dev = 0, cus = 0, per_cu = 0;
        hipGetDevice(&dev);
        hipDeviceGetAttribute(&cus, hipDeviceAttributeMultiprocessorCount, dev);
        hipOccupancyMaxActiveBlocksPerMultiprocessor(&per_cu, fwd_megakernel, NT, 0);
        if (per_cu > 1) per_cu = 1;
        grid_blocks = cus * per_cu;
    }
    Params p{};
    const float* const* in = (const float* const*)d_in;
    p.x = in[0]; p.w_in = in[1]; p.conv_w = in[2]; p.a_log = in[3]; p.dt_bias = in[4]; p.norm_g = in[5]; p.w_pa = in[6];
    p.w_pb = in[7]; p.w_out = in[8]; p.ln1_g = in[9]; p.ln1_b = in[10]; p.w_router = in[11]; p.router_bias = in[12];
    p.w_su = in[13]; p.w_sd = in[14]; p.w_eu = in[15]; p.w_ed = in[16]; p.ln2_g = in[17]; p.ln2_b = in[18];
    p.out = (float*)d_out;
    char* w = (char*)d_ws;
    size_t off = 0;
    auto take = [&](size_t bytes) { char* r = w + off; off += (bytes + 255) & ~(size_t)255; return r; };
    p.U = nullptr;
    p.proj = nullptr;
    p.xb = (unsigned short*)take((size_t)T * D * 2);
    p.w_in_t = (unsigned short*)take((size_t)PWP * D * 2);
    p.projb = nullptr;
    p.qkvraw = (unsigned short*)take((size_t)T * 1536 * 2); p.dzb = (unsigned short*)take((size_t)T * 512 * 2);
    p.sq = (unsigned short*)take((size_t)T * 512 * 2); p.sk = (unsigned short*)take((size_t)T * 512 * 2); p.vT = (unsigned short*)take((size_t)T * 512 * 2);
    p.dnblob = (unsigned short*)take((size_t)1024 * DN_BLOB * 2); p.dnu = (float*)take((size_t)1024 * 64 * 128 * 4); p.dnlast = (float*)take(1024 * 4);
    p.gab = (unsigned short*)take((size_t)T * D * 2); p.gbb = (unsigned short*)take((size_t)T * D * 2); p.small = (float*)take((size_t)T * 8 * 4);
    p.w_pa_t = (unsigned short*)take((size_t)D * DNW * 2); p.w_pb_t = (unsigned short*)take((size_t)D * SBW * 2);
    p.w_out_t = (unsigned short*)take((size_t)D * D * 2); p.w_router_t = (unsigned short*)take((size_t)NE * D * 2);
    p.w_su_t = (unsigned short*)take((size_t)2 * SFF * D * 2); p.w_sd_t = (unsigned short*)take((size_t)D * SFF * 2);
    p.oab = (unsigned short*)take((size_t)T * DNW * 2); p.obb = (unsigned short*)take((size_t)T * SBW * 2);
    p.mergedb = (unsigned short*)take((size_t)T * D * 2); p.hb = (unsigned short*)take((size_t)T * D * 2);
    p.actsh = (unsigned short*)take((size_t)T * SFF * 2);
    p.actr = (unsigned short*)take((size_t)PROWS * EFF * 2); p.ypairb = (unsigned short*)take((size_t)NPAIR * D * 2);
    p.qa = (float*)take((size_t)T * DNW * 4); p.ka = (float*)take((size_t)T * DNW * 4); p.va = (float*)take((size_t)T * DNW * 4);
    p.gl = (float*)take((size_t)T * 4 * 4); p.bt = (float*)take((size_t)T * 4 * 4);
    p.oraw = (float*)take((size_t)T * DNW * 4); p.oa = nullptr; p.ob = nullptr;
    p.m1 = nullptr; p.m2 = nullptr;
    p.pre1 = (float*)take((size_t)T * D * 4); p.h = (float*)take((size_t)T * D * 4);
    p.scores = (float*)take((size_t)T * NE * 4); p.gate = (float*)take((size_t)NPAIR * 4);
    p.Ush = nullptr;
    p.ypair = nullptr; p.ysh = (float*)take((size_t)T * D * 4);
    p.idx = (int*)take((size_t)NPAIR * 4); p.counts = (int*)take(NE * 4); p.cursor = (int*)take(NE * 4);
    p.padpair = (int*)take((size_t)PROWS * 4);
    if (off > ws_size) { fprintf(stderr, "workspace too small: need %zu have %zu\n", off, ws_size); return; }
    void* args[] = {&p};
    hipError_t e = hipLaunchCooperativeKernel((void*)fwd_megakernel, dim3(grid_blocks), dim3(NT), args, 0, stream);
    if (e != hipSuccess) fprintf(stderr, "cooperative launch failed: %s (grid %d)\n", hipGetErrorString(e), grid_blocks);
}
```

```cpp
#include <hip/hip_runtime.h>
#include <hip/hip_cooperative_groups.h>
#include <cstdio>
#include <cstdint>
namespace cg = cooperative_groups;

constexpr int D = 1024, NB = 8, SEQ = 2048, T = NB * SEQ;
constexpr int DNH = 4, DND = 128, DNW = 512;
constexpr int SBH = 8, SBD = 64, SBW = 512;
constexpr int NE = 256, TOPK = 8, NG = 8, TOPG = 4, EFF = 256, SFF = 256;
constexpr int PW = 5640;
constexpr int C_DQ = 0, C_DK = 512, C_DV = 1024, C_DZ = 1536, C_DBETA = 2048, C_DA = 2052, C_SQ = 2056, C_SK = 2568,
              C_SV = 3080, C_GA = 3592, C_GB = 4616;
constexpr int NPAIR = T * TOPK;
constexpr int NBLK = (NPAIR + NE * 127 + 127) / 128;
constexpr int PROWS = NBLK * 128;
constexpr float ALPHA = 1.189207115002721f;
constexpr float LN_EPS = 1e-5f, NORM_EPS = 1e-6f;
constexpr int NT = 512;

struct Params {
    const float *x, *w_in, *conv_w, *a_log, *dt_bias, *norm_g, *w_pa, *w_pb, *w_out, *ln1_g, *ln1_b, *w_router,
        *router_bias, *w_su, *w_sd, *w_eu, *w_ed, *ln2_g, *ln2_b;
    float* out;
    float *proj, *qa, *ka, *va, *gl, *bt, *oraw, *oa, *ob, *m1, *m2, *pre1, *h, *scores, *gate, *U, *Ush, *ypair, *ysh;
    int *idx, *counts, *cursor, *padpair;
    unsigned short *xb, *w_in_t, *projb, *w_pa_t, *w_pb_t, *w_out_t, *w_router_t, *w_su_t, *w_sd_t, *oab, *obb, *mergedb, *hb, *actsh, *actr, *ypairb;
    unsigned short *qkvraw, *dzb, *sq, *sk, *vT, *gab, *gbb;
    float* small;
    unsigned short* dnblob; float *dnu, *dnlast;
    int* explist;
    unsigned* bar;
};

__device__ __forceinline__ float sigmoidf_(float v) { return 1.f / (1.f + expf(-v)); }
__device__ __forceinline__ float siluf_(float v) { return v / (1.f + expf(-v)); }
__device__ __forceinline__ float wave_sum(float v) {
#pragma unroll
    for (int o = 32; o > 0; o >>= 1) v += __shfl_xor(v, o);
    return v;
}


#define XB_TMO      128
#define XB_XCNT(j)  (256  + 64 * (j))
#define XB_XSUB(j)  (1280 + 64 * (j))
#define XB_XGEN(j)  (2304 + 64 * (j))
#define XB_TOP      3328
#define XB_TOPGEN   3392
#define XCD_BAR_WORDS 3456
#define XB_SPIN_CAP (1u << 24)
#define LAS3 __attribute__((address_space(3)))
__device__ __forceinline__ unsigned xb_ld(unsigned* p)              { return __hip_atomic_load(p, __ATOMIC_RELAXED, __HIP_MEMORY_SCOPE_AGENT); }
__device__ __forceinline__ unsigned xb_add(unsigned* p, unsigned v) { return __hip_atomic_fetch_add(p, v, __ATOMIC_RELAXED, __HIP_MEMORY_SCOPE_AGENT); }
__device__ __forceinline__ unsigned xb_xcc_id() { return (unsigned)__builtin_amdgcn_s_getreg((3 << 11) | 20) & 0xFu; }
#define XB_SPIN(cond, bar) do { unsigned _sp = 0; while (cond) { __builtin_amdgcn_s_sleep(1); \
    if ((++_sp & 255u) == 0u) { if (xb_ld(&(bar)[XB_TMO])) break; if (_sp > XB_SPIN_CAP) { atomicAdd(&(bar)[XB_TMO], 1u); break; } } } } while (0)
struct XcdBarrier { unsigned* bar; unsigned x; volatile LAS3 unsigned* st; };
__device__ __forceinline__ XcdBarrier xcd_barrier_post(unsigned* bar, volatile LAS3 unsigned* st) {
    XcdBarrier b; b.bar = bar; b.x = xb_xcc_id(); b.st = st;
    if (threadIdx.x == 0) (void)xb_add(&bar[XB_XCNT(b.x)], 1u);
    return b;
}
__device__ __forceinline__ void xcd_barrier_complete(unsigned* bar, unsigned x, unsigned& nloc, unsigned& nx) {
    const unsigned G = gridDim.x * gridDim.y * gridDim.z;
    unsigned sum, cnt, mine, sp = 0u;
    for (;;) {
        sum = 0u; cnt = 0u; mine = 0u;
#pragma unroll
        for (unsigned j = 0; j < 16; ++j) { const unsigned c = xb_ld(&bar[XB_XCNT(j)]); sum += c; cnt += (c > 0u) ? 1u : 0u; mine = (j == x) ? c : mine; }
        if (sum == G) break;
        __builtin_amdgcn_s_sleep(1);
        if ((++sp & 255u) == 0u) { if (xb_ld(&bar[XB_TMO])) break; if (sp > XB_SPIN_CAP) { atomicAdd(&bar[XB_TMO], 1u); break; } }
    }
    nloc = mine > 0u ? mine : 1u; nx = cnt > 0u ? cnt : 1u;
}
__device__ __forceinline__ void xcd_barrier(const XcdBarrier& b) {
    asm volatile("s_waitcnt vmcnt(0)" ::: "memory");
    __syncthreads();
    if (threadIdx.x == 0) {
        unsigned* bar = b.bar;
        __builtin_amdgcn_s_waitcnt(0);
        unsigned nloc = b.st[0], nx = b.st[1];
        if (nloc == 0u) { xcd_barrier_complete(bar, b.x, nloc, nx); b.st[0] = nloc; b.st[1] = nx; }
        const unsigned old = xb_add(&bar[XB_XSUB(b.x)], 1u);
        const unsigned gen = old / nloc;
        if (old + 1u == (gen + 1u) * nloc) {
            __builtin_amdgcn_fence(__ATOMIC_RELEASE, "agent");
            asm volatile("s_waitcnt vmcnt(0)" ::: "memory");
            const unsigned og = xb_add(&bar[XB_TOP], 1u);
            const unsigned tg = og / nx;
            if (og + 1u == (tg + 1u) * nx) xb_add(&bar[XB_TOPGEN], 1u);
            else XB_SPIN(xb_ld(&bar[XB_TOPGEN]) == tg, bar);
            __builtin_amdgcn_fence(__ATOMIC_ACQUIRE, "agent");
            xb_add(&bar[XB_XGEN(b.x)], 1u);
            asm volatile("s_waitcnt vmcnt(0)" ::: "memory");
        } else {
            XB_SPIN(xb_ld(&bar[XB_XGEN(b.x)]) == gen, bar);
            __builtin_amdgcn_fence(__ATOMIC_ACQUIRE, "agent");
            asm volatile("s_waitcnt vmcnt(0)" ::: "memory");
        }
    }
    __syncthreads();
}

template <class AF, class TF, class BF, class EF>
__device__ __forceinline__ void gemm_naive(int M, int N, int K, AF af, TF tf, BF bf, EF ef, float* smem) {
    float(*As)[68] = (float(*)[68])smem;
    float(*Bs)[132] = (float(*)[132])(smem + 16 * 68);
    const int tid = threadIdx.x, tx = tid & 31, ty = tid >> 5;
    const int mt = M / 64, nt = (N + 127) / 128;
    for (int tile = blockIdx.x; tile < mt * nt; tile += gridDim.x) {
        const int tm = tile / nt, tn = tile % nt;
        const int ctx = tf(tm);
        float acc[4][4];
#pragma unroll
        for (int i = 0; i < 4; ++i)
#pragma unroll
            for (int j = 0; j < 4; ++j) acc[i][j] = 0.f;
        for (int k0 = 0; k0 < K; k0 += 16) {
#pragma unroll
            for (int i = 0; i < 2; ++i) {
                const int e = tid + i * 512, r = e >> 4, kk = e & 15;
                As[kk][r] = af(tm * 64 + r, k0 + kk);
            }
#pragma unroll
            for (int i = 0; i < 4; ++i) {
                const int e = tid + i * 512, kk = e >> 7, c = e & 127;
                const int col = tn * 128 + c;
                Bs[kk][c] = (col < N) ? bf(ctx, k0 + kk, col) : 0.f;
            }
            __syncthreads();
#pragma unroll
            for (int kk = 0; kk < 16; ++kk) {
                const float4 a = *(const float4*)&As[kk][ty * 4];
                const float4 b = *(const float4*)&Bs[kk][tx * 4];
                const float av[4] = {a.x, a.y, a.z, a.w}, bv[4] = {b.x, b.y, b.z, b.w};
#pragma unroll
                for (int i = 0; i < 4; ++i)
#pragma unroll
                    for (int j = 0; j < 4; ++j) acc[i][j] = fmaf(av[i], bv[j], acc[i][j]);
            }
            __syncthreads();
        }
#pragma unroll
        for (int i = 0; i < 4; ++i)
#pragma unroll
            for (int j = 0; j < 4; ++j) {
                const int r = tm * 64 + ty * 4 + i, c = tn * 128 + tx * 4 + j;
                if (c < N) ef(r, c, acc[i][j]);
            }
    }
}


typedef unsigned short bf16_t;
typedef short bf16x8 __attribute__((ext_vector_type(8)));
typedef float f32x16 __attribute__((ext_vector_type(16)));
typedef float f32x4 __attribute__((ext_vector_type(4)));
__device__ __forceinline__ unsigned pk_bf16(float a, float b) {
    typedef __bf16 bf2 __attribute__((ext_vector_type(2)));
    typedef float f2 __attribute__((ext_vector_type(2)));
    f2 v = {a, b};
    bf2 r = __builtin_convertvector(v, bf2);
    return __builtin_bit_cast(unsigned, r);
}
__device__ __forceinline__ bf16_t to_bf16(float a) { return (bf16_t)(pk_bf16(a, 0.f) & 0xffffu); }
__device__ __forceinline__ float bf2f(bf16_t v) { return __uint_as_float((unsigned)v << 16); }

__device__ __forceinline__ int opaque_tid() { int t = threadIdx.x; asm volatile("" : "+v"(t)); return t; }
constexpr int LROW = 128;
__device__ __forceinline__ int swz(int r) { return ((r >> 2) & 7) ^ ((r >> 1) & 1); }

template <int ROWS, bool MAYBE_NULL = false> struct LoadRowsBf16 {
    static constexpr int NCH = ROWS * 8 / NT;
    const bf16_t* base; int tid;
    unsigned off[NCH];
    uint4 regs[NCH];
    template <class RF> __device__ __forceinline__ void init(const bf16_t* base_, int ld, RF rowfn) {
        base = base_; tid = opaque_tid();
#pragma unroll
        for (int i = 0; i < NCH; ++i) {
            const int c = tid + i * NT, r = c >> 3, ch = c & 7;
            const long long src = rowfn(r);
            off[i] = (!MAYBE_NULL || src >= 0) ? (unsigned)(src * ld + ch * 8) : 0xffffffffu;
        }
    }
    __device__ __forceinline__ void load(int k0) {
#pragma unroll
        for (int i = 0; i < NCH; ++i)
            regs[i] = (!MAYBE_NULL || off[i] != 0xffffffffu) ? *(const uint4*)(base + (size_t)off[i] + k0) : make_uint4(0, 0, 0, 0);
    }
    __device__ __forceinline__ void store(unsigned char* lds) const {
#pragma unroll
        for (int i = 0; i < NCH; ++i) {
            const int c = tid + i * NT, r = c >> 3, ch = c & 7;
            *(uint4*)(lds + r * LROW + ((ch ^ swz(r)) << 4)) = regs[i];
        }
    }
};

struct LoadKNF32 {
    const float* base; int ld, kq, nq;
    f32x4 regs[8];
    template <class CF> __device__ __forceinline__ void init(const float* w, int ld_, CF colfn) {
        const int tid = opaque_tid(); kq = tid >> 6; nq = tid & 63; ld = ld_;
        base = w + (size_t)(kq * 8) * ld_ + colfn(nq * 4);
    }
    __device__ __forceinline__ void load(int k0) {
#pragma unroll
        for (int j = 0; j < 8; ++j) regs[j] = *(const f32x4*)(base + (size_t)(k0 + j) * ld);
    }
    __device__ __forceinline__ void store1(unsigned char* lds, int nn, float a0, float a1, float a2, float a3, float a4, float a5, float a6, float a7) const {
        uint4 o; o.x = pk_bf16(a0, a1); o.y = pk_bf16(a2, a3); o.z = pk_bf16(a4, a5); o.w = pk_bf16(a6, a7);
        const int row = nq * 4 + nn;
        *(uint4*)(lds + row * LROW + ((kq ^ swz(row)) << 4)) = o;
    }
    __device__ __forceinline__ void store(unsigned char* lds) const {
        store1(lds, 0, regs[0].x, regs[1].x, regs[2].x, regs[3].x, regs[4].x, regs[5].x, regs[6].x, regs[7].x);
        store1(lds, 1, regs[0].y, regs[1].y, regs[2].y, regs[3].y, regs[4].y, regs[5].y, regs[6].y, regs[7].y);
        store1(lds, 2, regs[0].z, regs[1].z, regs[2].z, regs[3].z, regs[4].z, regs[5].z, regs[6].z, regs[7].z);
        store1(lds, 3, regs[0].w, regs[1].w, regs[2].w, regs[3].w, regs[4].w, regs[5].w, regs[6].w, regs[7].w);
    }
};

template <int BM_, int BN_, int WM_, int WN_> struct GemmCfg {
    static constexpr int BM = BM_, BN = BN_, WM = WM_, WN = WN_;
    static constexpr int TM = BM / WM, TN = BN / WN, MI = TM / 32, NI = TN / 32;
    static constexpr int A_BYTES = BM * LROW, B_BYTES = BN * LROW, STAGE = A_BYTES + B_BYTES;
    static_assert(WM * WN == 8, "8 waves");
};

template <class CFG, class AL, class BL>
__device__ __forceinline__ void gemm_mainloop(AL& al, BL& bl, int nk, f32x16 (&acc)[CFG::MI][CFG::NI], unsigned char* lds) {
    constexpr int MI = CFG::MI, NI = CFG::NI;
    const int tid = opaque_tid(), lane = tid & 63, wid = tid >> 6;
    const int wm = wid / CFG::WN, wn = wid % CFG::WN;
    const int l31 = lane & 31, lh = lane >> 5;
    al.load(0); bl.load(0);
    const int a_off = (wm * CFG::TM + l31) * LROW;
    const int b_off = CFG::A_BYTES + (wn * CFG::TN + l31) * LROW;
    const int fsw = swz(l31);
    for (int kt = 0; kt < nk; ++kt) {
        unsigned char* st = lds + (kt & 1) * CFG::STAGE;
        al.store(st); bl.store(st + CFG::A_BYTES);
        __syncthreads();
        if (kt + 1 < nk) { al.load((kt + 1) * 64); bl.load((kt + 1) * 64); }
#pragma unroll
        for (int kk = 0; kk < 4; ++kk) {
            bf16x8 a[MI], b[NI];
#pragma unroll
            for (int mi = 0; mi < MI; ++mi) a[mi] = *(const bf16x8*)(st + a_off + mi * 32 * LROW + (((kk * 2 + lh) ^ fsw) << 4));
#pragma unroll
            for (int ni = 0; ni < NI; ++ni) b[ni] = *(const bf16x8*)(st + b_off + ni * 32 * LROW + (((kk * 2 + lh) ^ fsw) << 4));
#pragma unroll
            for (int mi = 0; mi < MI; ++mi)
#pragma unroll
                for (int ni = 0; ni < NI; ++ni)
                    acc[mi][ni] = __builtin_amdgcn_mfma_f32_32x32x16_bf16(a[mi], b[ni], acc[mi][ni], 0, 0, 0);
        }
    }
    __syncthreads();
}
template <class CFG> __device__ __forceinline__ void acc_zero(f32x16 (&acc)[CFG::MI][CFG::NI]) {
#pragma unroll
    for (int mi = 0; mi < CFG::MI; ++mi)
#pragma unroll
        for (int ni = 0; ni < CFG::NI; ++ni)
#pragma unroll
            for (int r = 0; r < 16; ++r) acc[mi][ni][r] = 0.f;
}
template <class CFG, class F> __device__ __forceinline__ void acc_foreach(f32x16 (&acc)[CFG::MI][CFG::NI], F f) {
    const int tid = opaque_tid(), lane = tid & 63, wid = tid >> 6;
    const int wm = wid / CFG::WN, wn = wid % CFG::WN;
#pragma unroll
    for (int mi = 0; mi < CFG::MI; ++mi)
#pragma unroll
        for (int ni = 0; ni < CFG::NI; ++ni) {
            asm volatile("" ::: "memory");
#pragma unroll
            for (int r = 0; r < 16; ++r)
                acc[mi][ni][r] = f(wm * CFG::TM + mi * 32 + (r & 3) + 8 * (r >> 2) + 4 * (lane >> 5), wn * CFG::TN + ni * 32 + (lane & 31), acc[mi][ni][r], mi, ni, r);
        }
}

struct TileMap {
    int ntm, ntn, npm, npn, rounds; bool patched;
    int pm, pn;
    __device__ __forceinline__ void init(int ntm_, int ntn_, int pn_ = 8) {
        ntm = ntm_; ntn = ntn_; patched = (gridDim.x == 256); pn = pn_; pm = 32 / pn_;
        if (patched) { npm = (ntm + pm - 1) / pm; npn = (ntn + pn - 1) / pn; rounds = (npm * npn + 7) / 8; }
        else { int G = gridDim.x; asm volatile("" : "+s"(G)); npm = npn = 0; rounds = (ntm * ntn + G - 1) / G; }
    }
    __device__ __forceinline__ bool get(int round, int& tm, int& tn) const {
        const int b = blockIdx.x;
        if (patched) {
            const int patch = round * 8 + (b & 7), slot = b >> 3;
            if (patch >= npm * npn) return false;
            tm = (patch / npn) * pm + slot / pn; tn = (patch % npn) * pn + slot % pn;
            return tm < ntm && tn < ntn;
        }
        const int t = round * gridDim.x + b;
        if (t >= ntm * ntn) return false;
        tm = t / ntn; tn = t % ntn; return true;
    }
};

template <class CM>
__device__ __forceinline__ void transpose_convert(const float* W, int K, int N, int NP, bf16_t* Wt, float* sm, CM cmap) {
    const int tid = opaque_tid(), ntk = K / 64, ntn = NP / 64;
    for (int tile = blockIdx.x; tile < ntk * ntn; tile += gridDim.x) {
        const int tk = tile % ntk, tn = tile / ntk;
#pragma unroll
        for (int i = 0; i < 8; ++i) {
            const int e = tid + i * NT, kk = e >> 6, nn = e & 63, col = cmap(tn * 64 + nn);
            sm[nn * 65 + kk] = col >= 0 ? W[(size_t)(tk * 64 + kk) * N + col] : 0.f;
        }
        __syncthreads();
        const int n = tid >> 3, kc = tid & 7;
        const float* r = sm + n * 65 + kc * 8;
        uint4 o; o.x = pk_bf16(r[0], r[1]); o.y = pk_bf16(r[2], r[3]); o.z = pk_bf16(r[4], r[5]); o.w = pk_bf16(r[6], r[7]);
        *(uint4*)(Wt + (size_t)(tn * 64 + n) * K + tk * 64 + kc * 8) = o;
        __syncthreads();
    }
}
__device__ __forceinline__ void convert_bf16(const float* src, bf16_t* dst, size_t n) {
    const size_t gtid = (size_t)blockIdx.x * NT + opaque_tid(), gsz = (size_t)gridDim.x * NT;
    for (size_t i = gtid; i < n / 8; i += gsz) {
        const float4 a = ((const float4*)src)[2 * i], b = ((const float4*)src)[2 * i + 1];
        uint4 o; o.x = pk_bf16(a.x, a.y); o.y = pk_bf16(a.z, a.w); o.z = pk_bf16(b.x, b.y); o.w = pk_bf16(b.z, b.w);
        ((uint4*)dst)[i] = o;
    }
}

constexpr int PWP = 5888;
__device__ __forceinline__ void phase_inproj(const Params& p, unsigned char* lds) {
    typedef GemmCfg<256, 256, 2, 4> CFG;
    TileMap tmap; tmap.init(T / 256, PWP / 256);
    for (int round = 0; round < tmap.rounds; ++round) {
        int tm, tn;
        if (!tmap.get(round, tm, tn)) continue;
        LoadRowsBf16<256> al, bl;
        al.init(p.xb, D, [&](int r) { return (long long)(tm * 256 + r); });
        bl.init(p.w_in_t, D, [&](int r) { return (long long)(tn * 256 + r); });
        f32x16 acc[CFG::MI][CFG::NI];
        acc_zero<CFG>(acc);
        gemm_mainloop<CFG>(al, bl, D / 64, acc, lds);
        asm volatile("" : "+s"(tm), "+s"(tn));
        if (tn == 12 || tn == 13) {
            const int tid = opaque_tid(), lane = tid & 63, wid = tid >> 6, wm = wid / CFG::WN, wn = wid % CFG::WN, l31 = lane & 31, lh = lane >> 5;
#pragma unroll
            for (int mi = 0; mi < CFG::MI; ++mi)
#pragma unroll
                for (int ni = 0; ni < CFG::NI; ++ni) {
                    const int svcol = (tn - 12) * 256 + wn * CFG::TN + ni * 32 + l31, hh = svcol >> 6, d = svcol & 63;
                    const int tok0 = tm * 256 + wm * CFG::TM + mi * 32, bb = tok0 >> 11, key0 = tok0 & (SEQ - 1);
                    bf16_t* dst = p.vT + ((size_t)((bb * 8 + hh) * 64 + d)) * SEQ + key0;
#pragma unroll
                    for (int g = 0; g < 4; ++g) {
                        uint2 o; o.x = pk_bf16(acc[mi][ni][4 * g], acc[mi][ni][4 * g + 1]); o.y = pk_bf16(acc[mi][ni][4 * g + 2], acc[mi][ni][4 * g + 3]);
                        *(uint2*)(dst + 16 * (g >> 1) + 8 * lh + 4 * (g & 1)) = o;
                    }
                }
        } else if (tn == 22) {
            acc_foreach<CFG>(acc, [&](int r, int c, float v, int, int, int) {
                if (c < 8) p.small[(size_t)(tm * 256 + r) * 8 + c] = v;
                return v;
            });
        } else {
            bf16_t* dst; int ld, c0; float sc = 1.f;
            if (tn < 6) { dst = p.qkvraw; ld = 1536; c0 = tn * 256; }
            else if (tn < 8) { dst = p.dzb; ld = 512; c0 = (tn - 6) * 256; }
            else if (tn < 10) { dst = p.sq; ld = 512; c0 = (tn - 8) * 256; sc = 0.125f * 1.4426950408889634f; }
            else if (tn < 12) { dst = p.sk; ld = 512; c0 = (tn - 10) * 256; }
            else if (tn < 18) { dst = p.gab; ld = 1024; c0 = (tn - 14) * 256; }
            else { dst = p.gbb; ld = 1024; c0 = (tn - 18) * 256; }
            acc_foreach<CFG>(acc, [&](int r, int c, float v, int, int, int) {
                dst[(size_t)(tm * 256 + r) * ld + c0 + c] = to_bf16(v * sc);
                return v;
            });
        }
    }
}

__device__ __forceinline__ void phase_merge(const Params& p, unsigned char* lds) {
    typedef GemmCfg<128, 256, 2, 4> CFG;
    TileMap tmap; tmap.init(T / 128, D / 256);
    for (int round = 0; round < tmap.rounds; ++round) {
        int tm, tn;
        if (!tmap.get(round, tm, tn)) continue;
        f32x16 acc[CFG::MI][CFG::NI];
        {
            LoadRowsBf16<128> al; LoadRowsBf16<256> bl;
            al.init(p.oab, DNW, [&](int r) { return (long long)(tm * 128 + r); });
            bl.init(p.w_pa_t, DNW, [&](int r) { return (long long)(tn * 256 + r); });
            acc_zero<CFG>(acc);
            gemm_mainloop<CFG>(al, bl, DNW / 64, acc, lds);
            asm volatile("" : "+s"(tm), "+s"(tn));
        }
        acc_foreach<CFG>(acc, [&](int r, int c, float v, int, int, int) {
            const size_t gi = (size_t)(tm * 128 + r) * D + tn * 256 + c;
            const float ga = sigmoidf_(bf2f(p.gab[gi])), gb = fmaxf(sigmoidf_(bf2f(p.gbb[gi])), 1e-30f);
            return v * (ga / gb);
        });
        {
            LoadRowsBf16<128> al; LoadRowsBf16<256> bl;
            al.init(p.obb, SBW, [&](int r) { return (long long)(tm * 128 + r); });
            bl.init(p.w_pb_t, SBW, [&](int r) { return (long long)(tn * 256 + r); });
            gemm_mainloop<CFG>(al, bl, SBW / 64, acc, lds);
            asm volatile("" : "+s"(tm), "+s"(tn));
        }
        acc_foreach<CFG>(acc, [&](int r, int c, float v, int, int, int) {
            const int row = tm * 128 + r, col = tn * 256 + c;
            const float gb = fmaxf(sigmoidf_(bf2f(p.gbb[(size_t)row * D + col])), 1e-30f);
            p.mergedb[(size_t)row * D + col] = to_bf16(v * gb);
            return v;
        });
    }
}

__device__ __forceinline__ void phase_outproj(const Params& p, unsigned char* lds) {
    typedef GemmCfg<256, 256, 2, 4> CFG;
    TileMap tmap; tmap.init(T / 256, D / 256);
    for (int round = 0; round < tmap.rounds; ++round) {
        int tm, tn;
        if (!tmap.get(round, tm, tn)) continue;
        LoadRowsBf16<256> al, bl;
        al.init(p.mergedb, D, [&](int r) { return (long long)(tm * 256 + r); });
        bl.init(p.w_out_t, D, [&](int r) { return (long long)(tn * 256 + r); });
        f32x16 acc[CFG::MI][CFG::NI];
        acc_zero<CFG>(acc);
        gemm_mainloop<CFG>(al, bl, D / 64, acc, lds);
        asm volatile("" : "+s"(tm), "+s"(tn));
        acc_foreach<CFG>(acc, [&](int r, int c, float v, int, int, int) {
            const size_t o = (size_t)(tm * 256 + r) * D + tn * 256 + c;
            p.pre1[o] = v + ALPHA * p.x[o];
            return v;
        });
    }
}

__device__ __forceinline__ void phase_router_shared_up(const Params& p, unsigned char* lds) {
    {
        typedef GemmCfg<128, 128, 4, 2> CFG;
        TileMap tmap; tmap.init(T / 128, NE / 128);
        for (int round = 0; round < tmap.rounds; ++round) {
            int tm, tn;
            if (!tmap.get(round, tm, tn)) continue;
            LoadRowsBf16<128> al, bl;
            al.init(p.hb, D, [&](int r) { return (long long)(tm * 128 + r); });
            bl.init(p.w_router_t, D, [&](int r) { return (long long)(tn * 128 + r); });
            f32x16 acc[CFG::MI][CFG::NI];
            acc_zero<CFG>(acc);
            gemm_mainloop<CFG>(al, bl, D / 64, acc, lds);
            asm volatile("" : "+s"(tm), "+s"(tn));
            acc_foreach<CFG>(acc, [&](int r, int c, float v, int, int, int) {
                p.scores[(size_t)(tm * 128 + r) * NE + tn * 128 + c] = sigmoidf_(v);
                return v;
            });
        }
    }
    {
        typedef GemmCfg<128, 256, 2, 4> CFG;
        TileMap tmap; tmap.init(T / 128, SFF / 128);
        for (int round = 0; round < tmap.rounds; ++round) {
            int tm, tn;
            if (!tmap.get(round, tm, tn)) continue;
            LoadRowsBf16<128> al; LoadRowsBf16<256> bl;
            al.init(p.hb, D, [&](int r) { return (long long)(tm * 128 + r); });
            bl.init(p.w_su_t, D, [&](int r) { return (long long)(((r >> 5) & 1) * SFF + tn * 128 + (r >> 6) * 32 + (r & 31)); });
            f32x16 acc[CFG::MI][CFG::NI];
            acc_zero<CFG>(acc);
            gemm_mainloop<CFG>(al, bl, D / 64, acc, lds);
            asm volatile("" : "+s"(tm), "+s"(tn));
            const int tid = opaque_tid(), lane = tid & 63, wid = tid >> 6, wm = wid / CFG::WN, wn = wid % CFG::WN;
#pragma unroll
            for (int mi = 0; mi < CFG::MI; ++mi)
#pragma unroll
                for (int r = 0; r < 16; ++r) {
                    const int row = tm * 128 + wm * CFG::TM + mi * 32 + (r & 3) + 8 * (r >> 2) + 4 * (lane >> 5);
                    const int j = tn * 128 + wn * 32 + (lane & 31);
                    const float g = acc[mi][0][r], u = acc[mi][1][r];
                    p.actsh[(size_t)row * SFF + j] = to_bf16(siluf_(g) * u);
                }
        }
    }
}

__device__ __forceinline__ void phase_shared_down(const Params& p, unsigned char* lds) {
    typedef GemmCfg<256, 256, 2, 4> CFG;
    TileMap tmap; tmap.init(T / 256, D / 256);
    for (int round = 0; round < tmap.rounds; ++round) {
        int tm, tn;
        if (!tmap.get(round, tm, tn)) continue;
        LoadRowsBf16<256> al, bl;
        al.init(p.actsh, SFF, [&](int r) { return (long long)(tm * 256 + r); });
        bl.init(p.w_sd_t, SFF, [&](int r) { return (long long)(tn * 256 + r); });
        f32x16 acc[CFG::MI][CFG::NI];
        acc_zero<CFG>(acc);
        gemm_mainloop<CFG>(al, bl, SFF / 64, acc, lds);
        asm volatile("" : "+s"(tm), "+s"(tn));
        acc_foreach<CFG>(acc, [&](int r, int c, float v, int, int, int) {
            p.ysh[(size_t)(tm * 256 + r) * D + tn * 256 + c] = v;
            return v;
        });
    }
}

__device__ __forceinline__ void phase_init(const Params& p) {
    const int gtid = blockIdx.x * NT + opaque_tid(), gsz = gridDim.x * NT;
    for (int i = gtid; i < NE; i += gsz) { p.counts[i] = 0; p.cursor[i] = 0; }
}

__device__ __forceinline__ void phase_dn_prep(const Params& p) {
    const int lane = opaque_tid() & 63, wave = (blockIdx.x * NT + opaque_tid()) >> 6, nw = (gridDim.x * NT) >> 6;
    for (int item = wave; item < T * 12; item += nw) {
        const int t = item / 12, j = item % 12, type = j >> 2, hh = j & 3;
        const int s = t & (SEQ - 1);
        float v[2];
#pragma unroll
        for (int u = 0; u < 2; ++u) {
            const int col = type * 512 + hh * 128 + lane * 2 + u;
            float acc = 0.f;
#pragma unroll
            for (int tap = 0; tap < 4; ++tap) {
                const int ds = s + tap - 3;
                if (ds >= 0) acc += bf2f(p.qkvraw[(size_t)(t + tap - 3) * 1536 + col]) * p.conv_w[tap * 1536 + col];
            }
            v[u] = siluf_(acc);
        }
        if (type < 2) {
            const float ss = wave_sum(v[0] * v[0] + v[1] * v[1]);
            float r = rsqrtf(ss + NORM_EPS);
            if (type == 0) r *= 0.08838834764831845f;
            v[0] *= r; v[1] *= r;
        }
        float* dst = (type == 0 ? p.qa : type == 1 ? p.ka : p.va) + (size_t)t * DNW + hh * 128 + lane * 2;
        dst[0] = v[0]; dst[1] = v[1];
    }
    const int gtid = blockIdx.x * NT + opaque_tid(), gsz = gridDim.x * NT;
    for (int i = gtid; i < T * 4; i += gsz) {
        const int t = i >> 2, hh = i & 3;
        const float da = p.small[(size_t)t * 8 + 4 + hh] + p.dt_bias[hh];
        const float sp = (da > 20.f) ? da : log1pf(expf(da));
        p.gl[i] = -expf(p.a_log[hh]) * sp;
        p.bt[i] = sigmoidf_(p.small[(size_t)t * 8 + hh]);
    }
}

__device__ __forceinline__ void deltanet_naive(const Params& p, int b, float* smem) {
    const int tid = threadIdx.x, hh = tid >> 7, e = tid & 127;
    float* ks = smem;
    float* qs = smem + 8 * 512;
    float* vs = smem + 16 * 512;
    float* gs = smem + 24 * 512;
    float* bs = gs + 32;
    float S[128];
#pragma unroll
    for (int d = 0; d < 128; ++d) S[d] = 0.f;
    for (int t0 = 0; t0 < SEQ; t0 += 8) {
        const size_t base = (size_t)(b * SEQ + t0) * DNW;
        for (int i = tid; i < 8 * 512; i += NT) { ks[i] = p.ka[base + i]; qs[i] = p.qa[base + i]; vs[i] = p.va[base + i]; }
        if (tid < 32) { gs[tid] = p.gl[(size_t)(b * SEQ + t0) * 4 + tid]; bs[tid] = p.bt[(size_t)(b * SEQ + t0) * 4 + tid]; }
        __syncthreads();
        for (int tt = 0; tt < 8; ++tt) {
            const float* kk = ks + tt * 512 + hh * 128;
            const float* qq = qs + tt * 512 + hh * 128;
            float kS = 0.f;
#pragma unroll
            for (int d = 0; d < 128; ++d) { kS = fmaf(kk[d], S[d], kS); if ((d & 15) == 15) asm volatile("" ::: "memory"); }
            const float eg = expf(gs[tt * 4 + hh]), be = bs[tt * 4 + hh], ve = vs[tt * 512 + tid];
            const float c = be * (ve - eg * kS);
            float o = 0.f;
#pragma unroll
            for (int d = 0; d < 128; ++d) { S[d] = fmaf(kk[d], c, eg * S[d]); o = fmaf(qq[d], S[d], o); if ((d & 15) == 15) asm volatile("" ::: "memory"); }
            p.oraw[(size_t)(b * SEQ + t0 + tt) * DNW + tid] = o;
        }
        __syncthreads();
    }
}

__device__ __forceinline__ void sb_attn_wave(const Params& p, int bh, int qt) {
    const int lane = opaque_tid() & 63, l31 = lane & 31, lh = lane >> 5;
    const int b = bh >> 3, hh = bh & 7;
    bf16x8 qf[4];
    {
        const bf16_t* qrow = p.sq + (size_t)(b * SEQ + qt * 32 + l31) * SBW + hh * 64 + lh * 8;
#pragma unroll
        for (int ks = 0; ks < 4; ++ks) qf[ks] = *(const bf16x8*)(qrow + ks * 16);
    }
    f32x16 o0, o1;
#pragma unroll
    for (int r = 0; r < 16; ++r) { o0[r] = 0.f; o1[r] = 0.f; }
    float run = 0.f;
    const bf16_t* vbase = p.vT + ((size_t)(bh * 64 + l31)) * SEQ + lh * 8;
    for (int kt = qt; kt >= 0; --kt) {
        const bf16_t* krow = p.sk + (size_t)(b * SEQ + kt * 32 + l31) * SBW + hh * 64 + lh * 8;
        bf16x8 kf[4];
#pragma unroll
        for (int ks = 0; ks < 4; ++ks) kf[ks] = *(const bf16x8*)(krow + ks * 16);
        bf16x8 vf[2][2];
#pragma unroll
        for (int md = 0; md < 2; ++md)
#pragma unroll
            for (int ss = 0; ss < 2; ++ss) vf[md][ss] = *(const bf16x8*)(vbase + (size_t)md * 32 * SEQ + kt * 32 + ss * 16);
        f32x16 sc;
#pragma unroll
        for (int r = 0; r < 16; ++r) sc[r] = 0.f;
#pragma unroll
        for (int ks = 0; ks < 4; ++ks) sc = __builtin_amdgcn_mfma_f32_32x32x16_bf16(kf[ks], qf[ks], sc, 0, 0, 0);
        float lb[16], lr[16];
        const bool diag = (kt == qt);
#pragma unroll
        for (int r = 0; r < 16; ++r) {
            const float z = sc[r];
            const float l = __builtin_amdgcn_logf(1.f + __builtin_amdgcn_exp2f(-fabsf(z)));
            float b_ = fminf(z, 0.f) - l, r_ = b_ - z;
            if (diag) { const bool valid = ((r & 3) + 8 * (r >> 2) + 4 * lh) < l31; r_ = valid ? r_ : 0.f; b_ = valid ? b_ : -INFINITY; }
            lb[r] = b_; lr[r] = r_;
        }
        float ex[16], B[4];
#pragma unroll
        for (int g = 0; g < 4; ++g) {
            ex[4 * g + 3] = 0.f;
            ex[4 * g + 2] = lr[4 * g + 3];
            ex[4 * g + 1] = ex[4 * g + 2] + lr[4 * g + 2];
            ex[4 * g + 0] = ex[4 * g + 1] + lr[4 * g + 1];
            B[g] = ex[4 * g + 0] + lr[4 * g + 0];
        }
        float P[4];
#pragma unroll
        for (int g = 0; g < 4; ++g) P[g] = __shfl_xor(B[g], 32);
        float off[4];
        {
            const float p3 = P[3], p2 = P[2] + p3, p1 = P[1] + p2, p0 = P[0] + p1;
            const float b3 = 0.f, b2 = B[3], b1 = B[2] + b2, b0 = B[1] + b1;
            off[0] = b0 + (lh ? p1 : p0);
            off[1] = b1 + (lh ? p2 : p1);
            off[2] = b2 + (lh ? p3 : p2);
            off[3] = b3 + (lh ? 0.f : p3);
            const float total = (B[0] + b0) + p0;
#pragma unroll
            for (int g = 0; g < 4; ++g) off[g] += run;
            run += total;
        }
        float a[16];
#pragma unroll
        for (int r = 0; r < 16; ++r) a[r] = __builtin_amdgcn_exp2f(lb[r] + ex[r] + off[r >> 2]);
        bf16x8 pf[2];
#pragma unroll
        for (int ss = 0; ss < 2; ++ss) {
            typedef unsigned u32x4 __attribute__((ext_vector_type(4)));
            u32x4 w;
            w[0] = pk_bf16(a[8 * ss + 0], a[8 * ss + 1]); w[1] = pk_bf16(a[8 * ss + 2], a[8 * ss + 3]);
            w[2] = pk_bf16(a[8 * ss + 4], a[8 * ss + 5]); w[3] = pk_bf16(a[8 * ss + 6], a[8 * ss + 7]);
            pf[ss] = __builtin_bit_cast(bf16x8, w);
        }
#pragma unroll
        for (int ss = 0; ss < 2; ++ss) {
            o0 = __builtin_amdgcn_mfma_f32_32x32x16_bf16(vf[0][ss], pf[ss], o0, 0, 0, 0);
            o1 = __builtin_amdgcn_mfma_f32_32x32x16_bf16(vf[1][ss], pf[ss], o1, 0, 0, 0);
        }
        if (__all(run < -160.f)) break;
    }
    bf16_t* orow = p.obb + (size_t)(b * SEQ + qt * 32 + l31) * SBW + hh * 64 + 4 * lh;
#pragma unroll
    for (int g = 0; g < 4; ++g) {
        uint2 w0, w1;
        w0.x = pk_bf16(o0[4 * g], o0[4 * g + 1]); w0.y = pk_bf16(o0[4 * g + 2], o0[4 * g + 3]);
        w1.x = pk_bf16(o1[4 * g], o1[4 * g + 1]); w1.y = pk_bf16(o1[4 * g + 2], o1[4 * g + 3]);
        *(uint2*)(orow + 8 * g) = w0;
        *(uint2*)(orow + 32 + 8 * g) = w1;
    }
}


constexpr int DN_RW = 0, DN_RQ = 128, DN_RAT = 256, DN_RKD = 320, DN_ROWS = 448, DN_BLOB = DN_ROWS * 64;
constexpr float LOG2E = 1.4426950408889634f;
__device__ __forceinline__ int pi16(int x) { return (x & ~12) | ((x & 4) << 1) | ((x & 8) >> 1); }
__device__ __forceinline__ uint4 pack8(const float* v) { uint4 o; o.x = pk_bf16(v[0], v[1]); o.y = pk_bf16(v[2], v[3]); o.z = pk_bf16(v[4], v[5]); o.w = pk_bf16(v[6], v[7]); return o; }

__device__ __forceinline__ void dn_chunk_item(const Params& p, int item, unsigned char* lds) {
    const int tid = opaque_tid(), lane = tid & 63, wid = tid >> 6;
    const int bh = item >> 5, n = item & 31, b = bh >> 2, hh = bh & 3;
    const int t0 = b * SEQ + n * 64;
    unsigned char* Kimg = lds; unsigned char* KBimg = lds + 16384; unsigned char* Qimg = lds + 32768;
    float* Vf = (float*)(lds + 49152); float* KBGf = (float*)(lds + 81920); float* MT = (float*)(lds + 114688);
    float* G2s = (float*)(lds + 114688 + 17408); float* betas = G2s + 64;
    bf16_t* blob = p.dnblob + (size_t)item * DN_BLOB;
    if (wid == 0) {
        const int t = t0 + lane;
        const float da = p.small[(size_t)t * 8 + 4 + hh] + p.dt_bias[hh];
        const float sp = da > 20.f ? da : log1pf(expf(da));
        float g2 = -expf(p.a_log[hh]) * sp * LOG2E;
#pragma unroll
        for (int off = 1; off < 64; off <<= 1) { const float v = __shfl_up(g2, off); if (lane >= off) g2 += v; }
        G2s[lane] = g2; betas[lane] = sigmoidf_(p.small[(size_t)t * 8 + hh]);
        if (lane == 63) p.dnlast[item] = exp2f(g2);
    }
    __syncthreads();
    {
        const int c8 = tid & 15, tq = tid >> 4, j0 = tq * 2;
        const float G0 = G2s[j0], G1 = G2s[j0 + 1], GL = G2s[63];
        const float be[2] = {betas[j0], betas[j0 + 1]};
        const float eg[2] = {exp2f(G0), exp2f(G1)}, el[2] = {exp2f(GL - G0), exp2f(GL - G1)};
        const int half = c8 >> 3, ch = c8 & 7;
#pragma unroll
        for (int type = 0; type < 3; ++type) {
            float o[2][8];
            {
                const bf16_t* src = p.qkvraw + (size_t)(t0 + j0 - 3) * 1536 + type * 512 + hh * 128 + c8 * 8;
                float x[5][8];
#pragma unroll
                for (int r = 0; r < 5; ++r) {
                    uint4 raw = make_uint4(0, 0, 0, 0);
                    if (n > 0 || j0 - 3 + r >= 0) raw = *(const uint4*)(src + (size_t)r * 1536);
                    const unsigned u[4] = {raw.x, raw.y, raw.z, raw.w};
#pragma unroll
                    for (int i = 0; i < 4; ++i) { x[r][2 * i] = __uint_as_float(u[i] << 16); x[r][2 * i + 1] = __uint_as_float(u[i] & 0xffff0000u); }
                }
                const float* wp = p.conv_w + type * 512 + hh * 128 + c8 * 8;
#pragma unroll
                for (int i = 0; i < 8; ++i) {
                    float a0 = 0.f, a1 = 0.f;
#pragma unroll
                    for (int tap = 0; tap < 4; ++tap) { const float w = wp[tap * 1536 + i]; a0 = fmaf(x[tap][i], w, a0); a1 = fmaf(x[tap + 1][i], w, a1); }
                    o[0][i] = siluf_(a0); o[1][i] = siluf_(a1);
                }
            }
            if (type < 2) {
#pragma unroll
                for (int tk = 0; tk < 2; ++tk) {
                    float ss = 0.f;
#pragma unroll
                    for (int i = 0; i < 8; ++i) ss = fmaf(o[tk][i], o[tk][i], ss);
                    ss += __shfl_xor(ss, 1); ss += __shfl_xor(ss, 2); ss += __shfl_xor(ss, 4); ss += __shfl_xor(ss, 8);
                    float r = rsqrtf(ss + NORM_EPS);
                    if (type == 0) r *= 0.08838834764831845f;
#pragma unroll
                    for (int i = 0; i < 8; ++i) o[tk][i] *= r;
                }
            }
#pragma unroll
            for (int tk = 0; tk < 2; ++tk) {
                const int j = j0 + tk;
                const int ioff = half * 8192 + j * 128 + ((ch ^ swz(j)) << 4);
                if (type == 0) {
                    *(uint4*)(Qimg + ioff) = pack8(o[tk]);
                    float qd[8];
#pragma unroll
                    for (int i = 0; i < 8; ++i) qd[i] = o[tk][i] * eg[tk];
                    bf16_t* qrow = blob + (size_t)(DN_RQ + half * 64 + j) * 64 + ((c8 >> 1) & 3) * 16 + 4 * (c8 & 1);
                    uint2 w0, w1; w0.x = pk_bf16(qd[0], qd[1]); w0.y = pk_bf16(qd[2], qd[3]); w1.x = pk_bf16(qd[4], qd[5]); w1.y = pk_bf16(qd[6], qd[7]);
                    *(uint2*)qrow = w0; *(uint2*)(qrow + 8) = w1;
                } else if (type == 1) {
                    float kb[8], kbg[8];
#pragma unroll
                    for (int i = 0; i < 8; ++i) { kb[i] = o[tk][i] * be[tk]; kbg[i] = kb[i] * eg[tk]; }
                    *(uint4*)(Kimg + ioff) = pack8(o[tk]);
                    *(uint4*)(KBimg + ioff) = pack8(kb);
                    f32x4* kd = (f32x4*)(KBGf + j * 128 + c8 * 8); kd[0] = (f32x4){kbg[0], kbg[1], kbg[2], kbg[3]}; kd[1] = (f32x4){kbg[4], kbg[5], kbg[6], kbg[7]};
                } else {
                    float vb[8];
#pragma unroll
                    for (int i = 0; i < 8; ++i) vb[i] = o[tk][i] * be[tk];
                    f32x4* vd = (f32x4*)(Vf + j * 128 + c8 * 8); vd[0] = (f32x4){vb[0], vb[1], vb[2], vb[3]}; vd[1] = (f32x4){vb[4], vb[5], vb[6], vb[7]};
                }
            }
            if (type == 1) {
                const int jp = (j0 & 48) | pi16(j0 & 15);
#pragma unroll
                for (int i = 0; i < 8; ++i)
                    *(unsigned*)(blob + (size_t)(DN_RKD + c8 * 8 + i) * 64 + jp) = pk_bf16(o[0][i] * el[0], o[1][i] * el[1]);
            }
            asm volatile("" ::: "memory");
        }
    }
    __syncthreads();
    {
        const int which = wid >> 2, ti = (wid >> 1) & 1, tj = wid & 1, l31 = lane & 31, lh = lane >> 5;
        if (!(ti == 0 && tj == 1)) {
            const unsigned char* Ab = (which == 0 ? KBimg : Qimg) + (ti * 32 + l31) * 128;
            const unsigned char* Bb = Kimg + (tj * 32 + l31) * 128;
            const int fsw = swz(l31);
            f32x16 acc;
#pragma unroll
            for (int r = 0; r < 16; ++r) acc[r] = 0.f;
#pragma unroll
            for (int ks = 0; ks < 8; ++ks) {
                const int off = (ks >> 2) * 8192 + ((((ks & 3) * 2 + lh) ^ fsw) << 4);
                acc = __builtin_amdgcn_mfma_f32_32x32x16_bf16(*(const bf16x8*)(Ab + off), *(const bf16x8*)(Bb + off), acc, 0, 0, 0);
            }
            const int j = tj * 32 + l31;
            const float Gj = G2s[j];
#pragma unroll
            for (int r = 0; r < 16; ++r) {
                const int i = ti * 32 + (r & 3) + 8 * (r >> 2) + 4 * lh;
                const float v = acc[r] * exp2f(G2s[i] - Gj);
                if (which == 0) MT[j * 68 + i] = (i > j) ? v : 0.f;
                else blob[(size_t)(DN_RAT + i) * 64 + ((j & 48) | pi16(j & 15))] = to_bf16((i >= j) ? v : 0.f);
            }
        }
    }
    __syncthreads();
#ifndef NO_SOLVE
    if (tid < 256) {
        const int c = tid & 127;
        const float* rhs = (tid < 128 ? Vf : KBGf) + c;
        float y[64];
#pragma unroll
        for (int j = 0; j < 64; ++j) y[j] = rhs[j * 128];
#pragma unroll
        for (int j = 0; j < 63; ++j) {
            const float yj = y[j];
#pragma unroll
            for (int i4 = (j + 1) & ~3; i4 < 64; i4 += 4) {
                const f32x4 m = *(const f32x4*)(MT + j * 68 + i4);
#pragma unroll
                for (int u = 0; u < 4; ++u) if (i4 + u > j) y[i4 + u] = fmaf(-m[u], yj, y[i4 + u]);
            }
            asm volatile("" ::: "memory");
        }
        if (tid < 128) {
#pragma unroll
            for (int mi = 0; mi < 2; ++mi)
#pragma unroll
                for (int h = 0; h < 2; ++h) {
                    f32x4* dst = (f32x4*)(p.dnu + ((((size_t)item * 2 + mi) * 4 + (c >> 5)) * 64 + h * 32 + (c & 31)) * 16);
#pragma unroll
                    for (int g = 0; g < 4; ++g)
                        dst[g] = (f32x4){y[mi * 32 + 8 * g + 4 * h], y[mi * 32 + 8 * g + 4 * h + 1], y[mi * 32 + 8 * g + 4 * h + 2], y[mi * 32 + 8 * g + 4 * h + 3]};
                }
        } else {
            bf16_t* dst = blob + (size_t)(DN_RW + (c >> 6) * 64) * 64 + ((c & 48) | pi16(c & 15));
#pragma unroll
            for (int i = 0; i < 64; ++i) dst[(size_t)i * 64] = to_bf16(-y[i]);
        }
    }
#endif
    __syncthreads();
}

__device__ __forceinline__ void phase_dn_chunks(const Params& p, unsigned char* lds) {
    for (int item = blockIdx.x; item < NB * DNH * 32; item += gridDim.x) dn_chunk_item(p, item, lds);
}

__device__ __forceinline__ void dn_scan(const Params& p, int bh, unsigned char* lds) {
    const int tid = opaque_tid(), lane = tid & 63, wid = tid >> 6, l31 = lane & 31, lh = lane >> 5;
    const int b = bh >> 2, hh = bh & 3;
    const int fsw = swz(l31);
    auto copy_blob = [&](int n, unsigned char* dst) {
        const uint4* src = (const uint4*)(p.dnblob + (size_t)(bh * 32 + n) * DN_BLOB);
        const int lt = tid - 256;
#pragma unroll
        for (int k = 0; k < 14; ++k) {
            const int c = lt + k * 256, row = c >> 3, ch = c & 7;
            *(uint4*)(dst + row * 128 + ((ch ^ swz(row)) << 4)) = src[c];
        }
    };
    if (wid >= 4) copy_blob(0, lds);
    __syncthreads();
    f32x16 S[4];
#pragma unroll
    for (int t = 0; t < 4; ++t)
#pragma unroll
        for (int r = 0; r < 16; ++r) S[t][r] = 0.f;
    for (int n = 0; n < 32; ++n) {
        if (wid >= 4) {
            if (n + 1 < 32) copy_blob(n + 1, lds + ((n + 1) & 1) * (DN_ROWS * 128));
        } else {
            const unsigned char* buf = lds + (n & 1) * (DN_ROWS * 128);
            const int item = bh * 32 + n;
            f32x16 vn[2], oa[2];
#pragma unroll
            for (int mi = 0; mi < 2; ++mi) {
                vn[mi] = *(const f32x16*)(p.dnu + ((((size_t)item * 2 + mi) * 4 + wid) * 64 + lane) * 16);
#pragma unroll
                for (int r = 0; r < 16; ++r) oa[mi][r] = 0.f;
            }
            const float last = p.dnlast[item];
            typedef unsigned u32x4 __attribute__((ext_vector_type(4)));
            bf16x8 sb[4][2];
#pragma unroll
            for (int t = 0; t < 4; ++t)
#pragma unroll
                for (int ss = 0; ss < 2; ++ss) {
                    u32x4 w;
#pragma unroll
                    for (int q = 0; q < 4; ++q) w[q] = pk_bf16(S[t][8 * ss + 2 * q], S[t][8 * ss + 2 * q + 1]);
                    sb[t][ss] = __builtin_bit_cast(bf16x8, w);
                }
#pragma unroll
            for (int mi = 0; mi < 2; ++mi)
#pragma unroll
                for (int ks = 0; ks < 8; ++ks) {
                    const int off = ((ks >> 2) * 64 + mi * 32 + l31) * 128 + ((((ks & 3) * 2 + lh) ^ fsw) << 4);
                    vn[mi] = __builtin_amdgcn_mfma_f32_32x32x16_bf16(*(const bf16x8*)(buf + DN_RW * 128 + off), sb[ks >> 1][ks & 1], vn[mi], 0, 0, 0);
                    oa[mi] = __builtin_amdgcn_mfma_f32_32x32x16_bf16(*(const bf16x8*)(buf + DN_RQ * 128 + off), sb[ks >> 1][ks & 1], oa[mi], 0, 0, 0);
                }
            bf16x8 vb[2][2];
#pragma unroll
            for (int mj = 0; mj < 2; ++mj)
#pragma unroll
                for (int ss = 0; ss < 2; ++ss) {
                    u32x4 w;
#pragma unroll
                    for (int q = 0; q < 4; ++q) w[q] = pk_bf16(vn[mj][8 * ss + 2 * q], vn[mj][8 * ss + 2 * q + 1]);
                    vb[mj][ss] = __builtin_bit_cast(bf16x8, w);
                }
#pragma unroll
            for (int mi = 0; mi < 2; ++mi)
#pragma unroll
                for (int kj = 0; kj < 4; ++kj)
                    if ((kj >> 1) <= mi) {
                        const int off = (DN_RAT + mi * 32 + l31) * 128 + (((kj * 2 + lh) ^ fsw) << 4);
                        oa[mi] = __builtin_amdgcn_mfma_f32_32x32x16_bf16(*(const bf16x8*)(buf + off), vb[kj >> 1][kj & 1], oa[mi], 0, 0, 0);
                    }
#pragma unroll
            for (int t = 0; t < 4; ++t) {
#pragma unroll
                for (int r = 0; r < 16; ++r) S[t][r] *= last;
#pragma unroll
                for (int kj = 0; kj < 4; ++kj) {
                    const int off = (DN_RKD + t * 32 + l31) * 128 + (((kj * 2 + lh) ^ fsw) << 4);
                    S[t] = __builtin_amdgcn_mfma_f32_32x32x16_bf16(*(const bf16x8*)(buf + off), vb[kj >> 1][kj & 1], S[t], 0, 0, 0);
                }
            }
            float* orow = p.oraw + (size_t)(b * SEQ + n * 64) * DNW + hh * 128 + wid * 32 + l31;
#pragma unroll
            for (int mi = 0; mi < 2; ++mi)
#pragma unroll
                for (int r = 0; r < 16; ++r) orow[(size_t)(mi * 32 + (r & 3) + 8 * (r >> 2) + 4 * lh) * DNW] = oa[mi][r];
        }
        __syncthreads();
    }
}

__device__ __forceinline__ void phase_mixers(const Params& p, float* smem) {
    const int nscan = NB * DNH;
    if (gridDim.x >= 2 * nscan) {
#ifndef SKIP_SCAN
        if ((int)blockIdx.x < nscan) dn_scan(p, blockIdx.x, (unsigned char*)smem);
#endif
        if ((int)blockIdx.x < nscan) {}
        else
            for (int it = blockIdx.x - nscan; it < 512; it += gridDim.x - nscan) sb_attn_wave(p, it >> 3, (it & 7) * 8 + (opaque_tid() >> 6));
    } else {
#ifndef SKIP_SCAN
        for (int bh = blockIdx.x; bh < nscan; bh += gridDim.x) dn_scan(p, bh, (unsigned char*)smem);
#endif
        for (int it = blockIdx.x; it < 512; it += gridDim.x) sb_attn_wave(p, it >> 3, (it & 7) * 8 + (opaque_tid() >> 6));
    }
}

__device__ __forceinline__ void phase_gated_norm(const Params& p) {
    const int lane = opaque_tid() & 63, wave = (blockIdx.x * NT + opaque_tid()) >> 6, nw = (gridDim.x * NT) >> 6;
    for (int item = wave; item < T * 4; item += nw) {
        const int t = item >> 2, hh = item & 3;
        const size_t off = (size_t)t * DNW + hh * 128 + lane * 2;
        const float v0 = p.oraw[off], v1 = p.oraw[off + 1];
        const float ss = wave_sum(v0 * v0 + v1 * v1);
        const float r = rsqrtf(ss * (1.f / 128.f) + NORM_EPS);
        const float z0 = bf2f(p.dzb[(size_t)t * 512 + hh * 128 + lane * 2]), z1 = bf2f(p.dzb[(size_t)t * 512 + hh * 128 + lane * 2 + 1]);
        p.oab[off] = to_bf16(v0 * r * p.norm_g[lane * 2] * siluf_(z0));
        p.oab[off + 1] = to_bf16(v1 * r * p.norm_g[lane * 2 + 1] * siluf_(z1));
    }
}

template <class SF>
__device__ __forceinline__ void layer_norm_rows(SF sf, const float* g, const float* bb, float* dst, bf16_t* dstb) {
    const int lane = opaque_tid() & 63, wave = (blockIdx.x * NT + opaque_tid()) >> 6, nw = (gridDim.x * NT) >> 6;
    for (int t = wave; t < T; t += nw) {
        float v[16];
        float s = 0.f;
#pragma unroll
        for (int i = 0; i < 16; ++i) { v[i] = sf(t, lane + i * 64); s += v[i]; }
        const float mu = wave_sum(s) * (1.f / 1024.f);
        float q = 0.f;
#pragma unroll
        for (int i = 0; i < 16; ++i) { const float d = v[i] - mu; q += d * d; }
        const float rstd = rsqrtf(wave_sum(q) * (1.f / 1024.f) + LN_EPS);
#pragma unroll
        for (int i = 0; i < 16; ++i) { const int c = lane + i * 64; const float y = (v[i] - mu) * rstd * g[c] + bb[c]; dst[(size_t)t * D + c] = y; if (dstb) dstb[(size_t)t * D + c] = to_bf16(y); }
    }
}

constexpr int ECAP = T;
__device__ __forceinline__ void phase_route(const Params& p) {
    const int tid = opaque_tid(), lane = tid & 63;
    const int wave = (blockIdx.x * NT + tid) >> 6, nw = (gridDim.x * NT) >> 6;
    const f32x4 bias = *(const f32x4*)(p.router_bias + lane * 4);
    for (int t = wave; t < T; t += nw) {
        const f32x4 sc = *(const f32x4*)(p.scores + (size_t)t * NE + lane * 4);
        const float sel[4] = {sc[0] + bias[0], sc[1] + bias[1], sc[2] + bias[2], sc[3] + bias[3]};
        float m1 = fmaxf(sel[0], sel[1]), m2 = fminf(sel[0], sel[1]);
        m2 = fmaxf(m2, fminf(m1, sel[2])); m1 = fmaxf(m1, sel[2]);
        m2 = fmaxf(m2, fminf(m1, sel[3])); m1 = fmaxf(m1, sel[3]);
#pragma unroll
        for (int off = 1; off < 8; off <<= 1) {
            const float o1 = __shfl_xor(m1, off), o2 = __shfl_xor(m2, off);
            const float n2 = fmaxf(fminf(m1, o1), fmaxf(m2, o2));
            m1 = fmaxf(m1, o1); m2 = n2;
        }
        const float gs = m1 + m2;
        const int g = lane >> 3;
        int rank = 0;
#pragma unroll
        for (int gg = 0; gg < NG; ++gg) { const float og = __shfl(gs, gg * 8); rank += (og > gs || (og == gs && gg < g)) ? 1 : 0; }
        const bool gsel = rank < TOPG;
        unsigned long long key[4];
#pragma unroll
        for (int i = 0; i < 4; ++i) {
            const unsigned u = __float_as_uint(gsel ? sel[i] : -INFINITY);
            const unsigned ku = (u & 0x80000000u) ? ~u : (u | 0x80000000u);
            key[i] = ((unsigned long long)ku << 32) | (unsigned)(255 - (lane * 4 + i));
        }
        float wsum = 0.f, myw = 0.f; int myidx = 0;
#pragma unroll
        for (int it = 0; it < TOPK; ++it) {
            unsigned long long best = key[0] > key[1] ? key[0] : key[1];
            best = key[2] > best ? key[2] : best; best = key[3] > best ? key[3] : best;
#pragma unroll
            for (int off = 32; off > 0; off >>= 1) { const unsigned long long o = __shfl_xor(best, off); best = o > best ? o : best; }
            const int e = 255 - (int)(unsigned)(best & 0xffffffffull);
#pragma unroll
            for (int i = 0; i < 4; ++i) if (lane * 4 + i == e) key[i] = 0ull;
            const int q = e & 3;
            const float mine = q == 0 ? sc[0] : q == 1 ? sc[1] : q == 2 ? sc[2] : sc[3];
            const float w = __shfl(mine, e >> 2);
            wsum += w;
            if (lane == it) { myidx = e; myw = w; }
        }
        if (lane < TOPK) {
            const int pr = t * TOPK + lane;
            p.idx[pr] = myidx;
            p.gate[pr] = myw / wsum * 2.5f;
            const int pos = atomicAdd(&p.counts[myidx], 1);
            p.explist[(size_t)myidx * ECAP + pos] = pr;
        }
    }
}

__device__ __forceinline__ void compute_pend(const Params& p, int* pend, int* cnt) {
    const int tid = opaque_tid();
    if (tid < 64) {
        int c[4], pc[4];
#pragma unroll
        for (int i = 0; i < 4; ++i) { c[i] = p.counts[tid * 4 + i]; cnt[tid * 4 + i] = c[i]; pc[i] = (c[i] + 127) / 128 * 128; }
        const int ssum = pc[0] + pc[1] + pc[2] + pc[3];
        int inc = ssum;
#pragma unroll
        for (int off = 1; off < 64; off <<= 1) { const int v = __shfl_up(inc, off); if (tid >= off) inc += v; }
        int run = inc - ssum;
#pragma unroll
        for (int i = 0; i < 4; ++i) { run += pc[i]; pend[tid * 4 + i] = run; }
    }
    __syncthreads();
}

__device__ __forceinline__ int expert_of_row(const int* pend, int row) {
    int lo = 0, hi = NE - 1;
    while (lo < hi) { const int mid = (lo + hi) >> 1; if (pend[mid] > row) hi = mid; else lo = mid + 1; }
    return lo;
}

__device__ __forceinline__ void phase_routed_up(const Params& p, int* pend, int* cnt, unsigned char* lds) {
    typedef GemmCfg<128, 256, 2, 4> CFG;
    compute_pend(p, pend, cnt);
    TileMap tmap; tmap.init(pend[NE - 1] / 128, EFF / 128, 2);
    for (int round = 0; round < tmap.rounds; ++round) {
        int tm, tn;
        if (!tmap.get(round, tm, tn)) continue;
        const int e = expert_of_row(pend, tm * 128);
        LoadRowsBf16<128, true> al; LoadKNF32 bl;
        const int q0 = tm * 128 - (e ? pend[e - 1] : 0), ce = cnt[e];
        al.init(p.hb, D, [&](int r) {
            const int pr = (q0 + r < ce) ? p.explist[(size_t)e * ECAP + q0 + r] : -1;
            if (tn == 0) p.padpair[tm * 128 + r] = pr;
            return pr >= 0 ? (long long)(pr >> 3) : -1LL; });
        bl.init(p.w_eu + (size_t)e * D * (2 * EFF), 2 * EFF, [&](int r) { return ((r >> 5) & 1) * EFF + tn * 128 + (r >> 6) * 32 + (r & 31); });
        f32x16 acc[CFG::MI][CFG::NI];
        acc_zero<CFG>(acc);
        gemm_mainloop<CFG>(al, bl, D / 64, acc, lds);
        asm volatile("" : "+s"(tm), "+s"(tn));
        const int tid = opaque_tid(), lane = tid & 63, wid = tid >> 6, wm = wid / CFG::WN, wn = wid % CFG::WN;
#pragma unroll
        for (int mi = 0; mi < CFG::MI; ++mi)
#pragma unroll
            for (int r = 0; r < 16; ++r) {
                const int row = tm * 128 + wm * CFG::TM + mi * 32 + (r & 3) + 8 * (r >> 2) + 4 * (lane >> 5);
                const int j = tn * 128 + wn * 32 + (lane & 31);
                const float g = acc[mi][0][r], u = acc[mi][1][r];
                p.actr[(size_t)row * EFF + j] = to_bf16(siluf_(g) * u);
            }
    }
}

__device__ __forceinline__ void phase_routed_down(const Params& p, const int* pend, unsigned char* lds) {
    typedef GemmCfg<128, 256, 2, 4> CFG;
    TileMap tmap; tmap.init(pend[NE - 1] / 128, D / 256, 4);
    for (int round = 0; round < tmap.rounds; ++round) {
        int tm, tn;
        if (!tmap.get(round, tm, tn)) continue;
        const int e = expert_of_row(pend, tm * 128);
        LoadRowsBf16<128> al; LoadKNF32 bl;
        al.init(p.actr, EFF, [&](int r) { return (long long)(tm * 128 + r); });
        bl.init(p.w_ed + (size_t)e * EFF * D, D, [&](int r) { return tn * 256 + r; });
        f32x16 acc[CFG::MI][CFG::NI];
        acc_zero<CFG>(acc);
        gemm_mainloop<CFG>(al, bl, EFF / 64, acc, lds);
        asm volatile("" : "+s"(tm), "+s"(tn));
        acc_foreach<CFG>(acc, [&](int r, int c, float v, int, int, int) {
            const int pr = p.padpair[tm * 128 + r];
            if (pr >= 0) p.ypairb[(size_t)pr * D + tn * 256 + c] = to_bf16(v * p.gate[pr]);
            return v;
        });
    }
}

#ifndef R0
#define R0 1
#define R1 1
#define R2 1
#define R3 1
#define R4 1
#define R5 1
#define R6 1
#define R7 1
#define R8 1
#define R10 1
#define R11 1
#define R12 1
#endif
constexpr int LDS_MAIN = 133120;
__global__ void __launch_bounds__(NT) fwd_megakernel(Params p) {
    __shared__ __attribute__((aligned(16))) unsigned char lds[LDS_MAIN + 2 * NE * 4 + 16];
    float* smem = (float*)lds;
    int* pend = (int*)(lds + LDS_MAIN);
    int* cnt = pend + NE;
    volatile LAS3 unsigned* xbst = (volatile LAS3 unsigned*)(lds + LDS_MAIN + 2 * NE * 4);
    if (threadIdx.x == 0) { xbst[0] = 0u; xbst[1] = 0u; }
    __syncthreads();
    const XcdBarrier xb = xcd_barrier_post(p.bar, xbst);

#define REPEAT(N, ...) { int reps_ = (N); asm volatile("" : "+s"(reps_)); for (int rep_ = 0; rep_ < reps_; ++rep_) { __VA_ARGS__; xcd_barrier(xb); } }
    phase_init(p);
    REPEAT(R0,
        convert_bf16(p.x, p.xb, (size_t)T * D);
        transpose_convert(p.w_in, D, PW, PWP, p.w_in_t, smem, [](int n) { return n < 2048 ? n : n < 5632 ? n + 8 : n < 5640 ? n - 5632 + 2048 : -1; });
        transpose_convert(p.w_pa, DNW, D, D, p.w_pa_t, smem, [](int n) { return n; });
        transpose_convert(p.w_pb, SBW, D, D, p.w_pb_t, smem, [](int n) { return n; });
        transpose_convert(p.w_out, D, D, D, p.w_out_t, smem, [](int n) { return n; });
        transpose_convert(p.w_router, D, NE, NE, p.w_router_t, smem, [](int n) { return n; });
        transpose_convert(p.w_su, D, 2 * SFF, 2 * SFF, p.w_su_t, smem, [](int n) { return n; });
        transpose_convert(p.w_sd, SFF, D, D, p.w_sd_t, smem, [](int n) { return n; }))
    REPEAT(R1, phase_inproj(p, lds))
    REPEAT(R2, phase_dn_chunks(p, lds))
    REPEAT(R3, phase_mixers(p, smem))
    REPEAT(R4, phase_gated_norm(p))
    REPEAT(R5, phase_merge(p, lds))
    REPEAT(R6, phase_outproj(p, lds))
    REPEAT(R7, layer_norm_rows([&](int t, int c) { return p.pre1[(size_t)t * D + c]; }, p.ln1_g, p.ln1_b, p.h, p.hb))
    REPEAT(R8, phase_router_shared_up(p, lds))
    phase_route(p);
    xcd_barrier(xb);
    REPEAT(R10, phase_routed_up(p, pend, cnt, lds); phase_shared_down(p, lds))
    REPEAT(R11, phase_routed_down(p, pend, lds))
    int reps12 = R12; asm volatile("" : "+s"(reps12));
    for (int rep = 0; rep < reps12; ++rep)
        layer_norm_rows([&](int t, int c) {
                float f = p.ysh[(size_t)t * D + c];
#pragma unroll
                for (int k = 0; k < TOPK; ++k) f += bf2f(p.ypairb[((size_t)t * TOPK + k) * D + c]);
                return ALPHA * p.h[(size_t)t * D + c] + f; },
            p.ln2_g, p.ln2_b, p.out, nullptr);
}

extern "C" void kernel_launch(void* const* d_in, const int* in_sizes, int n_in, void* d_out, int out_size, void* d_ws,
                              size_t ws_size, hipStream_t stream) {
    static int grid_blocks = 0;
    if (!grid_blocks) {
        int dev = 0, cus = 0, per_cu = 0;
        hipGetDevice(&dev);
        hipDeviceGetAttribute(&cus, hipDeviceAttributeMultiprocessorCount, dev);
        hipOccupancyMaxActiveBlocksPerMultiprocessor(&per_cu, fwd_megakernel, NT, 0);
        if (per_cu > 1) per_cu = 1;
        grid_blocks = cus * per_cu;
    }
    Params p{};
    const float* const* in = (const float* const*)d_in;
    p.x = in[0]; p.w_in = in[1]; p.conv_w = in[2]; p.a_log = in[3]; p.dt_bias = in[4]; p.norm_g = in[5]; p.w_pa = in[6];
    p.w_pb = in[7]; p.w_out = in[8]; p.ln1_g = in[9]; p.ln1_b = in[10]; p.w_router = in[11]; p.router_bias = in[12];
    p.w_su = in[13]; p.w_sd = in[14]; p.w_eu = in[15]; p.w_ed = in[16]; p.ln2_g = in[17]; p.ln2_b = in[18];
    p.out = (float*)d_out;
    char* w = (char*)d_ws;
    size_t off = 0;
    auto take = [&](size_t bytes) { char* r = w + off; off += (bytes + 255) & ~(size_t)255; return r; };
    p.U = nullptr;
    p.proj = nullptr;
    p.xb = (unsigned short*)take((size_t)T * D * 2);
    p.w_in_t = (unsigned short*)take((size_t)PWP * D * 2);
    p.projb = nullptr;
    p.qkvraw = (unsigned short*)take((size_t)T * 1536 * 2); p.dzb = (unsigned short*)take((size_t)T * 512 * 2);
    p.sq = (unsigned short*)take((size_t)T * 512 * 2); p.sk = (unsigned short*)take((size_t)T * 512 * 2); p.vT = (unsigned short*)take((size_t)T * 512 * 2);
    p.dnblob = (unsigned short*)take((size_t)1024 * DN_BLOB * 2); p.dnu = (float*)take((size_t)1024 * 64 * 128 * 4); p.dnlast = (float*)take(1024 * 4);
    p.gab = (unsigned short*)take((size_t)T * D * 2); p.gbb = (unsigned short*)take((size_t)T * D * 2); p.small = (float*)take((size_t)T * 8 * 4);
    p.w_pa_t = (unsigned short*)take((size_t)D * DNW * 2); p.w_pb_t = (unsigned short*)take((size_t)D * SBW * 2);
    p.w_out_t = (unsigned short*)take((size_t)D * D * 2); p.w_router_t = (unsigned short*)take((size_t)NE * D * 2);
    p.w_su_t = (unsigned short*)take((size_t)2 * SFF * D * 2); p.w_sd_t = (unsigned short*)take((size_t)D * SFF * 2);
    p.oab = (unsigned short*)take((size_t)T * DNW * 2); p.obb = (unsigned short*)take((size_t)T * SBW * 2);
    p.mergedb = (unsigned short*)take((size_t)T * D * 2); p.hb = (unsigned short*)take((size_t)T * D * 2);
    p.actsh = (unsigned short*)take((size_t)T * SFF * 2);
    p.actr = (unsigned short*)take((size_t)PROWS * EFF * 2); p.ypairb = (unsigned short*)take((size_t)NPAIR * D * 2);
    p.qa = (float*)take((size_t)T * DNW * 4); p.ka = (float*)take((size_t)T * DNW * 4); p.va = (float*)take((size_t)T * DNW * 4);
    p.gl = (float*)take((size_t)T * 4 * 4); p.bt = (float*)take((size_t)T * 4 * 4);
    p.oraw = (float*)take((size_t)T * DNW * 4); p.oa = nullptr; p.ob = nullptr;
    p.m1 = nullptr; p.m2 = nullptr;
    p.pre1 = (float*)take((size_t)T * D * 4); p.h = (float*)take((size_t)T * D * 4);
    p.scores = (float*)take((size_t)T * NE * 4); p.gate = (float*)take((size_t)NPAIR * 4);
    p.Ush = nullptr;
    p.ypair = nullptr; p.ysh = (float*)take((size_t)T * D * 4);
    p.idx = (int*)take((size_t)NPAIR * 4); p.counts = (int*)take(NE * 4); p.cursor = (int*)take(NE * 4);
    p.padpair = (int*)take((size_t)PROWS * 4);
    p.explist = (int*)take((size_t)NE * T * 4);
    p.bar = (unsigned*)take(XCD_BAR_WORDS * 4);
    if (off > ws_size) { fprintf(stderr, "workspace too small: need %zu have %zu\n", off, ws_size); return; }
    hipMemsetAsync(p.bar, 0, XCD_BAR_WORDS * 4, stream);
    void* args[] = {&p};
    hipError_t e = hipLaunchCooperativeKernel((void*)fwd_megakernel, dim3(grid_blocks), dim3(NT), args, 0, stream);
    if (e != hipSuccess) fprintf(stderr, "cooperative launch failed: %s (grid %d)\n", hipGetErrorString(e), grid_blocks);
}
```

```cpp
#include <hip/hip_runtime.h>
#include <hip/hip_cooperative_groups.h>
#include <cstdio>
#include <cstdint>
namespace cg = cooperative_groups;

constexpr int D = 1024, NB = 8, SEQ = 2048, T = NB * SEQ;
constexpr int DNH = 4, DND = 128, DNW = 512;
constexpr int SBH = 8, SBD = 64, SBW = 512;
constexpr int NE = 256, TOPK = 8, NG = 8, TOPG = 4, EFF = 256, SFF = 256;
constexpr int PW = 5640;
constexpr int NPAIR = T * TOPK;
constexpr int NBLK = (NPAIR + NE * 127 + 127) / 128;
constexpr int PROWS = NBLK * 128;
constexpr float ALPHA = 1.189207115002721f;
constexpr float LN_EPS = 1e-5f, NORM_EPS = 1e-6f;
constexpr int NT = 512;

typedef unsigned short bf16_t;
constexpr int PWP = 5888;
constexpr int DN_ROWS = 448, DN_BLOB = DN_ROWS * 64;
constexpr int ECAP = T;
#define XCD_BAR_WORDS 3456
constexpr size_t al256(size_t x) { return (x + 255) & ~(size_t)255; }
constexpr size_t OFF_XB = 0;
constexpr size_t OFF_WINT = OFF_XB + al256((size_t)T * D * 2);
constexpr size_t OFF_QKVRAW = OFF_WINT + al256((size_t)PWP * D * 2);
constexpr size_t OFF_DZB = OFF_QKVRAW + al256((size_t)T * 1536 * 2);
constexpr size_t OFF_SQ = OFF_DZB + al256((size_t)T * 512 * 2);
constexpr size_t OFF_SK = OFF_SQ + al256((size_t)T * 512 * 2);
constexpr size_t OFF_VT = OFF_SK + al256((size_t)T * 512 * 2);
constexpr size_t OFF_DNBLOB = OFF_VT + al256((size_t)T * 512 * 2);
constexpr size_t OFF_DNU = OFF_DNBLOB + al256((size_t)1024 * DN_BLOB * 2);
constexpr size_t OFF_DNLAST = OFF_DNU + al256((size_t)1024 * 64 * 128 * 4);
constexpr size_t OFF_GAB = OFF_DNLAST + al256(1024 * 4);
constexpr size_t OFF_GBB = OFF_GAB + al256((size_t)T * D * 2);
constexpr size_t OFF_SMALL = OFF_GBB + al256((size_t)T * D * 2);
constexpr size_t OFF_WPAT = OFF_SMALL + al256((size_t)T * 8 * 4);
constexpr size_t OFF_WPBT = OFF_WPAT + al256((size_t)D * DNW * 2);
constexpr size_t OFF_WOUTT = OFF_WPBT + al256((size_t)D * SBW * 2);
constexpr size_t OFF_WROUTT = OFF_WOUTT + al256((size_t)D * D * 2);
constexpr size_t OFF_WSUT = OFF_WROUTT + al256((size_t)NE * D * 2);
constexpr size_t OFF_WSDT = OFF_WSUT + al256((size_t)2 * SFF * D * 2);
constexpr size_t OFF_OAB = OFF_WSDT + al256((size_t)D * SFF * 2);
constexpr size_t OFF_OBB = OFF_OAB + al256((size_t)T * DNW * 2);
constexpr size_t OFF_MERGED = OFF_OBB + al256((size_t)T * SBW * 2);
constexpr size_t OFF_HB = OFF_MERGED + al256((size_t)T * D * 2);
constexpr size_t OFF_ACTSH = OFF_HB + al256((size_t)T * D * 2);
constexpr size_t OFF_YPAIRB = OFF_ACTSH + al256((size_t)T * SFF * 2);
constexpr size_t OFF_ORAW = OFF_YPAIRB + al256((size_t)NPAIR * D * 2);
constexpr size_t OFF_PRE1 = OFF_ORAW + al256((size_t)T * DNW * 4);
constexpr size_t OFF_H = OFF_PRE1 + al256((size_t)T * D * 4);
constexpr size_t OFF_SCORES = OFF_H + al256((size_t)T * D * 4);
constexpr size_t OFF_GATE = OFF_SCORES + al256((size_t)T * NE * 4);
constexpr size_t OFF_YSH = OFF_GATE + al256((size_t)NPAIR * 4);
constexpr size_t OFF_IDX = OFF_YSH + al256((size_t)T * D * 4);
constexpr size_t OFF_COUNTS = OFF_IDX + al256((size_t)NPAIR * 4);
constexpr size_t OFF_EXPLIST = OFF_COUNTS + al256(NE * 4);
constexpr size_t OFF_BAR = OFF_EXPLIST + al256((size_t)NE * ECAP * 4);
constexpr size_t WS_BYTES = OFF_BAR + al256(XCD_BAR_WORDS * 4);

struct KArgs {
    const float *x, *w_in, *conv_w, *a_log, *dt_bias, *norm_g, *w_pa, *w_pb, *w_out, *ln1_g, *ln1_b, *w_router,
        *router_bias, *w_su, *w_sd, *w_eu, *w_ed, *ln2_g, *ln2_b;
    float* out; unsigned char* ws;
};
struct Params {
    const float *x, *w_in, *conv_w, *a_log, *dt_bias, *norm_g, *w_pa, *w_pb, *w_out, *ln1_g, *ln1_b, *w_router,
        *router_bias, *w_su, *w_sd, *w_eu, *w_ed, *ln2_g, *ln2_b;
    float* out;
    float *oraw, *pre1, *h, *scores, *gate, *ysh, *small, *dnu, *dnlast;
    int *idx, *counts, *explist;
    bf16_t *xb, *w_in_t, *w_pa_t, *w_pb_t, *w_out_t, *w_router_t, *w_su_t, *w_sd_t, *oab, *obb, *mergedb, *hb, *actsh, *ypairb;
    bf16_t *qkvraw, *dzb, *sq, *sk, *vT, *gab, *gbb, *dnblob;
    unsigned* bar;
    __device__ __forceinline__ explicit Params(const KArgs& k) {
        x = k.x; w_in = k.w_in; conv_w = k.conv_w; a_log = k.a_log; dt_bias = k.dt_bias; norm_g = k.norm_g; w_pa = k.w_pa; w_pb = k.w_pb;
        w_out = k.w_out; ln1_g = k.ln1_g; ln1_b = k.ln1_b; w_router = k.w_router; router_bias = k.router_bias; w_su = k.w_su; w_sd = k.w_sd;
        w_eu = k.w_eu; w_ed = k.w_ed; ln2_g = k.ln2_g; ln2_b = k.ln2_b; out = k.out;
        unsigned char* w = k.ws;
        xb = (bf16_t*)(w + OFF_XB); w_in_t = (bf16_t*)(w + OFF_WINT); qkvraw = (bf16_t*)(w + OFF_QKVRAW); dzb = (bf16_t*)(w + OFF_DZB);
        sq = (bf16_t*)(w + OFF_SQ); sk = (bf16_t*)(w + OFF_SK); vT = (bf16_t*)(w + OFF_VT); dnblob = (bf16_t*)(w + OFF_DNBLOB);
        dnu = (float*)(w + OFF_DNU); dnlast = (float*)(w + OFF_DNLAST); gab = (bf16_t*)(w + OFF_GAB); gbb = (bf16_t*)(w + OFF_GBB);
        small = (float*)(w + OFF_SMALL); w_pa_t = (bf16_t*)(w + OFF_WPAT); w_pb_t = (bf16_t*)(w + OFF_WPBT); w_out_t = (bf16_t*)(w + OFF_WOUTT);
        w_router_t = (bf16_t*)(w + OFF_WROUTT); w_su_t = (bf16_t*)(w + OFF_WSUT); w_sd_t = (bf16_t*)(w + OFF_WSDT);
        oab = (bf16_t*)(w + OFF_OAB); obb = (bf16_t*)(w + OFF_OBB); mergedb = (bf16_t*)(w + OFF_MERGED); hb = (bf16_t*)(w + OFF_HB);
        actsh = (bf16_t*)(w + OFF_ACTSH); ypairb = (bf16_t*)(w + OFF_YPAIRB); oraw = (float*)(w + OFF_ORAW); pre1 = (float*)(w + OFF_PRE1);
        h = (float*)(w + OFF_H); scores = (float*)(w + OFF_SCORES); gate = (float*)(w + OFF_GATE); ysh = (float*)(w + OFF_YSH);
        idx = (int*)(w + OFF_IDX); counts = (int*)(w + OFF_COUNTS); explist = (int*)(w + OFF_EXPLIST); bar = (unsigned*)(w + OFF_BAR);
    }
};

__device__ __forceinline__ float sigmoidf_(float v) { return 1.f / (1.f + expf(-v)); }
__device__ __forceinline__ float siluf_(float v) { return v / (1.f + expf(-v)); }
__device__ __forceinline__ float wave_sum(float v) {
#pragma unroll
    for (int o = 32; o > 0; o >>= 1) v += __shfl_xor(v, o);
    return v;
}


#define XB_TMO      128
#define XB_XCNT(j)  (256  + 64 * (j))
#define XB_XSUB(j)  (1280 + 64 * (j))
#define XB_XGEN(j)  (2304 + 64 * (j))
#define XB_TOP      3328
#define XB_TOPGEN   3392
#define XB_SPIN_CAP (1u << 24)
#define LAS3 __attribute__((address_space(3)))
__device__ __forceinline__ unsigned xb_ld(unsigned* p)              { return __hip_atomic_load(p, __ATOMIC_RELAXED, __HIP_MEMORY_SCOPE_AGENT); }
__device__ __forceinline__ unsigned xb_add(unsigned* p, unsigned v) { return __hip_atomic_fetch_add(p, v, __ATOMIC_RELAXED, __HIP_MEMORY_SCOPE_AGENT); }
__device__ __forceinline__ unsigned xb_xcc_id() { return (unsigned)__builtin_amdgcn_s_getreg((3 << 11) | 20) & 0xFu; }
#define XB_SPIN(cond, bar) do { unsigned _sp = 0; while (cond) { __builtin_amdgcn_s_sleep(1); \
    if ((++_sp & 255u) == 0u) { if (xb_ld(&(bar)[XB_TMO])) break; if (_sp > XB_SPIN_CAP) { atomicAdd(&(bar)[XB_TMO], 1u); break; } } } } while (0)
struct XcdBarrier { unsigned* bar; unsigned x; volatile LAS3 unsigned* st; };
__device__ __forceinline__ XcdBarrier xcd_barrier_post(unsigned* bar, volatile LAS3 unsigned* st) {
    XcdBarrier b; b.bar = bar; b.x = xb_xcc_id(); b.st = st;
    if (threadIdx.x == 0) (void)xb_add(&bar[XB_XCNT(b.x)], 1u);
    return b;
}
__device__ __forceinline__ void xcd_barrier_complete(unsigned* bar, unsigned x, unsigned& nloc, unsigned& nx) {
    const unsigned G = gridDim.x * gridDim.y * gridDim.z;
    unsigned sum, cnt, mine, sp = 0u;
    asm volatile("" : "+s"(x));
    for (;;) {
        sum = 0u; cnt = 0u; mine = 0u;
#pragma unroll 1
        for (unsigned j = 0; j < 16; ++j) { const unsigned c = xb_ld(&bar[XB_XCNT(j)]); sum += c; cnt += (c > 0u) ? 1u : 0u; mine = (j == x) ? c : mine; }
        if (sum == G) break;
        __builtin_amdgcn_s_sleep(1);
        if ((++sp & 255u) == 0u) { if (xb_ld(&bar[XB_TMO])) break; if (sp > XB_SPIN_CAP) { atomicAdd(&bar[XB_TMO], 1u); break; } }
    }
    nloc = mine > 0u ? mine : 1u; nx = cnt > 0u ? cnt : 1u;
}
__device__ __forceinline__ void xcd_barrier(const XcdBarrier& b) {
    asm volatile("s_waitcnt vmcnt(0)" ::: "memory");
    __syncthreads();
    if (threadIdx.x == 0) {
        unsigned* bar = b.bar;
        __builtin_amdgcn_s_waitcnt(0);
        unsigned nloc = b.st[0], nx = b.st[1];
        if (nloc == 0u) { xcd_barrier_complete(bar, b.x, nloc, nx); b.st[0] = nloc; b.st[1] = nx; }
        const unsigned old = xb_add(&bar[XB_XSUB(b.x)], 1u);
        const unsigned gen = old / nloc;
        if (old + 1u == (gen + 1u) * nloc) {
            __builtin_amdgcn_fence(__ATOMIC_RELEASE, "agent");
            asm volatile("s_waitcnt vmcnt(0)" ::: "memory");
            const unsigned og = xb_add(&bar[XB_TOP], 1u);
            const unsigned tg = og / nx;
            if (og + 1u == (tg + 1u) * nx) xb_add(&bar[XB_TOPGEN], 1u);
            else XB_SPIN(xb_ld(&bar[XB_TOPGEN]) == tg, bar);
            __builtin_amdgcn_fence(__ATOMIC_ACQUIRE, "agent");
            xb_add(&bar[XB_XGEN(b.x)], 1u);
            asm volatile("s_waitcnt vmcnt(0)" ::: "memory");
        } else {
            XB_SPIN(xb_ld(&bar[XB_XGEN(b.x)]) == gen, bar);
            __builtin_amdgcn_fence(__ATOMIC_ACQUIRE, "agent");
            asm volatile("s_waitcnt vmcnt(0)" ::: "memory");
        }
    }
    __syncthreads();
}

typedef short bf16x8 __attribute__((ext_vector_type(8)));
typedef float f32x16 __attribute__((ext_vector_type(16)));
typedef float f32x4 __attribute__((ext_vector_type(4)));
__device__ __forceinline__ unsigned pk_bf16(float a, float b) {
    typedef __bf16 bf2 __attribute__((ext_vector_type(2)));
    typedef float f2 __attribute__((ext_vector_type(2)));
    f2 v = {a, b};
    bf2 r = __builtin_convertvector(v, bf2);
    return __builtin_bit_cast(unsigned, r);
}
__device__ __forceinline__ bf16_t to_bf16(float a) { return (bf16_t)(pk_bf16(a, 0.f) & 0xffffu); }
__device__ __forceinline__ float bf2f(bf16_t v) { return __uint_as_float((unsigned)v << 16); }

__device__ __forceinline__ int opaque_tid() { int t = threadIdx.x; asm volatile("" : "+v"(t)); return t; }
constexpr int LROW = 128;
__device__ __forceinline__ int swz(int r) { return ((r >> 2) & 7) ^ ((r >> 1) & 1); }

template <int ROWS, bool MAYBE_NULL = false> struct LoadRowsBf16 {
    static constexpr int NCH = ROWS * 8 / NT;
    const bf16_t* base; int tid;
    unsigned off[NCH];
    uint4 regs[NCH];
    template <class RF> __device__ __forceinline__ void init(const bf16_t* base_, int ld, RF rowfn) {
        base = base_; tid = opaque_tid();
#pragma unroll
        for (int i = 0; i < NCH; ++i) {
            const int c = tid + i * NT, r = c >> 3, ch = c & 7;
            const long long src = rowfn(r);
            off[i] = (!MAYBE_NULL || src >= 0) ? (unsigned)(src * ld + ch * 8) : 0xffffffffu;
        }
    }
    __device__ __forceinline__ void load(int k0) {
#pragma unroll
        for (int i = 0; i < NCH; ++i)
            regs[i] = (!MAYBE_NULL || off[i] != 0xffffffffu) ? *(const uint4*)(base + (size_t)off[i] + k0) : make_uint4(0, 0, 0, 0);
    }
    __device__ __forceinline__ void store(unsigned char* lds) const {
#pragma unroll
        for (int i = 0; i < NCH; ++i) {
            const int c = tid + i * NT, r = c >> 3, ch = c & 7;
            *(uint4*)(lds + r * LROW + ((ch ^ swz(r)) << 4)) = regs[i];
        }
    }
};

struct LoadKNF32 {
    const float* base; int ld, kq, nq;
    f32x4 regs[8];
    template <class CF> __device__ __forceinline__ void init(const float* w, int ld_, CF colfn) {
        const int tid = opaque_tid(); kq = tid >> 6; nq = tid & 63; ld = ld_;
        base = w + (size_t)(kq * 8) * ld_ + colfn(nq * 4);
    }
    __device__ __forceinline__ void load(int k0) {
#pragma unroll
        for (int j = 0; j < 8; ++j) regs[j] = *(const f32x4*)(base + (size_t)(k0 + j) * ld);
    }
    __device__ __forceinline__ void store1(unsigned char* lds, int nn, float a0, float a1, float a2, float a3, float a4, float a5, float a6, float a7) const {
        uint4 o; o.x = pk_bf16(a0, a1); o.y = pk_bf16(a2, a3); o.z = pk_bf16(a4, a5); o.w = pk_bf16(a6, a7);
        const int row = nq * 4 + nn;
        *(uint4*)(lds + row * LROW + ((kq ^ swz(row)) << 4)) = o;
    }
    __device__ __forceinline__ void store(unsigned char* lds) const {
        store1(lds, 0, regs[0].x, regs[1].x, regs[2].x, regs[3].x, regs[4].x, regs[5].x, regs[6].x, regs[7].x);
        store1(lds, 1, regs[0].y, regs[1].y, regs[2].y, regs[3].y, regs[4].y, regs[5].y, regs[6].y, regs[7].y);
        store1(lds, 2, regs[0].z, regs[1].z, regs[2].z, regs[3].z, regs[4].z, regs[5].z, regs[6].z, regs[7].z);
        store1(lds, 3, regs[0].w, regs[1].w, regs[2].w, regs[3].w, regs[4].w, regs[5].w, regs[6].w, regs[7].w);
    }
};

template <int BM_, int BN_, int WM_, int WN_> struct GemmCfg {
    static constexpr int BM = BM_, BN = BN_, WM = WM_, WN = WN_;
    static constexpr int TM = BM / WM, TN = BN / WN, MI = TM / 32, NI = TN / 32;
    static constexpr int A_BYTES = BM * LROW, B_BYTES = BN * LROW, STAGE = A_BYTES + B_BYTES;
    static_assert(WM * WN == 8, "8 waves");
};

template <class CFG, class AL, class BL>
__device__ __forceinline__ void gemm_mainloop(AL& al, BL& bl, int nk, f32x16 (&acc)[CFG::MI][CFG::NI], unsigned char* lds) {
    constexpr int MI = CFG::MI, NI = CFG::NI;
    const int tid = opaque_tid(), lane = tid & 63, wid = tid >> 6;
    const int wm = wid / CFG::WN, wn = wid % CFG::WN;
    const int l31 = lane & 31, lh = lane >> 5;
    al.load(0); bl.load(0);
    const int a_off = (wm * CFG::TM + l31) * LROW;
    const int b_off = CFG::A_BYTES + (wn * CFG::TN + l31) * LROW;
    const int fsw = swz(l31);
    for (int kt = 0; kt < nk; ++kt) {
        unsigned char* st = lds + (kt & 1) * CFG::STAGE;
        al.store(st); bl.store(st + CFG::A_BYTES);
        __syncthreads();
        if (kt + 1 < nk) { al.load((kt + 1) * 64); bl.load((kt + 1) * 64); }
#pragma unroll
        for (int kk = 0; kk < 4; ++kk) {
            bf16x8 a[MI], b[NI];
#pragma unroll
            for (int mi = 0; mi < MI; ++mi) a[mi] = *(const bf16x8*)(st + a_off + mi * 32 * LROW + (((kk * 2 + lh) ^ fsw) << 4));
#pragma unroll
            for (int ni = 0; ni < NI; ++ni) b[ni] = *(const bf16x8*)(st + b_off + ni * 32 * LROW + (((kk * 2 + lh) ^ fsw) << 4));
#pragma unroll
            for (int mi = 0; mi < MI; ++mi)
#pragma unroll
                for (int ni = 0; ni < NI; ++ni)
                    acc[mi][ni] = __builtin_amdgcn_mfma_f32_32x32x16_bf16(a[mi], b[ni], acc[mi][ni], 0, 0, 0);
        }
    }
    __syncthreads();
}
template <class CFG, bool A_RES, int ARES_ROT, class AL, class BL>
__device__ __forceinline__ void gemm_mainloop2(AL (&al)[2], BL (&bl)[2], int nk, f32x16 (&acc)[CFG::MI][CFG::NI], unsigned char* stages, const unsigned char* ares) {
    constexpr int MI = CFG::MI, NI = CFG::NI;
    constexpr int STG = A_RES ? CFG::B_BYTES : CFG::STAGE, BOFF = A_RES ? 0 : CFG::A_BYTES;
    const int tid = opaque_tid(), lane = tid & 63, wid = tid >> 6;
    const int wm = wid / CFG::WN, wn = wid % CFG::WN;
    const int l31 = lane & 31, lh = lane >> 5;
    if (!A_RES) { al[0].load(0); } bl[0].load(0);
    if (!A_RES) { al[1].load(64); } bl[1].load(64);
    const int a_off = (wm * CFG::TM + l31) * LROW;
    const int b_off = BOFF + (wn * CFG::TN + l31) * LROW;
    const int fsw = swz(l31);
    for (int kt = 0; kt < nk; kt += 2) {
#pragma unroll
        for (int u = 0; u < 2; ++u) {
            unsigned char* st = stages + u * STG;
            if (!A_RES) al[u].store(st);
            bl[u].store(st + BOFF);
            __syncthreads();
            if (kt + u + 2 < nk) { if (!A_RES) al[u].load((kt + u + 2) * 64); bl[u].load((kt + u + 2) * 64); }
            const unsigned char* ab = A_RES ? ares + (size_t)((kt + u + ARES_ROT) & 3) * (CFG::BM * LROW) : st;
#pragma unroll
            for (int kk = 0; kk < 4; ++kk) {
                bf16x8 a[MI], b[NI];
#pragma unroll
                for (int mi = 0; mi < MI; ++mi) a[mi] = *(const bf16x8*)(ab + a_off + mi * 32 * LROW + (((kk * 2 + lh) ^ fsw) << 4));
#pragma unroll
                for (int ni = 0; ni < NI; ++ni) b[ni] = *(const bf16x8*)(st + b_off + ni * 32 * LROW + (((kk * 2 + lh) ^ fsw) << 4));
#pragma unroll
                for (int mi = 0; mi < MI; ++mi)
#pragma unroll
                    for (int ni = 0; ni < NI; ++ni)
                        acc[mi][ni] = __builtin_amdgcn_mfma_f32_32x32x16_bf16(a[mi], b[ni], acc[mi][ni], 0, 0, 0);
            }
        }
    }
    __syncthreads();
}
template <class CFG> __device__ __forceinline__ void acc_zero(f32x16 (&acc)[CFG::MI][CFG::NI]) {
#pragma unroll
    for (int mi = 0; mi < CFG::MI; ++mi)
#pragma unroll
        for (int ni = 0; ni < CFG::NI; ++ni)
#pragma unroll
            for (int r = 0; r < 16; ++r) acc[mi][ni][r] = 0.f;
}
template <class CFG, class F> __device__ __forceinline__ void acc_foreach(f32x16 (&acc)[CFG::MI][CFG::NI], F f) {
    const int tid = opaque_tid(), lane = tid & 63, wid = tid >> 6;
    const int wm = wid / CFG::WN, wn = wid % CFG::WN;
#pragma unroll
    for (int mi = 0; mi < CFG::MI; ++mi)
#pragma unroll
        for (int ni = 0; ni < CFG::NI; ++ni) {
            asm volatile("" ::: "memory");
#pragma unroll
            for (int r = 0; r < 16; ++r)
                acc[mi][ni][r] = f(wm * CFG::TM + mi * 32 + (r & 3) + 8 * (r >> 2) + 4 * (lane >> 5), wn * CFG::TN + ni * 32 + (lane & 31), acc[mi][ni][r], mi, ni, r);
        }
}

struct TileMap {
    int ntm, ntn, npm, npn, rounds; bool patched;
    int pm, pn;
    __device__ __forceinline__ void init(int ntm_, int ntn_) {
        ntm = ntm_; ntn = ntn_; patched = (gridDim.x == 256);
        pn = ntn >= 8 ? 8 : ntn >= 4 ? 4 : ntn >= 2 ? 2 : 1; pm = 32 / pn;
        if (patched) { npm = (ntm + pm - 1) / pm; npn = (ntn + pn - 1) / pn; rounds = (npm * npn + 7) / 8; }
        else { int G = gridDim.x; asm volatile("" : "+s"(G)); npm = npn = 0; rounds = (ntm * ntn + G - 1) / G; }
    }
    __device__ __forceinline__ bool get(int round, int& tm, int& tn) const {
        const int b = blockIdx.x;
        if (patched) {
            const int patch = round * 8 + (b & 7), slot = b >> 3;
            if (patch >= npm * npn) return false;
            tm = (patch / npn) * pm + slot / pn; tn = (patch % npn) * pn + slot % pn;
            return tm < ntm && tn < ntn;
        }
        const int t = round * gridDim.x + b;
        if (t >= ntm * ntn) return false;
        tm = t / ntn; tn = t % ntn; return true;
    }
};

template <class CM>
__device__ __forceinline__ void transpose_convert(const float* W, int K, int N, int NP, bf16_t* Wt, float* sm, CM cmap) {
    const int tid = opaque_tid(), ntk = K / 64, ntn = NP / 64;
    for (int tile = blockIdx.x; tile < ntk * ntn; tile += gridDim.x) {
        const int tk = tile % ntk, tn = tile / ntk;
#pragma unroll
        for (int i = 0; i < 8; ++i) {
            const int e = tid + i * NT, kk = e >> 6, nn = e & 63, col = cmap(tn * 64 + nn);
            sm[nn * 65 + kk] = col >= 0 ? W[(size_t)(tk * 64 + kk) * N + col] : 0.f;
        }
        __syncthreads();
        const int n = tid >> 3, kc = tid & 7;
        const float* r = sm + n * 65 + kc * 8;
        uint4 o; o.x = pk_bf16(r[0], r[1]); o.y = pk_bf16(r[2], r[3]); o.z = pk_bf16(r[4], r[5]); o.w = pk_bf16(r[6], r[7]);
        *(uint4*)(Wt + (size_t)(tn * 64 + n) * K + tk * 64 + kc * 8) = o;
        __syncthreads();
    }
}
__device__ __forceinline__ void convert_bf16(const float* src, bf16_t* dst, size_t n) {
    const size_t gtid = (size_t)blockIdx.x * NT + opaque_tid(), gsz = (size_t)gridDim.x * NT;
    for (size_t i = gtid; i < n / 8; i += gsz) {
        const float4 a = ((const float4*)src)[2 * i], b = ((const float4*)src)[2 * i + 1];
        uint4 o; o.x = pk_bf16(a.x, a.y); o.y = pk_bf16(a.z, a.w); o.z = pk_bf16(b.x, b.y); o.w = pk_bf16(b.z, b.w);
        ((uint4*)dst)[i] = o;
    }
}

__device__ __forceinline__ void phase_inproj(const Params& p, unsigned char* lds) {
    typedef GemmCfg<256, 256, 2, 4> CFG;
    TileMap tmap; tmap.init(T / 256, PWP / 256);
    for (int round = 0; round < tmap.rounds; ++round) {
        int tm, tn;
        if (!tmap.get(round, tm, tn)) continue;
        LoadRowsBf16<256> al, bl;
        al.init(p.xb, D, [&](int r) { return (long long)(tm * 256 + r); });
        bl.init(p.w_in_t, D, [&](int r) { return (long long)(tn * 256 + r); });
        f32x16 acc[CFG::MI][CFG::NI];
        acc_zero<CFG>(acc);
        gemm_mainloop<CFG>(al, bl, D / 64, acc, lds);
        asm volatile("" : "+s"(tm), "+s"(tn));
        if (tn == 12 || tn == 13) {
            const int tid = opaque_tid(), lane = tid & 63, wid = tid >> 6, wm = wid / CFG::WN, wn = wid % CFG::WN, l31 = lane & 31, lh = lane >> 5;
#pragma unroll
            for (int mi = 0; mi < CFG::MI; ++mi)
#pragma unroll
                for (int ni = 0; ni < CFG::NI; ++ni) {
                    const int svcol = (tn - 12) * 256 + wn * CFG::TN + ni * 32 + l31, hh = svcol >> 6, d = svcol & 63;
                    const int tok0 = tm * 256 + wm * CFG::TM + mi * 32, bb = tok0 >> 11, key0 = tok0 & (SEQ - 1);
                    bf16_t* dst = p.vT + ((size_t)((bb * 8 + hh) * 64 + d)) * SEQ + key0;
#pragma unroll
                    for (int g = 0; g < 4; ++g) {
                        uint2 o; o.x = pk_bf16(acc[mi][ni][4 * g], acc[mi][ni][4 * g + 1]); o.y = pk_bf16(acc[mi][ni][4 * g + 2], acc[mi][ni][4 * g + 3]);
                        *(uint2*)(dst + 16 * (g >> 1) + 8 * lh + 4 * (g & 1)) = o;
                    }
                }
        } else if (tn == 22) {
            acc_foreach<CFG>(acc, [&](int r, int c, float v, int, int, int) {
                if (c < 8) p.small[(size_t)(tm * 256 + r) * 8 + c] = v;
                return v;
            });
        } else {
            bf16_t* dst; int ld, c0; float sc = 1.f;
            if (tn < 6) { dst = p.qkvraw; ld = 1536; c0 = tn * 256; }
            else if (tn < 8) { dst = p.dzb; ld = 512; c0 = (tn - 6) * 256; }
            else if (tn < 10) { dst = p.sq; ld = 512; c0 = (tn - 8) * 256; sc = 0.125f * 1.4426950408889634f; }
            else if (tn < 12) { dst = p.sk; ld = 512; c0 = (tn - 10) * 256; }
            else if (tn < 18) { dst = p.gab; ld = 1024; c0 = (tn - 14) * 256; }
            else { dst = p.gbb; ld = 1024; c0 = (tn - 18) * 256; }
            acc_foreach<CFG>(acc, [&](int r, int c, float v, int, int, int) {
                dst[(size_t)(tm * 256 + r) * ld + c0 + c] = to_bf16(v * sc);
                return v;
            });
        }
    }
}

__device__ __forceinline__ void phase_merge(const Params& p, unsigned char* lds) {
    typedef GemmCfg<128, 256, 2, 4> CFG;
    TileMap tmap; tmap.init(T / 128, D / 256);
    for (int round = 0; round < tmap.rounds; ++round) {
        int tm, tn;
        if (!tmap.get(round, tm, tn)) continue;
        f32x16 acc[CFG::MI][CFG::NI];
        {
            LoadRowsBf16<128> al; LoadRowsBf16<256> bl;
            al.init(p.oab, DNW, [&](int r) { return (long long)(tm * 128 + r); });
            bl.init(p.w_pa_t, DNW, [&](int r) { return (long long)(tn * 256 + r); });
            acc_zero<CFG>(acc);
            gemm_mainloop<CFG>(al, bl, DNW / 64, acc, lds);
            asm volatile("" : "+s"(tm), "+s"(tn));
        }
        acc_foreach<CFG>(acc, [&](int r, int c, float v, int, int, int) {
            const size_t gi = (size_t)(tm * 128 + r) * D + tn * 256 + c;
            const float ga = sigmoidf_(bf2f(p.gab[gi])), gb = fmaxf(sigmoidf_(bf2f(p.gbb[gi])), 1e-30f);
            return v * (ga / gb);
        });
        {
            LoadRowsBf16<128> al; LoadRowsBf16<256> bl;
            al.init(p.obb, SBW, [&](int r) { return (long long)(tm * 128 + r); });
            bl.init(p.w_pb_t, SBW, [&](int r) { return (long long)(tn * 256 + r); });
            gemm_mainloop<CFG>(al, bl, SBW / 64, acc, lds);
            asm volatile("" : "+s"(tm), "+s"(tn));
        }
        acc_foreach<CFG>(acc, [&](int r, int c, float v, int, int, int) {
            const int row = tm * 128 + r, col = tn * 256 + c;
            const float gb = fmaxf(sigmoidf_(bf2f(p.gbb[(size_t)row * D + col])), 1e-30f);
            p.mergedb[(size_t)row * D + col] = to_bf16(v * gb);
            return v;
        });
    }
}

__device__ __forceinline__ void phase_outproj(const Params& p, unsigned char* lds) {
    typedef GemmCfg<256, 256, 2, 4> CFG;
    TileMap tmap; tmap.init(T / 256, D / 256);
    for (int round = 0; round < tmap.rounds; ++round) {
        int tm, tn;
        if (!tmap.get(round, tm, tn)) continue;
        LoadRowsBf16<256> al, bl;
        al.init(p.mergedb, D, [&](int r) { return (long long)(tm * 256 + r); });
        bl.init(p.w_out_t, D, [&](int r) { return (long long)(tn * 256 + r); });
        f32x16 acc[CFG::MI][CFG::NI];
        acc_zero<CFG>(acc);
        gemm_mainloop<CFG>(al, bl, D / 64, acc, lds);
        asm volatile("" : "+s"(tm), "+s"(tn));
        acc_foreach<CFG>(acc, [&](int r, int c, float v, int, int, int) {
            const size_t o = (size_t)(tm * 256 + r) * D + tn * 256 + c;
            p.pre1[o] = v + ALPHA * p.x[o];
            return v;
        });
    }
}

__device__ __forceinline__ void phase_router_shared_up(const Params& p, unsigned char* lds) {
    {
        typedef GemmCfg<128, 128, 4, 2> CFG;
        TileMap tmap; tmap.init(T / 128, NE / 128);
        for (int round = 0; round < tmap.rounds; ++round) {
            int tm, tn;
            if (!tmap.get(round, tm, tn)) continue;
            LoadRowsBf16<128> al, bl;
            al.init(p.hb, D, [&](int r) { return (long long)(tm * 128 + r); });
            bl.init(p.w_router_t, D, [&](int r) { return (long long)(tn * 128 + r); });
            f32x16 acc[CFG::MI][CFG::NI];
            acc_zero<CFG>(acc);
            gemm_mainloop<CFG>(al, bl, D / 64, acc, lds);
            asm volatile("" : "+s"(tm), "+s"(tn));
            acc_foreach<CFG>(acc, [&](int r, int c, float v, int, int, int) {
                p.scores[(size_t)(tm * 128 + r) * NE + tn * 128 + c] = sigmoidf_(v);
                return v;
            });
        }
    }
    {
        typedef GemmCfg<128, 256, 2, 4> CFG;
        TileMap tmap; tmap.init(T / 128, SFF / 128);
        for (int round = 0; round < tmap.rounds; ++round) {
            int tm, tn;
            if (!tmap.get(round, tm, tn)) continue;
            LoadRowsBf16<128> al; LoadRowsBf16<256> bl;
            al.init(p.hb, D, [&](int r) { return (long long)(tm * 128 + r); });
            bl.init(p.w_su_t, D, [&](int r) { return (long long)(((r >> 5) & 1) * SFF + tn * 128 + (r >> 6) * 32 + (r & 31)); });
            f32x16 acc[CFG::MI][CFG::NI];
            acc_zero<CFG>(acc);
            gemm_mainloop<CFG>(al, bl, D / 64, acc, lds);
            asm volatile("" : "+s"(tm), "+s"(tn));
            const int tid = opaque_tid(), lane = tid & 63, wid = tid >> 6, wm = wid / CFG::WN, wn = wid % CFG::WN;
#pragma unroll
            for (int mi = 0; mi < CFG::MI; ++mi)
#pragma unroll
                for (int r = 0; r < 16; ++r) {
                    const int row = tm * 128 + wm * CFG::TM + mi * 32 + (r & 3) + 8 * (r >> 2) + 4 * (lane >> 5);
                    const int j = tn * 128 + wn * 32 + (lane & 31);
                    const float g = acc[mi][0][r], u = acc[mi][1][r];
                    p.actsh[(size_t)row * SFF + j] = to_bf16(siluf_(g) * u);
                }
        }
    }
}

__device__ __forceinline__ void phase_shared_down(const Params& p, unsigned char* lds) {
    typedef GemmCfg<256, 256, 2, 4> CFG;
    TileMap tmap; tmap.init(T / 256, D / 256);
    for (int round = 0; round < tmap.rounds; ++round) {
        int tm, tn;
        if (!tmap.get(round, tm, tn)) continue;
        LoadRowsBf16<256> al, bl;
        al.init(p.actsh, SFF, [&](int r) { return (long long)(tm * 256 + r); });
        bl.init(p.w_sd_t, SFF, [&](int r) { return (long long)(tn * 256 + r); });
        f32x16 acc[CFG::MI][CFG::NI];
        acc_zero<CFG>(acc);
        gemm_mainloop<CFG>(al, bl, SFF / 64, acc, lds);
        asm volatile("" : "+s"(tm), "+s"(tn));
        acc_foreach<CFG>(acc, [&](int r, int c, float v, int, int, int) {
            p.ysh[(size_t)(tm * 256 + r) * D + tn * 256 + c] = v;
            return v;
        });
    }
}

__device__ __forceinline__ void phase_init(const Params& p) {
    const int gtid = blockIdx.x * NT + opaque_tid(), gsz = gridDim.x * NT;
    for (int i = gtid; i < NE; i += gsz) p.counts[i] = 0;
}

__device__ __forceinline__ void sb_attn_wave(const Params& p, int bh, int qt) {
    const int lane = opaque_tid() & 63, l31 = lane & 31, lh = lane >> 5;
    const int b = bh >> 3, hh = bh & 7;
    bf16x8 qf[4];
    {
        const bf16_t* qrow = p.sq + (size_t)(b * SEQ + qt * 32 + l31) * SBW + hh * 64 + lh * 8;
#pragma unroll
        for (int ks = 0; ks < 4; ++ks) qf[ks] = *(const bf16x8*)(qrow + ks * 16);
    }
    f32x16 o0, o1;
#pragma unroll
    for (int r = 0; r < 16; ++r) { o0[r] = 0.f; o1[r] = 0.f; }
    float run = 0.f;
    const bf16_t* vbase = p.vT + ((size_t)(bh * 64 + l31)) * SEQ + lh * 8;
    for (int kt = qt; kt >= 0; --kt) {
        const bf16_t* krow = p.sk + (size_t)(b * SEQ + kt * 32 + l31) * SBW + hh * 64 + lh * 8;
        bf16x8 kf[4];
#pragma unroll
        for (int ks = 0; ks < 4; ++ks) kf[ks] = *(const bf16x8*)(krow + ks * 16);
        bf16x8 vf[2][2];
#pragma unroll
        for (int md = 0; md < 2; ++md)
#pragma unroll
            for (int ss = 0; ss < 2; ++ss) vf[md][ss] = *(const bf16x8*)(vbase + (size_t)md * 32 * SEQ + kt * 32 + ss * 16);
        f32x16 sc;
#pragma unroll
        for (int r = 0; r < 16; ++r) sc[r] = 0.f;
#pragma unroll
        for (int ks = 0; ks < 4; ++ks) sc = __builtin_amdgcn_mfma_f32_32x32x16_bf16(kf[ks], qf[ks], sc, 0, 0, 0);
        float lb[16], lr[16];
        const bool diag = (kt == qt);
#pragma unroll
        for (int r = 0; r < 16; ++r) {
            const float z = sc[r];
            const float l = __builtin_amdgcn_logf(1.f + __builtin_amdgcn_exp2f(-fabsf(z)));
            float b_ = fminf(z, 0.f) - l, r_ = b_ - z;
            if (diag) { const bool valid = ((r & 3) + 8 * (r >> 2) + 4 * lh) < l31; r_ = valid ? r_ : 0.f; b_ = valid ? b_ : -INFINITY; }
            lb[r] = b_; lr[r] = r_;
        }
        float ex[16], B[4];
#pragma unroll
        for (int g = 0; g < 4; ++g) {
            ex[4 * g + 3] = 0.f;
            ex[4 * g + 2] = lr[4 * g + 3];
            ex[4 * g + 1] = ex[4 * g + 2] + lr[4 * g + 2];
            ex[4 * g + 0] = ex[4 * g + 1] + lr[4 * g + 1];
            B[g] = ex[4 * g + 0] + lr[4 * g + 0];
        }
        float P[4];
#pragma unroll
        for (int g = 0; g < 4; ++g) P[g] = __shfl_xor(B[g], 32);
        float off[4];
        {
            const float p3 = P[3], p2 = P[2] + p3, p1 = P[1] + p2, p0 = P[0] + p1;
            const float b3 = 0.f, b2 = B[3], b1 = B[2] + b2, b0 = B[1] + b1;
            off[0] = b0 + (lh ? p1 : p0);
            off[1] = b1 + (lh ? p2 : p1);
            off[2] = b2 + (lh ? p3 : p2);
            off[3] = b3 + (lh ? 0.f : p3);
            const float total = (B[0] + b0) + p0;
#pragma unroll
            for (int g = 0; g < 4; ++g) off[g] += run;
            run += total;
        }
        float a[16];
#pragma unroll
        for (int r = 0; r < 16; ++r) a[r] = __builtin_amdgcn_exp2f(lb[r] + ex[r] + off[r >> 2]);
        bf16x8 pf[2];
#pragma unroll
        for (int ss = 0; ss < 2; ++ss) {
            typedef unsigned u32x4 __attribute__((ext_vector_type(4)));
            u32x4 w;
            w[0] = pk_bf16(a[8 * ss + 0], a[8 * ss + 1]); w[1] = pk_bf16(a[8 * ss + 2], a[8 * ss + 3]);
            w[2] = pk_bf16(a[8 * ss + 4], a[8 * ss + 5]); w[3] = pk_bf16(a[8 * ss + 6], a[8 * ss + 7]);
            pf[ss] = __builtin_bit_cast(bf16x8, w);
        }
#pragma unroll
        for (int ss = 0; ss < 2; ++ss) {
            o0 = __builtin_amdgcn_mfma_f32_32x32x16_bf16(vf[0][ss], pf[ss], o0, 0, 0, 0);
            o1 = __builtin_amdgcn_mfma_f32_32x32x16_bf16(vf[1][ss], pf[ss], o1, 0, 0, 0);
        }
        if (__all(run < -160.f)) break;
    }
    bf16_t* orow = p.obb + (size_t)(b * SEQ + qt * 32 + l31) * SBW + hh * 64 + 4 * lh;
#pragma unroll
    for (int g = 0; g < 4; ++g) {
        uint2 w0, w1;
        w0.x = pk_bf16(o0[4 * g], o0[4 * g + 1]); w0.y = pk_bf16(o0[4 * g + 2], o0[4 * g + 3]);
        w1.x = pk_bf16(o1[4 * g], o1[4 * g + 1]); w1.y = pk_bf16(o1[4 * g + 2], o1[4 * g + 3]);
        *(uint2*)(orow + 8 * g) = w0;
        *(uint2*)(orow + 32 + 8 * g) = w1;
    }
}


constexpr int DN_RW = 0, DN_RQ = 128, DN_RAT = 256, DN_RKD = 320;
constexpr float LOG2E = 1.4426950408889634f;
__device__ __forceinline__ int pi16(int x) { return (x & ~12) | ((x & 4) << 1) | ((x & 8) >> 1); }
__device__ __forceinline__ uint4 pack8(const float* v) { uint4 o; o.x = pk_bf16(v[0], v[1]); o.y = pk_bf16(v[2], v[3]); o.z = pk_bf16(v[4], v[5]); o.w = pk_bf16(v[6], v[7]); return o; }

__device__ __forceinline__ void dn_chunk_item(const Params& p, int item, unsigned char* lds) {
    const int tid = opaque_tid(), lane = tid & 63, wid = tid >> 6;
    const int bh = item >> 5, n = item & 31, b = bh >> 2, hh = bh & 3;
    const int t0 = b * SEQ + n * 64;
    unsigned char* Kimg = lds; unsigned char* KBimg = lds + 16384; unsigned char* Qimg = lds + 32768;
    float* Vf = (float*)(lds + 49152); float* KBGf = (float*)(lds + 81920); float* MT = (float*)(lds + 114688);
    float* G2s = (float*)(lds + 114688 + 17408); float* betas = G2s + 64;
    bf16_t* blob = p.dnblob + (size_t)item * DN_BLOB;
    if (wid == 0) {
        const int t = t0 + lane;
        const float da = p.small[(size_t)t * 8 + 4 + hh] + p.dt_bias[hh];
        const float sp = da > 20.f ? da : log1pf(expf(da));
        float g2 = -expf(p.a_log[hh]) * sp * LOG2E;
#pragma unroll
        for (int off = 1; off < 64; off <<= 1) { const float v = __shfl_up(g2, off); if (lane >= off) g2 += v; }
        G2s[lane] = g2; betas[lane] = sigmoidf_(p.small[(size_t)t * 8 + hh]);
        if (lane == 63) p.dnlast[item] = exp2f(g2);
    }
    __syncthreads();
    {
        const int c8 = tid & 15, tq = tid >> 4, j0 = tq * 2;
        const float G0 = G2s[j0], G1 = G2s[j0 + 1], GL = G2s[63];
        const float be[2] = {betas[j0], betas[j0 + 1]};
        const float eg[2] = {exp2f(G0), exp2f(G1)}, el[2] = {exp2f(GL - G0), exp2f(GL - G1)};
        const int half = c8 >> 3, ch = c8 & 7;
#pragma unroll
        for (int type = 0; type < 3; ++type) {
            float o[2][8];
            {
                const bf16_t* src = p.qkvraw + (size_t)(t0 + j0 - 3) * 1536 + type * 512 + hh * 128 + c8 * 8;
                float x[5][8];
#pragma unroll
                for (int r = 0; r < 5; ++r) {
                    uint4 raw = make_uint4(0, 0, 0, 0);
                    if (n > 0 || j0 - 3 + r >= 0) raw = *(const uint4*)(src + (size_t)r * 1536);
                    const unsigned u[4] = {raw.x, raw.y, raw.z, raw.w};
#pragma unroll
                    for (int i = 0; i < 4; ++i) { x[r][2 * i] = __uint_as_float(u[i] << 16); x[r][2 * i + 1] = __uint_as_float(u[i] & 0xffff0000u); }
                }
                const float* wp = p.conv_w + type * 512 + hh * 128 + c8 * 8;
#pragma unroll
                for (int i = 0; i < 8; ++i) {
                    float a0 = 0.f, a1 = 0.f;
#pragma unroll
                    for (int tap = 0; tap < 4; ++tap) { const float w = wp[tap * 1536 + i]; a0 = fmaf(x[tap][i], w, a0); a1 = fmaf(x[tap + 1][i], w, a1); }
                    o[0][i] = siluf_(a0); o[1][i] = siluf_(a1);
                }
            }
            if (type < 2) {
#pragma unroll
                for (int tk = 0; tk < 2; ++tk) {
                    float ss = 0.f;
#pragma unroll
                    for (int i = 0; i < 8; ++i) ss = fmaf(o[tk][i], o[tk][i], ss);
                    ss += __shfl_xor(ss, 1); ss += __shfl_xor(ss, 2); ss += __shfl_xor(ss, 4); ss += __shfl_xor(ss, 8);
                    float r = rsqrtf(ss + NORM_EPS);
                    if (type == 0) r *= 0.08838834764831845f;
#pragma unroll
                    for (int i = 0; i < 8; ++i) o[tk][i] *= r;
                }
            }
#pragma unroll
            for (int tk = 0; tk < 2; ++tk) {
                const int j = j0 + tk;
                const int ioff = half * 8192 + j * 128 + ((ch ^ swz(j)) << 4);
                if (type == 0) {
                    *(uint4*)(Qimg + ioff) = pack8(o[tk]);
                    float qd[8];
#pragma unroll
                    for (int i = 0; i < 8; ++i) qd[i] = o[tk][i] * eg[tk];
                    bf16_t* qrow = blob + (size_t)(DN_RQ + half * 64 + j) * 64 + ((c8 >> 1) & 3) * 16 + 4 * (c8 & 1);
                    uint2 w0, w1; w0.x = pk_bf16(qd[0], qd[1]); w0.y = pk_bf16(qd[2], qd[3]); w1.x = pk_bf16(qd[4], qd[5]); w1.y = pk_bf16(qd[6], qd[7]);
                    *(uint2*)qrow = w0; *(uint2*)(qrow + 8) = w1;
                } else if (type == 1) {
                    float kb[8], kbg[8];
#pragma unroll
                    for (int i = 0; i < 8; ++i) { kb[i] = o[tk][i] * be[tk]; kbg[i] = kb[i] * eg[tk]; }
                    *(uint4*)(Kimg + ioff) = pack8(o[tk]);
                    *(uint4*)(KBimg + ioff) = pack8(kb);
                    f32x4* kd = (f32x4*)(KBGf + j * 128 + c8 * 8); kd[0] = (f32x4){kbg[0], kbg[1], kbg[2], kbg[3]}; kd[1] = (f32x4){kbg[4], kbg[5], kbg[6], kbg[7]};
                } else {
                    float vb[8];
#pragma unroll
                    for (int i = 0; i < 8; ++i) vb[i] = o[tk][i] * be[tk];
                    f32x4* vd = (f32x4*)(Vf + j * 128 + c8 * 8); vd[0] = (f32x4){vb[0], vb[1], vb[2], vb[3]}; vd[1] = (f32x4){vb[4], vb[5], vb[6], vb[7]};
                }
            }
            if (type == 1) {
                const int jp = (j0 & 48) | pi16(j0 & 15);
#pragma unroll
                for (int i = 0; i < 8; ++i)
                    *(unsigned*)(blob + (size_t)(DN_RKD + c8 * 8 + i) * 64 + jp) = pk_bf16(o[0][i] * el[0], o[1][i] * el[1]);
            }
            asm volatile("" ::: "memory");
        }
    }
    __syncthreads();
    {
        const int which = wid >> 2, ti = (wid >> 1) & 1, tj = wid & 1, l31 = lane & 31, lh = lane >> 5;
        if (!(ti == 0 && tj == 1)) {
            const unsigned char* Ab = (which == 0 ? KBimg : Qimg) + (ti * 32 + l31) * 128;
            const unsigned char* Bb = Kimg + (tj * 32 + l31) * 128;
            const int fsw = swz(l31);
            f32x16 acc;
#pragma unroll
            for (int r = 0; r < 16; ++r) acc[r] = 0.f;
#pragma unroll
            for (int ks = 0; ks < 8; ++ks) {
                const int off = (ks >> 2) * 8192 + ((((ks & 3) * 2 + lh) ^ fsw) << 4);
                acc = __builtin_amdgcn_mfma_f32_32x32x16_bf16(*(const bf16x8*)(Ab + off), *(const bf16x8*)(Bb + off), acc, 0, 0, 0);
            }
            const int j = tj * 32 + l31;
            const float Gj = G2s[j];
#pragma unroll
            for (int r = 0; r < 16; ++r) {
                const int i = ti * 32 + (r & 3) + 8 * (r >> 2) + 4 * lh;
                const float v = acc[r] * exp2f(G2s[i] - Gj);
                if (which == 0) MT[j * 68 + i] = (i > j) ? v : 0.f;
                else blob[(size_t)(DN_RAT + i) * 64 + ((j & 48) | pi16(j & 15))] = to_bf16((i >= j) ? v : 0.f);
            }
        }
    }
    __syncthreads();
#ifndef NO_SOLVE
    if (tid < 256) {
        const int c = tid & 127;
        const float* rhs = (tid < 128 ? Vf : KBGf) + c;
        float y[64];
#pragma unroll
        for (int j = 0; j < 64; ++j) y[j] = rhs[j * 128];
#pragma unroll
        for (int j = 0; j < 63; ++j) {
            const float yj = y[j];
#pragma unroll
            for (int i4 = (j + 1) & ~3; i4 < 64; i4 += 4) {
                const f32x4 m = *(const f32x4*)(MT + j * 68 + i4);
#pragma unroll
                for (int u = 0; u < 4; ++u) if (i4 + u > j) y[i4 + u] = fmaf(-m[u], yj, y[i4 + u]);
            }
            asm volatile("" ::: "memory");
        }
        if (tid < 128) {
#pragma unroll
            for (int mi = 0; mi < 2; ++mi)
#pragma unroll
                for (int h = 0; h < 2; ++h) {
                    f32x4* dst = (f32x4*)(p.dnu + ((((size_t)item * 2 + mi) * 4 + (c >> 5)) * 64 + h * 32 + (c & 31)) * 16);
#pragma unroll
                    for (int g = 0; g < 4; ++g)
                        dst[g] = (f32x4){y[mi * 32 + 8 * g + 4 * h], y[mi * 32 + 8 * g + 4 * h + 1], y[mi * 32 + 8 * g + 4 * h + 2], y[mi * 32 + 8 * g + 4 * h + 3]};
                }
        } else {
            bf16_t* dst = blob + (size_t)(DN_RW + (c >> 6) * 64) * 64 + ((c & 48) | pi16(c & 15));
#pragma unroll
            for (int i = 0; i < 64; ++i) dst[(size_t)i * 64] = to_bf16(-y[i]);
        }
    }
#endif
    __syncthreads();
}

__device__ __forceinline__ void phase_dn_chunks(const Params& p, unsigned char* lds) {
    for (int item = blockIdx.x; item < NB * DNH * 32; item += gridDim.x) dn_chunk_item(p, item, lds);
}

__device__ __forceinline__ void dn_scan(const Params& p, int bh, unsigned char* lds) {
    const int tid = opaque_tid(), lane = tid & 63, wid = tid >> 6, l31 = lane & 31, lh = lane >> 5;
    const int b = bh >> 2, hh = bh & 3;
    const int fsw = swz(l31);
    auto copy_blob = [&](int n, unsigned char* dst) {
        const uint4* src = (const uint4*)(p.dnblob + (size_t)(bh * 32 + n) * DN_BLOB);
        const int lt = tid - 256;
#pragma unroll
        for (int k = 0; k < 14; ++k) {
            const int c = lt + k * 256, row = c >> 3, ch = c & 7;
            *(uint4*)(dst + row * 128 + ((ch ^ swz(row)) << 4)) = src[c];
        }
    };
    if (wid >= 4) copy_blob(0, lds);
    __syncthreads();
    f32x16 S[4];
#pragma unroll
    for (int t = 0; t < 4; ++t)
#pragma unroll
        for (int r = 0; r < 16; ++r) S[t][r] = 0.f;
    for (int n = 0; n < 32; ++n) {
        if (wid >= 4) {
            if (n + 1 < 32) copy_blob(n + 1, lds + ((n + 1) & 1) * (DN_ROWS * 128));
        } else {
            const unsigned char* buf = lds + (n & 1) * (DN_ROWS * 128);
            const int item = bh * 32 + n;
            f32x16 vn[2], oa[2];
#pragma unroll
            for (int mi = 0; mi < 2; ++mi) {
                vn[mi] = *(const f32x16*)(p.dnu + ((((size_t)item * 2 + mi) * 4 + wid) * 64 + lane) * 16);
#pragma unroll
                for (int r = 0; r < 16; ++r) oa[mi][r] = 0.f;
            }
            const float last = p.dnlast[item];
            typedef unsigned u32x4 __attribute__((ext_vector_type(4)));
            bf16x8 sb[4][2];
#pragma unroll
            for (int t = 0; t < 4; ++t)
#pragma unroll
                for (int ss = 0; ss < 2; ++ss) {
                    u32x4 w;
#pragma unroll
                    for (int q = 0; q < 4; ++q) w[q] = pk_bf16(S[t][8 * ss + 2 * q], S[t][8 * ss + 2 * q + 1]);
                    sb[t][ss] = __builtin_bit_cast(bf16x8, w);
                }
#pragma unroll
            for (int mi = 0; mi < 2; ++mi)
#pragma unroll
                for (int ks = 0; ks < 8; ++ks) {
                    const int off = ((ks >> 2) * 64 + mi * 32 + l31) * 128 + ((((ks & 3) * 2 + lh) ^ fsw) << 4);
                    vn[mi] = __builtin_amdgcn_mfma_f32_32x32x16_bf16(*(const bf16x8*)(buf + DN_RW * 128 + off), sb[ks >> 1][ks & 1], vn[mi], 0, 0, 0);
                    oa[mi] = __builtin_amdgcn_mfma_f32_32x32x16_bf16(*(const bf16x8*)(buf + DN_RQ * 128 + off), sb[ks >> 1][ks & 1], oa[mi], 0, 0, 0);
                }
            bf16x8 vb[2][2];
#pragma unroll
            for (int mj = 0; mj < 2; ++mj)
#pragma unroll
                for (int ss = 0; ss < 2; ++ss) {
                    u32x4 w;
#pragma unroll
                    for (int q = 0; q < 4; ++q) w[q] = pk_bf16(vn[mj][8 * ss + 2 * q], vn[mj][8 * ss + 2 * q + 1]);
                    vb[mj][ss] = __builtin_bit_cast(bf16x8, w);
                }
#pragma unroll
            for (int mi = 0; mi < 2; ++mi)
#pragma unroll
                for (int kj = 0; kj < 4; ++kj)
                    if ((kj >> 1) <= mi) {
                        const int off = (DN_RAT + mi * 32 + l31) * 128 + (((kj * 2 + lh) ^ fsw) << 4);
                        oa[mi] = __builtin_amdgcn_mfma_f32_32x32x16_bf16(*(const bf16x8*)(buf + off), vb[kj >> 1][kj & 1], oa[mi], 0, 0, 0);
                    }
#pragma unroll
            for (int t = 0; t < 4; ++t) {
#pragma unroll
                for (int r = 0; r < 16; ++r) S[t][r] *= last;
#pragma unroll
                for (int kj = 0; kj < 4; ++kj) {
                    const int off = (DN_RKD + t * 32 + l31) * 128 + (((kj * 2 + lh) ^ fsw) << 4);
                    S[t] = __builtin_amdgcn_mfma_f32_32x32x16_bf16(*(const bf16x8*)(buf + off), vb[kj >> 1][kj & 1], S[t], 0, 0, 0);
                }
            }
            float* orow = p.oraw + (size_t)(b * SEQ + n * 64) * DNW + hh * 128 + wid * 32 + l31;
#pragma unroll
            for (int mi = 0; mi < 2; ++mi)
#pragma unroll
                for (int r = 0; r < 16; ++r) orow[(size_t)(mi * 32 + (r & 3) + 8 * (r >> 2) + 4 * lh) * DNW] = oa[mi][r];
        }
        __syncthreads();
    }
}

__device__ __forceinline__ void phase_mixers(const Params& p, float* smem) {
    const int nscan = NB * DNH;
    if (gridDim.x >= 2 * nscan) {
#ifndef SKIP_SCAN
        if ((int)blockIdx.x < nscan) dn_scan(p, blockIdx.x, (unsigned char*)smem);
#endif
        if ((int)blockIdx.x < nscan) {}
        else
            for (int it = blockIdx.x - nscan; it < 512; it += gridDim.x - nscan) sb_attn_wave(p, it >> 3, (it & 7) * 8 + (opaque_tid() >> 6));
    } else {
#ifndef SKIP_SCAN
        for (int bh = blockIdx.x; bh < nscan; bh += gridDim.x) dn_scan(p, bh, (unsigned char*)smem);
#endif
        for (int it = blockIdx.x; it < 512; it += gridDim.x) sb_attn_wave(p, it >> 3, (it & 7) * 8 + (opaque_tid() >> 6));
    }
}

__device__ __forceinline__ void phase_gated_norm(const Params& p) {
    const int lane = opaque_tid() & 63, wave = (blockIdx.x * NT + opaque_tid()) >> 6, nw = (gridDim.x * NT) >> 6;
    for (int item = wave; item < T * 4; item += nw) {
        const int t = item >> 2, hh = item & 3;
        const size_t off = (size_t)t * DNW + hh * 128 + lane * 2;
        const float v0 = p.oraw[off], v1 = p.oraw[off + 1];
        const float ss = wave_sum(v0 * v0 + v1 * v1);
        const float r = rsqrtf(ss * (1.f / 128.f) + NORM_EPS);
        const float z0 = bf2f(p.dzb[(size_t)t * 512 + hh * 128 + lane * 2]), z1 = bf2f(p.dzb[(size_t)t * 512 + hh * 128 + lane * 2 + 1]);
        p.oab[off] = to_bf16(v0 * r * p.norm_g[lane * 2] * siluf_(z0));
        p.oab[off + 1] = to_bf16(v1 * r * p.norm_g[lane * 2 + 1] * siluf_(z1));
    }
}

template <class SF>
__device__ __forceinline__ void layer_norm_rows(SF sf, const float* g, const float* bb, float* dst, bf16_t* dstb) {
    const int lane = opaque_tid() & 63, wave = (blockIdx.x * NT + opaque_tid()) >> 6, nw = (gridDim.x * NT) >> 6;
    for (int t = wave; t < T; t += nw) {
        float v[16];
        float s = 0.f;
#pragma unroll
        for (int i = 0; i < 16; ++i) { v[i] = sf(t, lane + i * 64); s += v[i]; }
        const float mu = wave_sum(s) * (1.f / 1024.f);
        float q = 0.f;
#pragma unroll
        for (int i = 0; i < 16; ++i) { const float d = v[i] - mu; q += d * d; }
        const float rstd = rsqrtf(wave_sum(q) * (1.f / 1024.f) + LN_EPS);
#pragma unroll
        for (int i = 0; i < 16; ++i) { const int c = lane + i * 64; const float y = (v[i] - mu) * rstd * g[c] + bb[c]; dst[(size_t)t * D + c] = y; if (dstb) dstb[(size_t)t * D + c] = to_bf16(y); }
    }
}

__device__ __forceinline__ void phase_route(const Params& p) {
    const int tid = opaque_tid(), lane = tid & 63;
    const int wave = (blockIdx.x * NT + tid) >> 6, nw = (gridDim.x * NT) >> 6;
    const f32x4 bias = *(const f32x4*)(p.router_bias + lane * 4);
    for (int t = wave; t < T; t += nw) {
        const f32x4 sc = *(const f32x4*)(p.scores + (size_t)t * NE + lane * 4);
        const float sel[4] = {sc[0] + bias[0], sc[1] + bias[1], sc[2] + bias[2], sc[3] + bias[3]};
        float m1 = fmaxf(sel[0], sel[1]), m2 = fminf(sel[0], sel[1]);
        m2 = fmaxf(m2, fminf(m1, sel[2])); m1 = fmaxf(m1, sel[2]);
        m2 = fmaxf(m2, fminf(m1, sel[3])); m1 = fmaxf(m1, sel[3]);
#pragma unroll
        for (int off = 1; off < 8; off <<= 1) {
            const float o1 = __shfl_xor(m1, off), o2 = __shfl_xor(m2, off);
            const float n2 = fmaxf(fminf(m1, o1), fmaxf(m2, o2));
            m1 = fmaxf(m1, o1); m2 = n2;
        }
        const float gs = m1 + m2;
        const int g = lane >> 3;
        int rank = 0;
#pragma unroll
        for (int gg = 0; gg < NG; ++gg) { const float og = __shfl(gs, gg * 8); rank += (og > gs || (og == gs && gg < g)) ? 1 : 0; }
        const bool gsel = rank < TOPG;
        unsigned long long key[4];
#pragma unroll
        for (int i = 0; i < 4; ++i) {
            const unsigned u = __float_as_uint(gsel ? sel[i] : -INFINITY);
            const unsigned ku = (u & 0x80000000u) ? ~u : (u | 0x80000000u);
            key[i] = ((unsigned long long)ku << 32) | (unsigned)(255 - (lane * 4 + i));
        }
        float wsum = 0.f, myw = 0.f; int myidx = 0;
#pragma unroll
        for (int it = 0; it < TOPK; ++it) {
            unsigned long long best = key[0] > key[1] ? key[0] : key[1];
            best = key[2] > best ? key[2] : best; best = key[3] > best ? key[3] : best;
#pragma unroll
            for (int off = 32; off > 0; off >>= 1) { const unsigned long long o = __shfl_xor(best, off); best = o > best ? o : best; }
            const int e = 255 - (int)(unsigned)(best & 0xffffffffull);
#pragma unroll
            for (int i = 0; i < 4; ++i) if (lane * 4 + i == e) key[i] = 0ull;
            const int q = e & 3;
            const float mine = q == 0 ? sc[0] : q == 1 ? sc[1] : q == 2 ? sc[2] : sc[3];
            const float w = __shfl(mine, e >> 2);
            wsum += w;
            if (lane == it) { myidx = e; myw = w; }
        }
        if (lane < TOPK) {
            const int pr = t * TOPK + lane;
            p.idx[pr] = myidx;
            p.gate[pr] = myw / wsum * 2.5f;
            const int pos = atomicAdd(&p.counts[myidx], 1);
            p.explist[(size_t)myidx * ECAP + pos] = pr;
        }
    }
}

__device__ __forceinline__ void compute_pend(const Params& p, int* pend, int* cnt) {
    const int tid = opaque_tid();
    if (tid < 64) {
        int c[4], pc[4];
#pragma unroll
        for (int i = 0; i < 4; ++i) { c[i] = p.counts[tid * 4 + i]; cnt[tid * 4 + i] = c[i]; pc[i] = (c[i] + 127) / 128 * 128; }
        const int ssum = pc[0] + pc[1] + pc[2] + pc[3];
        int inc = ssum;
#pragma unroll
        for (int off = 1; off < 64; off <<= 1) { const int v = __shfl_up(inc, off); if (tid >= off) inc += v; }
        int run = inc - ssum;
#pragma unroll
        for (int i = 0; i < 4; ++i) { run += pc[i]; pend[tid * 4 + i] = run; }
    }
    __syncthreads();
}

__device__ __forceinline__ int expert_of_row(const int* pend, int row) {
    int lo = 0, hi = NE - 1;
    while (lo < hi) { const int mid = (lo + hi) >> 1; if (pend[mid] > row) hi = mid; else lo = mid + 1; }
    return lo;
}

__device__ __forceinline__ void phase_routed(const Params& p, int* pend, int* cnt, unsigned char* lds) {
    typedef GemmCfg<128, 256, 2, 4> CFG;
    compute_pend(p, pend, cnt);
    int* prs = (int*)(lds + 131072); float* gts = (float*)(lds + 131072 + 512);
    const int nrt = pend[NE - 1] / 128;
    for (int rt = blockIdx.x; rt < nrt; rt += gridDim.x) {
        const int e = expert_of_row(pend, rt * 128);
        const int q0 = rt * 128 - (e ? pend[e - 1] : 0), ce = cnt[e];
        {
            const int tid = opaque_tid();
            if (tid < 128) {
                const int pr = (q0 + tid < ce) ? p.explist[(size_t)e * ECAP + q0 + tid] : -1;
                prs[tid] = pr; gts[tid] = pr >= 0 ? p.gate[pr] : 0.f;
            }
        }
        __syncthreads();
#pragma unroll 1
        for (int tn = 0; tn < 2; ++tn) {
            LoadRowsBf16<128, true> al[2]; LoadKNF32 bl[2];
#pragma unroll
            for (int u = 0; u < 2; ++u) {
                al[u].init(p.hb, D, [&](int r) { const int pr = prs[r]; return pr >= 0 ? (long long)(pr >> 3) : -1LL; });
                bl[u].init(p.w_eu + (size_t)e * D * (2 * EFF), 2 * EFF, [&](int r) { return ((r >> 5) & 1) * EFF + tn * 128 + (r >> 6) * 32 + (r & 31); });
            }
            f32x16 acc[CFG::MI][CFG::NI];
            acc_zero<CFG>(acc);
            gemm_mainloop2<CFG, false, 0>(al, bl, D / 64, acc, lds, nullptr);
            const int tid = opaque_tid(), lane = tid & 63, wid = tid >> 6, wm = wid / CFG::WN, wn = wid % CFG::WN;
            const int j = tn * 128 + wn * 32 + (lane & 31);
            unsigned char* img = lds + 65536 + (((j >> 6) + 2) & 3) * 16384 + (j & 7) * 2;
            const int jc = (j & 63) >> 3;
#pragma unroll
            for (int mi = 0; mi < CFG::MI; ++mi)
#pragma unroll
                for (int r = 0; r < 16; ++r) {
                    const int row = wm * CFG::TM + mi * 32 + (r & 3) + 8 * (r >> 2) + 4 * (lane >> 5);
                    *(bf16_t*)(img + row * 128 + ((jc ^ swz(row)) << 4)) = to_bf16(siluf_(acc[mi][0][r]) * acc[mi][1][r]);
                }
        }
        __syncthreads();
#pragma unroll 1
        for (int tn = 0; tn < 4; ++tn) {
            LoadRowsBf16<128> aldummy[2]; LoadKNF32 bl[2];
#pragma unroll
            for (int u = 0; u < 2; ++u) bl[u].init(p.w_ed + (size_t)e * EFF * D, D, [&](int r) { return tn * 256 + r; });
            f32x16 acc[CFG::MI][CFG::NI];
            acc_zero<CFG>(acc);
            gemm_mainloop2<CFG, true, 2>(aldummy, bl, EFF / 64, acc, lds, lds + 65536);
            acc_foreach<CFG>(acc, [&](int r, int c, float v, int, int, int) {
                const int pr = prs[r];
                if (pr >= 0) p.ypairb[(size_t)pr * D + tn * 256 + c] = to_bf16(v * gts[r]);
                return v;
            });
        }
        __syncthreads();
    }
}

#ifndef R0
#define R0 1
#define R1 1
#define R2 1
#define R3 1
#define R4 1
#define R5 1
#define R6 1
#define R7 1
#define R8 1
#define R10 1
#define R11 1
#define R12 1
#endif
constexpr int LDS_MAIN = 133120;
__global__ void __launch_bounds__(NT) fwd_megakernel(KArgs ka) {
    const Params p(ka);
    __shared__ __attribute__((aligned(16))) unsigned char lds[LDS_MAIN + 2 * NE * 4 + 16];
    float* smem = (float*)lds;
    int* pend = (int*)(lds + LDS_MAIN);
    int* cnt = pend + NE;
    volatile LAS3 unsigned* xbst = (volatile LAS3 unsigned*)(lds + LDS_MAIN + 2 * NE * 4);
    if (threadIdx.x == 0) { xbst[0] = 0u; xbst[1] = 0u; }
    __syncthreads();
    const XcdBarrier xb = xcd_barrier_post(p.bar, xbst);

#define REPEAT(N, ...) { int reps_ = (N); asm volatile("" : "+s"(reps_)); for (int rep_ = 0; rep_ < reps_; ++rep_) { __VA_ARGS__; xcd_barrier(xb); } }
    phase_init(p);
    REPEAT(R0,
        convert_bf16(p.x, p.xb, (size_t)T * D);
        transpose_convert(p.w_in, D, PW, PWP, p.w_in_t, smem, [](int n) { return n < 2048 ? n : n < 5632 ? n + 8 : n < 5640 ? n - 5632 + 2048 : -1; });
        transpose_convert(p.w_pa, DNW, D, D, p.w_pa_t, smem, [](int n) { return n; });
        transpose_convert(p.w_pb, SBW, D, D, p.w_pb_t, smem, [](int n) { return n; });
        transpose_convert(p.w_out, D, D, D, p.w_out_t, smem, [](int n) { return n; });
        transpose_convert(p.w_router, D, NE, NE, p.w_router_t, smem, [](int n) { return n; });
        transpose_convert(p.w_su, D, 2 * SFF, 2 * SFF, p.w_su_t, smem, [](int n) { return n; });
        transpose_convert(p.w_sd, SFF, D, D, p.w_sd_t, smem, [](int n) { return n; }))
    REPEAT(R1, phase_inproj(p, lds))
    REPEAT(R2, phase_dn_chunks(p, lds))
    REPEAT(R3, phase_mixers(p, smem))
    REPEAT(R4, phase_gated_norm(p))
    REPEAT(R5, phase_merge(p, lds))
    REPEAT(R6, phase_outproj(p, lds))
    REPEAT(R7, layer_norm_rows([&](int t, int c) { return p.pre1[(size_t)t * D + c]; }, p.ln1_g, p.ln1_b, p.h, p.hb))
    REPEAT(R8, phase_router_shared_up(p, lds))
    phase_route(p);
    xcd_barrier(xb);
    REPEAT(R10, phase_routed(p, pend, cnt, lds); phase_shared_down(p, lds))
    int reps12 = R12; asm volatile("" : "+s"(reps12));
    for (int rep = 0; rep < reps12; ++rep)
        layer_norm_rows([&](int t, int c) {
                float f = p.ysh[(size_t)t * D + c];
#pragma unroll
                for (int k = 0; k < TOPK; ++k) f += bf2f(p.ypairb[((size_t)t * TOPK + k) * D + c]);
                return ALPHA * p.h[(size_t)t * D + c] + f; },
            p.ln2_g, p.ln2_b, p.out, nullptr);
}

extern "C" void kernel_launch(void* const* d_in, const int* in_sizes, int n_in, void* d_out, int out_size, void* d_ws,
                              size_t ws_size, hipStream_t stream) {
    static int grid_blocks = 0;
    if (!grid_blocks) {
        int dev = 0, cus = 0, per_cu = 0;
        hipGetDevice(&dev);
        hipDeviceGetAttribute(&cus, hipDeviceAttributeMultiprocessorCount, dev);
        hipOccupancyMaxActiveBlocksPerMultiprocessor(&per_cu, fwd_megakernel, NT, 0);
        if (per_cu > 1) per_cu = 1;
        grid_blocks = cus * per_cu;
    }
    KArgs p{};
    const float* const* in = (const float* const*)d_in;
    p.x = in[0]; p.w_in = in[1]; p.conv_w = in[2]; p.a_log = in[3]; p.dt_bias = in[4]; p.norm_g = in[5]; p.w_pa = in[6];
    p.w_pb = in[7]; p.w_out = in[8]; p.ln1_g = in[9]; p.ln1_b = in[10]; p.w_router = in[11]; p.router_bias = in[12];
    p.w_su = in[13]; p.w_sd = in[14]; p.w_eu = in[15]; p.w_ed = in[16]; p.ln2_g = in[17]; p.ln2_b = in[18];
    p.out = (float*)d_out; p.ws = (unsigned char*)d_ws;
    if (WS_BYTES > ws_size) { fprintf(stderr, "workspace too small: need %zu have %zu\n", (size_t)WS_BYTES, ws_size); return; }
    hipMemsetAsync(p.ws + OFF_BAR, 0, XCD_BAR_WORDS * 4, stream);
    void* args[] = {&p};
    hipError_t e = hipLaunchCooperativeKernel((void*)fwd_megakernel, dim3(grid_blocks), dim3(NT), args, 0, stream);
    if (e != hipSuccess) fprintf(stderr, "cooperative launch failed: %s (grid %d)\n", hipGetErrorString(e), grid_blocks);
}
```

```cpp
#include <hip/hip_runtime.h>
#include <hip/hip_cooperative_groups.h>
#include <cstdio>
#include <cstdint>
namespace cg = cooperative_groups;

constexpr int D = 1024, NB = 8, SEQ = 2048, T = NB * SEQ;
constexpr int DNH = 4, DND = 128, DNW = 512;
constexpr int SBH = 8, SBD = 64, SBW = 512;
constexpr int NE = 256, TOPK = 8, NG = 8, TOPG = 4, EFF = 256, SFF = 256;
constexpr int PW = 5640;
constexpr int NPAIR = T * TOPK;
constexpr int NBLK = (NPAIR + NE * 127 + 127) / 128;
constexpr int PROWS = NBLK * 128;
constexpr float ALPHA = 1.189207115002721f;
constexpr float LN_EPS = 1e-5f, NORM_EPS = 1e-6f;
constexpr int NT = 512;
#ifndef RU
#define RU 1
#define RD 1
#define R9 1
#define RB 0
#endif

typedef unsigned short bf16_t;
constexpr int PWP = 5888;
constexpr int DN_ROWS = 448, DN_BLOB = DN_ROWS * 64;
constexpr int ECAP = T;
#define XCD_BAR_WORDS 3456
constexpr int CSTRIDE = 64;
constexpr size_t al256(size_t x) { return (x + 255) & ~(size_t)255; }
constexpr size_t OFF_XB = 0;
constexpr size_t OFF_WINT = OFF_XB + al256((size_t)T * D * 2);
constexpr size_t OFF_QKVRAW = OFF_WINT + al256((size_t)PWP * D * 2);
constexpr size_t OFF_DZB = OFF_QKVRAW + al256((size_t)T * 1536 * 2);
constexpr size_t OFF_SQ = OFF_DZB + al256((size_t)T * 512 * 2);
constexpr size_t OFF_SK = OFF_SQ + al256((size_t)T * 512 * 2);
constexpr size_t OFF_VT = OFF_SK + al256((size_t)T * 512 * 2);
constexpr size_t OFF_DNBLOB = OFF_VT + al256((size_t)T * 512 * 2);
constexpr size_t OFF_DNU = OFF_DNBLOB + al256((size_t)1024 * DN_BLOB * 2);
constexpr size_t OFF_DNLAST = OFF_DNU + al256((size_t)1024 * 64 * 128 * 4);
constexpr size_t OFF_GAB = OFF_DNLAST + al256(1024 * 4);
constexpr size_t OFF_GBB = OFF_GAB + al256((size_t)T * D * 2);
constexpr size_t OFF_SMALL = OFF_GBB + al256((size_t)T * D * 2);
constexpr size_t OFF_WPAT = OFF_SMALL + al256((size_t)T * 8 * 4);
constexpr size_t OFF_WPBT = OFF_WPAT + al256((size_t)D * DNW * 2);
constexpr size_t OFF_WOUTT = OFF_WPBT + al256((size_t)D * SBW * 2);
constexpr size_t OFF_WROUTT = OFF_WOUTT + al256((size_t)D * D * 2);
constexpr size_t OFF_WSUT = OFF_WROUTT + al256((size_t)NE * D * 2);
constexpr size_t OFF_WSDT = OFF_WSUT + al256((size_t)2 * SFF * D * 2);
constexpr size_t OFF_OAB = OFF_WSDT + al256((size_t)D * SFF * 2);
constexpr size_t OFF_OBB = OFF_OAB + al256((size_t)T * DNW * 2);
constexpr size_t OFF_MERGED = OFF_OBB + al256((size_t)T * SBW * 2);
constexpr size_t OFF_HB = OFF_MERGED + al256((size_t)T * D * 2);
constexpr size_t OFF_ACTSH = OFF_HB + al256((size_t)T * D * 2);
constexpr size_t OFF_YPAIRB = OFF_ACTSH + al256((size_t)T * SFF * 2);
constexpr size_t OFF_ORAW = OFF_YPAIRB + al256((size_t)NPAIR * D * 2);
constexpr size_t OFF_PRE1 = OFF_ORAW + al256((size_t)T * DNW * 4);
constexpr size_t OFF_H = OFF_PRE1 + al256((size_t)T * D * 4);
constexpr size_t OFF_SCORES = OFF_H + al256((size_t)T * D * 4);
constexpr size_t OFF_GATE = OFF_SCORES + al256((size_t)T * NE * 4);
constexpr size_t OFF_YSH = OFF_GATE + al256((size_t)NPAIR * 4);
constexpr size_t OFF_IDX = OFF_YSH + al256((size_t)T * D * 4);
constexpr size_t OFF_COUNTS = OFF_IDX + al256((size_t)NPAIR * 4);
constexpr size_t OFF_EXPLIST = OFF_COUNTS + al256(2 * NE * CSTRIDE * 4);
constexpr size_t OFF_BAR = OFF_EXPLIST + al256((size_t)NE * ECAP * 4);
constexpr size_t WS_BYTES = OFF_BAR + al256(XCD_BAR_WORDS * 4);

struct KArgs {
    const float *x, *w_in, *conv_w, *a_log, *dt_bias, *norm_g, *w_pa, *w_pb, *w_out, *ln1_g, *ln1_b, *w_router,
        *router_bias, *w_su, *w_sd, *w_eu, *w_ed, *ln2_g, *ln2_b;
    float* out; unsigned char* ws;
};
struct Params {
    const float *x, *w_in, *conv_w, *a_log, *dt_bias, *norm_g, *w_pa, *w_pb, *w_out, *ln1_g, *ln1_b, *w_router,
        *router_bias, *w_su, *w_sd, *w_eu, *w_ed, *ln2_g, *ln2_b;
    float* out;
    float *oraw, *pre1, *h, *scores, *gate, *ysh, *small, *dnu, *dnlast;
    int *idx, *counts, *explist;
    bf16_t *xb, *w_in_t, *w_pa_t, *w_pb_t, *w_out_t, *w_router_t, *w_su_t, *w_sd_t, *oab, *obb, *mergedb, *hb, *actsh, *ypairb;
    bf16_t *qkvraw, *dzb, *sq, *sk, *vT, *gab, *gbb, *dnblob;
    unsigned* bar;
    __device__ __forceinline__ explicit Params(const KArgs& k) {
        x = k.x; w_in = k.w_in; conv_w = k.conv_w; a_log = k.a_log; dt_bias = k.dt_bias; norm_g = k.norm_g; w_pa = k.w_pa; w_pb = k.w_pb;
        w_out = k.w_out; ln1_g = k.ln1_g; ln1_b = k.ln1_b; w_router = k.w_router; router_bias = k.router_bias; w_su = k.w_su; w_sd = k.w_sd;
        w_eu = k.w_eu; w_ed = k.w_ed; ln2_g = k.ln2_g; ln2_b = k.ln2_b; out = k.out;
        unsigned char* w = k.ws;
        xb = (bf16_t*)(w + OFF_XB); w_in_t = (bf16_t*)(w + OFF_WINT); qkvraw = (bf16_t*)(w + OFF_QKVRAW); dzb = (bf16_t*)(w + OFF_DZB);
        sq = (bf16_t*)(w + OFF_SQ); sk = (bf16_t*)(w + OFF_SK); vT = (bf16_t*)(w + OFF_VT); dnblob = (bf16_t*)(w + OFF_DNBLOB);
        dnu = (float*)(w + OFF_DNU); dnlast = (float*)(w + OFF_DNLAST); gab = (bf16_t*)(w + OFF_GAB); gbb = (bf16_t*)(w + OFF_GBB);
        small = (float*)(w + OFF_SMALL); w_pa_t = (bf16_t*)(w + OFF_WPAT); w_pb_t = (bf16_t*)(w + OFF_WPBT); w_out_t = (bf16_t*)(w + OFF_WOUTT);
        w_router_t = (bf16_t*)(w + OFF_WROUTT); w_su_t = (bf16_t*)(w + OFF_WSUT); w_sd_t = (bf16_t*)(w + OFF_WSDT);
        oab = (bf16_t*)(w + OFF_OAB); obb = (bf16_t*)(w + OFF_OBB); mergedb = (bf16_t*)(w + OFF_MERGED); hb = (bf16_t*)(w + OFF_HB);
        actsh = (bf16_t*)(w + OFF_ACTSH); ypairb = (bf16_t*)(w + OFF_YPAIRB); oraw = (float*)(w + OFF_ORAW); pre1 = (float*)(w + OFF_PRE1);
        h = (float*)(w + OFF_H); scores = (float*)(w + OFF_SCORES); gate = (float*)(w + OFF_GATE); ysh = (float*)(w + OFF_YSH);
        idx = (int*)(w + OFF_IDX); counts = (int*)(w + OFF_COUNTS); explist = (int*)(w + OFF_EXPLIST); bar = (unsigned*)(w + OFF_BAR);
    }
};

__device__ __forceinline__ float sigmoidf_(float v) { return 1.f / (1.f + expf(-v)); }
__device__ __forceinline__ float siluf_(float v) { return v / (1.f + expf(-v)); }
__device__ __forceinline__ float wave_sum(float v) {
#pragma unroll
    for (int o = 32; o > 0; o >>= 1) v += __shfl_xor(v, o);
    return v;
}


#define XB_TMO      128
#define XB_XCNT(j)  (256  + 64 * (j))
#define XB_XSUB(j)  (1280 + 64 * (j))
#define XB_XGEN(j)  (2304 + 64 * (j))
#define XB_TOP      3328
#define XB_TOPGEN   3392
#define XB_SPIN_CAP (1u << 24)
#define LAS3 __attribute__((address_space(3)))
__device__ __forceinline__ unsigned xb_ld(unsigned* p)              { return __hip_atomic_load(p, __ATOMIC_RELAXED, __HIP_MEMORY_SCOPE_AGENT); }
__device__ __forceinline__ unsigned xb_add(unsigned* p, unsigned v) { return __hip_atomic_fetch_add(p, v, __ATOMIC_RELAXED, __HIP_MEMORY_SCOPE_AGENT); }
__device__ __forceinline__ unsigned xb_xcc_id() { return (unsigned)__builtin_amdgcn_s_getreg((3 << 11) | 20) & 0xFu; }
#define XB_SPIN(cond, bar) do { unsigned _sp = 0; while (cond) { __builtin_amdgcn_s_sleep(1); \
    if ((++_sp & 255u) == 0u) { if (xb_ld(&(bar)[XB_TMO])) break; if (_sp > XB_SPIN_CAP) { atomicAdd(&(bar)[XB_TMO], 1u); break; } } } } while (0)
struct XcdBarrier { unsigned* bar; unsigned x; volatile LAS3 unsigned* st; };
__device__ __forceinline__ XcdBarrier xcd_barrier_post(unsigned* bar, volatile LAS3 unsigned* st) {
    XcdBarrier b; b.bar = bar; b.x = xb_xcc_id(); b.st = st;
    if (threadIdx.x == 0) (void)xb_add(&bar[XB_XCNT(b.x)], 1u);
    return b;
}
__device__ __forceinline__ void xcd_barrier_complete(unsigned* bar, unsigned x, unsigned& nloc, unsigned& nx) {
    const unsigned G = gridDim.x * gridDim.y * gridDim.z;
    unsigned sum, cnt, mine, sp = 0u;
    asm volatile("" : "+s"(x));
    for (;;) {
        sum = 0u; cnt = 0u; mine = 0u;
#pragma unroll 1
        for (unsigned j = 0; j < 16; ++j) { const unsigned c = xb_ld(&bar[XB_XCNT(j)]); sum += c; cnt += (c > 0u) ? 1u : 0u; mine = (j == x) ? c : mine; }
        if (sum == G) break;
        __builtin_amdgcn_s_sleep(1);
        if ((++sp & 255u) == 0u) { if (xb_ld(&bar[XB_TMO])) break; if (sp > XB_SPIN_CAP) { atomicAdd(&bar[XB_TMO], 1u); break; } }
    }
    nloc = mine > 0u ? mine : 1u; nx = cnt > 0u ? cnt : 1u;
}
__device__ __forceinline__ void xcd_barrier(const XcdBarrier& b) {
    asm volatile("s_waitcnt vmcnt(0)" ::: "memory");
    __syncthreads();
    if (threadIdx.x == 0) {
        unsigned* bar = b.bar;
        __builtin_amdgcn_s_waitcnt(0);
        unsigned nloc = b.st[0], nx = b.st[1];
        if (nloc == 0u) { xcd_barrier_complete(bar, b.x, nloc, nx); b.st[0] = nloc; b.st[1] = nx; }
        const unsigned old = xb_add(&bar[XB_XSUB(b.x)], 1u);
        const unsigned gen = old / nloc;
        if (old + 1u == (gen + 1u) * nloc) {
            __builtin_amdgcn_fence(__ATOMIC_RELEASE, "agent");
            asm volatile("s_waitcnt vmcnt(0)" ::: "memory");
            const unsigned og = xb_add(&bar[XB_TOP], 1u);
            const unsigned tg = og / nx;
            if (og + 1u == (tg + 1u) * nx) xb_add(&bar[XB_TOPGEN], 1u);
            else XB_SPIN(xb_ld(&bar[XB_TOPGEN]) == tg, bar);
            __builtin_amdgcn_fence(__ATOMIC_ACQUIRE, "agent");
            xb_add(&bar[XB_XGEN(b.x)], 1u);
            asm volatile("s_waitcnt vmcnt(0)" ::: "memory");
        } else {
            XB_SPIN(xb_ld(&bar[XB_XGEN(b.x)]) == gen, bar);
            __builtin_amdgcn_fence(__ATOMIC_ACQUIRE, "agent");
            asm volatile("s_waitcnt vmcnt(0)" ::: "memory");
        }
    }
    __syncthreads();
}

typedef short bf16x8 __attribute__((ext_vector_type(8)));
typedef float f32x16 __attribute__((ext_vector_type(16)));
typedef float f32x4 __attribute__((ext_vector_type(4)));
__device__ __forceinline__ unsigned pk_bf16(float a, float b) {
    typedef __bf16 bf2 __attribute__((ext_vector_type(2)));
    typedef float f2 __attribute__((ext_vector_type(2)));
    f2 v = {a, b};
    bf2 r = __builtin_convertvector(v, bf2);
    return __builtin_bit_cast(unsigned, r);
}
__device__ __forceinline__ bf16_t to_bf16(float a) { return (bf16_t)(pk_bf16(a, 0.f) & 0xffffu); }
__device__ __forceinline__ float bf2f(bf16_t v) { return __uint_as_float((unsigned)v << 16); }

__device__ __forceinline__ int opaque_tid() { int t = threadIdx.x; asm volatile("" : "+v"(t)); return t; }
constexpr int LROW = 128;
__device__ __forceinline__ int swz(int r) { return ((r >> 2) & 7) ^ ((r >> 1) & 1); }

template <int ROWS, bool MAYBE_NULL = false> struct LoadRowsBf16 {
    static constexpr int NCH = ROWS * 8 / NT;
    const bf16_t* base; int tid;
    unsigned off[NCH];
    uint4 regs[NCH];
    template <class RF> __device__ __forceinline__ void init(const bf16_t* base_, int ld, RF rowfn) {
        base = base_; tid = opaque_tid();
#pragma unroll
        for (int i = 0; i < NCH; ++i) {
            const int c = tid + i * NT, r = c >> 3, ch = c & 7;
            const long long src = rowfn(r);
            off[i] = (!MAYBE_NULL || src >= 0) ? (unsigned)(src * ld + ch * 8) : 0xffffffffu;
        }
    }
    __device__ __forceinline__ void load(int k0) {
#pragma unroll
        for (int i = 0; i < NCH; ++i)
            regs[i] = (!MAYBE_NULL || off[i] != 0xffffffffu) ? *(const uint4*)(base + (size_t)off[i] + k0) : make_uint4(0, 0, 0, 0);
    }
    __device__ __forceinline__ void store(unsigned char* lds) const {
#pragma unroll
        for (int i = 0; i < NCH; ++i) {
            const int c = tid + i * NT, r = c >> 3, ch = c & 7;
            *(uint4*)(lds + r * LROW + ((ch ^ swz(r)) << 4)) = regs[i];
        }
    }
};

struct LoadKNF32 {
    const float* base; int ld, kq, nq;
    f32x4 regs[8];
    template <class CF> __device__ __forceinline__ void init(const float* w, int ld_, CF colfn) {
        const int tid = opaque_tid(); kq = tid >> 6; nq = tid & 63; ld = ld_;
        base = w + (size_t)(kq * 8) * ld_ + colfn(nq * 4);
    }
    __device__ __forceinline__ void load(int k0) {
#pragma unroll
        for (int j = 0; j < 8; ++j) regs[j] = *(const f32x4*)(base + (size_t)(k0 + j) * ld);
    }
    __device__ __forceinline__ void store1(unsigned char* lds, int nn, float a0, float a1, float a2, float a3, float a4, float a5, float a6, float a7) const {
        uint4 o; o.x = pk_bf16(a0, a1); o.y = pk_bf16(a2, a3); o.z = pk_bf16(a4, a5); o.w = pk_bf16(a6, a7);
        const int row = nq * 4 + nn;
        *(uint4*)(lds + row * LROW + ((kq ^ swz(row)) << 4)) = o;
    }
    __device__ __forceinline__ void store(unsigned char* lds) const {
        store1(lds, 0, regs[0].x, regs[1].x, regs[2].x, regs[3].x, regs[4].x, regs[5].x, regs[6].x, regs[7].x);
        store1(lds, 1, regs[0].y, regs[1].y, regs[2].y, regs[3].y, regs[4].y, regs[5].y, regs[6].y, regs[7].y);
        store1(lds, 2, regs[0].z, regs[1].z, regs[2].z, regs[3].z, regs[4].z, regs[5].z, regs[6].z, regs[7].z);
        store1(lds, 3, regs[0].w, regs[1].w, regs[2].w, regs[3].w, regs[4].w, regs[5].w, regs[6].w, regs[7].w);
    }
};

template <int BM_, int BN_, int WM_, int WN_> struct GemmCfg {
    static constexpr int BM = BM_, BN = BN_, WM = WM_, WN = WN_;
    static constexpr int TM = BM / WM, TN = BN / WN, MI = TM / 32, NI = TN / 32;
    static constexpr int A_BYTES = BM * LROW, B_BYTES = BN * LROW, STAGE = A_BYTES + B_BYTES;
    static_assert(WM * WN == 8, "8 waves");
};

template <class CFG, class AL, class BL>
__device__ __forceinline__ void gemm_mainloop(AL& al, BL& bl, int nk, f32x16 (&acc)[CFG::MI][CFG::NI], unsigned char* lds) {
    constexpr int MI = CFG::MI, NI = CFG::NI;
    const int tid = opaque_tid(), lane = tid & 63, wid = tid >> 6;
    const int wm = wid / CFG::WN, wn = wid % CFG::WN;
    const int l31 = lane & 31, lh = lane >> 5;
    al.load(0); bl.load(0);
    const int a_off = (wm * CFG::TM + l31) * LROW;
    const int b_off = CFG::A_BYTES + (wn * CFG::TN + l31) * LROW;
    const int fsw = swz(l31);
    for (int kt = 0; kt < nk; ++kt) {
        unsigned char* st = lds + (kt & 1) * CFG::STAGE;
        al.store(st); bl.store(st + CFG::A_BYTES);
        __syncthreads();
        if (kt + 1 < nk) { al.load((kt + 1) * 64); bl.load((kt + 1) * 64); }
#pragma unroll
        for (int kk = 0; kk < 4; ++kk) {
            bf16x8 a[MI], b[NI];
#pragma unroll
            for (int mi = 0; mi < MI; ++mi) a[mi] = *(const bf16x8*)(st + a_off + mi * 32 * LROW + (((kk * 2 + lh) ^ fsw) << 4));
#pragma unroll
            for (int ni = 0; ni < NI; ++ni) b[ni] = *(const bf16x8*)(st + b_off + ni * 32 * LROW + (((kk * 2 + lh) ^ fsw) << 4));
#pragma unroll
            for (int mi = 0; mi < MI; ++mi)
#pragma unroll
                for (int ni = 0; ni < NI; ++ni)
                    acc[mi][ni] = __builtin_amdgcn_mfma_f32_32x32x16_bf16(a[mi], b[ni], acc[mi][ni], 0, 0, 0);
        }
    }
    __syncthreads();
}
template <class CFG, bool A_RES, int ARES_ROT, class AL, class BL>
__device__ __forceinline__ void gemm_mainloop2(AL (&al)[2], BL (&bl)[2], int nk, f32x16 (&acc)[CFG::MI][CFG::NI], unsigned char* stages, const unsigned char* ares) {
    constexpr int MI = CFG::MI, NI = CFG::NI;
    constexpr int STG = A_RES ? CFG::B_BYTES : CFG::STAGE, BOFF = A_RES ? 0 : CFG::A_BYTES;
    const int tid = opaque_tid(), lane = tid & 63, wid = tid >> 6;
    const int wm = wid / CFG::WN, wn = wid % CFG::WN;
    const int l31 = lane & 31, lh = lane >> 5;
    if (!A_RES) { al[0].load(0); } bl[0].load(0);
    if (!A_RES) { al[1].load(64); } bl[1].load(64);
    const int a_off = (wm * CFG::TM + l31) * LROW;
    const int b_off = BOFF + (wn * CFG::TN + l31) * LROW;
    const int fsw = swz(l31);
    for (int kt = 0; kt < nk; kt += 2) {
#pragma unroll
        for (int u = 0; u < 2; ++u) {
            unsigned char* st = stages + u * STG;
            if (!A_RES) al[u].store(st);
            bl[u].store(st + BOFF);
            __syncthreads();
            if (kt + u + 2 < nk) { if (!A_RES) al[u].load((kt + u + 2) * 64); bl[u].load((kt + u + 2) * 64); }
            const unsigned char* ab = A_RES ? ares + (size_t)((kt + u + ARES_ROT) & 3) * (CFG::BM * LROW) : st;
#pragma unroll
            for (int kk = 0; kk < 4; ++kk) {
                bf16x8 a[MI], b[NI];
#pragma unroll
                for (int mi = 0; mi < MI; ++mi) a[mi] = *(const bf16x8*)(ab + a_off + mi * 32 * LROW + (((kk * 2 + lh) ^ fsw) << 4));
#pragma unroll
                for (int ni = 0; ni < NI; ++ni) b[ni] = *(const bf16x8*)(st + b_off + ni * 32 * LROW + (((kk * 2 + lh) ^ fsw) << 4));
#pragma unroll
                for (int mi = 0; mi < MI; ++mi)
#pragma unroll
                    for (int ni = 0; ni < NI; ++ni)
                        acc[mi][ni] = __builtin_amdgcn_mfma_f32_32x32x16_bf16(a[mi], b[ni], acc[mi][ni], 0, 0, 0);
            }
        }
    }
    __syncthreads();
}
template <class CFG> __device__ __forceinline__ void acc_zero(f32x16 (&acc)[CFG::MI][CFG::NI]) {
#pragma unroll
    for (int mi = 0; mi < CFG::MI; ++mi)
#pragma unroll
        for (int ni = 0; ni < CFG::NI; ++ni)
#pragma unroll
            for (int r = 0; r < 16; ++r) acc[mi][ni][r] = 0.f;
}
template <class CFG, class F> __device__ __forceinline__ void acc_foreach(f32x16 (&acc)[CFG::MI][CFG::NI], F f) {
    const int tid = opaque_tid(), lane = tid & 63, wid = tid >> 6;
    const int wm = wid / CFG::WN, wn = wid % CFG::WN;
#pragma unroll
    for (int mi = 0; mi < CFG::MI; ++mi)
#pragma unroll
        for (int ni = 0; ni < CFG::NI; ++ni) {
            asm volatile("" ::: "memory");
#pragma unroll
            for (int r = 0; r < 16; ++r)
                acc[mi][ni][r] = f(wm * CFG::TM + mi * 32 + (r & 3) + 8 * (r >> 2) + 4 * (lane >> 5), wn * CFG::TN + ni * 32 + (lane & 31), acc[mi][ni][r], mi, ni, r);
        }
}

struct TileMap {
    int ntm, ntn, npm, npn, rounds; bool patched;
    int pm, pn;
    __device__ __forceinline__ void init(int ntm_, int ntn_) {
        ntm = ntm_; ntn = ntn_; patched = (gridDim.x == 256);
        pn = ntn >= 8 ? 8 : ntn >= 4 ? 4 : ntn >= 2 ? 2 : 1; pm = 32 / pn;
        if (patched) { npm = (ntm + pm - 1) / pm; npn = (ntn + pn - 1) / pn; rounds = (npm * npn + 7) / 8; }
        else { int G = gridDim.x; asm volatile("" : "+s"(G)); npm = npn = 0; rounds = (ntm * ntn + G - 1) / G; }
    }
    __device__ __forceinline__ bool get(int round, int& tm, int& tn) const {
        const int b = blockIdx.x;
        if (patched) {
            const int patch = round * 8 + (b & 7), slot = b >> 3;
            if (patch >= npm * npn) return false;
            tm = (patch / npn) * pm + slot / pn; tn = (patch % npn) * pn + slot % pn;
            return tm < ntm && tn < ntn;
        }
        const int t = round * gridDim.x + b;
        if (t >= ntm * ntn) return false;
        tm = t / ntn; tn = t % ntn; return true;
    }
};

template <class CM>
__device__ __forceinline__ void transpose_convert(const float* W, int K, int N, int NP, bf16_t* Wt, float* sm, CM cmap) {
    const int tid = opaque_tid(), ntk = K / 64, ntn = NP / 64;
    for (int tile = blockIdx.x; tile < ntk * ntn; tile += gridDim.x) {
        const int tk = tile % ntk, tn = tile / ntk;
#pragma unroll
        for (int i = 0; i < 8; ++i) {
            const int e = tid + i * NT, kk = e >> 6, nn = e & 63, col = cmap(tn * 64 + nn);
            sm[nn * 65 + kk] = col >= 0 ? W[(size_t)(tk * 64 + kk) * N + col] : 0.f;
        }
        __syncthreads();
        const int n = tid >> 3, kc = tid & 7;
        const float* r = sm + n * 65 + kc * 8;
        uint4 o; o.x = pk_bf16(r[0], r[1]); o.y = pk_bf16(r[2], r[3]); o.z = pk_bf16(r[4], r[5]); o.w = pk_bf16(r[6], r[7]);
        *(uint4*)(Wt + (size_t)(tn * 64 + n) * K + tk * 64 + kc * 8) = o;
        __syncthreads();
    }
}
__device__ __forceinline__ void convert_bf16(const float* src, bf16_t* dst, size_t n) {
    const size_t gtid = (size_t)blockIdx.x * NT + opaque_tid(), gsz = (size_t)gridDim.x * NT;
    for (size_t i = gtid; i < n / 8; i += gsz) {
        const float4 a = ((const float4*)src)[2 * i], b = ((const float4*)src)[2 * i + 1];
        uint4 o; o.x = pk_bf16(a.x, a.y); o.y = pk_bf16(a.z, a.w); o.z = pk_bf16(b.x, b.y); o.w = pk_bf16(b.z, b.w);
        ((uint4*)dst)[i] = o;
    }
}

__device__ __forceinline__ void phase_inproj(const Params& p, unsigned char* lds) {
    typedef GemmCfg<256, 256, 2, 4> CFG;
    TileMap tmap; tmap.init(T / 256, PWP / 256);
    for (int round = 0; round < tmap.rounds; ++round) {
        int tm, tn;
        if (!tmap.get(round, tm, tn)) continue;
        LoadRowsBf16<256> al, bl;
        al.init(p.xb, D, [&](int r) { return (long long)(tm * 256 + r); });
        bl.init(p.w_in_t, D, [&](int r) { return (long long)(tn * 256 + r); });
        f32x16 acc[CFG::MI][CFG::NI];
        acc_zero<CFG>(acc);
        gemm_mainloop<CFG>(al, bl, D / 64, acc, lds);
        asm volatile("" : "+s"(tm), "+s"(tn));
        if (tn == 12 || tn == 13) {
            const int tid = opaque_tid(), lane = tid & 63, wid = tid >> 6, wm = wid / CFG::WN, wn = wid % CFG::WN, l31 = lane & 31, lh = lane >> 5;
#pragma unroll
            for (int mi = 0; mi < CFG::MI; ++mi)
#pragma unroll
                for (int ni = 0; ni < CFG::NI; ++ni) {
                    const int svcol = (tn - 12) * 256 + wn * CFG::TN + ni * 32 + l31, hh = svcol >> 6, d = svcol & 63;
                    const int tok0 = tm * 256 + wm * CFG::TM + mi * 32, bb = tok0 >> 11, key0 = tok0 & (SEQ - 1);
                    bf16_t* dst = p.vT + ((size_t)((bb * 8 + hh) * 64 + d)) * SEQ + key0;
#pragma unroll
                    for (int g = 0; g < 4; ++g) {
                        uint2 o; o.x = pk_bf16(acc[mi][ni][4 * g], acc[mi][ni][4 * g + 1]); o.y = pk_bf16(acc[mi][ni][4 * g + 2], acc[mi][ni][4 * g + 3]);
                        *(uint2*)(dst + 16 * (g >> 1) + 8 * lh + 4 * (g & 1)) = o;
                    }
                }
        } else if (tn >= 14 && tn < 22) {
            const int tid = opaque_tid(), lane = tid & 63, wid = tid >> 6, wm = wid / CFG::WN, wn = wid % CFG::WN;
            bf16_t* gbuf = tn < 18 ? p.gab : p.gbb;
            const int tnl = tn < 18 ? tn - 14 : tn - 18;
#pragma unroll
            for (int mi = 0; mi < CFG::MI; ++mi)
#pragma unroll
                for (int ni = 0; ni < CFG::NI; ++ni) {
                    const int rb = tm * 8 + wm * 4 + mi, cb = tnl * 8 + wn * 2 + ni;
                    unsigned w[8];
#pragma unroll
                    for (int i = 0; i < 8; ++i) w[i] = pk_bf16(sigmoidf_(acc[mi][ni][2 * i]), sigmoidf_(acc[mi][ni][2 * i + 1]));
                    uint4* dstv = (uint4*)(gbuf + ((size_t)(rb * 32 + cb) * 64 + lane) * 16);
                    dstv[0] = make_uint4(w[0], w[1], w[2], w[3]); dstv[1] = make_uint4(w[4], w[5], w[6], w[7]);
                }
        } else if (tn == 22) {
            acc_foreach<CFG>(acc, [&](int r, int c, float v, int, int, int) {
                if (c < 8) p.small[(size_t)(tm * 256 + r) * 8 + c] = v;
                return v;
            });
        } else {
            bf16_t* dst; int ld, c0; float sc = 1.f;
            if (tn < 6) { dst = p.qkvraw; ld = 1536; c0 = tn * 256; }
            else if (tn < 8) { dst = p.dzb; ld = 512; c0 = (tn - 6) * 256; }
            else if (tn < 10) { dst = p.sq; ld = 512; c0 = (tn - 8) * 256; sc = 0.125f * 1.4426950408889634f; }
            else if (tn < 12) { dst = p.sk; ld = 512; c0 = (tn - 10) * 256; }
            else { dst = nullptr; ld = 0; c0 = 0; }
            acc_foreach<CFG>(acc, [&](int r, int c, float v, int, int, int) {
                dst[(size_t)(tm * 256 + r) * ld + c0 + c] = to_bf16(v * sc);
                return v;
            });
        }
    }
}

__device__ __forceinline__ void load_gate16(const bf16_t* gbuf, int rb, int cb, int lane, float (&g)[16]) {
    const uint4* src = (const uint4*)(gbuf + ((size_t)(rb * 32 + cb) * 64 + lane) * 16);
    const uint4 a = src[0], b = src[1];
    const unsigned u[8] = {a.x, a.y, a.z, a.w, b.x, b.y, b.z, b.w};
#pragma unroll
    for (int i = 0; i < 8; ++i) { g[2 * i] = __uint_as_float(u[i] << 16); g[2 * i + 1] = __uint_as_float(u[i] & 0xffff0000u); }
}
__device__ __forceinline__ void phase_merge(const Params& p, unsigned char* lds) {
    typedef GemmCfg<128, 256, 2, 4> CFG;
    TileMap tmap; tmap.init(T / 128, D / 256);
    for (int round = 0; round < tmap.rounds; ++round) {
        int tm, tn;
        if (!tmap.get(round, tm, tn)) continue;
        f32x16 acc[CFG::MI][CFG::NI];
        {
            LoadRowsBf16<128> al; LoadRowsBf16<256> bl;
            al.init(p.oab, DNW, [&](int r) { return (long long)(tm * 128 + r); });
            bl.init(p.w_pa_t, DNW, [&](int r) { return (long long)(tn * 256 + r); });
            acc_zero<CFG>(acc);
            gemm_mainloop<CFG>(al, bl, DNW / 64, acc, lds);
            asm volatile("" : "+s"(tm), "+s"(tn));
        }
        {
            const int tid = opaque_tid(), lane = tid & 63, wid = tid >> 6, wm = wid / CFG::WN, wn = wid % CFG::WN;
#pragma unroll
            for (int mi = 0; mi < CFG::MI; ++mi)
#pragma unroll
                for (int ni = 0; ni < CFG::NI; ++ni) {
                    float ga[16], gb[16];
                    load_gate16(p.gab, tm * 4 + wm * 2 + mi, tn * 8 + wn * 2 + ni, lane, ga);
                    load_gate16(p.gbb, tm * 4 + wm * 2 + mi, tn * 8 + wn * 2 + ni, lane, gb);
#pragma unroll
                    for (int r = 0; r < 16; ++r) acc[mi][ni][r] *= ga[r] / fmaxf(gb[r], 1e-30f);
                }
        }
        {
            LoadRowsBf16<128> al; LoadRowsBf16<256> bl;
            al.init(p.obb, SBW, [&](int r) { return (long long)(tm * 128 + r); });
            bl.init(p.w_pb_t, SBW, [&](int r) { return (long long)(tn * 256 + r); });
            gemm_mainloop<CFG>(al, bl, SBW / 64, acc, lds);
            asm volatile("" : "+s"(tm), "+s"(tn));
        }
        {
            const int tid = opaque_tid(), lane = tid & 63, wid = tid >> 6, wm = wid / CFG::WN, wn = wid % CFG::WN;
#pragma unroll
            for (int mi = 0; mi < CFG::MI; ++mi)
#pragma unroll
                for (int ni = 0; ni < CFG::NI; ++ni) {
                    float gb[16];
                    load_gate16(p.gbb, tm * 4 + wm * 2 + mi, tn * 8 + wn * 2 + ni, lane, gb);
                    bf16_t* dst = p.mergedb + (size_t)(tm * 128 + wm * CFG::TM + mi * 32 + 4 * (lane >> 5)) * D + tn * 256 + wn * CFG::TN + ni * 32 + (lane & 31);
#pragma unroll
                    for (int r = 0; r < 16; ++r) dst[(size_t)((r & 3) + 8 * (r >> 2)) * D] = to_bf16(acc[mi][ni][r] * fmaxf(gb[r], 1e-30f));
                }
        }
    }
}

__device__ __forceinline__ void phase_outproj(const Params& p, unsigned char* lds) {
    typedef GemmCfg<256, 256, 2, 4> CFG;
    TileMap tmap; tmap.init(T / 256, D / 256);
    for (int round = 0; round < tmap.rounds; ++round) {
        int tm, tn;
        if (!tmap.get(round, tm, tn)) continue;
        LoadRowsBf16<256> al, bl;
        al.init(p.mergedb, D, [&](int r) { return (long long)(tm * 256 + r); });
        bl.init(p.w_out_t, D, [&](int r) { return (long long)(tn * 256 + r); });
        f32x16 acc[CFG::MI][CFG::NI];
        acc_zero<CFG>(acc);
        gemm_mainloop<CFG>(al, bl, D / 64, acc, lds);
        asm volatile("" : "+s"(tm), "+s"(tn));
        acc_foreach<CFG>(acc, [&](int r, int c, float v, int, int, int) {
            const size_t o = (size_t)(tm * 256 + r) * D + tn * 256 + c;
            p.pre1[o] = v + ALPHA * p.x[o];
            return v;
        });
    }
}

__device__ __forceinline__ void phase_router_shared_up(const Params& p, unsigned char* lds) {
    {
        typedef GemmCfg<128, 128, 4, 2> CFG;
        TileMap tmap; tmap.init(T / 128, NE / 128);
        for (int round = 0; round < tmap.rounds; ++round) {
            int tm, tn;
            if (!tmap.get(round, tm, tn)) continue;
            LoadRowsBf16<128> al, bl;
            al.init(p.hb, D, [&](int r) { return (long long)(tm * 128 + r); });
            bl.init(p.w_router_t, D, [&](int r) { return (long long)(tn * 128 + r); });
            f32x16 acc[CFG::MI][CFG::NI];
            acc_zero<CFG>(acc);
            gemm_mainloop<CFG>(al, bl, D / 64, acc, lds);
            asm volatile("" : "+s"(tm), "+s"(tn));
            acc_foreach<CFG>(acc, [&](int r, int c, float v, int, int, int) {
                p.scores[(size_t)(tm * 128 + r) * NE + tn * 128 + c] = sigmoidf_(v);
                return v;
            });
        }
    }
    {
        typedef GemmCfg<128, 256, 2, 4> CFG;
        TileMap tmap; tmap.init(T / 128, SFF / 128);
        for (int round = 0; round < tmap.rounds; ++round) {
            int tm, tn;
            if (!tmap.get(round, tm, tn)) continue;
            LoadRowsBf16<128> al; LoadRowsBf16<256> bl;
            al.init(p.hb, D, [&](int r) { return (long long)(tm * 128 + r); });
            bl.init(p.w_su_t, D, [&](int r) { return (long long)(((r >> 5) & 1) * SFF + tn * 128 + (r >> 6) * 32 + (r & 31)); });
            f32x16 acc[CFG::MI][CFG::NI];
            acc_zero<CFG>(acc);
            gemm_mainloop<CFG>(al, bl, D / 64, acc, lds);
            asm volatile("" : "+s"(tm), "+s"(tn));
            const int tid = opaque_tid(), lane = tid & 63, wid = tid >> 6, wm = wid / CFG::WN, wn = wid % CFG::WN;
#pragma unroll
            for (int mi = 0; mi < CFG::MI; ++mi)
#pragma unroll
                for (int r = 0; r < 16; ++r) {
                    const int row = tm * 128 + wm * CFG::TM + mi * 32 + (r & 3) + 8 * (r >> 2) + 4 * (lane >> 5);
                    const int j = tn * 128 + wn * 32 + (lane & 31);
                    const float g = acc[mi][0][r], u = acc[mi][1][r];
                    p.actsh[(size_t)row * SFF + j] = to_bf16(siluf_(g) * u);
                }
        }
    }
}

__device__ __forceinline__ void phase_shared_down(const Params& p, unsigned char* lds) {
    typedef GemmCfg<256, 256, 2, 4> CFG;
    TileMap tmap; tmap.init(T / 256, D / 256);
    for (int round = 0; round < tmap.rounds; ++round) {
        int tm, tn;
        if (!tmap.get(round, tm, tn)) continue;
        LoadRowsBf16<256> al, bl;
        al.init(p.actsh, SFF, [&](int r) { return (long long)(tm * 256 + r); });
        bl.init(p.w_sd_t, SFF, [&](int r) { return (long long)(tn * 256 + r); });
        f32x16 acc[CFG::MI][CFG::NI];
        acc_zero<CFG>(acc);
        gemm_mainloop<CFG>(al, bl, SFF / 64, acc, lds);
        asm volatile("" : "+s"(tm), "+s"(tn));
        acc_foreach<CFG>(acc, [&](int r, int c, float v, int, int, int) {
            p.ysh[(size_t)(tm * 256 + r) * D + tn * 256 + c] = v;
            return v;
        });
    }
}

__device__ __forceinline__ void phase_init(const Params& p) {
    const int gtid = blockIdx.x * NT + opaque_tid(), gsz = gridDim.x * NT;
    for (int i = gtid; i < 2 * NE * CSTRIDE; i += gsz) p.counts[i] = 0;
}

__device__ __forceinline__ void sb_attn_wave(const Params& p, int bh, int qt) {
    const int lane = opaque_tid() & 63, l31 = lane & 31, lh = lane >> 5;
    const int b = bh >> 3, hh = bh & 7;
    bf16x8 qf[4];
    {
        const bf16_t* qrow = p.sq + (size_t)(b * SEQ + qt * 32 + l31) * SBW + hh * 64 + lh * 8;
#pragma unroll
        for (int ks = 0; ks < 4; ++ks) qf[ks] = *(const bf16x8*)(qrow + ks * 16);
    }
    f32x16 o0, o1;
#pragma unroll
    for (int r = 0; r < 16; ++r) { o0[r] = 0.f; o1[r] = 0.f; }
    float run = 0.f;
    const bf16_t* vbase = p.vT + ((size_t)(bh * 64 + l31)) * SEQ + lh * 8;
    for (int kt = qt; kt >= 0; --kt) {
        const bf16_t* krow = p.sk + (size_t)(b * SEQ + kt * 32 + l31) * SBW + hh * 64 + lh * 8;
        bf16x8 kf[4];
#pragma unroll
        for (int ks = 0; ks < 4; ++ks) kf[ks] = *(const bf16x8*)(krow + ks * 16);
        bf16x8 vf[2][2];
#pragma unroll
        for (int md = 0; md < 2; ++md)
#pragma unroll
            for (int ss = 0; ss < 2; ++ss) vf[md][ss] = *(const bf16x8*)(vbase + (size_t)md * 32 * SEQ + kt * 32 + ss * 16);
        f32x16 sc;
#pragma unroll
        for (int r = 0; r < 16; ++r) sc[r] = 0.f;
#pragma unroll
        for (int ks = 0; ks < 4; ++ks) sc = __builtin_amdgcn_mfma_f32_32x32x16_bf16(kf[ks], qf[ks], sc, 0, 0, 0);
        float lb[16], lr[16];
        const bool diag = (kt == qt);
#pragma unroll
        for (int r = 0; r < 16; ++r) {
            const float z = sc[r];
            const float l = __builtin_amdgcn_logf(1.f + __builtin_amdgcn_exp2f(-fabsf(z)));
            float b_ = fminf(z, 0.f) - l, r_ = b_ - z;
            if (diag) { const bool valid = ((r & 3) + 8 * (r >> 2) + 4 * lh) < l31; r_ = valid ? r_ : 0.f; b_ = valid ? b_ : -INFINITY; }
            lb[r] = b_; lr[r] = r_;
        }
        float ex[16], B[4];
#pragma unroll
        for (int g = 0; g < 4; ++g) {
            ex[4 * g + 3] = 0.f;
            ex[4 * g + 2] = lr[4 * g + 3];
            ex[4 * g + 1] = ex[4 * g + 2] + lr[4 * g + 2];
            ex[4 * g + 0] = ex[4 * g + 1] + lr[4 * g + 1];
            B[g] = ex[4 * g + 0] + lr[4 * g + 0];
        }
        float P[4];
#pragma unroll
        for (int g = 0; g < 4; ++g) P[g] = __shfl_xor(B[g], 32);
        float off[4];
        {
            const float p3 = P[3], p2 = P[2] + p3, p1 = P[1] + p2, p0 = P[0] + p1;
            const float b3 = 0.f, b2 = B[3], b1 = B[2] + b2, b0 = B[1] + b1;
            off[0] = b0 + (lh ? p1 : p0);
            off[1] = b1 + (lh ? p2 : p1);
            off[2] = b2 + (lh ? p3 : p2);
            off[3] = b3 + (lh ? 0.f : p3);
            const float total = (B[0] + b0) + p0;
#pragma unroll
            for (int g = 0; g < 4; ++g) off[g] += run;
            run += total;
        }
        float a[16];
#pragma unroll
        for (int r = 0; r < 16; ++r) a[r] = __builtin_amdgcn_exp2f(lb[r] + ex[r] + off[r >> 2]);
        bf16x8 pf[2];
#pragma unroll
        for (int ss = 0; ss < 2; ++ss) {
            typedef unsigned u32x4 __attribute__((ext_vector_type(4)));
            u32x4 w;
            w[0] = pk_bf16(a[8 * ss + 0], a[8 * ss + 1]); w[1] = pk_bf16(a[8 * ss + 2], a[8 * ss + 3]);
            w[2] = pk_bf16(a[8 * ss + 4], a[8 * ss + 5]); w[3] = pk_bf16(a[8 * ss + 6], a[8 * ss + 7]);
            pf[ss] = __builtin_bit_cast(bf16x8, w);
        }
#pragma unroll
        for (int ss = 0; ss < 2; ++ss) {
            o0 = __builtin_amdgcn_mfma_f32_32x32x16_bf16(vf[0][ss], pf[ss], o0, 0, 0, 0);
            o1 = __builtin_amdgcn_mfma_f32_32x32x16_bf16(vf[1][ss], pf[ss], o1, 0, 0, 0);
        }
        if (__all(run < -160.f)) break;
    }
    bf16_t* orow = p.obb + (size_t)(b * SEQ + qt * 32 + l31) * SBW + hh * 64 + 4 * lh;
#pragma unroll
    for (int g = 0; g < 4; ++g) {
        uint2 w0, w1;
        w0.x = pk_bf16(o0[4 * g], o0[4 * g + 1]); w0.y = pk_bf16(o0[4 * g + 2], o0[4 * g + 3]);
        w1.x = pk_bf16(o1[4 * g], o1[4 * g + 1]); w1.y = pk_bf16(o1[4 * g + 2], o1[4 * g + 3]);
        *(uint2*)(orow + 8 * g) = w0;
        *(uint2*)(orow + 32 + 8 * g) = w1;
    }
}


constexpr int DN_RW = 0, DN_RQ = 128, DN_RAT = 256, DN_RKD = 320;
constexpr float LOG2E = 1.4426950408889634f;
__device__ __forceinline__ int pi16(int x) { return (x & ~12) | ((x & 4) << 1) | ((x & 8) >> 1); }
__device__ __forceinline__ uint4 pack8(const float* v) { uint4 o; o.x = pk_bf16(v[0], v[1]); o.y = pk_bf16(v[2], v[3]); o.z = pk_bf16(v[4], v[5]); o.w = pk_bf16(v[6], v[7]); return o; }

__device__ __forceinline__ void dn_chunk_item(const Params& p, int item, unsigned char* lds) {
    const int tid = opaque_tid(), lane = tid & 63, wid = tid >> 6;
    const int bh = item >> 5, n = item & 31, b = bh >> 2, hh = bh & 3;
    const int t0 = b * SEQ + n * 64;
    unsigned char* Kimg = lds; unsigned char* KBimg = lds + 16384; unsigned char* Qimg = lds + 32768;
    float* Vf = (float*)(lds + 49152); float* KBGf = (float*)(lds + 81920); float* MT = (float*)(lds + 114688);
    float* G2s = (float*)(lds + 114688 + 17408); float* betas = G2s + 64;
    bf16_t* blob = p.dnblob + (size_t)item * DN_BLOB;
    if (wid == 0) {
        const int t = t0 + lane;
        const float da = p.small[(size_t)t * 8 + 4 + hh] + p.dt_bias[hh];
        const float sp = da > 20.f ? da : log1pf(expf(da));
        float g2 = -expf(p.a_log[hh]) * sp * LOG2E;
#pragma unroll
        for (int off = 1; off < 64; off <<= 1) { const float v = __shfl_up(g2, off); if (lane >= off) g2 += v; }
        G2s[lane] = g2; betas[lane] = sigmoidf_(p.small[(size_t)t * 8 + hh]);
        if (lane == 63) p.dnlast[item] = exp2f(g2);
    }
    __syncthreads();
    {
        const int c8 = tid & 15, tq = tid >> 4, j0 = tq * 2;
        const float G0 = G2s[j0], G1 = G2s[j0 + 1], GL = G2s[63];
        const float be[2] = {betas[j0], betas[j0 + 1]};
        const float eg[2] = {exp2f(G0), exp2f(G1)}, el[2] = {exp2f(GL - G0), exp2f(GL - G1)};
        const int half = c8 >> 3, ch = c8 & 7;
#pragma unroll
        for (int type = 0; type < 3; ++type) {
            float o[2][8];
            {
                const bf16_t* src = p.qkvraw + (size_t)(t0 + j0 - 3) * 1536 + type * 512 + hh * 128 + c8 * 8;
                float x[5][8];
#pragma unroll
                for (int r = 0; r < 5; ++r) {
                    uint4 raw = make_uint4(0, 0, 0, 0);
                    if (n > 0 || j0 - 3 + r >= 0) raw = *(const uint4*)(src + (size_t)r * 1536);
                    const unsigned u[4] = {raw.x, raw.y, raw.z, raw.w};
#pragma unroll
                    for (int i = 0; i < 4; ++i) { x[r][2 * i] = __uint_as_float(u[i] << 16); x[r][2 * i + 1] = __uint_as_float(u[i] & 0xffff0000u); }
                }
                const float* wp = p.conv_w + type * 512 + hh * 128 + c8 * 8;
#pragma unroll
                for (int i = 0; i < 8; ++i) {
                    float a0 = 0.f, a1 = 0.f;
#pragma unroll
                    for (int tap = 0; tap < 4; ++tap) { const float w = wp[tap * 1536 + i]; a0 = fmaf(x[tap][i], w, a0); a1 = fmaf(x[tap + 1][i], w, a1); }
                    o[0][i] = siluf_(a0); o[1][i] = siluf_(a1);
                }
            }
            if (type < 2) {
#pragma unroll
                for (int tk = 0; tk < 2; ++tk) {
                    float ss = 0.f;
#pragma unroll
                    for (int i = 0; i < 8; ++i) ss = fmaf(o[tk][i], o[tk][i], ss);
                    ss += __shfl_xor(ss, 1); ss += __shfl_xor(ss, 2); ss += __shfl_xor(ss, 4); ss += __shfl_xor(ss, 8);
                    float r = rsqrtf(ss + NORM_EPS);
                    if (type == 0) r *= 0.08838834764831845f;
#pragma unroll
                    for (int i = 0; i < 8; ++i) o[tk][i] *= r;
                }
            }
#pragma unroll
            for (int tk = 0; tk < 2; ++tk) {
                const int j = j0 + tk;
                const int ioff = half * 8192 + j * 128 + ((ch ^ swz(j)) << 4);
                if (type == 0) {
                    *(uint4*)(Qimg + ioff) = pack8(o[tk]);
                    float qd[8];
#pragma unroll
                    for (int i = 0; i < 8; ++i) qd[i] = o[tk][i] * eg[tk];
                    bf16_t* qrow = blob + (size_t)(DN_RQ + half * 64 + j) * 64 + ((c8 >> 1) & 3) * 16 + 4 * (c8 & 1);
                    uint2 w0, w1; w0.x = pk_bf16(qd[0], qd[1]); w0.y = pk_bf16(qd[2], qd[3]); w1.x = pk_bf16(qd[4], qd[5]); w1.y = pk_bf16(qd[6], qd[7]);
                    *(uint2*)qrow = w0; *(uint2*)(qrow + 8) = w1;
                } else if (type == 1) {
                    float kb[8], kbg[8];
#pragma unroll
                    for (int i = 0; i < 8; ++i) { kb[i] = o[tk][i] * be[tk]; kbg[i] = kb[i] * eg[tk]; }
                    *(uint4*)(Kimg + ioff) = pack8(o[tk]);
                    *(uint4*)(KBimg + ioff) = pack8(kb);
                    f32x4* kd = (f32x4*)(KBGf + j * 128 + c8 * 8); kd[0] = (f32x4){kbg[0], kbg[1], kbg[2], kbg[3]}; kd[1] = (f32x4){kbg[4], kbg[5], kbg[6], kbg[7]};
                } else {
                    float vb[8];
#pragma unroll
                    for (int i = 0; i < 8; ++i) vb[i] = o[tk][i] * be[tk];
                    f32x4* vd = (f32x4*)(Vf + j * 128 + c8 * 8); vd[0] = (f32x4){vb[0], vb[1], vb[2], vb[3]}; vd[1] = (f32x4){vb[4], vb[5], vb[6], vb[7]};
                }
            }
            if (type == 1) {
                const int jp = (j0 & 48) | pi16(j0 & 15);
#pragma unroll
                for (int i = 0; i < 8; ++i)
                    *(unsigned*)(blob + (size_t)(DN_RKD + c8 * 8 + i) * 64 + jp) = pk_bf16(o[0][i] * el[0], o[1][i] * el[1]);
            }
            asm volatile("" ::: "memory");
        }
    }
    __syncthreads();
    {
        const int which = wid >> 2, ti = (wid >> 1) & 1, tj = wid & 1, l31 = lane & 31, lh = lane >> 5;
        if (!(ti == 0 && tj == 1)) {
            const unsigned char* Ab = (which == 0 ? KBimg : Qimg) + (ti * 32 + l31) * 128;
            const unsigned char* Bb = Kimg + (tj * 32 + l31) * 128;
            const int fsw = swz(l31);
            f32x16 acc;
#pragma unroll
            for (int r = 0; r < 16; ++r) acc[r] = 0.f;
#pragma unroll
            for (int ks = 0; ks < 8; ++ks) {
                const int off = (ks >> 2) * 8192 + ((((ks & 3) * 2 + lh) ^ fsw) << 4);
                acc = __builtin_amdgcn_mfma_f32_32x32x16_bf16(*(const bf16x8*)(Ab + off), *(const bf16x8*)(Bb + off), acc, 0, 0, 0);
            }
            const int j = tj * 32 + l31;
            const float Gj = G2s[j];
#pragma unroll
            for (int r = 0; r < 16; ++r) {
                const int i = ti * 32 + (r & 3) + 8 * (r >> 2) + 4 * lh;
                const float v = acc[r] * exp2f(G2s[i] - Gj);
                if (which == 0) MT[j * 68 + i] = (i > j) ? v : 0.f;
                else blob[(size_t)(DN_RAT + i) * 64 + ((j & 48) | pi16(j & 15))] = to_bf16((i >= j) ? v : 0.f);
            }
        }
    }
    __syncthreads();
#ifndef NO_SOLVE
    if (tid < 256) {
        const int c = tid & 127;
        const float* rhs = (tid < 128 ? Vf : KBGf) + c;
        float y[64];
#pragma unroll
        for (int j = 0; j < 64; ++j) y[j] = rhs[j * 128];
#pragma unroll
        for (int j = 0; j < 63; ++j) {
            const float yj = y[j];
#pragma unroll
            for (int i4 = (j + 1) & ~3; i4 < 64; i4 += 4) {
                const f32x4 m = *(const f32x4*)(MT + j * 68 + i4);
#pragma unroll
                for (int u = 0; u < 4; ++u) if (i4 + u > j) y[i4 + u] = fmaf(-m[u], yj, y[i4 + u]);
            }
            asm volatile("" ::: "memory");
        }
        if (tid < 128) {
#pragma unroll
            for (int mi = 0; mi < 2; ++mi)
#pragma unroll
                for (int h = 0; h < 2; ++h) {
                    f32x4* dst = (f32x4*)(p.dnu + ((((size_t)item * 2 + mi) * 4 + (c >> 5)) * 64 + h * 32 + (c & 31)) * 16);
#pragma unroll
                    for (int g = 0; g < 4; ++g)
                        dst[g] = (f32x4){y[mi * 32 + 8 * g + 4 * h], y[mi * 32 + 8 * g + 4 * h + 1], y[mi * 32 + 8 * g + 4 * h + 2], y[mi * 32 + 8 * g + 4 * h + 3]};
                }
        } else {
            bf16_t* dst = blob + (size_t)(DN_RW + (c >> 6) * 64) * 64 + ((c & 48) | pi16(c & 15));
#pragma unroll
            for (int i = 0; i < 64; ++i) dst[(size_t)i * 64] = to_bf16(-y[i]);
        }
    }
#endif
    __syncthreads();
}

__device__ __forceinline__ void phase_dn_chunks(const Params& p, unsigned char* lds) {
    for (int item = blockIdx.x; item < NB * DNH * 32; item += gridDim.x) dn_chunk_item(p, item, lds);
}

__device__ __forceinline__ void dn_scan(const Params& p, int bh, unsigned char* lds) {
    const int tid = opaque_tid(), lane = tid & 63, wid = tid >> 6, l31 = lane & 31, lh = lane >> 5;
    const int b = bh >> 2, hh = bh & 3;
    const int fsw = swz(l31);
    auto copy_blob = [&](int n, unsigned char* dst) {
        const uint4* src = (const uint4*)(p.dnblob + (size_t)(bh * 32 + n) * DN_BLOB);
        const int lt = tid - 256;
#pragma unroll
        for (int k = 0; k < 14; ++k) {
            const int c = lt + k * 256, row = c >> 3, ch = c & 7;
            *(uint4*)(dst + row * 128 + ((ch ^ swz(row)) << 4)) = src[c];
        }
    };
    if (wid >= 4) copy_blob(0, lds);
    __syncthreads();
    f32x16 S[4];
#pragma unroll
    for (int t = 0; t < 4; ++t)
#pragma unroll
        for (int r = 0; r < 16; ++r) S[t][r] = 0.f;
    for (int n = 0; n < 32; ++n) {
        if (wid >= 4) {
            if (n + 1 < 32) copy_blob(n + 1, lds + ((n + 1) & 1) * (DN_ROWS * 128));
        } else {
            const unsigned char* buf = lds + (n & 1) * (DN_ROWS * 128);
            const int item = bh * 32 + n;
            f32x16 vn[2], oa[2];
#pragma unroll
            for (int mi = 0; mi < 2; ++mi) {
                vn[mi] = *(const f32x16*)(p.dnu + ((((size_t)item * 2 + mi) * 4 + wid) * 64 + lane) * 16);
#pragma unroll
                for (int r = 0; r < 16; ++r) oa[mi][r] = 0.f;
            }
            const float last = p.dnlast[item];
            typedef unsigned u32x4 __attribute__((ext_vector_type(4)));
            bf16x8 sb[4][2];
#pragma unroll
            for (int t = 0; t < 4; ++t)
#pragma unroll
                for (int ss = 0; ss < 2; ++ss) {
                    u32x4 w;
#pragma unroll
                    for (int q = 0; q < 4; ++q) w[q] = pk_bf16(S[t][8 * ss + 2 * q], S[t][8 * ss + 2 * q + 1]);
                    sb[t][ss] = __builtin_bit_cast(bf16x8, w);
                }
#pragma unroll
            for (int mi = 0; mi < 2; ++mi)
#pragma unroll
                for (int ks = 0; ks < 8; ++ks) {
                    const int off = ((ks >> 2) * 64 + mi * 32 + l31) * 128 + ((((ks & 3) * 2 + lh) ^ fsw) << 4);
                    vn[mi] = __builtin_amdgcn_mfma_f32_32x32x16_bf16(*(const bf16x8*)(buf + DN_RW * 128 + off), sb[ks >> 1][ks & 1], vn[mi], 0, 0, 0);
                    oa[mi] = __builtin_amdgcn_mfma_f32_32x32x16_bf16(*(const bf16x8*)(buf + DN_RQ * 128 + off), sb[ks >> 1][ks & 1], oa[mi], 0, 0, 0);
                }
            bf16x8 vb[2][2];
#pragma unroll
            for (int mj = 0; mj < 2; ++mj)
#pragma unroll
                for (int ss = 0; ss < 2; ++ss) {
                    u32x4 w;
#pragma unroll
                    for (int q = 0; q < 4; ++q) w[q] = pk_bf16(vn[mj][8 * ss + 2 * q], vn[mj][8 * ss + 2 * q + 1]);
                    vb[mj][ss] = __builtin_bit_cast(bf16x8, w);
                }
#pragma unroll
            for (int mi = 0; mi < 2; ++mi)
#pragma unroll
                for (int kj = 0; kj < 4; ++kj)
                    if ((kj >> 1) <= mi) {
                        const int off = (DN_RAT + mi * 32 + l31) * 128 + (((kj * 2 + lh) ^ fsw) << 4);
                        oa[mi] = __builtin_amdgcn_mfma_f32_32x32x16_bf16(*(const bf16x8*)(buf + off), vb[kj >> 1][kj & 1], oa[mi], 0, 0, 0);
                    }
#pragma unroll
            for (int t = 0; t < 4; ++t) {
#pragma unroll
                for (int r = 0; r < 16; ++r) S[t][r] *= last;
#pragma unroll
                for (int kj = 0; kj < 4; ++kj) {
                    const int off = (DN_RKD + t * 32 + l31) * 128 + (((kj * 2 + lh) ^ fsw) << 4);
                    S[t] = __builtin_amdgcn_mfma_f32_32x32x16_bf16(*(const bf16x8*)(buf + off), vb[kj >> 1][kj & 1], S[t], 0, 0, 0);
                }
            }
            float* orow = p.oraw + (size_t)(b * SEQ + n * 64) * DNW + hh * 128 + wid * 32 + l31;
#pragma unroll
            for (int mi = 0; mi < 2; ++mi)
#pragma unroll
                for (int r = 0; r < 16; ++r) orow[(size_t)(mi * 32 + (r & 3) + 8 * (r >> 2) + 4 * lh) * DNW] = oa[mi][r];
        }
        __syncthreads();
    }
}

__device__ __forceinline__ void phase_mixers(const Params& p, float* smem) {
    const int nscan = NB * DNH;
    if (gridDim.x >= 2 * nscan) {
#ifndef SKIP_SCAN
        if ((int)blockIdx.x < nscan) dn_scan(p, blockIdx.x, (unsigned char*)smem);
#endif
        if ((int)blockIdx.x < nscan) {}
        else
            for (int it = blockIdx.x - nscan; it < 512; it += gridDim.x - nscan) sb_attn_wave(p, it >> 3, (it & 7) * 8 + (opaque_tid() >> 6));
    } else {
#ifndef SKIP_SCAN
        for (int bh = blockIdx.x; bh < nscan; bh += gridDim.x) dn_scan(p, bh, (unsigned char*)smem);
#endif
        for (int it = blockIdx.x; it < 512; it += gridDim.x) sb_attn_wave(p, it >> 3, (it & 7) * 8 + (opaque_tid() >> 6));
    }
}

__device__ __forceinline__ void phase_gated_norm(const Params& p) {
    const int lane = opaque_tid() & 63, wave = (blockIdx.x * NT + opaque_tid()) >> 6, nw = (gridDim.x * NT) >> 6;
    for (int item = wave; item < T * 4; item += nw) {
        const int t = item >> 2, hh = item & 3;
        const size_t off = (size_t)t * DNW + hh * 128 + lane * 2;
        const float v0 = p.oraw[off], v1 = p.oraw[off + 1];
        const float ss = wave_sum(v0 * v0 + v1 * v1);
        const float r = rsqrtf(ss * (1.f / 128.f) + NORM_EPS);
        const float z0 = bf2f(p.dzb[(size_t)t * 512 + hh * 128 + lane * 2]), z1 = bf2f(p.dzb[(size_t)t * 512 + hh * 128 + lane * 2 + 1]);
        p.oab[off] = to_bf16(v0 * r * p.norm_g[lane * 2] * siluf_(z0));
        p.oab[off + 1] = to_bf16(v1 * r * p.norm_g[lane * 2 + 1] * siluf_(z1));
    }
}

template <class SF>
__device__ __forceinline__ void layer_norm_rows(SF sf, const float* g, const float* bb, float* dst, bf16_t* dstb) {
    const int lane = opaque_tid() & 63, wave = (blockIdx.x * NT + opaque_tid()) >> 6, nw = (gridDim.x * NT) >> 6;
    for (int t = wave; t < T; t += nw) {
        float v[16];
        float s = 0.f;
#pragma unroll
        for (int i = 0; i < 16; ++i) { v[i] = sf(t, lane + i * 64); s += v[i]; }
        const float mu = wave_sum(s) * (1.f / 1024.f);
        float q = 0.f;
#pragma unroll
        for (int i = 0; i < 16; ++i) { const float d = v[i] - mu; q += d * d; }
        const float rstd = rsqrtf(wave_sum(q) * (1.f / 1024.f) + LN_EPS);
#pragma unroll
        for (int i = 0; i < 16; ++i) { const int c = lane + i * 64; const float y = (v[i] - mu) * rstd * g[c] + bb[c]; dst[(size_t)t * D + c] = y; if (dstb) dstb[(size_t)t * D + c] = to_bf16(y); }
    }
}

__device__ __forceinline__ void phase_route(const Params& p, int* counts, int* explist, int* ldsw) {
    const int tid = opaque_tid(), lane = tid & 63;
    const int wave = (blockIdx.x * NT + tid) >> 6, nw = (gridDim.x * NT) >> 6;
    int* mye = ldsw + (tid >> 6) * 64;
    const f32x4 bias = *(const f32x4*)(p.router_bias + lane * 4);
    for (int t0 = wave; t0 < T; t0 += nw * 8) {
        f32x4 scs[8];
#pragma unroll
        for (int k = 0; k < 8; ++k) { const int t = t0 + k * nw; scs[k] = t < T ? *(const f32x4*)(p.scores + (size_t)t * NE + lane * 4) : (f32x4){0.f, 0.f, 0.f, 0.f}; }
#pragma unroll 1
        for (int k = 0; k < 8; ++k) {
            const int t = t0 + k * nw;
            if (t >= T) break;
            f32x4 sc = scs[0];
#pragma unroll
            for (int kk = 1; kk < 8; ++kk) sc = (k == kk) ? scs[kk] : sc;
            const float sel[4] = {sc[0] + bias[0], sc[1] + bias[1], sc[2] + bias[2], sc[3] + bias[3]};
            float m1 = fmaxf(sel[0], sel[1]), m2 = fminf(sel[0], sel[1]);
            m2 = fmaxf(m2, fminf(m1, sel[2])); m1 = fmaxf(m1, sel[2]);
            m2 = fmaxf(m2, fminf(m1, sel[3])); m1 = fmaxf(m1, sel[3]);
#pragma unroll
            for (int off = 1; off < 8; off <<= 1) {
                const float o1 = __shfl_xor(m1, off), o2 = __shfl_xor(m2, off);
                const float n2 = fmaxf(fminf(m1, o1), fmaxf(m2, o2));
                m1 = fmaxf(m1, o1); m2 = n2;
            }
            const float gs = m1 + m2;
            const int g = lane >> 3;
            int rank = 0;
#pragma unroll
            for (int gg = 0; gg < NG; ++gg) { const float og = __int_as_float(__builtin_amdgcn_readlane(__float_as_int(gs), gg * 8)); rank += (og > gs || (og == gs && gg < g)) ? 1 : 0; }
            const bool gsel = rank < TOPG;
            unsigned ku[4];
#pragma unroll
            for (int i = 0; i < 4; ++i) {
                const unsigned u = __float_as_uint(sel[i]);
                ku[i] = gsel ? ((u & 0x80000000u) ? ~u : (u | 0x80000000u)) : 0u;
            }
            unsigned v8 = 0u;
#pragma unroll 1
            for (int bit = 31; bit >= 0; --bit) {
                const unsigned cand = v8 | (1u << bit);
                const int c = __popcll(__ballot(ku[0] >= cand)) + __popcll(__ballot(ku[1] >= cand)) + __popcll(__ballot(ku[2] >= cand)) + __popcll(__ballot(ku[3] >= cand));
                if (c >= TOPK) v8 = cand;
            }
            int ngt = 0, eqlow = 0, sellow = 0;
            unsigned long long eqm[4];
#pragma unroll
            for (int i = 0; i < 4; ++i) { ngt += __popcll(__ballot(ku[i] > v8)); eqm[i] = __ballot(ku[i] == v8); }
            const int need = TOPK - ngt;
#pragma unroll
            for (int i = 0; i < 4; ++i) eqlow += __builtin_amdgcn_mbcnt_hi((unsigned)(eqm[i] >> 32), __builtin_amdgcn_mbcnt_lo((unsigned)eqm[i], 0u));
            bool selc[4]; int eqrank = eqlow;
#pragma unroll
            for (int i = 0; i < 4; ++i) {
                const bool eq = ku[i] == v8;
                selc[i] = (ku[i] > v8) || (eq && eqrank < need);
                eqrank += eq ? 1 : 0;
            }
            float part = 0.f;
#pragma unroll
            for (int i = 0; i < 4; ++i) {
                const unsigned long long sm = __ballot(selc[i]);
                part += selc[i] ? sc[i] : 0.f;
                sellow += __builtin_amdgcn_mbcnt_hi((unsigned)(sm >> 32), __builtin_amdgcn_mbcnt_lo((unsigned)sm, 0u));
            }
            const float wsum = wave_sum(part);
            int slot = sellow;
#pragma unroll
            for (int i = 0; i < 4; ++i)
                if (selc[i]) {
                    const int e = lane * 4 + i, pr = t * TOPK + slot;
                    p.gate[pr] = sc[i] / wsum * 2.5f;
                    mye[k * 8 + slot] = e;
                    ++slot;
                }
        }
        {
            const int k = lane >> 3, t = t0 + k * nw;
            if (t < T) {
                const int e = mye[lane], pos = atomicAdd(&counts[e * CSTRIDE], 1);
                explist[(size_t)e * ECAP + pos] = t * TOPK + (lane & 7);
            }
        }
    }
}

__device__ __forceinline__ void compute_pend(const Params& p, int* pend, int* cnt) {
    const int tid = opaque_tid();
    if (tid < 64) {
        int c[4], pc[4];
#pragma unroll
        for (int i = 0; i < 4; ++i) { c[i] = p.counts[(tid * 4 + i) * CSTRIDE]; cnt[tid * 4 + i] = c[i]; pc[i] = (c[i] + 127) / 128 * 128; }
        const int ssum = pc[0] + pc[1] + pc[2] + pc[3];
        int inc = ssum;
#pragma unroll
        for (int off = 1; off < 64; off <<= 1) { const int v = __shfl_up(inc, off); if (tid >= off) inc += v; }
        int run = inc - ssum;
#pragma unroll
        for (int i = 0; i < 4; ++i) { run += pc[i]; pend[tid * 4 + i] = run; }
    }
    __syncthreads();
}

__device__ __forceinline__ int expert_of_row(const int* pend, int row) {
    int lo = 0, hi = NE - 1;
    while (lo < hi) { const int mid = (lo + hi) >> 1; if (pend[mid] > row) hi = mid; else lo = mid + 1; }
    return lo;
}

__device__ __forceinline__ void phase_routed(const Params& p, int* pend, int* cnt, unsigned char* lds) {
    typedef GemmCfg<128, 256, 2, 4> CFG;
    compute_pend(p, pend, cnt);
    int* prs = (int*)(lds + 131072); float* gts = (float*)(lds + 131072 + 512);
    const bool grouped = (gridDim.x % 8) == 0;
    const int xg = grouped ? (blockIdx.x & 7) : 0, estep = grouped ? 8 : 1;
    const int nslots = grouped ? (gridDim.x >> 3) : gridDim.x;
    int widx = grouped ? (blockIdx.x >> 3) : blockIdx.x, tbase = 0;
    for (int e = xg; e < NE; e += estep) {
      const int ce = cnt[e], ntile = (ce + 127) >> 7;
      for (; widx < tbase + ntile; widx += nslots) {
        const int q0 = (widx - tbase) * 128;
        {
            const int tid = opaque_tid();
            if (tid < 128) {
                const int pr = (q0 + tid < ce) ? p.explist[(size_t)e * ECAP + q0 + tid] : -1;
                prs[tid] = pr; gts[tid] = pr >= 0 ? p.gate[pr] : 0.f;
            }
        }
        __syncthreads();
#pragma unroll 1
        for (int tn_ = 0; tn_ < 2 * RU; ++tn_) {
            const int tn = tn_ & 1;
            LoadRowsBf16<128, true> al[2]; LoadKNF32 bl[2];
#pragma unroll
            for (int u = 0; u < 2; ++u) {
                al[u].init(p.hb, D, [&](int r) { const int pr = prs[r]; return pr >= 0 ? (long long)(pr >> 3) : -1LL; });
                bl[u].init(p.w_eu + (size_t)e * D * (2 * EFF), 2 * EFF, [&](int r) { return ((r >> 5) & 1) * EFF + tn * 128 + (r >> 6) * 32 + (r & 31); });
            }
            f32x16 acc[CFG::MI][CFG::NI];
            acc_zero<CFG>(acc);
            gemm_mainloop2<CFG, false, 0>(al, bl, D / 64, acc, lds, nullptr);
            const int tid = opaque_tid(), lane = tid & 63, wid = tid >> 6, wm = wid / CFG::WN, wn = wid % CFG::WN;
            const int j = tn * 128 + wn * 32 + (lane & 31);
            unsigned char* img = lds + 65536 + (((j >> 6) + 2) & 3) * 16384 + (j & 7) * 2;
            const int jc = (j & 63) >> 3;
#pragma unroll
            for (int mi = 0; mi < CFG::MI; ++mi)
#pragma unroll
                for (int r = 0; r < 16; ++r) {
                    const int row = wm * CFG::TM + mi * 32 + (r & 3) + 8 * (r >> 2) + 4 * (lane >> 5);
                    *(bf16_t*)(img + row * 128 + ((jc ^ swz(row)) << 4)) = to_bf16(siluf_(acc[mi][0][r]) * acc[mi][1][r]);
                }
        }
        __syncthreads();
#pragma unroll 1
        for (int tn_ = 0; tn_ < 4 * RD; ++tn_) {
            const int tn = tn_ & 3;
            LoadRowsBf16<128> aldummy[2]; LoadKNF32 bl[2];
#pragma unroll
            for (int u = 0; u < 2; ++u) bl[u].init(p.w_ed + (size_t)e * EFF * D, D, [&](int r) { return tn * 256 + r; });
            f32x16 acc[CFG::MI][CFG::NI];
            acc_zero<CFG>(acc);
            gemm_mainloop2<CFG, true, 2>(aldummy, bl, EFF / 64, acc, lds, lds + 65536);
            acc_foreach<CFG>(acc, [&](int r, int c, float v, int, int, int) {
                const int pr = prs[r];
                if (pr >= 0) p.ypairb[(size_t)pr * D + tn * 256 + c] = to_bf16(v * gts[r]);
                return v;
            });
        }
        __syncthreads();
      }
      tbase += ntile;
    }
}

#ifndef R0
#define R0 1
#define R1 1
#define R2 1
#define R3 1
#define R4 1
#define R5 1
#define R6 1
#define R7 1
#define R8 1
#define R10 1
#define R11 1
#define R12 1
#endif

constexpr int LDS_MAIN = 133120;
__global__ void __launch_bounds__(NT) fwd_megakernel(KArgs ka) {
    const Params p(ka);
    __shared__ __attribute__((aligned(16))) unsigned char lds[LDS_MAIN + 2 * NE * 4 + 16];
    float* smem = (float*)lds;
    int* pend = (int*)(lds + LDS_MAIN);
    int* cnt = pend + NE;
    volatile LAS3 unsigned* xbst = (volatile LAS3 unsigned*)(lds + LDS_MAIN + 2 * NE * 4);
    if (threadIdx.x == 0) { xbst[0] = 0u; xbst[1] = 0u; }
    __syncthreads();
    const XcdBarrier xb = xcd_barrier_post(p.bar, xbst);

#define REPEAT(N, ...) { int reps_ = (N); asm volatile("" : "+s"(reps_)); for (int rep_ = 0; rep_ < reps_; ++rep_) { __VA_ARGS__; xcd_barrier(xb); } }
    phase_init(p);
    REPEAT(R0,
        convert_bf16(p.x, p.xb, (size_t)T * D);
        transpose_convert(p.w_in, D, PW, PWP, p.w_in_t, smem, [](int n) { return n < 2048 ? n : n < 5632 ? n + 8 : n < 5640 ? n - 5632 + 2048 : -1; });
        transpose_convert(p.w_pa, DNW, D, D, p.w_pa_t, smem, [](int n) { return n; });
        transpose_convert(p.w_pb, SBW, D, D, p.w_pb_t, smem, [](int n) { return n; });
        transpose_convert(p.w_out, D, D, D, p.w_out_t, smem, [](int n) { return n; });
        transpose_convert(p.w_router, D, NE, NE, p.w_router_t, smem, [](int n) { return n; });
        transpose_convert(p.w_su, D, 2 * SFF, 2 * SFF, p.w_su_t, smem, [](int n) { return n; });
        transpose_convert(p.w_sd, SFF, D, D, p.w_sd_t, smem, [](int n) { return n; }))
    REPEAT(R1, phase_inproj(p, lds))
    REPEAT(R2, phase_dn_chunks(p, lds))
    REPEAT(R3, phase_mixers(p, smem))
    REPEAT(R4, phase_gated_norm(p))
    REPEAT(R5, phase_merge(p, lds))
    REPEAT(R6, phase_outproj(p, lds))
    REPEAT(R7, layer_norm_rows([&](int t, int c) { return p.pre1[(size_t)t * D + c]; }, p.ln1_g, p.ln1_b, p.h, p.hb))
    REPEAT(R8, phase_router_shared_up(p, lds))
    phase_route(p, p.counts, p.explist, (int*)lds);
    xcd_barrier(xb);
    { int reps9 = R9 - 1; asm volatile("" : "+s"(reps9)); for (int r9 = 0; r9 < reps9; ++r9) { phase_route(p, p.counts + NE * CSTRIDE, (int*)p.ypairb, (int*)lds); xcd_barrier(xb); } }
    { int repsb = RB; asm volatile("" : "+s"(repsb)); for (int rb = 0; rb < repsb; ++rb) xcd_barrier(xb); }
    REPEAT(R10, phase_routed(p, pend, cnt, lds); phase_shared_down(p, lds))
    int reps12 = R12; asm volatile("" : "+s"(reps12));
    for (int rep = 0; rep < reps12; ++rep)
        layer_norm_rows([&](int t, int c) {
                float f = p.ysh[(size_t)t * D + c];
#pragma unroll
                for (int k = 0; k < TOPK; ++k) f += bf2f(p.ypairb[((size_t)t * TOPK + k) * D + c]);
                return ALPHA * p.h[(size_t)t * D + c] + f; },
            p.ln2_g, p.ln2_b, p.out, nullptr);
}

extern "C" void kernel_launch(void* const* d_in, const int* in_sizes, int n_in, void* d_out, int out_size, void* d_ws,
                              size_t ws_size, hipStream_t stream) {
    static int grid_blocks = 0;
    if (!grid_blocks) {
        int dev = 0, cus = 0, per_cu = 0;
        hipGetDevice(&dev);
        hipDeviceGetAttribute(&cus, hipDeviceAttributeMultiprocessorCount, dev);
        hipOccupancyMaxActiveBlocksPerMultiprocessor(&per_cu, fwd_megakernel, NT, 0);
        if (per_cu > 1) per_cu = 1;
        grid_blocks = cus * per_cu;
    }
    KArgs p{};
    const float* const* in = (const float* const*)d_in;
    p.x = in[0]; p.w_in = in[1]; p.conv_w = in[2]; p.a_log = in[3]; p.dt_bias = in[4]; p.norm_g = in[5]; p.w_pa = in[6];
    p.w_pb = in[7]; p.w_out = in[8]; p.ln1_g = in[9]; p.ln1_b = in[10]; p.w_router = in[11]; p.router_bias = in[12];
    p.w_su = in[13]; p.w_sd = in[14]; p.w_eu = in[15]; p.w_ed = in[16]; p.ln2_g = in[17]; p.ln2_b = in[18];
    p.out = (float*)d_out; p.ws = (unsigned char*)d_ws;
    if (WS_BYTES > ws_size) { fprintf(stderr, "workspace too small: need %zu have %zu\n", (size_t)WS_BYTES, ws_size); return; }
    hipMemsetAsync(p.ws + OFF_BAR, 0, XCD_BAR_WORDS * 4, stream);
    void* args[] = {&p};
    hipError_t e = hipLaunchCooperativeKernel((void*)fwd_megakernel, dim3(grid_blocks), dim3(NT), args, 0, stream);
    if (e != hipSuccess) fprintf(stderr, "cooperative launch failed: %s (grid %d)\n", hipGetErrorString(e), grid_blocks);
}
```

```cpp
#include <hip/hip_runtime.h>
#include <hip/hip_cooperative_groups.h>
#include <cstdio>
#include <cstdint>
namespace cg = cooperative_groups;

constexpr int D = 1024, NB = 8, SEQ = 2048, T = NB * SEQ;
constexpr int DNH = 4, DND = 128, DNW = 512;
constexpr int SBH = 8, SBD = 64, SBW = 512;
constexpr int NE = 256, TOPK = 8, NG = 8, TOPG = 4, EFF = 256, SFF = 256;
constexpr int PW = 5640;
constexpr int NPAIR = T * TOPK;
constexpr int NBLK = (NPAIR + NE * 127 + 127) / 128;
constexpr int PROWS = NBLK * 128;
constexpr float ALPHA = 1.189207115002721f;
constexpr float LN_EPS = 1e-5f, NORM_EPS = 1e-6f;
constexpr int NT = 512;
#ifndef RU
#define RU 1
#define RD 1
#define R9 1
#define RB 0
#endif

typedef unsigned short bf16_t;
constexpr int PWP = 5888;
constexpr int DN_ROWS = 448, DN_BLOB = DN_ROWS * 64;
constexpr int ECAP = T;
#define XCD_BAR_WORDS 3456
constexpr int CSTRIDE = 64;
constexpr size_t al256(size_t x) { return (x + 255) & ~(size_t)255; }
constexpr size_t OFF_XB = 0;
constexpr size_t OFF_WINT = OFF_XB + al256((size_t)T * D * 2);
constexpr size_t OFF_QKVRAW = OFF_WINT + al256((size_t)PWP * D * 2);
constexpr size_t OFF_DZB = OFF_QKVRAW + al256((size_t)T * 1536 * 2);
constexpr size_t OFF_SQ = OFF_DZB + al256((size_t)T * 512 * 2);
constexpr size_t OFF_SK = OFF_SQ + al256((size_t)T * 512 * 2);
constexpr size_t OFF_VT = OFF_SK + al256((size_t)T * 512 * 2);
constexpr size_t OFF_DNBLOB = OFF_VT + al256((size_t)T * 512 * 2);
constexpr size_t OFF_DNU = OFF_DNBLOB + al256((size_t)1024 * DN_BLOB * 2);
constexpr size_t OFF_DNLAST = OFF_DNU + al256((size_t)1024 * 64 * 128 * 4);
constexpr size_t OFF_GAB = OFF_DNLAST + al256(1024 * 4);
constexpr size_t OFF_GBB = OFF_GAB + al256((size_t)T * D * 2);
constexpr size_t OFF_SMALL = OFF_GBB + al256((size_t)T * D * 2);
constexpr size_t OFF_WPAT = OFF_SMALL + al256((size_t)T * 8 * 4);
constexpr size_t OFF_WPBT = OFF_WPAT + al256((size_t)D * DNW * 2);
constexpr size_t OFF_WOUTT = OFF_WPBT + al256((size_t)D * SBW * 2);
constexpr size_t OFF_WROUTT = OFF_WOUTT + al256((size_t)D * D * 2);
constexpr size_t OFF_WSUT = OFF_WROUTT + al256((size_t)NE * D * 2);
constexpr size_t OFF_WSDT = OFF_WSUT + al256((size_t)2 * SFF * D * 2);
constexpr size_t OFF_OAB = OFF_WSDT + al256((size_t)D * SFF * 2);
constexpr size_t OFF_OBB = OFF_OAB + al256((size_t)T * DNW * 2);
constexpr size_t OFF_MERGED = OFF_OBB + al256((size_t)T * SBW * 2);
constexpr size_t OFF_HB = OFF_MERGED + al256((size_t)T * D * 2);
constexpr size_t OFF_ACTSH = OFF_HB + al256((size_t)T * D * 2);
constexpr size_t OFF_YPAIRB = OFF_ACTSH + al256((size_t)T * SFF * 2);
constexpr size_t OFF_ORAW = OFF_YPAIRB + al256((size_t)NPAIR * D * 2);
constexpr size_t OFF_PRE1 = OFF_ORAW + al256((size_t)T * DNW * 4);
constexpr size_t OFF_H = OFF_PRE1 + al256((size_t)T * D * 4);
constexpr size_t OFF_SCORES = OFF_H + al256((size_t)T * D * 4);
constexpr size_t OFF_GATE = OFF_SCORES + al256((size_t)T * NE * 4);
constexpr size_t OFF_YSH = OFF_GATE + al256((size_t)NPAIR * 4);
constexpr size_t OFF_IDX = OFF_YSH + al256((size_t)T * D * 4);
constexpr size_t OFF_COUNTS = OFF_IDX + al256((size_t)NPAIR * 4);
constexpr size_t OFF_EXPLIST = OFF_COUNTS + al256(2 * NE * CSTRIDE * 4);
constexpr size_t OFF_WEUT = OFF_EXPLIST + al256((size_t)NE * ECAP * 4);
constexpr size_t OFF_M1 = OFF_WEUT + al256((size_t)NE * 2 * EFF * D * 2);
constexpr size_t OFF_BAR = OFF_M1 + al256((size_t)T * D * 4);
constexpr size_t WS_BYTES = OFF_BAR + al256(XCD_BAR_WORDS * 4);

struct KArgs {
    const float *x, *w_in, *conv_w, *a_log, *dt_bias, *norm_g, *w_pa, *w_pb, *w_out, *ln1_g, *ln1_b, *w_router,
        *router_bias, *w_su, *w_sd, *w_eu, *w_ed, *ln2_g, *ln2_b;
    float* out; unsigned char* ws;
};
struct Params {
    const float *x, *w_in, *conv_w, *a_log, *dt_bias, *norm_g, *w_pa, *w_pb, *w_out, *ln1_g, *ln1_b, *w_router,
        *router_bias, *w_su, *w_sd, *w_eu, *w_ed, *ln2_g, *ln2_b;
    float* out;
    float *oraw, *pre1, *h, *scores, *gate, *ysh, *small, *dnu, *dnlast, *m1;
    int *idx, *counts, *explist;
    bf16_t *xb, *w_in_t, *w_pa_t, *w_pb_t, *w_out_t, *w_router_t, *w_su_t, *w_sd_t, *oab, *obb, *mergedb, *hb, *actsh, *ypairb;
    bf16_t *qkvraw, *dzb, *sq, *sk, *vT, *gab, *gbb, *dnblob, *w_eu_t;
    unsigned* bar;
    __device__ __forceinline__ explicit Params(const KArgs& k) {
        x = k.x; w_in = k.w_in; conv_w = k.conv_w; a_log = k.a_log; dt_bias = k.dt_bias; norm_g = k.norm_g; w_pa = k.w_pa; w_pb = k.w_pb;
        w_out = k.w_out; ln1_g = k.ln1_g; ln1_b = k.ln1_b; w_router = k.w_router; router_bias = k.router_bias; w_su = k.w_su; w_sd = k.w_sd;
        w_eu = k.w_eu; w_ed = k.w_ed; ln2_g = k.ln2_g; ln2_b = k.ln2_b; out = k.out;
        unsigned char* w = k.ws; asm volatile("" : "+s"(w));
        xb = (bf16_t*)(w + OFF_XB); w_in_t = (bf16_t*)(w + OFF_WINT); qkvraw = (bf16_t*)(w + OFF_QKVRAW); dzb = (bf16_t*)(w + OFF_DZB);
        sq = (bf16_t*)(w + OFF_SQ); sk = (bf16_t*)(w + OFF_SK); vT = (bf16_t*)(w + OFF_VT); dnblob = (bf16_t*)(w + OFF_DNBLOB);
        dnu = (float*)(w + OFF_DNU); dnlast = (float*)(w + OFF_DNLAST); gab = (bf16_t*)(w + OFF_GAB); gbb = (bf16_t*)(w + OFF_GBB);
        small = (float*)(w + OFF_SMALL); w_pa_t = (bf16_t*)(w + OFF_WPAT); w_pb_t = (bf16_t*)(w + OFF_WPBT); w_out_t = (bf16_t*)(w + OFF_WOUTT);
        w_router_t = (bf16_t*)(w + OFF_WROUTT); w_su_t = (bf16_t*)(w + OFF_WSUT); w_sd_t = (bf16_t*)(w + OFF_WSDT);
        oab = (bf16_t*)(w + OFF_OAB); obb = (bf16_t*)(w + OFF_OBB); mergedb = (bf16_t*)(w + OFF_MERGED); hb = (bf16_t*)(w + OFF_HB);
        actsh = (bf16_t*)(w + OFF_ACTSH); ypairb = (bf16_t*)(w + OFF_YPAIRB); oraw = (float*)(w + OFF_ORAW); pre1 = (float*)(w + OFF_PRE1);
        h = (float*)(w + OFF_H); scores = (float*)(w + OFF_SCORES); gate = (float*)(w + OFF_GATE); ysh = (float*)(w + OFF_YSH);
        idx = (int*)(w + OFF_IDX); counts = (int*)(w + OFF_COUNTS); explist = (int*)(w + OFF_EXPLIST); bar = (unsigned*)(w + OFF_BAR); w_eu_t = (bf16_t*)(w + OFF_WEUT); m1 = (float*)(w + OFF_M1);
    }
};

__device__ __forceinline__ float sigmoidf_(float v) { return 1.f / (1.f + expf(-v)); }
__device__ __forceinline__ float siluf_(float v) { return v / (1.f + expf(-v)); }
__device__ __forceinline__ float shfl_lane(float v, int src) { return __int_as_float(__builtin_amdgcn_ds_bpermute(src << 2, __float_as_int(v))); }
__device__ __forceinline__ int shfl_lane_i(int v, int src) { return __builtin_amdgcn_ds_bpermute(src << 2, v); }
__device__ __forceinline__ float wave_sum(float v, int lane) {
#pragma unroll
    for (int o = 32; o > 0; o >>= 1) v += shfl_lane(v, lane ^ o);
    return v;
}


#define XB_TMO      128
#define XB_XCNT(j)  (256  + 64 * (j))
#define XB_XSUB(j)  (1280 + 64 * (j))
#define XB_XGEN(j)  (2304 + 64 * (j))
#define XB_TOP      3328
#define XB_TOPGEN   3392
#define XB_SPIN_CAP (1u << 24)
#define LAS3 __attribute__((address_space(3)))
__device__ __forceinline__ unsigned xb_ld(unsigned* p)              { return __hip_atomic_load(p, __ATOMIC_RELAXED, __HIP_MEMORY_SCOPE_AGENT); }
__device__ __forceinline__ unsigned xb_add(unsigned* p, unsigned v) { return __hip_atomic_fetch_add(p, v, __ATOMIC_RELAXED, __HIP_MEMORY_SCOPE_AGENT); }
__device__ __forceinline__ unsigned xb_xcc_id() { return (unsigned)__builtin_amdgcn_s_getreg((3 << 11) | 20) & 0xFu; }
#define XB_SPIN(cond, bar) do { unsigned _sp = 0; while (cond) { __builtin_amdgcn_s_sleep(1); \
    if ((++_sp & 255u) == 0u) { if (xb_ld(&(bar)[XB_TMO])) break; if (_sp > XB_SPIN_CAP) { atomicAdd(&(bar)[XB_TMO], 1u); break; } } } } while (0)
struct XcdBarrier { unsigned* bar; unsigned x; volatile LAS3 unsigned* st; };
__device__ __forceinline__ XcdBarrier xcd_barrier_post(unsigned* bar, volatile LAS3 unsigned* st) {
    XcdBarrier b; b.bar = bar; b.x = xb_xcc_id(); b.st = st;
    if (threadIdx.x == 0) (void)xb_add(&bar[XB_XCNT(b.x)], 1u);
    return b;
}
__device__ __forceinline__ void xcd_barrier_complete(unsigned* bar, unsigned x, unsigned& nloc, unsigned& nx) {
    const unsigned G = gridDim.x * gridDim.y * gridDim.z;
    unsigned sum, cnt, mine, sp = 0u;
    asm volatile("" : "+s"(x));
    for (;;) {
        sum = 0u; cnt = 0u; mine = 0u;
#pragma unroll 1
        for (unsigned j = 0; j < 16; ++j) { const unsigned c = xb_ld(&bar[XB_XCNT(j)]); sum += c; cnt += (c > 0u) ? 1u : 0u; mine = (j == x) ? c : mine; }
        if (sum == G) break;
        __builtin_amdgcn_s_sleep(1);
        if ((++sp & 255u) == 0u) { if (xb_ld(&bar[XB_TMO])) break; if (sp > XB_SPIN_CAP) { atomicAdd(&bar[XB_TMO], 1u); break; } }
    }
    nloc = mine > 0u ? mine : 1u; nx = cnt > 0u ? cnt : 1u;
}
__device__ __forceinline__ void xcd_barrier(const XcdBarrier& b) {
    asm volatile("s_waitcnt vmcnt(0)" ::: "memory");
    __syncthreads();
    if (threadIdx.x == 0) {
        unsigned* bar = b.bar;
        __builtin_amdgcn_s_waitcnt(0);
        unsigned nloc = b.st[0], nx = b.st[1];
        if (nloc == 0u) { xcd_barrier_complete(bar, b.x, nloc, nx); b.st[0] = nloc; b.st[1] = nx; }
        const unsigned old = xb_add(&bar[XB_XSUB(b.x)], 1u);
        const unsigned gen = old / nloc;
        if (old + 1u == (gen + 1u) * nloc) {
            __builtin_amdgcn_fence(__ATOMIC_RELEASE, "agent");
            asm volatile("s_waitcnt vmcnt(0)" ::: "memory");
            const unsigned og = xb_add(&bar[XB_TOP], 1u);
            const unsigned tg = og / nx;
            if (og + 1u == (tg + 1u) * nx) xb_add(&bar[XB_TOPGEN], 1u);
            else XB_SPIN(xb_ld(&bar[XB_TOPGEN]) == tg, bar);
            __builtin_amdgcn_fence(__ATOMIC_ACQUIRE, "agent");
            xb_add(&bar[XB_XGEN(b.x)], 1u);
            asm volatile("s_waitcnt vmcnt(0)" ::: "memory");
        } else {
            XB_SPIN(xb_ld(&bar[XB_XGEN(b.x)]) == gen, bar);
            __builtin_amdgcn_fence(__ATOMIC_ACQUIRE, "agent");
            asm volatile("s_waitcnt vmcnt(0)" ::: "memory");
        }
    }
    __syncthreads();
}

typedef short bf16x8 __attribute__((ext_vector_type(8)));
typedef float f32x16 __attribute__((ext_vector_type(16)));
typedef float f32x4 __attribute__((ext_vector_type(4)));
__device__ __forceinline__ unsigned pk_bf16(float a, float b) {
    typedef __bf16 bf2 __attribute__((ext_vector_type(2)));
    typedef float f2 __attribute__((ext_vector_type(2)));
    f2 v = {a, b};
    bf2 r = __builtin_convertvector(v, bf2);
    return __builtin_bit_cast(unsigned, r);
}
__device__ __forceinline__ bf16_t to_bf16(float a) { return (bf16_t)(pk_bf16(a, 0.f) & 0xffffu); }
__device__ __forceinline__ float bf2f(bf16_t v) { return __uint_as_float((unsigned)v << 16); }

__device__ __forceinline__ int opaque_tid() { int t = threadIdx.x; asm volatile("" : "+v"(t)); return t; }
constexpr int LROW = 128;
__device__ __forceinline__ int swz(int r) { return ((r >> 2) & 7) ^ ((r >> 1) & 1); }

template <int ROWS, bool MAYBE_NULL = false> struct LoadRowsBf16 {
    static constexpr int NCH = ROWS * 8 / NT;
    const bf16_t* base; int tid;
    unsigned off[NCH];
    uint4 regs[NCH];
    template <class RF> __device__ __forceinline__ void init(const bf16_t* base_, int ld, RF rowfn) {
        base = base_; tid = opaque_tid();
#pragma unroll
        for (int i = 0; i < NCH; ++i) {
            const int c = tid + i * NT, r = c >> 3, ch = c & 7;
            const long long src = rowfn(r);
            off[i] = (!MAYBE_NULL || src >= 0) ? (unsigned)(src * ld + ch * 8) : 0xffffffffu;
        }
    }
    __device__ __forceinline__ void load(int k0) {
#pragma unroll
        for (int i = 0; i < NCH; ++i)
            regs[i] = (!MAYBE_NULL || off[i] != 0xffffffffu) ? *(const uint4*)(base + (size_t)off[i] + k0) : make_uint4(0, 0, 0, 0);
    }
    __device__ __forceinline__ void store(unsigned char* lds) const {
#pragma unroll
        for (int i = 0; i < NCH; ++i) {
            const int c = tid + i * NT, r = c >> 3, ch = c & 7;
            *(uint4*)(lds + r * LROW + ((ch ^ swz(r)) << 4)) = regs[i];
        }
    }
};

__device__ __forceinline__ int pi16(int x) { return (x & ~12) | ((x & 4) << 1) | ((x & 8) >> 1); }
namespace pg8 {
#define PG8_LAS __attribute__((address_space(3)))
typedef unsigned short bf16_t;
typedef short bf16x8 __attribute__((ext_vector_type(8)));
typedef float f32x4 __attribute__((ext_vector_type(4)));
typedef unsigned u32x4 __attribute__((ext_vector_type(4)));
constexpr int BM = 256, BK = 64, HALF = 128, HTB = HALF * BK * 2  , STAGE_BYTES = 8 * HTB, NXCD = 8, WGM = 8;

__host__ __device__ __forceinline__ int lds_byte(int r, int c) { const int st = (r >> 4) * 2 + (c >> 5), rr = r & 15, cc = c & 31, ob = rr * 64 + cc * 2; return st * 1024 + (ob ^ (((ob >> 9) & 1) << 5)); }
__host__ __device__ __forceinline__ void stage_rc(int b, int& R, int& C) { const int st = b / 1024, sb = b % 1024, swz = sb ^ (((sb >> 9) & 1) << 5); R = (st >> 1) * 16 + swz / 64; C = (st & 1) * 32 + (swz % 64) / 2; }
__host__ __device__ __forceinline__ int perm32(int rho) { const int n = rho >> 4, i = rho & 15; return 8 * (i >> 2) + 4 * n + (i & 3); }

struct Unit { int pm, pn; };
struct Gemm { const bf16_t* A; const bf16_t* Bt; int M, N, K; };

struct StaticOrder {
    int nM, nN, nwg, G, c;
    __host__ __device__ void init(int M, int N, int G_, int c_) { nM = M / BM; nN = N / BM; nwg = nM * nN; G = G_; c = c_; }
    __host__ __device__ bool next(int i, Unit& u) const {
        const long L = (long)i * G + c; if (L >= nwg) return false;
        int wgid = (int)L; { const int q = nwg / NXCD, r = nwg % NXCD, xcd = wgid % NXCD, off = wgid / NXCD; wgid = (xcd < r ? xcd * (q + 1) : r * (q + 1) + (xcd - r) * q) + off; }
        const int nig = WGM * nN, gid = wgid / nig, fm = gid * WGM, gsz = (nM - fm) < WGM ? (nM - fm) : WGM;
        u.pm = fm + ((wgid % nig) % gsz); u.pn = (wgid % nig) / gsz; return true;
    }
    __device__ __forceinline__ void a_ready(const Unit&) const {}
    __device__ __forceinline__ void done(const Unit&) const {}
};


__device__ __forceinline__ unsigned cvt_pk_bf16(float lo, float hi) { unsigned r; asm volatile("v_cvt_pk_bf16_f32 %0, %1, %2" : "=v"(r) : "v"(lo), "v"(hi)); return r; }

template <class Epi, class Sched, bool ALIGN_EPI = false, bool SP2 = false>
__device__ __forceinline__ void gemm_phase(PG8_LAS unsigned char* lds, const Gemm g, const Sched& S, const Epi& E) {
    const int tid = opaque_tid(), wid = __builtin_amdgcn_readfirstlane(tid >> 6), lane = tid & 63, wr = wid >> 2, wc = wid & 3, fr = lane & 15, fq = lane >> 4;
    const int K = g.K, nt = K / BK;
    unsigned voffA[2], voffB[2];
#pragma unroll
    for (int i = 0; i < 2; ++i) { int R, C; stage_rc(tid * 16 + i * 8192, R, C); const int Rb = Epi::PERM ? ((R & ~31) + perm32(R & 31)) : R;
        voffA[i] = (unsigned)(R * K + C) * 2u; voffB[i] = (unsigned)(Rb * K + C) * 2u; }
    const size_t rstep64 = (size_t)64 * K * 2;
    const size_t kstep = (size_t)(BK * 2);
    const size_t hstep = (size_t)HALF * K * 2;
    const size_t tstep = 2 * hstep;
    const unsigned ldsw = (unsigned)wid * 1024u;
    const int aoff = lds_byte(wr * 64 + fr, fq * 8), boff = lds_byte(wc * 32 + fr, fq * 8);
#define PG8_SA(b, h) (((b) * 2 + (h)) * HTB)
#define PG8_SB(b, h) ((4 + (b) * 2 + (h)) * HTB)
#define PG8_STAGE(bufoff, gbase, voff) do { _Pragma("unroll") for (int _i = 0; _i < 2; ++_i) \
        __builtin_amdgcn_global_load_lds((const unsigned*)((const char*)(gbase) + (size_t)_i * rstep64 + (voff)[0]), (PG8_LAS unsigned*)(lds + (bufoff) + ldsw + _i * 8192), 16, 0, 0); } while (0)
#define PG8_LDA(dst, b, h) do { _Pragma("unroll") for (int m = 0; m < 4; ++m) _Pragma("unroll") for (int k = 0; k < 2; ++k) dst[m][k] = *(const PG8_LAS bf16x8*)(lds + PG8_SA(b, h) + aoff + m * 2048 + k * 1024); } while (0)
#define PG8_LDB(dst, b, h) do { _Pragma("unroll") for (int n = 0; n < 2; ++n) _Pragma("unroll") for (int k = 0; k < 2; ++k) dst[n][k] = *(const PG8_LAS bf16x8*)(lds + PG8_SB(b, h) + boff + n * 2048 + k * 1024); } while (0)
#define PG8_MMA(ai, bj, At, Bt) do { __builtin_amdgcn_s_setprio(1); _Pragma("unroll") for (int m = 0; m < 4; ++m) _Pragma("unroll") for (int n = 0; n < 2; ++n) _Pragma("unroll") for (int k = 0; k < 2; ++k) \
        acc[ai][bj][m][n] = __builtin_amdgcn_mfma_f32_16x16x32_bf16(Bt[n][k], At[m][k], acc[ai][bj][m][n], 0, 0, 0); __builtin_amdgcn_s_setprio(0); } while (0)
#define PG8_WAIT_V(n) asm volatile("s_waitcnt vmcnt(" #n ")" ::: "memory")
#define PG8_WAIT_L(n) asm volatile("s_waitcnt lgkmcnt(" #n ")" ::: "memory")
#define PG8_BAR __builtin_amdgcn_s_barrier()
#define PG8_SCHED __builtin_amdgcn_sched_barrier(0)
    Unit cur, nxt; int ui = 0;
    if (!S.next(0, cur)) return;
    f32x4 acc[2][2][4][2];
#pragma unroll
    for (int a = 0; a < 2; ++a)
#pragma unroll
        for (int b = 0; b < 2; ++b)
#pragma unroll
            for (int m = 0; m < 4; ++m)
#pragma unroll
                for (int n = 0; n < 2; ++n) acc[a][b][m][n] = (f32x4){0.f, 0.f, 0.f, 0.f};
    bf16x8 At[4][2], B0[2][2], B1[2][2];
    const char* cA = (const char*)g.A + (size_t)cur.pm * tstep; const char* cB = (const char*)g.Bt + (size_t)cur.pn * tstep;
    S.a_ready(cur);
    if constexpr (SP2) {
        PG8_STAGE(PG8_SB(0, 0), cB, voffB); PG8_STAGE(PG8_SB(0, 1), cB + hstep, voffB); PG8_STAGE(PG8_SA(0, 0), cA, voffA); PG8_STAGE(PG8_SA(0, 1), cA + hstep, voffA);
        if (wr == 1) PG8_BAR;
        PG8_WAIT_V(2); PG8_BAR;
        PG8_STAGE(PG8_SB(1, 0), cB + kstep, voffB); PG8_STAGE(PG8_SA(1, 0), cA + kstep, voffA); PG8_STAGE(PG8_SB(1, 1), cB + hstep + kstep, voffB);
        PG8_WAIT_V(6); PG8_BAR;
    } else {
        PG8_STAGE(PG8_SB(0, 0), cB, voffB); PG8_STAGE(PG8_SA(0, 0), cA, voffA); PG8_STAGE(PG8_SB(0, 1), cB + hstep, voffB); PG8_STAGE(PG8_SA(0, 1), cA + hstep, voffA);
        if (wr == 1) PG8_BAR;
        PG8_WAIT_V(4); PG8_BAR;
        PG8_STAGE(PG8_SB(1, 0), cB + kstep, voffB); PG8_STAGE(PG8_SA(1, 0), cA + kstep, voffA); PG8_STAGE(PG8_SB(1, 1), cB + hstep + kstep, voffB);
        PG8_WAIT_V(6); PG8_BAR;
    }
    for (;;) {
        const bool has_next = S.next(ui + 1, nxt);
        const char* nA = has_next ? (const char*)g.A + (size_t)nxt.pm * tstep : cA; const char* nB = has_next ? (const char*)g.Bt + (size_t)nxt.pn * tstep : cB;
        for (int t = 0; t < nt; t += 2) {
            const bool last = (t == nt - 2);
            const char* a1 = cA + (size_t)(t + 1) * kstep;
            const char* a2 = last ? nA : cA + (size_t)(t + 2) * kstep; const char* b2 = last ? nB : cB + (size_t)(t + 2) * kstep;
            const char* a3 = a2 + kstep; const char* b3 = b2 + kstep;
            if (last && has_next) S.a_ready(nxt);
            if constexpr (SP2) {
            PG8_LDB(B0, 0, 0); PG8_LDB(B1, 0, 1); PG8_SCHED; PG8_LDA(At, 0, 0); PG8_STAGE(PG8_SA(1, 1), a1 + hstep, voffA);
            PG8_WAIT_V(8); PG8_WAIT_L(0); PG8_BAR; PG8_MMA(0, 0, At, B0); PG8_MMA(0, 1, At, B1); PG8_BAR; PG8_SCHED;
            PG8_LDA(At, 0, 1); PG8_STAGE(PG8_SB(0, 0), b2, voffB); PG8_STAGE(PG8_SB(0, 1), b2 + hstep, voffB); PG8_STAGE(PG8_SA(0, 0), a2, voffA);
            PG8_WAIT_V(8); PG8_WAIT_L(0); PG8_BAR; PG8_MMA(1, 0, At, B0); PG8_MMA(1, 1, At, B1); PG8_BAR; PG8_SCHED;
            PG8_LDB(B0, 1, 0); PG8_LDB(B1, 1, 1); PG8_SCHED; PG8_LDA(At, 1, 0); PG8_STAGE(PG8_SA(0, 1), a2 + hstep, voffA);
            PG8_WAIT_V(8); PG8_WAIT_L(0); PG8_BAR; PG8_MMA(0, 0, At, B0); PG8_MMA(0, 1, At, B1); PG8_BAR; PG8_SCHED;
            PG8_LDA(At, 1, 1); PG8_STAGE(PG8_SB(1, 0), b3, voffB); PG8_STAGE(PG8_SB(1, 1), b3 + hstep, voffB); PG8_STAGE(PG8_SA(1, 0), a3, voffA);
            PG8_WAIT_V(8); PG8_WAIT_L(0); PG8_BAR; PG8_MMA(1, 0, At, B0); PG8_MMA(1, 1, At, B1); PG8_BAR; PG8_SCHED;
            } else {
            PG8_LDB(B0, 0, 0); PG8_SCHED; PG8_LDA(At, 0, 0); PG8_STAGE(PG8_SA(1, 1), a1 + hstep, voffA);
            PG8_WAIT_L(8); PG8_BAR; PG8_WAIT_L(0); PG8_MMA(0, 0, At, B0); PG8_BAR; PG8_SCHED;
            PG8_LDB(B1, 0, 1); PG8_STAGE(PG8_SB(0, 0), b2, voffB);
            PG8_BAR; PG8_WAIT_L(0); PG8_MMA(0, 1, At, B1); PG8_BAR;
            PG8_LDA(At, 0, 1); PG8_STAGE(PG8_SA(0, 0), a2, voffA);
            PG8_BAR; PG8_WAIT_L(0); PG8_MMA(1, 0, At, B0); PG8_BAR; PG8_SCHED;
            PG8_STAGE(PG8_SB(0, 1), b2 + hstep, voffB);
            PG8_WAIT_V(6); PG8_BAR; PG8_MMA(1, 1, At, B1); PG8_BAR;
            PG8_LDB(B0, 1, 0); PG8_SCHED; PG8_LDA(At, 1, 0); PG8_STAGE(PG8_SA(0, 1), a2 + hstep, voffA);
            PG8_WAIT_L(8); PG8_BAR; PG8_WAIT_L(0); PG8_MMA(0, 0, At, B0); PG8_BAR; PG8_SCHED;
            PG8_LDB(B1, 1, 1); PG8_STAGE(PG8_SB(1, 0), b3, voffB);
            PG8_BAR; PG8_WAIT_L(0); PG8_MMA(0, 1, At, B1); PG8_BAR;
            PG8_LDA(At, 1, 1); PG8_STAGE(PG8_SA(1, 0), a3, voffA);
            PG8_BAR; PG8_WAIT_L(0); PG8_MMA(1, 0, At, B0); PG8_BAR; PG8_SCHED;
            PG8_STAGE(PG8_SB(1, 1), b3 + hstep, voffB);
            PG8_WAIT_V(6); PG8_BAR; PG8_MMA(1, 1, At, B1); PG8_BAR;
            }
        }
        if constexpr (ALIGN_EPI) { if (wr == 0) PG8_BAR; }
        if constexpr (!Epi::AFTER_DRAIN) { E(acc, cur, wr, wc, fr, fq); S.done(cur); }
        if (!has_next) break;
#pragma unroll
        for (int a = 0; a < 2; ++a)
#pragma unroll
            for (int b = 0; b < 2; ++b)
#pragma unroll
                for (int m = 0; m < 4; ++m)
#pragma unroll
                    for (int n = 0; n < 2; ++n) acc[a][b][m][n] = (f32x4){0.f, 0.f, 0.f, 0.f};
        cur = nxt; cA = nA; cB = nB; ++ui;
        if constexpr (ALIGN_EPI) { if (wr == 1) PG8_BAR; }
    }
    PG8_WAIT_V(0);
    if constexpr (!ALIGN_EPI) { if (wr == 0) PG8_BAR; }
    PG8_BAR;
    if constexpr (Epi::AFTER_DRAIN) { E.fused(acc, cur, wr, wc, fr, fq, lds, wid, lane); S.done(cur); }
#undef PG8_SA
#undef PG8_SB
#undef PG8_STAGE
#undef PG8_LDA
#undef PG8_LDB
#undef PG8_MMA
#undef PG8_WAIT_V
#undef PG8_WAIT_L
#undef PG8_BAR
#undef PG8_SCHED
}
}

struct EpiInproj {
    static constexpr bool PERM = true, AFTER_DRAIN = false;
    bf16_t *qkvraw, *dzb, *sq, *sk, *vT, *gab, *gbb; float* small;
    __device__ __forceinline__ void operator()(const pg8::f32x4 (&acc)[2][2][4][2], const pg8::Unit& u, int wr, int wc, int fr, int fq) const {
        const int pn = u.pn, row0 = u.pm * 256 + wr * 64 + fr;
        if (pn == 12 || pn == 13) {
#pragma unroll
            for (int ai = 0; ai < 2; ++ai)
#pragma unroll
                for (int m = 0; m < 4; ++m) {
                    const int tok = row0 + ai * 128 + m * 16, bb = tok >> 11, key = tok & (SEQ - 1), pos = (key & ~15) | pi16(key & 15);
#pragma unroll
                    for (int bj = 0; bj < 2; ++bj)
#pragma unroll
                        for (int n = 0; n < 2; ++n)
#pragma unroll
                            for (int j = 0; j < 4; ++j) {
                                const int svcol = (pn - 12) * 256 + bj * 128 + wc * 32 + fq * 8 + n * 4 + j;
                                vT[((size_t)((bb * 8 + (svcol >> 6)) * 64 + (svcol & 63))) * SEQ + pos] = to_bf16(acc[ai][bj][m][n][j]);
                            }
                }
        } else if (pn == 22) {
            if (wc == 0 && fq == 0) {
#pragma unroll
                for (int ai = 0; ai < 2; ++ai)
#pragma unroll
                    for (int m = 0; m < 4; ++m) {
                        pg8::f32x4* d = (pg8::f32x4*)(small + (size_t)(row0 + ai * 128 + m * 16) * 8);
                        d[0] = acc[ai][0][m][0]; d[1] = acc[ai][0][m][1];
                    }
            }
        } else {
            bf16_t* dst; int ld, c0; float sc = 1.f; bool gate = false;
            if (pn < 6) { dst = qkvraw; ld = 1536; c0 = pn * 256; }
            else if (pn < 8) { dst = dzb; ld = 512; c0 = (pn - 6) * 256; }
            else if (pn < 10) { dst = sq; ld = 512; c0 = (pn - 8) * 256; sc = 0.125f * 1.4426950408889634f; }
            else if (pn < 12) { dst = sk; ld = 512; c0 = (pn - 10) * 256; }
            else if (pn < 18) { dst = gab; ld = 1024; c0 = (pn - 14) * 256; gate = true; }
            else { dst = gbb; ld = 1024; c0 = (pn - 18) * 256; gate = true; }
#pragma unroll
            for (int ai = 0; ai < 2; ++ai)
#pragma unroll
                for (int m = 0; m < 4; ++m) {
                    bf16_t* rowp = dst + (size_t)(row0 + ai * 128 + m * 16) * ld + c0 + wc * 32 + fq * 8;
#pragma unroll
                    for (int bj = 0; bj < 2; ++bj) {
                        pg8::f32x4 v0 = acc[ai][bj][m][0] * sc, v1 = acc[ai][bj][m][1] * sc;
                        if (gate) {
#pragma unroll
                            for (int j = 0; j < 4; ++j) { v0[j] = sigmoidf_(v0[j]); v1[j] = sigmoidf_(v1[j]); }
                        }
                        pg8::u32x4 w; w.x = pk_bf16(v0[0], v0[1]); w.y = pk_bf16(v0[2], v0[3]); w.z = pk_bf16(v1[0], v1[1]); w.w = pk_bf16(v1[2], v1[3]);
                        *(pg8::u32x4*)(rowp + bj * 128) = w;
                    }
                }
        }
    }
};
template <class F> struct EpiF4 {
    static constexpr bool PERM = false, AFTER_DRAIN = false;
    F f;
    __device__ __forceinline__ void operator()(const pg8::f32x4 (&acc)[2][2][4][2], const pg8::Unit& u, int wr, int wc, int fr, int fq) const {
#pragma unroll
        for (int ai = 0; ai < 2; ++ai)
#pragma unroll
            for (int m = 0; m < 4; ++m) {
                const int row = u.pm * 256 + ai * 128 + wr * 64 + m * 16 + fr;
#pragma unroll
                for (int bj = 0; bj < 2; ++bj)
#pragma unroll
                    for (int n = 0; n < 2; ++n) f(row, u.pn * 256 + bj * 128 + wc * 32 + n * 16 + fq * 4, acc[ai][bj][m][n]);
            }
    }
};
template <class F> __device__ __forceinline__ void run_pg8(const bf16_t* A, const bf16_t* Bt, int M, int N, int K, unsigned char* lds, F f) {
    pg8::Gemm g{A, Bt, M, N, K};
    pg8::StaticOrder S; S.init(M, N, gridDim.x, blockIdx.x);
    EpiF4<F> E{f};
    pg8::gemm_phase<EpiF4<F>, pg8::StaticOrder, true, true>((PG8_LAS unsigned char*)lds, g, S, E);
}
__device__ __forceinline__ void unpack4(uint2 w, float (&g)[4]) {
    g[0] = __uint_as_float(w.x << 16); g[1] = __uint_as_float(w.x & 0xffff0000u); g[2] = __uint_as_float(w.y << 16); g[3] = __uint_as_float(w.y & 0xffff0000u);
}

struct LoadKNF32 {
    const float* base; int ld, kq, nq;
    f32x4 regs[8];
    template <class CF> __device__ __forceinline__ void init(const float* w, int ld_, CF colfn) {
        const int tid = opaque_tid(); kq = tid >> 6; nq = tid & 63; ld = ld_;
        base = w + (size_t)(kq * 8) * ld_ + colfn(nq * 4);
    }
    __device__ __forceinline__ void load(int k0) {
#pragma unroll
        for (int j = 0; j < 8; ++j) regs[j] = *(const f32x4*)(base + (size_t)(k0 + j) * ld);
    }
    __device__ __forceinline__ void store1(unsigned char* lds, int nn, float a0, float a1, float a2, float a3, float a4, float a5, float a6, float a7) const {
        uint4 o; o.x = pk_bf16(a0, a1); o.y = pk_bf16(a2, a3); o.z = pk_bf16(a4, a5); o.w = pk_bf16(a6, a7);
        const int row = nq * 4 + nn;
        *(uint4*)(lds + row * LROW + ((kq ^ swz(row)) << 4)) = o;
    }
    __device__ __forceinline__ void store(unsigned char* lds) const {
        store1(lds, 0, regs[0].x, regs[1].x, regs[2].x, regs[3].x, regs[4].x, regs[5].x, regs[6].x, regs[7].x);
        store1(lds, 1, regs[0].y, regs[1].y, regs[2].y, regs[3].y, regs[4].y, regs[5].y, regs[6].y, regs[7].y);
        store1(lds, 2, regs[0].z, regs[1].z, regs[2].z, regs[3].z, regs[4].z, regs[5].z, regs[6].z, regs[7].z);
        store1(lds, 3, regs[0].w, regs[1].w, regs[2].w, regs[3].w, regs[4].w, regs[5].w, regs[6].w, regs[7].w);
    }
};

template <int BM_, int BN_, int WM_, int WN_> struct GemmCfg {
    static constexpr int BM = BM_, BN = BN_, WM = WM_, WN = WN_;
    static constexpr int TM = BM / WM, TN = BN / WN, MI = TM / 32, NI = TN / 32;
    static constexpr int A_BYTES = BM * LROW, B_BYTES = BN * LROW, STAGE = A_BYTES + B_BYTES;
    static_assert(WM * WN == 8, "8 waves");
};

template <class CFG, class AL, class BL>
__device__ __forceinline__ void gemm_mainloop(AL& al, BL& bl, int nk, f32x16 (&acc)[CFG::MI][CFG::NI], unsigned char* lds) {
    constexpr int MI = CFG::MI, NI = CFG::NI;
    const int tid = opaque_tid(), lane = tid & 63, wid = tid >> 6;
    const int wm = wid / CFG::WN, wn = wid % CFG::WN;
    const int l31 = lane & 31, lh = lane >> 5;
    al.load(0); bl.load(0);
    const int a_off = (wm * CFG::TM + l31) * LROW;
    const int b_off = CFG::A_BYTES + (wn * CFG::TN + l31) * LROW;
    const int fsw = swz(l31);
    for (int kt = 0; kt < nk; ++kt) {
        unsigned char* st = lds + (kt & 1) * CFG::STAGE;
        al.store(st); bl.store(st + CFG::A_BYTES);
        __syncthreads();
        if (kt + 1 < nk) { al.load((kt + 1) * 64); bl.load((kt + 1) * 64); }
#pragma unroll
        for (int kk = 0; kk < 4; ++kk) {
            bf16x8 a[MI], b[NI];
#pragma unroll
            for (int mi = 0; mi < MI; ++mi) a[mi] = *(const bf16x8*)(st + a_off + mi * 32 * LROW + (((kk * 2 + lh) ^ fsw) << 4));
#pragma unroll
            for (int ni = 0; ni < NI; ++ni) b[ni] = *(const bf16x8*)(st + b_off + ni * 32 * LROW + (((kk * 2 + lh) ^ fsw) << 4));
#pragma unroll
            for (int mi = 0; mi < MI; ++mi)
#pragma unroll
                for (int ni = 0; ni < NI; ++ni)
                    acc[mi][ni] = __builtin_amdgcn_mfma_f32_32x32x16_bf16(a[mi], b[ni], acc[mi][ni], 0, 0, 0);
        }
    }
    __syncthreads();
}
template <class CFG, bool A_RES, int ARES_ROT, class AL, class BL>
__device__ __forceinline__ void gemm_mainloop2(AL (&al)[2], BL (&bl)[2], int nk, f32x16 (&acc)[CFG::MI][CFG::NI], unsigned char* stages, const unsigned char* ares) {
    constexpr int MI = CFG::MI, NI = CFG::NI;
    constexpr int STG = A_RES ? CFG::B_BYTES : CFG::STAGE, BOFF = A_RES ? 0 : CFG::A_BYTES;
    const int tid = opaque_tid(), lane = tid & 63, wid = tid >> 6;
    const int wm = wid / CFG::WN, wn = wid % CFG::WN;
    const int l31 = lane & 31, lh = lane >> 5;
    if (!A_RES) { al[0].load(0); } bl[0].load(0);
    if (!A_RES) { al[1].load(64); } bl[1].load(64);
    const int a_off = (wm * CFG::TM + l31) * LROW;
    const int b_off = BOFF + (wn * CFG::TN + l31) * LROW;
    const int fsw = swz(l31);
    for (int kt = 0; kt < nk; kt += 2) {
#pragma unroll
        for (int u = 0; u < 2; ++u) {
            unsigned char* st = stages + u * STG;
            if (!A_RES) al[u].store(st);
            bl[u].store(st + BOFF);
            __syncthreads();
            if (kt + u + 2 < nk) { if (!A_RES) al[u].load((kt + u + 2) * 64); bl[u].load((kt + u + 2) * 64); }
            const unsigned char* ab = A_RES ? ares + (size_t)((kt + u + ARES_ROT) & 3) * (CFG::BM * LROW) : st;
#pragma unroll
            for (int kk = 0; kk < 4; ++kk) {
                bf16x8 a[MI], b[NI];
#pragma unroll
                for (int mi = 0; mi < MI; ++mi) a[mi] = *(const bf16x8*)(ab + a_off + mi * 32 * LROW + (((kk * 2 + lh) ^ fsw) << 4));
#pragma unroll
                for (int ni = 0; ni < NI; ++ni) b[ni] = *(const bf16x8*)(st + b_off + ni * 32 * LROW + (((kk * 2 + lh) ^ fsw) << 4));
#pragma unroll
                for (int mi = 0; mi < MI; ++mi)
#pragma unroll
                    for (int ni = 0; ni < NI; ++ni)
                        acc[mi][ni] = __builtin_amdgcn_mfma_f32_32x32x16_bf16(a[mi], b[ni], acc[mi][ni], 0, 0, 0);
            }
        }
    }
    __syncthreads();
}
template <class CFG> __device__ __forceinline__ void acc_zero(f32x16 (&acc)[CFG::MI][CFG::NI]) {
#pragma unroll
    for (int mi = 0; mi < CFG::MI; ++mi)
#pragma unroll
        for (int ni = 0; ni < CFG::NI; ++ni)
#pragma unroll
            for (int r = 0; r < 16; ++r) acc[mi][ni][r] = 0.f;
}
template <class CFG, class F> __device__ __forceinline__ void acc_foreach(f32x16 (&acc)[CFG::MI][CFG::NI], F f) {
    const int tid = opaque_tid(), lane = tid & 63, wid = tid >> 6;
    const int wm = wid / CFG::WN, wn = wid % CFG::WN;
#pragma unroll
    for (int mi = 0; mi < CFG::MI; ++mi)
#pragma unroll
        for (int ni = 0; ni < CFG::NI; ++ni) {
            asm volatile("" ::: "memory");
#pragma unroll
            for (int r = 0; r < 16; ++r)
                acc[mi][ni][r] = f(wm * CFG::TM + mi * 32 + (r & 3) + 8 * (r >> 2) + 4 * (lane >> 5), wn * CFG::TN + ni * 32 + (lane & 31), acc[mi][ni][r], mi, ni, r);
        }
}

struct TileMap {
    int ntm, ntn, npm, npn, rounds; bool patched;
    int pm, pn;
    __device__ __forceinline__ void init(int ntm_, int ntn_) {
        ntm = ntm_; ntn = ntn_; patched = (gridDim.x == 256);
        pn = ntn >= 8 ? 8 : ntn >= 4 ? 4 : ntn >= 2 ? 2 : 1; pm = 32 / pn;
        if (patched) { npm = (ntm + pm - 1) / pm; npn = (ntn + pn - 1) / pn; rounds = (npm * npn + 7) / 8; }
        else { int G = gridDim.x; asm volatile("" : "+s"(G)); npm = npn = 0; rounds = (ntm * ntn + G - 1) / G; }
    }
    __device__ __forceinline__ bool get(int round, int& tm, int& tn) const {
        const int b = blockIdx.x;
        if (patched) {
            const int patch = round * 8 + (b & 7), slot = b >> 3;
            if (patch >= npm * npn) return false;
            tm = (patch / npn) * pm + slot / pn; tn = (patch % npn) * pn + slot % pn;
            return tm < ntm && tn < ntn;
        }
        const int t = round * gridDim.x + b;
        if (t >= ntm * ntn) return false;
        tm = t / ntn; tn = t % ntn; return true;
    }
};

template <class CM>
__device__ __forceinline__ void transpose_convert(const float* W, int K, int N, int NP, bf16_t* Wt, float* sm, CM cmap) {
    const int tid = opaque_tid(), ntk = K / 64, ntn = NP / 64;
    for (int tile = blockIdx.x; tile < ntk * ntn; tile += gridDim.x) {
        const int tk = tile % ntk, tn = tile / ntk;
#pragma unroll
        for (int i = 0; i < 8; ++i) {
            const int e = tid + i * NT, kk = e >> 6, nn = e & 63, col = cmap(tn * 64 + nn);
            sm[nn * 65 + kk] = col >= 0 ? W[(size_t)(tk * 64 + kk) * N + col] : 0.f;
        }
        __syncthreads();
        const int n = tid >> 3, kc = tid & 7;
        const float* r = sm + n * 65 + kc * 8;
        uint4 o; o.x = pk_bf16(r[0], r[1]); o.y = pk_bf16(r[2], r[3]); o.z = pk_bf16(r[4], r[5]); o.w = pk_bf16(r[6], r[7]);
        *(uint4*)(Wt + (size_t)(tn * 64 + n) * K + tk * 64 + kc * 8) = o;
        __syncthreads();
    }
}
__device__ __forceinline__ void transpose_tile_f4(const float* W, int K, int N, bf16_t* Wt, int k0, int n0, float* sm) {
    const int tid = opaque_tid(), kk = tid >> 4, n4 = tid & 15;
#pragma unroll
    for (int h = 0; h < 2; ++h) {
        const int k = kk + 32 * h;
        const f32x4 v = *(const f32x4*)(W + (size_t)(k0 + k) * N + n0 + n4 * 4);
#pragma unroll
        for (int j = 0; j < 4; ++j) sm[(n4 * 4 + j) * 65 + k] = v[j];
    }
    __syncthreads();
    const int n = tid >> 3, kc = tid & 7;
    const float* r = sm + n * 65 + kc * 8;
    uint4 o; o.x = pk_bf16(r[0], r[1]); o.y = pk_bf16(r[2], r[3]); o.z = pk_bf16(r[4], r[5]); o.w = pk_bf16(r[6], r[7]);
    *(uint4*)(Wt + (size_t)(n0 + n) * K + k0 + kc * 8) = o;
    __syncthreads();
}
__device__ __forceinline__ void convert_bf16(const float* src, bf16_t* dst, size_t n) {
    const size_t gtid = (size_t)blockIdx.x * NT + opaque_tid(), gsz = (size_t)gridDim.x * NT;
    for (size_t i = gtid; i < n / 8; i += gsz) {
        const float4 a = ((const float4*)src)[2 * i], b = ((const float4*)src)[2 * i + 1];
        uint4 o; o.x = pk_bf16(a.x, a.y); o.y = pk_bf16(a.z, a.w); o.z = pk_bf16(b.x, b.y); o.w = pk_bf16(b.z, b.w);
        ((uint4*)dst)[i] = o;
    }
}

__device__ __forceinline__ void phase_inproj(const Params& p, unsigned char* lds) {
    pg8::Gemm g{p.xb, p.w_in_t, T, PWP, D};
    pg8::StaticOrder S; S.init(T, PWP, gridDim.x, blockIdx.x);
    EpiInproj E{p.qkvraw, p.dzb, p.sq, p.sk, p.vT, p.gab, p.gbb, p.small};
    pg8::gemm_phase<EpiInproj, pg8::StaticOrder, true, true>((PG8_LAS unsigned char*)lds, g, S, E);
}

__device__ __forceinline__ void load_gate16(const bf16_t* gbuf, int rb, int cb, int lane, float (&g)[16]) {
    const uint4* src = (const uint4*)(gbuf + ((size_t)(rb * 32 + cb) * 64 + lane) * 16);
    const uint4 a = src[0], b = src[1];
    const unsigned u[8] = {a.x, a.y, a.z, a.w, b.x, b.y, b.z, b.w};
#pragma unroll
    for (int i = 0; i < 8; ++i) { g[2 * i] = __uint_as_float(u[i] << 16); g[2 * i + 1] = __uint_as_float(u[i] & 0xffff0000u); }
}
__device__ __forceinline__ void phase_merge(const Params& p, unsigned char* lds) {
    run_pg8(p.oab, p.w_pa_t, T, D, DNW, lds, [&](int row, int col, pg8::f32x4 v) {
        float g[4]; unpack4(*(const uint2*)(p.gab + (size_t)row * D + col), g);
        *(pg8::f32x4*)(p.m1 + (size_t)row * D + col) = (pg8::f32x4){v[0] * g[0], v[1] * g[1], v[2] * g[2], v[3] * g[3]};
    });
    run_pg8(p.obb, p.w_pb_t, T, D, SBW, lds, [&](int row, int col, pg8::f32x4 v) {
        float g[4]; unpack4(*(const uint2*)(p.gbb + (size_t)row * D + col), g);
        const pg8::f32x4 m = *(const pg8::f32x4*)(p.m1 + (size_t)row * D + col);
        uint2 w; w.x = pk_bf16(m[0] + v[0] * g[0], m[1] + v[1] * g[1]); w.y = pk_bf16(m[2] + v[2] * g[2], m[3] + v[3] * g[3]);
        *(uint2*)(p.mergedb + (size_t)row * D + col) = w;
    });
}

__device__ __forceinline__ void phase_outproj(const Params& p, unsigned char* lds) {
    run_pg8(p.mergedb, p.w_out_t, T, D, D, lds, [&](int row, int col, pg8::f32x4 v) {
        const size_t o = (size_t)row * D + col;
        const pg8::f32x4 x = *(const pg8::f32x4*)(p.x + o);
        *(pg8::f32x4*)(p.pre1 + o) = v + x * ALPHA;
    });
}

__device__ __forceinline__ void phase_router_shared_up(const Params& p, unsigned char* lds) {
    {
        typedef GemmCfg<128, 128, 4, 2> CFG;
        TileMap tmap; tmap.init(T / 128, NE / 128);
        for (int round = 0; round < tmap.rounds; ++round) {
            int tm, tn;
            if (!tmap.get(round, tm, tn)) continue;
            LoadRowsBf16<128> al, bl;
            al.init(p.hb, D, [&](int r) { return (long long)(tm * 128 + r); });
            bl.init(p.w_router_t, D, [&](int r) { return (long long)(tn * 128 + r); });
            f32x16 acc[CFG::MI][CFG::NI];
            acc_zero<CFG>(acc);
            gemm_mainloop<CFG>(al, bl, D / 64, acc, lds);
            asm volatile("" : "+s"(tm), "+s"(tn));
            acc_foreach<CFG>(acc, [&](int r, int c, float v, int, int, int) {
                p.scores[(size_t)(tm * 128 + r) * NE + tn * 128 + c] = sigmoidf_(v);
                return v;
            });
        }
    }
    {
        typedef GemmCfg<128, 256, 2, 4> CFG;
        TileMap tmap; tmap.init(T / 128, SFF / 128);
        for (int round = 0; round < tmap.rounds; ++round) {
            int tm, tn;
            if (!tmap.get(round, tm, tn)) continue;
            LoadRowsBf16<128> al; LoadRowsBf16<256> bl;
            al.init(p.hb, D, [&](int r) { return (long long)(tm * 128 + r); });
            bl.init(p.w_su_t, D, [&](int r) { return (long long)(((r >> 5) & 1) * SFF + tn * 128 + (r >> 6) * 32 + (r & 31)); });
            f32x16 acc[CFG::MI][CFG::NI];
            acc_zero<CFG>(acc);
            gemm_mainloop<CFG>(al, bl, D / 64, acc, lds);
            asm volatile("" : "+s"(tm), "+s"(tn));
            const int tid = opaque_tid(), lane = tid & 63, wid = tid >> 6, wm = wid / CFG::WN, wn = wid % CFG::WN;
#pragma unroll
            for (int mi = 0; mi < CFG::MI; ++mi)
#pragma unroll
                for (int r = 0; r < 16; ++r) {
                    const int row = tm * 128 + wm * CFG::TM + mi * 32 + (r & 3) + 8 * (r >> 2) + 4 * (lane >> 5);
                    const int j = tn * 128 + wn * 32 + (lane & 31);
                    const float g = acc[mi][0][r], u = acc[mi][1][r];
                    p.actsh[(size_t)row * SFF + j] = to_bf16(siluf_(g) * u);
                }
        }
    }
}

__device__ __forceinline__ void phase_shared_down(const Params& p, unsigned char* lds) {
    run_pg8(p.actsh, p.w_sd_t, T, D, SFF, lds, [&](int row, int col, pg8::f32x4 v) { *(pg8::f32x4*)(p.ysh + (size_t)row * D + col) = v; });
}

__device__ __forceinline__ void phase_init(const Params& p) {
    const int gtid = blockIdx.x * NT + opaque_tid(), gsz = gridDim.x * NT;
    for (int i = gtid; i < 2 * NE * CSTRIDE; i += gsz) p.counts[i] = 0;
}

__device__ __forceinline__ void sb_attn_wave(const Params& p, int bh, int qt) {
    const int lane = opaque_tid() & 63, l31 = lane & 31, lh = lane >> 5;
    const int b = bh >> 3, hh = bh & 7;
    bf16x8 qf[4];
    {
        const bf16_t* qrow = p.sq + (size_t)(b * SEQ + qt * 32 + l31) * SBW + hh * 64 + lh * 8;
#pragma unroll
        for (int ks = 0; ks < 4; ++ks) qf[ks] = *(const bf16x8*)(qrow + ks * 16);
    }
    f32x16 o0, o1;
#pragma unroll
    for (int r = 0; r < 16; ++r) { o0[r] = 0.f; o1[r] = 0.f; }
    float run = 0.f;
    const bf16_t* vbase = p.vT + ((size_t)(bh * 64 + l31)) * SEQ + lh * 8;
    for (int kt = qt; kt >= 0; --kt) {
        const bf16_t* krow = p.sk + (size_t)(b * SEQ + kt * 32 + l31) * SBW + hh * 64 + lh * 8;
        bf16x8 kf[4];
#pragma unroll
        for (int ks = 0; ks < 4; ++ks) kf[ks] = *(const bf16x8*)(krow + ks * 16);
        bf16x8 vf[2][2];
#pragma unroll
        for (int md = 0; md < 2; ++md)
#pragma unroll
            for (int ss = 0; ss < 2; ++ss) vf[md][ss] = *(const bf16x8*)(vbase + (size_t)md * 32 * SEQ + kt * 32 + ss * 16);
        f32x16 sc;
#pragma unroll
        for (int r = 0; r < 16; ++r) sc[r] = 0.f;
#pragma unroll
        for (int ks = 0; ks < 4; ++ks) sc = __builtin_amdgcn_mfma_f32_32x32x16_bf16(kf[ks], qf[ks], sc, 0, 0, 0);
        float lb[16], lr[16];
        const bool diag = (kt == qt);
#pragma unroll
        for (int r = 0; r < 16; ++r) {
            const float z = sc[r];
            const float l = __builtin_amdgcn_logf(1.f + __builtin_amdgcn_exp2f(-fabsf(z)));
            float b_ = fminf(z, 0.f) - l, r_ = b_ - z;
            if (diag) { const bool valid = ((r & 3) + 8 * (r >> 2) + 4 * lh) < l31; r_ = valid ? r_ : 0.f; b_ = valid ? b_ : -INFINITY; }
            lb[r] = b_; lr[r] = r_;
        }
        float ex[16], B[4];
#pragma unroll
        for (int g = 0; g < 4; ++g) {
            ex[4 * g + 3] = 0.f;
            ex[4 * g + 2] = lr[4 * g + 3];
            ex[4 * g + 1] = ex[4 * g + 2] + lr[4 * g + 2];
            ex[4 * g + 0] = ex[4 * g + 1] + lr[4 * g + 1];
            B[g] = ex[4 * g + 0] + lr[4 * g + 0];
        }
        float P[4];
#pragma unroll
        for (int g = 0; g < 4; ++g) P[g] = shfl_lane(B[g], lane ^ 32);
        float off[4];
        {
            const float p3 = P[3], p2 = P[2] + p3, p1 = P[1] + p2, p0 = P[0] + p1;
            const float b3 = 0.f, b2 = B[3], b1 = B[2] + b2, b0 = B[1] + b1;
            off[0] = b0 + (lh ? p1 : p0);
            off[1] = b1 + (lh ? p2 : p1);
            off[2] = b2 + (lh ? p3 : p2);
            off[3] = b3 + (lh ? 0.f : p3);
            const float total = (B[0] + b0) + p0;
#pragma unroll
            for (int g = 0; g < 4; ++g) off[g] += run;
            run += total;
        }
        float a[16];
#pragma unroll
        for (int r = 0; r < 16; ++r) a[r] = __builtin_amdgcn_exp2f(lb[r] + ex[r] + off[r >> 2]);
        bf16x8 pf[2];
#pragma unroll
        for (int ss = 0; ss < 2; ++ss) {
            typedef unsigned u32x4 __attribute__((ext_vector_type(4)));
            u32x4 w;
            w[0] = pk_bf16(a[8 * ss + 0], a[8 * ss + 1]); w[1] = pk_bf16(a[8 * ss + 2], a[8 * ss + 3]);
            w[2] = pk_bf16(a[8 * ss + 4], a[8 * ss + 5]); w[3] = pk_bf16(a[8 * ss + 6], a[8 * ss + 7]);
            pf[ss] = __builtin_bit_cast(bf16x8, w);
        }
#pragma unroll
        for (int ss = 0; ss < 2; ++ss) {
            o0 = __builtin_amdgcn_mfma_f32_32x32x16_bf16(vf[0][ss], pf[ss], o0, 0, 0, 0);
            o1 = __builtin_amdgcn_mfma_f32_32x32x16_bf16(vf[1][ss], pf[ss], o1, 0, 0, 0);
        }
        if (__all(run < -160.f)) break;
    }
    bf16_t* orow = p.obb + (size_t)(b * SEQ + qt * 32 + l31) * SBW + hh * 64 + 4 * lh;
#pragma unroll
    for (int g = 0; g < 4; ++g) {
        uint2 w0, w1;
        w0.x = pk_bf16(o0[4 * g], o0[4 * g + 1]); w0.y = pk_bf16(o0[4 * g + 2], o0[4 * g + 3]);
        w1.x = pk_bf16(o1[4 * g], o1[4 * g + 1]); w1.y = pk_bf16(o1[4 * g + 2], o1[4 * g + 3]);
        *(uint2*)(orow + 8 * g) = w0;
        *(uint2*)(orow + 32 + 8 * g) = w1;
    }
}


constexpr int DN_RW = 0, DN_RQ = 128, DN_RAT = 256, DN_RKD = 320;
constexpr float LOG2E = 1.4426950408889634f;
__device__ __forceinline__ uint4 pack8(const float* v) { uint4 o; o.x = pk_bf16(v[0], v[1]); o.y = pk_bf16(v[2], v[3]); o.z = pk_bf16(v[4], v[5]); o.w = pk_bf16(v[6], v[7]); return o; }

__device__ __forceinline__ void dn_chunk_item(const Params& p, int item, unsigned char* lds) {
    const int tid = opaque_tid(), lane = tid & 63, wid = tid >> 6;
    const int bh = item >> 5, n = item & 31, b = bh >> 2, hh = bh & 3;
    const int t0 = b * SEQ + n * 64;
    unsigned char* Kimg = lds; unsigned char* KBimg = lds + 16384; unsigned char* Qimg = lds + 32768;
    float* Vf = (float*)(lds + 49152); float* KBGf = (float*)(lds + 81920); float* MT = (float*)(lds + 114688);
    float* G2s = (float*)(lds + 114688 + 17408); float* betas = G2s + 64;
    bf16_t* blob = p.dnblob + (size_t)item * DN_BLOB;
    if (wid == 0) {
        const int t = t0 + lane;
        const float da = p.small[(size_t)t * 8 + 4 + hh] + p.dt_bias[hh];
        const float sp = da > 20.f ? da : log1pf(expf(da));
        float g2 = -expf(p.a_log[hh]) * sp * LOG2E;
#pragma unroll
        for (int off = 1; off < 64; off <<= 1) { const float v = shfl_lane(g2, lane - off); if (lane >= off) g2 += v; }
        G2s[lane] = g2; betas[lane] = sigmoidf_(p.small[(size_t)t * 8 + hh]);
        if (lane == 63) p.dnlast[item] = exp2f(g2);
    }
    __syncthreads();
    {
        const int c8 = tid & 15, tq = tid >> 4, j0 = tq * 2;
        const float G0 = G2s[j0], G1 = G2s[j0 + 1], GL = G2s[63];
        const float be[2] = {betas[j0], betas[j0 + 1]};
        const float eg[2] = {exp2f(G0), exp2f(G1)}, el[2] = {exp2f(GL - G0), exp2f(GL - G1)};
        const int half = c8 >> 3, ch = c8 & 7;
#pragma unroll
        for (int type = 0; type < 3; ++type) {
            float o[2][8];
            {
                const bf16_t* src = p.qkvraw + (size_t)(t0 + j0 - 3) * 1536 + type * 512 + hh * 128 + c8 * 8;
                float x[5][8];
#pragma unroll
                for (int r = 0; r < 5; ++r) {
                    uint4 raw = make_uint4(0, 0, 0, 0);
                    if (n > 0 || j0 - 3 + r >= 0) raw = *(const uint4*)(src + (size_t)r * 1536);
                    const unsigned u[4] = {raw.x, raw.y, raw.z, raw.w};
#pragma unroll
                    for (int i = 0; i < 4; ++i) { x[r][2 * i] = __uint_as_float(u[i] << 16); x[r][2 * i + 1] = __uint_as_float(u[i] & 0xffff0000u); }
                }
                const float* wp = p.conv_w + type * 512 + hh * 128 + c8 * 8;
#pragma unroll
                for (int i = 0; i < 8; ++i) {
                    float a0 = 0.f, a1 = 0.f;
#pragma unroll
                    for (int tap = 0; tap < 4; ++tap) { const float w = wp[tap * 1536 + i]; a0 = fmaf(x[tap][i], w, a0); a1 = fmaf(x[tap + 1][i], w, a1); }
                    o[0][i] = siluf_(a0); o[1][i] = siluf_(a1);
                }
            }
            if (type < 2) {
#pragma unroll
                for (int tk = 0; tk < 2; ++tk) {
                    float ss = 0.f;
#pragma unroll
                    for (int i = 0; i < 8; ++i) ss = fmaf(o[tk][i], o[tk][i], ss);
                    ss += shfl_lane(ss, lane ^ 1); ss += shfl_lane(ss, lane ^ 2); ss += shfl_lane(ss, lane ^ 4); ss += shfl_lane(ss, lane ^ 8);
                    float r = rsqrtf(ss + NORM_EPS);
                    if (type == 0) r *= 0.08838834764831845f;
#pragma unroll
                    for (int i = 0; i < 8; ++i) o[tk][i] *= r;
                }
            }
#pragma unroll
            for (int tk = 0; tk < 2; ++tk) {
                const int j = j0 + tk;
                const int ioff = half * 8192 + j * 128 + ((ch ^ swz(j)) << 4);
                if (type == 0) {
                    *(uint4*)(Qimg + ioff) = pack8(o[tk]);
                    float qd[8];
#pragma unroll
                    for (int i = 0; i < 8; ++i) qd[i] = o[tk][i] * eg[tk];
                    bf16_t* qrow = blob + (size_t)(DN_RQ + half * 64 + j) * 64 + ((c8 >> 1) & 3) * 16 + 4 * (c8 & 1);
                    uint2 w0, w1; w0.x = pk_bf16(qd[0], qd[1]); w0.y = pk_bf16(qd[2], qd[3]); w1.x = pk_bf16(qd[4], qd[5]); w1.y = pk_bf16(qd[6], qd[7]);
                    *(uint2*)qrow = w0; *(uint2*)(qrow + 8) = w1;
                } else if (type == 1) {
                    float kb[8], kbg[8];
#pragma unroll
                    for (int i = 0; i < 8; ++i) { kb[i] = o[tk][i] * be[tk]; kbg[i] = kb[i] * eg[tk]; }
                    *(uint4*)(Kimg + ioff) = pack8(o[tk]);
                    *(uint4*)(KBimg + ioff) = pack8(kb);
                    f32x4* kd = (f32x4*)(KBGf + j * 128 + c8 * 8); kd[0] = (f32x4){kbg[0], kbg[1], kbg[2], kbg[3]}; kd[1] = (f32x4){kbg[4], kbg[5], kbg[6], kbg[7]};
                } else {
                    float vb[8];
#pragma unroll
                    for (int i = 0; i < 8; ++i) vb[i] = o[tk][i] * be[tk];
                    f32x4* vd = (f32x4*)(Vf + j * 128 + c8 * 8); vd[0] = (f32x4){vb[0], vb[1], vb[2], vb[3]}; vd[1] = (f32x4){vb[4], vb[5], vb[6], vb[7]};
                }
            }
            if (type == 1) {
                const int jp = (j0 & 48) | pi16(j0 & 15);
#pragma unroll
                for (int i = 0; i < 8; ++i)
                    *(unsigned*)(blob + (size_t)(DN_RKD + c8 * 8 + i) * 64 + jp) = pk_bf16(o[0][i] * el[0], o[1][i] * el[1]);
            }
            asm volatile("" ::: "memory");
        }
    }
    __syncthreads();
    {
        const int which = wid >> 2, ti = (wid >> 1) & 1, tj = wid & 1, l31 = lane & 31, lh = lane >> 5;
        if (!(ti == 0 && tj == 1)) {
            const unsigned char* Ab = (which == 0 ? KBimg : Qimg) + (ti * 32 + l31) * 128;
            const unsigned char* Bb = Kimg + (tj * 32 + l31) * 128;
            const int fsw = swz(l31);
            f32x16 acc;
#pragma unroll
            for (int r = 0; r < 16; ++r) acc[r] = 0.f;
#pragma unroll
            for (int ks = 0; ks < 8; ++ks) {
                const int off = (ks >> 2) * 8192 + ((((ks & 3) * 2 + lh) ^ fsw) << 4);
                acc = __builtin_amdgcn_mfma_f32_32x32x16_bf16(*(const bf16x8*)(Ab + off), *(const bf16x8*)(Bb + off), acc, 0, 0, 0);
            }
            const int j = tj * 32 + l31;
            const float Gj = G2s[j];
#pragma unroll
            for (int r = 0; r < 16; ++r) {
                const int i = ti * 32 + (r & 3) + 8 * (r >> 2) + 4 * lh;
                const float v = acc[r] * exp2f(G2s[i] - Gj);
                if (which == 0) MT[j * 68 + i] = (i > j) ? v : 0.f;
                else blob[(size_t)(DN_RAT + i) * 64 + ((j & 48) | pi16(j & 15))] = to_bf16((i >= j) ? v : 0.f);
            }
        }
    }
    __syncthreads();
#ifndef NO_SOLVE
    if (tid < 256) {
        const int c = tid & 127;
        const float* rhs = (tid < 128 ? Vf : KBGf) + c;
        float y[64];
#pragma unroll
        for (int j = 0; j < 64; ++j) y[j] = rhs[j * 128];
#pragma unroll
        for (int j = 0; j < 63; ++j) {
            const float yj = y[j];
#pragma unroll
            for (int i4 = (j + 1) & ~3; i4 < 64; i4 += 4) {
                const f32x4 m = *(const f32x4*)(MT + j * 68 + i4);
#pragma unroll
                for (int u = 0; u < 4; ++u) if (i4 + u > j) y[i4 + u] = fmaf(-m[u], yj, y[i4 + u]);
            }
            asm volatile("" ::: "memory");
        }
        if (tid < 128) {
#pragma unroll
            for (int mi = 0; mi < 2; ++mi)
#pragma unroll
                for (int h = 0; h < 2; ++h) {
                    f32x4* dst = (f32x4*)(p.dnu + ((((size_t)item * 2 + mi) * 4 + (c >> 5)) * 64 + h * 32 + (c & 31)) * 16);
#pragma unroll
                    for (int g = 0; g < 4; ++g)
                        dst[g] = (f32x4){y[mi * 32 + 8 * g + 4 * h], y[mi * 32 + 8 * g + 4 * h + 1], y[mi * 32 + 8 * g + 4 * h + 2], y[mi * 32 + 8 * g + 4 * h + 3]};
                }
        } else {
            bf16_t* dst = blob + (size_t)(DN_RW + (c >> 6) * 64) * 64 + ((c & 48) | pi16(c & 15));
#pragma unroll
            for (int i = 0; i < 64; ++i) dst[(size_t)i * 64] = to_bf16(-y[i]);
        }
    }
#endif
    __syncthreads();
}

__device__ __forceinline__ void phase_dn_chunks(const Params& p, unsigned char* lds) {
    for (int item = blockIdx.x; item < NB * DNH * 32; item += gridDim.x) dn_chunk_item(p, item, lds);
}

__device__ __forceinline__ void dn_scan(const Params& p, int bh, unsigned char* lds) {
    const int tid = opaque_tid(), lane = tid & 63, wid = tid >> 6, l31 = lane & 31, lh = lane >> 5;
    const int b = bh >> 2, hh = bh & 3;
    const int fsw = swz(l31);
    auto copy_blob = [&](int n, unsigned char* dst) {
        const uint4* src = (const uint4*)(p.dnblob + (size_t)(bh * 32 + n) * DN_BLOB);
        const int lt = tid - 256;
#pragma unroll
        for (int k = 0; k < 14; ++k) {
            const int c = lt + k * 256, row = c >> 3, ch = c & 7;
            *(uint4*)(dst + row * 128 + ((ch ^ swz(row)) << 4)) = src[c];
        }
    };
    if (wid >= 4) copy_blob(0, lds);
    __syncthreads();
    f32x16 S[4];
#pragma unroll
    for (int t = 0; t < 4; ++t)
#pragma unroll
        for (int r = 0; r < 16; ++r) S[t][r] = 0.f;
    for (int n = 0; n < 32; ++n) {
        if (wid >= 4) {
            if (n + 1 < 32) copy_blob(n + 1, lds + ((n + 1) & 1) * (DN_ROWS * 128));
        } else {
            const unsigned char* buf = lds + (n & 1) * (DN_ROWS * 128);
            const int item = bh * 32 + n;
            f32x16 vn[2], oa[2];
#pragma unroll
            for (int mi = 0; mi < 2; ++mi) {
                vn[mi] = *(const f32x16*)(p.dnu + ((((size_t)item * 2 + mi) * 4 + wid) * 64 + lane) * 16);
#pragma unroll
                for (int r = 0; r < 16; ++r) oa[mi][r] = 0.f;
            }
            const float last = p.dnlast[item];
            typedef unsigned u32x4 __attribute__((ext_vector_type(4)));
            bf16x8 sb[4][2];
#pragma unroll
            for (int t = 0; t < 4; ++t)
#pragma unroll
                for (int ss = 0; ss < 2; ++ss) {
                    u32x4 w;
#pragma unroll
                    for (int q = 0; q < 4; ++q) w[q] = pk_bf16(S[t][8 * ss + 2 * q], S[t][8 * ss + 2 * q + 1]);
                    sb[t][ss] = __builtin_bit_cast(bf16x8, w);
                }
#pragma unroll
            for (int mi = 0; mi < 2; ++mi)
#pragma unroll
                for (int ks = 0; ks < 8; ++ks) {
                    const int off = ((ks >> 2) * 64 + mi * 32 + l31) * 128 + ((((ks & 3) * 2 + lh) ^ fsw) << 4);
                    vn[mi] = __builtin_amdgcn_mfma_f32_32x32x16_bf16(*(const bf16x8*)(buf + DN_RW * 128 + off), sb[ks >> 1][ks & 1], vn[mi], 0, 0, 0);
                    oa[mi] = __builtin_amdgcn_mfma_f32_32x32x16_bf16(*(const bf16x8*)(buf + DN_RQ * 128 + off), sb[ks >> 1][ks & 1], oa[mi], 0, 0, 0);
                }
            bf16x8 vb[2][2];
#pragma unroll
            for (int mj = 0; mj < 2; ++mj)
#pragma unroll
                for (int ss = 0; ss < 2; ++ss) {
                    u32x4 w;
#pragma unroll
                    for (int q = 0; q < 4; ++q) w[q] = pk_bf16(vn[mj][8 * ss + 2 * q], vn[mj][8 * ss + 2 * q + 1]);
                    vb[mj][ss] = __builtin_bit_cast(bf16x8, w);
                }
#pragma unroll
            for (int mi = 0; mi < 2; ++mi)
#pragma unroll
                for (int kj = 0; kj < 4; ++kj)
                    if ((kj >> 1) <= mi) {
                        const int off = (DN_RAT + mi * 32 + l31) * 128 + (((kj * 2 + lh) ^ fsw) << 4);
                        oa[mi] = __builtin_amdgcn_mfma_f32_32x32x16_bf16(*(const bf16x8*)(buf + off), vb[kj >> 1][kj & 1], oa[mi], 0, 0, 0);
                    }
#pragma unroll
            for (int t = 0; t < 4; ++t) {
#pragma unroll
                for (int r = 0; r < 16; ++r) S[t][r] *= last;
#pragma unroll
                for (int kj = 0; kj < 4; ++kj) {
                    const int off = (DN_RKD + t * 32 + l31) * 128 + (((kj * 2 + lh) ^ fsw) << 4);
                    S[t] = __builtin_amdgcn_mfma_f32_32x32x16_bf16(*(const bf16x8*)(buf + off), vb[kj >> 1][kj & 1], S[t], 0, 0, 0);
                }
            }
            float* orow = p.oraw + (size_t)(b * SEQ + n * 64) * DNW + hh * 128 + wid * 32 + l31;
#pragma unroll
            for (int mi = 0; mi < 2; ++mi)
#pragma unroll
                for (int r = 0; r < 16; ++r) orow[(size_t)(mi * 32 + (r & 3) + 8 * (r >> 2) + 4 * lh) * DNW] = oa[mi][r];
        }
        __syncthreads();
    }
}

__device__ __forceinline__ void phase_mixers(const Params& p, float* smem) {
    const int nscan = NB * DNH;
    if (gridDim.x >= 2 * nscan) {
#ifndef SKIP_SCAN
        if ((int)blockIdx.x < nscan) dn_scan(p, blockIdx.x, (unsigned char*)smem);
#endif
        if ((int)blockIdx.x < nscan) {}
        else {
            for (int it = blockIdx.x - nscan; it < 512; it += gridDim.x - nscan) sb_attn_wave(p, it >> 3, (it & 7) * 8 + (opaque_tid() >> 6));
        }
    } else {
#ifndef SKIP_SCAN
        for (int bh = blockIdx.x; bh < nscan; bh += gridDim.x) dn_scan(p, bh, (unsigned char*)smem);
#endif
        for (int it = blockIdx.x; it < 512; it += gridDim.x) sb_attn_wave(p, it >> 3, (it & 7) * 8 + (opaque_tid() >> 6));
    }
}

__device__ __forceinline__ void phase_gated_norm(const Params& p) {
    const int lane = opaque_tid() & 63, wave = (blockIdx.x * NT + opaque_tid()) >> 6, nw = (gridDim.x * NT) >> 6;
    for (int item = wave; item < T * 4; item += nw) {
        const int t = item >> 2, hh = item & 3;
        const size_t off = (size_t)t * DNW + hh * 128 + lane * 2;
        const float v0 = p.oraw[off], v1 = p.oraw[off + 1];
        const float ss = wave_sum(v0 * v0 + v1 * v1, lane);
        const float r = rsqrtf(ss * (1.f / 128.f) + NORM_EPS);
        const float z0 = bf2f(p.dzb[(size_t)t * 512 + hh * 128 + lane * 2]), z1 = bf2f(p.dzb[(size_t)t * 512 + hh * 128 + lane * 2 + 1]);
        p.oab[off] = to_bf16(v0 * r * p.norm_g[lane * 2] * siluf_(z0));
        p.oab[off + 1] = to_bf16(v1 * r * p.norm_g[lane * 2 + 1] * siluf_(z1));
    }
}

template <class SF>
__device__ __forceinline__ void layer_norm_rows(SF sf, const float* g, const float* bb, float* dst, bf16_t* dstb) {
    const int lane = opaque_tid() & 63, wave = (blockIdx.x * NT + opaque_tid()) >> 6, nw = (gridDim.x * NT) >> 6;
    for (int t = wave; t < T; t += nw) {
        float v[16];
        float s = 0.f;
#pragma unroll
        for (int i = 0; i < 16; ++i) { v[i] = sf(t, lane + i * 64); s += v[i]; }
        const float mu = wave_sum(s, lane) * (1.f / 1024.f);
        float q = 0.f;
#pragma unroll
        for (int i = 0; i < 16; ++i) { const float d = v[i] - mu; q += d * d; }
        const float rstd = rsqrtf(wave_sum(q, lane) * (1.f / 1024.f) + LN_EPS);
#pragma unroll
        for (int i = 0; i < 16; ++i) { const int c = lane + i * 64; const float y = (v[i] - mu) * rstd * g[c] + bb[c]; dst[(size_t)t * D + c] = y; if (dstb) dstb[(size_t)t * D + c] = to_bf16(y); }
    }
}

__device__ __forceinline__ void phase_route(const Params& p, int* counts, int* explist, int* ldsw) {
    const int tid = opaque_tid(), lane = tid & 63;
    const int wave = (blockIdx.x * NT + tid) >> 6, nw = (gridDim.x * NT) >> 6;
    int* mye = ldsw + (tid >> 6) * 64;
    const f32x4 bias = *(const f32x4*)(p.router_bias + lane * 4);
    for (int t0 = wave; t0 < T; t0 += nw * 8) {
        f32x4 scs[8];
#pragma unroll
        for (int k = 0; k < 8; ++k) { const int t = t0 + k * nw; scs[k] = t < T ? *(const f32x4*)(p.scores + (size_t)t * NE + lane * 4) : (f32x4){0.f, 0.f, 0.f, 0.f}; }
#pragma unroll 1
        for (int k = 0; k < 8; ++k) {
            const int t = t0 + k * nw;
            if (t >= T) break;
            f32x4 sc = scs[0];
#pragma unroll
            for (int kk = 1; kk < 8; ++kk) sc = (k == kk) ? scs[kk] : sc;
            const float sel[4] = {sc[0] + bias[0], sc[1] + bias[1], sc[2] + bias[2], sc[3] + bias[3]};
            float m1 = fmaxf(sel[0], sel[1]), m2 = fminf(sel[0], sel[1]);
            m2 = fmaxf(m2, fminf(m1, sel[2])); m1 = fmaxf(m1, sel[2]);
            m2 = fmaxf(m2, fminf(m1, sel[3])); m1 = fmaxf(m1, sel[3]);
#pragma unroll
            for (int off = 1; off < 8; off <<= 1) {
                const float o1 = shfl_lane(m1, lane ^ off), o2 = shfl_lane(m2, lane ^ off);
                const float n2 = fmaxf(fminf(m1, o1), fmaxf(m2, o2));
                m1 = fmaxf(m1, o1); m2 = n2;
            }
            const float gs = m1 + m2;
            const int g = lane >> 3;
            int rank = 0;
#pragma unroll
            for (int gg = 0; gg < NG; ++gg) { const float og = __int_as_float(__builtin_amdgcn_readlane(__float_as_int(gs), gg * 8)); rank += (og > gs || (og == gs && gg < g)) ? 1 : 0; }
            const bool gsel = rank < TOPG;
            unsigned ku[4];
#pragma unroll
            for (int i = 0; i < 4; ++i) {
                const unsigned u = __float_as_uint(sel[i]);
                ku[i] = gsel ? ((u & 0x80000000u) ? ~u : (u | 0x80000000u)) : 0u;
            }
            unsigned v8 = 0u;
#pragma unroll 1
            for (int bit = 31; bit >= 0; --bit) {
                const unsigned cand = v8 | (1u << bit);
                const int c = __popcll(__ballot(ku[0] >= cand)) + __popcll(__ballot(ku[1] >= cand)) + __popcll(__ballot(ku[2] >= cand)) + __popcll(__ballot(ku[3] >= cand));
                if (c >= TOPK) v8 = cand;
            }
            int ngt = 0, eqlow = 0, sellow = 0;
            unsigned long long eqm[4];
#pragma unroll
            for (int i = 0; i < 4; ++i) { ngt += __popcll(__ballot(ku[i] > v8)); eqm[i] = __ballot(ku[i] == v8); }
            const int need = TOPK - ngt;
#pragma unroll
            for (int i = 0; i < 4; ++i) eqlow += __builtin_amdgcn_mbcnt_hi((unsigned)(eqm[i] >> 32), __builtin_amdgcn_mbcnt_lo((unsigned)eqm[i], 0u));
            bool selc[4]; int eqrank = eqlow;
#pragma unroll
            for (int i = 0; i < 4; ++i) {
                const bool eq = ku[i] == v8;
                selc[i] = (ku[i] > v8) || (eq && eqrank < need);
                eqrank += eq ? 1 : 0;
            }
            float part = 0.f;
#pragma unroll
            for (int i = 0; i < 4; ++i) {
                const unsigned long long sm = __ballot(selc[i]);
                part += selc[i] ? sc[i] : 0.f;
                sellow += __builtin_amdgcn_mbcnt_hi((unsigned)(sm >> 32), __builtin_amdgcn_mbcnt_lo((unsigned)sm, 0u));
            }
            const float wsum = wave_sum(part, lane);
            int slot = sellow;
#pragma unroll
            for (int i = 0; i < 4; ++i)
                if (selc[i]) {
                    const int e = lane * 4 + i, pr = t * TOPK + slot;
                    p.gate[pr] = sc[i] / wsum * 2.5f;
                    mye[k * 8 + slot] = e;
                    ++slot;
                }
        }
        {
            const int k = lane >> 3, t = t0 + k * nw;
            if (t < T) {
                const int e = mye[lane], pos = atomicAdd(&counts[e * CSTRIDE], 1);
                explist[(size_t)e * ECAP + pos] = t * TOPK + (lane & 7);
            }
        }
    }
}

__device__ __forceinline__ void compute_pend(const Params& p, int* pend, int* cnt) {
    const int tid = opaque_tid();
    if (tid < 64) {
        int c[4], pc[4];
#pragma unroll
        for (int i = 0; i < 4; ++i) { c[i] = p.counts[(tid * 4 + i) * CSTRIDE]; cnt[tid * 4 + i] = c[i]; pc[i] = (c[i] + 127) / 128 * 128; }
        const int ssum = pc[0] + pc[1] + pc[2] + pc[3];
        int inc = ssum;
#pragma unroll
        for (int off = 1; off < 64; off <<= 1) { const int v = shfl_lane_i(inc, tid - off); if (tid >= off) inc += v; }
        int run = inc - ssum;
#pragma unroll
        for (int i = 0; i < 4; ++i) { run += pc[i]; pend[tid * 4 + i] = run; }
    }
    __syncthreads();
}

__device__ __forceinline__ int expert_of_row(const int* pend, int row) {
    int lo = 0, hi = NE - 1;
    while (lo < hi) { const int mid = (lo + hi) >> 1; if (pend[mid] > row) hi = mid; else lo = mid + 1; }
    return lo;
}

__device__ __forceinline__ void phase_routed(const Params& p, int* pend, int* cnt, unsigned char* lds) {
    typedef GemmCfg<128, 256, 2, 4> CFG;
    compute_pend(p, pend, cnt);
    int* prs = (int*)(lds + 131072); float* gts = (float*)(lds + 131072 + 512);
    const bool grouped = (gridDim.x % 8) == 0;
    const int xg = grouped ? (blockIdx.x & 7) : 0, estep = grouped ? 8 : 1;
    const int nslots = grouped ? (gridDim.x >> 3) : gridDim.x;
    int widx = grouped ? (blockIdx.x >> 3) : blockIdx.x, tbase = 0;
    for (int e = xg; e < NE; e += estep) {
      const int ce = cnt[e], ntile = (ce + 127) >> 7;
      for (; widx < tbase + ntile; widx += nslots) {
        const int q0 = (widx - tbase) * 128;
        {
            const int tid = opaque_tid();
            if (tid < 128) {
                const int pr = (q0 + tid < ce) ? p.explist[(size_t)e * ECAP + q0 + tid] : -1;
                prs[tid] = pr; gts[tid] = pr >= 0 ? p.gate[pr] : 0.f;
            }
        }
        __syncthreads();
#pragma unroll 1
        for (int tn_ = 0; tn_ < 2 * RU; ++tn_) {
            const int tn = tn_ & 1;
            LoadRowsBf16<128> al[2]; LoadKNF32 bl[2];
#pragma unroll
            for (int u = 0; u < 2; ++u) {
                al[u].init(p.hb, D, [&](int r) { const int pr = prs[r]; return (long long)(pr >= 0 ? (pr >> 3) : 0); });
                bl[u].init(p.w_eu + (size_t)e * D * (2 * EFF), 2 * EFF, [&](int r) { return ((r >> 5) & 1) * EFF + tn * 128 + (r >> 6) * 32 + (r & 31); });
            }
            f32x16 acc[CFG::MI][CFG::NI];
            acc_zero<CFG>(acc);
            gemm_mainloop2<CFG, false, 0>(al, bl, D / 64, acc, lds, nullptr);
            const int tid = opaque_tid(), lane = tid & 63, wid = tid >> 6, wm = wid / CFG::WN, wn = wid % CFG::WN;
            const int j = tn * 128 + wn * 32 + (lane & 31);
            unsigned char* img = lds + 65536 + (((j >> 6) + 2) & 3) * 16384 + (j & 7) * 2;
            const int jc = (j & 63) >> 3;
#pragma unroll
            for (int mi = 0; mi < CFG::MI; ++mi)
#pragma unroll
                for (int r = 0; r < 16; ++r) {
                    const int row = wm * CFG::TM + mi * 32 + (r & 3) + 8 * (r >> 2) + 4 * (lane >> 5);
                    *(bf16_t*)(img + row * 128 + ((jc ^ swz(row)) << 4)) = to_bf16(siluf_(acc[mi][0][r]) * acc[mi][1][r]);
                }
        }
        __syncthreads();
#pragma unroll 1
        for (int tn_ = 0; tn_ < 4 * RD; ++tn_) {
            const int tn = tn_ & 3;
            LoadRowsBf16<128> aldummy[2]; LoadKNF32 bl[2];
#pragma unroll
            for (int u = 0; u < 2; ++u) bl[u].init(p.w_ed + (size_t)e * EFF * D, D, [&](int r) { return tn * 256 + r; });
            f32x16 acc[CFG::MI][CFG::NI];
            acc_zero<CFG>(acc);
            gemm_mainloop2<CFG, true, 2>(aldummy, bl, EFF / 64, acc, lds, lds + 65536);
            acc_foreach<CFG>(acc, [&](int r, int c, float v, int, int, int) {
                const int pr = prs[r];
                if (pr >= 0) p.ypairb[(size_t)pr * D + tn * 256 + c] = to_bf16(v * gts[r]);
                return v;
            });
        }
        __syncthreads();
      }
      tbase += ntile;
    }
}

#ifndef R0
#define R0 1
#define R1 1
#define R2 1
#define R3 1
#define R4 1
#define R5 1
#define R6 1
#define R7 1
#define R8 1
#define R10 1
#define R11 1
#define R12 1
#endif

constexpr int LDS_MAIN = 133120;
__global__ void __launch_bounds__(NT) fwd_megakernel(KArgs ka) {
    __shared__ __attribute__((aligned(16))) unsigned char lds[LDS_MAIN + 2 * NE * 4 + 16];
    float* smem = (float*)lds;
    int* pend = (int*)(lds + LDS_MAIN);
    int* cnt = pend + NE;
    volatile LAS3 unsigned* xbst = (volatile LAS3 unsigned*)(lds + LDS_MAIN + 2 * NE * 4);
    if (threadIdx.x == 0) { xbst[0] = 0u; xbst[1] = 0u; }
    __syncthreads();
    const XcdBarrier xb = xcd_barrier_post((unsigned*)(ka.ws + OFF_BAR), xbst);

#define REPEAT(N, ...) { int reps_ = (N); asm volatile("" : "+s"(reps_)); for (int rep_ = 0; rep_ < reps_; ++rep_) { { const Params p(ka); __VA_ARGS__; } xcd_barrier(xb); } }
    { const Params p(ka); phase_init(p); }
    REPEAT(R0,
        convert_bf16(p.x, p.xb, (size_t)T * D);
        transpose_convert(p.w_in, D, PW, PWP, p.w_in_t, smem, [](int n) { return n < 2048 ? n : n < 5632 ? n + 8 : n < 5640 ? n - 5632 + 2048 : -1; });
        transpose_convert(p.w_pa, DNW, D, D, p.w_pa_t, smem, [](int n) { return n; });
        transpose_convert(p.w_pb, SBW, D, D, p.w_pb_t, smem, [](int n) { return n; });
        transpose_convert(p.w_out, D, D, D, p.w_out_t, smem, [](int n) { return n; });
        transpose_convert(p.w_router, D, NE, NE, p.w_router_t, smem, [](int n) { return n; });
        transpose_convert(p.w_su, D, 2 * SFF, 2 * SFF, p.w_su_t, smem, [](int n) { return n; });
        transpose_convert(p.w_sd, SFF, D, D, p.w_sd_t, smem, [](int n) { return n; }))
    REPEAT(R1, phase_inproj(p, lds))
    REPEAT(R2, phase_dn_chunks(p, lds))
    REPEAT(R3, phase_mixers(p, smem))
    REPEAT(R4, phase_gated_norm(p))
    REPEAT(R5, phase_merge(p, lds))
    REPEAT(R6, phase_outproj(p, lds))
    REPEAT(R7, layer_norm_rows([&](int t, int c) { return p.pre1[(size_t)t * D + c]; }, p.ln1_g, p.ln1_b, p.h, p.hb))
    REPEAT(R8, phase_router_shared_up(p, lds))
    { const Params p(ka); phase_route(p, p.counts, p.explist, (int*)lds); }
    xcd_barrier(xb);
    { int reps9 = R9 - 1; asm volatile("" : "+s"(reps9)); for (int r9 = 0; r9 < reps9; ++r9) { const Params p(ka); phase_route(p, p.counts + NE * CSTRIDE, (int*)p.ypairb, (int*)lds); xcd_barrier(xb); } }
    { int repsb = RB; asm volatile("" : "+s"(repsb)); for (int rb = 0; rb < repsb; ++rb) xcd_barrier(xb); }
    REPEAT(R10, phase_routed(p, pend, cnt, lds); phase_shared_down(p, lds))
    int reps12 = R12; asm volatile("" : "+s"(reps12));
    for (int rep = 0; rep < reps12; ++rep) {
        const Params p(ka);
        layer_norm_rows([&](int t, int c) {
                float f = p.ysh[(size_t)t * D + c];
#pragma unroll
                for (int k = 0; k < TOPK; ++k) f += bf2f(p.ypairb[((size_t)t * TOPK + k) * D + c]);
                return ALPHA * p.h[(size_t)t * D + c] + f; },
            p.ln2_g, p.ln2_b, p.out, nullptr);
    }
}

extern "C" void kernel_launch(void* const* d_in, const int* in_sizes, int n_in, void* d_out, int out_size, void* d_ws,
                              size_t ws_size, hipStream_t stream) {
    static int grid_blocks = 0;
    if (!grid_blocks) {
        int dev = 0, cus = 0, per_cu = 0;
        hipGetDevice(&dev);
        hipDeviceGetAttribute(&cus, hipDeviceAttributeMultiprocessorCount, dev);
        hipOccupancyMaxActiveBlocksPerMultiprocessor(&per_cu, fwd_megakernel, NT, 0);
        if (per_cu > 1) per_cu = 1;
        grid_blocks = cus * per_cu;
    }
    KArgs p{};
    const float* const* in = (const float* const*)d_in;
    p.x = in[0]; p.w_in = in[1]; p.conv_w = in[2]; p.a_log = in[3]; p.dt_bias = in[4]; p.norm_g = in[5]; p.w_pa = in[6];
    p.w_pb = in[7]; p.w_out = in[8]; p.ln1_g = in[9]; p.ln1_b = in[10]; p.w_router = in[11]; p.router_bias = in[12];
    p.w_su = in[13]; p.w_sd = in[14]; p.w_eu = in[15]; p.w_ed = in[16]; p.ln2_g = in[17]; p.ln2_b = in[18];
    p.out = (float*)d_out; p.ws = (unsigned char*)d_ws;
    if (WS_BYTES > ws_size) { fprintf(stderr, "workspace too small: need %zu have %zu\n", (size_t)WS_BYTES, ws_size); return; }
    hipMemsetAsync(p.ws + OFF_BAR, 0, XCD_BAR_WORDS * 4, stream);
    void* args[] = {&p};
    hipError_t e = hipLaunchCooperativeKernel((void*)fwd_megakernel, dim3(grid_blocks), dim3(NT), args, 0, stream);
    if (e != hipSuccess) fprintf(stderr, "cooperative launch failed: %s (grid %d)\n", hipGetErrorString(e), grid_blocks);
}
```

```cpp
#include <hip/hip_runtime.h>
#include <hip/hip_cooperative_groups.h>
#include <cstdio>
#include <cstdint>
namespace cg = cooperative_groups;

constexpr int D = 1024, NB = 8, SEQ = 2048, T = NB * SEQ;
constexpr int DNH = 4, DND = 128, DNW = 512;
constexpr int SBH = 8, SBD = 64, SBW = 512;
constexpr int NE = 256, TOPK = 8, NG = 8, TOPG = 4, EFF = 256, SFF = 256;
constexpr int PW = 5640;
constexpr int NPAIR = T * TOPK;
constexpr int NBLK = (NPAIR + NE * 127 + 127) / 128;
constexpr int PROWS = NBLK * 128;
constexpr float ALPHA = 1.189207115002721f;
constexpr float LN_EPS = 1e-5f, NORM_EPS = 1e-6f;
constexpr int NT = 512;
#ifndef RU
#define RU 1
#define RD 1
#define R9 1
#define RB 0
#endif

typedef unsigned short bf16_t;
constexpr int PWP = 5888;
constexpr int DN_ROWS = 448, DN_BLOB = DN_ROWS * 64;
constexpr int ECAP = T;
#define XCD_BAR_WORDS 3456
constexpr int CSTRIDE = 64;
constexpr size_t al256(size_t x) { return (x + 255) & ~(size_t)255; }
constexpr size_t OFF_XB = 0;
constexpr size_t OFF_WINT = OFF_XB + al256((size_t)T * D * 2);
constexpr size_t OFF_QKVRAW = OFF_WINT + al256((size_t)PWP * D * 2);
constexpr size_t OFF_DZB = OFF_QKVRAW + al256((size_t)T * 1536 * 2);
constexpr size_t OFF_SQ = OFF_DZB + al256((size_t)T * 512 * 2);
constexpr size_t OFF_SK = OFF_SQ + al256((size_t)T * 512 * 2);
constexpr size_t OFF_VT = OFF_SK + al256((size_t)T * 512 * 2);
constexpr size_t OFF_DNBLOB = OFF_VT + al256((size_t)T * 512 * 2);
constexpr size_t OFF_DNU = OFF_DNBLOB + al256((size_t)1024 * DN_BLOB * 2);
constexpr size_t OFF_DNLAST = OFF_DNU + al256((size_t)1024 * 64 * 128 * 4);
constexpr size_t OFF_GAB = OFF_DNLAST + al256(1024 * 4);
constexpr size_t OFF_GBB = OFF_GAB + al256((size_t)T * D * 2);
constexpr size_t OFF_SMALL = OFF_GBB + al256((size_t)T * D * 2);
constexpr size_t OFF_WPAT = OFF_SMALL + al256((size_t)T * 8 * 4);
constexpr size_t OFF_WPBT = OFF_WPAT + al256((size_t)D * DNW * 2);
constexpr size_t OFF_WOUTT = OFF_WPBT + al256((size_t)D * SBW * 2);
constexpr size_t OFF_WROUTT = OFF_WOUTT + al256((size_t)D * D * 2);
constexpr size_t OFF_WSUT = OFF_WROUTT + al256((size_t)NE * D * 2);
constexpr size_t OFF_WSDT = OFF_WSUT + al256((size_t)2 * SFF * D * 2);
constexpr size_t OFF_OAB = OFF_WSDT + al256((size_t)D * SFF * 2);
constexpr size_t OFF_OBB = OFF_OAB + al256((size_t)T * DNW * 2);
constexpr size_t OFF_MERGED = OFF_OBB + al256((size_t)T * SBW * 2);
constexpr size_t OFF_HB = OFF_MERGED + al256((size_t)T * D * 2);
constexpr size_t OFF_ACTSH = OFF_HB + al256((size_t)T * D * 2);
constexpr size_t OFF_YPAIRB = OFF_ACTSH + al256((size_t)T * SFF * 2);
constexpr size_t OFF_ORAW = OFF_YPAIRB + al256((size_t)NPAIR * D * 2);
constexpr size_t OFF_PRE1 = OFF_ORAW + al256((size_t)T * DNW * 4);
constexpr size_t OFF_H = OFF_PRE1 + al256((size_t)T * D * 4);
constexpr size_t OFF_SCORES = OFF_H + al256((size_t)T * D * 4);
constexpr size_t OFF_GATE = OFF_SCORES + al256((size_t)T * NE * 4);
constexpr size_t OFF_YSH = OFF_GATE + al256((size_t)NPAIR * 4);
constexpr size_t OFF_IDX = OFF_YSH + al256((size_t)T * D * 4);
constexpr size_t OFF_COUNTS = OFF_IDX + al256((size_t)NPAIR * 4);
constexpr size_t OFF_EXPLIST = OFF_COUNTS + al256(2 * NE * CSTRIDE * 4);
constexpr size_t OFF_WEUT = OFF_EXPLIST + al256((size_t)NE * ECAP * 4);
constexpr size_t OFF_M1 = OFF_WEUT + al256((size_t)NE * 2 * EFF * D * 2);
constexpr size_t OFF_BAR = OFF_M1 + al256((size_t)T * D * 4);
constexpr size_t WS_BYTES = OFF_BAR + al256(XCD_BAR_WORDS * 4);

struct KArgs {
    const float *x, *w_in, *conv_w, *a_log, *dt_bias, *norm_g, *w_pa, *w_pb, *w_out, *ln1_g, *ln1_b, *w_router,
        *router_bias, *w_su, *w_sd, *w_eu, *w_ed, *ln2_g, *ln2_b;
    float* out; unsigned char* ws;
};
struct Params {
    const float *x, *w_in, *conv_w, *a_log, *dt_bias, *norm_g, *w_pa, *w_pb, *w_out, *ln1_g, *ln1_b, *w_router,
        *router_bias, *w_su, *w_sd, *w_eu, *w_ed, *ln2_g, *ln2_b;
    float* out;
    float *oraw, *pre1, *h, *scores, *gate, *ysh, *small, *dnu, *dnlast, *m1;
    int *idx, *counts, *explist;
    bf16_t *xb, *w_in_t, *w_pa_t, *w_pb_t, *w_out_t, *w_router_t, *w_su_t, *w_sd_t, *oab, *obb, *mergedb, *hb, *actsh, *ypairb, *yshb;
    bf16_t *qkvraw, *dzb, *sq, *sk, *vT, *gab, *gbb, *dnblob, *w_eu_t;
    unsigned* bar;
    __device__ __forceinline__ explicit Params(const KArgs& k) {
        x = k.x; w_in = k.w_in; conv_w = k.conv_w; a_log = k.a_log; dt_bias = k.dt_bias; norm_g = k.norm_g; w_pa = k.w_pa; w_pb = k.w_pb;
        w_out = k.w_out; ln1_g = k.ln1_g; ln1_b = k.ln1_b; w_router = k.w_router; router_bias = k.router_bias; w_su = k.w_su; w_sd = k.w_sd;
        w_eu = k.w_eu; w_ed = k.w_ed; ln2_g = k.ln2_g; ln2_b = k.ln2_b; out = k.out;
        unsigned char* w = k.ws; asm volatile("" : "+s"(w));
        xb = (bf16_t*)(w + OFF_XB); w_in_t = (bf16_t*)(w + OFF_WINT); qkvraw = (bf16_t*)(w + OFF_QKVRAW); dzb = (bf16_t*)(w + OFF_DZB);
        sq = (bf16_t*)(w + OFF_SQ); sk = (bf16_t*)(w + OFF_SK); vT = (bf16_t*)(w + OFF_VT); dnblob = (bf16_t*)(w + OFF_DNBLOB);
        dnu = (float*)(w + OFF_DNU); dnlast = (float*)(w + OFF_DNLAST); gab = (bf16_t*)(w + OFF_GAB); gbb = (bf16_t*)(w + OFF_GBB);
        small = (float*)(w + OFF_SMALL); w_pa_t = (bf16_t*)(w + OFF_WPAT); w_pb_t = (bf16_t*)(w + OFF_WPBT); w_out_t = (bf16_t*)(w + OFF_WOUTT);
        w_router_t = (bf16_t*)(w + OFF_WROUTT); w_su_t = (bf16_t*)(w + OFF_WSUT); w_sd_t = (bf16_t*)(w + OFF_WSDT);
        oab = (bf16_t*)(w + OFF_OAB); obb = (bf16_t*)(w + OFF_OBB); mergedb = (bf16_t*)(w + OFF_MERGED); hb = (bf16_t*)(w + OFF_HB);
        actsh = (bf16_t*)(w + OFF_ACTSH); ypairb = (bf16_t*)(w + OFF_YPAIRB); oraw = (float*)(w + OFF_ORAW); pre1 = (float*)(w + OFF_PRE1);
        h = (float*)(w + OFF_H); scores = (float*)(w + OFF_SCORES); gate = (float*)(w + OFF_GATE); ysh = (float*)(w + OFF_YSH); yshb = (bf16_t*)(w + OFF_YSH);
        idx = (int*)(w + OFF_IDX); counts = (int*)(w + OFF_COUNTS); explist = (int*)(w + OFF_EXPLIST); bar = (unsigned*)(w + OFF_BAR); w_eu_t = (bf16_t*)(w + OFF_WEUT); m1 = (float*)(w + OFF_M1);
    }
};

__device__ __forceinline__ float sigmoidf_(float v) { return 1.f / (1.f + expf(-v)); }
__device__ __forceinline__ float siluf_(float v) { return v / (1.f + expf(-v)); }
__device__ __forceinline__ float shfl_lane(float v, int src) { return __int_as_float(__builtin_amdgcn_ds_bpermute(src << 2, __float_as_int(v))); }
__device__ __forceinline__ int shfl_lane_i(int v, int src) { return __builtin_amdgcn_ds_bpermute(src << 2, v); }
__device__ __forceinline__ float wave_sum(float v, int lane) {
#pragma unroll
    for (int o = 32; o > 0; o >>= 1) v += shfl_lane(v, lane ^ o);
    return v;
}


#define XB_TMO      128
#define XB_XCNT(j)  (256  + 64 * (j))
#define XB_XSUB(j)  (1280 + 64 * (j))
#define XB_XGEN(j)  (2304 + 64 * (j))
#define XB_TOP      3328
#define XB_TOPGEN   3392
#define XB_SPIN_CAP (1u << 24)
#define LAS3 __attribute__((address_space(3)))
__device__ __forceinline__ unsigned xb_ld(unsigned* p)              { return __hip_atomic_load(p, __ATOMIC_RELAXED, __HIP_MEMORY_SCOPE_AGENT); }
__device__ __forceinline__ unsigned xb_add(unsigned* p, unsigned v) { return __hip_atomic_fetch_add(p, v, __ATOMIC_RELAXED, __HIP_MEMORY_SCOPE_AGENT); }
__device__ __forceinline__ unsigned xb_xcc_id() { return (unsigned)__builtin_amdgcn_s_getreg((3 << 11) | 20) & 0xFu; }
#define XB_SPIN(cond, bar) do { unsigned _sp = 0; while (cond) { __builtin_amdgcn_s_sleep(1); \
    if ((++_sp & 255u) == 0u) { if (xb_ld(&(bar)[XB_TMO])) break; if (_sp > XB_SPIN_CAP) { atomicAdd(&(bar)[XB_TMO], 1u); break; } } } } while (0)
struct XcdBarrier { unsigned* bar; unsigned x; volatile LAS3 unsigned* st; };
__device__ __forceinline__ XcdBarrier xcd_barrier_post(unsigned* bar, volatile LAS3 unsigned* st) {
    XcdBarrier b; b.bar = bar; b.x = xb_xcc_id(); b.st = st;
    if (threadIdx.x == 0) (void)xb_add(&bar[XB_XCNT(b.x)], 1u);
    return b;
}
__device__ __forceinline__ void xcd_barrier_complete(unsigned* bar, unsigned x, unsigned& nloc, unsigned& nx) {
    const unsigned G = gridDim.x * gridDim.y * gridDim.z;
    unsigned sum, cnt, mine, sp = 0u;
    asm volatile("" : "+s"(x));
    for (;;) {
        sum = 0u; cnt = 0u; mine = 0u;
#pragma unroll 1
        for (unsigned j = 0; j < 16; ++j) { const unsigned c = xb_ld(&bar[XB_XCNT(j)]); sum += c; cnt += (c > 0u) ? 1u : 0u; mine = (j == x) ? c : mine; }
        if (sum == G) break;
        __builtin_amdgcn_s_sleep(1);
        if ((++sp & 255u) == 0u) { if (xb_ld(&bar[XB_TMO])) break; if (sp > XB_SPIN_CAP) { atomicAdd(&bar[XB_TMO], 1u); break; } }
    }
    nloc = mine > 0u ? mine : 1u; nx = cnt > 0u ? cnt : 1u;
}
__device__ __forceinline__ void xcd_barrier(const XcdBarrier& b) {
    asm volatile("s_waitcnt vmcnt(0)" ::: "memory");
    __syncthreads();
    if (threadIdx.x == 0) {
        unsigned* bar = b.bar;
        __builtin_amdgcn_s_waitcnt(0);
        unsigned nloc = b.st[0], nx = b.st[1];
        if (nloc == 0u) { xcd_barrier_complete(bar, b.x, nloc, nx); b.st[0] = nloc; b.st[1] = nx; }
        const unsigned old = xb_add(&bar[XB_XSUB(b.x)], 1u);
        const unsigned gen = old / nloc;
        if (old + 1u == (gen + 1u) * nloc) {
            __builtin_amdgcn_fence(__ATOMIC_RELEASE, "agent");
            asm volatile("s_waitcnt vmcnt(0)" ::: "memory");
            const unsigned og = xb_add(&bar[XB_TOP], 1u);
            const unsigned tg = og / nx;
            if (og + 1u == (tg + 1u) * nx) xb_add(&bar[XB_TOPGEN], 1u);
            else XB_SPIN(xb_ld(&bar[XB_TOPGEN]) == tg, bar);
            __builtin_amdgcn_fence(__ATOMIC_ACQUIRE, "agent");
            xb_add(&bar[XB_XGEN(b.x)], 1u);
            asm volatile("s_waitcnt vmcnt(0)" ::: "memory");
        } else {
            XB_SPIN(xb_ld(&bar[XB_XGEN(b.x)]) == gen, bar);
            __builtin_amdgcn_fence(__ATOMIC_ACQUIRE, "agent");
            asm volatile("s_waitcnt vmcnt(0)" ::: "memory");
        }
    }
    __syncthreads();
}

typedef short bf16x8 __attribute__((ext_vector_type(8)));
typedef float f32x16 __attribute__((ext_vector_type(16)));
typedef float f32x4 __attribute__((ext_vector_type(4)));
__device__ __forceinline__ unsigned pk_bf16(float a, float b) {
    typedef __bf16 bf2 __attribute__((ext_vector_type(2)));
    typedef float f2 __attribute__((ext_vector_type(2)));
    f2 v = {a, b};
    bf2 r = __builtin_convertvector(v, bf2);
    return __builtin_bit_cast(unsigned, r);
}
__device__ __forceinline__ bf16_t to_bf16(float a) { return (bf16_t)(pk_bf16(a, 0.f) & 0xffffu); }
__device__ __forceinline__ float bf2f(bf16_t v) { return __uint_as_float((unsigned)v << 16); }

__device__ __forceinline__ int opaque_tid() { int t = threadIdx.x; asm volatile("" : "+v"(t)); return t; }
constexpr int LROW = 128;
__device__ __forceinline__ int swz(int r) { return ((r >> 2) & 7) ^ ((r >> 1) & 1); }

template <int ROWS, bool MAYBE_NULL = false> struct LoadRowsBf16 {
    static constexpr int NCH = ROWS * 8 / NT;
    const bf16_t* base; int tid;
    unsigned off[NCH];
    uint4 regs[NCH];
    template <class RF> __device__ __forceinline__ void init(const bf16_t* base_, int ld, RF rowfn) {
        base = base_; tid = opaque_tid();
#pragma unroll
        for (int i = 0; i < NCH; ++i) {
            const int c = tid + i * NT, r = c >> 3, ch = c & 7;
            const long long src = rowfn(r);
            off[i] = (!MAYBE_NULL || src >= 0) ? (unsigned)(src * ld + ch * 8) : 0xffffffffu;
        }
    }
    __device__ __forceinline__ void load(int k0) {
#pragma unroll
        for (int i = 0; i < NCH; ++i)
            regs[i] = (!MAYBE_NULL || off[i] != 0xffffffffu) ? *(const uint4*)(base + (size_t)off[i] + k0) : make_uint4(0, 0, 0, 0);
    }
    __device__ __forceinline__ void store(unsigned char* lds) const {
#pragma unroll
        for (int i = 0; i < NCH; ++i) {
            const int c = tid + i * NT, r = c >> 3, ch = c & 7;
            *(uint4*)(lds + r * LROW + ((ch ^ swz(r)) << 4)) = regs[i];
        }
    }
};

__device__ __forceinline__ int pi16(int x) { return (x & ~12) | ((x & 4) << 1) | ((x & 8) >> 1); }
namespace pg8 {
#define PG8_LAS __attribute__((address_space(3)))
typedef unsigned short bf16_t;
typedef short bf16x8 __attribute__((ext_vector_type(8)));
typedef float f32x4 __attribute__((ext_vector_type(4)));
typedef unsigned u32x4 __attribute__((ext_vector_type(4)));
constexpr int BM = 256, BK = 64, HALF = 128, HTB = HALF * BK * 2  , STAGE_BYTES = 8 * HTB, NXCD = 8, WGM = 8;

__host__ __device__ __forceinline__ int lds_byte(int r, int c) { const int st = (r >> 4) * 2 + (c >> 5), rr = r & 15, cc = c & 31, ob = rr * 64 + cc * 2; return st * 1024 + (ob ^ (((ob >> 9) & 1) << 5)); }
__host__ __device__ __forceinline__ void stage_rc(int b, int& R, int& C) { const int st = b / 1024, sb = b % 1024, swz = sb ^ (((sb >> 9) & 1) << 5); R = (st >> 1) * 16 + swz / 64; C = (st & 1) * 32 + (swz % 64) / 2; }
__host__ __device__ __forceinline__ int perm32(int rho) { const int n = rho >> 4, i = rho & 15; return 8 * (i >> 2) + 4 * n + (i & 3); }

struct Unit { int pm, pn; };
struct Gemm { const bf16_t* A; const bf16_t* Bt; int M, N, K; };

struct StaticOrder {
    int nM, nN, nwg, G, c;
    __host__ __device__ void init(int M, int N, int G_, int c_) { nM = M / BM; nN = N / BM; nwg = nM * nN; G = G_; c = c_; }
    __host__ __device__ bool next(int i, Unit& u) const {
        const long L = (long)i * G + c; if (L >= nwg) return false;
        int wgid = (int)L; { const int q = nwg / NXCD, r = nwg % NXCD, xcd = wgid % NXCD, off = wgid / NXCD; wgid = (xcd < r ? xcd * (q + 1) : r * (q + 1) + (xcd - r) * q) + off; }
        const int nig = WGM * nN, gid = wgid / nig, fm = gid * WGM, gsz = (nM - fm) < WGM ? (nM - fm) : WGM;
        u.pm = fm + ((wgid % nig) % gsz); u.pn = (wgid % nig) / gsz; return true;
    }
    __device__ __forceinline__ void a_ready(const Unit&) const {}
    __device__ __forceinline__ void done(const Unit&) const {}
};


__device__ __forceinline__ unsigned cvt_pk_bf16(float lo, float hi) { unsigned r; asm volatile("v_cvt_pk_bf16_f32 %0, %1, %2" : "=v"(r) : "v"(lo), "v"(hi)); return r; }

template <class Epi, class Sched, bool ALIGN_EPI = false, bool SP2 = false>
__device__ __forceinline__ void gemm_phase(PG8_LAS unsigned char* lds, const Gemm g, const Sched& S, const Epi& E) {
    const int tid = opaque_tid(), wid = __builtin_amdgcn_readfirstlane(tid >> 6), lane = tid & 63, wr = wid >> 2, wc = wid & 3, fr = lane & 15, fq = lane >> 4;
    const int K = g.K, nt = K / BK;
    unsigned voffA[2], voffB[2];
#pragma unroll
    for (int i = 0; i < 2; ++i) { int R, C; stage_rc(tid * 16 + i * 8192, R, C); const int Rb = Epi::PERM ? ((R & ~31) + perm32(R & 31)) : R;
        voffA[i] = (unsigned)(R * K + C) * 2u; voffB[i] = (unsigned)(Rb * K + C) * 2u; }
    const size_t rstep64 = (size_t)64 * K * 2;
    const size_t kstep = (size_t)(BK * 2);
    const size_t hstep = (size_t)HALF * K * 2;
    const size_t tstep = 2 * hstep;
    const unsigned ldsw = (unsigned)wid * 1024u;
    const int aoff = lds_byte(wr * 64 + fr, fq * 8), boff = lds_byte(wc * 32 + fr, fq * 8);
#define PG8_SA(b, h) (((b) * 2 + (h)) * HTB)
#define PG8_SB(b, h) ((4 + (b) * 2 + (h)) * HTB)
#define PG8_STAGE(bufoff, gbase, voff) do { _Pragma("unroll") for (int _i = 0; _i < 2; ++_i) \
        __builtin_amdgcn_global_load_lds((const unsigned*)((const char*)(gbase) + (size_t)_i * rstep64 + (voff)[0]), (PG8_LAS unsigned*)(lds + (bufoff) + ldsw + _i * 8192), 16, 0, 0); } while (0)
#define PG8_LDA(dst, b, h) do { _Pragma("unroll") for (int m = 0; m < 4; ++m) _Pragma("unroll") for (int k = 0; k < 2; ++k) dst[m][k] = *(const PG8_LAS bf16x8*)(lds + PG8_SA(b, h) + aoff + m * 2048 + k * 1024); } while (0)
#define PG8_LDB(dst, b, h) do { _Pragma("unroll") for (int n = 0; n < 2; ++n) _Pragma("unroll") for (int k = 0; k < 2; ++k) dst[n][k] = *(const PG8_LAS bf16x8*)(lds + PG8_SB(b, h) + boff + n * 2048 + k * 1024); } while (0)
#define PG8_MMA(ai, bj, At, Bt) do { __builtin_amdgcn_s_setprio(1); _Pragma("unroll") for (int m = 0; m < 4; ++m) _Pragma("unroll") for (int n = 0; n < 2; ++n) _Pragma("unroll") for (int k = 0; k < 2; ++k) \
        acc[ai][bj][m][n] = __builtin_amdgcn_mfma_f32_16x16x32_bf16(Bt[n][k], At[m][k], acc[ai][bj][m][n], 0, 0, 0); __builtin_amdgcn_s_setprio(0); } while (0)
#define PG8_WAIT_V(n) asm volatile("s_waitcnt vmcnt(" #n ")" ::: "memory")
#define PG8_WAIT_L(n) asm volatile("s_waitcnt lgkmcnt(" #n ")" ::: "memory")
#define PG8_BAR __builtin_amdgcn_s_barrier()
#define PG8_SCHED __builtin_amdgcn_sched_barrier(0)
    Unit cur, nxt; int ui = 0;
    if (!S.next(0, cur)) return;
    f32x4 acc[2][2][4][2];
#pragma unroll
    for (int a = 0; a < 2; ++a)
#pragma unroll
        for (int b = 0; b < 2; ++b)
#pragma unroll
            for (int m = 0; m < 4; ++m)
#pragma unroll
                for (int n = 0; n < 2; ++n) acc[a][b][m][n] = (f32x4){0.f, 0.f, 0.f, 0.f};
    bf16x8 At[4][2], B0[2][2], B1[2][2];
    const char* cA = (const char*)g.A + (size_t)cur.pm * tstep; const char* cB = (const char*)g.Bt + (size_t)cur.pn * tstep;
    S.a_ready(cur);
    if constexpr (SP2) {
        PG8_STAGE(PG8_SB(0, 0), cB, voffB); PG8_STAGE(PG8_SB(0, 1), cB + hstep, voffB); PG8_STAGE(PG8_SA(0, 0), cA, voffA); PG8_STAGE(PG8_SA(0, 1), cA + hstep, voffA);
        if (wr == 1) PG8_BAR;
        PG8_WAIT_V(2); PG8_BAR;
        PG8_STAGE(PG8_SB(1, 0), cB + kstep, voffB); PG8_STAGE(PG8_SA(1, 0), cA + kstep, voffA); PG8_STAGE(PG8_SB(1, 1), cB + hstep + kstep, voffB);
        PG8_WAIT_V(6); PG8_BAR;
    } else {
        PG8_STAGE(PG8_SB(0, 0), cB, voffB); PG8_STAGE(PG8_SA(0, 0), cA, voffA); PG8_STAGE(PG8_SB(0, 1), cB + hstep, voffB); PG8_STAGE(PG8_SA(0, 1), cA + hstep, voffA);
        if (wr == 1) PG8_BAR;
        PG8_WAIT_V(4); PG8_BAR;
        PG8_STAGE(PG8_SB(1, 0), cB + kstep, voffB); PG8_STAGE(PG8_SA(1, 0), cA + kstep, voffA); PG8_STAGE(PG8_SB(1, 1), cB + hstep + kstep, voffB);
        PG8_WAIT_V(6); PG8_BAR;
    }
    for (;;) {
        const bool has_next = S.next(ui + 1, nxt);
        const char* nA = has_next ? (const char*)g.A + (size_t)nxt.pm * tstep : cA; const char* nB = has_next ? (const char*)g.Bt + (size_t)nxt.pn * tstep : cB;
        for (int t = 0; t < nt; t += 2) {
            const bool last = (t == nt - 2);
            const char* a1 = cA + (size_t)(t + 1) * kstep;
            const char* a2 = last ? nA : cA + (size_t)(t + 2) * kstep; const char* b2 = last ? nB : cB + (size_t)(t + 2) * kstep;
            const char* a3 = a2 + kstep; const char* b3 = b2 + kstep;
            if (last && has_next) S.a_ready(nxt);
            if constexpr (SP2) {
            PG8_LDB(B0, 0, 0); PG8_LDB(B1, 0, 1); PG8_SCHED; PG8_LDA(At, 0, 0); PG8_STAGE(PG8_SA(1, 1), a1 + hstep, voffA);
            PG8_WAIT_V(8); PG8_WAIT_L(0); PG8_BAR; PG8_MMA(0, 0, At, B0); PG8_MMA(0, 1, At, B1); PG8_BAR; PG8_SCHED;
            PG8_LDA(At, 0, 1); PG8_STAGE(PG8_SB(0, 0), b2, voffB); PG8_STAGE(PG8_SB(0, 1), b2 + hstep, voffB); PG8_STAGE(PG8_SA(0, 0), a2, voffA);
            PG8_WAIT_V(8); PG8_WAIT_L(0); PG8_BAR; PG8_MMA(1, 0, At, B0); PG8_MMA(1, 1, At, B1); PG8_BAR; PG8_SCHED;
            PG8_LDB(B0, 1, 0); PG8_LDB(B1, 1, 1); PG8_SCHED; PG8_LDA(At, 1, 0); PG8_STAGE(PG8_SA(0, 1), a2 + hstep, voffA);
            PG8_WAIT_V(8); PG8_WAIT_L(0); PG8_BAR; PG8_MMA(0, 0, At, B0); PG8_MMA(0, 1, At, B1); PG8_BAR; PG8_SCHED;
            PG8_LDA(At, 1, 1); PG8_STAGE(PG8_SB(1, 0), b3, voffB); PG8_STAGE(PG8_SB(1, 1), b3 + hstep, voffB); PG8_STAGE(PG8_SA(1, 0), a3, voffA);
            PG8_WAIT_V(8); PG8_WAIT_L(0); PG8_BAR; PG8_MMA(1, 0, At, B0); PG8_MMA(1, 1, At, B1); PG8_BAR; PG8_SCHED;
            } else {
            PG8_LDB(B0, 0, 0); PG8_SCHED; PG8_LDA(At, 0, 0); PG8_STAGE(PG8_SA(1, 1), a1 + hstep, voffA);
            PG8_WAIT_L(8); PG8_BAR; PG8_WAIT_L(0); PG8_MMA(0, 0, At, B0); PG8_BAR; PG8_SCHED;
            PG8_LDB(B1, 0, 1); PG8_STAGE(PG8_SB(0, 0), b2, voffB);
            PG8_BAR; PG8_WAIT_L(0); PG8_MMA(0, 1, At, B1); PG8_BAR;
            PG8_LDA(At, 0, 1); PG8_STAGE(PG8_SA(0, 0), a2, voffA);
            PG8_BAR; PG8_WAIT_L(0); PG8_MMA(1, 0, At, B0); PG8_BAR; PG8_SCHED;
            PG8_STAGE(PG8_SB(0, 1), b2 + hstep, voffB);
            PG8_WAIT_V(6); PG8_BAR; PG8_MMA(1, 1, At, B1); PG8_BAR;
            PG8_LDB(B0, 1, 0); PG8_SCHED; PG8_LDA(At, 1, 0); PG8_STAGE(PG8_SA(0, 1), a2 + hstep, voffA);
            PG8_WAIT_L(8); PG8_BAR; PG8_WAIT_L(0); PG8_MMA(0, 0, At, B0); PG8_BAR; PG8_SCHED;
            PG8_LDB(B1, 1, 1); PG8_STAGE(PG8_SB(1, 0), b3, voffB);
            PG8_BAR; PG8_WAIT_L(0); PG8_MMA(0, 1, At, B1); PG8_BAR;
            PG8_LDA(At, 1, 1); PG8_STAGE(PG8_SA(1, 0), a3, voffA);
            PG8_BAR; PG8_WAIT_L(0); PG8_MMA(1, 0, At, B0); PG8_BAR; PG8_SCHED;
            PG8_STAGE(PG8_SB(1, 1), b3 + hstep, voffB);
            PG8_WAIT_V(6); PG8_BAR; PG8_MMA(1, 1, At, B1); PG8_BAR;
            }
        }
        if constexpr (ALIGN_EPI) { if (wr == 0) PG8_BAR; }
        if constexpr (!Epi::AFTER_DRAIN) { E(acc, cur, wr, wc, fr, fq); S.done(cur); }
        if (!has_next) break;
#pragma unroll
        for (int a = 0; a < 2; ++a)
#pragma unroll
            for (int b = 0; b < 2; ++b)
#pragma unroll
                for (int m = 0; m < 4; ++m)
#pragma unroll
                    for (int n = 0; n < 2; ++n) acc[a][b][m][n] = (f32x4){0.f, 0.f, 0.f, 0.f};
        cur = nxt; cA = nA; cB = nB; ++ui;
        if constexpr (ALIGN_EPI) { if (wr == 1) PG8_BAR; }
    }
    PG8_WAIT_V(0);
    if constexpr (!ALIGN_EPI) { if (wr == 0) PG8_BAR; }
    PG8_BAR;
    if constexpr (Epi::AFTER_DRAIN) { E.fused(acc, cur, wr, wc, fr, fq, lds, wid, lane); S.done(cur); }
#undef PG8_SA
#undef PG8_SB
#undef PG8_STAGE
#undef PG8_LDA
#undef PG8_LDB
#undef PG8_MMA
#undef PG8_WAIT_V
#undef PG8_WAIT_L
#undef PG8_BAR
#undef PG8_SCHED
}
}

struct EpiInproj {
    static constexpr bool PERM = true, AFTER_DRAIN = false;
    bf16_t *qkvraw, *dzb, *sq, *sk, *vT, *gab, *gbb; float* small;
    __device__ __forceinline__ void operator()(const pg8::f32x4 (&acc)[2][2][4][2], const pg8::Unit& u, int wr, int wc, int fr, int fq) const {
        const int pn = u.pn, row0 = u.pm * 256 + wr * 64 + fr;
        if (pn == 12 || pn == 13) {
#pragma unroll
            for (int ai = 0; ai < 2; ++ai)
#pragma unroll
                for (int m = 0; m < 4; ++m) {
                    const int tok = row0 + ai * 128 + m * 16, bb = tok >> 11, key = tok & (SEQ - 1), pos = (key & ~15) | pi16(key & 15);
#pragma unroll
                    for (int bj = 0; bj < 2; ++bj)
#pragma unroll
                        for (int n = 0; n < 2; ++n)
#pragma unroll
                            for (int j = 0; j < 4; ++j) {
                                const int svcol = (pn - 12) * 256 + bj * 128 + wc * 32 + fq * 8 + n * 4 + j;
                                vT[((size_t)((bb * 8 + (svcol >> 6)) * 64 + (svcol & 63))) * SEQ + pos] = to_bf16(acc[ai][bj][m][n][j]);
                            }
                }
        } else if (pn == 22) {
            if (wc == 0 && fq == 0) {
#pragma unroll
                for (int ai = 0; ai < 2; ++ai)
#pragma unroll
                    for (int m = 0; m < 4; ++m) {
                        pg8::f32x4* d = (pg8::f32x4*)(small + (size_t)(row0 + ai * 128 + m * 16) * 8);
                        d[0] = acc[ai][0][m][0]; d[1] = acc[ai][0][m][1];
                    }
            }
        } else {
            bf16_t* dst; int ld, c0; float sc = 1.f; bool gate = false;
            if (pn < 6) { dst = qkvraw; ld = 1536; c0 = pn * 256; }
            else if (pn < 8) { dst = dzb; ld = 512; c0 = (pn - 6) * 256; }
            else if (pn < 10) { dst = sq; ld = 512; c0 = (pn - 8) * 256; sc = 0.125f * 1.4426950408889634f; }
            else if (pn < 12) { dst = sk; ld = 512; c0 = (pn - 10) * 256; }
            else if (pn < 18) { dst = gab; ld = 1024; c0 = (pn - 14) * 256; gate = true; }
            else { dst = gbb; ld = 1024; c0 = (pn - 18) * 256; gate = true; }
#pragma unroll
            for (int ai = 0; ai < 2; ++ai)
#pragma unroll
                for (int m = 0; m < 4; ++m) {
                    bf16_t* rowp = dst + (size_t)(row0 + ai * 128 + m * 16) * ld + c0 + wc * 32 + fq * 8;
#pragma unroll
                    for (int bj = 0; bj < 2; ++bj) {
                        pg8::f32x4 v0 = acc[ai][bj][m][0] * sc, v1 = acc[ai][bj][m][1] * sc;
                        if (gate) {
#pragma unroll
                            for (int j = 0; j < 4; ++j) { v0[j] = sigmoidf_(v0[j]); v1[j] = sigmoidf_(v1[j]); }
                        }
                        pg8::u32x4 w; w.x = pk_bf16(v0[0], v0[1]); w.y = pk_bf16(v0[2], v0[3]); w.z = pk_bf16(v1[0], v1[1]); w.w = pk_bf16(v1[2], v1[3]);
                        *(pg8::u32x4*)(rowp + bj * 128) = w;
                    }
                }
        }
    }
};
template <class F> struct EpiF4 {
    static constexpr bool PERM = false, AFTER_DRAIN = false;
    F f;
    __device__ __forceinline__ void operator()(const pg8::f32x4 (&acc)[2][2][4][2], const pg8::Unit& u, int wr, int wc, int fr, int fq) const {
#pragma unroll
        for (int ai = 0; ai < 2; ++ai)
#pragma unroll
            for (int m = 0; m < 4; ++m) {
                const int row = u.pm * 256 + ai * 128 + wr * 64 + m * 16 + fr;
#pragma unroll
                for (int bj = 0; bj < 2; ++bj)
#pragma unroll
                    for (int n = 0; n < 2; ++n) f(row, u.pn * 256 + bj * 128 + wc * 32 + n * 16 + fq * 4, acc[ai][bj][m][n]);
            }
    }
};
template <class F> __device__ __forceinline__ void run_pg8(const bf16_t* A, const bf16_t* Bt, int M, int N, int K, unsigned char* lds, F f) {
    pg8::Gemm g{A, Bt, M, N, K};
    pg8::StaticOrder S; S.init(M, N, gridDim.x, blockIdx.x);
    EpiF4<F> E{f};
    pg8::gemm_phase<EpiF4<F>, pg8::StaticOrder, true, true>((PG8_LAS unsigned char*)lds, g, S, E);
}
__device__ __forceinline__ void unpack4(uint2 w, float (&g)[4]) {
    g[0] = __uint_as_float(w.x << 16); g[1] = __uint_as_float(w.x & 0xffff0000u); g[2] = __uint_as_float(w.y << 16); g[3] = __uint_as_float(w.y & 0xffff0000u);
}

struct LoadKNF32 {
    const float* base; int ld, kq, nq;
    f32x4 regs[8];
    template <class CF> __device__ __forceinline__ void init(const float* w, int ld_, CF colfn) {
        const int tid = opaque_tid(); kq = tid >> 6; nq = tid & 63; ld = ld_;
        base = w + (size_t)(kq * 8) * ld_ + colfn(nq * 4);
    }
    __device__ __forceinline__ void load(int k0) {
#pragma unroll
        for (int j = 0; j < 8; ++j) regs[j] = *(const f32x4*)(base + (size_t)(k0 + j) * ld);
    }
    __device__ __forceinline__ void store1(unsigned char* lds, int nn, float a0, float a1, float a2, float a3, float a4, float a5, float a6, float a7) const {
        uint4 o; o.x = pk_bf16(a0, a1); o.y = pk_bf16(a2, a3); o.z = pk_bf16(a4, a5); o.w = pk_bf16(a6, a7);
        const int row = nq * 4 + nn;
        *(uint4*)(lds + row * LROW + ((kq ^ swz(row)) << 4)) = o;
    }
    __device__ __forceinline__ void store(unsigned char* lds) const {
        store1(lds, 0, regs[0].x, regs[1].x, regs[2].x, regs[3].x, regs[4].x, regs[5].x, regs[6].x, regs[7].x);
        store1(lds, 1, regs[0].y, regs[1].y, regs[2].y, regs[3].y, regs[4].y, regs[5].y, regs[6].y, regs[7].y);
        store1(lds, 2, regs[0].z, regs[1].z, regs[2].z, regs[3].z, regs[4].z, regs[5].z, regs[6].z, regs[7].z);
        store1(lds, 3, regs[0].w, regs[1].w, regs[2].w, regs[3].w, regs[4].w, regs[5].w, regs[6].w, regs[7].w);
    }
};

template <int BM_, int BN_, int WM_, int WN_> struct GemmCfg {
    static constexpr int BM = BM_, BN = BN_, WM = WM_, WN = WN_;
    static constexpr int TM = BM / WM, TN = BN / WN, MI = TM / 32, NI = TN / 32;
    static constexpr int A_BYTES = BM * LROW, B_BYTES = BN * LROW, STAGE = A_BYTES + B_BYTES;
    static_assert(WM * WN == 8, "8 waves");
};

template <class CFG, class AL, class BL>
__device__ __forceinline__ void gemm_mainloop(AL& al, BL& bl, int nk, f32x16 (&acc)[CFG::MI][CFG::NI], unsigned char* lds) {
    constexpr int MI = CFG::MI, NI = CFG::NI;
    const int tid = opaque_tid(), lane = tid & 63, wid = tid >> 6;
    const int wm = wid / CFG::WN, wn = wid % CFG::WN;
    const int l31 = lane & 31, lh = lane >> 5;
    al.load(0); bl.load(0);
    const int a_off = (wm * CFG::TM + l31) * LROW;
    const int b_off = CFG::A_BYTES + (wn * CFG::TN + l31) * LROW;
    const int fsw = swz(l31);
    for (int kt = 0; kt < nk; ++kt) {
        unsigned char* st = lds + (kt & 1) * CFG::STAGE;
        al.store(st); bl.store(st + CFG::A_BYTES);
        __syncthreads();
        if (kt + 1 < nk) { al.load((kt + 1) * 64); bl.load((kt + 1) * 64); }
#pragma unroll
        for (int kk = 0; kk < 4; ++kk) {
            bf16x8 a[MI], b[NI];
#pragma unroll
            for (int mi = 0; mi < MI; ++mi) a[mi] = *(const bf16x8*)(st + a_off + mi * 32 * LROW + (((kk * 2 + lh) ^ fsw) << 4));
#pragma unroll
            for (int ni = 0; ni < NI; ++ni) b[ni] = *(const bf16x8*)(st + b_off + ni * 32 * LROW + (((kk * 2 + lh) ^ fsw) << 4));
#pragma unroll
            for (int mi = 0; mi < MI; ++mi)
#pragma unroll
                for (int ni = 0; ni < NI; ++ni)
                    acc[mi][ni] = __builtin_amdgcn_mfma_f32_32x32x16_bf16(a[mi], b[ni], acc[mi][ni], 0, 0, 0);
        }
    }
    __syncthreads();
}
template <class CFG, bool A_RES, int ARES_ROT, bool TRANS, class AL, class BL>
__device__ __forceinline__ void gemm_mainloop2(AL (&al)[2], BL (&bl)[2], int nk, f32x16 (&acc)[CFG::MI][CFG::NI], unsigned char* stages, const unsigned char* ares) {
    constexpr int MI = CFG::MI, NI = CFG::NI;
    constexpr int STG = A_RES ? CFG::B_BYTES : CFG::STAGE, BOFF = A_RES ? 0 : CFG::A_BYTES;
    const int tid = opaque_tid(), lane = tid & 63, wid = tid >> 6;
    const int wm = wid / CFG::WN, wn = wid % CFG::WN;
    const int l31 = lane & 31, lh = lane >> 5;
    if (!A_RES) { al[0].load(0); } bl[0].load(0);
    if (!A_RES) { al[1].load(64); } bl[1].load(64);
    const int a_off = (wm * CFG::TM + l31) * LROW;
    const int b_off = BOFF + (wn * CFG::TN + l31) * LROW;
    const int fsw = swz(l31);
    for (int kt = 0; kt < nk; kt += 2) {
#pragma unroll
        for (int u = 0; u < 2; ++u) {
            unsigned char* st = stages + u * STG;
            if (!A_RES) al[u].store(st);
            bl[u].store(st + BOFF);
            __syncthreads();
            if (kt + u + 2 < nk) { if (!A_RES) al[u].load((kt + u + 2) * 64); bl[u].load((kt + u + 2) * 64); }
            const unsigned char* ab = A_RES ? ares + (size_t)((kt + u + ARES_ROT) & 3) * (CFG::BM * LROW) : st;
#pragma unroll
            for (int kk = 0; kk < 4; ++kk) {
                bf16x8 a[MI], b[NI];
#pragma unroll
                for (int mi = 0; mi < MI; ++mi) a[mi] = *(const bf16x8*)(ab + a_off + mi * 32 * LROW + (((kk * 2 + lh) ^ fsw) << 4));
#pragma unroll
                for (int ni = 0; ni < NI; ++ni) b[ni] = *(const bf16x8*)(st + b_off + ni * 32 * LROW + (((kk * 2 + lh) ^ fsw) << 4));
#pragma unroll
                for (int mi = 0; mi < MI; ++mi)
#pragma unroll
                    for (int ni = 0; ni < NI; ++ni)
                        acc[mi][ni] = TRANS ? __builtin_amdgcn_mfma_f32_32x32x16_bf16(b[ni], a[mi], acc[mi][ni], 0, 0, 0)
                                            : __builtin_amdgcn_mfma_f32_32x32x16_bf16(a[mi], b[ni], acc[mi][ni], 0, 0, 0);
            }
        }
    }
    __syncthreads();
}
template <class CFG> __device__ __forceinline__ void acc_zero(f32x16 (&acc)[CFG::MI][CFG::NI]) {
#pragma unroll
    for (int mi = 0; mi < CFG::MI; ++mi)
#pragma unroll
        for (int ni = 0; ni < CFG::NI; ++ni)
#pragma unroll
            for (int r = 0; r < 16; ++r) acc[mi][ni][r] = 0.f;
}
template <class CFG, class F> __device__ __forceinline__ void acc_foreach(f32x16 (&acc)[CFG::MI][CFG::NI], F f) {
    const int tid = opaque_tid(), lane = tid & 63, wid = tid >> 6;
    const int wm = wid / CFG::WN, wn = wid % CFG::WN;
#pragma unroll
    for (int mi = 0; mi < CFG::MI; ++mi)
#pragma unroll
        for (int ni = 0; ni < CFG::NI; ++ni) {
            asm volatile("" ::: "memory");
#pragma unroll
            for (int r = 0; r < 16; ++r)
                acc[mi][ni][r] = f(wm * CFG::TM + mi * 32 + (r & 3) + 8 * (r >> 2) + 4 * (lane >> 5), wn * CFG::TN + ni * 32 + (lane & 31), acc[mi][ni][r], mi, ni, r);
        }
}

struct TileMap {
    int ntm, ntn, npm, npn, rounds; bool patched;
    int pm, pn;
    __device__ __forceinline__ void init(int ntm_, int ntn_) {
        ntm = ntm_; ntn = ntn_; patched = (gridDim.x == 256);
        pn = ntn >= 8 ? 8 : ntn >= 4 ? 4 : ntn >= 2 ? 2 : 1; pm = 32 / pn;
        if (patched) { npm = (ntm + pm - 1) / pm; npn = (ntn + pn - 1) / pn; rounds = (npm * npn + 7) / 8; }
        else { int G = gridDim.x; asm volatile("" : "+s"(G)); npm = npn = 0; rounds = (ntm * ntn + G - 1) / G; }
    }
    __device__ __forceinline__ bool get(int round, int& tm, int& tn) const {
        const int b = blockIdx.x;
        if (patched) {
            const int patch = round * 8 + (b & 7), slot = b >> 3;
            if (patch >= npm * npn) return false;
            tm = (patch / npn) * pm + slot / pn; tn = (patch % npn) * pn + slot % pn;
            return tm < ntm && tn < ntn;
        }
        const int t = round * gridDim.x + b;
        if (t >= ntm * ntn) return false;
        tm = t / ntn; tn = t % ntn; return true;
    }
};

template <class CM>
__device__ __forceinline__ void transpose_convert(const float* W, int K, int N, int NP, bf16_t* Wt, float* sm, CM cmap) {
    const int tid = opaque_tid(), ntk = K / 64, ntn = NP / 64;
    for (int tile = blockIdx.x; tile < ntk * ntn; tile += gridDim.x) {
        const int tk = tile % ntk, tn = tile / ntk;
#pragma unroll
        for (int i = 0; i < 8; ++i) {
            const int e = tid + i * NT, kk = e >> 6, nn = e & 63, col = cmap(tn * 64 + nn);
            sm[nn * 65 + kk] = col >= 0 ? W[(size_t)(tk * 64 + kk) * N + col] : 0.f;
        }
        __syncthreads();
        const int n = tid >> 3, kc = tid & 7;
        const float* r = sm + n * 65 + kc * 8;
        uint4 o; o.x = pk_bf16(r[0], r[1]); o.y = pk_bf16(r[2], r[3]); o.z = pk_bf16(r[4], r[5]); o.w = pk_bf16(r[6], r[7]);
        *(uint4*)(Wt + (size_t)(tn * 64 + n) * K + tk * 64 + kc * 8) = o;
        __syncthreads();
    }
}
__device__ __forceinline__ void transpose_tile_f4(const float* W, int K, int N, bf16_t* Wt, int k0, int n0, float* sm) {
    const int tid = opaque_tid(), kk = tid >> 4, n4 = tid & 15;
#pragma unroll
    for (int h = 0; h < 2; ++h) {
        const int k = kk + 32 * h;
        const f32x4 v = *(const f32x4*)(W + (size_t)(k0 + k) * N + n0 + n4 * 4);
#pragma unroll
        for (int j = 0; j < 4; ++j) sm[(n4 * 4 + j) * 65 + k] = v[j];
    }
    __syncthreads();
    const int n = tid >> 3, kc = tid & 7;
    const float* r = sm + n * 65 + kc * 8;
    uint4 o; o.x = pk_bf16(r[0], r[1]); o.y = pk_bf16(r[2], r[3]); o.z = pk_bf16(r[4], r[5]); o.w = pk_bf16(r[6], r[7]);
    *(uint4*)(Wt + (size_t)(n0 + n) * K + k0 + kc * 8) = o;
    __syncthreads();
}
__device__ __forceinline__ void convert_bf16(const float* src, bf16_t* dst, size_t n) {
    const size_t gtid = (size_t)blockIdx.x * NT + opaque_tid(), gsz = (size_t)gridDim.x * NT;
    for (size_t i = gtid; i < n / 8; i += gsz) {
        const float4 a = ((const float4*)src)[2 * i], b = ((const float4*)src)[2 * i + 1];
        uint4 o; o.x = pk_bf16(a.x, a.y); o.y = pk_bf16(a.z, a.w); o.z = pk_bf16(b.x, b.y); o.w = pk_bf16(b.z, b.w);
        ((uint4*)dst)[i] = o;
    }
}

__device__ __forceinline__ void phase_inproj(const Params& p, unsigned char* lds) {
    pg8::Gemm g{p.xb, p.w_in_t, T, PWP, D};
    pg8::StaticOrder S; S.init(T, PWP, gridDim.x, blockIdx.x);
    EpiInproj E{p.qkvraw, p.dzb, p.sq, p.sk, p.vT, p.gab, p.gbb, p.small};
    pg8::gemm_phase<EpiInproj, pg8::StaticOrder, true, true>((PG8_LAS unsigned char*)lds, g, S, E);
}

__device__ __forceinline__ void load_gate16(const bf16_t* gbuf, int rb, int cb, int lane, float (&g)[16]) {
    const uint4* src = (const uint4*)(gbuf + ((size_t)(rb * 32 + cb) * 64 + lane) * 16);
    const uint4 a = src[0], b = src[1];
    const unsigned u[8] = {a.x, a.y, a.z, a.w, b.x, b.y, b.z, b.w};
#pragma unroll
    for (int i = 0; i < 8; ++i) { g[2 * i] = __uint_as_float(u[i] << 16); g[2 * i + 1] = __uint_as_float(u[i] & 0xffff0000u); }
}
__device__ __forceinline__ void phase_merge(const Params& p, unsigned char* lds) {
    run_pg8(p.oab, p.w_pa_t, T, D, DNW, lds, [&](int row, int col, pg8::f32x4 v) {
        float g[4]; unpack4(*(const uint2*)(p.gab + (size_t)row * D + col), g);
        *(pg8::f32x4*)(p.m1 + (size_t)row * D + col) = (pg8::f32x4){v[0] * g[0], v[1] * g[1], v[2] * g[2], v[3] * g[3]};
    });
    run_pg8(p.obb, p.w_pb_t, T, D, SBW, lds, [&](int row, int col, pg8::f32x4 v) {
        float g[4]; unpack4(*(const uint2*)(p.gbb + (size_t)row * D + col), g);
        const pg8::f32x4 m = *(const pg8::f32x4*)(p.m1 + (size_t)row * D + col);
        uint2 w; w.x = pk_bf16(m[0] + v[0] * g[0], m[1] + v[1] * g[1]); w.y = pk_bf16(m[2] + v[2] * g[2], m[3] + v[3] * g[3]);
        *(uint2*)(p.mergedb + (size_t)row * D + col) = w;
    });
}

__device__ __forceinline__ void phase_outproj(const Params& p, unsigned char* lds) {
    run_pg8(p.mergedb, p.w_out_t, T, D, D, lds, [&](int row, int col, pg8::f32x4 v) {
        const size_t o = (size_t)row * D + col;
        const pg8::f32x4 x = *(const pg8::f32x4*)(p.x + o);
        *(pg8::f32x4*)(p.pre1 + o) = v + x * ALPHA;
    });
}

__device__ __forceinline__ void phase_router_shared_up(const Params& p, unsigned char* lds) {
    {
        typedef GemmCfg<128, 128, 4, 2> CFG;
        TileMap tmap; tmap.init(T / 128, NE / 128);
        for (int round = 0; round < tmap.rounds; ++round) {
            int tm, tn;
            if (!tmap.get(round, tm, tn)) continue;
            LoadRowsBf16<128> al, bl;
            al.init(p.hb, D, [&](int r) { return (long long)(tm * 128 + r); });
            bl.init(p.w_router_t, D, [&](int r) { return (long long)(tn * 128 + r); });
            f32x16 acc[CFG::MI][CFG::NI];
            acc_zero<CFG>(acc);
            gemm_mainloop<CFG>(al, bl, D / 64, acc, lds);
            asm volatile("" : "+s"(tm), "+s"(tn));
            acc_foreach<CFG>(acc, [&](int r, int c, float v, int, int, int) {
                p.scores[(size_t)(tm * 128 + r) * NE + tn * 128 + c] = sigmoidf_(v);
                return v;
            });
        }
    }
    {
        typedef GemmCfg<128, 256, 2, 4> CFG;
        TileMap tmap; tmap.init(T / 128, SFF / 128);
        for (int round = 0; round < tmap.rounds; ++round) {
            int tm, tn;
            if (!tmap.get(round, tm, tn)) continue;
            LoadRowsBf16<128> al; LoadRowsBf16<256> bl;
            al.init(p.hb, D, [&](int r) { return (long long)(tm * 128 + r); });
            bl.init(p.w_su_t, D, [&](int r) { return (long long)(((r >> 5) & 1) * SFF + tn * 128 + (r >> 6) * 32 + (r & 31)); });
            f32x16 acc[CFG::MI][CFG::NI];
            acc_zero<CFG>(acc);
            gemm_mainloop<CFG>(al, bl, D / 64, acc, lds);
            asm volatile("" : "+s"(tm), "+s"(tn));
            const int tid = opaque_tid(), lane = tid & 63, wid = tid >> 6, wm = wid / CFG::WN, wn = wid % CFG::WN;
#pragma unroll
            for (int mi = 0; mi < CFG::MI; ++mi)
#pragma unroll
                for (int r = 0; r < 16; ++r) {
                    const int row = tm * 128 + wm * CFG::TM + mi * 32 + (r & 3) + 8 * (r >> 2) + 4 * (lane >> 5);
                    const int j = tn * 128 + wn * 32 + (lane & 31);
                    const float g = acc[mi][0][r], u = acc[mi][1][r];
                    p.actsh[(size_t)row * SFF + j] = to_bf16(siluf_(g) * u);
                }
        }
    }
}

__device__ __forceinline__ void phase_shared_down(const Params& p, unsigned char* lds) {
    run_pg8(p.actsh, p.w_sd_t, T, D, SFF, lds, [&](int row, int col, pg8::f32x4 v) {
        uint2 w; w.x = pk_bf16(v[0], v[1]); w.y = pk_bf16(v[2], v[3]);
        *(uint2*)(p.yshb + (size_t)row * D + col) = w;
    });
}

__device__ __forceinline__ void phase_init(const Params& p) {
    const int gtid = blockIdx.x * NT + opaque_tid(), gsz = gridDim.x * NT;
    for (int i = gtid; i < 2 * NE * CSTRIDE; i += gsz) p.counts[i] = 0;
}

__device__ __forceinline__ void sb_attn_wave(const Params& p, int bh, int qt) {
    const int lane = opaque_tid() & 63, l31 = lane & 31, lh = lane >> 5;
    const int b = bh >> 3, hh = bh & 7;
    bf16x8 qf[4];
    {
        const bf16_t* qrow = p.sq + (size_t)(b * SEQ + qt * 32 + l31) * SBW + hh * 64 + lh * 8;
#pragma unroll
        for (int ks = 0; ks < 4; ++ks) qf[ks] = *(const bf16x8*)(qrow + ks * 16);
    }
    f32x16 o0, o1;
#pragma unroll
    for (int r = 0; r < 16; ++r) { o0[r] = 0.f; o1[r] = 0.f; }
    float run = 0.f;
    const bf16_t* vbase = p.vT + ((size_t)(bh * 64 + l31)) * SEQ + lh * 8;
    for (int kt = qt; kt >= 0; --kt) {
        const bf16_t* krow = p.sk + (size_t)(b * SEQ + kt * 32 + l31) * SBW + hh * 64 + lh * 8;
        bf16x8 kf[4];
#pragma unroll
        for (int ks = 0; ks < 4; ++ks) kf[ks] = *(const bf16x8*)(krow + ks * 16);
        bf16x8 vf[2][2];
#pragma unroll
        for (int md = 0; md < 2; ++md)
#pragma unroll
            for (int ss = 0; ss < 2; ++ss) vf[md][ss] = *(const bf16x8*)(vbase + (size_t)md * 32 * SEQ + kt * 32 + ss * 16);
        f32x16 sc;
#pragma unroll
        for (int r = 0; r < 16; ++r) sc[r] = 0.f;
#pragma unroll
        for (int ks = 0; ks < 4; ++ks) sc = __builtin_amdgcn_mfma_f32_32x32x16_bf16(kf[ks], qf[ks], sc, 0, 0, 0);
        float lb[16], lr[16];
        const bool diag = (kt == qt);
#pragma unroll
        for (int r = 0; r < 16; ++r) {
            const float z = sc[r];
            const float l = __builtin_amdgcn_logf(1.f + __builtin_amdgcn_exp2f(-fabsf(z)));
            float b_ = fminf(z, 0.f) - l, r_ = b_ - z;
            if (diag) { const bool valid = ((r & 3) + 8 * (r >> 2) + 4 * lh) < l31; r_ = valid ? r_ : 0.f; b_ = valid ? b_ : -INFINITY; }
            lb[r] = b_; lr[r] = r_;
        }
        float ex[16], B[4];
#pragma unroll
        for (int g = 0; g < 4; ++g) {
            ex[4 * g + 3] = 0.f;
            ex[4 * g + 2] = lr[4 * g + 3];
            ex[4 * g + 1] = ex[4 * g + 2] + lr[4 * g + 2];
            ex[4 * g + 0] = ex[4 * g + 1] + lr[4 * g + 1];
            B[g] = ex[4 * g + 0] + lr[4 * g + 0];
        }
        float P[4];
#pragma unroll
        for (int g = 0; g < 4; ++g) P[g] = shfl_lane(B[g], lane ^ 32);
        float off[4];
        {
            const float p3 = P[3], p2 = P[2] + p3, p1 = P[1] + p2, p0 = P[0] + p1;
            const float b3 = 0.f, b2 = B[3], b1 = B[2] + b2, b0 = B[1] + b1;
            off[0] = b0 + (lh ? p1 : p0);
            off[1] = b1 + (lh ? p2 : p1);
            off[2] = b2 + (lh ? p3 : p2);
            off[3] = b3 + (lh ? 0.f : p3);
            const float total = (B[0] + b0) + p0;
#pragma unroll
            for (int g = 0; g < 4; ++g) off[g] += run;
            run += total;
        }
        float a[16];
#pragma unroll
        for (int r = 0; r < 16; ++r) a[r] = __builtin_amdgcn_exp2f(lb[r] + ex[r] + off[r >> 2]);
        bf16x8 pf[2];
#pragma unroll
        for (int ss = 0; ss < 2; ++ss) {
            typedef unsigned u32x4 __attribute__((ext_vector_type(4)));
            u32x4 w;
            w[0] = pk_bf16(a[8 * ss + 0], a[8 * ss + 1]); w[1] = pk_bf16(a[8 * ss + 2], a[8 * ss + 3]);
            w[2] = pk_bf16(a[8 * ss + 4], a[8 * ss + 5]); w[3] = pk_bf16(a[8 * ss + 6], a[8 * ss + 7]);
            pf[ss] = __builtin_bit_cast(bf16x8, w);
        }
#pragma unroll
        for (int ss = 0; ss < 2; ++ss) {
            o0 = __builtin_amdgcn_mfma_f32_32x32x16_bf16(vf[0][ss], pf[ss], o0, 0, 0, 0);
            o1 = __builtin_amdgcn_mfma_f32_32x32x16_bf16(vf[1][ss], pf[ss], o1, 0, 0, 0);
        }
        if (__all(run < -160.f)) break;
    }
    bf16_t* orow = p.obb + (size_t)(b * SEQ + qt * 32 + l31) * SBW + hh * 64 + 4 * lh;
#pragma unroll
    for (int g = 0; g < 4; ++g) {
        uint2 w0, w1;
        w0.x = pk_bf16(o0[4 * g], o0[4 * g + 1]); w0.y = pk_bf16(o0[4 * g + 2], o0[4 * g + 3]);
        w1.x = pk_bf16(o1[4 * g], o1[4 * g + 1]); w1.y = pk_bf16(o1[4 * g + 2], o1[4 * g + 3]);
        *(uint2*)(orow + 8 * g) = w0;
        *(uint2*)(orow + 32 + 8 * g) = w1;
    }
}


constexpr int DN_RW = 0, DN_RQ = 128, DN_RAT = 256, DN_RKD = 320;
constexpr float LOG2E = 1.4426950408889634f;
__device__ __forceinline__ uint4 pack8(const float* v) { uint4 o; o.x = pk_bf16(v[0], v[1]); o.y = pk_bf16(v[2], v[3]); o.z = pk_bf16(v[4], v[5]); o.w = pk_bf16(v[6], v[7]); return o; }

__device__ __forceinline__ void dn_chunk_item(const Params& p, int item, unsigned char* lds) {
    const int tid = opaque_tid(), lane = tid & 63, wid = tid >> 6;
    const int bh = item >> 5, n = item & 31, b = bh >> 2, hh = bh & 3;
    const int t0 = b * SEQ + n * 64;
    unsigned char* Kimg = lds; unsigned char* KBimg = lds + 16384; unsigned char* Qimg = lds + 32768;
    float* Vf = (float*)(lds + 49152); float* KBGf = (float*)(lds + 81920); float* MT = (float*)(lds + 114688);
    float* G2s = (float*)(lds + 114688 + 17408); float* betas = G2s + 64;
    bf16_t* blob = p.dnblob + (size_t)item * DN_BLOB;
    if (wid == 0) {
        const int t = t0 + lane;
        const float da = p.small[(size_t)t * 8 + 4 + hh] + p.dt_bias[hh];
        const float sp = da > 20.f ? da : log1pf(expf(da));
        float g2 = -expf(p.a_log[hh]) * sp * LOG2E;
#pragma unroll
        for (int off = 1; off < 64; off <<= 1) { const float v = shfl_lane(g2, lane - off); if (lane >= off) g2 += v; }
        G2s[lane] = g2; betas[lane] = sigmoidf_(p.small[(size_t)t * 8 + hh]);
        if (lane == 63) p.dnlast[item] = exp2f(g2);
    }
    __syncthreads();
    {
        const int c8 = tid & 15, tq = tid >> 4, j0 = tq * 2;
        const float G0 = G2s[j0], G1 = G2s[j0 + 1], GL = G2s[63];
        const float be[2] = {betas[j0], betas[j0 + 1]};
        const float eg[2] = {exp2f(G0), exp2f(G1)}, el[2] = {exp2f(GL - G0), exp2f(GL - G1)};
        const int half = c8 >> 3, ch = c8 & 7;
#pragma unroll
        for (int type = 0; type < 3; ++type) {
            float o[2][8];
            {
                const bf16_t* src = p.qkvraw + (size_t)(t0 + j0 - 3) * 1536 + type * 512 + hh * 128 + c8 * 8;
                float x[5][8];
#pragma unroll
                for (int r = 0; r < 5; ++r) {
                    uint4 raw = make_uint4(0, 0, 0, 0);
                    if (n > 0 || j0 - 3 + r >= 0) raw = *(const uint4*)(src + (size_t)r * 1536);
                    const unsigned u[4] = {raw.x, raw.y, raw.z, raw.w};
#pragma unroll
                    for (int i = 0; i < 4; ++i) { x[r][2 * i] = __uint_as_float(u[i] << 16); x[r][2 * i + 1] = __uint_as_float(u[i] & 0xffff0000u); }
                }
                const float* wp = p.conv_w + type * 512 + hh * 128 + c8 * 8;
#pragma unroll
                for (int i = 0; i < 8; ++i) {
                    float a0 = 0.f, a1 = 0.f;
#pragma unroll
                    for (int tap = 0; tap < 4; ++tap) { const float w = wp[tap * 1536 + i]; a0 = fmaf(x[tap][i], w, a0); a1 = fmaf(x[tap + 1][i], w, a1); }
                    o[0][i] = siluf_(a0); o[1][i] = siluf_(a1);
                }
            }
            if (type < 2) {
#pragma unroll
                for (int tk = 0; tk < 2; ++tk) {
                    float ss = 0.f;
#pragma unroll
                    for (int i = 0; i < 8; ++i) ss = fmaf(o[tk][i], o[tk][i], ss);
                    ss += shfl_lane(ss, lane ^ 1); ss += shfl_lane(ss, lane ^ 2); ss += shfl_lane(ss, lane ^ 4); ss += shfl_lane(ss, lane ^ 8);
                    float r = rsqrtf(ss + NORM_EPS);
                    if (type == 0) r *= 0.08838834764831845f;
#pragma unroll
                    for (int i = 0; i < 8; ++i) o[tk][i] *= r;
                }
            }
#pragma unroll
            for (int tk = 0; tk < 2; ++tk) {
                const int j = j0 + tk;
                const int ioff = half * 8192 + j * 128 + ((ch ^ swz(j)) << 4);
                if (type == 0) {
                    *(uint4*)(Qimg + ioff) = pack8(o[tk]);
                    float qd[8];
#pragma unroll
                    for (int i = 0; i < 8; ++i) qd[i] = o[tk][i] * eg[tk];
                    bf16_t* qrow = blob + (size_t)(DN_RQ + half * 64 + j) * 64 + ((c8 >> 1) & 3) * 16 + 4 * (c8 & 1);
                    uint2 w0, w1; w0.x = pk_bf16(qd[0], qd[1]); w0.y = pk_bf16(qd[2], qd[3]); w1.x = pk_bf16(qd[4], qd[5]); w1.y = pk_bf16(qd[6], qd[7]);
                    *(uint2*)qrow = w0; *(uint2*)(qrow + 8) = w1;
                } else if (type == 1) {
                    float kb[8], kbg[8];
#pragma unroll
                    for (int i = 0; i < 8; ++i) { kb[i] = o[tk][i] * be[tk]; kbg[i] = kb[i] * eg[tk]; }
                    *(uint4*)(Kimg + ioff) = pack8(o[tk]);
                    *(uint4*)(KBimg + ioff) = pack8(kb);
                    f32x4* kd = (f32x4*)(KBGf + j * 128 + c8 * 8); kd[0] = (f32x4){kbg[0], kbg[1], kbg[2], kbg[3]}; kd[1] = (f32x4){kbg[4], kbg[5], kbg[6], kbg[7]};
                } else {
                    float vb[8];
#pragma unroll
                    for (int i = 0; i < 8; ++i) vb[i] = o[tk][i] * be[tk];
                    f32x4* vd = (f32x4*)(Vf + j * 128 + c8 * 8); vd[0] = (f32x4){vb[0], vb[1], vb[2], vb[3]}; vd[1] = (f32x4){vb[4], vb[5], vb[6], vb[7]};
                }
            }
            if (type == 1) {
                const int jp = (j0 & 48) | pi16(j0 & 15);
#pragma unroll
                for (int i = 0; i < 8; ++i)
                    *(unsigned*)(blob + (size_t)(DN_RKD + c8 * 8 + i) * 64 + jp) = pk_bf16(o[0][i] * el[0], o[1][i] * el[1]);
            }
            asm volatile("" ::: "memory");
        }
    }
    __syncthreads();
    {
        const int which = wid >> 2, ti = (wid >> 1) & 1, tj = wid & 1, l31 = lane & 31, lh = lane >> 5;
        if (!(ti == 0 && tj == 1)) {
            const unsigned char* Ab = (which == 0 ? KBimg : Qimg) + (ti * 32 + l31) * 128;
            const unsigned char* Bb = Kimg + (tj * 32 + l31) * 128;
            const int fsw = swz(l31);
            f32x16 acc;
#pragma unroll
            for (int r = 0; r < 16; ++r) acc[r] = 0.f;
#pragma unroll
            for (int ks = 0; ks < 8; ++ks) {
                const int off = (ks >> 2) * 8192 + ((((ks & 3) * 2 + lh) ^ fsw) << 4);
                acc = __builtin_amdgcn_mfma_f32_32x32x16_bf16(*(const bf16x8*)(Ab + off), *(const bf16x8*)(Bb + off), acc, 0, 0, 0);
            }
            const int j = tj * 32 + l31;
            const float Gj = G2s[j];
#pragma unroll
            for (int r = 0; r < 16; ++r) {
                const int i = ti * 32 + (r & 3) + 8 * (r >> 2) + 4 * lh;
                const float v = acc[r] * exp2f(G2s[i] - Gj);
                if (which == 0) MT[j * 68 + i] = (i > j) ? v : 0.f;
                else blob[(size_t)(DN_RAT + i) * 64 + ((j & 48) | pi16(j & 15))] = to_bf16((i >= j) ? v : 0.f);
            }
        }
    }
    __syncthreads();
#ifndef NO_SOLVE
    if (tid < 256) {
        const int c = tid & 127;
        const float* rhs = (tid < 128 ? Vf : KBGf) + c;
        float y[64];
#pragma unroll
        for (int j = 0; j < 64; ++j) y[j] = rhs[j * 128];
#pragma unroll
        for (int j = 0; j < 63; ++j) {
            const float yj = y[j];
#pragma unroll
            for (int i4 = (j + 1) & ~3; i4 < 64; i4 += 4) {
                const f32x4 m = *(const f32x4*)(MT + j * 68 + i4);
#pragma unroll
                for (int u = 0; u < 4; ++u) if (i4 + u > j) y[i4 + u] = fmaf(-m[u], yj, y[i4 + u]);
            }
            asm volatile("" ::: "memory");
        }
        if (tid < 128) {
#pragma unroll
            for (int mi = 0; mi < 2; ++mi)
#pragma unroll
                for (int h = 0; h < 2; ++h) {
                    f32x4* dst = (f32x4*)(p.dnu + ((((size_t)item * 2 + mi) * 4 + (c >> 5)) * 64 + h * 32 + (c & 31)) * 16);
#pragma unroll
                    for (int g = 0; g < 4; ++g)
                        dst[g] = (f32x4){y[mi * 32 + 8 * g + 4 * h], y[mi * 32 + 8 * g + 4 * h + 1], y[mi * 32 + 8 * g + 4 * h + 2], y[mi * 32 + 8 * g + 4 * h + 3]};
                }
        } else {
            bf16_t* dst = blob + (size_t)(DN_RW + (c >> 6) * 64) * 64 + ((c & 48) | pi16(c & 15));
#pragma unroll
            for (int i = 0; i < 64; ++i) dst[(size_t)i * 64] = to_bf16(-y[i]);
        }
    }
#endif
    __syncthreads();
}

__device__ __forceinline__ void phase_dn_chunks(const Params& p, unsigned char* lds) {
    for (int item = blockIdx.x; item < NB * DNH * 32; item += gridDim.x) dn_chunk_item(p, item, lds);
}

__device__ __forceinline__ void dn_scan(const Params& p, int bh, unsigned char* lds) {
    const int tid = opaque_tid(), lane = tid & 63, wid = tid >> 6, l31 = lane & 31, lh = lane >> 5;
    const int b = bh >> 2, hh = bh & 3;
    const int fsw = swz(l31);
    auto copy_blob = [&](int n, unsigned char* dst) {
        const uint4* src = (const uint4*)(p.dnblob + (size_t)(bh * 32 + n) * DN_BLOB);
        const int lt = tid - 256;
#pragma unroll
        for (int k = 0; k < 14; ++k) {
            const int c = lt + k * 256, row = c >> 3, ch = c & 7;
            *(uint4*)(dst + row * 128 + ((ch ^ swz(row)) << 4)) = src[c];
        }
    };
    if (wid >= 4) copy_blob(0, lds);
    __syncthreads();
    f32x16 S[4];
#pragma unroll
    for (int t = 0; t < 4; ++t)
#pragma unroll
        for (int r = 0; r < 16; ++r) S[t][r] = 0.f;
    f32x16 vn[2]; float lastn = 0.f;
    if (wid < 4) {
#pragma unroll
        for (int mi = 0; mi < 2; ++mi) vn[mi] = *(const f32x16*)(p.dnu + ((((size_t)(bh * 32) * 2 + mi) * 4 + wid) * 64 + lane) * 16);
        lastn = p.dnlast[bh * 32];
    }
    for (int n = 0; n < 32; ++n) {
        if (wid >= 4) {
            if (n + 1 < 32) copy_blob(n + 1, lds + ((n + 1) & 1) * (DN_ROWS * 128));
        } else {
            const unsigned char* buf = lds + (n & 1) * (DN_ROWS * 128);
            const int item = bh * 32 + n;
            f32x16 oa[2];
#pragma unroll
            for (int mi = 0; mi < 2; ++mi)
#pragma unroll
                for (int r = 0; r < 16; ++r) oa[mi][r] = 0.f;
            const float last = lastn;
            typedef unsigned u32x4 __attribute__((ext_vector_type(4)));
            bf16x8 sb[4][2];
#pragma unroll
            for (int t = 0; t < 4; ++t)
#pragma unroll
                for (int ss = 0; ss < 2; ++ss) {
                    u32x4 w;
#pragma unroll
                    for (int q = 0; q < 4; ++q) w[q] = pk_bf16(S[t][8 * ss + 2 * q], S[t][8 * ss + 2 * q + 1]);
                    sb[t][ss] = __builtin_bit_cast(bf16x8, w);
                }
#pragma unroll
            for (int mi = 0; mi < 2; ++mi)
#pragma unroll
                for (int ks = 0; ks < 8; ++ks) {
                    const int off = ((ks >> 2) * 64 + mi * 32 + l31) * 128 + ((((ks & 3) * 2 + lh) ^ fsw) << 4);
                    vn[mi] = __builtin_amdgcn_mfma_f32_32x32x16_bf16(*(const bf16x8*)(buf + DN_RW * 128 + off), sb[ks >> 1][ks & 1], vn[mi], 0, 0, 0);
                    oa[mi] = __builtin_amdgcn_mfma_f32_32x32x16_bf16(*(const bf16x8*)(buf + DN_RQ * 128 + off), sb[ks >> 1][ks & 1], oa[mi], 0, 0, 0);
                }
            bf16x8 vb[2][2];
#pragma unroll
            for (int mj = 0; mj < 2; ++mj)
#pragma unroll
                for (int ss = 0; ss < 2; ++ss) {
                    u32x4 w;
#pragma unroll
                    for (int q = 0; q < 4; ++q) w[q] = pk_bf16(vn[mj][8 * ss + 2 * q], vn[mj][8 * ss + 2 * q + 1]);
                    vb[mj][ss] = __builtin_bit_cast(bf16x8, w);
                }
            {
                const int nx = (n + 1 < 32) ? item + 1 : item;
#pragma unroll
                for (int mi = 0; mi < 2; ++mi) vn[mi] = *(const f32x16*)(p.dnu + ((((size_t)nx * 2 + mi) * 4 + wid) * 64 + lane) * 16);
                lastn = p.dnlast[nx];
            }
#pragma unroll
            for (int mi = 0; mi < 2; ++mi)
#pragma unroll
                for (int kj = 0; kj < 4; ++kj)
                    if ((kj >> 1) <= mi) {
                        const int off = (DN_RAT + mi * 32 + l31) * 128 + (((kj * 2 + lh) ^ fsw) << 4);
                        oa[mi] = __builtin_amdgcn_mfma_f32_32x32x16_bf16(*(const bf16x8*)(buf + off), vb[kj >> 1][kj & 1], oa[mi], 0, 0, 0);
                    }
#pragma unroll
            for (int t = 0; t < 4; ++t) {
#pragma unroll
                for (int r = 0; r < 16; ++r) S[t][r] *= last;
#pragma unroll
                for (int kj = 0; kj < 4; ++kj) {
                    const int off = (DN_RKD + t * 32 + l31) * 128 + (((kj * 2 + lh) ^ fsw) << 4);
                    S[t] = __builtin_amdgcn_mfma_f32_32x32x16_bf16(*(const bf16x8*)(buf + off), vb[kj >> 1][kj & 1], S[t], 0, 0, 0);
                }
            }
            float* orow = p.oraw + (size_t)(b * SEQ + n * 64) * DNW + hh * 128 + wid * 32 + l31;
#pragma unroll
            for (int mi = 0; mi < 2; ++mi)
#pragma unroll
                for (int r = 0; r < 16; ++r) orow[(size_t)(mi * 32 + (r & 3) + 8 * (r >> 2) + 4 * lh) * DNW] = oa[mi][r];
        }
        __syncthreads();
    }
}

__device__ __forceinline__ void phase_mixers(const Params& p, float* smem) {
    const int nscan = NB * DNH;
    if (gridDim.x >= 2 * nscan) {
#ifndef SKIP_SCAN
        if ((int)blockIdx.x < nscan) dn_scan(p, blockIdx.x, (unsigned char*)smem);
#endif
        if ((int)blockIdx.x < nscan) {}
        else {
            for (int it = blockIdx.x - nscan; it < 512; it += gridDim.x - nscan) sb_attn_wave(p, it >> 3, (it & 7) * 8 + (opaque_tid() >> 6));
        }
    } else {
#ifndef SKIP_SCAN
        for (int bh = blockIdx.x; bh < nscan; bh += gridDim.x) dn_scan(p, bh, (unsigned char*)smem);
#endif
        for (int it = blockIdx.x; it < 512; it += gridDim.x) sb_attn_wave(p, it >> 3, (it & 7) * 8 + (opaque_tid() >> 6));
    }
}

__device__ __forceinline__ void phase_gated_norm(const Params& p) {
    const int lane = opaque_tid() & 63, wave = (blockIdx.x * NT + opaque_tid()) >> 6, nw = (gridDim.x * NT) >> 6;
    for (int item = wave; item < T * 4; item += nw) {
        const int t = item >> 2, hh = item & 3;
        const size_t off = (size_t)t * DNW + hh * 128 + lane * 2;
        const float v0 = p.oraw[off], v1 = p.oraw[off + 1];
        const float ss = wave_sum(v0 * v0 + v1 * v1, lane);
        const float r = rsqrtf(ss * (1.f / 128.f) + NORM_EPS);
        const float z0 = bf2f(p.dzb[(size_t)t * 512 + hh * 128 + lane * 2]), z1 = bf2f(p.dzb[(size_t)t * 512 + hh * 128 + lane * 2 + 1]);
        p.oab[off] = to_bf16(v0 * r * p.norm_g[lane * 2] * siluf_(z0));
        p.oab[off + 1] = to_bf16(v1 * r * p.norm_g[lane * 2 + 1] * siluf_(z1));
    }
}

template <class SF>
__device__ __forceinline__ void layer_norm_rows(SF sf, const float* g, const float* bb, float* dst, bf16_t* dstb) {
    const int lane = opaque_tid() & 63, wave = (blockIdx.x * NT + opaque_tid()) >> 6, nw = (gridDim.x * NT) >> 6;
    for (int t = wave; t < T; t += nw) {
        float v[16];
        float s = 0.f;
#pragma unroll
        for (int i = 0; i < 16; ++i) { v[i] = sf(t, lane + i * 64); s += v[i]; }
        const float mu = wave_sum(s, lane) * (1.f / 1024.f);
        float q = 0.f;
#pragma unroll
        for (int i = 0; i < 16; ++i) { const float d = v[i] - mu; q += d * d; }
        const float rstd = rsqrtf(wave_sum(q, lane) * (1.f / 1024.f) + LN_EPS);
#pragma unroll
        for (int i = 0; i < 16; ++i) { const int c = lane + i * 64; const float y = (v[i] - mu) * rstd * g[c] + bb[c]; if (dst) dst[(size_t)t * D + c] = y; if (dstb) dstb[(size_t)t * D + c] = to_bf16(y); }
    }
}

__device__ __forceinline__ void phase_route(const Params& p, int* counts, int* explist, int* ldsw) {
    const int tid = opaque_tid(), lane = tid & 63;
    const int wave = (blockIdx.x * NT + tid) >> 6, nw = (gridDim.x * NT) >> 6;
    int* mye = ldsw + (tid >> 6) * 64;
    const f32x4 bias = *(const f32x4*)(p.router_bias + lane * 4);
    for (int t0 = wave; t0 < T; t0 += nw * 8) {
        f32x4 scs[8];
#pragma unroll
        for (int k = 0; k < 8; ++k) { const int t = t0 + k * nw; scs[k] = t < T ? *(const f32x4*)(p.scores + (size_t)t * NE + lane * 4) : (f32x4){0.f, 0.f, 0.f, 0.f}; }
#pragma unroll 1
        for (int k = 0; k < 8; ++k) {
            const int t = t0 + k * nw;
            if (t >= T) break;
            f32x4 sc = scs[0];
#pragma unroll
            for (int kk = 1; kk < 8; ++kk) sc = (k == kk) ? scs[kk] : sc;
            const float sel[4] = {sc[0] + bias[0], sc[1] + bias[1], sc[2] + bias[2], sc[3] + bias[3]};
            float m1 = fmaxf(sel[0], sel[1]), m2 = fminf(sel[0], sel[1]);
            m2 = fmaxf(m2, fminf(m1, sel[2])); m1 = fmaxf(m1, sel[2]);
            m2 = fmaxf(m2, fminf(m1, sel[3])); m1 = fmaxf(m1, sel[3]);
#pragma unroll
            for (int off = 1; off < 8; off <<= 1) {
                const float o1 = shfl_lane(m1, lane ^ off), o2 = shfl_lane(m2, lane ^ off);
                const float n2 = fmaxf(fminf(m1, o1), fmaxf(m2, o2));
                m1 = fmaxf(m1, o1); m2 = n2;
            }
            const float gs = m1 + m2;
            const int g = lane >> 3;
            int rank = 0;
#pragma unroll
            for (int gg = 0; gg < NG; ++gg) { const float og = __int_as_float(__builtin_amdgcn_readlane(__float_as_int(gs), gg * 8)); rank += (og > gs || (og == gs && gg < g)) ? 1 : 0; }
            const bool gsel = rank < TOPG;
            unsigned ku[4];
#pragma unroll
            for (int i = 0; i < 4; ++i) {
                const unsigned u = __float_as_uint(sel[i]);
                ku[i] = gsel ? ((u & 0x80000000u) ? ~u : (u | 0x80000000u)) : 0u;
            }
            unsigned v8 = 0u;
#pragma unroll 1
            for (int bit = 31; bit >= 0; --bit) {
                const unsigned cand = v8 | (1u << bit);
                const int c = __popcll(__ballot(ku[0] >= cand)) + __popcll(__ballot(ku[1] >= cand)) + __popcll(__ballot(ku[2] >= cand)) + __popcll(__ballot(ku[3] >= cand));
                if (c >= TOPK) v8 = cand;
            }
            int ngt = 0, eqlow = 0, sellow = 0;
            unsigned long long eqm[4];
#pragma unroll
            for (int i = 0; i < 4; ++i) { ngt += __popcll(__ballot(ku[i] > v8)); eqm[i] = __ballot(ku[i] == v8); }
            const int need = TOPK - ngt;
#pragma unroll
            for (int i = 0; i < 4; ++i) eqlow += __builtin_amdgcn_mbcnt_hi((unsigned)(eqm[i] >> 32), __builtin_amdgcn_mbcnt_lo((unsigned)eqm[i], 0u));
            bool selc[4]; int eqrank = eqlow;
#pragma unroll
            for (int i = 0; i < 4; ++i) {
                const bool eq = ku[i] == v8;
                selc[i] = (ku[i] > v8) || (eq && eqrank < need);
                eqrank += eq ? 1 : 0;
            }
            float part = 0.f;
#pragma unroll
            for (int i = 0; i < 4; ++i) {
                const unsigned long long sm = __ballot(selc[i]);
                part += selc[i] ? sc[i] : 0.f;
                sellow += __builtin_amdgcn_mbcnt_hi((unsigned)(sm >> 32), __builtin_amdgcn_mbcnt_lo((unsigned)sm, 0u));
            }
            const float wsum = wave_sum(part, lane);
            int slot = sellow;
#pragma unroll
            for (int i = 0; i < 4; ++i)
                if (selc[i]) {
                    const int e = lane * 4 + i, pr = t * TOPK + slot;
                    p.gate[pr] = sc[i] / wsum * 2.5f;
                    mye[k * 8 + slot] = e;
                    ++slot;
                }
        }
        {
            const int k = lane >> 3, t = t0 + k * nw;
            if (t < T) {
                const int e = mye[lane], pos = atomicAdd(&counts[e * CSTRIDE], 1);
                explist[(size_t)e * ECAP + pos] = t * TOPK + (lane & 7);
            }
        }
    }
}

__device__ __forceinline__ void compute_pend(const Params& p, int* pend, int* cnt) {
    const int tid = opaque_tid();
    if (tid < 64) {
        int c[4], pc[4];
#pragma unroll
        for (int i = 0; i < 4; ++i) { c[i] = p.counts[(tid * 4 + i) * CSTRIDE]; cnt[tid * 4 + i] = c[i]; pc[i] = (c[i] + 127) / 128 * 128; }
        const int ssum = pc[0] + pc[1] + pc[2] + pc[3];
        int inc = ssum;
#pragma unroll
        for (int off = 1; off < 64; off <<= 1) { const int v = shfl_lane_i(inc, tid - off); if (tid >= off) inc += v; }
        int run = inc - ssum;
#pragma unroll
        for (int i = 0; i < 4; ++i) { run += pc[i]; pend[tid * 4 + i] = run; }
    }
    __syncthreads();
}

__device__ __forceinline__ int expert_of_row(const int* pend, int row) {
    int lo = 0, hi = NE - 1;
    while (lo < hi) { const int mid = (lo + hi) >> 1; if (pend[mid] > row) hi = mid; else lo = mid + 1; }
    return lo;
}

__device__ __forceinline__ void phase_routed(const Params& p, int* pend, int* cnt, unsigned char* lds) {
    typedef GemmCfg<128, 256, 2, 4> CFG;
    compute_pend(p, pend, cnt);
    int* prs = (int*)(lds + 131072); float* gts = (float*)(lds + 131072 + 512);
    const bool grouped = (gridDim.x % 8) == 0;
    const int xg = grouped ? (blockIdx.x & 7) : 0, estep = grouped ? 8 : 1;
    const int nslots = grouped ? (gridDim.x >> 3) : gridDim.x;
    int widx = grouped ? (blockIdx.x >> 3) : blockIdx.x, tbase = 0;
    for (int e = xg; e < NE; e += estep) {
      const int ce = cnt[e], ntile = (ce + 127) >> 7;
      for (; widx < tbase + ntile; widx += nslots) {
        const int q0 = (widx - tbase) * 128;
        {
            const int tid = opaque_tid();
            if (tid < 128) {
                const int pr = (q0 + tid < ce) ? p.explist[(size_t)e * ECAP + q0 + tid] : -1;
                prs[tid] = pr; gts[tid] = pr >= 0 ? p.gate[pr] : 0.f;
            }
        }
        __syncthreads();
#pragma unroll 1
        for (int tn_ = 0; tn_ < 2 * RU; ++tn_) {
            const int tn = tn_ & 1;
            LoadRowsBf16<128> al[2]; LoadKNF32 bl[2];
#pragma unroll
            for (int u = 0; u < 2; ++u) {
                al[u].init(p.hb, D, [&](int r) { const int pr = prs[r]; return (long long)(pr >= 0 ? (pr >> 3) : 0); });
                bl[u].init(p.w_eu + (size_t)e * D * (2 * EFF), 2 * EFF, [&](int r) { return ((r >> 5) & 1) * EFF + tn * 128 + (r >> 6) * 32 + (r & 31); });
            }
            f32x16 acc[CFG::MI][CFG::NI];
            acc_zero<CFG>(acc);
            gemm_mainloop2<CFG, false, 0, false>(al, bl, D / 64, acc, lds, nullptr);
            const int tid = opaque_tid(), lane = tid & 63, wid = tid >> 6, wm = wid / CFG::WN, wn = wid % CFG::WN;
            const int j = tn * 128 + wn * 32 + (lane & 31);
            unsigned char* img = lds + 65536 + (((j >> 6) + 2) & 3) * 16384 + (j & 7) * 2;
            const int jc = (j & 63) >> 3;
#pragma unroll
            for (int mi = 0; mi < CFG::MI; ++mi)
#pragma unroll
                for (int r = 0; r < 16; ++r) {
                    const int row = wm * CFG::TM + mi * 32 + (r & 3) + 8 * (r >> 2) + 4 * (lane >> 5);
                    *(bf16_t*)(img + row * 128 + ((jc ^ swz(row)) << 4)) = to_bf16(siluf_(acc[mi][0][r]) * acc[mi][1][r]);
                }
        }
        __syncthreads();
#pragma unroll 1
        for (int tn_ = 0; tn_ < 4 * RD; ++tn_) {
            const int tn = tn_ & 3;
            LoadRowsBf16<128> aldummy[2]; LoadKNF32 bl[2];
#pragma unroll
            for (int u = 0; u < 2; ++u) bl[u].init(p.w_ed + (size_t)e * EFF * D, D, [&](int r) { return tn * 256 + r; });
            f32x16 acc[CFG::MI][CFG::NI];
            acc_zero<CFG>(acc);
            gemm_mainloop2<CFG, true, 2, true>(aldummy, bl, EFF / 64, acc, lds, lds + 65536);
            {
                const int tid = opaque_tid(), lane = tid & 63, wid = tid >> 6, wm = wid / CFG::WN, wn = wid % CFG::WN;
#pragma unroll
                for (int mi = 0; mi < CFG::MI; ++mi) {
                    const int row = wm * CFG::TM + mi * 32 + (lane & 31);
                    const int pr = prs[row]; const float g = gts[row];
                    if (pr >= 0) {
#pragma unroll
                        for (int ni = 0; ni < CFG::NI; ++ni) {
                            bf16_t* dst = p.ypairb + (size_t)pr * D + tn * 256 + wn * CFG::TN + ni * 32 + 4 * (lane >> 5);
#pragma unroll
                            for (int gq = 0; gq < 4; ++gq) {
                                uint2 w; w.x = pk_bf16(acc[mi][ni][4 * gq] * g, acc[mi][ni][4 * gq + 1] * g); w.y = pk_bf16(acc[mi][ni][4 * gq + 2] * g, acc[mi][ni][4 * gq + 3] * g);
                                *(uint2*)(dst + 8 * gq) = w;
                            }
                        }
                    }
                }
            }
        }
        __syncthreads();
      }
      tbase += ntile;
    }
}

#ifndef R0
#define R0 1
#define R1 1
#define R2 1
#define R3 1
#define R4 1
#define R5 1
#define R6 1
#define R7 1
#define R8 1
#define R10 1
#define R11 1
#define R12 1
#endif

constexpr int LDS_MAIN = 133120;
__global__ void __launch_bounds__(NT) fwd_megakernel(KArgs ka) {
    __shared__ __attribute__((aligned(16))) unsigned char lds[LDS_MAIN + 2 * NE * 4 + 16];
    float* smem = (float*)lds;
    int* pend = (int*)(lds + LDS_MAIN);
    int* cnt = pend + NE;
    volatile LAS3 unsigned* xbst = (volatile LAS3 unsigned*)(lds + LDS_MAIN + 2 * NE * 4);
    if (threadIdx.x == 0) { xbst[0] = 0u; xbst[1] = 0u; }
    __syncthreads();
    const XcdBarrier xb = xcd_barrier_post((unsigned*)(ka.ws + OFF_BAR), xbst);

#define REPEAT(N, ...) { int reps_ = (N); asm volatile("" : "+s"(reps_)); for (int rep_ = 0; rep_ < reps_; ++rep_) { { const Params p(ka); __VA_ARGS__; } xcd_barrier(xb); } }
    { const Params p(ka); phase_init(p); }
    REPEAT(R0,
        convert_bf16(p.x, p.xb, (size_t)T * D);
        transpose_convert(p.w_in, D, PW, PWP, p.w_in_t, smem, [](int n) { return n < 2048 ? n : n < 5632 ? n + 8 : n < 5640 ? n - 5632 + 2048 : -1; });
        transpose_convert(p.w_pa, DNW, D, D, p.w_pa_t, smem, [](int n) { return n; });
        transpose_convert(p.w_pb, SBW, D, D, p.w_pb_t, smem, [](int n) { return n; });
        transpose_convert(p.w_out, D, D, D, p.w_out_t, smem, [](int n) { return n; });
        transpose_convert(p.w_router, D, NE, NE, p.w_router_t, smem, [](int n) { return n; });
        transpose_convert(p.w_su, D, 2 * SFF, 2 * SFF, p.w_su_t, smem, [](int n) { return n; });
        transpose_convert(p.w_sd, SFF, D, D, p.w_sd_t, smem, [](int n) { return n; }))
    REPEAT(R1, phase_inproj(p, lds))
    REPEAT(R2, phase_dn_chunks(p, lds))
    REPEAT(R3, phase_mixers(p, smem))
    REPEAT(R4, phase_gated_norm(p))
    REPEAT(R5, phase_merge(p, lds))
    REPEAT(R6, phase_outproj(p, lds))
    REPEAT(R7, layer_norm_rows([&](int t, int c) { return p.pre1[(size_t)t * D + c]; }, p.ln1_g, p.ln1_b, nullptr, p.hb))
    REPEAT(R8, phase_router_shared_up(p, lds))
    { const Params p(ka); phase_route(p, p.counts, p.explist, (int*)lds); }
    xcd_barrier(xb);
    { int reps9 = R9 - 1; asm volatile("" : "+s"(reps9)); for (int r9 = 0; r9 < reps9; ++r9) { const Params p(ka); phase_route(p, p.counts + NE * CSTRIDE, (int*)p.ypairb, (int*)lds); xcd_barrier(xb); } }
    { int repsb = RB; asm volatile("" : "+s"(repsb)); for (int rb = 0; rb < repsb; ++rb) xcd_barrier(xb); }
    REPEAT(R10, phase_routed(p, pend, cnt, lds); phase_shared_down(p, lds))
    int reps12 = R12; asm volatile("" : "+s"(reps12));
    for (int rep = 0; rep < reps12; ++rep) {
        const Params p(ka);
        layer_norm_rows([&](int t, int c) {
                float f = bf2f(p.yshb[(size_t)t * D + c]);
#pragma unroll
                for (int k = 0; k < TOPK; ++k) f += bf2f(p.ypairb[((size_t)t * TOPK + k) * D + c]);
                return ALPHA * bf2f(p.hb[(size_t)t * D + c]) + f; },
            p.ln2_g, p.ln2_b, p.out, nullptr);
    }
}

extern "C" void kernel_launch(void* const* d_in, const int* in_sizes, int n_in, void* d_out, int out_size, void* d_ws,
                              size_t ws_size, hipStream_t stream) {
    static int grid_blocks = 0;
    if (!grid_blocks) {
        int dev = 0, cus = 0, per_cu = 0;
        hipGetDevice(&dev);
        hipDeviceGetAttribute(&cus, hipDeviceAttributeMultiprocessorCount, dev);
        hipOccupancyMaxActiveBlocksPerMultiprocessor(&per_cu, fwd_megakernel, NT, 0);
        if (per_cu > 1) per_cu = 1;
        grid_blocks = cus * per_cu;
    }
    KArgs p{};
    const float* const* in = (const float* const*)d_in;
    p.x = in[0]; p.w_in = in[1]; p.conv_w = in[2]; p.a_log = in[3]; p.dt_bias = in[4]; p.norm_g = in[5]; p.w_pa = in[6];
    p.w_pb = in[7]; p.w_out = in[8]; p.ln1_g = in[9]; p.ln1_b = in[10]; p.w_router = in[11]; p.router_bias = in[12];
    p.w_su = in[13]; p.w_sd = in[14]; p.w_eu = in[15]; p.w_ed = in[16]; p.ln2_g = in[17]; p.ln2_b = in[18];
    p.out = (float*)d_out; p.ws = (unsigned char*)d_ws;
    if (WS_BYTES > ws_size) { fprintf(stderr, "workspace too small: need %zu have %zu\n", (size_t)WS_BYTES, ws_size); return; }
    hipMemsetAsync(p.ws + OFF_BAR, 0, XCD_BAR_WORDS * 4, stream);
    void* args[] = {&p};
    hipError_t e = hipLaunchCooperativeKernel((void*)fwd_megakernel, dim3(grid_blocks), dim3(NT), args, 0, stream);
    if (e != hipSuccess) fprintf(stderr, "cooperative launch failed: %s (grid %d)\n", hipGetErrorString(e), grid_blocks);
}
```

```cpp
#include <hip/hip_runtime.h>
#include <hip/hip_cooperative_groups.h>
#include <cstdio>
#include <cstdint>
namespace cg = cooperative_groups;

constexpr int D = 1024, NB = 8, SEQ = 2048, T = NB * SEQ;
constexpr int DNH = 4, DND = 128, DNW = 512;
constexpr int SBH = 8, SBD = 64, SBW = 512;
constexpr int NE = 256, TOPK = 8, NG = 8, TOPG = 4, EFF = 256, SFF = 256;
constexpr int PW = 5640;
constexpr int NPAIR = T * TOPK;
constexpr int NBLK = (NPAIR + NE * 127 + 127) / 128;
constexpr int PROWS = NBLK * 128;
constexpr float ALPHA = 1.189207115002721f;
constexpr float LN_EPS = 1e-5f, NORM_EPS = 1e-6f;
constexpr int NT = 512;
#ifndef RU
#define RU 1
#define RD 1
#define R9 1
#define RB 0
#endif

typedef unsigned short bf16_t;
constexpr int PWP = 5888;
constexpr int DN_ROWS = 448, DN_BLOB = DN_ROWS * 64;
constexpr int ECAP = T;
#define XCD_BAR_WORDS 3456
constexpr int CSTRIDE = 64;
constexpr size_t al256(size_t x) { return (x + 255) & ~(size_t)255; }
constexpr size_t OFF_XB = 0;
constexpr size_t OFF_WINT = OFF_XB + al256((size_t)T * D * 2);
constexpr size_t OFF_QKVRAW = OFF_WINT + al256((size_t)PWP * D * 2);
constexpr size_t OFF_DZB = OFF_QKVRAW + al256((size_t)T * 1536 * 2);
constexpr size_t OFF_SQ = OFF_DZB + al256((size_t)T * 512 * 2);
constexpr size_t OFF_SK = OFF_SQ + al256((size_t)T * 512 * 2);
constexpr size_t OFF_VT = OFF_SK + al256((size_t)T * 512 * 2);
constexpr size_t OFF_DNBLOB = OFF_VT + al256((size_t)T * 512 * 2);
constexpr size_t OFF_DNU = OFF_DNBLOB + al256((size_t)1024 * DN_BLOB * 2);
constexpr size_t OFF_DNLAST = OFF_DNU + al256((size_t)1024 * 64 * 128 * 4);
constexpr size_t OFF_GAB = OFF_DNLAST + al256(1024 * 4);
constexpr size_t OFF_GBB = OFF_GAB + al256((size_t)T * D * 2);
constexpr size_t OFF_SMALL = OFF_GBB + al256((size_t)T * D * 2);
constexpr size_t OFF_WPAT = OFF_SMALL + al256((size_t)T * 8 * 4);
constexpr size_t OFF_WPBT = OFF_WPAT + al256((size_t)D * DNW * 2);
constexpr size_t OFF_WOUTT = OFF_WPBT + al256((size_t)D * SBW * 2);
constexpr size_t OFF_WROUTT = OFF_WOUTT + al256((size_t)D * D * 2);
constexpr size_t OFF_WSUT = OFF_WROUTT + al256((size_t)NE * D * 2);
constexpr size_t OFF_WSDT = OFF_WSUT + al256((size_t)2 * SFF * D * 2);
constexpr size_t OFF_OAB = OFF_WSDT + al256((size_t)D * SFF * 2);
constexpr size_t OFF_OBB = OFF_OAB + al256((size_t)T * DNW * 2);
constexpr size_t OFF_MERGED = OFF_OBB + al256((size_t)T * SBW * 2);
constexpr size_t OFF_HB = OFF_MERGED + al256((size_t)T * D * 2);
constexpr size_t OFF_ACTSH = OFF_HB + al256((size_t)T * D * 2);
constexpr size_t OFF_YPAIRB = OFF_ACTSH + al256((size_t)T * SFF * 2);
constexpr size_t OFF_ORAW = OFF_YPAIRB + al256((size_t)NPAIR * D * 2);
constexpr size_t OFF_PRE1 = OFF_ORAW + al256((size_t)T * DNW * 4);
constexpr size_t OFF_H = OFF_PRE1 + al256((size_t)T * D * 4);
constexpr size_t OFF_SCORES = OFF_H + al256((size_t)T * D * 4);
constexpr size_t OFF_GATE = OFF_SCORES + al256((size_t)T * NE * 4);
constexpr size_t OFF_YSH = OFF_GATE + al256((size_t)NPAIR * 4);
constexpr size_t OFF_IDX = OFF_YSH + al256((size_t)T * D * 4);
constexpr size_t OFF_COUNTS = OFF_IDX + al256((size_t)NPAIR * 4);
constexpr size_t OFF_EXPLIST = OFF_COUNTS + al256(2 * NE * CSTRIDE * 4);
constexpr size_t OFF_WEUT = OFF_EXPLIST + al256((size_t)NE * ECAP * 4);
constexpr size_t OFF_M1 = OFF_WEUT + al256((size_t)NE * 2 * EFF * D * 2);
constexpr size_t OFF_BAR = OFF_M1 + al256((size_t)T * D * 4);
constexpr size_t WS_BYTES = OFF_BAR + al256(XCD_BAR_WORDS * 4);

struct KArgs {
    const float *x, *w_in, *conv_w, *a_log, *dt_bias, *norm_g, *w_pa, *w_pb, *w_out, *ln1_g, *ln1_b, *w_router,
        *router_bias, *w_su, *w_sd, *w_eu, *w_ed, *ln2_g, *ln2_b;
    float* out; unsigned char* ws;
};
struct Params {
    const float *x, *w_in, *conv_w, *a_log, *dt_bias, *norm_g, *w_pa, *w_pb, *w_out, *ln1_g, *ln1_b, *w_router,
        *router_bias, *w_su, *w_sd, *w_eu, *w_ed, *ln2_g, *ln2_b;
    float* out;
    float *oraw, *pre1, *h, *scores, *gate, *ysh, *small, *dnu, *dnlast, *m1;
    int *idx, *counts, *explist;
    bf16_t *xb, *w_in_t, *w_pa_t, *w_pb_t, *w_out_t, *w_router_t, *w_su_t, *w_sd_t, *oab, *obb, *mergedb, *hb, *actsh, *ypairb, *yshb;
    bf16_t *qkvraw, *dzb, *sq, *sk, *vT, *gab, *gbb, *dnblob, *w_eu_t;
    unsigned* bar;
    __device__ __forceinline__ explicit Params(const KArgs& k) {
        x = k.x; w_in = k.w_in; conv_w = k.conv_w; a_log = k.a_log; dt_bias = k.dt_bias; norm_g = k.norm_g; w_pa = k.w_pa; w_pb = k.w_pb;
        w_out = k.w_out; ln1_g = k.ln1_g; ln1_b = k.ln1_b; w_router = k.w_router; router_bias = k.router_bias; w_su = k.w_su; w_sd = k.w_sd;
        w_eu = k.w_eu; w_ed = k.w_ed; ln2_g = k.ln2_g; ln2_b = k.ln2_b; out = k.out;
        unsigned char* w = k.ws; asm volatile("" : "+s"(w));
        xb = (bf16_t*)(w + OFF_XB); w_in_t = (bf16_t*)(w + OFF_WINT); qkvraw = (bf16_t*)(w + OFF_QKVRAW); dzb = (bf16_t*)(w + OFF_DZB);
        sq = (bf16_t*)(w + OFF_SQ); sk = (bf16_t*)(w + OFF_SK); vT = (bf16_t*)(w + OFF_VT); dnblob = (bf16_t*)(w + OFF_DNBLOB);
        dnu = (float*)(w + OFF_DNU); dnlast = (float*)(w + OFF_DNLAST); gab = (bf16_t*)(w + OFF_GAB); gbb = (bf16_t*)(w + OFF_GBB);
        small = (float*)(w + OFF_SMALL); w_pa_t = (bf16_t*)(w + OFF_WPAT); w_pb_t = (bf16_t*)(w + OFF_WPBT); w_out_t = (bf16_t*)(w + OFF_WOUTT);
        w_router_t = (bf16_t*)(w + OFF_WROUTT); w_su_t = (bf16_t*)(w + OFF_WSUT); w_sd_t = (bf16_t*)(w + OFF_WSDT);
        oab = (bf16_t*)(w + OFF_OAB); obb = (bf16_t*)(w + OFF_OBB); mergedb = (bf16_t*)(w + OFF_MERGED); hb = (bf16_t*)(w + OFF_HB);
        actsh = (bf16_t*)(w + OFF_ACTSH); ypairb = (bf16_t*)(w + OFF_YPAIRB); oraw = (float*)(w + OFF_ORAW); pre1 = (float*)(w + OFF_PRE1);
        h = (float*)(w + OFF_H); scores = (float*)(w + OFF_SCORES); gate = (float*)(w + OFF_GATE); ysh = (float*)(w + OFF_YSH); yshb = (bf16_t*)(w + OFF_YSH);
        idx = (int*)(w + OFF_IDX); counts = (int*)(w + OFF_COUNTS); explist = (int*)(w + OFF_EXPLIST); bar = (unsigned*)(w + OFF_BAR); w_eu_t = (bf16_t*)(w + OFF_WEUT); m1 = (float*)(w + OFF_M1);
    }
};

__device__ __forceinline__ float sigmoidf_(float v) { return 1.f / (1.f + expf(-v)); }
__device__ __forceinline__ float siluf_(float v) { return v / (1.f + expf(-v)); }
__device__ __forceinline__ float shfl_lane(float v, int src) { return __int_as_float(__builtin_amdgcn_ds_bpermute(src << 2, __float_as_int(v))); }
__device__ __forceinline__ int shfl_lane_i(int v, int src) { return __builtin_amdgcn_ds_bpermute(src << 2, v); }
__device__ __forceinline__ float wave_sum(float v, int lane) {
#pragma unroll
    for (int o = 32; o > 0; o >>= 1) v += shfl_lane(v, lane ^ o);
    return v;
}


#define XB_TMO      128
#define XB_XCNT(j)  (256  + 64 * (j))
#define XB_XSUB(j)  (1280 + 64 * (j))
#define XB_XGEN(j)  (2304 + 64 * (j))
#define XB_TOP      3328
#define XB_TOPGEN   3392
#define XB_SPIN_CAP (1u << 24)
#define LAS3 __attribute__((address_space(3)))
__device__ __forceinline__ unsigned xb_ld(unsigned* p)              { return __hip_atomic_load(p, __ATOMIC_RELAXED, __HIP_MEMORY_SCOPE_AGENT); }
__device__ __forceinline__ unsigned xb_add(unsigned* p, unsigned v) { return __hip_atomic_fetch_add(p, v, __ATOMIC_RELAXED, __HIP_MEMORY_SCOPE_AGENT); }
__device__ __forceinline__ unsigned xb_xcc_id() { return (unsigned)__builtin_amdgcn_s_getreg((3 << 11) | 20) & 0xFu; }
#define XB_SPIN(cond, bar) do { unsigned _sp = 0; while (cond) { __builtin_amdgcn_s_sleep(1); \
    if ((++_sp & 255u) == 0u) { if (xb_ld(&(bar)[XB_TMO])) break; if (_sp > XB_SPIN_CAP) { atomicAdd(&(bar)[XB_TMO], 1u); break; } } } } while (0)
struct XcdBarrier { unsigned* bar; unsigned x; volatile LAS3 unsigned* st; };
__device__ __forceinline__ XcdBarrier xcd_barrier_post(unsigned* bar, volatile LAS3 unsigned* st) {
    XcdBarrier b; b.bar = bar; b.x = xb_xcc_id(); b.st = st;
    if (threadIdx.x == 0) (void)xb_add(&bar[XB_XCNT(b.x)], 1u);
    return b;
}
__device__ __forceinline__ void xcd_barrier_complete(unsigned* bar, unsigned x, unsigned& nloc, unsigned& nx) {
    const unsigned G = gridDim.x * gridDim.y * gridDim.z;
    unsigned sum, cnt, mine, sp = 0u;
    asm volatile("" : "+s"(x));
    for (;;) {
        sum = 0u; cnt = 0u; mine = 0u;
#pragma unroll 1
        for (unsigned j = 0; j < 16; ++j) { const unsigned c = xb_ld(&bar[XB_XCNT(j)]); sum += c; cnt += (c > 0u) ? 1u : 0u; mine = (j == x) ? c : mine; }
        if (sum == G) break;
        __builtin_amdgcn_s_sleep(1);
        if ((++sp & 255u) == 0u) { if (xb_ld(&bar[XB_TMO])) break; if (sp > XB_SPIN_CAP) { atomicAdd(&bar[XB_TMO], 1u); break; } }
    }
    nloc = mine > 0u ? mine : 1u; nx = cnt > 0u ? cnt : 1u;
}
__device__ __forceinline__ void xcd_barrier(const XcdBarrier& b) {
    asm volatile("s_waitcnt vmcnt(0)" ::: "memory");
    __syncthreads();
    if (threadIdx.x == 0) {
        unsigned* bar = b.bar;
        __builtin_amdgcn_s_waitcnt(0);
        unsigned nloc = b.st[0], nx = b.st[1];
        if (nloc == 0u) { xcd_barrier_complete(bar, b.x, nloc, nx); b.st[0] = nloc; b.st[1] = nx; }
        const unsigned old = xb_add(&bar[XB_XSUB(b.x)], 1u);
        const unsigned gen = old / nloc;
        if (old + 1u == (gen + 1u) * nloc) {
            __builtin_amdgcn_fence(__ATOMIC_RELEASE, "agent");
            asm volatile("s_waitcnt vmcnt(0)" ::: "memory");
            const unsigned og = xb_add(&bar[XB_TOP], 1u);
            const unsigned tg = og / nx;
            if (og + 1u == (tg + 1u) * nx) xb_add(&bar[XB_TOPGEN], 1u);
            else XB_SPIN(xb_ld(&bar[XB_TOPGEN]) == tg, bar);
            __builtin_amdgcn_fence(__ATOMIC_ACQUIRE, "agent");
            xb_add(&bar[XB_XGEN(b.x)], 1u);
            asm volatile("s_waitcnt vmcnt(0)" ::: "memory");
        } else {
            XB_SPIN(xb_ld(&bar[XB_XGEN(b.x)]) == gen, bar);
            __builtin_amdgcn_fence(__ATOMIC_ACQUIRE, "agent");
            asm volatile("s_waitcnt vmcnt(0)" ::: "memory");
        }
    }
    __syncthreads();
}

typedef short bf16x8 __attribute__((ext_vector_type(8)));
typedef float f32x16 __attribute__((ext_vector_type(16)));
typedef float f32x4 __attribute__((ext_vector_type(4)));
__device__ __forceinline__ unsigned pk_bf16(float a, float b) {
    typedef __bf16 bf2 __attribute__((ext_vector_type(2)));
    typedef float f2 __attribute__((ext_vector_type(2)));
    f2 v = {a, b};
    bf2 r = __builtin_convertvector(v, bf2);
    return __builtin_bit_cast(unsigned, r);
}
__device__ __forceinline__ bf16_t to_bf16(float a) { return (bf16_t)(pk_bf16(a, 0.f) & 0xffffu); }
__device__ __forceinline__ float bf2f(bf16_t v) { return __uint_as_float((unsigned)v << 16); }

__device__ __forceinline__ int opaque_tid() { int t = threadIdx.x; asm volatile("" : "+v"(t)); return t; }
constexpr int LROW = 128;
__device__ __forceinline__ int swz(int r) { return ((r >> 2) & 7) ^ ((r >> 1) & 1); }

template <int ROWS, bool MAYBE_NULL = false> struct LoadRowsBf16 {
    static constexpr int NCH = ROWS * 8 / NT;
    const bf16_t* base; int tid;
    unsigned off[NCH];
    uint4 regs[NCH];
    template <class RF> __device__ __forceinline__ void init(const bf16_t* base_, int ld, RF rowfn) {
        base = base_; tid = opaque_tid();
#pragma unroll
        for (int i = 0; i < NCH; ++i) {
            const int c = tid + i * NT, r = c >> 3, ch = c & 7;
            const long long src = rowfn(r);
            off[i] = (!MAYBE_NULL || src >= 0) ? (unsigned)(src * ld + ch * 8) : 0xffffffffu;
        }
    }
    __device__ __forceinline__ void load(int k0) {
#pragma unroll
        for (int i = 0; i < NCH; ++i)
            regs[i] = (!MAYBE_NULL || off[i] != 0xffffffffu) ? *(const uint4*)(base + (size_t)off[i] + k0) : make_uint4(0, 0, 0, 0);
    }
    __device__ __forceinline__ void store(unsigned char* lds) const {
#pragma unroll
        for (int i = 0; i < NCH; ++i) {
            const int c = tid + i * NT, r = c >> 3, ch = c & 7;
            *(uint4*)(lds + r * LROW + ((ch ^ swz(r)) << 4)) = regs[i];
        }
    }
};

__device__ __forceinline__ int pi16(int x) { return (x & ~12) | ((x & 4) << 1) | ((x & 8) >> 1); }
namespace pg8 {
#define PG8_LAS __attribute__((address_space(3)))
typedef unsigned short bf16_t;
typedef short bf16x8 __attribute__((ext_vector_type(8)));
typedef float f32x4 __attribute__((ext_vector_type(4)));
typedef unsigned u32x4 __attribute__((ext_vector_type(4)));
constexpr int BM = 256, BK = 64, HALF = 128, HTB = HALF * BK * 2  , STAGE_BYTES = 8 * HTB, NXCD = 8, WGM = 8;

__host__ __device__ __forceinline__ int lds_byte(int r, int c) { const int st = (r >> 4) * 2 + (c >> 5), rr = r & 15, cc = c & 31, ob = rr * 64 + cc * 2; return st * 1024 + (ob ^ (((ob >> 9) & 1) << 5)); }
__host__ __device__ __forceinline__ void stage_rc(int b, int& R, int& C) { const int st = b / 1024, sb = b % 1024, swz = sb ^ (((sb >> 9) & 1) << 5); R = (st >> 1) * 16 + swz / 64; C = (st & 1) * 32 + (swz % 64) / 2; }
__host__ __device__ __forceinline__ int perm32(int rho) { const int n = rho >> 4, i = rho & 15; return 8 * (i >> 2) + 4 * n + (i & 3); }

struct Unit { int pm, pn; };
struct Gemm { const bf16_t* A; const bf16_t* Bt; int M, N, K; };

struct StaticOrder {
    int nM, nN, nwg, G, c;
    __host__ __device__ void init(int M, int N, int G_, int c_) { nM = M / BM; nN = N / BM; nwg = nM * nN; G = G_; c = c_; }
    __host__ __device__ bool next(int i, Unit& u) const {
        const long L = (long)i * G + c; if (L >= nwg) return false;
        int wgid = (int)L; { const int q = nwg / NXCD, r = nwg % NXCD, xcd = wgid % NXCD, off = wgid / NXCD; wgid = (xcd < r ? xcd * (q + 1) : r * (q + 1) + (xcd - r) * q) + off; }
        const int nig = WGM * nN, gid = wgid / nig, fm = gid * WGM, gsz = (nM - fm) < WGM ? (nM - fm) : WGM;
        u.pm = fm + ((wgid % nig) % gsz); u.pn = (wgid % nig) / gsz; return true;
    }
    __device__ __forceinline__ void a_ready(const Unit&) const {}
    __device__ __forceinline__ void done(const Unit&) const {}
};


__device__ __forceinline__ unsigned cvt_pk_bf16(float lo, float hi) { unsigned r; asm volatile("v_cvt_pk_bf16_f32 %0, %1, %2" : "=v"(r) : "v"(lo), "v"(hi)); return r; }

template <class Epi, class Sched, bool ALIGN_EPI = false, bool SP2 = false>
__device__ __forceinline__ void gemm_phase(PG8_LAS unsigned char* lds, const Gemm g, const Sched& S, const Epi& E) {
    const int tid = opaque_tid(), wid = __builtin_amdgcn_readfirstlane(tid >> 6), lane = tid & 63, wr = wid >> 2, wc = wid & 3, fr = lane & 15, fq = lane >> 4;
    const int K = g.K, nt = K / BK;
    unsigned voffA[2], voffB[2];
#pragma unroll
    for (int i = 0; i < 2; ++i) { int R, C; stage_rc(tid * 16 + i * 8192, R, C); const int Rb = Epi::PERM ? ((R & ~31) + perm32(R & 31)) : R;
        voffA[i] = (unsigned)(R * K + C) * 2u; voffB[i] = (unsigned)(Rb * K + C) * 2u; }
    const size_t rstep64 = (size_t)64 * K * 2;
    const size_t kstep = (size_t)(BK * 2);
    const size_t hstep = (size_t)HALF * K * 2;
    const size_t tstep = 2 * hstep;
    const unsigned ldsw = (unsigned)wid * 1024u;
    const int aoff = lds_byte(wr * 64 + fr, fq * 8), boff = lds_byte(wc * 32 + fr, fq * 8);
#define PG8_SA(b, h) (((b) * 2 + (h)) * HTB)
#define PG8_SB(b, h) ((4 + (b) * 2 + (h)) * HTB)
#define PG8_STAGE(bufoff, gbase, voff) do { _Pragma("unroll") for (int _i = 0; _i < 2; ++_i) \
        __builtin_amdgcn_global_load_lds((const unsigned*)((const char*)(gbase) + (size_t)_i * rstep64 + (voff)[0]), (PG8_LAS unsigned*)(lds + (bufoff) + ldsw + _i * 8192), 16, 0, 0); } while (0)
#define PG8_LDA(dst, b, h) do { _Pragma("unroll") for (int m = 0; m < 4; ++m) _Pragma("unroll") for (int k = 0; k < 2; ++k) dst[m][k] = *(const PG8_LAS bf16x8*)(lds + PG8_SA(b, h) + aoff + m * 2048 + k * 1024); } while (0)
#define PG8_LDB(dst, b, h) do { _Pragma("unroll") for (int n = 0; n < 2; ++n) _Pragma("unroll") for (int k = 0; k < 2; ++k) dst[n][k] = *(const PG8_LAS bf16x8*)(lds + PG8_SB(b, h) + boff + n * 2048 + k * 1024); } while (0)
#define PG8_MMA(ai, bj, At, Bt) do { __builtin_amdgcn_s_setprio(1); _Pragma("unroll") for (int m = 0; m < 4; ++m) _Pragma("unroll") for (int n = 0; n < 2; ++n) _Pragma("unroll") for (int k = 0; k < 2; ++k) \
        acc[ai][bj][m][n] = __builtin_amdgcn_mfma_f32_16x16x32_bf16(Bt[n][k], At[m][k], acc[ai][bj][m][n], 0, 0, 0); __builtin_amdgcn_s_setprio(0); } while (0)
#define PG8_WAIT_V(n) asm volatile("s_waitcnt vmcnt(" #n ")" ::: "memory")
#define PG8_WAIT_L(n) asm volatile("s_waitcnt lgkmcnt(" #n ")" ::: "memory")
#define PG8_BAR __builtin_amdgcn_s_barrier()
#define PG8_SCHED __builtin_amdgcn_sched_barrier(0)
    Unit cur, nxt; int ui = 0;
    if (!S.next(0, cur)) return;
    f32x4 acc[2][2][4][2];
#pragma unroll
    for (int a = 0; a < 2; ++a)
#pragma unroll
        for (int b = 0; b < 2; ++b)
#pragma unroll
            for (int m = 0; m < 4; ++m)
#pragma unroll
                for (int n = 0; n < 2; ++n) acc[a][b][m][n] = (f32x4){0.f, 0.f, 0.f, 0.f};
    bf16x8 At[4][2], B0[2][2], B1[2][2];
    const char* cA = (const char*)g.A + (size_t)cur.pm * tstep; const char* cB = (const char*)g.Bt + (size_t)cur.pn * tstep;
    S.a_ready(cur);
    if constexpr (SP2) {
        PG8_STAGE(PG8_SB(0, 0), cB, voffB); PG8_STAGE(PG8_SB(0, 1), cB + hstep, voffB); PG8_STAGE(PG8_SA(0, 0), cA, voffA); PG8_STAGE(PG8_SA(0, 1), cA + hstep, voffA);
        if (wr == 1) PG8_BAR;
        PG8_WAIT_V(2); PG8_BAR;
        PG8_STAGE(PG8_SB(1, 0), cB + kstep, voffB); PG8_STAGE(PG8_SA(1, 0), cA + kstep, voffA); PG8_STAGE(PG8_SB(1, 1), cB + hstep + kstep, voffB);
        PG8_WAIT_V(6); PG8_BAR;
    } else {
        PG8_STAGE(PG8_SB(0, 0), cB, voffB); PG8_STAGE(PG8_SA(0, 0), cA, voffA); PG8_STAGE(PG8_SB(0, 1), cB + hstep, voffB); PG8_STAGE(PG8_SA(0, 1), cA + hstep, voffA);
        if (wr == 1) PG8_BAR;
        PG8_WAIT_V(4); PG8_BAR;
        PG8_STAGE(PG8_SB(1, 0), cB + kstep, voffB); PG8_STAGE(PG8_SA(1, 0), cA + kstep, voffA); PG8_STAGE(PG8_SB(1, 1), cB + hstep + kstep, voffB);
        PG8_WAIT_V(6); PG8_BAR;
    }
    for (;;) {
        const bool has_next = S.next(ui + 1, nxt);
        const char* nA = has_next ? (const char*)g.A + (size_t)nxt.pm * tstep : cA; const char* nB = has_next ? (const char*)g.Bt + (size_t)nxt.pn * tstep : cB;
        for (int t = 0; t < nt; t += 2) {
            const bool last = (t == nt - 2);
            const char* a1 = cA + (size_t)(t + 1) * kstep;
            const char* a2 = last ? nA : cA + (size_t)(t + 2) * kstep; const char* b2 = last ? nB : cB + (size_t)(t + 2) * kstep;
            const char* a3 = a2 + kstep; const char* b3 = b2 + kstep;
            if (last && has_next) S.a_ready(nxt);
            if constexpr (SP2) {
            PG8_LDB(B0, 0, 0); PG8_LDB(B1, 0, 1); PG8_SCHED; PG8_LDA(At, 0, 0); PG8_STAGE(PG8_SA(1, 1), a1 + hstep, voffA);
            PG8_WAIT_V(8); PG8_WAIT_L(0); PG8_BAR; PG8_MMA(0, 0, At, B0); PG8_MMA(0, 1, At, B1); PG8_BAR; PG8_SCHED;
            PG8_LDA(At, 0, 1); PG8_STAGE(PG8_SB(0, 0), b2, voffB); PG8_STAGE(PG8_SB(0, 1), b2 + hstep, voffB); PG8_STAGE(PG8_SA(0, 0), a2, voffA);
            PG8_WAIT_V(8); PG8_WAIT_L(0); PG8_BAR; PG8_MMA(1, 0, At, B0); PG8_MMA(1, 1, At, B1); PG8_BAR; PG8_SCHED;
            PG8_LDB(B0, 1, 0); PG8_LDB(B1, 1, 1); PG8_SCHED; PG8_LDA(At, 1, 0); PG8_STAGE(PG8_SA(0, 1), a2 + hstep, voffA);
            PG8_WAIT_V(8); PG8_WAIT_L(0); PG8_BAR; PG8_MMA(0, 0, At, B0); PG8_MMA(0, 1, At, B1); PG8_BAR; PG8_SCHED;
            PG8_LDA(At, 1, 1); PG8_STAGE(PG8_SB(1, 0), b3, voffB); PG8_STAGE(PG8_SB(1, 1), b3 + hstep, voffB); PG8_STAGE(PG8_SA(1, 0), a3, voffA);
            PG8_WAIT_V(8); PG8_WAIT_L(0); PG8_BAR; PG8_MMA(1, 0, At, B0); PG8_MMA(1, 1, At, B1); PG8_BAR; PG8_SCHED;
            } else {
            PG8_LDB(B0, 0, 0); PG8_SCHED; PG8_LDA(At, 0, 0); PG8_STAGE(PG8_SA(1, 1), a1 + hstep, voffA);
            PG8_WAIT_L(8); PG8_BAR; PG8_WAIT_L(0); PG8_MMA(0, 0, At, B0); PG8_BAR; PG8_SCHED;
            PG8_LDB(B1, 0, 1); PG8_STAGE(PG8_SB(0, 0), b2, voffB);
            PG8_BAR; PG8_WAIT_L(0); PG8_MMA(0, 1, At, B1); PG8_BAR;
            PG8_LDA(At, 0, 1); PG8_STAGE(PG8_SA(0, 0), a2, voffA);
            PG8_BAR; PG8_WAIT_L(0); PG8_MMA(1, 0, At, B0); PG8_BAR; PG8_SCHED;
            PG8_STAGE(PG8_SB(0, 1), b2 + hstep, voffB);
            PG8_WAIT_V(6); PG8_BAR; PG8_MMA(1, 1, At, B1); PG8_BAR;
            PG8_LDB(B0, 1, 0); PG8_SCHED; PG8_LDA(At, 1, 0); PG8_STAGE(PG8_SA(0, 1), a2 + hstep, voffA);
            PG8_WAIT_L(8); PG8_BAR; PG8_WAIT_L(0); PG8_MMA(0, 0, At, B0); PG8_BAR; PG8_SCHED;
            PG8_LDB(B1, 1, 1); PG8_STAGE(PG8_SB(1, 0), b3, voffB);
            PG8_BAR; PG8_WAIT_L(0); PG8_MMA(0, 1, At, B1); PG8_BAR;
            PG8_LDA(At, 1, 1); PG8_STAGE(PG8_SA(1, 0), a3, voffA);
            PG8_BAR; PG8_WAIT_L(0); PG8_MMA(1, 0, At, B0); PG8_BAR; PG8_SCHED;
            PG8_STAGE(PG8_SB(1, 1), b3 + hstep, voffB);
            PG8_WAIT_V(6); PG8_BAR; PG8_MMA(1, 1, At, B1); PG8_BAR;
            }
        }
        if constexpr (ALIGN_EPI) { if (wr == 0) PG8_BAR; }
        if constexpr (!Epi::AFTER_DRAIN) { E(acc, cur, wr, wc, fr, fq); S.done(cur); }
        if (!has_next) break;
#pragma unroll
        for (int a = 0; a < 2; ++a)
#pragma unroll
            for (int b = 0; b < 2; ++b)
#pragma unroll
                for (int m = 0; m < 4; ++m)
#pragma unroll
                    for (int n = 0; n < 2; ++n) acc[a][b][m][n] = (f32x4){0.f, 0.f, 0.f, 0.f};
        cur = nxt; cA = nA; cB = nB; ++ui;
        if constexpr (ALIGN_EPI) { if (wr == 1) PG8_BAR; }
    }
    PG8_WAIT_V(0);
    if constexpr (!ALIGN_EPI) { if (wr == 0) PG8_BAR; }
    PG8_BAR;
    if constexpr (Epi::AFTER_DRAIN) { E.fused(acc, cur, wr, wc, fr, fq, lds, wid, lane); S.done(cur); }
#undef PG8_SA
#undef PG8_SB
#undef PG8_STAGE
#undef PG8_LDA
#undef PG8_LDB
#undef PG8_MMA
#undef PG8_WAIT_V
#undef PG8_WAIT_L
#undef PG8_BAR
#undef PG8_SCHED
}
}

struct EpiInproj {
    static constexpr bool PERM = true, AFTER_DRAIN = false;
    bf16_t *qkvraw, *dzb, *sq, *sk, *vT, *gab, *gbb; float* small;
    __device__ __forceinline__ void operator()(const pg8::f32x4 (&acc)[2][2][4][2], const pg8::Unit& u, int wr, int wc, int fr, int fq) const {
        const int pn = u.pn, row0 = u.pm * 256 + wr * 64 + fr;
        if (pn == 12 || pn == 13) {
#pragma unroll
            for (int ai = 0; ai < 2; ++ai)
#pragma unroll
                for (int m = 0; m < 4; ++m) {
                    const int tok = row0 + ai * 128 + m * 16, bb = tok >> 11, key = tok & (SEQ - 1), pos = (key & ~15) | pi16(key & 15);
#pragma unroll
                    for (int bj = 0; bj < 2; ++bj)
#pragma unroll
                        for (int n = 0; n < 2; ++n)
#pragma unroll
                            for (int j = 0; j < 4; ++j) {
                                const int svcol = (pn - 12) * 256 + bj * 128 + wc * 32 + fq * 8 + n * 4 + j;
                                vT[((size_t)((bb * 8 + (svcol >> 6)) * 64 + (svcol & 63))) * SEQ + pos] = to_bf16(acc[ai][bj][m][n][j]);
                            }
                }
        } else if (pn == 22) {
            if (wc == 0 && fq == 0) {
#pragma unroll
                for (int ai = 0; ai < 2; ++ai)
#pragma unroll
                    for (int m = 0; m < 4; ++m) {
                        pg8::f32x4* d = (pg8::f32x4*)(small + (size_t)(row0 + ai * 128 + m * 16) * 8);
                        d[0] = acc[ai][0][m][0]; d[1] = acc[ai][0][m][1];
                    }
            }
        } else {
            bf16_t* dst; int ld, c0; float sc = 1.f; bool gate = false;
            if (pn < 6) { dst = qkvraw; ld = 1536; c0 = pn * 256; }
            else if (pn < 8) { dst = dzb; ld = 512; c0 = (pn - 6) * 256; }
            else if (pn < 10) { dst = sq; ld = 512; c0 = (pn - 8) * 256; sc = 0.125f * 1.4426950408889634f; }
            else if (pn < 12) { dst = sk; ld = 512; c0 = (pn - 10) * 256; }
            else if (pn < 18) { dst = gab; ld = 1024; c0 = (pn - 14) * 256; gate = true; }
            else { dst = gbb; ld = 1024; c0 = (pn - 18) * 256; gate = true; }
#pragma unroll
            for (int ai = 0; ai < 2; ++ai)
#pragma unroll
                for (int m = 0; m < 4; ++m) {
                    bf16_t* rowp = dst + (size_t)(row0 + ai * 128 + m * 16) * ld + c0 + wc * 32 + fq * 8;
#pragma unroll
                    for (int bj = 0; bj < 2; ++bj) {
                        pg8::f32x4 v0 = acc[ai][bj][m][0] * sc, v1 = acc[ai][bj][m][1] * sc;
                        if (gate) {
#pragma unroll
                            for (int j = 0; j < 4; ++j) { v0[j] = sigmoidf_(v0[j]); v1[j] = sigmoidf_(v1[j]); }
                        }
                        pg8::u32x4 w; w.x = pk_bf16(v0[0], v0[1]); w.y = pk_bf16(v0[2], v0[3]); w.z = pk_bf16(v1[0], v1[1]); w.w = pk_bf16(v1[2], v1[3]);
                        *(pg8::u32x4*)(rowp + bj * 128) = w;
                    }
                }
        }
    }
};
template <class F> struct EpiF4 {
    static constexpr bool PERM = false, AFTER_DRAIN = false;
    F f;
    __device__ __forceinline__ void operator()(const pg8::f32x4 (&acc)[2][2][4][2], const pg8::Unit& u, int wr, int wc, int fr, int fq) const {
#pragma unroll
        for (int ai = 0; ai < 2; ++ai)
#pragma unroll
            for (int m = 0; m < 4; ++m) {
                const int row = u.pm * 256 + ai * 128 + wr * 64 + m * 16 + fr;
#pragma unroll
                for (int bj = 0; bj < 2; ++bj)
#pragma unroll
                    for (int n = 0; n < 2; ++n) f(row, u.pn * 256 + bj * 128 + wc * 32 + n * 16 + fq * 4, acc[ai][bj][m][n]);
            }
    }
};
template <class F> __device__ __forceinline__ void run_pg8(const bf16_t* A, const bf16_t* Bt, int M, int N, int K, unsigned char* lds, F f) {
    pg8::Gemm g{A, Bt, M, N, K};
    pg8::StaticOrder S; S.init(M, N, gridDim.x, blockIdx.x);
    EpiF4<F> E{f};
    pg8::gemm_phase<EpiF4<F>, pg8::StaticOrder, true, true>((PG8_LAS unsigned char*)lds, g, S, E);
}
__device__ __forceinline__ void unpack4(uint2 w, float (&g)[4]) {
    g[0] = __uint_as_float(w.x << 16); g[1] = __uint_as_float(w.x & 0xffff0000u); g[2] = __uint_as_float(w.y << 16); g[3] = __uint_as_float(w.y & 0xffff0000u);
}

struct LoadKNF32 {
    const float* base; int ld, kq, nq;
    f32x4 regs[8];
    template <class CF> __device__ __forceinline__ void init(const float* w, int ld_, CF colfn) {
        const int tid = opaque_tid(); kq = tid >> 6; nq = tid & 63; ld = ld_;
        base = w + (size_t)(kq * 8) * ld_ + colfn(nq * 4);
    }
    __device__ __forceinline__ void load(int k0) {
#pragma unroll
        for (int j = 0; j < 8; ++j) regs[j] = *(const f32x4*)(base + (size_t)(k0 + j) * ld);
    }
    __device__ __forceinline__ void store1(unsigned char* lds, int nn, float a0, float a1, float a2, float a3, float a4, float a5, float a6, float a7) const {
        uint4 o; o.x = pk_bf16(a0, a1); o.y = pk_bf16(a2, a3); o.z = pk_bf16(a4, a5); o.w = pk_bf16(a6, a7);
        const int row = nq * 4 + nn;
        *(uint4*)(lds + row * LROW + ((kq ^ swz(row)) << 4)) = o;
    }
    __device__ __forceinline__ void store(unsigned char* lds) const {
        store1(lds, 0, regs[0].x, regs[1].x, regs[2].x, regs[3].x, regs[4].x, regs[5].x, regs[6].x, regs[7].x);
        store1(lds, 1, regs[0].y, regs[1].y, regs[2].y, regs[3].y, regs[4].y, regs[5].y, regs[6].y, regs[7].y);
        store1(lds, 2, regs[0].z, regs[1].z, regs[2].z, regs[3].z, regs[4].z, regs[5].z, regs[6].z, regs[7].z);
        store1(lds, 3, regs[0].w, regs[1].w, regs[2].w, regs[3].w, regs[4].w, regs[5].w, regs[6].w, regs[7].w);
    }
};

template <int BM_, int BN_, int WM_, int WN_> struct GemmCfg {
    static constexpr int BM = BM_, BN = BN_, WM = WM_, WN = WN_;
    static constexpr int TM = BM / WM, TN = BN / WN, MI = TM / 32, NI = TN / 32;
    static constexpr int A_BYTES = BM * LROW, B_BYTES = BN * LROW, STAGE = A_BYTES + B_BYTES;
    static_assert(WM * WN == 8, "8 waves");
};

template <class CFG, class AL, class BL>
__device__ __forceinline__ void gemm_mainloop(AL& al, BL& bl, int nk, f32x16 (&acc)[CFG::MI][CFG::NI], unsigned char* lds) {
    constexpr int MI = CFG::MI, NI = CFG::NI;
    const int tid = opaque_tid(), lane = tid & 63, wid = tid >> 6;
    const int wm = wid / CFG::WN, wn = wid % CFG::WN;
    const int l31 = lane & 31, lh = lane >> 5;
    al.load(0); bl.load(0);
    const int a_off = (wm * CFG::TM + l31) * LROW;
    const int b_off = CFG::A_BYTES + (wn * CFG::TN + l31) * LROW;
    const int fsw = swz(l31);
    for (int kt = 0; kt < nk; ++kt) {
        unsigned char* st = lds + (kt & 1) * CFG::STAGE;
        al.store(st); bl.store(st + CFG::A_BYTES);
        __syncthreads();
        if (kt + 1 < nk) { al.load((kt + 1) * 64); bl.load((kt + 1) * 64); }
#pragma unroll
        for (int kk = 0; kk < 4; ++kk) {
            bf16x8 a[MI], b[NI];
#pragma unroll
            for (int mi = 0; mi < MI; ++mi) a[mi] = *(const bf16x8*)(st + a_off + mi * 32 * LROW + (((kk * 2 + lh) ^ fsw) << 4));
#pragma unroll
            for (int ni = 0; ni < NI; ++ni) b[ni] = *(const bf16x8*)(st + b_off + ni * 32 * LROW + (((kk * 2 + lh) ^ fsw) << 4));
#pragma unroll
            for (int mi = 0; mi < MI; ++mi)
#pragma unroll
                for (int ni = 0; ni < NI; ++ni)
                    acc[mi][ni] = __builtin_amdgcn_mfma_f32_32x32x16_bf16(a[mi], b[ni], acc[mi][ni], 0, 0, 0);
        }
    }
    __syncthreads();
}
template <class CFG, bool A_RES, int ARES_ROT, bool TRANS, class AL, class BL>
__device__ __forceinline__ void gemm_mainloop2(AL (&al)[2], BL (&bl)[2], int nk, f32x16 (&acc)[CFG::MI][CFG::NI], unsigned char* stages, const unsigned char* ares) {
    constexpr int MI = CFG::MI, NI = CFG::NI;
    constexpr int STG = A_RES ? CFG::B_BYTES : CFG::STAGE, BOFF = A_RES ? 0 : CFG::A_BYTES;
    const int tid = opaque_tid(), lane = tid & 63, wid = tid >> 6;
    const int wm = wid / CFG::WN, wn = wid % CFG::WN;
    const int l31 = lane & 31, lh = lane >> 5;
    if (!A_RES) { al[0].load(0); } bl[0].load(0);
    if (!A_RES) { al[1].load(64); } bl[1].load(64);
    const int a_off = (wm * CFG::TM + l31) * LROW;
    const int b_off = BOFF + (wn * CFG::TN + l31) * LROW;
    const int fsw = swz(l31);
    for (int kt = 0; kt < nk; kt += 2) {
#pragma unroll
        for (int u = 0; u < 2; ++u) {
            unsigned char* st = stages + u * STG;
            if (!A_RES) al[u].store(st);
            bl[u].store(st + BOFF);
            __syncthreads();
            if (kt + u + 2 < nk) { if (!A_RES) al[u].load((kt + u + 2) * 64); bl[u].load((kt + u + 2) * 64); }
            const unsigned char* ab = A_RES ? ares + (size_t)((kt + u + ARES_ROT) & 3) * (CFG::BM * LROW) : st;
#pragma unroll
            for (int kk = 0; kk < 4; ++kk) {
                bf16x8 a[MI], b[NI];
#pragma unroll
                for (int mi = 0; mi < MI; ++mi) a[mi] = *(const bf16x8*)(ab + a_off + mi * 32 * LROW + (((kk * 2 + lh) ^ fsw) << 4));
#pragma unroll
                for (int ni = 0; ni < NI; ++ni) b[ni] = *(const bf16x8*)(st + b_off + ni * 32 * LROW + (((kk * 2 + lh) ^ fsw) << 4));
#pragma unroll
                for (int mi = 0; mi < MI; ++mi)
#pragma unroll
                    for (int ni = 0; ni < NI; ++ni)
                        acc[mi][ni] = TRANS ? __builtin_amdgcn_mfma_f32_32x32x16_bf16(b[ni], a[mi], acc[mi][ni], 0, 0, 0)
                                            : __builtin_amdgcn_mfma_f32_32x32x16_bf16(a[mi], b[ni], acc[mi][ni], 0, 0, 0);
            }
        }
    }
    __syncthreads();
}
template <class CFG> __device__ __forceinline__ void acc_zero(f32x16 (&acc)[CFG::MI][CFG::NI]) {
#pragma unroll
    for (int mi = 0; mi < CFG::MI; ++mi)
#pragma unroll
        for (int ni = 0; ni < CFG::NI; ++ni)
#pragma unroll
            for (int r = 0; r < 16; ++r) acc[mi][ni][r] = 0.f;
}
template <class CFG, class F> __device__ __forceinline__ void acc_foreach(f32x16 (&acc)[CFG::MI][CFG::NI], F f) {
    const int tid = opaque_tid(), lane = tid & 63, wid = tid >> 6;
    const int wm = wid / CFG::WN, wn = wid % CFG::WN;
#pragma unroll
    for (int mi = 0; mi < CFG::MI; ++mi)
#pragma unroll
        for (int ni = 0; ni < CFG::NI; ++ni) {
            asm volatile("" ::: "memory");
#pragma unroll
            for (int r = 0; r < 16; ++r)
                acc[mi][ni][r] = f(wm * CFG::TM + mi * 32 + (r & 3) + 8 * (r >> 2) + 4 * (lane >> 5), wn * CFG::TN + ni * 32 + (lane & 31), acc[mi][ni][r], mi, ni, r);
        }
}

struct TileMap {
    int ntm, ntn, npm, npn, rounds; bool patched;
    int pm, pn;
    __device__ __forceinline__ void init(int ntm_, int ntn_) {
        ntm = ntm_; ntn = ntn_; patched = (gridDim.x == 256);
        pn = ntn >= 8 ? 8 : ntn >= 4 ? 4 : ntn >= 2 ? 2 : 1; pm = 32 / pn;
        if (patched) { npm = (ntm + pm - 1) / pm; npn = (ntn + pn - 1) / pn; rounds = (npm * npn + 7) / 8; }
        else { int G = gridDim.x; asm volatile("" : "+s"(G)); npm = npn = 0; rounds = (ntm * ntn + G - 1) / G; }
    }
    __device__ __forceinline__ bool get(int round, int& tm, int& tn) const {
        const int b = blockIdx.x;
        if (patched) {
            const int patch = round * 8 + (b & 7), slot = b >> 3;
            if (patch >= npm * npn) return false;
            tm = (patch / npn) * pm + slot / pn; tn = (patch % npn) * pn + slot % pn;
            return tm < ntm && tn < ntn;
        }
        const int t = round * gridDim.x + b;
        if (t >= ntm * ntn) return false;
        tm = t / ntn; tn = t % ntn; return true;
    }
};

template <class CM>
__device__ __forceinline__ void transpose_convert(const float* W, int K, int N, int NP, bf16_t* Wt, float* sm, CM cmap) {
    const int tid = opaque_tid(), ntk = K / 64, ntn = NP / 64;
    for (int tile = blockIdx.x; tile < ntk * ntn; tile += gridDim.x) {
        const int tk = tile % ntk, tn = tile / ntk;
#pragma unroll
        for (int i = 0; i < 8; ++i) {
            const int e = tid + i * NT, kk = e >> 6, nn = e & 63, col = cmap(tn * 64 + nn);
            sm[nn * 65 + kk] = col >= 0 ? W[(size_t)(tk * 64 + kk) * N + col] : 0.f;
        }
        __syncthreads();
        const int n = tid >> 3, kc = tid & 7;
        const float* r = sm + n * 65 + kc * 8;
        uint4 o; o.x = pk_bf16(r[0], r[1]); o.y = pk_bf16(r[2], r[3]); o.z = pk_bf16(r[4], r[5]); o.w = pk_bf16(r[6], r[7]);
        *(uint4*)(Wt + (size_t)(tn * 64 + n) * K + tk * 64 + kc * 8) = o;
        __syncthreads();
    }
}
__device__ __forceinline__ void transpose_tile_f4(const float* W, int K, int N, bf16_t* Wt, int k0, int n0, float* sm) {
    const int tid = opaque_tid(), kk = tid >> 4, n4 = tid & 15;
#pragma unroll
    for (int h = 0; h < 2; ++h) {
        const int k = kk + 32 * h;
        const f32x4 v = *(const f32x4*)(W + (size_t)(k0 + k) * N + n0 + n4 * 4);
#pragma unroll
        for (int j = 0; j < 4; ++j) sm[(n4 * 4 + j) * 65 + k] = v[j];
    }
    __syncthreads();
    const int n = tid >> 3, kc = tid & 7;
    const float* r = sm + n * 65 + kc * 8;
    uint4 o; o.x = pk_bf16(r[0], r[1]); o.y = pk_bf16(r[2], r[3]); o.z = pk_bf16(r[4], r[5]); o.w = pk_bf16(r[6], r[7]);
    *(uint4*)(Wt + (size_t)(n0 + n) * K + k0 + kc * 8) = o;
    __syncthreads();
}
__device__ __forceinline__ void convert_bf16(const float* src, bf16_t* dst, size_t n) {
    const size_t gtid = (size_t)blockIdx.x * NT + opaque_tid(), gsz = (size_t)gridDim.x * NT;
    for (size_t i = gtid; i < n / 8; i += gsz) {
        const float4 a = ((const float4*)src)[2 * i], b = ((const float4*)src)[2 * i + 1];
        uint4 o; o.x = pk_bf16(a.x, a.y); o.y = pk_bf16(a.z, a.w); o.z = pk_bf16(b.x, b.y); o.w = pk_bf16(b.z, b.w);
        ((uint4*)dst)[i] = o;
    }
}

__device__ __forceinline__ void phase_inproj(const Params& p, unsigned char* lds) {
    pg8::Gemm g{p.xb, p.w_in_t, T, PWP, D};
    pg8::StaticOrder S; S.init(T, PWP, gridDim.x, blockIdx.x);
    EpiInproj E{p.qkvraw, p.dzb, p.sq, p.sk, p.vT, p.gab, p.gbb, p.small};
    pg8::gemm_phase<EpiInproj, pg8::StaticOrder, true, true>((PG8_LAS unsigned char*)lds, g, S, E);
}

__device__ __forceinline__ void load_gate16(const bf16_t* gbuf, int rb, int cb, int lane, float (&g)[16]) {
    const uint4* src = (const uint4*)(gbuf + ((size_t)(rb * 32 + cb) * 64 + lane) * 16);
    const uint4 a = src[0], b = src[1];
    const unsigned u[8] = {a.x, a.y, a.z, a.w, b.x, b.y, b.z, b.w};
#pragma unroll
    for (int i = 0; i < 8; ++i) { g[2 * i] = __uint_as_float(u[i] << 16); g[2 * i + 1] = __uint_as_float(u[i] & 0xffff0000u); }
}
__device__ __forceinline__ void phase_merge(const Params& p, unsigned char* lds) {
    run_pg8(p.oab, p.w_pa_t, T, D, DNW, lds, [&](int row, int col, pg8::f32x4 v) {
        float g[4]; unpack4(*(const uint2*)(p.gab + (size_t)row * D + col), g);
        *(pg8::f32x4*)(p.m1 + (size_t)row * D + col) = (pg8::f32x4){v[0] * g[0], v[1] * g[1], v[2] * g[2], v[3] * g[3]};
    });
    run_pg8(p.obb, p.w_pb_t, T, D, SBW, lds, [&](int row, int col, pg8::f32x4 v) {
        float g[4]; unpack4(*(const uint2*)(p.gbb + (size_t)row * D + col), g);
        const pg8::f32x4 m = *(const pg8::f32x4*)(p.m1 + (size_t)row * D + col);
        uint2 w; w.x = pk_bf16(m[0] + v[0] * g[0], m[1] + v[1] * g[1]); w.y = pk_bf16(m[2] + v[2] * g[2], m[3] + v[3] * g[3]);
        *(uint2*)(p.mergedb + (size_t)row * D + col) = w;
    });
}

__device__ __forceinline__ void phase_outproj(const Params& p, unsigned char* lds) {
    run_pg8(p.mergedb, p.w_out_t, T, D, D, lds, [&](int row, int col, pg8::f32x4 v) {
        const size_t o = (size_t)row * D + col;
        const pg8::f32x4 x = *(const pg8::f32x4*)(p.x + o);
        *(pg8::f32x4*)(p.pre1 + o) = v + x * ALPHA;
    });
}

__device__ __forceinline__ void phase_router_shared_up(const Params& p, unsigned char* lds) {
    {
        typedef GemmCfg<128, 128, 4, 2> CFG;
        TileMap tmap; tmap.init(T / 128, NE / 128);
        for (int round = 0; round < tmap.rounds; ++round) {
            int tm, tn;
            if (!tmap.get(round, tm, tn)) continue;
            LoadRowsBf16<128> al, bl;
            al.init(p.hb, D, [&](int r) { return (long long)(tm * 128 + r); });
            bl.init(p.w_router_t, D, [&](int r) { return (long long)(tn * 128 + r); });
            f32x16 acc[CFG::MI][CFG::NI];
            acc_zero<CFG>(acc);
            gemm_mainloop<CFG>(al, bl, D / 64, acc, lds);
            asm volatile("" : "+s"(tm), "+s"(tn));
            acc_foreach<CFG>(acc, [&](int r, int c, float v, int, int, int) {
                p.scores[(size_t)(tm * 128 + r) * NE + tn * 128 + c] = sigmoidf_(v);
                return v;
            });
        }
    }
    {
        typedef GemmCfg<128, 256, 2, 4> CFG;
        TileMap tmap; tmap.init(T / 128, SFF / 128);
        for (int round = 0; round < tmap.rounds; ++round) {
            int tm, tn;
            if (!tmap.get(round, tm, tn)) continue;
            LoadRowsBf16<128> al; LoadRowsBf16<256> bl;
            al.init(p.hb, D, [&](int r) { return (long long)(tm * 128 + r); });
            bl.init(p.w_su_t, D, [&](int r) { return (long long)(((r >> 5) & 1) * SFF + tn * 128 + (r >> 6) * 32 + (r & 31)); });
            f32x16 acc[CFG::MI][CFG::NI];
            acc_zero<CFG>(acc);
            gemm_mainloop<CFG>(al, bl, D / 64, acc, lds);
            asm volatile("" : "+s"(tm), "+s"(tn));
            const int tid = opaque_tid(), lane = tid & 63, wid = tid >> 6, wm = wid / CFG::WN, wn = wid % CFG::WN;
#pragma unroll
            for (int mi = 0; mi < CFG::MI; ++mi)
#pragma unroll
                for (int r = 0; r < 16; ++r) {
                    const int row = tm * 128 + wm * CFG::TM + mi * 32 + (r & 3) + 8 * (r >> 2) + 4 * (lane >> 5);
                    const int j = tn * 128 + wn * 32 + (lane & 31);
                    const float g = acc[mi][0][r], u = acc[mi][1][r];
                    p.actsh[(size_t)row * SFF + j] = to_bf16(siluf_(g) * u);
                }
        }
    }
}

__device__ __forceinline__ void phase_shared_down(const Params& p, unsigned char* lds) {
    run_pg8(p.actsh, p.w_sd_t, T, D, SFF, lds, [&](int row, int col, pg8::f32x4 v) {
        uint2 w; w.x = pk_bf16(v[0], v[1]); w.y = pk_bf16(v[2], v[3]);
        *(uint2*)(p.yshb + (size_t)row * D + col) = w;
    });
}

__device__ __forceinline__ void phase_init(const Params& p) {
    const int gtid = blockIdx.x * NT + opaque_tid(), gsz = gridDim.x * NT;
    for (int i = gtid; i < 2 * NE * CSTRIDE; i += gsz) p.counts[i] = 0;
}

__device__ __forceinline__ void sb_attn_wave(const Params& p, int bh, int qt) {
    const int lane = opaque_tid() & 63, l31 = lane & 31, lh = lane >> 5;
    const int b = bh >> 3, hh = bh & 7;
    bf16x8 qf[4];
    {
        const bf16_t* qrow = p.sq + (size_t)(b * SEQ + qt * 32 + l31) * SBW + hh * 64 + lh * 8;
#pragma unroll
        for (int ks = 0; ks < 4; ++ks) qf[ks] = *(const bf16x8*)(qrow + ks * 16);
    }
    f32x16 o0, o1;
#pragma unroll
    for (int r = 0; r < 16; ++r) { o0[r] = 0.f; o1[r] = 0.f; }
    float run = 0.f;
    const bf16_t* vbase = p.vT + ((size_t)(bh * 64 + l31)) * SEQ + lh * 8;
    for (int kt = qt; kt >= 0; --kt) {
        const bf16_t* krow = p.sk + (size_t)(b * SEQ + kt * 32 + l31) * SBW + hh * 64 + lh * 8;
        bf16x8 kf[4];
#pragma unroll
        for (int ks = 0; ks < 4; ++ks) kf[ks] = *(const bf16x8*)(krow + ks * 16);
        bf16x8 vf[2][2];
#pragma unroll
        for (int md = 0; md < 2; ++md)
#pragma unroll
            for (int ss = 0; ss < 2; ++ss) vf[md][ss] = *(const bf16x8*)(vbase + (size_t)md * 32 * SEQ + kt * 32 + ss * 16);
        f32x16 sc;
#pragma unroll
        for (int r = 0; r < 16; ++r) sc[r] = 0.f;
#pragma unroll
        for (int ks = 0; ks < 4; ++ks) sc = __builtin_amdgcn_mfma_f32_32x32x16_bf16(kf[ks], qf[ks], sc, 0, 0, 0);
        float lb[16], lr[16];
        const bool diag = (kt == qt);
#pragma unroll
        for (int r = 0; r < 16; ++r) {
            const float z = sc[r];
            const float l = __builtin_amdgcn_logf(1.f + __builtin_amdgcn_exp2f(-fabsf(z)));
            float b_ = fminf(z, 0.f) - l, r_ = b_ - z;
            if (diag) { const bool valid = ((r & 3) + 8 * (r >> 2) + 4 * lh) < l31; r_ = valid ? r_ : 0.f; b_ = valid ? b_ : -INFINITY; }
            lb[r] = b_; lr[r] = r_;
        }
        float ex[16], B[4];
#pragma unroll
        for (int g = 0; g < 4; ++g) {
            ex[4 * g + 3] = 0.f;
            ex[4 * g + 2] = lr[4 * g + 3];
            ex[4 * g + 1] = ex[4 * g + 2] + lr[4 * g + 2];
            ex[4 * g + 0] = ex[4 * g + 1] + lr[4 * g + 1];
            B[g] = ex[4 * g + 0] + lr[4 * g + 0];
        }
        float P[4];
#pragma unroll
        for (int g = 0; g < 4; ++g) P[g] = shfl_lane(B[g], lane ^ 32);
        float off[4];
        {
            const float p3 = P[3], p2 = P[2] + p3, p1 = P[1] + p2, p0 = P[0] + p1;
            const float b3 = 0.f, b2 = B[3], b1 = B[2] + b2, b0 = B[1] + b1;
            off[0] = b0 + (lh ? p1 : p0);
            off[1] = b1 + (lh ? p2 : p1);
            off[2] = b2 + (lh ? p3 : p2);
            off[3] = b3 + (lh ? 0.f : p3);
            const float total = (B[0] + b0) + p0;
#pragma unroll
            for (int g = 0; g < 4; ++g) off[g] += run;
            run += total;
        }
        float a[16];
#pragma unroll
        for (int r = 0; r < 16; ++r) a[r] = __builtin_amdgcn_exp2f(lb[r] + ex[r] + off[r >> 2]);
        bf16x8 pf[2];
#pragma unroll
        for (int ss = 0; ss < 2; ++ss) {
            typedef unsigned u32x4 __attribute__((ext_vector_type(4)));
            u32x4 w;
            w[0] = pk_bf16(a[8 * ss + 0], a[8 * ss + 1]); w[1] = pk_bf16(a[8 * ss + 2], a[8 * ss + 3]);
            w[2] = pk_bf16(a[8 * ss + 4], a[8 * ss + 5]); w[3] = pk_bf16(a[8 * ss + 6], a[8 * ss + 7]);
            pf[ss] = __builtin_bit_cast(bf16x8, w);
        }
#pragma unroll
        for (int ss = 0; ss < 2; ++ss) {
            o0 = __builtin_amdgcn_mfma_f32_32x32x16_bf16(vf[0][ss], pf[ss], o0, 0, 0, 0);
            o1 = __builtin_amdgcn_mfma_f32_32x32x16_bf16(vf[1][ss], pf[ss], o1, 0, 0, 0);
        }
        if (__all(run < -160.f)) break;
    }
    bf16_t* orow = p.obb + (size_t)(b * SEQ + qt * 32 + l31) * SBW + hh * 64 + 4 * lh;
#pragma unroll
    for (int g = 0; g < 4; ++g) {
        uint2 w0, w1;
        w0.x = pk_bf16(o0[4 * g], o0[4 * g + 1]); w0.y = pk_bf16(o0[4 * g + 2], o0[4 * g + 3]);
        w1.x = pk_bf16(o1[4 * g], o1[4 * g + 1]); w1.y = pk_bf16(o1[4 * g + 2], o1[4 * g + 3]);
        *(uint2*)(orow + 8 * g) = w0;
        *(uint2*)(orow + 32 + 8 * g) = w1;
    }
}


constexpr int DN_RW = 0, DN_RQ = 128, DN_RAT = 256, DN_RKD = 320;
constexpr float LOG2E = 1.4426950408889634f;
__device__ __forceinline__ uint4 pack8(const float* v) { uint4 o; o.x = pk_bf16(v[0], v[1]); o.y = pk_bf16(v[2], v[3]); o.z = pk_bf16(v[4], v[5]); o.w = pk_bf16(v[6], v[7]); return o; }

__device__ __forceinline__ void dn_chunk_item(const Params& p, int item, unsigned char* lds) {
    const int tid = opaque_tid(), lane = tid & 63, wid = tid >> 6;
    const int bh = item >> 5, n = item & 31, b = bh >> 2, hh = bh & 3;
    const int t0 = b * SEQ + n * 64;
    unsigned char* Kimg = lds; unsigned char* KBimg = lds + 16384; unsigned char* Qimg = lds + 32768;
    float* Vf = (float*)(lds + 49152); float* KBGf = (float*)(lds + 81920); float* MT = (float*)(lds + 114688);
    float* G2s = (float*)(lds + 114688 + 17408); float* betas = G2s + 64;
    bf16_t* blob = p.dnblob + (size_t)item * DN_BLOB;
    if (wid == 0) {
        const int t = t0 + lane;
        const float da = p.small[(size_t)t * 8 + 4 + hh] + p.dt_bias[hh];
        const float sp = da > 20.f ? da : log1pf(expf(da));
        float g2 = -expf(p.a_log[hh]) * sp * LOG2E;
#pragma unroll
        for (int off = 1; off < 64; off <<= 1) { const float v = shfl_lane(g2, lane - off); if (lane >= off) g2 += v; }
        G2s[lane] = g2; betas[lane] = sigmoidf_(p.small[(size_t)t * 8 + hh]);
        if (lane == 63) p.dnlast[item] = exp2f(g2);
    }
    __syncthreads();
    {
        const int c8 = tid & 15, tq = tid >> 4, j0 = tq * 2;
        const float G0 = G2s[j0], G1 = G2s[j0 + 1], GL = G2s[63];
        const float be[2] = {betas[j0], betas[j0 + 1]};
        const float eg[2] = {exp2f(G0), exp2f(G1)}, el[2] = {exp2f(GL - G0), exp2f(GL - G1)};
        const int half = c8 >> 3, ch = c8 & 7;
#pragma unroll
        for (int type = 0; type < 3; ++type) {
            float o[2][8];
            {
                const bf16_t* src = p.qkvraw + (size_t)(t0 + j0 - 3) * 1536 + type * 512 + hh * 128 + c8 * 8;
                float x[5][8];
#pragma unroll
                for (int r = 0; r < 5; ++r) {
                    uint4 raw = make_uint4(0, 0, 0, 0);
                    if (n > 0 || j0 - 3 + r >= 0) raw = *(const uint4*)(src + (size_t)r * 1536);
                    const unsigned u[4] = {raw.x, raw.y, raw.z, raw.w};
#pragma unroll
                    for (int i = 0; i < 4; ++i) { x[r][2 * i] = __uint_as_float(u[i] << 16); x[r][2 * i + 1] = __uint_as_float(u[i] & 0xffff0000u); }
                }
                const float* wp = p.conv_w + type * 512 + hh * 128 + c8 * 8;
#pragma unroll
                for (int i = 0; i < 8; ++i) {
                    float a0 = 0.f, a1 = 0.f;
#pragma unroll
                    for (int tap = 0; tap < 4; ++tap) { const float w = wp[tap * 1536 + i]; a0 = fmaf(x[tap][i], w, a0); a1 = fmaf(x[tap + 1][i], w, a1); }
                    o[0][i] = siluf_(a0); o[1][i] = siluf_(a1);
                }
            }
            if (type < 2) {
#pragma unroll
                for (int tk = 0; tk < 2; ++tk) {
                    float ss = 0.f;
#pragma unroll
                    for (int i = 0; i < 8; ++i) ss = fmaf(o[tk][i], o[tk][i], ss);
                    ss += shfl_lane(ss, lane ^ 1); ss += shfl_lane(ss, lane ^ 2); ss += shfl_lane(ss, lane ^ 4); ss += shfl_lane(ss, lane ^ 8);
                    float r = rsqrtf(ss + NORM_EPS);
                    if (type == 0) r *= 0.08838834764831845f;
#pragma unroll
                    for (int i = 0; i < 8; ++i) o[tk][i] *= r;
                }
            }
#pragma unroll
            for (int tk = 0; tk < 2; ++tk) {
                const int j = j0 + tk;
                const int ioff = half * 8192 + j * 128 + ((ch ^ swz(j)) << 4);
                if (type == 0) {
                    *(uint4*)(Qimg + ioff) = pack8(o[tk]);
                    float qd[8];
#pragma unroll
                    for (int i = 0; i < 8; ++i) qd[i] = o[tk][i] * eg[tk];
                    bf16_t* qrow = blob + (size_t)(DN_RQ + half * 64 + j) * 64 + ((c8 >> 1) & 3) * 16 + 4 * (c8 & 1);
                    uint2 w0, w1; w0.x = pk_bf16(qd[0], qd[1]); w0.y = pk_bf16(qd[2], qd[3]); w1.x = pk_bf16(qd[4], qd[5]); w1.y = pk_bf16(qd[6], qd[7]);
                    *(uint2*)qrow = w0; *(uint2*)(qrow + 8) = w1;
                } else if (type == 1) {
                    float kb[8], kbg[8];
#pragma unroll
                    for (int i = 0; i < 8; ++i) { kb[i] = o[tk][i] * be[tk]; kbg[i] = kb[i] * eg[tk]; }
                    *(uint4*)(Kimg + ioff) = pack8(o[tk]);
                    *(uint4*)(KBimg + ioff) = pack8(kb);
                    f32x4* kd = (f32x4*)(KBGf + j * 128 + c8 * 8); kd[0] = (f32x4){kbg[0], kbg[1], kbg[2], kbg[3]}; kd[1] = (f32x4){kbg[4], kbg[5], kbg[6], kbg[7]};
                } else {
                    float vb[8];
#pragma unroll
                    for (int i = 0; i < 8; ++i) vb[i] = o[tk][i] * be[tk];
                    f32x4* vd = (f32x4*)(Vf + j * 128 + c8 * 8); vd[0] = (f32x4){vb[0], vb[1], vb[2], vb[3]}; vd[1] = (f32x4){vb[4], vb[5], vb[6], vb[7]};
                }
            }
            if (type == 1) {
                const int jp = (j0 & 48) | pi16(j0 & 15);
#pragma unroll
                for (int i = 0; i < 8; ++i)
                    *(unsigned*)(blob + (size_t)(DN_RKD + c8 * 8 + i) * 64 + jp) = pk_bf16(o[0][i] * el[0], o[1][i] * el[1]);
            }
        }
    }
    __syncthreads();
    {
        const int which = wid >> 2, ti = (wid >> 1) & 1, tj = wid & 1, l31 = lane & 31, lh = lane >> 5;
        if (!(ti == 0 && tj == 1)) {
            const unsigned char* Ab = (which == 0 ? KBimg : Qimg) + (ti * 32 + l31) * 128;
            const unsigned char* Bb = Kimg + (tj * 32 + l31) * 128;
            const int fsw = swz(l31);
            f32x16 acc;
#pragma unroll
            for (int r = 0; r < 16; ++r) acc[r] = 0.f;
#pragma unroll
            for (int ks = 0; ks < 8; ++ks) {
                const int off = (ks >> 2) * 8192 + ((((ks & 3) * 2 + lh) ^ fsw) << 4);
                acc = __builtin_amdgcn_mfma_f32_32x32x16_bf16(*(const bf16x8*)(Ab + off), *(const bf16x8*)(Bb + off), acc, 0, 0, 0);
            }
            const int j = tj * 32 + l31;
            const float Gj = G2s[j];
#pragma unroll
            for (int r = 0; r < 16; ++r) {
                const int i = ti * 32 + (r & 3) + 8 * (r >> 2) + 4 * lh;
                const float v = acc[r] * exp2f(G2s[i] - Gj);
                if (which == 0) MT[j * 68 + i] = (i > j) ? v : 0.f;
                else blob[(size_t)(DN_RAT + i) * 64 + ((j & 48) | pi16(j & 15))] = to_bf16((i >= j) ? v : 0.f);
            }
        }
    }
    __syncthreads();
#ifndef NO_SOLVE
    if (tid < 256) {
        const int c = tid & 127;
        const float* rhs = (tid < 128 ? Vf : KBGf) + c;
        float y[64];
#pragma unroll
        for (int j = 0; j < 64; ++j) y[j] = rhs[j * 128];
#pragma unroll
        for (int j = 0; j < 63; ++j) {
            const float yj = y[j];
#pragma unroll
            for (int i4 = (j + 1) & ~3; i4 < 64; i4 += 4) {
                const f32x4 m = *(const f32x4*)(MT + j * 68 + i4);
#pragma unroll
                for (int u = 0; u < 4; ++u) if (i4 + u > j) y[i4 + u] = fmaf(-m[u], yj, y[i4 + u]);
            }
            asm volatile("" ::: "memory");
        }
        if (tid < 128) {
#pragma unroll
            for (int mi = 0; mi < 2; ++mi)
#pragma unroll
                for (int h = 0; h < 2; ++h) {
                    f32x4* dst = (f32x4*)(p.dnu + ((((size_t)item * 2 + mi) * 4 + (c >> 5)) * 64 + h * 32 + (c & 31)) * 16);
#pragma unroll
                    for (int g = 0; g < 4; ++g)
                        dst[g] = (f32x4){y[mi * 32 + 8 * g + 4 * h], y[mi * 32 + 8 * g + 4 * h + 1], y[mi * 32 + 8 * g + 4 * h + 2], y[mi * 32 + 8 * g + 4 * h + 3]};
                }
        } else {
            bf16_t* dst = blob + (size_t)(DN_RW + (c >> 6) * 64) * 64 + ((c & 48) | pi16(c & 15));
#pragma unroll
            for (int i = 0; i < 64; ++i) dst[(size_t)i * 64] = to_bf16(-y[i]);
        }
    }
#endif
    __syncthreads();
}

__device__ __forceinline__ void phase_dn_chunks(const Params& p, unsigned char* lds) {
    for (int item = blockIdx.x; item < NB * DNH * 32; item += gridDim.x) dn_chunk_item(p, item, lds);
}

__device__ __forceinline__ void dn_scan(const Params& p, int bh, unsigned char* lds) {
    const int tid = opaque_tid(), lane = tid & 63, wid = tid >> 6, l31 = lane & 31, lh = lane >> 5;
    const int b = bh >> 2, hh = bh & 3;
    const int fsw = swz(l31);
    auto copy_blob = [&](int n, unsigned char* dst) {
        const uint4* src = (const uint4*)(p.dnblob + (size_t)(bh * 32 + n) * DN_BLOB);
        const int lt = tid - 256;
#pragma unroll
        for (int k = 0; k < 14; ++k) {
            const int c = lt + k * 256, row = c >> 3, ch = c & 7;
            *(uint4*)(dst + row * 128 + ((ch ^ swz(row)) << 4)) = src[c];
        }
    };
    if (wid >= 4) copy_blob(0, lds);
    __syncthreads();
    f32x16 S[4];
#pragma unroll
    for (int t = 0; t < 4; ++t)
#pragma unroll
        for (int r = 0; r < 16; ++r) S[t][r] = 0.f;
    f32x16 vn[2]; float lastn = 0.f;
    if (wid < 4) {
#pragma unroll
        for (int mi = 0; mi < 2; ++mi) vn[mi] = *(const f32x16*)(p.dnu + ((((size_t)(bh * 32) * 2 + mi) * 4 + wid) * 64 + lane) * 16);
        lastn = p.dnlast[bh * 32];
    }
    for (int n = 0; n < 32; ++n) {
        if (wid >= 4) {
            if (n + 1 < 32) copy_blob(n + 1, lds + ((n + 1) & 1) * (DN_ROWS * 128));
        } else {
            const unsigned char* buf = lds + (n & 1) * (DN_ROWS * 128);
            const int item = bh * 32 + n;
            f32x16 oa[2];
#pragma unroll
            for (int mi = 0; mi < 2; ++mi)
#pragma unroll
                for (int r = 0; r < 16; ++r) oa[mi][r] = 0.f;
            const float last = lastn;
            typedef unsigned u32x4 __attribute__((ext_vector_type(4)));
            bf16x8 sb[4][2];
#pragma unroll
            for (int t = 0; t < 4; ++t)
#pragma unroll
                for (int ss = 0; ss < 2; ++ss) {
                    u32x4 w;
#pragma unroll
                    for (int q = 0; q < 4; ++q) w[q] = pk_bf16(S[t][8 * ss + 2 * q], S[t][8 * ss + 2 * q + 1]);
                    sb[t][ss] = __builtin_bit_cast(bf16x8, w);
                }
#pragma unroll
            for (int mi = 0; mi < 2; ++mi)
#pragma unroll
                for (int ks = 0; ks < 8; ++ks) {
                    const int off = ((ks >> 2) * 64 + mi * 32 + l31) * 128 + ((((ks & 3) * 2 + lh) ^ fsw) << 4);
                    vn[mi] = __builtin_amdgcn_mfma_f32_32x32x16_bf16(*(const bf16x8*)(buf + DN_RW * 128 + off), sb[ks >> 1][ks & 1], vn[mi], 0, 0, 0);
                    oa[mi] = __builtin_amdgcn_mfma_f32_32x32x16_bf16(*(const bf16x8*)(buf + DN_RQ * 128 + off), sb[ks >> 1][ks & 1], oa[mi], 0, 0, 0);
                }
            bf16x8 vb[2][2];
#pragma unroll
            for (int mj = 0; mj < 2; ++mj)
#pragma unroll
                for (int ss = 0; ss < 2; ++ss) {
                    u32x4 w;
#pragma unroll
                    for (int q = 0; q < 4; ++q) w[q] = pk_bf16(vn[mj][8 * ss + 2 * q], vn[mj][8 * ss + 2 * q + 1]);
                    vb[mj][ss] = __builtin_bit_cast(bf16x8, w);
                }
            {
                const int nx = (n + 1 < 32) ? item + 1 : item;
#pragma unroll
                for (int mi = 0; mi < 2; ++mi) vn[mi] = *(const f32x16*)(p.dnu + ((((size_t)nx * 2 + mi) * 4 + wid) * 64 + lane) * 16);
                lastn = p.dnlast[nx];
            }
#pragma unroll
            for (int mi = 0; mi < 2; ++mi)
#pragma unroll
                for (int kj = 0; kj < 4; ++kj)
                    if ((kj >> 1) <= mi) {
                        const int off = (DN_RAT + mi * 32 + l31) * 128 + (((kj * 2 + lh) ^ fsw) << 4);
                        oa[mi] = __builtin_amdgcn_mfma_f32_32x32x16_bf16(*(const bf16x8*)(buf + off), vb[kj >> 1][kj & 1], oa[mi], 0, 0, 0);
                    }
#pragma unroll
            for (int t = 0; t < 4; ++t) {
#pragma unroll
                for (int r = 0; r < 16; ++r) S[t][r] *= last;
#pragma unroll
                for (int kj = 0; kj < 4; ++kj) {
                    const int off = (DN_RKD + t * 32 + l31) * 128 + (((kj * 2 + lh) ^ fsw) << 4);
                    S[t] = __builtin_amdgcn_mfma_f32_32x32x16_bf16(*(const bf16x8*)(buf + off), vb[kj >> 1][kj & 1], S[t], 0, 0, 0);
                }
            }
            float* orow = p.oraw + (size_t)(b * SEQ + n * 64) * DNW + hh * 128 + wid * 32 + l31;
#pragma unroll
            for (int mi = 0; mi < 2; ++mi)
#pragma unroll
                for (int r = 0; r < 16; ++r) orow[(size_t)(mi * 32 + (r & 3) + 8 * (r >> 2) + 4 * lh) * DNW] = oa[mi][r];
        }
        __syncthreads();
    }
}

__device__ __forceinline__ void phase_mixers(const Params& p, float* smem) {
    const int nscan = NB * DNH;
    if (gridDim.x >= 2 * nscan) {
#ifndef SKIP_SCAN
        if ((int)blockIdx.x < nscan) dn_scan(p, blockIdx.x, (unsigned char*)smem);
#endif
        if ((int)blockIdx.x < nscan) {}
        else {
            for (int it = blockIdx.x - nscan; it < 512; it += gridDim.x - nscan) sb_attn_wave(p, it >> 3, (it & 7) * 8 + (opaque_tid() >> 6));
        }
    } else {
#ifndef SKIP_SCAN
        for (int bh = blockIdx.x; bh < nscan; bh += gridDim.x) dn_scan(p, bh, (unsigned char*)smem);
#endif
        for (int it = blockIdx.x; it < 512; it += gridDim.x) sb_attn_wave(p, it >> 3, (it & 7) * 8 + (opaque_tid() >> 6));
    }
}

__device__ __forceinline__ void phase_gated_norm(const Params& p) {
    const int lane = opaque_tid() & 63, wave = (blockIdx.x * NT + opaque_tid()) >> 6, nw = (gridDim.x * NT) >> 6;
    for (int item = wave; item < T * 4; item += nw) {
        const int t = item >> 2, hh = item & 3;
        const size_t off = (size_t)t * DNW + hh * 128 + lane * 2;
        const float v0 = p.oraw[off], v1 = p.oraw[off + 1];
        const float ss = wave_sum(v0 * v0 + v1 * v1, lane);
        const float r = rsqrtf(ss * (1.f / 128.f) + NORM_EPS);
        const float z0 = bf2f(p.dzb[(size_t)t * 512 + hh * 128 + lane * 2]), z1 = bf2f(p.dzb[(size_t)t * 512 + hh * 128 + lane * 2 + 1]);
        p.oab[off] = to_bf16(v0 * r * p.norm_g[lane * 2] * siluf_(z0));
        p.oab[off + 1] = to_bf16(v1 * r * p.norm_g[lane * 2 + 1] * siluf_(z1));
    }
}

template <class SF>
__device__ __forceinline__ void layer_norm_rows(SF sf, const float* g, const float* bb, float* dst, bf16_t* dstb) {
    const int lane = opaque_tid() & 63, wave = (blockIdx.x * NT + opaque_tid()) >> 6, nw = (gridDim.x * NT) >> 6;
    for (int t = wave; t < T; t += nw) {
        float v[16];
        float s = 0.f;
#pragma unroll
        for (int i = 0; i < 16; ++i) { v[i] = sf(t, lane + i * 64); s += v[i]; }
        const float mu = wave_sum(s, lane) * (1.f / 1024.f);
        float q = 0.f;
#pragma unroll
        for (int i = 0; i < 16; ++i) { const float d = v[i] - mu; q += d * d; }
        const float rstd = rsqrtf(wave_sum(q, lane) * (1.f / 1024.f) + LN_EPS);
#pragma unroll
        for (int i = 0; i < 16; ++i) { const int c = lane + i * 64; const float y = (v[i] - mu) * rstd * g[c] + bb[c]; if (dst) dst[(size_t)t * D + c] = y; if (dstb) dstb[(size_t)t * D + c] = to_bf16(y); }
    }
}

__device__ __forceinline__ void phase_route(const Params& p, int* counts, int* explist, int* ldsw) {
    const int tid = opaque_tid(), lane = tid & 63;
    const int wave = (blockIdx.x * NT + tid) >> 6, nw = (gridDim.x * NT) >> 6;
    int* mye = ldsw + (tid >> 6) * 64;
    const f32x4 bias = *(const f32x4*)(p.router_bias + lane * 4);
    for (int t0 = wave; t0 < T; t0 += nw * 8) {
        f32x4 scs[8];
#pragma unroll
        for (int k = 0; k < 8; ++k) { const int t = t0 + k * nw; scs[k] = t < T ? *(const f32x4*)(p.scores + (size_t)t * NE + lane * 4) : (f32x4){0.f, 0.f, 0.f, 0.f}; }
#pragma unroll 1
        for (int k = 0; k < 8; ++k) {
            const int t = t0 + k * nw;
            if (t >= T) break;
            f32x4 sc = scs[0];
#pragma unroll
            for (int kk = 1; kk < 8; ++kk) sc = (k == kk) ? scs[kk] : sc;
            const float sel[4] = {sc[0] + bias[0], sc[1] + bias[1], sc[2] + bias[2], sc[3] + bias[3]};
            float m1 = fmaxf(sel[0], sel[1]), m2 = fminf(sel[0], sel[1]);
            m2 = fmaxf(m2, fminf(m1, sel[2])); m1 = fmaxf(m1, sel[2]);
            m2 = fmaxf(m2, fminf(m1, sel[3])); m1 = fmaxf(m1, sel[3]);
#pragma unroll
            for (int off = 1; off < 8; off <<= 1) {
                const float o1 = shfl_lane(m1, lane ^ off), o2 = shfl_lane(m2, lane ^ off);
                const float n2 = fmaxf(fminf(m1, o1), fmaxf(m2, o2));
                m1 = fmaxf(m1, o1); m2 = n2;
            }
            const float gs = m1 + m2;
            const int g = lane >> 3;
            int rank = 0;
#pragma unroll
            for (int gg = 0; gg < NG; ++gg) { const float og = __int_as_float(__builtin_amdgcn_readlane(__float_as_int(gs), gg * 8)); rank += (og > gs || (og == gs && gg < g)) ? 1 : 0; }
            const bool gsel = rank < TOPG;
            unsigned ku[4];
#pragma unroll
            for (int i = 0; i < 4; ++i) {
                const unsigned u = __float_as_uint(sel[i]);
                ku[i] = gsel ? ((u & 0x80000000u) ? ~u : (u | 0x80000000u)) : 0u;
            }
            unsigned v8 = 0u;
#pragma unroll 1
            for (int bit = 31; bit >= 0; --bit) {
                const unsigned cand = v8 | (1u << bit);
                const int c = __popcll(__ballot(ku[0] >= cand)) + __popcll(__ballot(ku[1] >= cand)) + __popcll(__ballot(ku[2] >= cand)) + __popcll(__ballot(ku[3] >= cand));
                if (c >= TOPK) v8 = cand;
            }
            int ngt = 0, eqlow = 0, sellow = 0;
            unsigned long long eqm[4];
#pragma unroll
            for (int i = 0; i < 4; ++i) { ngt += __popcll(__ballot(ku[i] > v8)); eqm[i] = __ballot(ku[i] == v8); }
            const int need = TOPK - ngt;
#pragma unroll
            for (int i = 0; i < 4; ++i) eqlow += __builtin_amdgcn_mbcnt_hi((unsigned)(eqm[i] >> 32), __builtin_amdgcn_mbcnt_lo((unsigned)eqm[i], 0u));
            bool selc[4]; int eqrank = eqlow;
#pragma unroll
            for (int i = 0; i < 4; ++i) {
                const bool eq = ku[i] == v8;
                selc[i] = (ku[i] > v8) || (eq && eqrank < need);
                eqrank += eq ? 1 : 0;
            }
            float part = 0.f;
#pragma unroll
            for (int i = 0; i < 4; ++i) {
                const unsigned long long sm = __ballot(selc[i]);
                part += selc[i] ? sc[i] : 0.f;
                sellow += __builtin_amdgcn_mbcnt_hi((unsigned)(sm >> 32), __builtin_amdgcn_mbcnt_lo((unsigned)sm, 0u));
            }
            const float wsum = wave_sum(part, lane);
            int slot = sellow;
#pragma unroll
            for (int i = 0; i < 4; ++i)
                if (selc[i]) {
                    const int e = lane * 4 + i, pr = t * TOPK + slot;
                    p.gate[pr] = sc[i] / wsum * 2.5f;
                    mye[k * 8 + slot] = e;
                    ++slot;
                }
        }
        {
            const int k = lane >> 3, t = t0 + k * nw;
            if (t < T) {
                const int e = mye[lane], pos = atomicAdd(&counts[e * CSTRIDE], 1);
                explist[(size_t)e * ECAP + pos] = t * TOPK + (lane & 7);
            }
        }
    }
}

__device__ __forceinline__ void compute_pend(const Params& p, int* pend, int* cnt) {
    const int tid = opaque_tid();
    if (tid < 64) {
        int c[4], pc[4];
#pragma unroll
        for (int i = 0; i < 4; ++i) { c[i] = p.counts[(tid * 4 + i) * CSTRIDE]; cnt[tid * 4 + i] = c[i]; pc[i] = (c[i] + 127) / 128 * 128; }
        const int ssum = pc[0] + pc[1] + pc[2] + pc[3];
        int inc = ssum;
#pragma unroll
        for (int off = 1; off < 64; off <<= 1) { const int v = shfl_lane_i(inc, tid - off); if (tid >= off) inc += v; }
        int run = inc - ssum;
#pragma unroll
        for (int i = 0; i < 4; ++i) { run += pc[i]; pend[tid * 4 + i] = run; }
    }
    __syncthreads();
}

__device__ __forceinline__ int expert_of_row(const int* pend, int row) {
    int lo = 0, hi = NE - 1;
    while (lo < hi) { const int mid = (lo + hi) >> 1; if (pend[mid] > row) hi = mid; else lo = mid + 1; }
    return lo;
}

__device__ __forceinline__ void phase_routed(const Params& p, int* pend, int* cnt, unsigned char* lds) {
    typedef GemmCfg<128, 256, 2, 4> CFG;
    compute_pend(p, pend, cnt);
    int* prs = (int*)(lds + 131072); float* gts = (float*)(lds + 131072 + 512);
    const bool grouped = (gridDim.x % 8) == 0;
    const int xg = grouped ? (blockIdx.x & 7) : 0, estep = grouped ? 8 : 1;
    const int nslots = grouped ? (gridDim.x >> 3) : gridDim.x;
    int widx = grouped ? (blockIdx.x >> 3) : blockIdx.x, tbase = 0;
    for (int e = xg; e < NE; e += estep) {
      const int ce = cnt[e], ntile = (ce + 127) >> 7;
      for (; widx < tbase + ntile; widx += nslots) {
        const int q0 = (widx - tbase) * 128;
        {
            const int tid = opaque_tid();
            if (tid < 128) {
                const int pr = (q0 + tid < ce) ? p.explist[(size_t)e * ECAP + q0 + tid] : -1;
                prs[tid] = pr; gts[tid] = pr >= 0 ? p.gate[pr] : 0.f;
            }
        }
        __syncthreads();
#pragma unroll 1
        for (int tn_ = 0; tn_ < 2 * RU; ++tn_) {
            const int tn = tn_ & 1;
            LoadRowsBf16<128> al[2]; LoadKNF32 bl[2];
#pragma unroll
            for (int u = 0; u < 2; ++u) {
                al[u].init(p.hb, D, [&](int r) { const int pr = prs[r]; return (long long)(pr >= 0 ? (pr >> 3) : 0); });
                bl[u].init(p.w_eu + (size_t)e * D * (2 * EFF), 2 * EFF, [&](int r) { return ((r >> 5) & 1) * EFF + tn * 128 + (r >> 6) * 32 + (r & 31); });
            }
            f32x16 acc[CFG::MI][CFG::NI];
            acc_zero<CFG>(acc);
            gemm_mainloop2<CFG, false, 0, false>(al, bl, D / 64, acc, lds, nullptr);
            const int tid = opaque_tid(), lane = tid & 63, wid = tid >> 6, wm = wid / CFG::WN, wn = wid % CFG::WN;
            const int j = tn * 128 + wn * 32 + (lane & 31);
            unsigned char* img = lds + 65536 + (((j >> 6) + 2) & 3) * 16384 + (j & 7) * 2;
            const int jc = (j & 63) >> 3;
#pragma unroll
            for (int mi = 0; mi < CFG::MI; ++mi)
#pragma unroll
                for (int r = 0; r < 16; ++r) {
                    const int row = wm * CFG::TM + mi * 32 + (r & 3) + 8 * (r >> 2) + 4 * (lane >> 5);
                    *(bf16_t*)(img + row * 128 + ((jc ^ swz(row)) << 4)) = to_bf16(siluf_(acc[mi][0][r]) * acc[mi][1][r]);
                }
        }
        __syncthreads();
#pragma unroll 1
        for (int tn_ = 0; tn_ < 4 * RD; ++tn_) {
            const int tn = tn_ & 3;
            LoadRowsBf16<128> aldummy[2]; LoadKNF32 bl[2];
#pragma unroll
            for (int u = 0; u < 2; ++u) bl[u].init(p.w_ed + (size_t)e * EFF * D, D, [&](int r) { return tn * 256 + r; });
            f32x16 acc[CFG::MI][CFG::NI];
            acc_zero<CFG>(acc);
            gemm_mainloop2<CFG, true, 2, true>(aldummy, bl, EFF / 64, acc, lds, lds + 65536);
            {
                const int tid = opaque_tid(), lane = tid & 63, wid = tid >> 6, wm = wid / CFG::WN, wn = wid % CFG::WN;
#pragma unroll
                for (int mi = 0; mi < CFG::MI; ++mi) {
                    const int row = wm * CFG::TM + mi * 32 + (lane & 31);
                    const int pr = prs[row]; const float g = gts[row];
                    if (pr >= 0) {
#pragma unroll
                        for (int ni = 0; ni < CFG::NI; ++ni) {
                            bf16_t* dst = p.ypairb + (size_t)pr * D + tn * 256 + wn * CFG::TN + ni * 32 + 4 * (lane >> 5);
#pragma unroll
                            for (int gq = 0; gq < 4; ++gq) {
                                uint2 w; w.x = pk_bf16(acc[mi][ni][4 * gq] * g, acc[mi][ni][4 * gq + 1] * g); w.y = pk_bf16(acc[mi][ni][4 * gq + 2] * g, acc[mi][ni][4 * gq + 3] * g);
                                *(uint2*)(dst + 8 * gq) = w;
                            }
                        }
                    }
                }
            }
        }
        __syncthreads();
      }
      tbase += ntile;
    }
}

#ifndef R0
#define R0 1
#define R1 1
#define R2 1
#define R3 1
#define R4 1
#define R5 1
#define R6 1
#define R7 1
#define R8 1
#define R10 1
#define R11 1
#define R12 1
#endif

constexpr int LDS_MAIN = 133120;
__global__ void __launch_bounds__(NT) fwd_megakernel(KArgs ka) {
    __shared__ __attribute__((aligned(16))) unsigned char lds[LDS_MAIN + 2 * NE * 4 + 16];
    float* smem = (float*)lds;
    int* pend = (int*)(lds + LDS_MAIN);
    int* cnt = pend + NE;
    volatile LAS3 unsigned* xbst = (volatile LAS3 unsigned*)(lds + LDS_MAIN + 2 * NE * 4);
    if (threadIdx.x == 0) { xbst[0] = 0u; xbst[1] = 0u; }
    __syncthreads();
    const XcdBarrier xb = xcd_barrier_post((unsigned*)(ka.ws + OFF_BAR), xbst);

#define REPEAT(N, ...) { int reps_ = (N); asm volatile("" : "+s"(reps_)); for (int rep_ = 0; rep_ < reps_; ++rep_) { { const Params p(ka); __VA_ARGS__; } xcd_barrier(xb); } }
    { const Params p(ka); phase_init(p); }
    REPEAT(R0,
        convert_bf16(p.x, p.xb, (size_t)T * D);
        transpose_convert(p.w_in, D, PW, PWP, p.w_in_t, smem, [](int n) { return n < 2048 ? n : n < 5632 ? n + 8 : n < 5640 ? n - 5632 + 2048 : -1; });
        transpose_convert(p.w_pa, DNW, D, D, p.w_pa_t, smem, [](int n) { return n; });
        transpose_convert(p.w_pb, SBW, D, D, p.w_pb_t, smem, [](int n) { return n; });
        transpose_convert(p.w_out, D, D, D, p.w_out_t, smem, [](int n) { return n; });
        transpose_convert(p.w_router, D, NE, NE, p.w_router_t, smem, [](int n) { return n; });
        transpose_convert(p.w_su, D, 2 * SFF, 2 * SFF, p.w_su_t, smem, [](int n) { return n; });
        transpose_convert(p.w_sd, SFF, D, D, p.w_sd_t, smem, [](int n) { return n; }))
    REPEAT(R1, phase_inproj(p, lds))
    REPEAT(R2, phase_dn_chunks(p, lds))
    REPEAT(R3, phase_mixers(p, smem))
    REPEAT(R4, phase_gated_norm(p))
    REPEAT(R5, phase_merge(p, lds))
    REPEAT(R6, phase_outproj(p, lds))
    REPEAT(R7, layer_norm_rows([&](int t, int c) { return p.pre1[(size_t)t * D + c]; }, p.ln1_g, p.ln1_b, nullptr, p.hb))
    REPEAT(R8, phase_router_shared_up(p, lds))
    { const Params p(ka); phase_route(p, p.counts, p.explist, (int*)lds); }
    xcd_barrier(xb);
    { int reps9 = R9 - 1; asm volatile("" : "+s"(reps9)); for (int r9 = 0; r9 < reps9; ++r9) { const Params p(ka); phase_route(p, p.counts + NE * CSTRIDE, (int*)p.ypairb, (int*)lds); xcd_barrier(xb); } }
    { int repsb = RB; asm volatile("" : "+s"(repsb)); for (int rb = 0; rb < repsb; ++rb) xcd_barrier(xb); }
    REPEAT(R10, phase_routed(p, pend, cnt, lds); phase_shared_down(p, lds))
    int reps12 = R12; asm volatile("" : "+s"(reps12));
    for (int rep = 0; rep < reps12; ++rep) {
        const Params p(ka);
        layer_norm_rows([&](int t, int c) {
                float f = bf2f(p.yshb[(size_t)t * D + c]);
#pragma unroll
                for (int k = 0; k < TOPK; ++k) f += bf2f(p.ypairb[((size_t)t * TOPK + k) * D + c]);
                return ALPHA * bf2f(p.hb[(size_t)t * D + c]) + f; },
            p.ln2_g, p.ln2_b, p.out, nullptr);
    }
}

extern "C" void kernel_launch(void* const* d_in, const int* in_sizes, int n_in, void* d_out, int out_size, void* d_ws,
                              size_t ws_size, hipStream_t stream) {
    static int grid_blocks = 0;
    if (!grid_blocks) {
        int dev = 0, cus = 0, per_cu = 0;
        hipGetDevice(&dev);
        hipDeviceGetAttribute(&cus, hipDeviceAttributeMultiprocessorCount, dev);
        hipOccupancyMaxActiveBlocksPerMultiprocessor(&per_cu, fwd_megakernel, NT, 0);
        if (per_cu > 1) per_cu = 1;
        grid_blocks = cus * per_cu;
    }
    KArgs p{};
    const float* const* in = (const float* const*)d_in;
    p.x = in[0]; p.w_in = in[1]; p.conv_w = in[2]; p.a_log = in[3]; p.dt_bias = in[4]; p.norm_g = in[5]; p.w_pa = in[6];
    p.w_pb = in[7]; p.w_out = in[8]; p.ln1_g = in[9]; p.ln1_b = in[10]; p.w_router = in[11]; p.router_bias = in[12];
    p.w_su = in[13]; p.w_sd = in[14]; p.w_eu = in[15]; p.w_ed = in[16]; p.ln2_g = in[17]; p.ln2_b = in[18];
    p.out = (float*)d_out; p.ws = (unsigned char*)d_ws;
    if (WS_BYTES > ws_size) { fprintf(stderr, "workspace too small: need %zu have %zu\n", (size_t)WS_BYTES, ws_size); return; }
    hipMemsetAsync(p.ws + OFF_BAR, 0, XCD_BAR_WORDS * 4, stream);
    void* args[] = {&p};
    hipError_t e = hipLaunchCooperativeKernel((void*)fwd_megakernel, dim3(grid_blocks), dim3(NT), args, 0, stream);
    if (e != hipSuccess) fprintf(stderr, "cooperative launch failed: %s (grid %d)\n", hipGetErrorString(e), grid_blocks);
}
```

```cpp
#include <hip/hip_runtime.h>
#include <hip/hip_cooperative_groups.h>
#include <cstdio>
#include <cstdint>
namespace cg = cooperative_groups;

constexpr int D = 1024, NB = 8, SEQ = 2048, T = NB * SEQ;
constexpr int DNH = 4, DND = 128, DNW = 512;
constexpr int SBH = 8, SBD = 64, SBW = 512;
constexpr int NE = 256, TOPK = 8, NG = 8, TOPG = 4, EFF = 256, SFF = 256;
constexpr int PW = 5640;
constexpr int NPAIR = T * TOPK;
constexpr int NBLK = (NPAIR + NE * 127 + 127) / 128;
constexpr int PROWS = NBLK * 128;
constexpr float ALPHA = 1.189207115002721f;
constexpr float LN_EPS = 1e-5f, NORM_EPS = 1e-6f;
constexpr int NT = 512;
#ifndef RU
#define RU 1
#define RD 1
#define R9 1
#define RB 0
#endif

typedef unsigned short bf16_t;
constexpr int PWP = 5888;
constexpr int DN_ROWS = 448, DN_BLOB = DN_ROWS * 64;
constexpr int ECAP = T;
#define XCD_BAR_WORDS 3456
constexpr int CSTRIDE = 64;
constexpr size_t al256(size_t x) { return (x + 255) & ~(size_t)255; }
constexpr size_t OFF_XB = 0;
constexpr size_t OFF_WINT = OFF_XB + al256((size_t)T * D * 2);
constexpr size_t OFF_QKVRAW = OFF_WINT + al256((size_t)PWP * D * 2);
constexpr size_t OFF_DZB = OFF_QKVRAW + al256((size_t)T * 1536 * 2);
constexpr size_t OFF_SQ = OFF_DZB + al256((size_t)T * 512 * 2);
constexpr size_t OFF_SK = OFF_SQ + al256((size_t)T * 512 * 2);
constexpr size_t OFF_VT = OFF_SK + al256((size_t)T * 512 * 2);
constexpr size_t OFF_DNBLOB = OFF_VT + al256((size_t)T * 512 * 2);
constexpr size_t OFF_DNU = OFF_DNBLOB + al256((size_t)1024 * DN_BLOB * 2);
constexpr size_t OFF_DNLAST = OFF_DNU + al256((size_t)1024 * 64 * 128 * 4);
constexpr size_t OFF_GAB = OFF_DNLAST + al256(1024 * 4);
constexpr size_t OFF_GBB = OFF_GAB + al256((size_t)T * D * 2);
constexpr size_t OFF_SMALL = OFF_GBB + al256((size_t)T * D * 2);
constexpr size_t OFF_WPAT = OFF_SMALL + al256((size_t)T * 8 * 4);
constexpr size_t OFF_WPBT = OFF_WPAT + al256((size_t)D * DNW * 2);
constexpr size_t OFF_WOUTT = OFF_WPBT + al256((size_t)D * SBW * 2);
constexpr size_t OFF_WROUTT = OFF_WOUTT + al256((size_t)D * D * 2);
constexpr size_t OFF_WSUT = OFF_WROUTT + al256((size_t)NE * D * 2);
constexpr size_t OFF_WSDT = OFF_WSUT + al256((size_t)2 * SFF * D * 2);
constexpr size_t OFF_OAB = OFF_WSDT + al256((size_t)D * SFF * 2);
constexpr size_t OFF_OBB = OFF_OAB + al256((size_t)T * DNW * 2);
constexpr size_t OFF_MERGED = OFF_OBB + al256((size_t)T * SBW * 2);
constexpr size_t OFF_HB = OFF_MERGED + al256((size_t)T * D * 2);
constexpr size_t OFF_ACTSH = OFF_HB + al256((size_t)T * D * 2);
constexpr size_t OFF_YPAIRB = OFF_ACTSH + al256((size_t)T * SFF * 2);
constexpr size_t OFF_ORAW = OFF_YPAIRB + al256((size_t)NPAIR * D * 2);
constexpr size_t OFF_PRE1 = OFF_ORAW + al256((size_t)T * DNW * 4);
constexpr size_t OFF_H = OFF_PRE1 + al256((size_t)T * D * 4);
constexpr size_t OFF_SCORES = OFF_H + al256((size_t)T * D * 4);
constexpr size_t OFF_GATE = OFF_SCORES + al256((size_t)T * NE * 4);
constexpr size_t OFF_YSH = OFF_GATE + al256((size_t)NPAIR * 4);
constexpr size_t OFF_IDX = OFF_YSH + al256((size_t)T * D * 4);
constexpr size_t OFF_COUNTS = OFF_IDX + al256((size_t)NPAIR * 4);
constexpr size_t OFF_EXPLIST = OFF_COUNTS + al256(2 * NE * CSTRIDE * 4);
constexpr size_t OFF_WEUT = OFF_EXPLIST + al256((size_t)NE * ECAP * 4);
constexpr size_t OFF_M1 = OFF_WEUT + al256((size_t)NE * 2 * EFF * D * 2);
constexpr size_t OFF_BAR = OFF_M1 + al256((size_t)T * D * 4);
constexpr size_t WS_BYTES = OFF_BAR + al256(XCD_BAR_WORDS * 4);

struct KArgs {
    const float *x, *w_in, *conv_w, *a_log, *dt_bias, *norm_g, *w_pa, *w_pb, *w_out, *ln1_g, *ln1_b, *w_router,
        *router_bias, *w_su, *w_sd, *w_eu, *w_ed, *ln2_g, *ln2_b;
    float* out; unsigned char* ws;
};
struct Params {
    const float *x, *w_in, *conv_w, *a_log, *dt_bias, *norm_g, *w_pa, *w_pb, *w_out, *ln1_g, *ln1_b, *w_router,
        *router_bias, *w_su, *w_sd, *w_eu, *w_ed, *ln2_g, *ln2_b;
    float* out;
    float *oraw, *pre1, *h, *scores, *gate, *ysh, *small, *dnu, *dnlast, *m1;
    int *idx, *counts, *explist;
    bf16_t *xb, *w_in_t, *w_pa_t, *w_pb_t, *w_out_t, *w_router_t, *w_su_t, *w_sd_t, *oab, *obb, *mergedb, *hb, *actsh, *ypairb, *yshb;
    bf16_t *qkvraw, *dzb, *sq, *sk, *vT, *gab, *gbb, *dnblob, *w_eu_t;
    unsigned* bar;
    __device__ __forceinline__ explicit Params(const KArgs& k) {
        x = k.x; w_in = k.w_in; conv_w = k.conv_w; a_log = k.a_log; dt_bias = k.dt_bias; norm_g = k.norm_g; w_pa = k.w_pa; w_pb = k.w_pb;
        w_out = k.w_out; ln1_g = k.ln1_g; ln1_b = k.ln1_b; w_router = k.w_router; router_bias = k.router_bias; w_su = k.w_su; w_sd = k.w_sd;
        w_eu = k.w_eu; w_ed = k.w_ed; ln2_g = k.ln2_g; ln2_b = k.ln2_b; out = k.out;
        unsigned char* w = k.ws; asm volatile("" : "+s"(w));
        xb = (bf16_t*)(w + OFF_XB); w_in_t = (bf16_t*)(w + OFF_WINT); qkvraw = (bf16_t*)(w + OFF_QKVRAW); dzb = (bf16_t*)(w + OFF_DZB);
        sq = (bf16_t*)(w + OFF_SQ); sk = (bf16_t*)(w + OFF_SK); vT = (bf16_t*)(w + OFF_VT); dnblob = (bf16_t*)(w + OFF_DNBLOB);
        dnu = (float*)(w + OFF_DNU); dnlast = (float*)(w + OFF_DNLAST); gab = (bf16_t*)(w + OFF_GAB); gbb = (bf16_t*)(w + OFF_GBB);
        small = (float*)(w + OFF_SMALL); w_pa_t = (bf16_t*)(w + OFF_WPAT); w_pb_t = (bf16_t*)(w + OFF_WPBT); w_out_t = (bf16_t*)(w + OFF_WOUTT);
        w_router_t = (bf16_t*)(w + OFF_WROUTT); w_su_t = (bf16_t*)(w + OFF_WSUT); w_sd_t = (bf16_t*)(w + OFF_WSDT);
        oab = (bf16_t*)(w + OFF_OAB); obb = (bf16_t*)(w + OFF_OBB); mergedb = (bf16_t*)(w + OFF_MERGED); hb = (bf16_t*)(w + OFF_HB);
        actsh = (bf16_t*)(w + OFF_ACTSH); ypairb = (bf16_t*)(w + OFF_YPAIRB); oraw = (float*)(w + OFF_ORAW); pre1 = (float*)(w + OFF_PRE1);
        h = (float*)(w + OFF_H); scores = (float*)(w + OFF_SCORES); gate = (float*)(w + OFF_GATE); ysh = (float*)(w + OFF_YSH); yshb = (bf16_t*)(w + OFF_YSH);
        idx = (int*)(w + OFF_IDX); counts = (int*)(w + OFF_COUNTS); explist = (int*)(w + OFF_EXPLIST); bar = (unsigned*)(w + OFF_BAR); w_eu_t = (bf16_t*)(w + OFF_WEUT); m1 = (float*)(w + OFF_M1);
    }
};

__device__ __forceinline__ float sigmoidf_(float v) { return 1.f / (1.f + expf(-v)); }
__device__ __forceinline__ float siluf_(float v) { return v / (1.f + expf(-v)); }
__device__ __forceinline__ float shfl_lane(float v, int src) { return __int_as_float(__builtin_amdgcn_ds_bpermute(src << 2, __float_as_int(v))); }
__device__ __forceinline__ int shfl_lane_i(int v, int src) { return __builtin_amdgcn_ds_bpermute(src << 2, v); }
__device__ __forceinline__ float wave_sum(float v, int lane) {
#pragma unroll
    for (int o = 32; o > 0; o >>= 1) v += shfl_lane(v, lane ^ o);
    return v;
}


#define XB_TMO      128
#define XB_XCNT(j)  (256  + 64 * (j))
#define XB_XSUB(j)  (1280 + 64 * (j))
#define XB_XGEN(j)  (2304 + 64 * (j))
#define XB_TOP      3328
#define XB_TOPGEN   3392
#define XB_SPIN_CAP (1u << 24)
#define LAS3 __attribute__((address_space(3)))
__device__ __forceinline__ unsigned xb_ld(unsigned* p)              { return __hip_atomic_load(p, __ATOMIC_RELAXED, __HIP_MEMORY_SCOPE_AGENT); }
__device__ __forceinline__ unsigned xb_add(unsigned* p, unsigned v) { return __hip_atomic_fetch_add(p, v, __ATOMIC_RELAXED, __HIP_MEMORY_SCOPE_AGENT); }
__device__ __forceinline__ unsigned xb_xcc_id() { return (unsigned)__builtin_amdgcn_s_getreg((3 << 11) | 20) & 0xFu; }
#define XB_SPIN(cond, bar) do { unsigned _sp = 0; while (cond) { __builtin_amdgcn_s_sleep(1); \
    if ((++_sp & 255u) == 0u) { if (xb_ld(&(bar)[XB_TMO])) break; if (_sp > XB_SPIN_CAP) { atomicAdd(&(bar)[XB_TMO], 1u); break; } } } } while (0)
struct XcdBarrier { unsigned* bar; unsigned x; volatile LAS3 unsigned* st; };
__device__ __forceinline__ XcdBarrier xcd_barrier_post(unsigned* bar, volatile LAS3 unsigned* st) {
    XcdBarrier b; b.bar = bar; b.x = xb_xcc_id(); b.st = st;
    if (threadIdx.x == 0) (void)xb_add(&bar[XB_XCNT(b.x)], 1u);
    return b;
}
__device__ __forceinline__ void xcd_barrier_complete(unsigned* bar, unsigned x, unsigned& nloc, unsigned& nx) {
    const unsigned G = gridDim.x * gridDim.y * gridDim.z;
    unsigned sum, cnt, mine, sp = 0u;
    asm volatile("" : "+s"(x));
    for (;;) {
        sum = 0u; cnt = 0u; mine = 0u;
#pragma unroll 1
        for (unsigned j = 0; j < 16; ++j) { const unsigned c = xb_ld(&bar[XB_XCNT(j)]); sum += c; cnt += (c > 0u) ? 1u : 0u; mine = (j == x) ? c : mine; }
        if (sum == G) break;
        __builtin_amdgcn_s_sleep(1);
        if ((++sp & 255u) == 0u) { if (xb_ld(&bar[XB_TMO])) break; if (sp > XB_SPIN_CAP) { atomicAdd(&bar[XB_TMO], 1u); break; } }
    }
    nloc = mine > 0u ? mine : 1u; nx = cnt > 0u ? cnt : 1u;
}
__device__ __forceinline__ void xcd_barrier(const XcdBarrier& b) {
    asm volatile("s_waitcnt vmcnt(0)" ::: "memory");
    __syncthreads();
    if (threadIdx.x == 0) {
        unsigned* bar = b.bar;
        __builtin_amdgcn_s_waitcnt(0);
        unsigned nloc = b.st[0], nx = b.st[1];
        if (nloc == 0u) { xcd_barrier_complete(bar, b.x, nloc, nx); b.st[0] = nloc; b.st[1] = nx; }
        const unsigned old = xb_add(&bar[XB_XSUB(b.x)], 1u);
        const unsigned gen = old / nloc;
        if (old + 1u == (gen + 1u) * nloc) {
            __builtin_amdgcn_fence(__ATOMIC_RELEASE, "agent");
            asm volatile("s_waitcnt vmcnt(0)" ::: "memory");
            const unsigned og = xb_add(&bar[XB_TOP], 1u);
            const unsigned tg = og / nx;
            if (og + 1u == (tg + 1u) * nx) xb_add(&bar[XB_TOPGEN], 1u);
            else XB_SPIN(xb_ld(&bar[XB_TOPGEN]) == tg, bar);
            __builtin_amdgcn_fence(__ATOMIC_ACQUIRE, "agent");
            xb_add(&bar[XB_XGEN(b.x)], 1u);
            asm volatile("s_waitcnt vmcnt(0)" ::: "memory");
        } else {
            XB_SPIN(xb_ld(&bar[XB_XGEN(b.x)]) == gen, bar);
            __builtin_amdgcn_fence(__ATOMIC_ACQUIRE, "agent");
            asm volatile("s_waitcnt vmcnt(0)" ::: "memory");
        }
    }
    __syncthreads();
}

typedef short bf16x8 __attribute__((ext_vector_type(8)));
typedef float f32x16 __attribute__((ext_vector_type(16)));
typedef float f32x4 __attribute__((ext_vector_type(4)));
__device__ __forceinline__ unsigned pk_bf16(float a, float b) {
    typedef __bf16 bf2 __attribute__((ext_vector_type(2)));
    typedef float f2 __attribute__((ext_vector_type(2)));
    f2 v = {a, b};
    bf2 r = __builtin_convertvector(v, bf2);
    return __builtin_bit_cast(unsigned, r);
}
__device__ __forceinline__ bf16_t to_bf16(float a) { return (bf16_t)(pk_bf16(a, 0.f) & 0xffffu); }
__device__ __forceinline__ float bf2f(bf16_t v) { return __uint_as_float((unsigned)v << 16); }

__device__ __forceinline__ int opaque_tid() { int t = threadIdx.x; asm volatile("" : "+v"(t)); return t; }
constexpr int LROW = 128;
__device__ __forceinline__ int swz(int r) { return ((r >> 2) & 7) ^ ((r >> 1) & 1); }

template <int ROWS, bool MAYBE_NULL = false> struct LoadRowsBf16 {
    static constexpr int NCH = ROWS * 8 / NT;
    const bf16_t* base; int tid;
    unsigned off[NCH];
    uint4 regs[NCH];
    template <class RF> __device__ __forceinline__ void init(const bf16_t* base_, int ld, RF rowfn) {
        base = base_; tid = opaque_tid();
#pragma unroll
        for (int i = 0; i < NCH; ++i) {
            const int c = tid + i * NT, r = c >> 3, ch = c & 7;
            const long long src = rowfn(r);
            off[i] = (!MAYBE_NULL || src >= 0) ? (unsigned)(src * ld + ch * 8) : 0xffffffffu;
        }
    }
    __device__ __forceinline__ void load(int k0) {
#pragma unroll
        for (int i = 0; i < NCH; ++i)
            regs[i] = (!MAYBE_NULL || off[i] != 0xffffffffu) ? *(const uint4*)(base + (size_t)off[i] + k0) : make_uint4(0, 0, 0, 0);
    }
    __device__ __forceinline__ void store(unsigned char* lds) const {
#pragma unroll
        for (int i = 0; i < NCH; ++i) {
            const int c = tid + i * NT, r = c >> 3, ch = c & 7;
            *(uint4*)(lds + r * LROW + ((ch ^ swz(r)) << 4)) = regs[i];
        }
    }
};

__device__ __forceinline__ int pi16(int x) { return (x & ~12) | ((x & 4) << 1) | ((x & 8) >> 1); }
namespace pg8 {
#define PG8_LAS __attribute__((address_space(3)))
typedef unsigned short bf16_t;
typedef short bf16x8 __attribute__((ext_vector_type(8)));
typedef float f32x4 __attribute__((ext_vector_type(4)));
typedef unsigned u32x4 __attribute__((ext_vector_type(4)));
constexpr int BM = 256, BK = 64, HALF = 128, HTB = HALF * BK * 2  , STAGE_BYTES = 8 * HTB, NXCD = 8, WGM = 8;

__host__ __device__ __forceinline__ int lds_byte(int r, int c) { const int st = (r >> 4) * 2 + (c >> 5), rr = r & 15, cc = c & 31, ob = rr * 64 + cc * 2; return st * 1024 + (ob ^ (((ob >> 9) & 1) << 5)); }
__host__ __device__ __forceinline__ void stage_rc(int b, int& R, int& C) { const int st = b / 1024, sb = b % 1024, swz = sb ^ (((sb >> 9) & 1) << 5); R = (st >> 1) * 16 + swz / 64; C = (st & 1) * 32 + (swz % 64) / 2; }
__host__ __device__ __forceinline__ int perm32(int rho) { const int n = rho >> 4, i = rho & 15; return 8 * (i >> 2) + 4 * n + (i & 3); }

struct Unit { int pm, pn; };
struct Gemm { const bf16_t* A; const bf16_t* Bt; int M, N, K; };

struct StaticOrder {
    int nM, nN, nwg, G, c;
    __host__ __device__ void init(int M, int N, int G_, int c_) { nM = M / BM; nN = N / BM; nwg = nM * nN; G = G_; c = c_; }
    __host__ __device__ bool next(int i, Unit& u) const {
        const long L = (long)i * G + c; if (L >= nwg) return false;
        int wgid = (int)L; { const int q = nwg / NXCD, r = nwg % NXCD, xcd = wgid % NXCD, off = wgid / NXCD; wgid = (xcd < r ? xcd * (q + 1) : r * (q + 1) + (xcd - r) * q) + off; }
        const int nig = WGM * nN, gid = wgid / nig, fm = gid * WGM, gsz = (nM - fm) < WGM ? (nM - fm) : WGM;
        u.pm = fm + ((wgid % nig) % gsz); u.pn = (wgid % nig) / gsz; return true;
    }
    __device__ __forceinline__ void a_ready(const Unit&) const {}
    __device__ __forceinline__ void done(const Unit&) const {}
};


__device__ __forceinline__ unsigned cvt_pk_bf16(float lo, float hi) { unsigned r; asm volatile("v_cvt_pk_bf16_f32 %0, %1, %2" : "=v"(r) : "v"(lo), "v"(hi)); return r; }

template <class Epi, class Sched, bool ALIGN_EPI = false, bool SP2 = false>
__device__ __forceinline__ void gemm_phase(PG8_LAS unsigned char* lds, const Gemm g, const Sched& S, const Epi& E) {
    const int tid = opaque_tid(), wid = __builtin_amdgcn_readfirstlane(tid >> 6), lane = tid & 63, wr = wid >> 2, wc = wid & 3, fr = lane & 15, fq = lane >> 4;
    const int K = g.K, nt = K / BK;
    unsigned voffA[2], voffB[2];
#pragma unroll
    for (int i = 0; i < 2; ++i) { int R, C; stage_rc(tid * 16 + i * 8192, R, C); const int Rb = Epi::PERM ? ((R & ~31) + perm32(R & 31)) : R;
        voffA[i] = (unsigned)(R * K + C) * 2u; voffB[i] = (unsigned)(Rb * K + C) * 2u; }
    const size_t rstep64 = (size_t)64 * K * 2;
    const size_t kstep = (size_t)(BK * 2);
    const size_t hstep = (size_t)HALF * K * 2;
    const size_t tstep = 2 * hstep;
    const unsigned ldsw = (unsigned)wid * 1024u;
    const int aoff = lds_byte(wr * 64 + fr, fq * 8), boff = lds_byte(wc * 32 + fr, fq * 8);
#define PG8_SA(b, h) (((b) * 2 + (h)) * HTB)
#define PG8_SB(b, h) ((4 + (b) * 2 + (h)) * HTB)
#define PG8_STAGE(bufoff, gbase, voff) do { _Pragma("unroll") for (int _i = 0; _i < 2; ++_i) \
        __builtin_amdgcn_global_load_lds((const unsigned*)((const char*)(gbase) + (size_t)_i * rstep64 + (voff)[0]), (PG8_LAS unsigned*)(lds + (bufoff) + ldsw + _i * 8192), 16, 0, 0); } while (0)
#define PG8_LDA(dst, b, h) do { _Pragma("unroll") for (int m = 0; m < 4; ++m) _Pragma("unroll") for (int k = 0; k < 2; ++k) dst[m][k] = *(const PG8_LAS bf16x8*)(lds + PG8_SA(b, h) + aoff + m * 2048 + k * 1024); } while (0)
#define PG8_LDB(dst, b, h) do { _Pragma("unroll") for (int n = 0; n < 2; ++n) _Pragma("unroll") for (int k = 0; k < 2; ++k) dst[n][k] = *(const PG8_LAS bf16x8*)(lds + PG8_SB(b, h) + boff + n * 2048 + k * 1024); } while (0)
#define PG8_MMA(ai, bj, At, Bt) do { __builtin_amdgcn_s_setprio(1); _Pragma("unroll") for (int m = 0; m < 4; ++m) _Pragma("unroll") for (int n = 0; n < 2; ++n) _Pragma("unroll") for (int k = 0; k < 2; ++k) \
        acc[ai][bj][m][n] = __builtin_amdgcn_mfma_f32_16x16x32_bf16(Bt[n][k], At[m][k], acc[ai][bj][m][n], 0, 0, 0); __builtin_amdgcn_s_setprio(0); } while (0)
#define PG8_WAIT_V(n) asm volatile("s_waitcnt vmcnt(" #n ")" ::: "memory")
#define PG8_WAIT_L(n) asm volatile("s_waitcnt lgkmcnt(" #n ")" ::: "memory")
#define PG8_BAR __builtin_amdgcn_s_barrier()
#define PG8_SCHED __builtin_amdgcn_sched_barrier(0)
    Unit cur, nxt; int ui = 0;
    if (!S.next(0, cur)) return;
    f32x4 acc[2][2][4][2];
#pragma unroll
    for (int a = 0; a < 2; ++a)
#pragma unroll
        for (int b = 0; b < 2; ++b)
#pragma unroll
            for (int m = 0; m < 4; ++m)
#pragma unroll
                for (int n = 0; n < 2; ++n) acc[a][b][m][n] = (f32x4){0.f, 0.f, 0.f, 0.f};
    bf16x8 At[4][2], B0[2][2], B1[2][2];
    const char* cA = (const char*)g.A + (size_t)cur.pm * tstep; const char* cB = (const char*)g.Bt + (size_t)cur.pn * tstep;
    S.a_ready(cur);
    if constexpr (SP2) {
        PG8_STAGE(PG8_SB(0, 0), cB, voffB); PG8_STAGE(PG8_SB(0, 1), cB + hstep, voffB); PG8_STAGE(PG8_SA(0, 0), cA, voffA); PG8_STAGE(PG8_SA(0, 1), cA + hstep, voffA);
        if (wr == 1) PG8_BAR;
        PG8_WAIT_V(2); PG8_BAR;
        PG8_STAGE(PG8_SB(1, 0), cB + kstep, voffB); PG8_STAGE(PG8_SA(1, 0), cA + kstep, voffA); PG8_STAGE(PG8_SB(1, 1), cB + hstep + kstep, voffB);
        PG8_WAIT_V(6); PG8_BAR;
    } else {
        PG8_STAGE(PG8_SB(0, 0), cB, voffB); PG8_STAGE(PG8_SA(0, 0), cA, voffA); PG8_STAGE(PG8_SB(0, 1), cB + hstep, voffB); PG8_STAGE(PG8_SA(0, 1), cA + hstep, voffA);
        if (wr == 1) PG8_BAR;
        PG8_WAIT_V(4); PG8_BAR;
        PG8_STAGE(PG8_SB(1, 0), cB + kstep, voffB); PG8_STAGE(PG8_SA(1, 0), cA + kstep, voffA); PG8_STAGE(PG8_SB(1, 1), cB + hstep + kstep, voffB);
        PG8_WAIT_V(6); PG8_BAR;
    }
    for (;;) {
        const bool has_next = S.next(ui + 1, nxt);
        const char* nA = has_next ? (const char*)g.A + (size_t)nxt.pm * tstep : cA; const char* nB = has_next ? (const char*)g.Bt + (size_t)nxt.pn * tstep : cB;
        for (int t = 0; t < nt; t += 2) {
            const bool last = (t == nt - 2);
            const char* a1 = cA + (size_t)(t + 1) * kstep;
            const char* a2 = last ? nA : cA + (size_t)(t + 2) * kstep; const char* b2 = last ? nB : cB + (size_t)(t + 2) * kstep;
            const char* a3 = a2 + kstep; const char* b3 = b2 + kstep;
            if (last && has_next) S.a_ready(nxt);
            if constexpr (SP2) {
            PG8_LDB(B0, 0, 0); PG8_LDB(B1, 0, 1); PG8_SCHED; PG8_LDA(At, 0, 0); PG8_STAGE(PG8_SA(1, 1), a1 + hstep, voffA);
            PG8_WAIT_V(8); PG8_WAIT_L(0); PG8_BAR; PG8_MMA(0, 0, At, B0); PG8_MMA(0, 1, At, B1); PG8_BAR; PG8_SCHED;
            PG8_LDA(At, 0, 1); PG8_STAGE(PG8_SB(0, 0), b2, voffB); PG8_STAGE(PG8_SB(0, 1), b2 + hstep, voffB); PG8_STAGE(PG8_SA(0, 0), a2, voffA);
            PG8_WAIT_V(8); PG8_WAIT_L(0); PG8_BAR; PG8_MMA(1, 0, At, B0); PG8_MMA(1, 1, At, B1); PG8_BAR; PG8_SCHED;
            PG8_LDB(B0, 1, 0); PG8_LDB(B1, 1, 1); PG8_SCHED; PG8_LDA(At, 1, 0); PG8_STAGE(PG8_SA(0, 1), a2 + hstep, voffA);
            PG8_WAIT_V(8); PG8_WAIT_L(0); PG8_BAR; PG8_MMA(0, 0, At, B0); PG8_MMA(0, 1, At, B1); PG8_BAR; PG8_SCHED;
            PG8_LDA(At, 1, 1); PG8_STAGE(PG8_SB(1, 0), b3, voffB); PG8_STAGE(PG8_SB(1, 1), b3 + hstep, voffB); PG8_STAGE(PG8_SA(1, 0), a3, voffA);
            PG8_WAIT_V(8); PG8_WAIT_L(0); PG8_BAR; PG8_MMA(1, 0, At, B0); PG8_MMA(1, 1, At, B1); PG8_BAR; PG8_SCHED;
            } else {
            PG8_LDB(B0, 0, 0); PG8_SCHED; PG8_LDA(At, 0, 0); PG8_STAGE(PG8_SA(1, 1), a1 + hstep, voffA);
            PG8_WAIT_L(8); PG8_BAR; PG8_WAIT_L(0); PG8_MMA(0, 0, At, B0); PG8_BAR; PG8_SCHED;
            PG8_LDB(B1, 0, 1); PG8_STAGE(PG8_SB(0, 0), b2, voffB);
            PG8_BAR; PG8_WAIT_L(0); PG8_MMA(0, 1, At, B1); PG8_BAR;
            PG8_LDA(At, 0, 1); PG8_STAGE(PG8_SA(0, 0), a2, voffA);
            PG8_BAR; PG8_WAIT_L(0); PG8_MMA(1, 0, At, B0); PG8_BAR; PG8_SCHED;
            PG8_STAGE(PG8_SB(0, 1), b2 + hstep, voffB);
            PG8_WAIT_V(6); PG8_BAR; PG8_MMA(1, 1, At, B1); PG8_BAR;
            PG8_LDB(B0, 1, 0); PG8_SCHED; PG8_LDA(At, 1, 0); PG8_STAGE(PG8_SA(0, 1), a2 + hstep, voffA);
            PG8_WAIT_L(8); PG8_BAR; PG8_WAIT_L(0); PG8_MMA(0, 0, At, B0); PG8_BAR; PG8_SCHED;
            PG8_LDB(B1, 1, 1); PG8_STAGE(PG8_SB(1, 0), b3, voffB);
            PG8_BAR; PG8_WAIT_L(0); PG8_MMA(0, 1, At, B1); PG8_BAR;
            PG8_LDA(At, 1, 1); PG8_STAGE(PG8_SA(1, 0), a3, voffA);
            PG8_BAR; PG8_WAIT_L(0); PG8_MMA(1, 0, At, B0); PG8_BAR; PG8_SCHED;
            PG8_STAGE(PG8_SB(1, 1), b3 + hstep, voffB);
            PG8_WAIT_V(6); PG8_BAR; PG8_MMA(1, 1, At, B1); PG8_BAR;
            }
        }
        if constexpr (ALIGN_EPI) { if (wr == 0) PG8_BAR; }
        if constexpr (!Epi::AFTER_DRAIN) { E(acc, cur, wr, wc, fr, fq); S.done(cur); }
        if (!has_next) break;
#pragma unroll
        for (int a = 0; a < 2; ++a)
#pragma unroll
            for (int b = 0; b < 2; ++b)
#pragma unroll
                for (int m = 0; m < 4; ++m)
#pragma unroll
                    for (int n = 0; n < 2; ++n) acc[a][b][m][n] = (f32x4){0.f, 0.f, 0.f, 0.f};
        cur = nxt; cA = nA; cB = nB; ++ui;
        if constexpr (ALIGN_EPI) { if (wr == 1) PG8_BAR; }
    }
    PG8_WAIT_V(0);
    if constexpr (!ALIGN_EPI) { if (wr == 0) PG8_BAR; }
    PG8_BAR;
    if constexpr (Epi::AFTER_DRAIN) { E.fused(acc, cur, wr, wc, fr, fq, lds, wid, lane); S.done(cur); }
#undef PG8_SA
#undef PG8_SB
#undef PG8_STAGE
#undef PG8_LDA
#undef PG8_LDB
#undef PG8_MMA
#undef PG8_WAIT_V
#undef PG8_WAIT_L
#undef PG8_BAR
#undef PG8_SCHED
}
}

struct EpiInproj {
    static constexpr bool PERM = true, AFTER_DRAIN = false;
    bf16_t *qkvraw, *dzb, *sq, *sk, *vT, *gab, *gbb; float* small;
    __device__ __forceinline__ void operator()(const pg8::f32x4 (&acc)[2][2][4][2], const pg8::Unit& u, int wr, int wc, int fr, int fq) const {
        const int pn = u.pn, row0 = u.pm * 256 + wr * 64 + fr;
        if (pn == 12 || pn == 13) {
#pragma unroll
            for (int ai = 0; ai < 2; ++ai)
#pragma unroll
                for (int m = 0; m < 4; ++m) {
                    const int tok = row0 + ai * 128 + m * 16, bb = tok >> 11, key = tok & (SEQ - 1), pos = (key & ~15) | pi16(key & 15);
#pragma unroll
                    for (int bj = 0; bj < 2; ++bj)
#pragma unroll
                        for (int n = 0; n < 2; ++n)
#pragma unroll
                            for (int j = 0; j < 4; ++j) {
                                const int svcol = (pn - 12) * 256 + bj * 128 + wc * 32 + fq * 8 + n * 4 + j;
                                vT[((size_t)((bb * 8 + (svcol >> 6)) * 64 + (svcol & 63))) * SEQ + pos] = to_bf16(acc[ai][bj][m][n][j]);
                            }
                }
        } else if (pn == 22) {
            if (wc == 0 && fq == 0) {
#pragma unroll
                for (int ai = 0; ai < 2; ++ai)
#pragma unroll
                    for (int m = 0; m < 4; ++m) {
                        pg8::f32x4* d = (pg8::f32x4*)(small + (size_t)(row0 + ai * 128 + m * 16) * 8);
                        d[0] = acc[ai][0][m][0]; d[1] = acc[ai][0][m][1];
                    }
            }
        } else {
            bf16_t* dst; int ld, c0; float sc = 1.f; bool gate = false;
            if (pn < 6) { dst = qkvraw; ld = 1536; c0 = pn * 256; }
            else if (pn < 8) { dst = dzb; ld = 512; c0 = (pn - 6) * 256; }
            else if (pn < 10) { dst = sq; ld = 512; c0 = (pn - 8) * 256; sc = 0.125f * 1.4426950408889634f; }
            else if (pn < 12) { dst = sk; ld = 512; c0 = (pn - 10) * 256; }
            else if (pn < 18) { dst = gab; ld = 1024; c0 = (pn - 14) * 256; gate = true; }
            else { dst = gbb; ld = 1024; c0 = (pn - 18) * 256; gate = true; }
#pragma unroll
            for (int ai = 0; ai < 2; ++ai)
#pragma unroll
                for (int m = 0; m < 4; ++m) {
                    bf16_t* rowp = dst + (size_t)(row0 + ai * 128 + m * 16) * ld + c0 + wc * 32 + fq * 8;
#pragma unroll
                    for (int bj = 0; bj < 2; ++bj) {
                        pg8::f32x4 v0 = acc[ai][bj][m][0] * sc, v1 = acc[ai][bj][m][1] * sc;
                        if (gate) {
#pragma unroll
                            for (int j = 0; j < 4; ++j) { v0[j] = sigmoidf_(v0[j]); v1[j] = sigmoidf_(v1[j]); }
                        }
                        pg8::u32x4 w; w.x = pk_bf16(v0[0], v0[1]); w.y = pk_bf16(v0[2], v0[3]); w.z = pk_bf16(v1[0], v1[1]); w.w = pk_bf16(v1[2], v1[3]);
                        *(pg8::u32x4*)(rowp + bj * 128) = w;
                    }
                }
        }
    }
};
template <class F> struct EpiF4 {
    static constexpr bool PERM = false, AFTER_DRAIN = false;
    F f;
    __device__ __forceinline__ void operator()(const pg8::f32x4 (&acc)[2][2][4][2], const pg8::Unit& u, int wr, int wc, int fr, int fq) const {
#pragma unroll
        for (int ai = 0; ai < 2; ++ai)
#pragma unroll
            for (int m = 0; m < 4; ++m) {
                const int row = u.pm * 256 + ai * 128 + wr * 64 + m * 16 + fr;
#pragma unroll
                for (int bj = 0; bj < 2; ++bj)
#pragma unroll
                    for (int n = 0; n < 2; ++n) f(row, u.pn * 256 + bj * 128 + wc * 32 + n * 16 + fq * 4, acc[ai][bj][m][n]);
            }
    }
};
template <class F> __device__ __forceinline__ void run_pg8(const bf16_t* A, const bf16_t* Bt, int M, int N, int K, unsigned char* lds, F f) {
    pg8::Gemm g{A, Bt, M, N, K};
    pg8::StaticOrder S; S.init(M, N, gridDim.x, blockIdx.x);
    EpiF4<F> E{f};
    pg8::gemm_phase<EpiF4<F>, pg8::StaticOrder, true, true>((PG8_LAS unsigned char*)lds, g, S, E);
}
__device__ __forceinline__ void unpack4(uint2 w, float (&g)[4]) {
    g[0] = __uint_as_float(w.x << 16); g[1] = __uint_as_float(w.x & 0xffff0000u); g[2] = __uint_as_float(w.y << 16); g[3] = __uint_as_float(w.y & 0xffff0000u);
}

struct LoadKNF32 {
    const float* base; int ld, kq, nq;
    f32x4 regs[8];
    template <class CF> __device__ __forceinline__ void init(const float* w, int ld_, CF colfn) {
        const int tid = opaque_tid(); kq = tid >> 6; nq = tid & 63; ld = ld_;
        base = w + (size_t)(kq * 8) * ld_ + colfn(nq * 4);
    }
    __device__ __forceinline__ void load(int k0) {
#pragma unroll
        for (int j = 0; j < 8; ++j) regs[j] = *(const f32x4*)(base + (size_t)(k0 + j) * ld);
    }
    __device__ __forceinline__ void store1(unsigned char* lds, int nn, float a0, float a1, float a2, float a3, float a4, float a5, float a6, float a7) const {
        uint4 o; o.x = pk_bf16(a0, a1); o.y = pk_bf16(a2, a3); o.z = pk_bf16(a4, a5); o.w = pk_bf16(a6, a7);
        const int row = nq * 4 + nn;
        *(uint4*)(lds + row * LROW + ((kq ^ swz(row)) << 4)) = o;
    }
    __device__ __forceinline__ void store(unsigned char* lds) const {
        store1(lds, 0, regs[0].x, regs[1].x, regs[2].x, regs[3].x, regs[4].x, regs[5].x, regs[6].x, regs[7].x);
        store1(lds, 1, regs[0].y, regs[1].y, regs[2].y, regs[3].y, regs[4].y, regs[5].y, regs[6].y, regs[7].y);
        store1(lds, 2, regs[0].z, regs[1].z, regs[2].z, regs[3].z, regs[4].z, regs[5].z, regs[6].z, regs[7].z);
        store1(lds, 3, regs[0].w, regs[1].w, regs[2].w, regs[3].w, regs[4].w, regs[5].w, regs[6].w, regs[7].w);
    }
};

template <int BM_, int BN_, int WM_, int WN_> struct GemmCfg {
    static constexpr int BM = BM_, BN = BN_, WM = WM_, WN = WN_;
    static constexpr int TM = BM / WM, TN = BN / WN, MI = TM / 32, NI = TN / 32;
    static constexpr int A_BYTES = BM * LROW, B_BYTES = BN * LROW, STAGE = A_BYTES + B_BYTES;
    static_assert(WM * WN == 8, "8 waves");
};

template <class CFG, class AL, class BL>
__device__ __forceinline__ void gemm_mainloop(AL& al, BL& bl, int nk, f32x16 (&acc)[CFG::MI][CFG::NI], unsigned char* lds) {
    constexpr int MI = CFG::MI, NI = CFG::NI;
    const int tid = opaque_tid(), lane = tid & 63, wid = tid >> 6;
    const int wm = wid / CFG::WN, wn = wid % CFG::WN;
    const int l31 = lane & 31, lh = lane >> 5;
    al.load(0); bl.load(0);
    const int a_off = (wm * CFG::TM + l31) * LROW;
    const int b_off = CFG::A_BYTES + (wn * CFG::TN + l31) * LROW;
    const int fsw = swz(l31);
    for (int kt = 0; kt < nk; ++kt) {
        unsigned char* st = lds + (kt & 1) * CFG::STAGE;
        al.store(st); bl.store(st + CFG::A_BYTES);
        __syncthreads();
        if (kt + 1 < nk) { al.load((kt + 1) * 64); bl.load((kt + 1) * 64); }
#pragma unroll
        for (int kk = 0; kk < 4; ++kk) {
            bf16x8 a[MI], b[NI];
#pragma unroll
            for (int mi = 0; mi < MI; ++mi) a[mi] = *(const bf16x8*)(st + a_off + mi * 32 * LROW + (((kk * 2 + lh) ^ fsw) << 4));
#pragma unroll
            for (int ni = 0; ni < NI; ++ni) b[ni] = *(const bf16x8*)(st + b_off + ni * 32 * LROW + (((kk * 2 + lh) ^ fsw) << 4));
#pragma unroll
            for (int mi = 0; mi < MI; ++mi)
#pragma unroll
                for (int ni = 0; ni < NI; ++ni)
                    acc[mi][ni] = __builtin_amdgcn_mfma_f32_32x32x16_bf16(a[mi], b[ni], acc[mi][ni], 0, 0, 0);
        }
    }
    __syncthreads();
}
template <class CFG, bool A_RES, int ARES_ROT, bool TRANS, class AL, class BL>
__device__ __forceinline__ void gemm_mainloop2(AL (&al)[2], BL (&bl)[2], int nk, f32x16 (&acc)[CFG::MI][CFG::NI], unsigned char* stages, const unsigned char* ares) {
    constexpr int MI = CFG::MI, NI = CFG::NI;
    constexpr int STG = A_RES ? CFG::B_BYTES : CFG::STAGE, BOFF = A_RES ? 0 : CFG::A_BYTES;
    const int tid = opaque_tid(), lane = tid & 63, wid = tid >> 6;
    const int wm = wid / CFG::WN, wn = wid % CFG::WN;
    const int l31 = lane & 31, lh = lane >> 5;
    if (!A_RES) { al[0].load(0); } bl[0].load(0);
    if (!A_RES) { al[1].load(64); } bl[1].load(64);
    const int a_off = (wm * CFG::TM + l31) * LROW;
    const int b_off = BOFF + (wn * CFG::TN + l31) * LROW;
    const int fsw = swz(l31);
    for (int kt = 0; kt < nk; kt += 2) {
#pragma unroll
        for (int u = 0; u < 2; ++u) {
            unsigned char* st = stages + u * STG;
            if (!A_RES) al[u].store(st);
            bl[u].store(st + BOFF);
            __syncthreads();
            if (kt + u + 2 < nk) { if (!A_RES) al[u].load((kt + u + 2) * 64); bl[u].load((kt + u + 2) * 64); }
            const unsigned char* ab = A_RES ? ares + (size_t)((kt + u + ARES_ROT) & 3) * (CFG::BM * LROW) : st;
#pragma unroll
            for (int kk = 0; kk < 4; ++kk) {
                bf16x8 a[MI], b[NI];
#pragma unroll
                for (int mi = 0; mi < MI; ++mi) a[mi] = *(const bf16x8*)(ab + a_off + mi * 32 * LROW + (((kk * 2 + lh) ^ fsw) << 4));
#pragma unroll
                for (int ni = 0; ni < NI; ++ni) b[ni] = *(const bf16x8*)(st + b_off + ni * 32 * LROW + (((kk * 2 + lh) ^ fsw) << 4));
#pragma unroll
                for (int mi = 0; mi < MI; ++mi)
#pragma unroll
                    for (int ni = 0; ni < NI; ++ni)
                        acc[mi][ni] = TRANS ? __builtin_amdgcn_mfma_f32_32x32x16_bf16(b[ni], a[mi], acc[mi][ni], 0, 0, 0)
                                            : __builtin_amdgcn_mfma_f32_32x32x16_bf16(a[mi], b[ni], acc[mi][ni], 0, 0, 0);
            }
        }
    }
    __syncthreads();
}
template <class CFG> __device__ __forceinline__ void acc_zero(f32x16 (&acc)[CFG::MI][CFG::NI]) {
#pragma unroll
    for (int mi = 0; mi < CFG::MI; ++mi)
#pragma unroll
        for (int ni = 0; ni < CFG::NI; ++ni)
#pragma unroll
            for (int r = 0; r < 16; ++r) acc[mi][ni][r] = 0.f;
}
template <class CFG, class F> __device__ __forceinline__ void acc_foreach(f32x16 (&acc)[CFG::MI][CFG::NI], F f) {
    const int tid = opaque_tid(), lane = tid & 63, wid = tid >> 6;
    const int wm = wid / CFG::WN, wn = wid % CFG::WN;
#pragma unroll
    for (int mi = 0; mi < CFG::MI; ++mi)
#pragma unroll
        for (int ni = 0; ni < CFG::NI; ++ni) {
            asm volatile("" ::: "memory");
#pragma unroll
            for (int r = 0; r < 16; ++r)
                acc[mi][ni][r] = f(wm * CFG::TM + mi * 32 + (r & 3) + 8 * (r >> 2) + 4 * (lane >> 5), wn * CFG::TN + ni * 32 + (lane & 31), acc[mi][ni][r], mi, ni, r);
        }
}

struct TileMap {
    int ntm, ntn, npm, npn, rounds; bool patched;
    int pm, pn;
    __device__ __forceinline__ void init(int ntm_, int ntn_) {
        ntm = ntm_; ntn = ntn_; patched = (gridDim.x == 256);
        pn = ntn >= 8 ? 8 : ntn >= 4 ? 4 : ntn >= 2 ? 2 : 1; pm = 32 / pn;
        if (patched) { npm = (ntm + pm - 1) / pm; npn = (ntn + pn - 1) / pn; rounds = (npm * npn + 7) / 8; }
        else { int G = gridDim.x; asm volatile("" : "+s"(G)); npm = npn = 0; rounds = (ntm * ntn + G - 1) / G; }
    }
    __device__ __forceinline__ bool get(int round, int& tm, int& tn) const {
        const int b = blockIdx.x;
        if (patched) {
            const int patch = round * 8 + (b & 7), slot = b >> 3;
            if (patch >= npm * npn) return false;
            tm = (patch / npn) * pm + slot / pn; tn = (patch % npn) * pn + slot % pn;
            return tm < ntm && tn < ntn;
        }
        const int t = round * gridDim.x + b;
        if (t >= ntm * ntn) return false;
        tm = t / ntn; tn = t % ntn; return true;
    }
};

template <class CM>
__device__ __forceinline__ void transpose_convert(const float* W, int K, int N, int NP, bf16_t* Wt, float* sm, CM cmap) {
    const int tid = opaque_tid(), ntk = K / 64, ntn = NP / 64;
    for (int tile = blockIdx.x; tile < ntk * ntn; tile += gridDim.x) {
        const int tk = tile % ntk, tn = tile / ntk;
#pragma unroll
        for (int i = 0; i < 8; ++i) {
            const int e = tid + i * NT, kk = e >> 6, nn = e & 63, col = cmap(tn * 64 + nn);
            sm[nn * 65 + kk] = col >= 0 ? W[(size_t)(tk * 64 + kk) * N + col] : 0.f;
        }
        __syncthreads();
        const int n = tid >> 3, kc = tid & 7;
        const float* r = sm + n * 65 + kc * 8;
        uint4 o; o.x = pk_bf16(r[0], r[1]); o.y = pk_bf16(r[2], r[3]); o.z = pk_bf16(r[4], r[5]); o.w = pk_bf16(r[6], r[7]);
        *(uint4*)(Wt + (size_t)(tn * 64 + n) * K + tk * 64 + kc * 8) = o;
        __syncthreads();
    }
}
__device__ __forceinline__ void transpose_tile_f4(const float* W, int K, int N, bf16_t* Wt, int k0, int n0, float* sm) {
    const int tid = opaque_tid(), kk = tid >> 4, n4 = tid & 15;
#pragma unroll
    for (int h = 0; h < 2; ++h) {
        const int k = kk + 32 * h;
        const f32x4 v = *(const f32x4*)(W + (size_t)(k0 + k) * N + n0 + n4 * 4);
#pragma unroll
        for (int j = 0; j < 4; ++j) sm[(n4 * 4 + j) * 65 + k] = v[j];
    }
    __syncthreads();
    const int n = tid >> 3, kc = tid & 7;
    const float* r = sm + n * 65 + kc * 8;
    uint4 o; o.x = pk_bf16(r[0], r[1]); o.y = pk_bf16(r[2], r[3]); o.z = pk_bf16(r[4], r[5]); o.w = pk_bf16(r[6], r[7]);
    *(uint4*)(Wt + (size_t)(n0 + n) * K + k0 + kc * 8) = o;
    __syncthreads();
}
__device__ __forceinline__ void convert_bf16(const float* src, bf16_t* dst, size_t n) {
    const size_t gtid = (size_t)blockIdx.x * NT + opaque_tid(), gsz = (size_t)gridDim.x * NT;
    for (size_t i = gtid; i < n / 8; i += gsz) {
        const float4 a = ((const float4*)src)[2 * i], b = ((const float4*)src)[2 * i + 1];
        uint4 o; o.x = pk_bf16(a.x, a.y); o.y = pk_bf16(a.z, a.w); o.z = pk_bf16(b.x, b.y); o.w = pk_bf16(b.z, b.w);
        ((uint4*)dst)[i] = o;
    }
}

__device__ __forceinline__ void phase_inproj(const Params& p, unsigned char* lds) {
    pg8::Gemm g{p.xb, p.w_in_t, T, PWP, D};
    pg8::StaticOrder S; S.init(T, PWP, gridDim.x, blockIdx.x);
    EpiInproj E{p.qkvraw, p.dzb, p.sq, p.sk, p.vT, p.gab, p.gbb, p.small};
    pg8::gemm_phase<EpiInproj, pg8::StaticOrder, true, true>((PG8_LAS unsigned char*)lds, g, S, E);
}

__device__ __forceinline__ void load_gate16(const bf16_t* gbuf, int rb, int cb, int lane, float (&g)[16]) {
    const uint4* src = (const uint4*)(gbuf + ((size_t)(rb * 32 + cb) * 64 + lane) * 16);
    const uint4 a = src[0], b = src[1];
    const unsigned u[8] = {a.x, a.y, a.z, a.w, b.x, b.y, b.z, b.w};
#pragma unroll
    for (int i = 0; i < 8; ++i) { g[2 * i] = __uint_as_float(u[i] << 16); g[2 * i + 1] = __uint_as_float(u[i] & 0xffff0000u); }
}
__device__ __forceinline__ void phase_merge(const Params& p, unsigned char* lds) {
    run_pg8(p.oab, p.w_pa_t, T, D, DNW, lds, [&](int row, int col, pg8::f32x4 v) {
        float g[4]; unpack4(*(const uint2*)(p.gab + (size_t)row * D + col), g);
        *(pg8::f32x4*)(p.m1 + (size_t)row * D + col) = (pg8::f32x4){v[0] * g[0], v[1] * g[1], v[2] * g[2], v[3] * g[3]};
    });
    run_pg8(p.obb, p.w_pb_t, T, D, SBW, lds, [&](int row, int col, pg8::f32x4 v) {
        float g[4]; unpack4(*(const uint2*)(p.gbb + (size_t)row * D + col), g);
        const pg8::f32x4 m = *(const pg8::f32x4*)(p.m1 + (size_t)row * D + col);
        uint2 w; w.x = pk_bf16(m[0] + v[0] * g[0], m[1] + v[1] * g[1]); w.y = pk_bf16(m[2] + v[2] * g[2], m[3] + v[3] * g[3]);
        *(uint2*)(p.mergedb + (size_t)row * D + col) = w;
    });
}

__device__ __forceinline__ void phase_outproj(const Params& p, unsigned char* lds) {
    run_pg8(p.mergedb, p.w_out_t, T, D, D, lds, [&](int row, int col, pg8::f32x4 v) {
        const size_t o = (size_t)row * D + col;
        const pg8::f32x4 x = *(const pg8::f32x4*)(p.x + o);
        *(pg8::f32x4*)(p.pre1 + o) = v + x * ALPHA;
    });
}

__device__ __forceinline__ void phase_router_shared_up(const Params& p, unsigned char* lds) {
    {
        typedef GemmCfg<128, 128, 4, 2> CFG;
        TileMap tmap; tmap.init(T / 128, NE / 128);
        for (int round = 0; round < tmap.rounds; ++round) {
            int tm, tn;
            if (!tmap.get(round, tm, tn)) continue;
            LoadRowsBf16<128> al, bl;
            al.init(p.hb, D, [&](int r) { return (long long)(tm * 128 + r); });
            bl.init(p.w_router_t, D, [&](int r) { return (long long)(tn * 128 + r); });
            f32x16 acc[CFG::MI][CFG::NI];
            acc_zero<CFG>(acc);
            gemm_mainloop<CFG>(al, bl, D / 64, acc, lds);
            asm volatile("" : "+s"(tm), "+s"(tn));
            acc_foreach<CFG>(acc, [&](int r, int c, float v, int, int, int) {
                p.scores[(size_t)(tm * 128 + r) * NE + tn * 128 + c] = sigmoidf_(v);
                return v;
            });
        }
    }
    {
        typedef GemmCfg<128, 256, 2, 4> CFG;
        TileMap tmap; tmap.init(T / 128, SFF / 128);
        for (int round = 0; round < tmap.rounds; ++round) {
            int tm, tn;
            if (!tmap.get(round, tm, tn)) continue;
            LoadRowsBf16<128> al; LoadRowsBf16<256> bl;
            al.init(p.hb, D, [&](int r) { return (long long)(tm * 128 + r); });
            bl.init(p.w_su_t, D, [&](int r) { return (long long)(((r >> 5) & 1) * SFF + tn * 128 + (r >> 6) * 32 + (r & 31)); });
            f32x16 acc[CFG::MI][CFG::NI];
            acc_zero<CFG>(acc);
            gemm_mainloop<CFG>(al, bl, D / 64, acc, lds);
            asm volatile("" : "+s"(tm), "+s"(tn));
            const int tid = opaque_tid(), lane = tid & 63, wid = tid >> 6, wm = wid / CFG::WN, wn = wid % CFG::WN;
#pragma unroll
            for (int mi = 0; mi < CFG::MI; ++mi)
#pragma unroll
                for (int r = 0; r < 16; ++r) {
                    const int row = tm * 128 + wm * CFG::TM + mi * 32 + (r & 3) + 8 * (r >> 2) + 4 * (lane >> 5);
                    const int j = tn * 128 + wn * 32 + (lane & 31);
                    const float g = acc[mi][0][r], u = acc[mi][1][r];
                    p.actsh[(size_t)row * SFF + j] = to_bf16(siluf_(g) * u);
                }
        }
    }
}

__device__ __forceinline__ void phase_shared_down(const Params& p, unsigned char* lds) {
    run_pg8(p.actsh, p.w_sd_t, T, D, SFF, lds, [&](int row, int col, pg8::f32x4 v) {
        uint2 w; w.x = pk_bf16(v[0], v[1]); w.y = pk_bf16(v[2], v[3]);
        *(uint2*)(p.yshb + (size_t)row * D + col) = w;
    });
}

__device__ __forceinline__ void phase_init(const Params& p) {
    const int gtid = blockIdx.x * NT + opaque_tid(), gsz = gridDim.x * NT;
    for (int i = gtid; i < 2 * NE * CSTRIDE; i += gsz) p.counts[i] = 0;
}

__device__ __forceinline__ void sb_attn_wave(const Params& p, int bh, int qt) {
    const int lane = opaque_tid() & 63, l31 = lane & 31, lh = lane >> 5;
    const int b = bh >> 3, hh = bh & 7;
    bf16x8 qf[4];
    {
        const bf16_t* qrow = p.sq + (size_t)(b * SEQ + qt * 32 + l31) * SBW + hh * 64 + lh * 8;
#pragma unroll
        for (int ks = 0; ks < 4; ++ks) qf[ks] = *(const bf16x8*)(qrow + ks * 16);
    }
    f32x16 o0, o1;
#pragma unroll
    for (int r = 0; r < 16; ++r) { o0[r] = 0.f; o1[r] = 0.f; }
    float run = 0.f;
    const bf16_t* vbase = p.vT + ((size_t)(bh * 64 + l31)) * SEQ + lh * 8;
    for (int kt = qt; kt >= 0; --kt) {
        const bf16_t* krow = p.sk + (size_t)(b * SEQ + kt * 32 + l31) * SBW + hh * 64 + lh * 8;
        bf16x8 kf[4];
#pragma unroll
        for (int ks = 0; ks < 4; ++ks) kf[ks] = *(const bf16x8*)(krow + ks * 16);
        bf16x8 vf[2][2];
#pragma unroll
        for (int md = 0; md < 2; ++md)
#pragma unroll
            for (int ss = 0; ss < 2; ++ss) vf[md][ss] = *(const bf16x8*)(vbase + (size_t)md * 32 * SEQ + kt * 32 + ss * 16);
        f32x16 sc;
#pragma unroll
        for (int r = 0; r < 16; ++r) sc[r] = 0.f;
#pragma unroll
        for (int ks = 0; ks < 4; ++ks) sc = __builtin_amdgcn_mfma_f32_32x32x16_bf16(kf[ks], qf[ks], sc, 0, 0, 0);
        float lb[16], lr[16];
        const bool diag = (kt == qt);
#pragma unroll
        for (int r = 0; r < 16; ++r) {
            const float z = sc[r];
            const float l = __builtin_amdgcn_logf(1.f + __builtin_amdgcn_exp2f(-fabsf(z)));
            float b_ = fminf(z, 0.f) - l, r_ = b_ - z;
            if (diag) { const bool valid = ((r & 3) + 8 * (r >> 2) + 4 * lh) < l31; r_ = valid ? r_ : 0.f; b_ = valid ? b_ : -INFINITY; }
            lb[r] = b_; lr[r] = r_;
        }
        float ex[16], B[4];
#pragma unroll
        for (int g = 0; g < 4; ++g) {
            ex[4 * g + 3] = 0.f;
            ex[4 * g + 2] = lr[4 * g + 3];
            ex[4 * g + 1] = ex[4 * g + 2] + lr[4 * g + 2];
            ex[4 * g + 0] = ex[4 * g + 1] + lr[4 * g + 1];
            B[g] = ex[4 * g + 0] + lr[4 * g + 0];
        }
        float P[4];
#pragma unroll
        for (int g = 0; g < 4; ++g) P[g] = shfl_lane(B[g], lane ^ 32);
        float off[4];
        {
            const float p3 = P[3], p2 = P[2] + p3, p1 = P[1] + p2, p0 = P[0] + p1;
            const float b3 = 0.f, b2 = B[3], b1 = B[2] + b2, b0 = B[1] + b1;
            off[0] = b0 + (lh ? p1 : p0);
            off[1] = b1 + (lh ? p2 : p1);
            off[2] = b2 + (lh ? p3 : p2);
            off[3] = b3 + (lh ? 0.f : p3);
            const float total = (B[0] + b0) + p0;
#pragma unroll
            for (int g = 0; g < 4; ++g) off[g] += run;
            run += total;
        }
        float a[16];
#pragma unroll
        for (int r = 0; r < 16; ++r) a[r] = __builtin_amdgcn_exp2f(lb[r] + ex[r] + off[r >> 2]);
        bf16x8 pf[2];
#pragma unroll
        for (int ss = 0; ss < 2; ++ss) {
            typedef unsigned u32x4 __attribute__((ext_vector_type(4)));
            u32x4 w;
            w[0] = pk_bf16(a[8 * ss + 0], a[8 * ss + 1]); w[1] = pk_bf16(a[8 * ss + 2], a[8 * ss + 3]);
            w[2] = pk_bf16(a[8 * ss + 4], a[8 * ss + 5]); w[3] = pk_bf16(a[8 * ss + 6], a[8 * ss + 7]);
            pf[ss] = __builtin_bit_cast(bf16x8, w);
        }
#pragma unroll
        for (int ss = 0; ss < 2; ++ss) {
            o0 = __builtin_amdgcn_mfma_f32_32x32x16_bf16(vf[0][ss], pf[ss], o0, 0, 0, 0);
            o1 = __builtin_amdgcn_mfma_f32_32x32x16_bf16(vf[1][ss], pf[ss], o1, 0, 0, 0);
        }
        if (__all(run < -160.f)) break;
    }
    bf16_t* orow = p.obb + (size_t)(b * SEQ + qt * 32 + l31) * SBW + hh * 64 + 4 * lh;
#pragma unroll
    for (int g = 0; g < 4; ++g) {
        uint2 w0, w1;
        w0.x = pk_bf16(o0[4 * g], o0[4 * g + 1]); w0.y = pk_bf16(o0[4 * g + 2], o0[4 * g + 3]);
        w1.x = pk_bf16(o1[4 * g], o1[4 * g + 1]); w1.y = pk_bf16(o1[4 * g + 2], o1[4 * g + 3]);
        *(uint2*)(orow + 8 * g) = w0;
        *(uint2*)(orow + 32 + 8 * g) = w1;
    }
}


constexpr int DN_RW = 0, DN_RQ = 128, DN_RAT = 256, DN_RKD = 320;
constexpr float LOG2E = 1.4426950408889634f;
__device__ __forceinline__ uint4 pack8(const float* v) { uint4 o; o.x = pk_bf16(v[0], v[1]); o.y = pk_bf16(v[2], v[3]); o.z = pk_bf16(v[4], v[5]); o.w = pk_bf16(v[6], v[7]); return o; }

__device__ __forceinline__ void dn_chunk_item(const Params& p, int item, unsigned char* lds) {
    const int tid = opaque_tid(), lane = tid & 63, wid = tid >> 6;
    const int bh = item >> 5, n = item & 31, b = bh >> 2, hh = bh & 3;
    const int t0 = b * SEQ + n * 64;
    unsigned char* Kimg = lds; unsigned char* KBimg = lds + 16384; unsigned char* Qimg = lds + 32768;
    float* Vf = (float*)(lds + 49152); float* KBGf = (float*)(lds + 81920); float* MT = (float*)(lds + 114688);
    float* G2s = (float*)(lds + 114688 + 17408); float* betas = G2s + 64;
    bf16_t* blob = p.dnblob + (size_t)item * DN_BLOB;
    if (wid == 0) {
        const int t = t0 + lane;
        const float da = p.small[(size_t)t * 8 + 4 + hh] + p.dt_bias[hh];
        const float sp = da > 20.f ? da : log1pf(expf(da));
        float g2 = -expf(p.a_log[hh]) * sp * LOG2E;
#pragma unroll
        for (int off = 1; off < 64; off <<= 1) { const float v = shfl_lane(g2, lane - off); if (lane >= off) g2 += v; }
        G2s[lane] = g2; betas[lane] = sigmoidf_(p.small[(size_t)t * 8 + hh]);
        if (lane == 63) p.dnlast[item] = exp2f(g2);
    }
    __syncthreads();
    {
        const int c8 = tid & 15, tq = tid >> 4, j0 = tq * 2;
        const float G0 = G2s[j0], G1 = G2s[j0 + 1], GL = G2s[63];
        const float be[2] = {betas[j0], betas[j0 + 1]};
        const float eg[2] = {exp2f(G0), exp2f(G1)}, el[2] = {exp2f(GL - G0), exp2f(GL - G1)};
        const int half = c8 >> 3, ch = c8 & 7;
#pragma unroll
        for (int type = 0; type < 3; ++type) {
            float o[2][8];
            {
                const bf16_t* src = p.qkvraw + (size_t)(t0 + j0 - 3) * 1536 + type * 512 + hh * 128 + c8 * 8;
                float x[5][8];
#pragma unroll
                for (int r = 0; r < 5; ++r) {
                    uint4 raw = make_uint4(0, 0, 0, 0);
                    if (n > 0 || j0 - 3 + r >= 0) raw = *(const uint4*)(src + (size_t)r * 1536);
                    const unsigned u[4] = {raw.x, raw.y, raw.z, raw.w};
#pragma unroll
                    for (int i = 0; i < 4; ++i) { x[r][2 * i] = __uint_as_float(u[i] << 16); x[r][2 * i + 1] = __uint_as_float(u[i] & 0xffff0000u); }
                }
                const float* wp = p.conv_w + type * 512 + hh * 128 + c8 * 8;
#pragma unroll
                for (int i = 0; i < 8; ++i) {
                    float a0 = 0.f, a1 = 0.f;
#pragma unroll
                    for (int tap = 0; tap < 4; ++tap) { const float w = wp[tap * 1536 + i]; a0 = fmaf(x[tap][i], w, a0); a1 = fmaf(x[tap + 1][i], w, a1); }
                    o[0][i] = siluf_(a0); o[1][i] = siluf_(a1);
                }
            }
            if (type < 2) {
#pragma unroll
                for (int tk = 0; tk < 2; ++tk) {
                    float ss = 0.f;
#pragma unroll
                    for (int i = 0; i < 8; ++i) ss = fmaf(o[tk][i], o[tk][i], ss);
                    ss += shfl_lane(ss, lane ^ 1); ss += shfl_lane(ss, lane ^ 2); ss += shfl_lane(ss, lane ^ 4); ss += shfl_lane(ss, lane ^ 8);
                    float r = rsqrtf(ss + NORM_EPS);
                    if (type == 0) r *= 0.08838834764831845f;
#pragma unroll
                    for (int i = 0; i < 8; ++i) o[tk][i] *= r;
                }
            }
#pragma unroll
            for (int tk = 0; tk < 2; ++tk) {
                const int j = j0 + tk;
                const int ioff = half * 8192 + j * 128 + ((ch ^ swz(j)) << 4);
                if (type == 0) {
                    *(uint4*)(Qimg + ioff) = pack8(o[tk]);
                    float qd[8];
#pragma unroll
                    for (int i = 0; i < 8; ++i) qd[i] = o[tk][i] * eg[tk];
                    bf16_t* qrow = blob + (size_t)(DN_RQ + half * 64 + j) * 64 + ((c8 >> 1) & 3) * 16 + 4 * (c8 & 1);
                    uint2 w0, w1; w0.x = pk_bf16(qd[0], qd[1]); w0.y = pk_bf16(qd[2], qd[3]); w1.x = pk_bf16(qd[4], qd[5]); w1.y = pk_bf16(qd[6], qd[7]);
                    *(uint2*)qrow = w0; *(uint2*)(qrow + 8) = w1;
                } else if (type == 1) {
                    float kb[8], kbg[8];
#pragma unroll
                    for (int i = 0; i < 8; ++i) { kb[i] = o[tk][i] * be[tk]; kbg[i] = kb[i] * eg[tk]; }
                    *(uint4*)(Kimg + ioff) = pack8(o[tk]);
                    *(uint4*)(KBimg + ioff) = pack8(kb);
                    f32x4* kd = (f32x4*)(KBGf + j * 128 + c8 * 8); kd[0] = (f32x4){kbg[0], kbg[1], kbg[2], kbg[3]}; kd[1] = (f32x4){kbg[4], kbg[5], kbg[6], kbg[7]};
                } else {
                    float vb[8];
#pragma unroll
                    for (int i = 0; i < 8; ++i) vb[i] = o[tk][i] * be[tk];
                    f32x4* vd = (f32x4*)(Vf + j * 128 + c8 * 8); vd[0] = (f32x4){vb[0], vb[1], vb[2], vb[3]}; vd[1] = (f32x4){vb[4], vb[5], vb[6], vb[7]};
                }
            }
            if (type == 1) {
                const int jp = (j0 & 48) | pi16(j0 & 15);
#pragma unroll
                for (int i = 0; i < 8; ++i)
                    *(unsigned*)(blob + (size_t)(DN_RKD + c8 * 8 + i) * 64 + jp) = pk_bf16(o[0][i] * el[0], o[1][i] * el[1]);
            }
        }
    }
    __syncthreads();
    {
        const int which = wid >> 2, ti = (wid >> 1) & 1, tj = wid & 1, l31 = lane & 31, lh = lane >> 5;
        if (!(ti == 0 && tj == 1)) {
            const unsigned char* Ab = (which == 0 ? KBimg : Qimg) + (ti * 32 + l31) * 128;
            const unsigned char* Bb = Kimg + (tj * 32 + l31) * 128;
            const int fsw = swz(l31);
            f32x16 acc;
#pragma unroll
            for (int r = 0; r < 16; ++r) acc[r] = 0.f;
#pragma unroll
            for (int ks = 0; ks < 8; ++ks) {
                const int off = (ks >> 2) * 8192 + ((((ks & 3) * 2 + lh) ^ fsw) << 4);
                acc = __builtin_amdgcn_mfma_f32_32x32x16_bf16(*(const bf16x8*)(Ab + off), *(const bf16x8*)(Bb + off), acc, 0, 0, 0);
            }
            const int j = tj * 32 + l31;
            const float Gj = G2s[j];
#pragma unroll
            for (int r = 0; r < 16; ++r) {
                const int i = ti * 32 + (r & 3) + 8 * (r >> 2) + 4 * lh;
                const float v = acc[r] * exp2f(G2s[i] - Gj);
                if (which == 0) MT[j * 68 + i] = (i > j) ? v : 0.f;
                else blob[(size_t)(DN_RAT + i) * 64 + ((j & 48) | pi16(j & 15))] = to_bf16((i >= j) ? v : 0.f);
            }
        }
    }
    __syncthreads();
#ifndef NO_SOLVE
    if (tid < 256) {
        const int c = tid & 127;
        const float* rhs = (tid < 128 ? Vf : KBGf) + c;
        float y[64];
#pragma unroll
        for (int j = 0; j < 64; ++j) y[j] = rhs[j * 128];
#pragma unroll
        for (int j = 0; j < 63; ++j) {
            const float yj = y[j];
#pragma unroll
            for (int i4 = (j + 1) & ~3; i4 < 64; i4 += 4) {
                const f32x4 m = *(const f32x4*)(MT + j * 68 + i4);
#pragma unroll
                for (int u = 0; u < 4; ++u) if (i4 + u > j) y[i4 + u] = fmaf(-m[u], yj, y[i4 + u]);
            }
            asm volatile("" ::: "memory");
        }
        if (tid < 128) {
#pragma unroll
            for (int mi = 0; mi < 2; ++mi)
#pragma unroll
                for (int h = 0; h < 2; ++h) {
                    f32x4* dst = (f32x4*)(p.dnu + ((((size_t)item * 2 + mi) * 4 + (c >> 5)) * 64 + h * 32 + (c & 31)) * 16);
#pragma unroll
                    for (int g = 0; g < 4; ++g)
                        dst[g] = (f32x4){y[mi * 32 + 8 * g + 4 * h], y[mi * 32 + 8 * g + 4 * h + 1], y[mi * 32 + 8 * g + 4 * h + 2], y[mi * 32 + 8 * g + 4 * h + 3]};
                }
        } else {
            bf16_t* dst = blob + (size_t)(DN_RW + (c >> 6) * 64) * 64 + ((c & 48) | pi16(c & 15));
#pragma unroll
            for (int i = 0; i < 64; ++i) dst[(size_t)i * 64] = to_bf16(-y[i]);
        }
    }
#endif
    __syncthreads();
}

__device__ __forceinline__ void phase_dn_chunks(const Params& p, unsigned char* lds) {
    for (int item = blockIdx.x; item < NB * DNH * 32; item += gridDim.x) dn_chunk_item(p, item, lds);
}

__device__ __forceinline__ void dn_scan(const Params& p, int bh, unsigned char* lds) {
    const int tid = opaque_tid(), lane = tid & 63, wid = tid >> 6, l31 = lane & 31, lh = lane >> 5;
    const int b = bh >> 2, hh = bh & 3;
    const int fsw = swz(l31);
    if (wid >= 4) {
        const int lt = tid - 256;
        typedef unsigned u32x4v __attribute__((ext_vector_type(4)));
        const u32x4v* src = (const u32x4v*)(p.dnblob + (size_t)(bh * 32) * DN_BLOB) + lt;
        u32x4v lr[14];
#define DN_LOAD(n_) { _Pragma("unroll") for (int k = 0; k < 14; ++k) lr[k] = src[(size_t)(n_) * (DN_BLOB / 8) + k * 256]; }
#define DN_STORE(dst_) { _Pragma("unroll") for (int k = 0; k < 14; ++k) { const int c = lt + k * 256, row = c >> 3, ch = c & 7; \
            *(u32x4v*)((dst_) + row * 128 + ((ch ^ swz(row)) << 4)) = lr[k]; } }
        DN_LOAD(0); DN_STORE(lds); DN_LOAD(1);
        __builtin_amdgcn_s_waitcnt(0xc07f);
        __builtin_amdgcn_s_barrier();
        for (int n = 0; n < 32; ++n) {
            if (n + 1 < 32) { DN_STORE(lds + ((n + 1) & 1) * (DN_ROWS * 128)); if (n + 2 < 32) DN_LOAD(n + 2); }
            __builtin_amdgcn_s_waitcnt(0xc07f);
            __builtin_amdgcn_s_barrier();
        }
#undef DN_LOAD
#undef DN_STORE
        return;
    }
    __builtin_amdgcn_s_barrier();
    f32x16 S[4];
#pragma unroll
    for (int t = 0; t < 4; ++t)
#pragma unroll
        for (int r = 0; r < 16; ++r) S[t][r] = 0.f;
    f32x16 vn[2]; float lastn = 0.f;
    {
#pragma unroll
        for (int mi = 0; mi < 2; ++mi) vn[mi] = *(const f32x16*)(p.dnu + ((((size_t)(bh * 32) * 2 + mi) * 4 + wid) * 64 + lane) * 16);
        lastn = p.dnlast[bh * 32];
    }
    for (int n = 0; n < 32; ++n) {
        {
            const unsigned char* buf = lds + (n & 1) * (DN_ROWS * 128);
            const int item = bh * 32 + n;
            f32x16 oa[2];
#pragma unroll
            for (int mi = 0; mi < 2; ++mi)
#pragma unroll
                for (int r = 0; r < 16; ++r) oa[mi][r] = 0.f;
            const float last = lastn;
            typedef unsigned u32x4 __attribute__((ext_vector_type(4)));
            bf16x8 sb[4][2];
#pragma unroll
            for (int t = 0; t < 4; ++t)
#pragma unroll
                for (int ss = 0; ss < 2; ++ss) {
                    u32x4 w;
#pragma unroll
                    for (int q = 0; q < 4; ++q) w[q] = pk_bf16(S[t][8 * ss + 2 * q], S[t][8 * ss + 2 * q + 1]);
                    sb[t][ss] = __builtin_bit_cast(bf16x8, w);
                }
#pragma unroll
            for (int mi = 0; mi < 2; ++mi)
#pragma unroll
                for (int ks = 0; ks < 8; ++ks) {
                    const int off = ((ks >> 2) * 64 + mi * 32 + l31) * 128 + ((((ks & 3) * 2 + lh) ^ fsw) << 4);
                    vn[mi] = __builtin_amdgcn_mfma_f32_32x32x16_bf16(*(const bf16x8*)(buf + DN_RW * 128 + off), sb[ks >> 1][ks & 1], vn[mi], 0, 0, 0);
                    oa[mi] = __builtin_amdgcn_mfma_f32_32x32x16_bf16(*(const bf16x8*)(buf + DN_RQ * 128 + off), sb[ks >> 1][ks & 1], oa[mi], 0, 0, 0);
                }
            bf16x8 vb[2][2];
#pragma unroll
            for (int mj = 0; mj < 2; ++mj)
#pragma unroll
                for (int ss = 0; ss < 2; ++ss) {
                    u32x4 w;
#pragma unroll
                    for (int q = 0; q < 4; ++q) w[q] = pk_bf16(vn[mj][8 * ss + 2 * q], vn[mj][8 * ss + 2 * q + 1]);
                    vb[mj][ss] = __builtin_bit_cast(bf16x8, w);
                }
            {
                const int nx = (n + 1 < 32) ? item + 1 : item;
#pragma unroll
                for (int mi = 0; mi < 2; ++mi) vn[mi] = *(const f32x16*)(p.dnu + ((((size_t)nx * 2 + mi) * 4 + wid) * 64 + lane) * 16);
                lastn = p.dnlast[nx];
            }
#pragma unroll
            for (int mi = 0; mi < 2; ++mi)
#pragma unroll
                for (int kj = 0; kj < 4; ++kj)
                    if ((kj >> 1) <= mi) {
                        const int off = (DN_RAT + mi * 32 + l31) * 128 + (((kj * 2 + lh) ^ fsw) << 4);
                        oa[mi] = __builtin_amdgcn_mfma_f32_32x32x16_bf16(*(const bf16x8*)(buf + off), vb[kj >> 1][kj & 1], oa[mi], 0, 0, 0);
                    }
#pragma unroll
            for (int t = 0; t < 4; ++t) {
#pragma unroll
                for (int r = 0; r < 16; ++r) S[t][r] *= last;
#pragma unroll
                for (int kj = 0; kj < 4; ++kj) {
                    const int off = (DN_RKD + t * 32 + l31) * 128 + (((kj * 2 + lh) ^ fsw) << 4);
                    S[t] = __builtin_amdgcn_mfma_f32_32x32x16_bf16(*(const bf16x8*)(buf + off), vb[kj >> 1][kj & 1], S[t], 0, 0, 0);
                }
            }
            float* orow = p.oraw + (size_t)(b * SEQ + n * 64) * DNW + hh * 128 + wid * 32 + l31;
#pragma unroll
            for (int mi = 0; mi < 2; ++mi)
#pragma unroll
                for (int r = 0; r < 16; ++r) orow[(size_t)(mi * 32 + (r & 3) + 8 * (r >> 2) + 4 * lh) * DNW] = oa[mi][r];
        }
        __builtin_amdgcn_s_waitcnt(0xc07f);
        __builtin_amdgcn_s_barrier();
    }
}

__device__ __forceinline__ void phase_mixers(const Params& p, float* smem) {
    const int nscan = NB * DNH;
    if (gridDim.x >= 2 * nscan) {
#ifndef SKIP_SCAN
        if ((int)blockIdx.x < nscan) dn_scan(p, blockIdx.x, (unsigned char*)smem);
#endif
        if ((int)blockIdx.x < nscan) {}
        else {
            for (int it = blockIdx.x - nscan; it < 512; it += gridDim.x - nscan) sb_attn_wave(p, it >> 3, (it & 7) * 8 + (opaque_tid() >> 6));
        }
    } else {
#ifndef SKIP_SCAN
        for (int bh = blockIdx.x; bh < nscan; bh += gridDim.x) dn_scan(p, bh, (unsigned char*)smem);
#endif
        for (int it = blockIdx.x; it < 512; it += gridDim.x) sb_attn_wave(p, it >> 3, (it & 7) * 8 + (opaque_tid() >> 6));
    }
}

__device__ __forceinline__ void phase_gated_norm(const Params& p) {
    const int lane = opaque_tid() & 63, wave = (blockIdx.x * NT + opaque_tid()) >> 6, nw = (gridDim.x * NT) >> 6;
    for (int item = wave; item < T * 4; item += nw) {
        const int t = item >> 2, hh = item & 3;
        const size_t off = (size_t)t * DNW + hh * 128 + lane * 2;
        const float v0 = p.oraw[off], v1 = p.oraw[off + 1];
        const float ss = wave_sum(v0 * v0 + v1 * v1, lane);
        const float r = rsqrtf(ss * (1.f / 128.f) + NORM_EPS);
        const float z0 = bf2f(p.dzb[(size_t)t * 512 + hh * 128 + lane * 2]), z1 = bf2f(p.dzb[(size_t)t * 512 + hh * 128 + lane * 2 + 1]);
        p.oab[off] = to_bf16(v0 * r * p.norm_g[lane * 2] * siluf_(z0));
        p.oab[off + 1] = to_bf16(v1 * r * p.norm_g[lane * 2 + 1] * siluf_(z1));
    }
}

template <class SF>
__device__ __forceinline__ void layer_norm_rows(SF sf, const float* g, const float* bb, float* dst, bf16_t* dstb) {
    const int lane = opaque_tid() & 63, wave = (blockIdx.x * NT + opaque_tid()) >> 6, nw = (gridDim.x * NT) >> 6;
    for (int t = wave; t < T; t += nw) {
        float v[16];
        float s = 0.f;
#pragma unroll
        for (int i = 0; i < 16; ++i) { v[i] = sf(t, lane + i * 64); s += v[i]; }
        const float mu = wave_sum(s, lane) * (1.f / 1024.f);
        float q = 0.f;
#pragma unroll
        for (int i = 0; i < 16; ++i) { const float d = v[i] - mu; q += d * d; }
        const float rstd = rsqrtf(wave_sum(q, lane) * (1.f / 1024.f) + LN_EPS);
#pragma unroll
        for (int i = 0; i < 16; ++i) { const int c = lane + i * 64; const float y = (v[i] - mu) * rstd * g[c] + bb[c]; if (dst) dst[(size_t)t * D + c] = y; if (dstb) dstb[(size_t)t * D + c] = to_bf16(y); }
    }
}

__device__ __forceinline__ void phase_route(const Params& p, int* counts, int* explist, int* ldsw) {
    const int tid = opaque_tid(), lane = tid & 63;
    const int wave = (blockIdx.x * NT + tid) >> 6, nw = (gridDim.x * NT) >> 6;
    int* mye = ldsw + (tid >> 6) * 64;
    const f32x4 bias = *(const f32x4*)(p.router_bias + lane * 4);
    for (int t0 = wave; t0 < T; t0 += nw * 8) {
        f32x4 scs[8];
#pragma unroll
        for (int k = 0; k < 8; ++k) { const int t = t0 + k * nw; scs[k] = t < T ? *(const f32x4*)(p.scores + (size_t)t * NE + lane * 4) : (f32x4){0.f, 0.f, 0.f, 0.f}; }
#pragma unroll 1
        for (int k = 0; k < 8; ++k) {
            const int t = t0 + k * nw;
            if (t >= T) break;
            f32x4 sc = scs[0];
#pragma unroll
            for (int kk = 1; kk < 8; ++kk) sc = (k == kk) ? scs[kk] : sc;
            const float sel[4] = {sc[0] + bias[0], sc[1] + bias[1], sc[2] + bias[2], sc[3] + bias[3]};
            float m1 = fmaxf(sel[0], sel[1]), m2 = fminf(sel[0], sel[1]);
            m2 = fmaxf(m2, fminf(m1, sel[2])); m1 = fmaxf(m1, sel[2]);
            m2 = fmaxf(m2, fminf(m1, sel[3])); m1 = fmaxf(m1, sel[3]);
#pragma unroll
            for (int off = 1; off < 8; off <<= 1) {
                const float o1 = shfl_lane(m1, lane ^ off), o2 = shfl_lane(m2, lane ^ off);
                const float n2 = fmaxf(fminf(m1, o1), fmaxf(m2, o2));
                m1 = fmaxf(m1, o1); m2 = n2;
            }
            const float gs = m1 + m2;
            const int g = lane >> 3;
            int rank = 0;
#pragma unroll
            for (int gg = 0; gg < NG; ++gg) { const float og = __int_as_float(__builtin_amdgcn_readlane(__float_as_int(gs), gg * 8)); rank += (og > gs || (og == gs && gg < g)) ? 1 : 0; }
            const bool gsel = rank < TOPG;
            unsigned ku[4];
#pragma unroll
            for (int i = 0; i < 4; ++i) {
                const unsigned u = __float_as_uint(sel[i]);
                ku[i] = gsel ? ((u & 0x80000000u) ? ~u : (u | 0x80000000u)) : 0u;
            }
            unsigned v8 = 0u;
#pragma unroll 1
            for (int bit = 31; bit >= 0; --bit) {
                const unsigned cand = v8 | (1u << bit);
                const int c = __popcll(__ballot(ku[0] >= cand)) + __popcll(__ballot(ku[1] >= cand)) + __popcll(__ballot(ku[2] >= cand)) + __popcll(__ballot(ku[3] >= cand));
                if (c >= TOPK) v8 = cand;
            }
            int ngt = 0, eqlow = 0, sellow = 0;
            unsigned long long eqm[4];
#pragma unroll
            for (int i = 0; i < 4; ++i) { ngt += __popcll(__ballot(ku[i] > v8)); eqm[i] = __ballot(ku[i] == v8); }
            const int need = TOPK - ngt;
#pragma unroll
            for (int i = 0; i < 4; ++i) eqlow += __builtin_amdgcn_mbcnt_hi((unsigned)(eqm[i] >> 32), __builtin_amdgcn_mbcnt_lo((unsigned)eqm[i], 0u));
            bool selc[4]; int eqrank = eqlow;
#pragma unroll
            for (int i = 0; i < 4; ++i) {
                const bool eq = ku[i] == v8;
                selc[i] = (ku[i] > v8) || (eq && eqrank < need);
                eqrank += eq ? 1 : 0;
            }
            float part = 0.f;
#pragma unroll
            for (int i = 0; i < 4; ++i) {
                const unsigned long long sm = __ballot(selc[i]);
                part += selc[i] ? sc[i] : 0.f;
                sellow += __builtin_amdgcn_mbcnt_hi((unsigned)(sm >> 32), __builtin_amdgcn_mbcnt_lo((unsigned)sm, 0u));
            }
            const float wsum = wave_sum(part, lane);
            int slot = sellow;
#pragma unroll
            for (int i = 0; i < 4; ++i)
                if (selc[i]) {
                    const int e = lane * 4 + i, pr = t * TOPK + slot;
                    p.gate[pr] = sc[i] / wsum * 2.5f;
                    mye[k * 8 + slot] = e;
                    ++slot;
                }
        }
        {
            const int k = lane >> 3, t = t0 + k * nw;
            if (t < T) {
                const int e = mye[lane], pos = atomicAdd(&counts[e * CSTRIDE], 1);
                explist[(size_t)e * ECAP + pos] = t * TOPK + (lane & 7);
            }
        }
    }
}

__device__ __forceinline__ void compute_pend(const Params& p, int* pend, int* cnt) {
    const int tid = opaque_tid();
    if (tid < 64) {
        int c[4], pc[4];
#pragma unroll
        for (int i = 0; i < 4; ++i) { c[i] = p.counts[(tid * 4 + i) * CSTRIDE]; cnt[tid * 4 + i] = c[i]; pc[i] = (c[i] + 127) / 128 * 128; }
        const int ssum = pc[0] + pc[1] + pc[2] + pc[3];
        int inc = ssum;
#pragma unroll
        for (int off = 1; off < 64; off <<= 1) { const int v = shfl_lane_i(inc, tid - off); if (tid >= off) inc += v; }
        int run = inc - ssum;
#pragma unroll
        for (int i = 0; i < 4; ++i) { run += pc[i]; pend[tid * 4 + i] = run; }
    }
    __syncthreads();
}

__device__ __forceinline__ int expert_of_row(const int* pend, int row) {
    int lo = 0, hi = NE - 1;
    while (lo < hi) { const int mid = (lo + hi) >> 1; if (pend[mid] > row) hi = mid; else lo = mid + 1; }
    return lo;
}

__device__ __forceinline__ void phase_routed(const Params& p, int* pend, int* cnt, unsigned char* lds) {
    typedef GemmCfg<128, 256, 2, 4> CFG;
    compute_pend(p, pend, cnt);
    int* prs = (int*)(lds + 131072); float* gts = (float*)(lds + 131072 + 512);
    const bool grouped = (gridDim.x % 8) == 0;
    const int xg = grouped ? (blockIdx.x & 7) : 0, estep = grouped ? 8 : 1;
    const int nslots = grouped ? (gridDim.x >> 3) : gridDim.x;
    int widx = grouped ? (blockIdx.x >> 3) : blockIdx.x, tbase = 0;
    for (int e = xg; e < NE; e += estep) {
      const int ce = cnt[e], ntile = (ce + 127) >> 7;
      for (; widx < tbase + ntile; widx += nslots) {
        const int q0 = (widx - tbase) * 128;
        {
            const int tid = opaque_tid();
            if (tid < 128) {
                const int pr = (q0 + tid < ce) ? p.explist[(size_t)e * ECAP + q0 + tid] : -1;
                prs[tid] = pr; gts[tid] = pr >= 0 ? p.gate[pr] : 0.f;
            }
        }
        __syncthreads();
#pragma unroll 1
        for (int tn_ = 0; tn_ < 2 * RU; ++tn_) {
            const int tn = tn_ & 1;
            LoadRowsBf16<128> al[2]; LoadKNF32 bl[2];
#pragma unroll
            for (int u = 0; u < 2; ++u) {
                al[u].init(p.hb, D, [&](int r) { const int pr = prs[r]; return (long long)(pr >= 0 ? (pr >> 3) : 0); });
                bl[u].init(p.w_eu + (size_t)e * D * (2 * EFF), 2 * EFF, [&](int r) { return ((r >> 5) & 1) * EFF + tn * 128 + (r >> 6) * 32 + (r & 31); });
            }
            f32x16 acc[CFG::MI][CFG::NI];
            acc_zero<CFG>(acc);
            gemm_mainloop2<CFG, false, 0, false>(al, bl, D / 64, acc, lds, nullptr);
            const int tid = opaque_tid(), lane = tid & 63, wid = tid >> 6, wm = wid / CFG::WN, wn = wid % CFG::WN;
            const int j = tn * 128 + wn * 32 + (lane & 31);
            unsigned char* img = lds + 65536 + (((j >> 6) + 2) & 3) * 16384 + (j & 7) * 2;
            const int jc = (j & 63) >> 3;
#pragma unroll
            for (int mi = 0; mi < CFG::MI; ++mi)
#pragma unroll
                for (int r = 0; r < 16; ++r) {
                    const int row = wm * CFG::TM + mi * 32 + (r & 3) + 8 * (r >> 2) + 4 * (lane >> 5);
                    *(bf16_t*)(img + row * 128 + ((jc ^ swz(row)) << 4)) = to_bf16(siluf_(acc[mi][0][r]) * acc[mi][1][r]);
                }
        }
        __syncthreads();
#pragma unroll 1
        for (int tn_ = 0; tn_ < 4 * RD; ++tn_) {
            const int tn = tn_ & 3;
            LoadRowsBf16<128> aldummy[2]; LoadKNF32 bl[2];
#pragma unroll
            for (int u = 0; u < 2; ++u) bl[u].init(p.w_ed + (size_t)e * EFF * D, D, [&](int r) { return tn * 256 + r; });
            f32x16 acc[CFG::MI][CFG::NI];
            acc_zero<CFG>(acc);
            gemm_mainloop2<CFG, true, 2, true>(aldummy, bl, EFF / 64, acc, lds, lds + 65536);
            {
                const int tid = opaque_tid(), lane = tid & 63, wid = tid >> 6, wm = wid / CFG::WN, wn = wid % CFG::WN;
#pragma unroll
                for (int mi = 0; mi < CFG::MI; ++mi) {
                    const int row = wm * CFG::TM + mi * 32 + (lane & 31);
                    const int pr = prs[row]; const float g = gts[row];
                    if (pr >= 0) {
#pragma unroll
                        for (int ni = 0; ni < CFG::NI; ++ni) {
                            bf16_t* dst = p.ypairb + (size_t)pr * D + tn * 256 + wn * CFG::TN + ni * 32 + 4 * (lane >> 5);
#pragma unroll
                            for (int gq = 0; gq < 4; ++gq) {
                                uint2 w; w.x = pk_bf16(acc[mi][ni][4 * gq] * g, acc[mi][ni][4 * gq + 1] * g); w.y = pk_bf16(acc[mi][ni][4 * gq + 2] * g, acc[mi][ni][4 * gq + 3] * g);
                                *(uint2*)(dst + 8 * gq) = w;
                            }
                        }
                    }
                }
            }
        }
        __syncthreads();
      }
      tbase += ntile;
    }
}

#ifndef R0
#define R0 1
#define R1 1
#define R2 1
#define R3 1
#define R4 1
#define R5 1
#define R6 1
#define R7 1
#define R8 1
#define R10 1
#define R11 1
#define R12 1
#endif

constexpr int LDS_MAIN = 133120;
__global__ void __launch_bounds__(NT) fwd_megakernel(KArgs ka) {
    __shared__ __attribute__((aligned(16))) unsigned char lds[LDS_MAIN + 2 * NE * 4 + 16];
    float* smem = (float*)lds;
    int* pend = (int*)(lds + LDS_MAIN);
    int* cnt = pend + NE;
    volatile LAS3 unsigned* xbst = (volatile LAS3 unsigned*)(lds + LDS_MAIN + 2 * NE * 4);
    if (threadIdx.x == 0) { xbst[0] = 0u; xbst[1] = 0u; }
    __syncthreads();
    const XcdBarrier xb = xcd_barrier_post((unsigned*)(ka.ws + OFF_BAR), xbst);

#define REPEAT(N, ...) { int reps_ = (N); asm volatile("" : "+s"(reps_)); for (int rep_ = 0; rep_ < reps_; ++rep_) { { const Params p(ka); __VA_ARGS__; } xcd_barrier(xb); } }
    { const Params p(ka); phase_init(p); }
    REPEAT(R0,
        convert_bf16(p.x, p.xb, (size_t)T * D);
        transpose_convert(p.w_in, D, PW, PWP, p.w_in_t, smem, [](int n) { return n < 2048 ? n : n < 5632 ? n + 8 : n < 5640 ? n - 5632 + 2048 : -1; });
        transpose_convert(p.w_pa, DNW, D, D, p.w_pa_t, smem, [](int n) { return n; });
        transpose_convert(p.w_pb, SBW, D, D, p.w_pb_t, smem, [](int n) { return n; });
        transpose_convert(p.w_out, D, D, D, p.w_out_t, smem, [](int n) { return n; });
        transpose_convert(p.w_router, D, NE, NE, p.w_router_t, smem, [](int n) { return n; });
        transpose_convert(p.w_su, D, 2 * SFF, 2 * SFF, p.w_su_t, smem, [](int n) { return n; });
        transpose_convert(p.w_sd, SFF, D, D, p.w_sd_t, smem, [](int n) { return n; }))
    REPEAT(R1, phase_inproj(p, lds))
    REPEAT(R2, phase_dn_chunks(p, lds))
    REPEAT(R3, phase_mixers(p, smem))
    REPEAT(R4, phase_gated_norm(p))
    REPEAT(R5, phase_merge(p, lds))
    REPEAT(R6, phase_outproj(p, lds))
    REPEAT(R7, layer_norm_rows([&](int t, int c) { return p.pre1[(size_t)t * D + c]; }, p.ln1_g, p.ln1_b, nullptr, p.hb))
    REPEAT(R8, phase_router_shared_up(p, lds))
    { const Params p(ka); phase_route(p, p.counts, p.explist, (int*)lds); }
    xcd_barrier(xb);
    { int reps9 = R9 - 1; asm volatile("" : "+s"(reps9)); for (int r9 = 0; r9 < reps9; ++r9) { const Params p(ka); phase_route(p, p.counts + NE * CSTRIDE, (int*)p.ypairb, (int*)lds); xcd_barrier(xb); } }
    { int repsb = RB; asm volatile("" : "+s"(repsb)); for (int rb = 0; rb < repsb; ++rb) xcd_barrier(xb); }
    REPEAT(R10, phase_routed(p, pend, cnt, lds); phase_shared_down(p, lds))
    int reps12 = R12; asm volatile("" : "+s"(reps12));
    for (int rep = 0; rep < reps12; ++rep) {
        const Params p(ka);
        layer_norm_rows([&](int t, int c) {
                float f = bf2f(p.yshb[(size_t)t * D + c]);
#pragma unroll
                for (int k = 0; k < TOPK; ++k) f += bf2f(p.ypairb[((size_t)t * TOPK + k) * D + c]);
                return ALPHA * bf2f(p.hb[(size_t)t * D + c]) + f; },
            p.ln2_g, p.ln2_b, p.out, nullptr);
    }
}

extern "C" void kernel_launch(void* const* d_in, const int* in_sizes, int n_in, void* d_out, int out_size, void* d_ws,
                              size_t ws_size, hipStream_t stream) {
    static int grid_blocks = 0;
    if (!grid_blocks) {
        int dev = 0, cus = 0, per_cu = 0;
        hipGetDevice(&dev);
        hipDeviceGetAttribute(&cus, hipDeviceAttributeMultiprocessorCount, dev);
        hipOccupancyMaxActiveBlocksPerMultiprocessor(&per_cu, fwd_megakernel, NT, 0);
        if (per_cu > 1) per_cu = 1;
        grid_blocks = cus * per_cu;
    }
    KArgs p{};
    const float* const* in = (const float* const*)d_in;
    p.x = in[0]; p.w_in = in[1]; p.conv_w = in[2]; p.a_log = in[3]; p.dt_bias = in[4]; p.norm_g = in[5]; p.w_pa = in[6];
    p.w_pb = in[7]; p.w_out = in[8]; p.ln1_g = in[9]; p.ln1_b = in[10]; p.w_router = in[11]; p.router_bias = in[12];
    p.w_su = in[13]; p.w_sd = in[14]; p.w_eu = in[15]; p.w_ed = in[16]; p.ln2_g = in[17]; p.ln2_b = in[18];
    p.out = (float*)d_out; p.ws = (unsigned char*)d_ws;
    if (WS_BYTES > ws_size) { fprintf(stderr, "workspace too small: need %zu have %zu\n", (size_t)WS_BYTES, ws_size); return; }
    hipMemsetAsync(p.ws + OFF_BAR, 0, XCD_BAR_WORDS * 4, stream);
    void* args[] = {&p};
    hipError_t e = hipLaunchCooperativeKernel((void*)fwd_megakernel, dim3(grid_blocks), dim3(NT), args, 0, stream);
    if (e != hipSuccess) fprintf(stderr, "cooperative launch failed: %s (grid %d)\n", hipGetErrorString(e), grid_blocks);
}
```

```cpp
#include <hip/hip_runtime.h>
#include <hip/hip_cooperative_groups.h>
#include <cstdio>
#include <cstdint>
namespace cg = cooperative_groups;

constexpr int D = 1024, NB = 8, SEQ = 2048, T = NB * SEQ;
constexpr int DNH = 4, DND = 128, DNW = 512;
constexpr int SBH = 8, SBD = 64, SBW = 512;
constexpr int NE = 256, TOPK = 8, NG = 8, TOPG = 4, EFF = 256, SFF = 256;
constexpr int PW = 5640;
constexpr int NPAIR = T * TOPK;
constexpr int NBLK = (NPAIR + NE * 127 + 127) / 128;
constexpr int PROWS = NBLK * 128;
constexpr float ALPHA = 1.189207115002721f;
constexpr float LN_EPS = 1e-5f, NORM_EPS = 1e-6f;
constexpr int NT = 512;
#ifndef RU
#define RU 1
#define RD 1
#define R9 1
#define RB 0
#endif

typedef unsigned short bf16_t;
constexpr int PWP = 5888;
constexpr int DN_ROWS = 448, DN_BLOB = DN_ROWS * 64;
constexpr int ECAP = T;
#define XCD_BAR_WORDS 3456
constexpr int CSTRIDE = 64;
constexpr size_t al256(size_t x) { return (x + 255) & ~(size_t)255; }
constexpr size_t OFF_XB = 0;
constexpr size_t OFF_WINT = OFF_XB + al256((size_t)T * D * 2);
constexpr size_t OFF_QKVRAW = OFF_WINT + al256((size_t)PWP * D * 2);
constexpr size_t OFF_DZB = OFF_QKVRAW + al256((size_t)T * 1536 * 2);
constexpr size_t OFF_SQ = OFF_DZB + al256((size_t)T * 512 * 2);
constexpr size_t OFF_SK = OFF_SQ + al256((size_t)T * 512 * 2);
constexpr size_t OFF_VT = OFF_SK + al256((size_t)T * 512 * 2);
constexpr size_t OFF_DNBLOB = OFF_VT + al256((size_t)T * 512 * 2);
constexpr size_t OFF_DNU = OFF_DNBLOB + al256((size_t)1024 * DN_BLOB * 2);
constexpr size_t OFF_DNLAST = OFF_DNU + al256((size_t)1024 * 64 * 128 * 4);
constexpr size_t OFF_GAB = OFF_DNLAST + al256(1024 * 4);
constexpr size_t OFF_GBB = OFF_GAB + al256((size_t)T * D * 2);
constexpr size_t OFF_SMALL = OFF_GBB + al256((size_t)T * D * 2);
constexpr size_t OFF_WPAT = OFF_SMALL + al256((size_t)T * 8 * 4);
constexpr size_t OFF_WPBT = OFF_WPAT + al256((size_t)D * DNW * 2);
constexpr size_t OFF_WOUTT = OFF_WPBT + al256((size_t)D * SBW * 2);
constexpr size_t OFF_WROUTT = OFF_WOUTT + al256((size_t)D * D * 2);
constexpr size_t OFF_WSUT = OFF_WROUTT + al256((size_t)NE * D * 2);
constexpr size_t OFF_WSDT = OFF_WSUT + al256((size_t)2 * SFF * D * 2);
constexpr size_t OFF_OAB = OFF_WSDT + al256((size_t)D * SFF * 2);
constexpr size_t OFF_OBB = OFF_OAB + al256((size_t)T * DNW * 2);
constexpr size_t OFF_MERGED = OFF_OBB + al256((size_t)T * SBW * 2);
constexpr size_t OFF_HB = OFF_MERGED + al256((size_t)T * D * 2);
constexpr size_t OFF_ACTSH = OFF_HB + al256((size_t)T * D * 2);
constexpr size_t OFF_YPAIRB = OFF_ACTSH + al256((size_t)T * SFF * 2);
constexpr size_t OFF_ORAW = OFF_YPAIRB + al256((size_t)NPAIR * D * 2);
constexpr size_t OFF_PRE1 = OFF_ORAW + al256((size_t)T * DNW * 4);
constexpr size_t OFF_H = OFF_PRE1 + al256((size_t)T * D * 4);
constexpr size_t OFF_SCORES = OFF_H + al256((size_t)T * D * 4);
constexpr size_t OFF_GATE = OFF_SCORES + al256((size_t)T * NE * 4);
constexpr size_t OFF_YSH = OFF_GATE + al256((size_t)NPAIR * 4);
constexpr size_t OFF_IDX = OFF_YSH + al256((size_t)T * D * 4);
constexpr size_t OFF_COUNTS = OFF_IDX + al256((size_t)NPAIR * 4);
constexpr size_t OFF_EXPLIST = OFF_COUNTS + al256(2 * NE * CSTRIDE * 4);
constexpr size_t OFF_WEUT = OFF_EXPLIST + al256((size_t)NE * ECAP * 4);
constexpr size_t OFF_M1 = OFF_WEUT + al256((size_t)NE * 2 * EFF * D * 2);
constexpr size_t OFF_BAR = OFF_M1 + al256((size_t)T * D * 4);
constexpr size_t WS_BYTES = OFF_BAR + al256(XCD_BAR_WORDS * 4);

struct KArgs {
    const float *x, *w_in, *conv_w, *a_log, *dt_bias, *norm_g, *w_pa, *w_pb, *w_out, *ln1_g, *ln1_b, *w_router,
        *router_bias, *w_su, *w_sd, *w_eu, *w_ed, *ln2_g, *ln2_b;
    float* out; unsigned char* ws;
};
struct Params {
    const float *x, *w_in, *conv_w, *a_log, *dt_bias, *norm_g, *w_pa, *w_pb, *w_out, *ln1_g, *ln1_b, *w_router,
        *router_bias, *w_su, *w_sd, *w_eu, *w_ed, *ln2_g, *ln2_b;
    float* out;
    float *oraw, *pre1, *h, *scores, *gate, *ysh, *small, *dnu, *dnlast, *m1;
    int *idx, *counts, *explist;
    bf16_t *xb, *w_in_t, *w_pa_t, *w_pb_t, *w_out_t, *w_router_t, *w_su_t, *w_sd_t, *oab, *obb, *mergedb, *hb, *actsh, *ypairb, *yshb;
    bf16_t *qkvraw, *dzb, *sq, *sk, *vT, *gab, *gbb, *dnblob, *w_eu_t;
    unsigned* bar;
    __device__ __forceinline__ explicit Params(const KArgs& k) {
        x = k.x; w_in = k.w_in; conv_w = k.conv_w; a_log = k.a_log; dt_bias = k.dt_bias; norm_g = k.norm_g; w_pa = k.w_pa; w_pb = k.w_pb;
        w_out = k.w_out; ln1_g = k.ln1_g; ln1_b = k.ln1_b; w_router = k.w_router; router_bias = k.router_bias; w_su = k.w_su; w_sd = k.w_sd;
        w_eu = k.w_eu; w_ed = k.w_ed; ln2_g = k.ln2_g; ln2_b = k.ln2_b; out = k.out;
        unsigned char* w = k.ws; asm volatile("" : "+s"(w));
        xb = (bf16_t*)(w + OFF_XB); w_in_t = (bf16_t*)(w + OFF_WINT); qkvraw = (bf16_t*)(w + OFF_QKVRAW); dzb = (bf16_t*)(w + OFF_DZB);
        sq = (bf16_t*)(w + OFF_SQ); sk = (bf16_t*)(w + OFF_SK); vT = (bf16_t*)(w + OFF_VT); dnblob = (bf16_t*)(w + OFF_DNBLOB);
        dnu = (float*)(w + OFF_DNU); dnlast = (float*)(w + OFF_DNLAST); gab = (bf16_t*)(w + OFF_GAB); gbb = (bf16_t*)(w + OFF_GBB);
        small = (float*)(w + OFF_SMALL); w_pa_t = (bf16_t*)(w + OFF_WPAT); w_pb_t = (bf16_t*)(w + OFF_WPBT); w_out_t = (bf16_t*)(w + OFF_WOUTT);
        w_router_t = (bf16_t*)(w + OFF_WROUTT); w_su_t = (bf16_t*)(w + OFF_WSUT); w_sd_t = (bf16_t*)(w + OFF_WSDT);
        oab = (bf16_t*)(w + OFF_OAB); obb = (bf16_t*)(w + OFF_OBB); mergedb = (bf16_t*)(w + OFF_MERGED); hb = (bf16_t*)(w + OFF_HB);
        actsh = (bf16_t*)(w + OFF_ACTSH); ypairb = (bf16_t*)(w + OFF_YPAIRB); oraw = (float*)(w + OFF_ORAW); pre1 = (float*)(w + OFF_PRE1);
        h = (float*)(w + OFF_H); scores = (float*)(w + OFF_SCORES); gate = (float*)(w + OFF_GATE); ysh = (float*)(w + OFF_YSH); yshb = (bf16_t*)(w + OFF_YSH);
        idx = (int*)(w + OFF_IDX); counts = (int*)(w + OFF_COUNTS); explist = (int*)(w + OFF_EXPLIST); bar = (unsigned*)(w + OFF_BAR); w_eu_t = (bf16_t*)(w + OFF_WEUT); m1 = (float*)(w + OFF_M1);
    }
};

__device__ __forceinline__ float sigmoidf_(float v) { return 1.f / (1.f + expf(-v)); }
__device__ __forceinline__ float siluf_(float v) { return v / (1.f + expf(-v)); }
__device__ __forceinline__ float shfl_lane(float v, int src) { return __int_as_float(__builtin_amdgcn_ds_bpermute(src << 2, __float_as_int(v))); }
__device__ __forceinline__ int shfl_lane_i(int v, int src) { return __builtin_amdgcn_ds_bpermute(src << 2, v); }
__device__ __forceinline__ float wave_sum(float v, int lane) {
#pragma unroll
    for (int o = 32; o > 0; o >>= 1) v += shfl_lane(v, lane ^ o);
    return v;
}


#define XB_TMO      128
#define XB_XCNT(j)  (256  + 64 * (j))
#define XB_XSUB(j)  (1280 + 64 * (j))
#define XB_XGEN(j)  (2304 + 64 * (j))
#define XB_TOP      3328
#define XB_TOPGEN   3392
#define XB_SPIN_CAP (1u << 24)
#define LAS3 __attribute__((address_space(3)))
__device__ __forceinline__ unsigned xb_ld(unsigned* p)              { return __hip_atomic_load(p, __ATOMIC_RELAXED, __HIP_MEMORY_SCOPE_AGENT); }
__device__ __forceinline__ unsigned xb_add(unsigned* p, unsigned v) { return __hip_atomic_fetch_add(p, v, __ATOMIC_RELAXED, __HIP_MEMORY_SCOPE_AGENT); }
__device__ __forceinline__ unsigned xb_xcc_id() { return (unsigned)__builtin_amdgcn_s_getreg((3 << 11) | 20) & 0xFu; }
#define XB_SPIN(cond, bar) do { unsigned _sp = 0; while (cond) { __builtin_amdgcn_s_sleep(1); \
    if ((++_sp & 255u) == 0u) { if (xb_ld(&(bar)[XB_TMO])) break; if (_sp > XB_SPIN_CAP) { atomicAdd(&(bar)[XB_TMO], 1u); break; } } } } while (0)
struct XcdBarrier { unsigned* bar; unsigned x; volatile LAS3 unsigned* st; };
__device__ __forceinline__ XcdBarrier xcd_barrier_post(unsigned* bar, volatile LAS3 unsigned* st) {
    XcdBarrier b; b.bar = bar; b.x = xb_xcc_id(); b.st = st;
    if (threadIdx.x == 0) (void)xb_add(&bar[XB_XCNT(b.x)], 1u);
    return b;
}
__device__ __forceinline__ void xcd_barrier_complete(unsigned* bar, unsigned x, unsigned& nloc, unsigned& nx) {
    const unsigned G = gridDim.x * gridDim.y * gridDim.z;
    unsigned sum, cnt, mine, sp = 0u;
    asm volatile("" : "+s"(x));
    for (;;) {
        sum = 0u; cnt = 0u; mine = 0u;
#pragma unroll 1
        for (unsigned j = 0; j < 16; ++j) { const unsigned c = xb_ld(&bar[XB_XCNT(j)]); sum += c; cnt += (c > 0u) ? 1u : 0u; mine = (j == x) ? c : mine; }
        if (sum == G) break;
        __builtin_amdgcn_s_sleep(1);
        if ((++sp & 255u) == 0u) { if (xb_ld(&bar[XB_TMO])) break; if (sp > XB_SPIN_CAP) { atomicAdd(&bar[XB_TMO], 1u); break; } }
    }
    nloc = mine > 0u ? mine : 1u; nx = cnt > 0u ? cnt : 1u;
}
__device__ __forceinline__ void xcd_barrier(const XcdBarrier& b) {
    asm volatile("s_waitcnt vmcnt(0)" ::: "memory");
    __syncthreads();
    if (threadIdx.x == 0) {
        unsigned* bar = b.bar;
        __builtin_amdgcn_s_waitcnt(0);
        unsigned nloc = b.st[0], nx = b.st[1];
        if (nloc == 0u) { xcd_barrier_complete(bar, b.x, nloc, nx); b.st[0] = nloc; b.st[1] = nx; }
        const unsigned old = xb_add(&bar[XB_XSUB(b.x)], 1u);
        const unsigned gen = old / nloc;
        if (old + 1u == (gen + 1u) * nloc) {
            __builtin_amdgcn_fence(__ATOMIC_RELEASE, "agent");
            asm volatile("s_waitcnt vmcnt(0)" ::: "memory");
            const unsigned og = xb_add(&bar[XB_TOP], 1u);
            const unsigned tg = og / nx;
            if (og + 1u == (tg + 1u) * nx) xb_add(&bar[XB_TOPGEN], 1u);
            else XB_SPIN(xb_ld(&bar[XB_TOPGEN]) == tg, bar);
            __builtin_amdgcn_fence(__ATOMIC_ACQUIRE, "agent");
            xb_add(&bar[XB_XGEN(b.x)], 1u);
            asm volatile("s_waitcnt vmcnt(0)" ::: "memory");
        } else {
            XB_SPIN(xb_ld(&bar[XB_XGEN(b.x)]) == gen, bar);
            __builtin_amdgcn_fence(__ATOMIC_ACQUIRE, "agent");
            asm volatile("s_waitcnt vmcnt(0)" ::: "memory");
        }
    }
    __syncthreads();
}

typedef short bf16x8 __attribute__((ext_vector_type(8)));
typedef float f32x16 __attribute__((ext_vector_type(16)));
typedef float f32x4 __attribute__((ext_vector_type(4)));
__device__ __forceinline__ unsigned pk_bf16(float a, float b) {
    typedef __bf16 bf2 __attribute__((ext_vector_type(2)));
    typedef float f2 __attribute__((ext_vector_type(2)));
    f2 v = {a, b};
    bf2 r = __builtin_convertvector(v, bf2);
    return __builtin_bit_cast(unsigned, r);
}
__device__ __forceinline__ bf16_t to_bf16(float a) { return (bf16_t)(pk_bf16(a, 0.f) & 0xffffu); }
__device__ __forceinline__ float bf2f(bf16_t v) { return __uint_as_float((unsigned)v << 16); }

__device__ __forceinline__ int opaque_tid() { int t = threadIdx.x; asm volatile("" : "+v"(t)); return t; }
constexpr int LROW = 128;
__device__ __forceinline__ int swz(int r) { return ((r >> 2) & 7) ^ ((r >> 1) & 1); }

template <int ROWS, bool MAYBE_NULL = false> struct LoadRowsBf16 {
    static constexpr int NCH = ROWS * 8 / NT;
    const bf16_t* base; int tid;
    unsigned off[NCH];
    typedef unsigned u32x4r __attribute__((ext_vector_type(4)));
    u32x4r regs[NCH];
    template <class RF> __device__ __forceinline__ void init(const bf16_t* base_, int ld, RF rowfn) {
        base = base_; tid = opaque_tid();
#pragma unroll
        for (int i = 0; i < NCH; ++i) {
            const int c = tid + i * NT, r = c >> 3, ch = c & 7;
            const long long src = rowfn(r);
            off[i] = (!MAYBE_NULL || src >= 0) ? (unsigned)(src * ld + ch * 8) : 0xffffffffu;
        }
    }
    __device__ __forceinline__ void load(int k0) {
#pragma unroll
        for (int i = 0; i < NCH; ++i)
            regs[i] = (!MAYBE_NULL || off[i] != 0xffffffffu) ? *(const u32x4r*)(base + (size_t)off[i] + k0) : (u32x4r){0u, 0u, 0u, 0u};
    }
    __device__ __forceinline__ void store(unsigned char* lds) const {
#pragma unroll
        for (int i = 0; i < NCH; ++i) {
            const int c = tid + i * NT, r = c >> 3, ch = c & 7;
            *(u32x4r*)(lds + r * LROW + ((ch ^ swz(r)) << 4)) = regs[i];
        }
    }
};

__device__ __forceinline__ int pi16(int x) { return (x & ~12) | ((x & 4) << 1) | ((x & 8) >> 1); }
namespace pg8 {
#define PG8_LAS __attribute__((address_space(3)))
typedef unsigned short bf16_t;
typedef short bf16x8 __attribute__((ext_vector_type(8)));
typedef float f32x4 __attribute__((ext_vector_type(4)));
typedef unsigned u32x4 __attribute__((ext_vector_type(4)));
constexpr int BM = 256, BK = 64, HALF = 128, HTB = HALF * BK * 2  , STAGE_BYTES = 8 * HTB, NXCD = 8, WGM = 8;

__host__ __device__ __forceinline__ int lds_byte(int r, int c) { const int st = (r >> 4) * 2 + (c >> 5), rr = r & 15, cc = c & 31, ob = rr * 64 + cc * 2; return st * 1024 + (ob ^ (((ob >> 9) & 1) << 5)); }
__host__ __device__ __forceinline__ void stage_rc(int b, int& R, int& C) { const int st = b / 1024, sb = b % 1024, swz = sb ^ (((sb >> 9) & 1) << 5); R = (st >> 1) * 16 + swz / 64; C = (st & 1) * 32 + (swz % 64) / 2; }
__host__ __device__ __forceinline__ int perm32(int rho) { const int n = rho >> 4, i = rho & 15; return 8 * (i >> 2) + 4 * n + (i & 3); }

struct Unit { int pm, pn; };
struct Gemm { const bf16_t* A; const bf16_t* Bt; int M, N, K; };

struct StaticOrder {
    int nM, nN, nwg, G, c;
    __host__ __device__ void init(int M, int N, int G_, int c_) { nM = M / BM; nN = N / BM; nwg = nM * nN; G = G_; c = c_; }
    __host__ __device__ bool next(int i, Unit& u) const {
        const long L = (long)i * G + c; if (L >= nwg) return false;
        int wgid = (int)L; { const int q = nwg / NXCD, r = nwg % NXCD, xcd = wgid % NXCD, off = wgid / NXCD; wgid = (xcd < r ? xcd * (q + 1) : r * (q + 1) + (xcd - r) * q) + off; }
        const int nig = WGM * nN, gid = wgid / nig, fm = gid * WGM, gsz = (nM - fm) < WGM ? (nM - fm) : WGM;
        u.pm = fm + ((wgid % nig) % gsz); u.pn = (wgid % nig) / gsz; return true;
    }
    __device__ __forceinline__ void a_ready(const Unit&) const {}
    __device__ __forceinline__ void done(const Unit&) const {}
};


__device__ __forceinline__ unsigned cvt_pk_bf16(float lo, float hi) { unsigned r; asm volatile("v_cvt_pk_bf16_f32 %0, %1, %2" : "=v"(r) : "v"(lo), "v"(hi)); return r; }

template <class Epi, class Sched, bool ALIGN_EPI = false, bool SP2 = false>
__device__ __forceinline__ void gemm_phase(PG8_LAS unsigned char* lds, const Gemm g, const Sched& S, const Epi& E) {
    const int tid = opaque_tid(), wid = __builtin_amdgcn_readfirstlane(tid >> 6), lane = tid & 63, wr = wid >> 2, wc = wid & 3, fr = lane & 15, fq = lane >> 4;
    const int K = g.K, nt = K / BK;
    unsigned voffA[2], voffB[2];
#pragma unroll
    for (int i = 0; i < 2; ++i) { int R, C; stage_rc(tid * 16 + i * 8192, R, C); const int Rb = Epi::PERM ? ((R & ~31) + perm32(R & 31)) : R;
        voffA[i] = (unsigned)(R * K + C) * 2u; voffB[i] = (unsigned)(Rb * K + C) * 2u; }
    const size_t rstep64 = (size_t)64 * K * 2;
    const size_t kstep = (size_t)(BK * 2);
    const size_t hstep = (size_t)HALF * K * 2;
    const size_t tstep = 2 * hstep;
    const unsigned ldsw = (unsigned)wid * 1024u;
    const int aoff = lds_byte(wr * 64 + fr, fq * 8), boff = lds_byte(wc * 32 + fr, fq * 8);
#define PG8_SA(b, h) (((b) * 2 + (h)) * HTB)
#define PG8_SB(b, h) ((4 + (b) * 2 + (h)) * HTB)
#define PG8_STAGE(bufoff, gbase, voff) do { _Pragma("unroll") for (int _i = 0; _i < 2; ++_i) \
        __builtin_amdgcn_global_load_lds((const unsigned*)((const char*)(gbase) + (size_t)_i * rstep64 + (voff)[0]), (PG8_LAS unsigned*)(lds + (bufoff) + ldsw + _i * 8192), 16, 0, 0); } while (0)
#define PG8_LDA(dst, b, h) do { _Pragma("unroll") for (int m = 0; m < 4; ++m) _Pragma("unroll") for (int k = 0; k < 2; ++k) dst[m][k] = *(const PG8_LAS bf16x8*)(lds + PG8_SA(b, h) + aoff + m * 2048 + k * 1024); } while (0)
#define PG8_LDB(dst, b, h) do { _Pragma("unroll") for (int n = 0; n < 2; ++n) _Pragma("unroll") for (int k = 0; k < 2; ++k) dst[n][k] = *(const PG8_LAS bf16x8*)(lds + PG8_SB(b, h) + boff + n * 2048 + k * 1024); } while (0)
#define PG8_MMA(ai, bj, At, Bt) do { __builtin_amdgcn_s_setprio(1); _Pragma("unroll") for (int m = 0; m < 4; ++m) _Pragma("unroll") for (int n = 0; n < 2; ++n) _Pragma("unroll") for (int k = 0; k < 2; ++k) \
        acc[ai][bj][m][n] = __builtin_amdgcn_mfma_f32_16x16x32_bf16(Bt[n][k], At[m][k], acc[ai][bj][m][n], 0, 0, 0); __builtin_amdgcn_s_setprio(0); } while (0)
#define PG8_WAIT_V(n) asm volatile("s_waitcnt vmcnt(" #n ")" ::: "memory")
#define PG8_WAIT_L(n) asm volatile("s_waitcnt lgkmcnt(" #n ")" ::: "memory")
#define PG8_BAR __builtin_amdgcn_s_barrier()
#define PG8_SCHED __builtin_amdgcn_sched_barrier(0)
    Unit cur, nxt; int ui = 0;
    if (!S.next(0, cur)) return;
    f32x4 acc[2][2][4][2];
#pragma unroll
    for (int a = 0; a < 2; ++a)
#pragma unroll
        for (int b = 0; b < 2; ++b)
#pragma unroll
            for (int m = 0; m < 4; ++m)
#pragma unroll
                for (int n = 0; n < 2; ++n) acc[a][b][m][n] = (f32x4){0.f, 0.f, 0.f, 0.f};
    bf16x8 At[4][2], B0[2][2], B1[2][2];
    const char* cA = (const char*)g.A + (size_t)cur.pm * tstep; const char* cB = (const char*)g.Bt + (size_t)cur.pn * tstep;
    S.a_ready(cur);
    if constexpr (SP2) {
        PG8_STAGE(PG8_SB(0, 0), cB, voffB); PG8_STAGE(PG8_SB(0, 1), cB + hstep, voffB); PG8_STAGE(PG8_SA(0, 0), cA, voffA); PG8_STAGE(PG8_SA(0, 1), cA + hstep, voffA);
        if (wr == 1) PG8_BAR;
        PG8_WAIT_V(2); PG8_BAR;
        PG8_STAGE(PG8_SB(1, 0), cB + kstep, voffB); PG8_STAGE(PG8_SA(1, 0), cA + kstep, voffA); PG8_STAGE(PG8_SB(1, 1), cB + hstep + kstep, voffB);
        PG8_WAIT_V(6); PG8_BAR;
    } else {
        PG8_STAGE(PG8_SB(0, 0), cB, voffB); PG8_STAGE(PG8_SA(0, 0), cA, voffA); PG8_STAGE(PG8_SB(0, 1), cB + hstep, voffB); PG8_STAGE(PG8_SA(0, 1), cA + hstep, voffA);
        if (wr == 1) PG8_BAR;
        PG8_WAIT_V(4); PG8_BAR;
        PG8_STAGE(PG8_SB(1, 0), cB + kstep, voffB); PG8_STAGE(PG8_SA(1, 0), cA + kstep, voffA); PG8_STAGE(PG8_SB(1, 1), cB + hstep + kstep, voffB);
        PG8_WAIT_V(6); PG8_BAR;
    }
    for (;;) {
        const bool has_next = S.next(ui + 1, nxt);
        const char* nA = has_next ? (const char*)g.A + (size_t)nxt.pm * tstep : cA; const char* nB = has_next ? (const char*)g.Bt + (size_t)nxt.pn * tstep : cB;
        for (int t = 0; t < nt; t += 2) {
            const bool last = (t == nt - 2);
            const char* a1 = cA + (size_t)(t + 1) * kstep;
            const char* a2 = last ? nA : cA + (size_t)(t + 2) * kstep; const char* b2 = last ? nB : cB + (size_t)(t + 2) * kstep;
            const char* a3 = a2 + kstep; const char* b3 = b2 + kstep;
            if (last && has_next) S.a_ready(nxt);
            if constexpr (SP2) {
            PG8_LDB(B0, 0, 0); PG8_LDB(B1, 0, 1); PG8_SCHED; PG8_LDA(At, 0, 0); PG8_STAGE(PG8_SA(1, 1), a1 + hstep, voffA);
            PG8_WAIT_V(8); PG8_WAIT_L(0); PG8_BAR; PG8_MMA(0, 0, At, B0); PG8_MMA(0, 1, At, B1); PG8_BAR; PG8_SCHED;
            PG8_LDA(At, 0, 1); PG8_STAGE(PG8_SB(0, 0), b2, voffB); PG8_STAGE(PG8_SB(0, 1), b2 + hstep, voffB); PG8_STAGE(PG8_SA(0, 0), a2, voffA);
            PG8_WAIT_V(8); PG8_WAIT_L(0); PG8_BAR; PG8_MMA(1, 0, At, B0); PG8_MMA(1, 1, At, B1); PG8_BAR; PG8_SCHED;
            PG8_LDB(B0, 1, 0); PG8_LDB(B1, 1, 1); PG8_SCHED; PG8_LDA(At, 1, 0); PG8_STAGE(PG8_SA(0, 1), a2 + hstep, voffA);
            PG8_WAIT_V(8); PG8_WAIT_L(0); PG8_BAR; PG8_MMA(0, 0, At, B0); PG8_MMA(0, 1, At, B1); PG8_BAR; PG8_SCHED;
            PG8_LDA(At, 1, 1); PG8_STAGE(PG8_SB(1, 0), b3, voffB); PG8_STAGE(PG8_SB(1, 1), b3 + hstep, voffB); PG8_STAGE(PG8_SA(1, 0), a3, voffA);
            PG8_WAIT_V(8); PG8_WAIT_L(0); PG8_BAR; PG8_MMA(1, 0, At, B0); PG8_MMA(1, 1, At, B1); PG8_BAR; PG8_SCHED;
            } else {
            PG8_LDB(B0, 0, 0); PG8_SCHED; PG8_LDA(At, 0, 0); PG8_STAGE(PG8_SA(1, 1), a1 + hstep, voffA);
            PG8_WAIT_L(8); PG8_BAR; PG8_WAIT_L(0); PG8_MMA(0, 0, At, B0); PG8_BAR; PG8_SCHED;
            PG8_LDB(B1, 0, 1); PG8_STAGE(PG8_SB(0, 0), b2, voffB);
            PG8_BAR; PG8_WAIT_L(0); PG8_MMA(0, 1, At, B1); PG8_BAR;
            PG8_LDA(At, 0, 1); PG8_STAGE(PG8_SA(0, 0), a2, voffA);
            PG8_BAR; PG8_WAIT_L(0); PG8_MMA(1, 0, At, B0); PG8_BAR; PG8_SCHED;
            PG8_STAGE(PG8_SB(0, 1), b2 + hstep, voffB);
            PG8_WAIT_V(6); PG8_BAR; PG8_MMA(1, 1, At, B1); PG8_BAR;
            PG8_LDB(B0, 1, 0); PG8_SCHED; PG8_LDA(At, 1, 0); PG8_STAGE(PG8_SA(0, 1), a2 + hstep, voffA);
            PG8_WAIT_L(8); PG8_BAR; PG8_WAIT_L(0); PG8_MMA(0, 0, At, B0); PG8_BAR; PG8_SCHED;
            PG8_LDB(B1, 1, 1); PG8_STAGE(PG8_SB(1, 0), b3, voffB);
            PG8_BAR; PG8_WAIT_L(0); PG8_MMA(0, 1, At, B1); PG8_BAR;
            PG8_LDA(At, 1, 1); PG8_STAGE(PG8_SA(1, 0), a3, voffA);
            PG8_BAR; PG8_WAIT_L(0); PG8_MMA(1, 0, At, B0); PG8_BAR; PG8_SCHED;
            PG8_STAGE(PG8_SB(1, 1), b3 + hstep, voffB);
            PG8_WAIT_V(6); PG8_BAR; PG8_MMA(1, 1, At, B1); PG8_BAR;
            }
        }
        if constexpr (ALIGN_EPI) { if (wr == 0) PG8_BAR; }
        if constexpr (!Epi::AFTER_DRAIN) { E(acc, cur, wr, wc, fr, fq); S.done(cur); }
        if (!has_next) break;
#pragma unroll
        for (int a = 0; a < 2; ++a)
#pragma unroll
            for (int b = 0; b < 2; ++b)
#pragma unroll
                for (int m = 0; m < 4; ++m)
#pragma unroll
                    for (int n = 0; n < 2; ++n) acc[a][b][m][n] = (f32x4){0.f, 0.f, 0.f, 0.f};
        cur = nxt; cA = nA; cB = nB; ++ui;
        if constexpr (ALIGN_EPI) { if (wr == 1) PG8_BAR; }
    }
    PG8_WAIT_V(0);
    if constexpr (!ALIGN_EPI) { if (wr == 0) PG8_BAR; }
    PG8_BAR;
    if constexpr (Epi::AFTER_DRAIN) { E.fused(acc, cur, wr, wc, fr, fq, lds, wid, lane); S.done(cur); }
#undef PG8_SA
#undef PG8_SB
#undef PG8_STAGE
#undef PG8_LDA
#undef PG8_LDB
#undef PG8_MMA
#undef PG8_WAIT_V
#undef PG8_WAIT_L
#undef PG8_BAR
#undef PG8_SCHED
}
}

struct EpiInproj {
    static constexpr bool PERM = true, AFTER_DRAIN = false;
    bf16_t *qkvraw, *dzb, *sq, *sk, *vT, *gab, *gbb; float* small;
    __device__ __forceinline__ void operator()(const pg8::f32x4 (&acc)[2][2][4][2], const pg8::Unit& u, int wr, int wc, int fr, int fq) const {
        const int pn = u.pn, row0 = u.pm * 256 + wr * 64 + fr;
        if (pn == 12 || pn == 13) {
#pragma unroll
            for (int ai = 0; ai < 2; ++ai)
#pragma unroll
                for (int m = 0; m < 4; ++m) {
                    const int tok = row0 + ai * 128 + m * 16, bb = tok >> 11, key = tok & (SEQ - 1), pos = (key & ~15) | pi16(key & 15);
#pragma unroll
                    for (int bj = 0; bj < 2; ++bj)
#pragma unroll
                        for (int n = 0; n < 2; ++n)
#pragma unroll
                            for (int j = 0; j < 4; ++j) {
                                const int svcol = (pn - 12) * 256 + bj * 128 + wc * 32 + fq * 8 + n * 4 + j;
                                vT[((size_t)((bb * 8 + (svcol >> 6)) * 64 + (svcol & 63))) * SEQ + pos] = to_bf16(acc[ai][bj][m][n][j]);
                            }
                }
        } else if (pn == 22) {
            if (wc == 0 && fq == 0) {
#pragma unroll
                for (int ai = 0; ai < 2; ++ai)
#pragma unroll
                    for (int m = 0; m < 4; ++m) {
                        pg8::f32x4* d = (pg8::f32x4*)(small + (size_t)(row0 + ai * 128 + m * 16) * 8);
                        d[0] = acc[ai][0][m][0]; d[1] = acc[ai][0][m][1];
                    }
            }
        } else {
            bf16_t* dst; int ld, c0; float sc = 1.f; bool gate = false;
            if (pn < 6) { dst = qkvraw; ld = 1536; c0 = pn * 256; }
            else if (pn < 8) { dst = dzb; ld = 512; c0 = (pn - 6) * 256; }
            else if (pn < 10) { dst = sq; ld = 512; c0 = (pn - 8) * 256; sc = 0.125f * 1.4426950408889634f; }
            else if (pn < 12) { dst = sk; ld = 512; c0 = (pn - 10) * 256; }
            else if (pn < 18) { dst = gab; ld = 1024; c0 = (pn - 14) * 256; gate = true; }
            else { dst = gbb; ld = 1024; c0 = (pn - 18) * 256; gate = true; }
#pragma unroll
            for (int ai = 0; ai < 2; ++ai)
#pragma unroll
                for (int m = 0; m < 4; ++m) {
                    bf16_t* rowp = dst + (size_t)(row0 + ai * 128 + m * 16) * ld + c0 + wc * 32 + fq * 8;
#pragma unroll
                    for (int bj = 0; bj < 2; ++bj) {
                        pg8::f32x4 v0 = acc[ai][bj][m][0] * sc, v1 = acc[ai][bj][m][1] * sc;
                        if (gate) {
#pragma unroll
                            for (int j = 0; j < 4; ++j) { v0[j] = sigmoidf_(v0[j]); v1[j] = sigmoidf_(v1[j]); }
                        }
                        pg8::u32x4 w; w.x = pk_bf16(v0[0], v0[1]); w.y = pk_bf16(v0[2], v0[3]); w.z = pk_bf16(v1[0], v1[1]); w.w = pk_bf16(v1[2], v1[3]);
                        *(pg8::u32x4*)(rowp + bj * 128) = w;
                    }
                }
        }
    }
};
template <class F> struct EpiF4 {
    static constexpr bool PERM = false, AFTER_DRAIN = false;
    F f;
    __device__ __forceinline__ void operator()(const pg8::f32x4 (&acc)[2][2][4][2], const pg8::Unit& u, int wr, int wc, int fr, int fq) const {
#pragma unroll
        for (int ai = 0; ai < 2; ++ai)
#pragma unroll
            for (int m = 0; m < 4; ++m) {
                const int row = u.pm * 256 + ai * 128 + wr * 64 + m * 16 + fr;
#pragma unroll
                for (int bj = 0; bj < 2; ++bj)
#pragma unroll
                    for (int n = 0; n < 2; ++n) f(row, u.pn * 256 + bj * 128 + wc * 32 + n * 16 + fq * 4, acc[ai][bj][m][n]);
            }
    }
};
template <class F> __device__ __forceinline__ void run_pg8(const bf16_t* A, const bf16_t* Bt, int M, int N, int K, unsigned char* lds, F f) {
    pg8::Gemm g{A, Bt, M, N, K};
    pg8::StaticOrder S; S.init(M, N, gridDim.x, blockIdx.x);
    EpiF4<F> E{f};
    pg8::gemm_phase<EpiF4<F>, pg8::StaticOrder, true, true>((PG8_LAS unsigned char*)lds, g, S, E);
}
__device__ __forceinline__ void unpack4(uint2 w, float (&g)[4]) {
    g[0] = __uint_as_float(w.x << 16); g[1] = __uint_as_float(w.x & 0xffff0000u); g[2] = __uint_as_float(w.y << 16); g[3] = __uint_as_float(w.y & 0xffff0000u);
}

struct LoadKNF32 {
    const float* base; int ld, kq, nq;
    f32x4 regs[8];
    template <class CF> __device__ __forceinline__ void init(const float* w, int ld_, CF colfn) {
        const int tid = opaque_tid(); kq = tid >> 6; nq = tid & 63; ld = ld_;
        base = w + (size_t)(kq * 8) * ld_ + colfn(nq * 4);
    }
    __device__ __forceinline__ void load(int k0) {
#pragma unroll
        for (int j = 0; j < 8; ++j) regs[j] = *(const f32x4*)(base + (size_t)(k0 + j) * ld);
    }
    __device__ __forceinline__ void store1(unsigned char* lds, int nn, float a0, float a1, float a2, float a3, float a4, float a5, float a6, float a7) const {
        uint4 o; o.x = pk_bf16(a0, a1); o.y = pk_bf16(a2, a3); o.z = pk_bf16(a4, a5); o.w = pk_bf16(a6, a7);
        const int row = nq * 4 + nn;
        *(uint4*)(lds + row * LROW + ((kq ^ swz(row)) << 4)) = o;
    }
    __device__ __forceinline__ void store(unsigned char* lds) const {
        store1(lds, 0, regs[0].x, regs[1].x, regs[2].x, regs[3].x, regs[4].x, regs[5].x, regs[6].x, regs[7].x);
        store1(lds, 1, regs[0].y, regs[1].y, regs[2].y, regs[3].y, regs[4].y, regs[5].y, regs[6].y, regs[7].y);
        store1(lds, 2, regs[0].z, regs[1].z, regs[2].z, regs[3].z, regs[4].z, regs[5].z, regs[6].z, regs[7].z);
        store1(lds, 3, regs[0].w, regs[1].w, regs[2].w, regs[3].w, regs[4].w, regs[5].w, regs[6].w, regs[7].w);
    }
};

template <int BM_, int BN_, int WM_, int WN_> struct GemmCfg {
    static constexpr int BM = BM_, BN = BN_, WM = WM_, WN = WN_;
    static constexpr int TM = BM / WM, TN = BN / WN, MI = TM / 32, NI = TN / 32;
    static constexpr int A_BYTES = BM * LROW, B_BYTES = BN * LROW, STAGE = A_BYTES + B_BYTES;
    static_assert(WM * WN == 8, "8 waves");
};

template <class CFG, class AL, class BL>
__device__ __forceinline__ void gemm_mainloop(AL& al, BL& bl, int nk, f32x16 (&acc)[CFG::MI][CFG::NI], unsigned char* lds) {
    constexpr int MI = CFG::MI, NI = CFG::NI;
    const int tid = opaque_tid(), lane = tid & 63, wid = tid >> 6;
    const int wm = wid / CFG::WN, wn = wid % CFG::WN;
    const int l31 = lane & 31, lh = lane >> 5;
    al.load(0); bl.load(0);
    const int a_off = (wm * CFG::TM + l31) * LROW;
    const int b_off = CFG::A_BYTES + (wn * CFG::TN + l31) * LROW;
    const int fsw = swz(l31);
    for (int kt = 0; kt < nk; ++kt) {
        unsigned char* st = lds + (kt & 1) * CFG::STAGE;
        al.store(st); bl.store(st + CFG::A_BYTES);
        __syncthreads();
        if (kt + 1 < nk) { al.load((kt + 1) * 64); bl.load((kt + 1) * 64); }
#pragma unroll
        for (int kk = 0; kk < 4; ++kk) {
            bf16x8 a[MI], b[NI];
#pragma unroll
            for (int mi = 0; mi < MI; ++mi) a[mi] = *(const bf16x8*)(st + a_off + mi * 32 * LROW + (((kk * 2 + lh) ^ fsw) << 4));
#pragma unroll
            for (int ni = 0; ni < NI; ++ni) b[ni] = *(const bf16x8*)(st + b_off + ni * 32 * LROW + (((kk * 2 + lh) ^ fsw) << 4));
#pragma unroll
            for (int mi = 0; mi < MI; ++mi)
#pragma unroll
                for (int ni = 0; ni < NI; ++ni)
                    acc[mi][ni] = __builtin_amdgcn_mfma_f32_32x32x16_bf16(a[mi], b[ni], acc[mi][ni], 0, 0, 0);
        }
    }
    __syncthreads();
}
template <class CFG, bool A_RES, int ARES_ROT, bool TRANS, class AL, class BL>
__device__ __forceinline__ void gemm_mainloop2(AL (&al)[2], BL (&bl)[2], int nk, f32x16 (&acc)[CFG::MI][CFG::NI], unsigned char* stages, const unsigned char* ares) {
    constexpr int MI = CFG::MI, NI = CFG::NI;
    constexpr int STG = A_RES ? CFG::B_BYTES : CFG::STAGE, BOFF = A_RES ? 0 : CFG::A_BYTES;
    const int tid = opaque_tid(), lane = tid & 63, wid = tid >> 6;
    const int wm = wid / CFG::WN, wn = wid % CFG::WN;
    const int l31 = lane & 31, lh = lane >> 5;
    if (!A_RES) { al[0].load(0); } bl[0].load(0);
    if (!A_RES) { al[1].load(64); } bl[1].load(64);
    const int a_off = (wm * CFG::TM + l31) * LROW;
    const int b_off = BOFF + (wn * CFG::TN + l31) * LROW;
    const int fsw = swz(l31);
    for (int kt = 0; kt < nk; kt += 2) {
#pragma unroll
        for (int u = 0; u < 2; ++u) {
            unsigned char* st = stages + u * STG;
            if (!A_RES) al[u].store(st);
            bl[u].store(st + BOFF);
            __syncthreads();
            if (kt + u + 2 < nk) { if (!A_RES) al[u].load((kt + u + 2) * 64); bl[u].load((kt + u + 2) * 64); }
            const unsigned char* ab = A_RES ? ares + (size_t)((kt + u + ARES_ROT) & 3) * (CFG::BM * LROW) : st;
#pragma unroll
            for (int kk = 0; kk < 4; ++kk) {
                bf16x8 a[MI], b[NI];
#pragma unroll
                for (int mi = 0; mi < MI; ++mi) a[mi] = *(const bf16x8*)(ab + a_off + mi * 32 * LROW + (((kk * 2 + lh) ^ fsw) << 4));
#pragma unroll
                for (int ni = 0; ni < NI; ++ni) b[ni] = *(const bf16x8*)(st + b_off + ni * 32 * LROW + (((kk * 2 + lh) ^ fsw) << 4));
#pragma unroll
                for (int mi = 0; mi < MI; ++mi)
#pragma unroll
                    for (int ni = 0; ni < NI; ++ni)
                        acc[mi][ni] = TRANS ? __builtin_amdgcn_mfma_f32_32x32x16_bf16(b[ni], a[mi], acc[mi][ni], 0, 0, 0)
                                            : __builtin_amdgcn_mfma_f32_32x32x16_bf16(a[mi], b[ni], acc[mi][ni], 0, 0, 0);
            }
        }
    }
    __syncthreads();
}
template <int ROWS, int NSET> struct LoadRowsBf16N {
    static constexpr int NCH = ROWS * 8 / NT;
    typedef unsigned u32x4r __attribute__((ext_vector_type(4)));
    const bf16_t* base; int tid;
    unsigned off[NCH];
    u32x4r regs[NSET][NCH];
    template <class RF> __device__ __forceinline__ void init(const bf16_t* base_, int ld, RF rowfn) {
        base = base_; tid = opaque_tid();
#pragma unroll
        for (int i = 0; i < NCH; ++i) { const int c = tid + i * NT, r = c >> 3, ch = c & 7; off[i] = (unsigned)(rowfn(r) * ld + ch * 8); }
    }
    template <int U> __device__ __forceinline__ void load(int k0) {
#pragma unroll
        for (int i = 0; i < NCH; ++i) regs[U][i] = *(const u32x4r*)(base + (size_t)off[i] + k0);
    }
    template <int U> __device__ __forceinline__ void store(unsigned char* lds) const {
#pragma unroll
        for (int i = 0; i < NCH; ++i) { const int c = tid + i * NT, r = c >> 3, ch = c & 7; *(u32x4r*)(lds + r * LROW + ((ch ^ swz(r)) << 4)) = regs[U][i]; }
    }
};
template <int NSET> struct LoadKNF32N {
    const float* base; int ld, kq, nq;
    f32x4 regs[NSET][8];
    template <class CF> __device__ __forceinline__ void init(const float* w, int ld_, CF colfn) {
        const int tid = opaque_tid(); kq = tid >> 6; nq = tid & 63; ld = ld_;
        base = w + (size_t)(kq * 8) * ld_ + colfn(nq * 4);
    }
    template <int U> __device__ __forceinline__ void load(int k0) {
#pragma unroll
        for (int j = 0; j < 8; ++j) regs[U][j] = *(const f32x4*)(base + (size_t)(k0 + j) * ld);
    }
    template <int U> __device__ __forceinline__ void store(unsigned char* lds) const {
#pragma unroll
        for (int nn = 0; nn < 4; ++nn) {
            uint4 o; o.x = pk_bf16(regs[U][0][nn], regs[U][1][nn]); o.y = pk_bf16(regs[U][2][nn], regs[U][3][nn]);
            o.z = pk_bf16(regs[U][4][nn], regs[U][5][nn]); o.w = pk_bf16(regs[U][6][nn], regs[U][7][nn]);
            const int row = nq * 4 + nn;
            *(uint4*)(lds + row * LROW + ((kq ^ swz(row)) << 4)) = o;
        }
    }
};
template <class CFG, bool TRANS, int U, class AL, class BL>
__device__ __forceinline__ void d3_step(AL& al, BL& bl, int t, int nk, f32x16 (&acc)[CFG::MI][CFG::NI], unsigned char* stages, int a_off, int b_off, int fsw, int lh) {
    constexpr int MI = CFG::MI, NI = CFG::NI, UN = (U + 1) % 3;
    if (t < nk) {
        unsigned char* st = stages + (t & 1) * CFG::STAGE;
        unsigned char* nx = stages + ((t + 1) & 1) * CFG::STAGE;
#pragma unroll
        for (int kk = 0; kk < 4; ++kk) {
            if (kk == 2 && t + 1 < nk) {
                al.template store<UN>(nx); bl.template store<UN>(nx + CFG::A_BYTES);
                if (t + 4 < nk) { al.template load<UN>((t + 4) * 64); bl.template load<UN>((t + 4) * 64); }
            }
            bf16x8 a[MI], b[NI];
#pragma unroll
            for (int mi = 0; mi < MI; ++mi) a[mi] = *(const bf16x8*)(st + a_off + mi * 32 * LROW + (((kk * 2 + lh) ^ fsw) << 4));
#pragma unroll
            for (int ni = 0; ni < NI; ++ni) b[ni] = *(const bf16x8*)(st + b_off + ni * 32 * LROW + (((kk * 2 + lh) ^ fsw) << 4));
#pragma unroll
            for (int mi = 0; mi < MI; ++mi)
#pragma unroll
                for (int ni = 0; ni < NI; ++ni)
                    acc[mi][ni] = TRANS ? __builtin_amdgcn_mfma_f32_32x32x16_bf16(b[ni], a[mi], acc[mi][ni], 0, 0, 0)
                                        : __builtin_amdgcn_mfma_f32_32x32x16_bf16(a[mi], b[ni], acc[mi][ni], 0, 0, 0);
        }
        __syncthreads();
    }
}
template <class CFG, bool TRANS, class AL, class BL>
__device__ __forceinline__ void gemm_mainloop_d3(AL& al, BL& bl, int nk, f32x16 (&acc)[CFG::MI][CFG::NI], unsigned char* stages) {
    const int tid = opaque_tid(), lane = tid & 63, wid = tid >> 6;
    const int wm = wid / CFG::WN, wn = wid % CFG::WN;
    const int l31 = lane & 31, lh = lane >> 5;
    al.template load<0>(0); bl.template load<0>(0);
    al.template load<1>(64); bl.template load<1>(64);
    al.template load<2>(128); bl.template load<2>(128);
    const int a_off = (wm * CFG::TM + l31) * LROW;
    const int b_off = CFG::A_BYTES + (wn * CFG::TN + l31) * LROW;
    const int fsw = swz(l31);
    al.template store<0>(stages); bl.template store<0>(stages + CFG::A_BYTES);
    __syncthreads();
    if (3 < nk) { al.template load<0>(192); bl.template load<0>(192); }
    for (int kt = 0; kt < nk; kt += 3) {
        d3_step<CFG, TRANS, 0>(al, bl, kt, nk, acc, stages, a_off, b_off, fsw, lh);
        d3_step<CFG, TRANS, 1>(al, bl, kt + 1, nk, acc, stages, a_off, b_off, fsw, lh);
        d3_step<CFG, TRANS, 2>(al, bl, kt + 2, nk, acc, stages, a_off, b_off, fsw, lh);
    }
}
template <class CFG> __device__ __forceinline__ void acc_zero(f32x16 (&acc)[CFG::MI][CFG::NI]) {
#pragma unroll
    for (int mi = 0; mi < CFG::MI; ++mi)
#pragma unroll
        for (int ni = 0; ni < CFG::NI; ++ni)
#pragma unroll
            for (int r = 0; r < 16; ++r) acc[mi][ni][r] = 0.f;
}
template <class CFG, class F> __device__ __forceinline__ void acc_foreach(f32x16 (&acc)[CFG::MI][CFG::NI], F f) {
    const int tid = opaque_tid(), lane = tid & 63, wid = tid >> 6;
    const int wm = wid / CFG::WN, wn = wid % CFG::WN;
#pragma unroll
    for (int mi = 0; mi < CFG::MI; ++mi)
#pragma unroll
        for (int ni = 0; ni < CFG::NI; ++ni) {
            asm volatile("" ::: "memory");
#pragma unroll
            for (int r = 0; r < 16; ++r)
                acc[mi][ni][r] = f(wm * CFG::TM + mi * 32 + (r & 3) + 8 * (r >> 2) + 4 * (lane >> 5), wn * CFG::TN + ni * 32 + (lane & 31), acc[mi][ni][r], mi, ni, r);
        }
}

struct TileMap {
    int ntm, ntn, npm, npn, rounds; bool patched;
    int pm, pn;
    __device__ __forceinline__ void init(int ntm_, int ntn_) {
        ntm = ntm_; ntn = ntn_; patched = (gridDim.x == 256);
        pn = ntn >= 8 ? 8 : ntn >= 4 ? 4 : ntn >= 2 ? 2 : 1; pm = 32 / pn;
        if (patched) { npm = (ntm + pm - 1) / pm; npn = (ntn + pn - 1) / pn; rounds = (npm * npn + 7) / 8; }
        else { int G = gridDim.x; asm volatile("" : "+s"(G)); npm = npn = 0; rounds = (ntm * ntn + G - 1) / G; }
    }
    __device__ __forceinline__ bool get(int round, int& tm, int& tn) const {
        const int b = blockIdx.x;
        if (patched) {
            const int patch = round * 8 + (b & 7), slot = b >> 3;
            if (patch >= npm * npn) return false;
            tm = (patch / npn) * pm + slot / pn; tn = (patch % npn) * pn + slot % pn;
            return tm < ntm && tn < ntn;
        }
        const int t = round * gridDim.x + b;
        if (t >= ntm * ntn) return false;
        tm = t / ntn; tn = t % ntn; return true;
    }
};

template <class CM>
__device__ __forceinline__ void transpose_convert(const float* W, int K, int N, int NP, bf16_t* Wt, float* sm, CM cmap) {
    const int tid = opaque_tid(), ntk = K / 64, ntn = NP / 64;
    for (int tile = blockIdx.x; tile < ntk * ntn; tile += gridDim.x) {
        const int tk = tile % ntk, tn = tile / ntk;
#pragma unroll
        for (int i = 0; i < 8; ++i) {
            const int e = tid + i * NT, kk = e >> 6, nn = e & 63, col = cmap(tn * 64 + nn);
            sm[nn * 65 + kk] = col >= 0 ? W[(size_t)(tk * 64 + kk) * N + col] : 0.f;
        }
        __syncthreads();
        const int n = tid >> 3, kc = tid & 7;
        const float* r = sm + n * 65 + kc * 8;
        uint4 o; o.x = pk_bf16(r[0], r[1]); o.y = pk_bf16(r[2], r[3]); o.z = pk_bf16(r[4], r[5]); o.w = pk_bf16(r[6], r[7]);
        *(uint4*)(Wt + (size_t)(tn * 64 + n) * K + tk * 64 + kc * 8) = o;
        __syncthreads();
    }
}
__device__ __forceinline__ void transpose_tile_f4(const float* W, int K, int N, bf16_t* Wt, int k0, int n0, float* sm) {
    const int tid = opaque_tid(), kk = tid >> 4, n4 = tid & 15;
#pragma unroll
    for (int h = 0; h < 2; ++h) {
        const int k = kk + 32 * h;
        const f32x4 v = *(const f32x4*)(W + (size_t)(k0 + k) * N + n0 + n4 * 4);
#pragma unroll
        for (int j = 0; j < 4; ++j) sm[(n4 * 4 + j) * 65 + k] = v[j];
    }
    __syncthreads();
    const int n = tid >> 3, kc = tid & 7;
    const float* r = sm + n * 65 + kc * 8;
    uint4 o; o.x = pk_bf16(r[0], r[1]); o.y = pk_bf16(r[2], r[3]); o.z = pk_bf16(r[4], r[5]); o.w = pk_bf16(r[6], r[7]);
    *(uint4*)(Wt + (size_t)(n0 + n) * K + k0 + kc * 8) = o;
    __syncthreads();
}
__device__ __forceinline__ void convert_bf16(const float* src, bf16_t* dst, size_t n) {
    const size_t gtid = (size_t)blockIdx.x * NT + opaque_tid(), gsz = (size_t)gridDim.x * NT;
    for (size_t i = gtid; i < n / 8; i += gsz) {
        const float4 a = ((const float4*)src)[2 * i], b = ((const float4*)src)[2 * i + 1];
        uint4 o; o.x = pk_bf16(a.x, a.y); o.y = pk_bf16(a.z, a.w); o.z = pk_bf16(b.x, b.y); o.w = pk_bf16(b.z, b.w);
        ((uint4*)dst)[i] = o;
    }
}

__device__ __forceinline__ void phase_inproj(const Params& p, unsigned char* lds) {
    pg8::Gemm g{p.xb, p.w_in_t, T, PWP, D};
    pg8::StaticOrder S; S.init(T, PWP, gridDim.x, blockIdx.x);
    EpiInproj E{p.qkvraw, p.dzb, p.sq, p.sk, p.vT, p.gab, p.gbb, p.small};
    pg8::gemm_phase<EpiInproj, pg8::StaticOrder, true, true>((PG8_LAS unsigned char*)lds, g, S, E);
}

__device__ __forceinline__ void load_gate16(const bf16_t* gbuf, int rb, int cb, int lane, float (&g)[16]) {
    const uint4* src = (const uint4*)(gbuf + ((size_t)(rb * 32 + cb) * 64 + lane) * 16);
    const uint4 a = src[0], b = src[1];
    const unsigned u[8] = {a.x, a.y, a.z, a.w, b.x, b.y, b.z, b.w};
#pragma unroll
    for (int i = 0; i < 8; ++i) { g[2 * i] = __uint_as_float(u[i] << 16); g[2 * i + 1] = __uint_as_float(u[i] & 0xffff0000u); }
}
__device__ __forceinline__ void phase_merge(const Params& p, unsigned char* lds) {
    run_pg8(p.oab, p.w_pa_t, T, D, DNW, lds, [&](int row, int col, pg8::f32x4 v) {
        float g[4]; unpack4(*(const uint2*)(p.gab + (size_t)row * D + col), g);
        *(pg8::f32x4*)(p.m1 + (size_t)row * D + col) = (pg8::f32x4){v[0] * g[0], v[1] * g[1], v[2] * g[2], v[3] * g[3]};
    });
    run_pg8(p.obb, p.w_pb_t, T, D, SBW, lds, [&](int row, int col, pg8::f32x4 v) {
        float g[4]; unpack4(*(const uint2*)(p.gbb + (size_t)row * D + col), g);
        const pg8::f32x4 m = *(const pg8::f32x4*)(p.m1 + (size_t)row * D + col);
        uint2 w; w.x = pk_bf16(m[0] + v[0] * g[0], m[1] + v[1] * g[1]); w.y = pk_bf16(m[2] + v[2] * g[2], m[3] + v[3] * g[3]);
        *(uint2*)(p.mergedb + (size_t)row * D + col) = w;
    });
}

__device__ __forceinline__ void phase_outproj(const Params& p, unsigned char* lds) {
    run_pg8(p.mergedb, p.w_out_t, T, D, D, lds, [&](int row, int col, pg8::f32x4 v) {
        const size_t o = (size_t)row * D + col;
        const pg8::f32x4 x = *(const pg8::f32x4*)(p.x + o);
        *(pg8::f32x4*)(p.pre1 + o) = v + x * ALPHA;
    });
}

__device__ __forceinline__ void phase_router_shared_up(const Params& p, unsigned char* lds) {
    {
        typedef GemmCfg<128, 128, 4, 2> CFG;
        TileMap tmap; tmap.init(T / 128, NE / 128);
        for (int round = 0; round < tmap.rounds; ++round) {
            int tm, tn;
            if (!tmap.get(round, tm, tn)) continue;
            LoadRowsBf16<128> al, bl;
            al.init(p.hb, D, [&](int r) { return (long long)(tm * 128 + r); });
            bl.init(p.w_router_t, D, [&](int r) { return (long long)(tn * 128 + r); });
            f32x16 acc[CFG::MI][CFG::NI];
            acc_zero<CFG>(acc);
            gemm_mainloop<CFG>(al, bl, D / 64, acc, lds);
            asm volatile("" : "+s"(tm), "+s"(tn));
            acc_foreach<CFG>(acc, [&](int r, int c, float v, int, int, int) {
                p.scores[(size_t)(tm * 128 + r) * NE + tn * 128 + c] = sigmoidf_(v);
                return v;
            });
        }
    }
    {
        typedef GemmCfg<128, 256, 2, 4> CFG;
        TileMap tmap; tmap.init(T / 128, SFF / 128);
        for (int round = 0; round < tmap.rounds; ++round) {
            int tm, tn;
            if (!tmap.get(round, tm, tn)) continue;
            LoadRowsBf16<128> al; LoadRowsBf16<256> bl;
            al.init(p.hb, D, [&](int r) { return (long long)(tm * 128 + r); });
            bl.init(p.w_su_t, D, [&](int r) { return (long long)(((r >> 5) & 1) * SFF + tn * 128 + (r >> 6) * 32 + (r & 31)); });
            f32x16 acc[CFG::MI][CFG::NI];
            acc_zero<CFG>(acc);
            gemm_mainloop<CFG>(al, bl, D / 64, acc, lds);
            asm volatile("" : "+s"(tm), "+s"(tn));
            const int tid = opaque_tid(), lane = tid & 63, wid = tid >> 6, wm = wid / CFG::WN, wn = wid % CFG::WN;
#pragma unroll
            for (int mi = 0; mi < CFG::MI; ++mi)
#pragma unroll
                for (int r = 0; r < 16; ++r) {
                    const int row = tm * 128 + wm * CFG::TM + mi * 32 + (r & 3) + 8 * (r >> 2) + 4 * (lane >> 5);
                    const int j = tn * 128 + wn * 32 + (lane & 31);
                    const float g = acc[mi][0][r], u = acc[mi][1][r];
                    p.actsh[(size_t)row * SFF + j] = to_bf16(siluf_(g) * u);
                }
        }
    }
}

__device__ __forceinline__ void phase_shared_down(const Params& p, unsigned char* lds) {
    run_pg8(p.actsh, p.w_sd_t, T, D, SFF, lds, [&](int row, int col, pg8::f32x4 v) {
        uint2 w; w.x = pk_bf16(v[0], v[1]); w.y = pk_bf16(v[2], v[3]);
        *(uint2*)(p.yshb + (size_t)row * D + col) = w;
    });
}

__device__ __forceinline__ void phase_init(const Params& p) {
    const int gtid = blockIdx.x * NT + opaque_tid(), gsz = gridDim.x * NT;
    for (int i = gtid; i < 2 * NE * CSTRIDE; i += gsz) p.counts[i] = 0;
}

__device__ __forceinline__ void sb_attn_wave(const Params& p, int bh, int qt) {
    const int lane = opaque_tid() & 63, l31 = lane & 31, lh = lane >> 5;
    const int b = bh >> 3, hh = bh & 7;
    bf16x8 qf[4];
    {
        const bf16_t* qrow = p.sq + (size_t)(b * SEQ + qt * 32 + l31) * SBW + hh * 64 + lh * 8;
#pragma unroll
        for (int ks = 0; ks < 4; ++ks) qf[ks] = *(const bf16x8*)(qrow + ks * 16);
    }
    f32x16 o0, o1;
#pragma unroll
    for (int r = 0; r < 16; ++r) { o0[r] = 0.f; o1[r] = 0.f; }
    float run = 0.f;
    const bf16_t* vbase = p.vT + ((size_t)(bh * 64 + l31)) * SEQ + lh * 8;
    for (int kt = qt; kt >= 0; --kt) {
        const bf16_t* krow = p.sk + (size_t)(b * SEQ + kt * 32 + l31) * SBW + hh * 64 + lh * 8;
        bf16x8 kf[4];
#pragma unroll
        for (int ks = 0; ks < 4; ++ks) kf[ks] = *(const bf16x8*)(krow + ks * 16);
        bf16x8 vf[2][2];
#pragma unroll
        for (int md = 0; md < 2; ++md)
#pragma unroll
            for (int ss = 0; ss < 2; ++ss) vf[md][ss] = *(const bf16x8*)(vbase + (size_t)md * 32 * SEQ + kt * 32 + ss * 16);
        f32x16 sc;
#pragma unroll
        for (int r = 0; r < 16; ++r) sc[r] = 0.f;
#pragma unroll
        for (int ks = 0; ks < 4; ++ks) sc = __builtin_amdgcn_mfma_f32_32x32x16_bf16(kf[ks], qf[ks], sc, 0, 0, 0);
        float lb[16], lr[16];
        const bool diag = (kt == qt);
#pragma unroll
        for (int r = 0; r < 16; ++r) {
            const float z = sc[r];
            const float l = __builtin_amdgcn_logf(1.f + __builtin_amdgcn_exp2f(-fabsf(z)));
            float b_ = fminf(z, 0.f) - l, r_ = b_ - z;
            if (diag) { const bool valid = ((r & 3) + 8 * (r >> 2) + 4 * lh) < l31; r_ = valid ? r_ : 0.f; b_ = valid ? b_ : -INFINITY; }
            lb[r] = b_; lr[r] = r_;
        }
        float ex[16], B[4];
#pragma unroll
        for (int g = 0; g < 4; ++g) {
            ex[4 * g + 3] = 0.f;
            ex[4 * g + 2] = lr[4 * g + 3];
            ex[4 * g + 1] = ex[4 * g + 2] + lr[4 * g + 2];
            ex[4 * g + 0] = ex[4 * g + 1] + lr[4 * g + 1];
            B[g] = ex[4 * g + 0] + lr[4 * g + 0];
        }
        float P[4];
#pragma unroll
        for (int g = 0; g < 4; ++g) P[g] = shfl_lane(B[g], lane ^ 32);
        float off[4];
        {
            const float p3 = P[3], p2 = P[2] + p3, p1 = P[1] + p2, p0 = P[0] + p1;
            const float b3 = 0.f, b2 = B[3], b1 = B[2] + b2, b0 = B[1] + b1;
            off[0] = b0 + (lh ? p1 : p0);
            off[1] = b1 + (lh ? p2 : p1);
            off[2] = b2 + (lh ? p3 : p2);
            off[3] = b3 + (lh ? 0.f : p3);
            const float total = (B[0] + b0) + p0;
#pragma unroll
            for (int g = 0; g < 4; ++g) off[g] += run;
            run += total;
        }
        float a[16];
#pragma unroll
        for (int r = 0; r < 16; ++r) a[r] = __builtin_amdgcn_exp2f(lb[r] + ex[r] + off[r >> 2]);
        bf16x8 pf[2];
#pragma unroll
        for (int ss = 0; ss < 2; ++ss) {
            typedef unsigned u32x4 __attribute__((ext_vector_type(4)));
            u32x4 w;
            w[0] = pk_bf16(a[8 * ss + 0], a[8 * ss + 1]); w[1] = pk_bf16(a[8 * ss + 2], a[8 * ss + 3]);
            w[2] = pk_bf16(a[8 * ss + 4], a[8 * ss + 5]); w[3] = pk_bf16(a[8 * ss + 6], a[8 * ss + 7]);
            pf[ss] = __builtin_bit_cast(bf16x8, w);
        }
#pragma unroll
        for (int ss = 0; ss < 2; ++ss) {
            o0 = __builtin_amdgcn_mfma_f32_32x32x16_bf16(vf[0][ss], pf[ss], o0, 0, 0, 0);
            o1 = __builtin_amdgcn_mfma_f32_32x32x16_bf16(vf[1][ss], pf[ss], o1, 0, 0, 0);
        }
        if (__all(run < -160.f)) break;
    }
    bf16_t* orow = p.obb + (size_t)(b * SEQ + qt * 32 + l31) * SBW + hh * 64 + 4 * lh;
#pragma unroll
    for (int g = 0; g < 4; ++g) {
        uint2 w0, w1;
        w0.x = pk_bf16(o0[4 * g], o0[4 * g + 1]); w0.y = pk_bf16(o0[4 * g + 2], o0[4 * g + 3]);
        w1.x = pk_bf16(o1[4 * g], o1[4 * g + 1]); w1.y = pk_bf16(o1[4 * g + 2], o1[4 * g + 3]);
        *(uint2*)(orow + 8 * g) = w0;
        *(uint2*)(orow + 32 + 8 * g) = w1;
    }
}


constexpr int DN_RW = 0, DN_RQ = 128, DN_RAT = 256, DN_RKD = 320;
constexpr float LOG2E = 1.4426950408889634f;
__device__ __forceinline__ uint4 pack8(const float* v) { uint4 o; o.x = pk_bf16(v[0], v[1]); o.y = pk_bf16(v[2], v[3]); o.z = pk_bf16(v[4], v[5]); o.w = pk_bf16(v[6], v[7]); return o; }

__device__ __forceinline__ void dn_chunk_item(const Params& p, int item, unsigned char* lds) {
    const int tid = opaque_tid(), lane = tid & 63, wid = tid >> 6;
    const int bh = item >> 5, n = item & 31, b = bh >> 2, hh = bh & 3;
    const int t0 = b * SEQ + n * 64;
    unsigned char* Kimg = lds; unsigned char* KBimg = lds + 16384; unsigned char* Qimg = lds + 32768;
    float* Vf = (float*)(lds + 49152); float* KBGf = (float*)(lds + 81920); float* MT = (float*)(lds + 114688);
    float* G2s = (float*)(lds + 114688 + 17408); float* betas = G2s + 64;
    bf16_t* blob = p.dnblob + (size_t)item * DN_BLOB;
    if (wid == 0) {
        const int t = t0 + lane;
        const float da = p.small[(size_t)t * 8 + 4 + hh] + p.dt_bias[hh];
        const float sp = da > 20.f ? da : log1pf(expf(da));
        float g2 = -expf(p.a_log[hh]) * sp * LOG2E;
#pragma unroll
        for (int off = 1; off < 64; off <<= 1) { const float v = shfl_lane(g2, lane - off); if (lane >= off) g2 += v; }
        G2s[lane] = g2; betas[lane] = sigmoidf_(p.small[(size_t)t * 8 + hh]);
        if (lane == 63) p.dnlast[item] = exp2f(g2);
    }
    __syncthreads();
    {
        const int c8 = tid & 15, tq = tid >> 4, j0 = tq * 2;
        const float G0 = G2s[j0], G1 = G2s[j0 + 1], GL = G2s[63];
        const float be[2] = {betas[j0], betas[j0 + 1]};
        const float eg[2] = {exp2f(G0), exp2f(G1)}, el[2] = {exp2f(GL - G0), exp2f(GL - G1)};
        const int half = c8 >> 3, ch = c8 & 7;
#pragma unroll
        for (int type = 0; type < 3; ++type) {
            float o[2][8];
            {
                const bf16_t* src = p.qkvraw + (size_t)(t0 + j0 - 3) * 1536 + type * 512 + hh * 128 + c8 * 8;
                float x[5][8];
#pragma unroll
                for (int r = 0; r < 5; ++r) {
                    uint4 raw = make_uint4(0, 0, 0, 0);
                    if (n > 0 || j0 - 3 + r >= 0) raw = *(const uint4*)(src + (size_t)r * 1536);
                    const unsigned u[4] = {raw.x, raw.y, raw.z, raw.w};
#pragma unroll
                    for (int i = 0; i < 4; ++i) { x[r][2 * i] = __uint_as_float(u[i] << 16); x[r][2 * i + 1] = __uint_as_float(u[i] & 0xffff0000u); }
                }
                const float* wp = p.conv_w + type * 512 + hh * 128 + c8 * 8;
#pragma unroll
                for (int i = 0; i < 8; ++i) {
                    float a0 = 0.f, a1 = 0.f;
#pragma unroll
                    for (int tap = 0; tap < 4; ++tap) { const float w = wp[tap * 1536 + i]; a0 = fmaf(x[tap][i], w, a0); a1 = fmaf(x[tap + 1][i], w, a1); }
                    o[0][i] = siluf_(a0); o[1][i] = siluf_(a1);
                }
            }
            if (type < 2) {
#pragma unroll
                for (int tk = 0; tk < 2; ++tk) {
                    float ss = 0.f;
#pragma unroll
                    for (int i = 0; i < 8; ++i) ss = fmaf(o[tk][i], o[tk][i], ss);
                    ss += shfl_lane(ss, lane ^ 1); ss += shfl_lane(ss, lane ^ 2); ss += shfl_lane(ss, lane ^ 4); ss += shfl_lane(ss, lane ^ 8);
                    float r = rsqrtf(ss + NORM_EPS);
                    if (type == 0) r *= 0.08838834764831845f;
#pragma unroll
                    for (int i = 0; i < 8; ++i) o[tk][i] *= r;
                }
            }
#pragma unroll
            for (int tk = 0; tk < 2; ++tk) {
                const int j = j0 + tk;
                const int ioff = half * 8192 + j * 128 + ((ch ^ swz(j)) << 4);
                if (type == 0) {
                    *(uint4*)(Qimg + ioff) = pack8(o[tk]);
                    float qd[8];
#pragma unroll
                    for (int i = 0; i < 8; ++i) qd[i] = o[tk][i] * eg[tk];
                    bf16_t* qrow = blob + (size_t)(DN_RQ + half * 64 + j) * 64 + ((c8 >> 1) & 3) * 16 + 4 * (c8 & 1);
                    uint2 w0, w1; w0.x = pk_bf16(qd[0], qd[1]); w0.y = pk_bf16(qd[2], qd[3]); w1.x = pk_bf16(qd[4], qd[5]); w1.y = pk_bf16(qd[6], qd[7]);
                    *(uint2*)qrow = w0; *(uint2*)(qrow + 8) = w1;
                } else if (type == 1) {
                    float kb[8], kbg[8];
#pragma unroll
                    for (int i = 0; i < 8; ++i) { kb[i] = o[tk][i] * be[tk]; kbg[i] = kb[i] * eg[tk]; }
                    *(uint4*)(Kimg + ioff) = pack8(o[tk]);
                    *(uint4*)(KBimg + ioff) = pack8(kb);
                    f32x4* kd = (f32x4*)(KBGf + j * 128 + c8 * 8); kd[0] = (f32x4){kbg[0], kbg[1], kbg[2], kbg[3]}; kd[1] = (f32x4){kbg[4], kbg[5], kbg[6], kbg[7]};
                } else {
                    float vb[8];
#pragma unroll
                    for (int i = 0; i < 8; ++i) vb[i] = o[tk][i] * be[tk];
                    f32x4* vd = (f32x4*)(Vf + j * 128 + c8 * 8); vd[0] = (f32x4){vb[0], vb[1], vb[2], vb[3]}; vd[1] = (f32x4){vb[4], vb[5], vb[6], vb[7]};
                }
            }
            if (type == 1) {
                const int jp = (j0 & 48) | pi16(j0 & 15);
#pragma unroll
                for (int i = 0; i < 8; ++i)
                    *(unsigned*)(blob + (size_t)(DN_RKD + c8 * 8 + i) * 64 + jp) = pk_bf16(o[0][i] * el[0], o[1][i] * el[1]);
            }
        }
    }
    __syncthreads();
    {
        const int which = wid >> 2, ti = (wid >> 1) & 1, tj = wid & 1, l31 = lane & 31, lh = lane >> 5;
        if (!(ti == 0 && tj == 1)) {
            const unsigned char* Ab = (which == 0 ? KBimg : Qimg) + (ti * 32 + l31) * 128;
            const unsigned char* Bb = Kimg + (tj * 32 + l31) * 128;
            const int fsw = swz(l31);
            f32x16 acc;
#pragma unroll
            for (int r = 0; r < 16; ++r) acc[r] = 0.f;
#pragma unroll
            for (int ks = 0; ks < 8; ++ks) {
                const int off = (ks >> 2) * 8192 + ((((ks & 3) * 2 + lh) ^ fsw) << 4);
                acc = __builtin_amdgcn_mfma_f32_32x32x16_bf16(*(const bf16x8*)(Ab + off), *(const bf16x8*)(Bb + off), acc, 0, 0, 0);
            }
            const int j = tj * 32 + l31;
            const float Gj = G2s[j];
#pragma unroll
            for (int r = 0; r < 16; ++r) {
                const int i = ti * 32 + (r & 3) + 8 * (r >> 2) + 4 * lh;
                const float v = acc[r] * exp2f(G2s[i] - Gj);
                if (which == 0) MT[j * 68 + i] = (i > j) ? v : 0.f;
                else blob[(size_t)(DN_RAT + i) * 64 + ((j & 48) | pi16(j & 15))] = to_bf16((i >= j) ? v : 0.f);
            }
        }
    }
    __syncthreads();
#ifndef NO_SOLVE
    if (tid < 256) {
        const int c = tid & 127;
        const float* rhs = (tid < 128 ? Vf : KBGf) + c;
        float y[64];
#pragma unroll
        for (int j = 0; j < 64; ++j) y[j] = rhs[j * 128];
#pragma unroll
        for (int j = 0; j < 63; ++j) {
            const float yj = y[j];
#pragma unroll
            for (int i4 = (j + 1) & ~3; i4 < 64; i4 += 4) {
                const f32x4 m = *(const f32x4*)(MT + j * 68 + i4);
#pragma unroll
                for (int u = 0; u < 4; ++u) if (i4 + u > j) y[i4 + u] = fmaf(-m[u], yj, y[i4 + u]);
            }
            asm volatile("" ::: "memory");
        }
        if (tid < 128) {
#pragma unroll
            for (int mi = 0; mi < 2; ++mi)
#pragma unroll
                for (int h = 0; h < 2; ++h) {
                    f32x4* dst = (f32x4*)(p.dnu + ((((size_t)item * 2 + mi) * 4 + (c >> 5)) * 64 + h * 32 + (c & 31)) * 16);
#pragma unroll
                    for (int g = 0; g < 4; ++g)
                        dst[g] = (f32x4){y[mi * 32 + 8 * g + 4 * h], y[mi * 32 + 8 * g + 4 * h + 1], y[mi * 32 + 8 * g + 4 * h + 2], y[mi * 32 + 8 * g + 4 * h + 3]};
                }
        } else {
            bf16_t* dst = blob + (size_t)(DN_RW + (c >> 6) * 64) * 64 + ((c & 48) | pi16(c & 15));
#pragma unroll
            for (int i = 0; i < 64; ++i) dst[(size_t)i * 64] = to_bf16(-y[i]);
        }
    }
#endif
    __syncthreads();
}

__device__ __forceinline__ void phase_dn_chunks(const Params& p, unsigned char* lds) {
    for (int item = blockIdx.x; item < NB * DNH * 32; item += gridDim.x) dn_chunk_item(p, item, lds);
}

__device__ __forceinline__ void dn_scan(const Params& p, int bh, unsigned char* lds) {
    const int tid = opaque_tid(), lane = tid & 63, wid = tid >> 6, l31 = lane & 31, lh = lane >> 5;
    const int b = bh >> 2, hh = bh & 3;
    const int fsw = swz(l31);
    if (wid >= 4) {
        const int lt = tid - 256;
        typedef unsigned u32x4v __attribute__((ext_vector_type(4)));
        const u32x4v* src = (const u32x4v*)(p.dnblob + (size_t)(bh * 32) * DN_BLOB) + lt;
        u32x4v lr[14];
#define DN_LOAD(n_) { _Pragma("unroll") for (int k = 0; k < 14; ++k) lr[k] = src[(size_t)(n_) * (DN_BLOB / 8) + k * 256]; }
#define DN_STORE(dst_) { _Pragma("unroll") for (int k = 0; k < 14; ++k) { const int c = lt + k * 256, row = c >> 3, ch = c & 7; \
            *(u32x4v*)((dst_) + row * 128 + ((ch ^ swz(row)) << 4)) = lr[k]; } }
        DN_LOAD(0); DN_STORE(lds); DN_LOAD(1);
        __builtin_amdgcn_s_waitcnt(0xc07f);
        __builtin_amdgcn_s_barrier();
        for (int n = 0; n < 32; ++n) {
            if (n + 1 < 32) { DN_STORE(lds + ((n + 1) & 1) * (DN_ROWS * 128)); if (n + 2 < 32) DN_LOAD(n + 2); }
            __builtin_amdgcn_s_waitcnt(0xc07f);
            __builtin_amdgcn_s_barrier();
        }
#undef DN_LOAD
#undef DN_STORE
        return;
    }
    __builtin_amdgcn_s_barrier();
    f32x16 S[4];
#pragma unroll
    for (int t = 0; t < 4; ++t)
#pragma unroll
        for (int r = 0; r < 16; ++r) S[t][r] = 0.f;
    f32x16 vn[2]; float lastn = 0.f;
    {
#pragma unroll
        for (int mi = 0; mi < 2; ++mi) vn[mi] = *(const f32x16*)(p.dnu + ((((size_t)(bh * 32) * 2 + mi) * 4 + wid) * 64 + lane) * 16);
        lastn = p.dnlast[bh * 32];
    }
    for (int n = 0; n < 32; ++n) {
        {
            const unsigned char* buf = lds + (n & 1) * (DN_ROWS * 128);
            const int item = bh * 32 + n;
            f32x16 oa[2];
#pragma unroll
            for (int mi = 0; mi < 2; ++mi)
#pragma unroll
                for (int r = 0; r < 16; ++r) oa[mi][r] = 0.f;
            const float last = lastn;
            typedef unsigned u32x4 __attribute__((ext_vector_type(4)));
            bf16x8 sb[4][2];
#pragma unroll
            for (int t = 0; t < 4; ++t)
#pragma unroll
                for (int ss = 0; ss < 2; ++ss) {
                    u32x4 w;
#pragma unroll
                    for (int q = 0; q < 4; ++q) w[q] = pk_bf16(S[t][8 * ss + 2 * q], S[t][8 * ss + 2 * q + 1]);
                    sb[t][ss] = __builtin_bit_cast(bf16x8, w);
                }
#pragma unroll
            for (int mi = 0; mi < 2; ++mi)
#pragma unroll
                for (int ks = 0; ks < 8; ++ks) {
                    const int off = ((ks >> 2) * 64 + mi * 32 + l31) * 128 + ((((ks & 3) * 2 + lh) ^ fsw) << 4);
                    vn[mi] = __builtin_amdgcn_mfma_f32_32x32x16_bf16(*(const bf16x8*)(buf + DN_RW * 128 + off), sb[ks >> 1][ks & 1], vn[mi], 0, 0, 0);
                    oa[mi] = __builtin_amdgcn_mfma_f32_32x32x16_bf16(*(const bf16x8*)(buf + DN_RQ * 128 + off), sb[ks >> 1][ks & 1], oa[mi], 0, 0, 0);
                }
            bf16x8 vb[2][2];
#pragma unroll
            for (int mj = 0; mj < 2; ++mj)
#pragma unroll
                for (int ss = 0; ss < 2; ++ss) {
                    u32x4 w;
#pragma unroll
                    for (int q = 0; q < 4; ++q) w[q] = pk_bf16(vn[mj][8 * ss + 2 * q], vn[mj][8 * ss + 2 * q + 1]);
                    vb[mj][ss] = __builtin_bit_cast(bf16x8, w);
                }
            {
                const int nx = (n + 1 < 32) ? item + 1 : item;
#pragma unroll
                for (int mi = 0; mi < 2; ++mi) vn[mi] = *(const f32x16*)(p.dnu + ((((size_t)nx * 2 + mi) * 4 + wid) * 64 + lane) * 16);
                lastn = p.dnlast[nx];
            }
#pragma unroll
            for (int mi = 0; mi < 2; ++mi)
#pragma unroll
                for (int kj = 0; kj < 4; ++kj)
                    if ((kj >> 1) <= mi) {
                        const int off = (DN_RAT + mi * 32 + l31) * 128 + (((kj * 2 + lh) ^ fsw) << 4);
                        oa[mi] = __builtin_amdgcn_mfma_f32_32x32x16_bf16(*(const bf16x8*)(buf + off), vb[kj >> 1][kj & 1], oa[mi], 0, 0, 0);
                    }
#pragma unroll
            for (int t = 0; t < 4; ++t) {
#pragma unroll
                for (int r = 0; r < 16; ++r) S[t][r] *= last;
#pragma unroll
                for (int kj = 0; kj < 4; ++kj) {
                    const int off = (DN_RKD + t * 32 + l31) * 128 + (((kj * 2 + lh) ^ fsw) << 4);
                    S[t] = __builtin_amdgcn_mfma_f32_32x32x16_bf16(*(const bf16x8*)(buf + off), vb[kj >> 1][kj & 1], S[t], 0, 0, 0);
                }
            }
            float* orow = p.oraw + (size_t)(b * SEQ + n * 64) * DNW + hh * 128 + wid * 32 + l31;
#pragma unroll
            for (int mi = 0; mi < 2; ++mi)
#pragma unroll
                for (int r = 0; r < 16; ++r) orow[(size_t)(mi * 32 + (r & 3) + 8 * (r >> 2) + 4 * lh) * DNW] = oa[mi][r];
        }
        __builtin_amdgcn_s_waitcnt(0xc07f);
        __builtin_amdgcn_s_barrier();
    }
}

__device__ __forceinline__ void phase_mixers(const Params& p, float* smem) {
    const int nscan = NB * DNH;
    if (gridDim.x >= 2 * nscan) {
#ifndef SKIP_SCAN
        if ((int)blockIdx.x < nscan) dn_scan(p, blockIdx.x, (unsigned char*)smem);
#endif
        if ((int)blockIdx.x < nscan) {}
        else {
            for (int it = blockIdx.x - nscan; it < 512; it += gridDim.x - nscan) sb_attn_wave(p, it >> 3, (it & 7) * 8 + (opaque_tid() >> 6));
        }
    } else {
#ifndef SKIP_SCAN
        for (int bh = blockIdx.x; bh < nscan; bh += gridDim.x) dn_scan(p, bh, (unsigned char*)smem);
#endif
        for (int it = blockIdx.x; it < 512; it += gridDim.x) sb_attn_wave(p, it >> 3, (it & 7) * 8 + (opaque_tid() >> 6));
    }
}

__device__ __forceinline__ void phase_gated_norm(const Params& p) {
    const int lane = opaque_tid() & 63, wave = (blockIdx.x * NT + opaque_tid()) >> 6, nw = (gridDim.x * NT) >> 6;
    for (int item = wave; item < T * 4; item += nw) {
        const int t = item >> 2, hh = item & 3;
        const size_t off = (size_t)t * DNW + hh * 128 + lane * 2;
        const float v0 = p.oraw[off], v1 = p.oraw[off + 1];
        const float ss = wave_sum(v0 * v0 + v1 * v1, lane);
        const float r = rsqrtf(ss * (1.f / 128.f) + NORM_EPS);
        const float z0 = bf2f(p.dzb[(size_t)t * 512 + hh * 128 + lane * 2]), z1 = bf2f(p.dzb[(size_t)t * 512 + hh * 128 + lane * 2 + 1]);
        p.oab[off] = to_bf16(v0 * r * p.norm_g[lane * 2] * siluf_(z0));
        p.oab[off + 1] = to_bf16(v1 * r * p.norm_g[lane * 2 + 1] * siluf_(z1));
    }
}

__device__ __forceinline__ void add_bf16x16(const bf16_t* src, float sc, float (&v)[16]) {
    typedef unsigned u32x4r __attribute__((ext_vector_type(4)));
    const u32x4r a = ((const u32x4r*)src)[0], b = ((const u32x4r*)src)[1];
#pragma unroll
    for (int i = 0; i < 4; ++i) {
        v[2 * i] += sc * __uint_as_float(a[i] << 16); v[2 * i + 1] += sc * __uint_as_float(a[i] & 0xffff0000u);
        v[8 + 2 * i] += sc * __uint_as_float(b[i] << 16); v[8 + 2 * i + 1] += sc * __uint_as_float(b[i] & 0xffff0000u);
    }
}
template <class SF>
__device__ __forceinline__ void layer_norm_rows(SF sf, const float* g, const float* bb, float* dst, bf16_t* dstb) {
    const int lane = opaque_tid() & 63, wave = (blockIdx.x * NT + opaque_tid()) >> 6, nw = (gridDim.x * NT) >> 6;
    const int c0 = lane * 16;
    float gg[16], be[16];
#pragma unroll
    for (int i = 0; i < 4; ++i) {
        const f32x4 x = *(const f32x4*)(g + c0 + 4 * i), y = *(const f32x4*)(bb + c0 + 4 * i);
#pragma unroll
        for (int j = 0; j < 4; ++j) { gg[4 * i + j] = x[j]; be[4 * i + j] = y[j]; }
    }
    for (int t = wave; t < T; t += nw) {
        float v[16];
        sf(t, c0, v);
        float s = 0.f;
#pragma unroll
        for (int i = 0; i < 16; ++i) s += v[i];
        const float mu = wave_sum(s, lane) * (1.f / 1024.f);
        float q = 0.f;
#pragma unroll
        for (int i = 0; i < 16; ++i) { const float d = v[i] - mu; q += d * d; }
        const float rstd = rsqrtf(wave_sum(q, lane) * (1.f / 1024.f) + LN_EPS);
        float y[16];
#pragma unroll
        for (int i = 0; i < 16; ++i) y[i] = (v[i] - mu) * rstd * gg[i] + be[i];
        if (dst) {
#pragma unroll
            for (int i = 0; i < 4; ++i) *(f32x4*)(dst + (size_t)t * D + c0 + 4 * i) = (f32x4){y[4 * i], y[4 * i + 1], y[4 * i + 2], y[4 * i + 3]};
        }
        if (dstb) {
            typedef unsigned u32x4r __attribute__((ext_vector_type(4)));
#pragma unroll
            for (int i = 0; i < 2; ++i)
                *(u32x4r*)(dstb + (size_t)t * D + c0 + 8 * i) = (u32x4r){pk_bf16(y[8 * i], y[8 * i + 1]), pk_bf16(y[8 * i + 2], y[8 * i + 3]), pk_bf16(y[8 * i + 4], y[8 * i + 5]), pk_bf16(y[8 * i + 6], y[8 * i + 7])};
        }
    }
}

__device__ __forceinline__ void phase_route(const Params& p, int* counts, int* explist, int* ldsw) {
    const int tid = opaque_tid(), lane = tid & 63;
    const int wave = (blockIdx.x * NT + tid) >> 6, nw = (gridDim.x * NT) >> 6;
    int* mye = ldsw + (tid >> 6) * 64;
    const f32x4 bias = *(const f32x4*)(p.router_bias + lane * 4);
    for (int t0 = wave; t0 < T; t0 += nw * 8) {
        f32x4 scs[8];
#pragma unroll
        for (int k = 0; k < 8; ++k) { const int t = t0 + k * nw; scs[k] = t < T ? *(const f32x4*)(p.scores + (size_t)t * NE + lane * 4) : (f32x4){0.f, 0.f, 0.f, 0.f}; }
#pragma unroll 1
        for (int k = 0; k < 8; ++k) {
            const int t = t0 + k * nw;
            if (t >= T) break;
            f32x4 sc = scs[0];
#pragma unroll
            for (int kk = 1; kk < 8; ++kk) sc = (k == kk) ? scs[kk] : sc;
            const float sel[4] = {sc[0] + bias[0], sc[1] + bias[1], sc[2] + bias[2], sc[3] + bias[3]};
            float m1 = fmaxf(sel[0], sel[1]), m2 = fminf(sel[0], sel[1]);
            m2 = fmaxf(m2, fminf(m1, sel[2])); m1 = fmaxf(m1, sel[2]);
            m2 = fmaxf(m2, fminf(m1, sel[3])); m1 = fmaxf(m1, sel[3]);
#pragma unroll
            for (int off = 1; off < 8; off <<= 1) {
                const float o1 = shfl_lane(m1, lane ^ off), o2 = shfl_lane(m2, lane ^ off);
                const float n2 = fmaxf(fminf(m1, o1), fmaxf(m2, o2));
                m1 = fmaxf(m1, o1); m2 = n2;
            }
            const float gs = m1 + m2;
            const int g = lane >> 3;
            int rank = 0;
#pragma unroll
            for (int gg = 0; gg < NG; ++gg) { const float og = __int_as_float(__builtin_amdgcn_readlane(__float_as_int(gs), gg * 8)); rank += (og > gs || (og == gs && gg < g)) ? 1 : 0; }
            const bool gsel = rank < TOPG;
            unsigned ku[4];
#pragma unroll
            for (int i = 0; i < 4; ++i) {
                const unsigned u = __float_as_uint(sel[i]);
                ku[i] = gsel ? ((u & 0x80000000u) ? ~u : (u | 0x80000000u)) : 0u;
            }
            unsigned v8 = 0u;
#pragma unroll 1
            for (int bit = 31; bit >= 0; --bit) {
                const unsigned cand = v8 | (1u << bit);
                const int c = __popcll(__ballot(ku[0] >= cand)) + __popcll(__ballot(ku[1] >= cand)) + __popcll(__ballot(ku[2] >= cand)) + __popcll(__ballot(ku[3] >= cand));
                if (c >= TOPK) v8 = cand;
            }
            int ngt = 0, eqlow = 0, sellow = 0;
            unsigned long long eqm[4];
#pragma unroll
            for (int i = 0; i < 4; ++i) { ngt += __popcll(__ballot(ku[i] > v8)); eqm[i] = __ballot(ku[i] == v8); }
            const int need = TOPK - ngt;
#pragma unroll
            for (int i = 0; i < 4; ++i) eqlow += __builtin_amdgcn_mbcnt_hi((unsigned)(eqm[i] >> 32), __builtin_amdgcn_mbcnt_lo((unsigned)eqm[i], 0u));
            bool selc[4]; int eqrank = eqlow;
#pragma unroll
            for (int i = 0; i < 4; ++i) {
                const bool eq = ku[i] == v8;
                selc[i] = (ku[i] > v8) || (eq && eqrank < need);
                eqrank += eq ? 1 : 0;
            }
            float part = 0.f;
#pragma unroll
            for (int i = 0; i < 4; ++i) {
                const unsigned long long sm = __ballot(selc[i]);
                part += selc[i] ? sc[i] : 0.f;
                sellow += __builtin_amdgcn_mbcnt_hi((unsigned)(sm >> 32), __builtin_amdgcn_mbcnt_lo((unsigned)sm, 0u));
            }
            const float wsum = wave_sum(part, lane);
            int slot = sellow;
#pragma unroll
            for (int i = 0; i < 4; ++i)
                if (selc[i]) {
                    const int e = lane * 4 + i, pr = t * TOPK + slot;
                    p.gate[pr] = sc[i] / wsum * 2.5f;
                    mye[k * 8 + slot] = e;
                    ++slot;
                }
        }
        {
            const int k = lane >> 3, t = t0 + k * nw;
            if (t < T) {
                const int e = mye[lane], pos = atomicAdd(&counts[e * CSTRIDE], 1);
                explist[(size_t)e * ECAP + pos] = t * TOPK + (lane & 7);
            }
        }
    }
}

__device__ __forceinline__ void compute_pend(const Params& p, int* pend, int* cnt) {
    const int tid = opaque_tid();
    if (tid < 64) {
        int c[4], pc[4];
#pragma unroll
        for (int i = 0; i < 4; ++i) { c[i] = p.counts[(tid * 4 + i) * CSTRIDE]; cnt[tid * 4 + i] = c[i]; pc[i] = (c[i] + 127) / 128 * 128; }
        const int ssum = pc[0] + pc[1] + pc[2] + pc[3];
        int inc = ssum;
#pragma unroll
        for (int off = 1; off < 64; off <<= 1) { const int v = shfl_lane_i(inc, tid - off); if (tid >= off) inc += v; }
        int run = inc - ssum;
#pragma unroll
        for (int i = 0; i < 4; ++i) { run += pc[i]; pend[tid * 4 + i] = run; }
    }
    __syncthreads();
}

__device__ __forceinline__ int expert_of_row(const int* pend, int row) {
    int lo = 0, hi = NE - 1;
    while (lo < hi) { const int mid = (lo + hi) >> 1; if (pend[mid] > row) hi = mid; else lo = mid + 1; }
    return lo;
}

__device__ __forceinline__ void phase_routed(const Params& p, int* pend, int* cnt, unsigned char* lds) {
    typedef GemmCfg<128, 256, 2, 4> CFG;
    compute_pend(p, pend, cnt);
    int* prs = (int*)(lds + 131072); float* gts = (float*)(lds + 131072 + 512);
    const bool grouped = (gridDim.x % 8) == 0;
    const int xg = grouped ? (blockIdx.x & 7) : 0, estep = grouped ? 8 : 1;
    const int nslots = grouped ? (gridDim.x >> 3) : gridDim.x;
    int widx = grouped ? (blockIdx.x >> 3) : blockIdx.x, tbase = 0;
    for (int e = xg; e < NE; e += estep) {
      const int ce = cnt[e], ntile = (ce + 127) >> 7;
      for (; widx < tbase + ntile; widx += nslots) {
        const int q0 = (widx - tbase) * 128;
        {
            const int tid = opaque_tid();
            if (tid < 128) {
                const int pr = (q0 + tid < ce) ? p.explist[(size_t)e * ECAP + q0 + tid] : -1;
                prs[tid] = pr; gts[tid] = pr >= 0 ? p.gate[pr] : 0.f;
            }
        }
        __syncthreads();
#pragma unroll 1
        for (int tn_ = 0; tn_ < 2 * RU; ++tn_) {
            const int tn = tn_ & 1;
            LoadRowsBf16N<128, 3> al; LoadKNF32N<3> bl;
            al.init(p.hb, D, [&](int r) { const int pr = prs[r]; return (long long)(pr >= 0 ? (pr >> 3) : 0); });
            bl.init(p.w_eu + (size_t)e * D * (2 * EFF), 2 * EFF, [&](int r) { return ((r >> 5) & 1) * EFF + tn * 128 + (r >> 6) * 32 + (r & 31); });
            f32x16 acc[CFG::MI][CFG::NI];
            acc_zero<CFG>(acc);
            gemm_mainloop_d3<CFG, false>(al, bl, D / 64, acc, lds);
            const int tid = opaque_tid(), lane = tid & 63, wid = tid >> 6, wm = wid / CFG::WN, wn = wid % CFG::WN;
            const int j = tn * 128 + wn * 32 + (lane & 31);
            unsigned char* img = lds + 65536 + (((j >> 6) + 2) & 3) * 16384 + (j & 7) * 2;
            const int jc = (j & 63) >> 3;
#pragma unroll
            for (int mi = 0; mi < CFG::MI; ++mi)
#pragma unroll
                for (int r = 0; r < 16; ++r) {
                    const int row = wm * CFG::TM + mi * 32 + (r & 3) + 8 * (r >> 2) + 4 * (lane >> 5);
                    *(bf16_t*)(img + row * 128 + ((jc ^ swz(row)) << 4)) = to_bf16(siluf_(acc[mi][0][r]) * acc[mi][1][r]);
                }
        }
        __syncthreads();
#pragma unroll 1
        for (int tn_ = 0; tn_ < 4 * RD; ++tn_) {
            const int tn = tn_ & 3;
            LoadRowsBf16<128> aldummy[2]; LoadKNF32 bl[2];
#pragma unroll
            for (int u = 0; u < 2; ++u) bl[u].init(p.w_ed + (size_t)e * EFF * D, D, [&](int r) { return tn * 256 + r; });
            f32x16 acc[CFG::MI][CFG::NI];
            acc_zero<CFG>(acc);
            gemm_mainloop2<CFG, true, 2, true>(aldummy, bl, EFF / 64, acc, lds, lds + 65536);
            {
                const int tid = opaque_tid(), lane = tid & 63, wid = tid >> 6, wm = wid / CFG::WN, wn = wid % CFG::WN;
#pragma unroll
                for (int mi = 0; mi < CFG::MI; ++mi) {
                    const int row = wm * CFG::TM + mi * 32 + (lane & 31);
                    const int pr = prs[row]; const float g = gts[row];
                    if (pr >= 0) {
#pragma unroll
                        for (int ni = 0; ni < CFG::NI; ++ni) {
                            bf16_t* dst = p.ypairb + (size_t)pr * D + tn * 256 + wn * CFG::TN + ni * 32 + 4 * (lane >> 5);
#pragma unroll
                            for (int gq = 0; gq < 4; ++gq) {
                                uint2 w; w.x = pk_bf16(acc[mi][ni][4 * gq] * g, acc[mi][ni][4 * gq + 1] * g); w.y = pk_bf16(acc[mi][ni][4 * gq + 2] * g, acc[mi][ni][4 * gq + 3] * g);
                                *(uint2*)(dst + 8 * gq) = w;
                            }
                        }
                    }
                }
            }
        }
        __syncthreads();
      }
      tbase += ntile;
    }
}

#ifndef R0
#define R0 1
#define R1 1
#define R2 1
#define R3 1
#define R4 1
#define R5 1
#define R6 1
#define R7 1
#define R8 1
#define R10 1
#define R11 1
#define R12 1
#endif

constexpr int LDS_MAIN = 133120;
__global__ void __launch_bounds__(NT) fwd_megakernel(KArgs ka) {
    __shared__ __attribute__((aligned(16))) unsigned char lds[LDS_MAIN + 2 * NE * 4 + 16];
    float* smem = (float*)lds;
    int* pend = (int*)(lds + LDS_MAIN);
    int* cnt = pend + NE;
    volatile LAS3 unsigned* xbst = (volatile LAS3 unsigned*)(lds + LDS_MAIN + 2 * NE * 4);
    if (threadIdx.x == 0) { xbst[0] = 0u; xbst[1] = 0u; }
    __syncthreads();
    const XcdBarrier xb = xcd_barrier_post((unsigned*)(ka.ws + OFF_BAR), xbst);

#define REPEAT(N, ...) { int reps_ = (N); asm volatile("" : "+s"(reps_)); for (int rep_ = 0; rep_ < reps_; ++rep_) { { const Params p(ka); __VA_ARGS__; } xcd_barrier(xb); } }
    { const Params p(ka); phase_init(p); }
    REPEAT(R0,
        convert_bf16(p.x, p.xb, (size_t)T * D);
        transpose_convert(p.w_in, D, PW, PWP, p.w_in_t, smem, [](int n) { return n < 2048 ? n : n < 5632 ? n + 8 : n < 5640 ? n - 5632 + 2048 : -1; });
        transpose_convert(p.w_pa, DNW, D, D, p.w_pa_t, smem, [](int n) { return n; });
        transpose_convert(p.w_pb, SBW, D, D, p.w_pb_t, smem, [](int n) { return n; });
        transpose_convert(p.w_out, D, D, D, p.w_out_t, smem, [](int n) { return n; });
        transpose_convert(p.w_router, D, NE, NE, p.w_router_t, smem, [](int n) { return n; });
        transpose_convert(p.w_su, D, 2 * SFF, 2 * SFF, p.w_su_t, smem, [](int n) { return n; });
        transpose_convert(p.w_sd, SFF, D, D, p.w_sd_t, smem, [](int n) { return n; }))
    REPEAT(R1, phase_inproj(p, lds))
    REPEAT(R2, phase_dn_chunks(p, lds))
    REPEAT(R3, phase_mixers(p, smem))
    REPEAT(R4, phase_gated_norm(p))
    REPEAT(R5, phase_merge(p, lds))
    REPEAT(R6, phase_outproj(p, lds))
    REPEAT(R7, layer_norm_rows([&](int t, int c0, float (&v)[16]) {
            _Pragma("unroll") for (int i = 0; i < 4; ++i) { const f32x4 x = *(const f32x4*)(p.pre1 + (size_t)t * D + c0 + 4 * i); v[4 * i] = x[0]; v[4 * i + 1] = x[1]; v[4 * i + 2] = x[2]; v[4 * i + 3] = x[3]; } },
        p.ln1_g, p.ln1_b, nullptr, p.hb))
    REPEAT(R8, phase_router_shared_up(p, lds))
    { const Params p(ka); phase_route(p, p.counts, p.explist, (int*)lds); }
    xcd_barrier(xb);
    { int reps9 = R9 - 1; asm volatile("" : "+s"(reps9)); for (int r9 = 0; r9 < reps9; ++r9) { const Params p(ka); phase_route(p, p.counts + NE * CSTRIDE, (int*)p.ypairb, (int*)lds); xcd_barrier(xb); } }
    { int repsb = RB; asm volatile("" : "+s"(repsb)); for (int rb = 0; rb < repsb; ++rb) xcd_barrier(xb); }
    REPEAT(R10, phase_routed(p, pend, cnt, lds); phase_shared_down(p, lds))
    int reps12 = R12; asm volatile("" : "+s"(reps12));
    for (int rep = 0; rep < reps12; ++rep) {
        const Params p(ka);
        layer_norm_rows([&](int t, int c0, float (&v)[16]) {
#pragma unroll
                for (int i = 0; i < 16; ++i) v[i] = 0.f;
                add_bf16x16(p.hb + (size_t)t * D + c0, ALPHA, v);
                add_bf16x16(p.yshb + (size_t)t * D + c0, 1.f, v);
#pragma unroll
                for (int k = 0; k < TOPK; ++k) add_bf16x16(p.ypairb + ((size_t)t * TOPK + k) * D + c0, 1.f, v); },
            p.ln2_g, p.ln2_b, p.out, nullptr);
    }
}

extern "C" void kernel_launch(void* const* d_in, const int* in_sizes, int n_in, void* d_out, int out_size, void* d_ws,
                              size_t ws_size, hipStream_t stream) {
    static int grid_blocks = 0;
    if (!grid_blocks) {
        int dev = 0, cus = 0, per_cu = 0;
        hipGetDevice(&dev);
        hipDeviceGetAttribute(&cus, hipDeviceAttributeMultiprocessorCount, dev);
        hipOccupancyMaxActiveBlocksPerMultiprocessor(&per_cu, fwd_megakernel, NT, 0);
        if (per_cu > 1) per_cu = 1;
        grid_blocks = cus * per_cu;
    }
    KArgs p{};
    const float* const* in = (const float* const*)d_in;
    p.x = in[0]; p.w_in = in[1]; p.conv_w = in[2]; p.a_log = in[3]; p.dt_bias = in[4]; p.norm_g = in[5]; p.w_pa = in[6];
    p.w_pb = in[7]; p.w_out = in[8]; p.ln1_g = in[9]; p.ln1_b = in[10]; p.w_router = in[11]; p.router_bias = in[12];
    p.w_su = in[13]; p.w_sd = in[14]; p.w_eu = in[15]; p.w_ed = in[16]; p.ln2_g = in[17]; p.ln2_b = in[18];
    p.out = (float*)d_out; p.ws = (unsigned char*)d_ws;
    if (WS_BYTES > ws_size) { fprintf(stderr, "workspace too small: need %zu have %zu\n", (size_t)WS_BYTES, ws_size); return; }
    hipMemsetAsync(p.ws + OFF_BAR, 0, XCD_BAR_WORDS * 4, stream);
    void* args[] = {&p};
    hipError_t e = hipLaunchCooperativeKernel((void*)fwd_megakernel, dim3(grid_blocks), dim3(NT), args, 0, stream);
    if (e != hipSuccess) fprintf(stderr, "cooperative launch failed: %s (grid %d)\n", hipGetErrorString(e), grid_blocks);
}
```

```cpp
#include <hip/hip_runtime.h>
#include <hip/hip_cooperative_groups.h>
#include <cstdio>
#include <cstdint>
namespace cg = cooperative_groups;

constexpr int D = 1024, NB = 8, SEQ = 2048, T = NB * SEQ;
constexpr int DNH = 4, DND = 128, DNW = 512;
constexpr int SBH = 8, SBD = 64, SBW = 512;
constexpr int NE = 256, TOPK = 8, NG = 8, TOPG = 4, EFF = 256, SFF = 256;
constexpr int PW = 5640;
constexpr int NPAIR = T * TOPK;
constexpr int NBLK = (NPAIR + NE * 127 + 127) / 128;
constexpr int PROWS = NBLK * 128;
constexpr float ALPHA = 1.189207115002721f;
constexpr float LN_EPS = 1e-5f, NORM_EPS = 1e-6f;
constexpr int NT = 512;
#ifndef RU
#define RU 1
#define RD 1
#define R9 1
#define RB 0
#endif

typedef unsigned short bf16_t;
constexpr int PWP = 5888;
constexpr int DN_ROWS = 448, DN_BLOB = DN_ROWS * 64;
constexpr int ECAP = T;
#define XCD_BAR_WORDS 3456
constexpr int CSTRIDE = 64;
constexpr size_t al256(size_t x) { return (x + 255) & ~(size_t)255; }
constexpr size_t OFF_XB = 0;
constexpr size_t OFF_WINT = OFF_XB + al256((size_t)T * D * 2);
constexpr size_t OFF_QKVRAW = OFF_WINT + al256((size_t)PWP * D * 2);
constexpr size_t OFF_DZB = OFF_QKVRAW + al256((size_t)T * 1536 * 2);
constexpr size_t OFF_SQ = OFF_DZB + al256((size_t)T * 512 * 2);
constexpr size_t OFF_SK = OFF_SQ + al256((size_t)T * 512 * 2);
constexpr size_t OFF_VT = OFF_SK + al256((size_t)T * 512 * 2);
constexpr size_t OFF_DNBLOB = OFF_VT + al256((size_t)T * 512 * 2);
constexpr size_t OFF_DNU = OFF_DNBLOB + al256((size_t)1024 * DN_BLOB * 2);
constexpr size_t OFF_DNLAST = OFF_DNU + al256((size_t)1024 * 64 * 128 * 4);
constexpr size_t OFF_GAB = OFF_DNLAST + al256(1024 * 4);
constexpr size_t OFF_GBB = OFF_GAB + al256((size_t)T * D * 2);
constexpr size_t OFF_SMALL = OFF_GBB + al256((size_t)T * D * 2);
constexpr size_t OFF_WPAT = OFF_SMALL + al256((size_t)T * 8 * 4);
constexpr size_t OFF_WPBT = OFF_WPAT + al256((size_t)D * DNW * 2);
constexpr size_t OFF_WOUTT = OFF_WPBT + al256((size_t)D * SBW * 2);
constexpr size_t OFF_WROUTT = OFF_WOUTT + al256((size_t)D * D * 2);
constexpr size_t OFF_WSUT = OFF_WROUTT + al256((size_t)NE * D * 2);
constexpr size_t OFF_WSDT = OFF_WSUT + al256((size_t)2 * SFF * D * 2);
constexpr size_t OFF_OAB = OFF_WSDT + al256((size_t)D * SFF * 2);
constexpr size_t OFF_OBB = OFF_OAB + al256((size_t)T * DNW * 2);
constexpr size_t OFF_MERGED = OFF_OBB + al256((size_t)T * SBW * 2);
constexpr size_t OFF_HB = OFF_MERGED + al256((size_t)T * D * 2);
constexpr size_t OFF_ACTSH = OFF_HB + al256((size_t)T * D * 2);
constexpr size_t OFF_YPAIRB = OFF_ACTSH + al256((size_t)T * SFF * 2);
constexpr size_t OFF_ORAW = OFF_YPAIRB + al256((size_t)NPAIR * D * 2);
constexpr size_t OFF_PRE1 = OFF_ORAW + al256((size_t)T * DNW * 4);
constexpr size_t OFF_H = OFF_PRE1 + al256((size_t)T * D * 4);
constexpr size_t OFF_SCORES = OFF_H + al256((size_t)T * D * 4);
constexpr size_t OFF_GATE = OFF_SCORES + al256((size_t)T * NE * 4);
constexpr size_t OFF_YSH = OFF_GATE + al256((size_t)NPAIR * 4);
constexpr size_t OFF_IDX = OFF_YSH + al256((size_t)T * D * 4);
constexpr size_t OFF_COUNTS = OFF_IDX + al256((size_t)NPAIR * 4);
constexpr size_t OFF_EXPLIST = OFF_COUNTS + al256(2 * NE * CSTRIDE * 4);
constexpr size_t OFF_WEUT = OFF_EXPLIST + al256((size_t)NE * ECAP * 4);
constexpr size_t OFF_M1 = OFF_WEUT + al256((size_t)NE * 2 * EFF * D * 2);
constexpr size_t OFF_BAR = OFF_M1 + al256((size_t)T * D * 4);
constexpr size_t WS_BYTES = OFF_BAR + al256(XCD_BAR_WORDS * 4);

struct KArgs {
    const float *x, *w_in, *conv_w, *a_log, *dt_bias, *norm_g, *w_pa, *w_pb, *w_out, *ln1_g, *ln1_b, *w_router,
        *router_bias, *w_su, *w_sd, *w_eu, *w_ed, *ln2_g, *ln2_b;
    float* out; unsigned char* ws;
};
struct Params {
    const float *x, *w_in, *conv_w, *a_log, *dt_bias, *norm_g, *w_pa, *w_pb, *w_out, *ln1_g, *ln1_b, *w_router,
        *router_bias, *w_su, *w_sd, *w_eu, *w_ed, *ln2_g, *ln2_b;
    float* out;
    float *oraw, *pre1, *h, *scores, *gate, *ysh, *small, *dnu, *dnlast, *m1;
    int *idx, *counts, *explist;
    bf16_t *xb, *w_in_t, *w_pa_t, *w_pb_t, *w_out_t, *w_router_t, *w_su_t, *w_sd_t, *oab, *obb, *mergedb, *hb, *actsh, *ypairb, *yshb;
    bf16_t *qkvraw, *dzb, *sq, *sk, *vT, *gab, *gbb, *dnblob, *w_eu_t;
    unsigned* bar;
    __device__ __forceinline__ explicit Params(const KArgs& k) {
        x = k.x; w_in = k.w_in; conv_w = k.conv_w; a_log = k.a_log; dt_bias = k.dt_bias; norm_g = k.norm_g; w_pa = k.w_pa; w_pb = k.w_pb;
        w_out = k.w_out; ln1_g = k.ln1_g; ln1_b = k.ln1_b; w_router = k.w_router; router_bias = k.router_bias; w_su = k.w_su; w_sd = k.w_sd;
        w_eu = k.w_eu; w_ed = k.w_ed; ln2_g = k.ln2_g; ln2_b = k.ln2_b; out = k.out;
        unsigned char* w = k.ws; asm volatile("" : "+s"(w));
        xb = (bf16_t*)(w + OFF_XB); w_in_t = (bf16_t*)(w + OFF_WINT); qkvraw = (bf16_t*)(w + OFF_QKVRAW); dzb = (bf16_t*)(w + OFF_DZB);
        sq = (bf16_t*)(w + OFF_SQ); sk = (bf16_t*)(w + OFF_SK); vT = (bf16_t*)(w + OFF_VT); dnblob = (bf16_t*)(w + OFF_DNBLOB);
        dnu = (float*)(w + OFF_DNU); dnlast = (float*)(w + OFF_DNLAST); gab = (bf16_t*)(w + OFF_GAB); gbb = (bf16_t*)(w + OFF_GBB);
        small = (float*)(w + OFF_SMALL); w_pa_t = (bf16_t*)(w + OFF_WPAT); w_pb_t = (bf16_t*)(w + OFF_WPBT); w_out_t = (bf16_t*)(w + OFF_WOUTT);
        w_router_t = (bf16_t*)(w + OFF_WROUTT); w_su_t = (bf16_t*)(w + OFF_WSUT); w_sd_t = (bf16_t*)(w + OFF_WSDT);
        oab = (bf16_t*)(w + OFF_OAB); obb = (bf16_t*)(w + OFF_OBB); mergedb = (bf16_t*)(w + OFF_MERGED); hb = (bf16_t*)(w + OFF_HB);
        actsh = (bf16_t*)(w + OFF_ACTSH); ypairb = (bf16_t*)(w + OFF_YPAIRB); oraw = (float*)(w + OFF_ORAW); pre1 = (float*)(w + OFF_PRE1);
        h = (float*)(w + OFF_H); scores = (float*)(w + OFF_SCORES); gate = (float*)(w + OFF_GATE); ysh = (float*)(w + OFF_YSH); yshb = (bf16_t*)(w + OFF_YSH);
        idx = (int*)(w + OFF_IDX); counts = (int*)(w + OFF_COUNTS); explist = (int*)(w + OFF_EXPLIST); bar = (unsigned*)(w + OFF_BAR); w_eu_t = (bf16_t*)(w + OFF_WEUT); m1 = (float*)(w + OFF_M1);
    }
};

__device__ __forceinline__ float sigmoidf_(float v) { return 1.f / (1.f + expf(-v)); }
__device__ __forceinline__ float siluf_(float v) { return v / (1.f + expf(-v)); }
__device__ __forceinline__ float shfl_lane(float v, int src) { return __int_as_float(__builtin_amdgcn_ds_bpermute(src << 2, __float_as_int(v))); }
__device__ __forceinline__ int shfl_lane_i(int v, int src) { return __builtin_amdgcn_ds_bpermute(src << 2, v); }
__device__ __forceinline__ float wave_sum(float v, int lane) {
#pragma unroll
    for (int o = 32; o > 0; o >>= 1) v += shfl_lane(v, lane ^ o);
    return v;
}


#define XB_TMO      128
#define XB_XCNT(j)  (256  + 64 * (j))
#define XB_XSUB(j)  (1280 + 64 * (j))
#define XB_XGEN(j)  (2304 + 64 * (j))
#define XB_TOP      3328
#define XB_TOPGEN   3392
#define XB_SPIN_CAP (1u << 24)
#define LAS3 __attribute__((address_space(3)))
__device__ __forceinline__ unsigned xb_ld(unsigned* p)              { return __hip_atomic_load(p, __ATOMIC_RELAXED, __HIP_MEMORY_SCOPE_AGENT); }
__device__ __forceinline__ unsigned xb_add(unsigned* p, unsigned v) { return __hip_atomic_fetch_add(p, v, __ATOMIC_RELAXED, __HIP_MEMORY_SCOPE_AGENT); }
__device__ __forceinline__ unsigned xb_xcc_id() { return (unsigned)__builtin_amdgcn_s_getreg((3 << 11) | 20) & 0xFu; }
#define XB_SPIN(cond, bar) do { unsigned _sp = 0; while (cond) { __builtin_amdgcn_s_sleep(1); \
    if ((++_sp & 255u) == 0u) { if (xb_ld(&(bar)[XB_TMO])) break; if (_sp > XB_SPIN_CAP) { atomicAdd(&(bar)[XB_TMO], 1u); break; } } } } while (0)
struct XcdBarrier { unsigned* bar; unsigned x; volatile LAS3 unsigned* st; };
__device__ __forceinline__ XcdBarrier xcd_barrier_post(unsigned* bar, volatile LAS3 unsigned* st) {
    XcdBarrier b; b.bar = bar; b.x = xb_xcc_id(); b.st = st;
    if (threadIdx.x == 0) st[2] = xb_add(&bar[XB_XCNT(b.x)], 1u);
    return b;
}
__device__ __forceinline__ void xcd_barrier_complete(unsigned* bar, unsigned x, unsigned& nloc, unsigned& nx, int& vbx) {
    const unsigned G = gridDim.x * gridDim.y * gridDim.z;
    unsigned sum, cnt, mine, sp = 0u, xlow = 0u; bool uni = true;
    asm volatile("" : "+s"(x));
    for (;;) {
        sum = 0u; cnt = 0u; mine = 0u;
        xlow = 0u; uni = true; unsigned first = 0u;
#pragma unroll 1
        for (unsigned j = 0; j < 16; ++j) { const unsigned c = xb_ld(&bar[XB_XCNT(j)]); sum += c; cnt += (c > 0u) ? 1u : 0u; mine = (j == x) ? c : mine;
            xlow += (c > 0u && j < x) ? 1u : 0u; if (c) { if (first == 0u) first = c; else if (c != first) uni = false; } }
        if (sum == G) break;
        __builtin_amdgcn_s_sleep(1);
        if ((++sp & 255u) == 0u) { if (xb_ld(&bar[XB_TMO])) break; if (sp > XB_SPIN_CAP) { atomicAdd(&bar[XB_TMO], 1u); break; } }
    }
    nloc = mine > 0u ? mine : 1u; nx = cnt > 0u ? cnt : 1u;
    vbx = (uni && cnt == 8u && mine * 8u == G) ? (int)xlow : -1;
}
__device__ __forceinline__ void xcd_barrier(const XcdBarrier& b) {
    asm volatile("s_waitcnt vmcnt(0)" ::: "memory");
    __syncthreads();
    if (threadIdx.x == 0) {
        unsigned* bar = b.bar;
        __builtin_amdgcn_s_waitcnt(0);
        unsigned nloc = b.st[0], nx = b.st[1];
        if (nloc == 0u) { int vbx; xcd_barrier_complete(bar, b.x, nloc, nx, vbx); b.st[0] = nloc; b.st[1] = nx; if (vbx >= 0) b.st[3] = b.st[2] * 8u + (unsigned)vbx; }
        const unsigned old = xb_add(&bar[XB_XSUB(b.x)], 1u);
        const unsigned gen = old / nloc;
        if (old + 1u == (gen + 1u) * nloc) {
            __builtin_amdgcn_fence(__ATOMIC_RELEASE, "agent");
            asm volatile("s_waitcnt vmcnt(0)" ::: "memory");
            const unsigned og = xb_add(&bar[XB_TOP], 1u);
            const unsigned tg = og / nx;
            if (og + 1u == (tg + 1u) * nx) xb_add(&bar[XB_TOPGEN], 1u);
            else XB_SPIN(xb_ld(&bar[XB_TOPGEN]) == tg, bar);
            __builtin_amdgcn_fence(__ATOMIC_ACQUIRE, "agent");
            xb_add(&bar[XB_XGEN(b.x)], 1u);
            asm volatile("s_waitcnt vmcnt(0)" ::: "memory");
        } else {
            XB_SPIN(xb_ld(&bar[XB_XGEN(b.x)]) == gen, bar);
            __builtin_amdgcn_fence(__ATOMIC_ACQUIRE, "agent");
            asm volatile("s_waitcnt vmcnt(0)" ::: "memory");
        }
    }
    __syncthreads();
}

constexpr int VB_LDS_OFF = 133120 + 2 * 256 * 4 + 12;
__device__ __forceinline__ int vblock() { return *(const volatile LAS3 int*)(unsigned long)(VB_LDS_OFF); }
typedef short bf16x8 __attribute__((ext_vector_type(8)));
typedef float f32x16 __attribute__((ext_vector_type(16)));
typedef float f32x4 __attribute__((ext_vector_type(4)));
__device__ __forceinline__ unsigned pk_bf16(float a, float b) {
    typedef __bf16 bf2 __attribute__((ext_vector_type(2)));
    typedef float f2 __attribute__((ext_vector_type(2)));
    f2 v = {a, b};
    bf2 r = __builtin_convertvector(v, bf2);
    return __builtin_bit_cast(unsigned, r);
}
__device__ __forceinline__ bf16_t to_bf16(float a) { return (bf16_t)(pk_bf16(a, 0.f) & 0xffffu); }
__device__ __forceinline__ float bf2f(bf16_t v) { return __uint_as_float((unsigned)v << 16); }

__device__ __forceinline__ int opaque_tid() { int t = threadIdx.x; asm volatile("" : "+v"(t)); return t; }
constexpr int LROW = 128;
__device__ __forceinline__ int swz(int r) { return ((r >> 2) & 7) ^ ((r >> 1) & 1); }

template <int ROWS, bool MAYBE_NULL = false> struct LoadRowsBf16 {
    static constexpr int NCH = ROWS * 8 / NT;
    const bf16_t* base; int tid;
    unsigned off[NCH];
    typedef unsigned u32x4r __attribute__((ext_vector_type(4)));
    u32x4r regs[NCH];
    template <class RF> __device__ __forceinline__ void init(const bf16_t* base_, int ld, RF rowfn) {
        base = base_; tid = opaque_tid();
#pragma unroll
        for (int i = 0; i < NCH; ++i) {
            const int c = tid + i * NT, r = c >> 3, ch = c & 7;
            const long long src = rowfn(r);
            off[i] = (!MAYBE_NULL || src >= 0) ? (unsigned)(src * ld + ch * 8) : 0xffffffffu;
        }
    }
    __device__ __forceinline__ void load(int k0) {
#pragma unroll
        for (int i = 0; i < NCH; ++i)
            regs[i] = (!MAYBE_NULL || off[i] != 0xffffffffu) ? *(const u32x4r*)(base + (size_t)off[i] + k0) : (u32x4r){0u, 0u, 0u, 0u};
    }
    __device__ __forceinline__ void store(unsigned char* lds) const {
#pragma unroll
        for (int i = 0; i < NCH; ++i) {
            const int c = tid + i * NT, r = c >> 3, ch = c & 7;
            *(u32x4r*)(lds + r * LROW + ((ch ^ swz(r)) << 4)) = regs[i];
        }
    }
};

__device__ __forceinline__ int pi16(int x) { return (x & ~12) | ((x & 4) << 1) | ((x & 8) >> 1); }
namespace pg8 {
#define PG8_LAS __attribute__((address_space(3)))
typedef unsigned short bf16_t;
typedef short bf16x8 __attribute__((ext_vector_type(8)));
typedef float f32x4 __attribute__((ext_vector_type(4)));
typedef unsigned u32x4 __attribute__((ext_vector_type(4)));
constexpr int BM = 256, BK = 64, HALF = 128, HTB = HALF * BK * 2  , STAGE_BYTES = 8 * HTB, NXCD = 8, WGM = 8;

__host__ __device__ __forceinline__ int lds_byte(int r, int c) { const int st = (r >> 4) * 2 + (c >> 5), rr = r & 15, cc = c & 31, ob = rr * 64 + cc * 2; return st * 1024 + (ob ^ (((ob >> 9) & 1) << 5)); }
__host__ __device__ __forceinline__ void stage_rc(int b, int& R, int& C) { const int st = b / 1024, sb = b % 1024, swz = sb ^ (((sb >> 9) & 1) << 5); R = (st >> 1) * 16 + swz / 64; C = (st & 1) * 32 + (swz % 64) / 2; }
__host__ __device__ __forceinline__ int perm32(int rho) { const int n = rho >> 4, i = rho & 15; return 8 * (i >> 2) + 4 * n + (i & 3); }

struct Unit { int pm, pn; };
struct Gemm { const bf16_t* A; const bf16_t* Bt; int M, N, K; };

struct StaticOrder {
    int nM, nN, nwg, G, c;
    __host__ __device__ void init(int M, int N, int G_, int c_) { nM = M / BM; nN = N / BM; nwg = nM * nN; G = G_; c = c_; }
    __host__ __device__ bool next(int i, Unit& u) const {
        const long L = (long)i * G + c; if (L >= nwg) return false;
        int wgid = (int)L; { const int q = nwg / NXCD, r = nwg % NXCD, xcd = wgid % NXCD, off = wgid / NXCD; wgid = (xcd < r ? xcd * (q + 1) : r * (q + 1) + (xcd - r) * q) + off; }
        const int nig = WGM * nN, gid = wgid / nig, fm = gid * WGM, gsz = (nM - fm) < WGM ? (nM - fm) : WGM;
        u.pm = fm + ((wgid % nig) % gsz); u.pn = (wgid % nig) / gsz; return true;
    }
    __device__ __forceinline__ void a_ready(const Unit&) const {}
    __device__ __forceinline__ void done(const Unit&) const {}
};


__device__ __forceinline__ unsigned cvt_pk_bf16(float lo, float hi) { unsigned r; asm volatile("v_cvt_pk_bf16_f32 %0, %1, %2" : "=v"(r) : "v"(lo), "v"(hi)); return r; }

template <class Epi, class Sched, bool ALIGN_EPI = false, bool SP2 = false>
__device__ __forceinline__ void gemm_phase(PG8_LAS unsigned char* lds, const Gemm g, const Sched& S, const Epi& E) {
    const int tid = opaque_tid(), wid = __builtin_amdgcn_readfirstlane(tid >> 6), lane = tid & 63, wr = wid >> 2, wc = wid & 3, fr = lane & 15, fq = lane >> 4;
    const int K = g.K, nt = K / BK;
    unsigned voffA[2], voffB[2];
#pragma unroll
    for (int i = 0; i < 2; ++i) { int R, C; stage_rc(tid * 16 + i * 8192, R, C); const int Rb = Epi::PERM ? ((R & ~31) + perm32(R & 31)) : R;
        voffA[i] = (unsigned)(R * K + C) * 2u; voffB[i] = (unsigned)(Rb * K + C) * 2u; }
    const size_t rstep64 = (size_t)64 * K * 2;
    const size_t kstep = (size_t)(BK * 2);
    const size_t hstep = (size_t)HALF * K * 2;
    const size_t tstep = 2 * hstep;
    const unsigned ldsw = (unsigned)wid * 1024u;
    const int aoff = lds_byte(wr * 64 + fr, fq * 8), boff = lds_byte(wc * 32 + fr, fq * 8);
#define PG8_SA(b, h) (((b) * 2 + (h)) * HTB)
#define PG8_SB(b, h) ((4 + (b) * 2 + (h)) * HTB)
#define PG8_STAGE(bufoff, gbase, voff) do { _Pragma("unroll") for (int _i = 0; _i < 2; ++_i) \
        __builtin_amdgcn_global_load_lds((const unsigned*)((const char*)(gbase) + (size_t)_i * rstep64 + (voff)[0]), (PG8_LAS unsigned*)(lds + (bufoff) + ldsw + _i * 8192), 16, 0, 0); } while (0)
#define PG8_LDA(dst, b, h) do { _Pragma("unroll") for (int m = 0; m < 4; ++m) _Pragma("unroll") for (int k = 0; k < 2; ++k) dst[m][k] = *(const PG8_LAS bf16x8*)(lds + PG8_SA(b, h) + aoff + m * 2048 + k * 1024); } while (0)
#define PG8_LDB(dst, b, h) do { _Pragma("unroll") for (int n = 0; n < 2; ++n) _Pragma("unroll") for (int k = 0; k < 2; ++k) dst[n][k] = *(const PG8_LAS bf16x8*)(lds + PG8_SB(b, h) + boff + n * 2048 + k * 1024); } while (0)
#define PG8_MMA(ai, bj, At, Bt) do { __builtin_amdgcn_s_setprio(1); _Pragma("unroll") for (int m = 0; m < 4; ++m) _Pragma("unroll") for (int n = 0; n < 2; ++n) _Pragma("unroll") for (int k = 0; k < 2; ++k) \
        acc[ai][bj][m][n] = __builtin_amdgcn_mfma_f32_16x16x32_bf16(Bt[n][k], At[m][k], acc[ai][bj][m][n], 0, 0, 0); __builtin_amdgcn_s_setprio(0); } while (0)
#define PG8_WAIT_V(n) asm volatile("s_waitcnt vmcnt(" #n ")" ::: "memory")
#define PG8_WAIT_L(n) asm volatile("s_waitcnt lgkmcnt(" #n ")" ::: "memory")
#define PG8_BAR __builtin_amdgcn_s_barrier()
#define PG8_SCHED __builtin_amdgcn_sched_barrier(0)
    Unit cur, nxt; int ui = 0;
    if (!S.next(0, cur)) return;
    f32x4 acc[2][2][4][2];
#pragma unroll
    for (int a = 0; a < 2; ++a)
#pragma unroll
        for (int b = 0; b < 2; ++b)
#pragma unroll
            for (int m = 0; m < 4; ++m)
#pragma unroll
                for (int n = 0; n < 2; ++n) acc[a][b][m][n] = (f32x4){0.f, 0.f, 0.f, 0.f};
    bf16x8 At[4][2], B0[2][2], B1[2][2];
    const char* cA = (const char*)g.A + (size_t)cur.pm * tstep; const char* cB = (const char*)g.Bt + (size_t)cur.pn * tstep;
    S.a_ready(cur);
    if constexpr (SP2) {
        PG8_STAGE(PG8_SB(0, 0), cB, voffB); PG8_STAGE(PG8_SB(0, 1), cB + hstep, voffB); PG8_STAGE(PG8_SA(0, 0), cA, voffA); PG8_STAGE(PG8_SA(0, 1), cA + hstep, voffA);
        if (wr == 1) PG8_BAR;
        PG8_WAIT_V(2); PG8_BAR;
        PG8_STAGE(PG8_SB(1, 0), cB + kstep, voffB); PG8_STAGE(PG8_SA(1, 0), cA + kstep, voffA); PG8_STAGE(PG8_SB(1, 1), cB + hstep + kstep, voffB);
        PG8_WAIT_V(6); PG8_BAR;
    } else {
        PG8_STAGE(PG8_SB(0, 0), cB, voffB); PG8_STAGE(PG8_SA(0, 0), cA, voffA); PG8_STAGE(PG8_SB(0, 1), cB + hstep, voffB); PG8_STAGE(PG8_SA(0, 1), cA + hstep, voffA);
        if (wr == 1) PG8_BAR;
        PG8_WAIT_V(4); PG8_BAR;
        PG8_STAGE(PG8_SB(1, 0), cB + kstep, voffB); PG8_STAGE(PG8_SA(1, 0), cA + kstep, voffA); PG8_STAGE(PG8_SB(1, 1), cB + hstep + kstep, voffB);
        PG8_WAIT_V(6); PG8_BAR;
    }
    for (;;) {
        const bool has_next = S.next(ui + 1, nxt);
        const char* nA = has_next ? (const char*)g.A + (size_t)nxt.pm * tstep : cA; const char* nB = has_next ? (const char*)g.Bt + (size_t)nxt.pn * tstep : cB;
        for (int t = 0; t < nt; t += 2) {
            const bool last = (t == nt - 2);
            const char* a1 = cA + (size_t)(t + 1) * kstep;
            const char* a2 = last ? nA : cA + (size_t)(t + 2) * kstep; const char* b2 = last ? nB : cB + (size_t)(t + 2) * kstep;
            const char* a3 = a2 + kstep; const char* b3 = b2 + kstep;
            if (last && has_next) S.a_ready(nxt);
            if constexpr (SP2) {
            PG8_LDB(B0, 0, 0); PG8_LDB(B1, 0, 1); PG8_SCHED; PG8_LDA(At, 0, 0); PG8_STAGE(PG8_SA(1, 1), a1 + hstep, voffA);
            PG8_WAIT_V(8); PG8_WAIT_L(0); PG8_BAR; PG8_MMA(0, 0, At, B0); PG8_MMA(0, 1, At, B1); PG8_BAR; PG8_SCHED;
            PG8_LDA(At, 0, 1); PG8_STAGE(PG8_SB(0, 0), b2, voffB); PG8_STAGE(PG8_SB(0, 1), b2 + hstep, voffB); PG8_STAGE(PG8_SA(0, 0), a2, voffA);
            PG8_WAIT_V(8); PG8_WAIT_L(0); PG8_BAR; PG8_MMA(1, 0, At, B0); PG8_MMA(1, 1, At, B1); PG8_BAR; PG8_SCHED;
            PG8_LDB(B0, 1, 0); PG8_LDB(B1, 1, 1); PG8_SCHED; PG8_LDA(At, 1, 0); PG8_STAGE(PG8_SA(0, 1), a2 + hstep, voffA);
            PG8_WAIT_V(8); PG8_WAIT_L(0); PG8_BAR; PG8_MMA(0, 0, At, B0); PG8_MMA(0, 1, At, B1); PG8_BAR; PG8_SCHED;
            PG8_LDA(At, 1, 1); PG8_STAGE(PG8_SB(1, 0), b3, voffB); PG8_STAGE(PG8_SB(1, 1), b3 + hstep, voffB); PG8_STAGE(PG8_SA(1, 0), a3, voffA);
            PG8_WAIT_V(8); PG8_WAIT_L(0); PG8_BAR; PG8_MMA(1, 0, At, B0); PG8_MMA(1, 1, At, B1); PG8_BAR; PG8_SCHED;
            } else {
            PG8_LDB(B0, 0, 0); PG8_SCHED; PG8_LDA(At, 0, 0); PG8_STAGE(PG8_SA(1, 1), a1 + hstep, voffA);
            PG8_WAIT_L(8); PG8_BAR; PG8_WAIT_L(0); PG8_MMA(0, 0, At, B0); PG8_BAR; PG8_SCHED;
            PG8_LDB(B1, 0, 1); PG8_STAGE(PG8_SB(0, 0), b2, voffB);
            PG8_BAR; PG8_WAIT_L(0); PG8_MMA(0, 1, At, B1); PG8_BAR;
            PG8_LDA(At, 0, 1); PG8_STAGE(PG8_SA(0, 0), a2, voffA);
            PG8_BAR; PG8_WAIT_L(0); PG8_MMA(1, 0, At, B0); PG8_BAR; PG8_SCHED;
            PG8_STAGE(PG8_SB(0, 1), b2 + hstep, voffB);
            PG8_WAIT_V(6); PG8_BAR; PG8_MMA(1, 1, At, B1); PG8_BAR;
            PG8_LDB(B0, 1, 0); PG8_SCHED; PG8_LDA(At, 1, 0); PG8_STAGE(PG8_SA(0, 1), a2 + hstep, voffA);
            PG8_WAIT_L(8); PG8_BAR; PG8_WAIT_L(0); PG8_MMA(0, 0, At, B0); PG8_BAR; PG8_SCHED;
            PG8_LDB(B1, 1, 1); PG8_STAGE(PG8_SB(1, 0), b3, voffB);
            PG8_BAR; PG8_WAIT_L(0); PG8_MMA(0, 1, At, B1); PG8_BAR;
            PG8_LDA(At, 1, 1); PG8_STAGE(PG8_SA(1, 0), a3, voffA);
            PG8_BAR; PG8_WAIT_L(0); PG8_MMA(1, 0, At, B0); PG8_BAR; PG8_SCHED;
            PG8_STAGE(PG8_SB(1, 1), b3 + hstep, voffB);
            PG8_WAIT_V(6); PG8_BAR; PG8_MMA(1, 1, At, B1); PG8_BAR;
            }
        }
        if constexpr (ALIGN_EPI) { if (wr == 0) PG8_BAR; }
        if constexpr (!Epi::AFTER_DRAIN) { E(acc, cur, wr, wc, fr, fq); S.done(cur); }
        if (!has_next) break;
#pragma unroll
        for (int a = 0; a < 2; ++a)
#pragma unroll
            for (int b = 0; b < 2; ++b)
#pragma unroll
                for (int m = 0; m < 4; ++m)
#pragma unroll
                    for (int n = 0; n < 2; ++n) acc[a][b][m][n] = (f32x4){0.f, 0.f, 0.f, 0.f};
        cur = nxt; cA = nA; cB = nB; ++ui;
        if constexpr (ALIGN_EPI) { if (wr == 1) PG8_BAR; }
    }
    PG8_WAIT_V(0);
    if constexpr (!ALIGN_EPI) { if (wr == 0) PG8_BAR; }
    PG8_BAR;
    if constexpr (Epi::AFTER_DRAIN) { E.fused(acc, cur, wr, wc, fr, fq, lds, wid, lane); S.done(cur); }
#undef PG8_SA
#undef PG8_SB
#undef PG8_STAGE
#undef PG8_LDA
#undef PG8_LDB
#undef PG8_MMA
#undef PG8_WAIT_V
#undef PG8_WAIT_L
#undef PG8_BAR
#undef PG8_SCHED
}
}

struct EpiInproj {
    static constexpr bool PERM = true, AFTER_DRAIN = false;
    bf16_t *qkvraw, *dzb, *sq, *sk, *vT, *gab, *gbb; float* small;
    __device__ __forceinline__ void operator()(const pg8::f32x4 (&acc)[2][2][4][2], const pg8::Unit& u, int wr, int wc, int fr, int fq) const {
        const int pn = u.pn, row0 = u.pm * 256 + wr * 64 + fr;
        if (pn == 12 || pn == 13) {
#pragma unroll
            for (int ai = 0; ai < 2; ++ai)
#pragma unroll
                for (int m = 0; m < 4; ++m) {
                    const int tok = row0 + ai * 128 + m * 16, bb = tok >> 11, key = tok & (SEQ - 1), pos = (key & ~15) | pi16(key & 15);
#pragma unroll
                    for (int bj = 0; bj < 2; ++bj)
#pragma unroll
                        for (int n = 0; n < 2; ++n)
#pragma unroll
                            for (int j = 0; j < 4; ++j) {
                                const int svcol = (pn - 12) * 256 + bj * 128 + wc * 32 + fq * 8 + n * 4 + j;
                                vT[((size_t)((bb * 8 + (svcol >> 6)) * 64 + (svcol & 63))) * SEQ + pos] = to_bf16(acc[ai][bj][m][n][j]);
                            }
                }
        } else if (pn == 22) {
            if (wc == 0 && fq == 0) {
#pragma unroll
                for (int ai = 0; ai < 2; ++ai)
#pragma unroll
                    for (int m = 0; m < 4; ++m) {
                        pg8::f32x4* d = (pg8::f32x4*)(small + (size_t)(row0 + ai * 128 + m * 16) * 8);
                        d[0] = acc[ai][0][m][0]; d[1] = acc[ai][0][m][1];
                    }
            }
        } else {
            bf16_t* dst; int ld, c0; float sc = 1.f; bool gate = false;
            if (pn < 6) { dst = qkvraw; ld = 1536; c0 = pn * 256; }
            else if (pn < 8) { dst = dzb; ld = 512; c0 = (pn - 6) * 256; }
            else if (pn < 10) { dst = sq; ld = 512; c0 = (pn - 8) * 256; sc = 0.125f * 1.4426950408889634f; }
            else if (pn < 12) { dst = sk; ld = 512; c0 = (pn - 10) * 256; }
            else if (pn < 18) { dst = gab; ld = 1024; c0 = (pn - 14) * 256; gate = true; }
            else { dst = gbb; ld = 1024; c0 = (pn - 18) * 256; gate = true; }
#pragma unroll
            for (int ai = 0; ai < 2; ++ai)
#pragma unroll
                for (int m = 0; m < 4; ++m) {
                    bf16_t* rowp = dst + (size_t)(row0 + ai * 128 + m * 16) * ld + c0 + wc * 32 + fq * 8;
#pragma unroll
                    for (int bj = 0; bj < 2; ++bj) {
                        pg8::f32x4 v0 = acc[ai][bj][m][0] * sc, v1 = acc[ai][bj][m][1] * sc;
                        if (gate) {
#pragma unroll
                            for (int j = 0; j < 4; ++j) { v0[j] = sigmoidf_(v0[j]); v1[j] = sigmoidf_(v1[j]); }
                        }
                        pg8::u32x4 w; w.x = pk_bf16(v0[0], v0[1]); w.y = pk_bf16(v0[2], v0[3]); w.z = pk_bf16(v1[0], v1[1]); w.w = pk_bf16(v1[2], v1[3]);
                        *(pg8::u32x4*)(rowp + bj * 128) = w;
                    }
                }
        }
    }
};
template <class F> struct EpiF4 {
    static constexpr bool PERM = false, AFTER_DRAIN = false;
    F f;
    __device__ __forceinline__ void operator()(const pg8::f32x4 (&acc)[2][2][4][2], const pg8::Unit& u, int wr, int wc, int fr, int fq) const {
#pragma unroll
        for (int ai = 0; ai < 2; ++ai)
#pragma unroll
            for (int m = 0; m < 4; ++m) {
                const int row = u.pm * 256 + ai * 128 + wr * 64 + m * 16 + fr;
#pragma unroll
                for (int bj = 0; bj < 2; ++bj)
#pragma unroll
                    for (int n = 0; n < 2; ++n) f(row, u.pn * 256 + bj * 128 + wc * 32 + n * 16 + fq * 4, acc[ai][bj][m][n]);
            }
    }
};
template <class F> __device__ __forceinline__ void run_pg8(const bf16_t* A, const bf16_t* Bt, int M, int N, int K, unsigned char* lds, F f) {
    pg8::Gemm g{A, Bt, M, N, K};
    pg8::StaticOrder S; S.init(M, N, gridDim.x, vblock());
    EpiF4<F> E{f};
    pg8::gemm_phase<EpiF4<F>, pg8::StaticOrder, true, true>((PG8_LAS unsigned char*)lds, g, S, E);
}
__device__ __forceinline__ void unpack4(uint2 w, float (&g)[4]) {
    g[0] = __uint_as_float(w.x << 16); g[1] = __uint_as_float(w.x & 0xffff0000u); g[2] = __uint_as_float(w.y << 16); g[3] = __uint_as_float(w.y & 0xffff0000u);
}

struct LoadKNF32 {
    const float* base; int ld, kq, nq;
    f32x4 regs[8];
    template <class CF> __device__ __forceinline__ void init(const float* w, int ld_, CF colfn) {
        const int tid = opaque_tid(); kq = tid >> 6; nq = tid & 63; ld = ld_;
        base = w + (size_t)(kq * 8) * ld_ + colfn(nq * 4);
    }
    __device__ __forceinline__ void load(int k0) {
#pragma unroll
        for (int j = 0; j < 8; ++j) regs[j] = *(const f32x4*)(base + (size_t)(k0 + j) * ld);
    }
    __device__ __forceinline__ void store1(unsigned char* lds, int nn, float a0, float a1, float a2, float a3, float a4, float a5, float a6, float a7) const {
        uint4 o; o.x = pk_bf16(a0, a1); o.y = pk_bf16(a2, a3); o.z = pk_bf16(a4, a5); o.w = pk_bf16(a6, a7);
        const int row = nq * 4 + nn;
        *(uint4*)(lds + row * LROW + ((kq ^ swz(row)) << 4)) = o;
    }
    __device__ __forceinline__ void store(unsigned char* lds) const {
        store1(lds, 0, regs[0].x, regs[1].x, regs[2].x, regs[3].x, regs[4].x, regs[5].x, regs[6].x, regs[7].x);
        store1(lds, 1, regs[0].y, regs[1].y, regs[2].y, regs[3].y, regs[4].y, regs[5].y, regs[6].y, regs[7].y);
        store1(lds, 2, regs[0].z, regs[1].z, regs[2].z, regs[3].z, regs[4].z, regs[5].z, regs[6].z, regs[7].z);
        store1(lds, 3, regs[0].w, regs[1].w, regs[2].w, regs[3].w, regs[4].w, regs[5].w, regs[6].w, regs[7].w);
    }
};

template <int BM_, int BN_, int WM_, int WN_> struct GemmCfg {
    static constexpr int BM = BM_, BN = BN_, WM = WM_, WN = WN_;
    static constexpr int TM = BM / WM, TN = BN / WN, MI = TM / 32, NI = TN / 32;
    static constexpr int A_BYTES = BM * LROW, B_BYTES = BN * LROW, STAGE = A_BYTES + B_BYTES;
    static_assert(WM * WN == 8, "8 waves");
};

template <class CFG, class AL, class BL>
__device__ __forceinline__ void gemm_mainloop(AL& al, BL& bl, int nk, f32x16 (&acc)[CFG::MI][CFG::NI], unsigned char* lds) {
    constexpr int MI = CFG::MI, NI = CFG::NI;
    const int tid = opaque_tid(), lane = tid & 63, wid = tid >> 6;
    const int wm = wid / CFG::WN, wn = wid % CFG::WN;
    const int l31 = lane & 31, lh = lane >> 5;
    al.load(0); bl.load(0);
    const int a_off = (wm * CFG::TM + l31) * LROW;
    const int b_off = CFG::A_BYTES + (wn * CFG::TN + l31) * LROW;
    const int fsw = swz(l31);
    for (int kt = 0; kt < nk; ++kt) {
        unsigned char* st = lds + (kt & 1) * CFG::STAGE;
        al.store(st); bl.store(st + CFG::A_BYTES);
        __syncthreads();
        if (kt + 1 < nk) { al.load((kt + 1) * 64); bl.load((kt + 1) * 64); }
#pragma unroll
        for (int kk = 0; kk < 4; ++kk) {
            bf16x8 a[MI], b[NI];
#pragma unroll
            for (int mi = 0; mi < MI; ++mi) a[mi] = *(const bf16x8*)(st + a_off + mi * 32 * LROW + (((kk * 2 + lh) ^ fsw) << 4));
#pragma unroll
            for (int ni = 0; ni < NI; ++ni) b[ni] = *(const bf16x8*)(st + b_off + ni * 32 * LROW + (((kk * 2 + lh) ^ fsw) << 4));
#pragma unroll
            for (int mi = 0; mi < MI; ++mi)
#pragma unroll
                for (int ni = 0; ni < NI; ++ni)
                    acc[mi][ni] = __builtin_amdgcn_mfma_f32_32x32x16_bf16(a[mi], b[ni], acc[mi][ni], 0, 0, 0);
        }
    }
    __syncthreads();
}
template <class CFG, bool A_RES, int ARES_ROT, bool TRANS, class AL, class BL>
__device__ __forceinline__ void gemm_mainloop2(AL (&al)[2], BL (&bl)[2], int nk, f32x16 (&acc)[CFG::MI][CFG::NI], unsigned char* stages, const unsigned char* ares) {
    constexpr int MI = CFG::MI, NI = CFG::NI;
    constexpr int STG = A_RES ? CFG::B_BYTES : CFG::STAGE, BOFF = A_RES ? 0 : CFG::A_BYTES;
    const int tid = opaque_tid(), lane = tid & 63, wid = tid >> 6;
    const int wm = wid / CFG::WN, wn = wid % CFG::WN;
    const int l31 = lane & 31, lh = lane >> 5;
    if (!A_RES) { al[0].load(0); } bl[0].load(0);
    if (!A_RES) { al[1].load(64); } bl[1].load(64);
    const int a_off = (wm * CFG::TM + l31) * LROW;
    const int b_off = BOFF + (wn * CFG::TN + l31) * LROW;
    const int fsw = swz(l31);
    for (int kt = 0; kt < nk; kt += 2) {
#pragma unroll
        for (int u = 0; u < 2; ++u) {
            unsigned char* st = stages + u * STG;
            if (!A_RES) al[u].store(st);
            bl[u].store(st + BOFF);
            __syncthreads();
            if (kt + u + 2 < nk) { if (!A_RES) al[u].load((kt + u + 2) * 64); bl[u].load((kt + u + 2) * 64); }
            const unsigned char* ab = A_RES ? ares + (size_t)((kt + u + ARES_ROT) & 3) * (CFG::BM * LROW) : st;
#pragma unroll
            for (int kk = 0; kk < 4; ++kk) {
                bf16x8 a[MI], b[NI];
#pragma unroll
                for (int mi = 0; mi < MI; ++mi) a[mi] = *(const bf16x8*)(ab + a_off + mi * 32 * LROW + (((kk * 2 + lh) ^ fsw) << 4));
#pragma unroll
                for (int ni = 0; ni < NI; ++ni) b[ni] = *(const bf16x8*)(st + b_off + ni * 32 * LROW + (((kk * 2 + lh) ^ fsw) << 4));
#pragma unroll
                for (int mi = 0; mi < MI; ++mi)
#pragma unroll
                    for (int ni = 0; ni < NI; ++ni)
                        acc[mi][ni] = TRANS ? __builtin_amdgcn_mfma_f32_32x32x16_bf16(b[ni], a[mi], acc[mi][ni], 0, 0, 0)
                                            : __builtin_amdgcn_mfma_f32_32x32x16_bf16(a[mi], b[ni], acc[mi][ni], 0, 0, 0);
            }
        }
    }
    __syncthreads();
}
template <int ROWS, int NSET> struct LoadRowsBf16N {
    static constexpr int NCH = ROWS * 8 / NT;
    typedef unsigned u32x4r __attribute__((ext_vector_type(4)));
    const bf16_t* base; int tid;
    unsigned off[NCH];
    u32x4r regs[NSET][NCH];
    template <class RF> __device__ __forceinline__ void init(const bf16_t* base_, int ld, RF rowfn) {
        base = base_; tid = opaque_tid();
#pragma unroll
        for (int i = 0; i < NCH; ++i) { const int c = tid + i * NT, r = c >> 3, ch = c & 7; off[i] = (unsigned)(rowfn(r) * ld + ch * 8); }
    }
    template <int U> __device__ __forceinline__ void load(int k0) {
#pragma unroll
        for (int i = 0; i < NCH; ++i) regs[U][i] = *(const u32x4r*)(base + (size_t)off[i] + k0);
    }
    template <int U> __device__ __forceinline__ void store(unsigned char* lds) const {
#pragma unroll
        for (int i = 0; i < NCH; ++i) { const int c = tid + i * NT, r = c >> 3, ch = c & 7; *(u32x4r*)(lds + r * LROW + ((ch ^ swz(r)) << 4)) = regs[U][i]; }
    }
};
template <int NSET> struct LoadKNF32N {
    const float* base; int ld, kq, nq;
    f32x4 regs[NSET][8];
    template <class CF> __device__ __forceinline__ void init(const float* w, int ld_, CF colfn) {
        const int tid = opaque_tid(); kq = tid >> 6; nq = tid & 63; ld = ld_;
        base = w + (size_t)(kq * 8) * ld_ + colfn(nq * 4);
    }
    template <int U> __device__ __forceinline__ void load(int k0) {
#pragma unroll
        for (int j = 0; j < 8; ++j) regs[U][j] = *(const f32x4*)(base + (size_t)(k0 + j) * ld);
    }
    template <int U> __device__ __forceinline__ void store(unsigned char* lds) const {
#pragma unroll
        for (int nn = 0; nn < 4; ++nn) {
            uint4 o; o.x = pk_bf16(regs[U][0][nn], regs[U][1][nn]); o.y = pk_bf16(regs[U][2][nn], regs[U][3][nn]);
            o.z = pk_bf16(regs[U][4][nn], regs[U][5][nn]); o.w = pk_bf16(regs[U][6][nn], regs[U][7][nn]);
            const int row = nq * 4 + nn;
            *(uint4*)(lds + row * LROW + ((kq ^ swz(row)) << 4)) = o;
        }
    }
};
template <class CFG, bool TRANS, int U, class AL, class BL>
__device__ __forceinline__ void d3_step(AL& al, BL& bl, int t, int nk, f32x16 (&acc)[CFG::MI][CFG::NI], unsigned char* stages, int a_off, int b_off, int fsw, int lh) {
    constexpr int MI = CFG::MI, NI = CFG::NI, UN = (U + 1) % 3;
    if (t < nk) {
        unsigned char* st = stages + (t & 1) * CFG::STAGE;
        unsigned char* nx = stages + ((t + 1) & 1) * CFG::STAGE;
#pragma unroll
        for (int kk = 0; kk < 4; ++kk) {
            if (kk == 2 && t + 1 < nk) {
                al.template store<UN>(nx); bl.template store<UN>(nx + CFG::A_BYTES);
                if (t + 4 < nk) { al.template load<UN>((t + 4) * 64); bl.template load<UN>((t + 4) * 64); }
            }
            bf16x8 a[MI], b[NI];
#pragma unroll
            for (int mi = 0; mi < MI; ++mi) a[mi] = *(const bf16x8*)(st + a_off + mi * 32 * LROW + (((kk * 2 + lh) ^ fsw) << 4));
#pragma unroll
            for (int ni = 0; ni < NI; ++ni) b[ni] = *(const bf16x8*)(st + b_off + ni * 32 * LROW + (((kk * 2 + lh) ^ fsw) << 4));
#pragma unroll
            for (int mi = 0; mi < MI; ++mi)
#pragma unroll
                for (int ni = 0; ni < NI; ++ni)
                    acc[mi][ni] = TRANS ? __builtin_amdgcn_mfma_f32_32x32x16_bf16(b[ni], a[mi], acc[mi][ni], 0, 0, 0)
                                        : __builtin_amdgcn_mfma_f32_32x32x16_bf16(a[mi], b[ni], acc[mi][ni], 0, 0, 0);
        }
        __syncthreads();
    }
}
template <class CFG, bool TRANS, class AL, class BL>
__device__ __forceinline__ void gemm_mainloop_d3(AL& al, BL& bl, int nk, f32x16 (&acc)[CFG::MI][CFG::NI], unsigned char* stages) {
    const int tid = opaque_tid(), lane = tid & 63, wid = tid >> 6;
    const int wm = wid / CFG::WN, wn = wid % CFG::WN;
    const int l31 = lane & 31, lh = lane >> 5;
    al.template load<0>(0); bl.template load<0>(0);
    al.template load<1>(64); bl.template load<1>(64);
    al.template load<2>(128); bl.template load<2>(128);
    const int a_off = (wm * CFG::TM + l31) * LROW;
    const int b_off = CFG::A_BYTES + (wn * CFG::TN + l31) * LROW;
    const int fsw = swz(l31);
    al.template store<0>(stages); bl.template store<0>(stages + CFG::A_BYTES);
    __syncthreads();
    if (3 < nk) { al.template load<0>(192); bl.template load<0>(192); }
    for (int kt = 0; kt < nk; kt += 3) {
        d3_step<CFG, TRANS, 0>(al, bl, kt, nk, acc, stages, a_off, b_off, fsw, lh);
        d3_step<CFG, TRANS, 1>(al, bl, kt + 1, nk, acc, stages, a_off, b_off, fsw, lh);
        d3_step<CFG, TRANS, 2>(al, bl, kt + 2, nk, acc, stages, a_off, b_off, fsw, lh);
    }
}
template <class CFG> __device__ __forceinline__ void acc_zero(f32x16 (&acc)[CFG::MI][CFG::NI]) {
#pragma unroll
    for (int mi = 0; mi < CFG::MI; ++mi)
#pragma unroll
        for (int ni = 0; ni < CFG::NI; ++ni)
#pragma unroll
            for (int r = 0; r < 16; ++r) acc[mi][ni][r] = 0.f;
}
template <class CFG, class F> __device__ __forceinline__ void acc_foreach(f32x16 (&acc)[CFG::MI][CFG::NI], F f) {
    const int tid = opaque_tid(), lane = tid & 63, wid = tid >> 6;
    const int wm = wid / CFG::WN, wn = wid % CFG::WN;
#pragma unroll
    for (int mi = 0; mi < CFG::MI; ++mi)
#pragma unroll
        for (int ni = 0; ni < CFG::NI; ++ni) {
            asm volatile("" ::: "memory");
#pragma unroll
            for (int r = 0; r < 16; ++r)
                acc[mi][ni][r] = f(wm * CFG::TM + mi * 32 + (r & 3) + 8 * (r >> 2) + 4 * (lane >> 5), wn * CFG::TN + ni * 32 + (lane & 31), acc[mi][ni][r], mi, ni, r);
        }
}

struct TileMap {
    int ntm, ntn, npm, npn, rounds; bool patched;
    int pm, pn;
    __device__ __forceinline__ void init(int ntm_, int ntn_) {
        ntm = ntm_; ntn = ntn_; patched = (gridDim.x == 256);
        pn = ntn >= 8 ? 8 : ntn >= 4 ? 4 : ntn >= 2 ? 2 : 1; pm = 32 / pn;
        if (patched) { npm = (ntm + pm - 1) / pm; npn = (ntn + pn - 1) / pn; rounds = (npm * npn + 7) / 8; }
        else { int G = gridDim.x; asm volatile("" : "+s"(G)); npm = npn = 0; rounds = (ntm * ntn + G - 1) / G; }
    }
    __device__ __forceinline__ bool get(int round, int& tm, int& tn) const {
        const int b = vblock();
        if (patched) {
            const int patch = round * 8 + (b & 7), slot = b >> 3;
            if (patch >= npm * npn) return false;
            tm = (patch / npn) * pm + slot / pn; tn = (patch % npn) * pn + slot % pn;
            return tm < ntm && tn < ntn;
        }
        const int t = round * gridDim.x + b;
        if (t >= ntm * ntn) return false;
        tm = t / ntn; tn = t % ntn; return true;
    }
};

template <class CM>
__device__ __forceinline__ void transpose_convert(const float* W, int K, int N, int NP, bf16_t* Wt, float* sm, CM cmap) {
    const int tid = opaque_tid(), ntk = K / 64, ntn = NP / 64;
    for (int tile = blockIdx.x; tile < ntk * ntn; tile += gridDim.x) {
        const int tk = tile % ntk, tn = tile / ntk;
#pragma unroll
        for (int i = 0; i < 8; ++i) {
            const int e = tid + i * NT, kk = e >> 6, nn = e & 63, col = cmap(tn * 64 + nn);
            sm[nn * 65 + kk] = col >= 0 ? W[(size_t)(tk * 64 + kk) * N + col] : 0.f;
        }
        __syncthreads();
        const int n = tid >> 3, kc = tid & 7;
        const float* r = sm + n * 65 + kc * 8;
        uint4 o; o.x = pk_bf16(r[0], r[1]); o.y = pk_bf16(r[2], r[3]); o.z = pk_bf16(r[4], r[5]); o.w = pk_bf16(r[6], r[7]);
        *(uint4*)(Wt + (size_t)(tn * 64 + n) * K + tk * 64 + kc * 8) = o;
        __syncthreads();
    }
}
__device__ __forceinline__ void transpose_tile_f4(const float* W, int K, int N, bf16_t* Wt, int k0, int n0, float* sm) {
    const int tid = opaque_tid(), kk = tid >> 4, n4 = tid & 15;
#pragma unroll
    for (int h = 0; h < 2; ++h) {
        const int k = kk + 32 * h;
        const f32x4 v = *(const f32x4*)(W + (size_t)(k0 + k) * N + n0 + n4 * 4);
#pragma unroll
        for (int j = 0; j < 4; ++j) sm[(n4 * 4 + j) * 65 + k] = v[j];
    }
    __syncthreads();
    const int n = tid >> 3, kc = tid & 7;
    const float* r = sm + n * 65 + kc * 8;
    uint4 o; o.x = pk_bf16(r[0], r[1]); o.y = pk_bf16(r[2], r[3]); o.z = pk_bf16(r[4], r[5]); o.w = pk_bf16(r[6], r[7]);
    *(uint4*)(Wt + (size_t)(n0 + n) * K + k0 + kc * 8) = o;
    __syncthreads();
}
__device__ __forceinline__ void convert_bf16(const float* src, bf16_t* dst, size_t n) {
    const size_t gtid = (size_t)blockIdx.x * NT + opaque_tid(), gsz = (size_t)gridDim.x * NT;
    for (size_t i = gtid; i < n / 8; i += gsz) {
        const float4 a = ((const float4*)src)[2 * i], b = ((const float4*)src)[2 * i + 1];
        uint4 o; o.x = pk_bf16(a.x, a.y); o.y = pk_bf16(a.z, a.w); o.z = pk_bf16(b.x, b.y); o.w = pk_bf16(b.z, b.w);
        ((uint4*)dst)[i] = o;
    }
}

__device__ __forceinline__ void phase_inproj(const Params& p, unsigned char* lds) {
    pg8::Gemm g{p.xb, p.w_in_t, T, PWP, D};
    pg8::StaticOrder S; S.init(T, PWP, gridDim.x, vblock());
    EpiInproj E{p.qkvraw, p.dzb, p.sq, p.sk, p.vT, p.gab, p.gbb, p.small};
    pg8::gemm_phase<EpiInproj, pg8::StaticOrder, true, true>((PG8_LAS unsigned char*)lds, g, S, E);
}

__device__ __forceinline__ void load_gate16(const bf16_t* gbuf, int rb, int cb, int lane, float (&g)[16]) {
    const uint4* src = (const uint4*)(gbuf + ((size_t)(rb * 32 + cb) * 64 + lane) * 16);
    const uint4 a = src[0], b = src[1];
    const unsigned u[8] = {a.x, a.y, a.z, a.w, b.x, b.y, b.z, b.w};
#pragma unroll
    for (int i = 0; i < 8; ++i) { g[2 * i] = __uint_as_float(u[i] << 16); g[2 * i + 1] = __uint_as_float(u[i] & 0xffff0000u); }
}
__device__ __forceinline__ void phase_merge(const Params& p, unsigned char* lds) {
    run_pg8(p.oab, p.w_pa_t, T, D, DNW, lds, [&](int row, int col, pg8::f32x4 v) {
        float g[4]; unpack4(*(const uint2*)(p.gab + (size_t)row * D + col), g);
        *(pg8::f32x4*)(p.m1 + (size_t)row * D + col) = (pg8::f32x4){v[0] * g[0], v[1] * g[1], v[2] * g[2], v[3] * g[3]};
    });
    run_pg8(p.obb, p.w_pb_t, T, D, SBW, lds, [&](int row, int col, pg8::f32x4 v) {
        float g[4]; unpack4(*(const uint2*)(p.gbb + (size_t)row * D + col), g);
        const pg8::f32x4 m = *(const pg8::f32x4*)(p.m1 + (size_t)row * D + col);
        uint2 w; w.x = pk_bf16(m[0] + v[0] * g[0], m[1] + v[1] * g[1]); w.y = pk_bf16(m[2] + v[2] * g[2], m[3] + v[3] * g[3]);
        *(uint2*)(p.mergedb + (size_t)row * D + col) = w;
    });
}

__device__ __forceinline__ void phase_outproj(const Params& p, unsigned char* lds) {
    run_pg8(p.mergedb, p.w_out_t, T, D, D, lds, [&](int row, int col, pg8::f32x4 v) {
        const size_t o = (size_t)row * D + col;
        const pg8::f32x4 x = *(const pg8::f32x4*)(p.x + o);
        *(pg8::f32x4*)(p.pre1 + o) = v + x * ALPHA;
    });
}

__device__ __forceinline__ void phase_router_shared_up(const Params& p, unsigned char* lds) {
    {
        typedef GemmCfg<128, 128, 4, 2> CFG;
        TileMap tmap; tmap.init(T / 128, NE / 128);
        for (int round = 0; round < tmap.rounds; ++round) {
            int tm, tn;
            if (!tmap.get(round, tm, tn)) continue;
            LoadRowsBf16<128> al, bl;
            al.init(p.hb, D, [&](int r) { return (long long)(tm * 128 + r); });
            bl.init(p.w_router_t, D, [&](int r) { return (long long)(tn * 128 + r); });
            f32x16 acc[CFG::MI][CFG::NI];
            acc_zero<CFG>(acc);
            gemm_mainloop<CFG>(al, bl, D / 64, acc, lds);
            asm volatile("" : "+s"(tm), "+s"(tn));
            acc_foreach<CFG>(acc, [&](int r, int c, float v, int, int, int) {
                p.scores[(size_t)(tm * 128 + r) * NE + tn * 128 + c] = sigmoidf_(v);
                return v;
            });
        }
    }
    {
        typedef GemmCfg<128, 256, 2, 4> CFG;
        TileMap tmap; tmap.init(T / 128, SFF / 128);
        for (int round = 0; round < tmap.rounds; ++round) {
            int tm, tn;
            if (!tmap.get(round, tm, tn)) continue;
            LoadRowsBf16<128> al; LoadRowsBf16<256> bl;
            al.init(p.hb, D, [&](int r) { return (long long)(tm * 128 + r); });
            bl.init(p.w_su_t, D, [&](int r) { return (long long)(((r >> 5) & 1) * SFF + tn * 128 + (r >> 6) * 32 + (r & 31)); });
            f32x16 acc[CFG::MI][CFG::NI];
            acc_zero<CFG>(acc);
            gemm_mainloop<CFG>(al, bl, D / 64, acc, lds);
            asm volatile("" : "+s"(tm), "+s"(tn));
            const int tid = opaque_tid(), lane = tid & 63, wid = tid >> 6, wm = wid / CFG::WN, wn = wid % CFG::WN;
#pragma unroll
            for (int mi = 0; mi < CFG::MI; ++mi)
#pragma unroll
                for (int r = 0; r < 16; ++r) {
                    const int row = tm * 128 + wm * CFG::TM + mi * 32 + (r & 3) + 8 * (r >> 2) + 4 * (lane >> 5);
                    const int j = tn * 128 + wn * 32 + (lane & 31);
                    const float g = acc[mi][0][r], u = acc[mi][1][r];
                    p.actsh[(size_t)row * SFF + j] = to_bf16(siluf_(g) * u);
                }
        }
    }
}

__device__ __forceinline__ void phase_shared_down(const Params& p, unsigned char* lds) {
    run_pg8(p.actsh, p.w_sd_t, T, D, SFF, lds, [&](int row, int col, pg8::f32x4 v) {
        uint2 w; w.x = pk_bf16(v[0], v[1]); w.y = pk_bf16(v[2], v[3]);
        *(uint2*)(p.yshb + (size_t)row * D + col) = w;
    });
}

__device__ __forceinline__ void phase_init(const Params& p) {
    const int gtid = blockIdx.x * NT + opaque_tid(), gsz = gridDim.x * NT;
    for (int i = gtid; i < 2 * NE * CSTRIDE; i += gsz) p.counts[i] = 0;
}

__device__ __forceinline__ void sb_attn_wave(const Params& p, int bh, int qt) {
    const int lane = opaque_tid() & 63, l31 = lane & 31, lh = lane >> 5;
    const int b = bh >> 3, hh = bh & 7;
    bf16x8 qf[4];
    {
        const bf16_t* qrow = p.sq + (size_t)(b * SEQ + qt * 32 + l31) * SBW + hh * 64 + lh * 8;
#pragma unroll
        for (int ks = 0; ks < 4; ++ks) qf[ks] = *(const bf16x8*)(qrow + ks * 16);
    }
    f32x16 o0, o1;
#pragma unroll
    for (int r = 0; r < 16; ++r) { o0[r] = 0.f; o1[r] = 0.f; }
    float run = 0.f;
    const bf16_t* vbase = p.vT + ((size_t)(bh * 64 + l31)) * SEQ + lh * 8;
    for (int kt = qt; kt >= 0; --kt) {
        const bf16_t* krow = p.sk + (size_t)(b * SEQ + kt * 32 + l31) * SBW + hh * 64 + lh * 8;
        bf16x8 kf[4];
#pragma unroll
        for (int ks = 0; ks < 4; ++ks) kf[ks] = *(const bf16x8*)(krow + ks * 16);
        bf16x8 vf[2][2];
#pragma unroll
        for (int md = 0; md < 2; ++md)
#pragma unroll
            for (int ss = 0; ss < 2; ++ss) vf[md][ss] = *(const bf16x8*)(vbase + (size_t)md * 32 * SEQ + kt * 32 + ss * 16);
        f32x16 sc;
#pragma unroll
        for (int r = 0; r < 16; ++r) sc[r] = 0.f;
#pragma unroll
        for (int ks = 0; ks < 4; ++ks) sc = __builtin_amdgcn_mfma_f32_32x32x16_bf16(kf[ks], qf[ks], sc, 0, 0, 0);
        float lb[16], lr[16];
        const bool diag = (kt == qt);
#pragma unroll
        for (int r = 0; r < 16; ++r) {
            const float z = sc[r];
            const float l = __builtin_amdgcn_logf(1.f + __builtin_amdgcn_exp2f(-fabsf(z)));
            float b_ = fminf(z, 0.f) - l, r_ = b_ - z;
            if (diag) { const bool valid = ((r & 3) + 8 * (r >> 2) + 4 * lh) < l31; r_ = valid ? r_ : 0.f; b_ = valid ? b_ : -INFINITY; }
            lb[r] = b_; lr[r] = r_;
        }
        float ex[16], B[4];
#pragma unroll
        for (int g = 0; g < 4; ++g) {
            ex[4 * g + 3] = 0.f;
            ex[4 * g + 2] = lr[4 * g + 3];
            ex[4 * g + 1] = ex[4 * g + 2] + lr[4 * g + 2];
            ex[4 * g + 0] = ex[4 * g + 1] + lr[4 * g + 1];
            B[g] = ex[4 * g + 0] + lr[4 * g + 0];
        }
        float P[4];
#pragma unroll
        for (int g = 0; g < 4; ++g) P[g] = shfl_lane(B[g], lane ^ 32);
        float off[4];
        {
            const float p3 = P[3], p2 = P[2] + p3, p1 = P[1] + p2, p0 = P[0] + p1;
            const float b3 = 0.f, b2 = B[3], b1 = B[2] + b2, b0 = B[1] + b1;
            off[0] = b0 + (lh ? p1 : p0);
            off[1] = b1 + (lh ? p2 : p1);
            off[2] = b2 + (lh ? p3 : p2);
            off[3] = b3 + (lh ? 0.f : p3);
            const float total = (B[0] + b0) + p0;
#pragma unroll
            for (int g = 0; g < 4; ++g) off[g] += run;
            run += total;
        }
        float a[16];
#pragma unroll
        for (int r = 0; r < 16; ++r) a[r] = __builtin_amdgcn_exp2f(lb[r] + ex[r] + off[r >> 2]);
        bf16x8 pf[2];
#pragma unroll
        for (int ss = 0; ss < 2; ++ss) {
            typedef unsigned u32x4 __attribute__((ext_vector_type(4)));
            u32x4 w;
            w[0] = pk_bf16(a[8 * ss + 0], a[8 * ss + 1]); w[1] = pk_bf16(a[8 * ss + 2], a[8 * ss + 3]);
            w[2] = pk_bf16(a[8 * ss + 4], a[8 * ss + 5]); w[3] = pk_bf16(a[8 * ss + 6], a[8 * ss + 7]);
            pf[ss] = __builtin_bit_cast(bf16x8, w);
        }
#pragma unroll
        for (int ss = 0; ss < 2; ++ss) {
            o0 = __builtin_amdgcn_mfma_f32_32x32x16_bf16(vf[0][ss], pf[ss], o0, 0, 0, 0);
            o1 = __builtin_amdgcn_mfma_f32_32x32x16_bf16(vf[1][ss], pf[ss], o1, 0, 0, 0);
        }
        if (__all(run < -160.f)) break;
    }
    bf16_t* orow = p.obb + (size_t)(b * SEQ + qt * 32 + l31) * SBW + hh * 64 + 4 * lh;
#pragma unroll
    for (int g = 0; g < 4; ++g) {
        uint2 w0, w1;
        w0.x = pk_bf16(o0[4 * g], o0[4 * g + 1]); w0.y = pk_bf16(o0[4 * g + 2], o0[4 * g + 3]);
        w1.x = pk_bf16(o1[4 * g], o1[4 * g + 1]); w1.y = pk_bf16(o1[4 * g + 2], o1[4 * g + 3]);
        *(uint2*)(orow + 8 * g) = w0;
        *(uint2*)(orow + 32 + 8 * g) = w1;
    }
}


constexpr int DN_RW = 0, DN_RQ = 128, DN_RAT = 256, DN_RKD = 320;
constexpr float LOG2E = 1.4426950408889634f;
__device__ __forceinline__ uint4 pack8(const float* v) { uint4 o; o.x = pk_bf16(v[0], v[1]); o.y = pk_bf16(v[2], v[3]); o.z = pk_bf16(v[4], v[5]); o.w = pk_bf16(v[6], v[7]); return o; }

__device__ __forceinline__ void dn_chunk_item(const Params& p, int item, unsigned char* lds) {
    const int tid = opaque_tid(), lane = tid & 63, wid = tid >> 6;
    const int bh = item >> 5, n = item & 31, b = bh >> 2, hh = bh & 3;
    const int t0 = b * SEQ + n * 64;
    unsigned char* Kimg = lds; unsigned char* KBimg = lds + 16384; unsigned char* Qimg = lds + 32768;
    float* Vf = (float*)(lds + 49152); float* KBGf = (float*)(lds + 81920); float* MT = (float*)(lds + 114688);
    float* G2s = (float*)(lds + 114688 + 17408); float* betas = G2s + 64;
    bf16_t* blob = p.dnblob + (size_t)item * DN_BLOB;
    if (wid == 0) {
        const int t = t0 + lane;
        const float da = p.small[(size_t)t * 8 + 4 + hh] + p.dt_bias[hh];
        const float sp = da > 20.f ? da : log1pf(expf(da));
        float g2 = -expf(p.a_log[hh]) * sp * LOG2E;
#pragma unroll
        for (int off = 1; off < 64; off <<= 1) { const float v = shfl_lane(g2, lane - off); if (lane >= off) g2 += v; }
        G2s[lane] = g2; betas[lane] = sigmoidf_(p.small[(size_t)t * 8 + hh]);
        if (lane == 63) p.dnlast[item] = exp2f(g2);
    }
    __syncthreads();
    {
        const int c8 = tid & 15, tq = tid >> 4, j0 = tq * 2;
        const float G0 = G2s[j0], G1 = G2s[j0 + 1], GL = G2s[63];
        const float be[2] = {betas[j0], betas[j0 + 1]};
        const float eg[2] = {exp2f(G0), exp2f(G1)}, el[2] = {exp2f(GL - G0), exp2f(GL - G1)};
        const int half = c8 >> 3, ch = c8 & 7;
#pragma unroll
        for (int type = 0; type < 3; ++type) {
            float o[2][8];
            {
                const bf16_t* src = p.qkvraw + (size_t)(t0 + j0 - 3) * 1536 + type * 512 + hh * 128 + c8 * 8;
                float x[5][8];
#pragma unroll
                for (int r = 0; r < 5; ++r) {
                    uint4 raw = make_uint4(0, 0, 0, 0);
                    if (n > 0 || j0 - 3 + r >= 0) raw = *(const uint4*)(src + (size_t)r * 1536);
                    const unsigned u[4] = {raw.x, raw.y, raw.z, raw.w};
#pragma unroll
                    for (int i = 0; i < 4; ++i) { x[r][2 * i] = __uint_as_float(u[i] << 16); x[r][2 * i + 1] = __uint_as_float(u[i] & 0xffff0000u); }
                }
                const float* wp = p.conv_w + type * 512 + hh * 128 + c8 * 8;
#pragma unroll
                for (int i = 0; i < 8; ++i) {
                    float a0 = 0.f, a1 = 0.f;
#pragma unroll
                    for (int tap = 0; tap < 4; ++tap) { const float w = wp[tap * 1536 + i]; a0 = fmaf(x[tap][i], w, a0); a1 = fmaf(x[tap + 1][i], w, a1); }
                    o[0][i] = siluf_(a0); o[1][i] = siluf_(a1);
                }
            }
            if (type < 2) {
#pragma unroll
                for (int tk = 0; tk < 2; ++tk) {
                    float ss = 0.f;
#pragma unroll
                    for (int i = 0; i < 8; ++i) ss = fmaf(o[tk][i], o[tk][i], ss);
                    ss += shfl_lane(ss, lane ^ 1); ss += shfl_lane(ss, lane ^ 2); ss += shfl_lane(ss, lane ^ 4); ss += shfl_lane(ss, lane ^ 8);
                    float r = rsqrtf(ss + NORM_EPS);
                    if (type == 0) r *= 0.08838834764831845f;
#pragma unroll
                    for (int i = 0; i < 8; ++i) o[tk][i] *= r;
                }
            }
#pragma unroll
            for (int tk = 0; tk < 2; ++tk) {
                const int j = j0 + tk;
                const int ioff = half * 8192 + j * 128 + ((ch ^ swz(j)) << 4);
                if (type == 0) {
                    *(uint4*)(Qimg + ioff) = pack8(o[tk]);
                    float qd[8];
#pragma unroll
                    for (int i = 0; i < 8; ++i) qd[i] = o[tk][i] * eg[tk];
                    bf16_t* qrow = blob + (size_t)(DN_RQ + half * 64 + j) * 64 + ((c8 >> 1) & 3) * 16 + 4 * (c8 & 1);
                    uint2 w0, w1; w0.x = pk_bf16(qd[0], qd[1]); w0.y = pk_bf16(qd[2], qd[3]); w1.x = pk_bf16(qd[4], qd[5]); w1.y = pk_bf16(qd[6], qd[7]);
                    *(uint2*)qrow = w0; *(uint2*)(qrow + 8) = w1;
                } else if (type == 1) {
                    float kb[8], kbg[8];
#pragma unroll
                    for (int i = 0; i < 8; ++i) { kb[i] = o[tk][i] * be[tk]; kbg[i] = kb[i] * eg[tk]; }
                    *(uint4*)(Kimg + ioff) = pack8(o[tk]);
                    *(uint4*)(KBimg + ioff) = pack8(kb);
                    f32x4* kd = (f32x4*)(KBGf + j * 128 + c8 * 8); kd[0] = (f32x4){kbg[0], kbg[1], kbg[2], kbg[3]}; kd[1] = (f32x4){kbg[4], kbg[5], kbg[6], kbg[7]};
                } else {
                    float vb[8];
#pragma unroll
                    for (int i = 0; i < 8; ++i) vb[i] = o[tk][i] * be[tk];
                    f32x4* vd = (f32x4*)(Vf + j * 128 + c8 * 8); vd[0] = (f32x4){vb[0], vb[1], vb[2], vb[3]}; vd[1] = (f32x4){vb[4], vb[5], vb[6], vb[7]};
                }
            }
            if (type == 1) {
                const int jp = (j0 & 48) | pi16(j0 & 15);
#pragma unroll
                for (int i = 0; i < 8; ++i)
                    *(unsigned*)(blob + (size_t)(DN_RKD + c8 * 8 + i) * 64 + jp) = pk_bf16(o[0][i] * el[0], o[1][i] * el[1]);
            }
        }
    }
    __syncthreads();
    {
        const int which = wid >> 2, ti = (wid >> 1) & 1, tj = wid & 1, l31 = lane & 31, lh = lane >> 5;
        if (!(ti == 0 && tj == 1)) {
            const unsigned char* Ab = (which == 0 ? KBimg : Qimg) + (ti * 32 + l31) * 128;
            const unsigned char* Bb = Kimg + (tj * 32 + l31) * 128;
            const int fsw = swz(l31);
            f32x16 acc;
#pragma unroll
            for (int r = 0; r < 16; ++r) acc[r] = 0.f;
#pragma unroll
            for (int ks = 0; ks < 8; ++ks) {
                const int off = (ks >> 2) * 8192 + ((((ks & 3) * 2 + lh) ^ fsw) << 4);
                acc = __builtin_amdgcn_mfma_f32_32x32x16_bf16(*(const bf16x8*)(Ab + off), *(const bf16x8*)(Bb + off), acc, 0, 0, 0);
            }
            const int j = tj * 32 + l31;
            const float Gj = G2s[j];
#pragma unroll
            for (int r = 0; r < 16; ++r) {
                const int i = ti * 32 + (r & 3) + 8 * (r >> 2) + 4 * lh;
                const float v = acc[r] * exp2f(G2s[i] - Gj);
                if (which == 0) MT[j * 68 + i] = (i > j) ? v : 0.f;
                else blob[(size_t)(DN_RAT + i) * 64 + ((j & 48) | pi16(j & 15))] = to_bf16((i >= j) ? v : 0.f);
            }
        }
    }
    __syncthreads();
#ifndef NO_SOLVE
    if (tid < 256) {
        const int c = tid & 127;
        const float* rhs = (tid < 128 ? Vf : KBGf) + c;
        float y[64];
#pragma unroll
        for (int j = 0; j < 64; ++j) y[j] = rhs[j * 128];
#pragma unroll
        for (int j = 0; j < 63; ++j) {
            const float yj = y[j];
#pragma unroll
            for (int i4 = (j + 1) & ~3; i4 < 64; i4 += 4) {
                const f32x4 m = *(const f32x4*)(MT + j * 68 + i4);
#pragma unroll
                for (int u = 0; u < 4; ++u) if (i4 + u > j) y[i4 + u] = fmaf(-m[u], yj, y[i4 + u]);
            }
            asm volatile("" ::: "memory");
        }
        if (tid < 128) {
#pragma unroll
            for (int mi = 0; mi < 2; ++mi)
#pragma unroll
                for (int h = 0; h < 2; ++h) {
                    f32x4* dst = (f32x4*)(p.dnu + ((((size_t)item * 2 + mi) * 4 + (c >> 5)) * 64 + h * 32 + (c & 31)) * 16);
#pragma unroll
                    for (int g = 0; g < 4; ++g)
                        dst[g] = (f32x4){y[mi * 32 + 8 * g + 4 * h], y[mi * 32 + 8 * g + 4 * h + 1], y[mi * 32 + 8 * g + 4 * h + 2], y[mi * 32 + 8 * g + 4 * h + 3]};
                }
        } else {
            bf16_t* dst = blob + (size_t)(DN_RW + (c >> 6) * 64) * 64 + ((c & 48) | pi16(c & 15));
#pragma unroll
            for (int i = 0; i < 64; ++i) dst[(size_t)i * 64] = to_bf16(-y[i]);
        }
    }
#endif
    __syncthreads();
}

__device__ __forceinline__ void phase_dn_chunks(const Params& p, unsigned char* lds) {
    for (int item = blockIdx.x; item < NB * DNH * 32; item += gridDim.x) dn_chunk_item(p, item, lds);
}

__device__ __forceinline__ void dn_scan(const Params& p, int bh, unsigned char* lds) {
    const int tid = opaque_tid(), lane = tid & 63, wid = tid >> 6, l31 = lane & 31, lh = lane >> 5;
    const int b = bh >> 2, hh = bh & 3;
    const int fsw = swz(l31);
    if (wid >= 4) {
        const int lt = tid - 256;
        typedef unsigned u32x4v __attribute__((ext_vector_type(4)));
        const u32x4v* src = (const u32x4v*)(p.dnblob + (size_t)(bh * 32) * DN_BLOB) + lt;
        u32x4v lr[14];
#define DN_LOAD(n_) { _Pragma("unroll") for (int k = 0; k < 14; ++k) lr[k] = src[(size_t)(n_) * (DN_BLOB / 8) + k * 256]; }
#define DN_STORE(dst_) { _Pragma("unroll") for (int k = 0; k < 14; ++k) { const int c = lt + k * 256, row = c >> 3, ch = c & 7; \
            *(u32x4v*)((dst_) + row * 128 + ((ch ^ swz(row)) << 4)) = lr[k]; } }
        DN_LOAD(0); DN_STORE(lds); DN_LOAD(1);
        __builtin_amdgcn_s_waitcnt(0xc07f);
        __builtin_amdgcn_s_barrier();
        for (int n = 0; n < 32; ++n) {
            if (n + 1 < 32) { DN_STORE(lds + ((n + 1) & 1) * (DN_ROWS * 128)); if (n + 2 < 32) DN_LOAD(n + 2); }
            __builtin_amdgcn_s_waitcnt(0xc07f);
            __builtin_amdgcn_s_barrier();
        }
#undef DN_LOAD
#undef DN_STORE
        return;
    }
    __builtin_amdgcn_s_barrier();
    f32x16 S[4];
#pragma unroll
    for (int t = 0; t < 4; ++t)
#pragma unroll
        for (int r = 0; r < 16; ++r) S[t][r] = 0.f;
    f32x16 vn[2]; float lastn = 0.f;
    {
#pragma unroll
        for (int mi = 0; mi < 2; ++mi) vn[mi] = *(const f32x16*)(p.dnu + ((((size_t)(bh * 32) * 2 + mi) * 4 + wid) * 64 + lane) * 16);
        lastn = p.dnlast[bh * 32];
    }
    for (int n = 0; n < 32; ++n) {
        {
            const unsigned char* buf = lds + (n & 1) * (DN_ROWS * 128);
            const int item = bh * 32 + n;
            f32x16 oa[2];
#pragma unroll
            for (int mi = 0; mi < 2; ++mi)
#pragma unroll
                for (int r = 0; r < 16; ++r) oa[mi][r] = 0.f;
            const float last = lastn;
            typedef unsigned u32x4 __attribute__((ext_vector_type(4)));
            bf16x8 sb[4][2];
#pragma unroll
            for (int t = 0; t < 4; ++t)
#pragma unroll
                for (int ss = 0; ss < 2; ++ss) {
                    u32x4 w;
#pragma unroll
                    for (int q = 0; q < 4; ++q) w[q] = pk_bf16(S[t][8 * ss + 2 * q], S[t][8 * ss + 2 * q + 1]);
                    sb[t][ss] = __builtin_bit_cast(bf16x8, w);
                }
#pragma unroll
            for (int mi = 0; mi < 2; ++mi)
#pragma unroll
                for (int ks = 0; ks < 8; ++ks) {
                    const int off = ((ks >> 2) * 64 + mi * 32 + l31) * 128 + ((((ks & 3) * 2 + lh) ^ fsw) << 4);
                    vn[mi] = __builtin_amdgcn_mfma_f32_32x32x16_bf16(*(const bf16x8*)(buf + DN_RW * 128 + off), sb[ks >> 1][ks & 1], vn[mi], 0, 0, 0);
                    oa[mi] = __builtin_amdgcn_mfma_f32_32x32x16_bf16(*(const bf16x8*)(buf + DN_RQ * 128 + off), sb[ks >> 1][ks & 1], oa[mi], 0, 0, 0);
                }
            bf16x8 vb[2][2];
#pragma unroll
            for (int mj = 0; mj < 2; ++mj)
#pragma unroll
                for (int ss = 0; ss < 2; ++ss) {
                    u32x4 w;
#pragma unroll
                    for (int q = 0; q < 4; ++q) w[q] = pk_bf16(vn[mj][8 * ss + 2 * q], vn[mj][8 * ss + 2 * q + 1]);
                    vb[mj][ss] = __builtin_bit_cast(bf16x8, w);
                }
            {
                const int nx = (n + 1 < 32) ? item + 1 : item;
#pragma unroll
                for (int mi = 0; mi < 2; ++mi) vn[mi] = *(const f32x16*)(p.dnu + ((((size_t)nx * 2 + mi) * 4 + wid) * 64 + lane) * 16);
                lastn = p.dnlast[nx];
            }
#pragma unroll
            for (int mi = 0; mi < 2; ++mi)
#pragma unroll
                for (int kj = 0; kj < 4; ++kj)
                    if ((kj >> 1) <= mi) {
                        const int off = (DN_RAT + mi * 32 + l31) * 128 + (((kj * 2 + lh) ^ fsw) << 4);
                        oa[mi] = __builtin_amdgcn_mfma_f32_32x32x16_bf16(*(const bf16x8*)(buf + off), vb[kj >> 1][kj & 1], oa[mi], 0, 0, 0);
                    }
#pragma unroll
            for (int t = 0; t < 4; ++t) {
#pragma unroll
                for (int r = 0; r < 16; ++r) S[t][r] *= last;
#pragma unroll
                for (int kj = 0; kj < 4; ++kj) {
                    const int off = (DN_RKD + t * 32 + l31) * 128 + (((kj * 2 + lh) ^ fsw) << 4);
                    S[t] = __builtin_amdgcn_mfma_f32_32x32x16_bf16(*(const bf16x8*)(buf + off), vb[kj >> 1][kj & 1], S[t], 0, 0, 0);
                }
            }
            float* orow = p.oraw + (size_t)(b * SEQ + n * 64) * DNW + hh * 128 + wid * 32 + l31;
#pragma unroll
            for (int mi = 0; mi < 2; ++mi)
#pragma unroll
                for (int r = 0; r < 16; ++r) orow[(size_t)(mi * 32 + (r & 3) + 8 * (r >> 2) + 4 * lh) * DNW] = oa[mi][r];
        }
        __builtin_amdgcn_s_waitcnt(0xc07f);
        __builtin_amdgcn_s_barrier();
    }
}

__device__ __forceinline__ void phase_mixers(const Params& p, float* smem) {
    const int nscan = NB * DNH;
    if (gridDim.x >= 2 * nscan) {
#ifndef SKIP_SCAN
        if ((int)blockIdx.x < nscan) dn_scan(p, blockIdx.x, (unsigned char*)smem);
#endif
        if ((int)blockIdx.x < nscan) {}
        else {
            for (int it = blockIdx.x - nscan; it < 512; it += gridDim.x - nscan) sb_attn_wave(p, it >> 3, (it & 7) * 8 + (opaque_tid() >> 6));
        }
    } else {
#ifndef SKIP_SCAN
        for (int bh = blockIdx.x; bh < nscan; bh += gridDim.x) dn_scan(p, bh, (unsigned char*)smem);
#endif
        for (int it = blockIdx.x; it < 512; it += gridDim.x) sb_attn_wave(p, it >> 3, (it & 7) * 8 + (opaque_tid() >> 6));
    }
}

__device__ __forceinline__ void phase_gated_norm(const Params& p) {
    const int lane = opaque_tid() & 63, wave = (blockIdx.x * NT + opaque_tid()) >> 6, nw = (gridDim.x * NT) >> 6;
    for (int item = wave; item < T * 4; item += nw) {
        const int t = item >> 2, hh = item & 3;
        const size_t off = (size_t)t * DNW + hh * 128 + lane * 2;
        const float v0 = p.oraw[off], v1 = p.oraw[off + 1];
        const float ss = wave_sum(v0 * v0 + v1 * v1, lane);
        const float r = rsqrtf(ss * (1.f / 128.f) + NORM_EPS);
        const float z0 = bf2f(p.dzb[(size_t)t * 512 + hh * 128 + lane * 2]), z1 = bf2f(p.dzb[(size_t)t * 512 + hh * 128 + lane * 2 + 1]);
        p.oab[off] = to_bf16(v0 * r * p.norm_g[lane * 2] * siluf_(z0));
        p.oab[off + 1] = to_bf16(v1 * r * p.norm_g[lane * 2 + 1] * siluf_(z1));
    }
}

__device__ __forceinline__ void add_bf16x16(const bf16_t* src, float sc, float (&v)[16]) {
    typedef unsigned u32x4r __attribute__((ext_vector_type(4)));
    const u32x4r a = ((const u32x4r*)src)[0], b = ((const u32x4r*)src)[1];
#pragma unroll
    for (int i = 0; i < 4; ++i) {
        v[2 * i] += sc * __uint_as_float(a[i] << 16); v[2 * i + 1] += sc * __uint_as_float(a[i] & 0xffff0000u);
        v[8 + 2 * i] += sc * __uint_as_float(b[i] << 16); v[8 + 2 * i + 1] += sc * __uint_as_float(b[i] & 0xffff0000u);
    }
}
template <class SF>
__device__ __forceinline__ void layer_norm_rows(SF sf, const float* g, const float* bb, float* dst, bf16_t* dstb) {
    const int lane = opaque_tid() & 63, wave = (blockIdx.x * NT + opaque_tid()) >> 6, nw = (gridDim.x * NT) >> 6;
    const int c0 = lane * 16;
    float gg[16], be[16];
#pragma unroll
    for (int i = 0; i < 4; ++i) {
        const f32x4 x = *(const f32x4*)(g + c0 + 4 * i), y = *(const f32x4*)(bb + c0 + 4 * i);
#pragma unroll
        for (int j = 0; j < 4; ++j) { gg[4 * i + j] = x[j]; be[4 * i + j] = y[j]; }
    }
    for (int t = wave; t < T; t += nw) {
        float v[16];
        sf(t, c0, v);
        float s = 0.f;
#pragma unroll
        for (int i = 0; i < 16; ++i) s += v[i];
        const float mu = wave_sum(s, lane) * (1.f / 1024.f);
        float q = 0.f;
#pragma unroll
        for (int i = 0; i < 16; ++i) { const float d = v[i] - mu; q += d * d; }
        const float rstd = rsqrtf(wave_sum(q, lane) * (1.f / 1024.f) + LN_EPS);
        float y[16];
#pragma unroll
        for (int i = 0; i < 16; ++i) y[i] = (v[i] - mu) * rstd * gg[i] + be[i];
        if (dst) {
#pragma unroll
            for (int i = 0; i < 4; ++i) *(f32x4*)(dst + (size_t)t * D + c0 + 4 * i) = (f32x4){y[4 * i], y[4 * i + 1], y[4 * i + 2], y[4 * i + 3]};
        }
        if (dstb) {
            typedef unsigned u32x4r __attribute__((ext_vector_type(4)));
#pragma unroll
            for (int i = 0; i < 2; ++i)
                *(u32x4r*)(dstb + (size_t)t * D + c0 + 8 * i) = (u32x4r){pk_bf16(y[8 * i], y[8 * i + 1]), pk_bf16(y[8 * i + 2], y[8 * i + 3]), pk_bf16(y[8 * i + 4], y[8 * i + 5]), pk_bf16(y[8 * i + 6], y[8 * i + 7])};
        }
    }
}

__device__ __forceinline__ void phase_route(const Params& p, int* counts, int* explist, int* ldsw) {
    const int tid = opaque_tid(), lane = tid & 63;
    const int wave = (blockIdx.x * NT + tid) >> 6, nw = (gridDim.x * NT) >> 6;
    int* mye = ldsw + (tid >> 6) * 64;
    const f32x4 bias = *(const f32x4*)(p.router_bias + lane * 4);
    for (int t0 = wave; t0 < T; t0 += nw * 8) {
        f32x4 scs[8];
#pragma unroll
        for (int k = 0; k < 8; ++k) { const int t = t0 + k * nw; scs[k] = t < T ? *(const f32x4*)(p.scores + (size_t)t * NE + lane * 4) : (f32x4){0.f, 0.f, 0.f, 0.f}; }
#pragma unroll 1
        for (int k = 0; k < 8; ++k) {
            const int t = t0 + k * nw;
            if (t >= T) break;
            f32x4 sc = scs[0];
#pragma unroll
            for (int kk = 1; kk < 8; ++kk) sc = (k == kk) ? scs[kk] : sc;
            const float sel[4] = {sc[0] + bias[0], sc[1] + bias[1], sc[2] + bias[2], sc[3] + bias[3]};
            float m1 = fmaxf(sel[0], sel[1]), m2 = fminf(sel[0], sel[1]);
            m2 = fmaxf(m2, fminf(m1, sel[2])); m1 = fmaxf(m1, sel[2]);
            m2 = fmaxf(m2, fminf(m1, sel[3])); m1 = fmaxf(m1, sel[3]);
#pragma unroll
            for (int off = 1; off < 8; off <<= 1) {
                const float o1 = shfl_lane(m1, lane ^ off), o2 = shfl_lane(m2, lane ^ off);
                const float n2 = fmaxf(fminf(m1, o1), fmaxf(m2, o2));
                m1 = fmaxf(m1, o1); m2 = n2;
            }
            const float gs = m1 + m2;
            const int g = lane >> 3;
            int rank = 0;
#pragma unroll
            for (int gg = 0; gg < NG; ++gg) { const float og = __int_as_float(__builtin_amdgcn_readlane(__float_as_int(gs), gg * 8)); rank += (og > gs || (og == gs && gg < g)) ? 1 : 0; }
            const bool gsel = rank < TOPG;
            unsigned ku[4];
#pragma unroll
            for (int i = 0; i < 4; ++i) {
                const unsigned u = __float_as_uint(sel[i]);
                ku[i] = gsel ? ((u & 0x80000000u) ? ~u : (u | 0x80000000u)) : 0u;
            }
            unsigned v8 = 0u;
#pragma unroll 1
            for (int bit = 31; bit >= 0; --bit) {
                const unsigned cand = v8 | (1u << bit);
                const int c = __popcll(__ballot(ku[0] >= cand)) + __popcll(__ballot(ku[1] >= cand)) + __popcll(__ballot(ku[2] >= cand)) + __popcll(__ballot(ku[3] >= cand));
                if (c >= TOPK) v8 = cand;
            }
            int ngt = 0, eqlow = 0, sellow = 0;
            unsigned long long eqm[4];
#pragma unroll
            for (int i = 0; i < 4; ++i) { ngt += __popcll(__ballot(ku[i] > v8)); eqm[i] = __ballot(ku[i] == v8); }
            const int need = TOPK - ngt;
#pragma unroll
            for (int i = 0; i < 4; ++i) eqlow += __builtin_amdgcn_mbcnt_hi((unsigned)(eqm[i] >> 32), __builtin_amdgcn_mbcnt_lo((unsigned)eqm[i], 0u));
            bool selc[4]; int eqrank = eqlow;
#pragma unroll
            for (int i = 0; i < 4; ++i) {
                const bool eq = ku[i] == v8;
                selc[i] = (ku[i] > v8) || (eq && eqrank < need);
                eqrank += eq ? 1 : 0;
            }
            float part = 0.f;
#pragma unroll
            for (int i = 0; i < 4; ++i) {
                const unsigned long long sm = __ballot(selc[i]);
                part += selc[i] ? sc[i] : 0.f;
                sellow += __builtin_amdgcn_mbcnt_hi((unsigned)(sm >> 32), __builtin_amdgcn_mbcnt_lo((unsigned)sm, 0u));
            }
            const float wsum = wave_sum(part, lane);
            int slot = sellow;
#pragma unroll
            for (int i = 0; i < 4; ++i)
                if (selc[i]) {
                    const int e = lane * 4 + i, pr = t * TOPK + slot;
                    p.gate[pr] = sc[i] / wsum * 2.5f;
                    mye[k * 8 + slot] = e;
                    ++slot;
                }
        }
        {
            const int k = lane >> 3, t = t0 + k * nw;
            if (t < T) {
                const int e = mye[lane], pos = atomicAdd(&counts[e * CSTRIDE], 1);
                explist[(size_t)e * ECAP + pos] = t * TOPK + (lane & 7);
            }
        }
    }
}

__device__ __forceinline__ void compute_pend(const Params& p, int* pend, int* cnt) {
    const int tid = opaque_tid();
    if (tid < 64) {
        int c[4], pc[4];
#pragma unroll
        for (int i = 0; i < 4; ++i) { c[i] = p.counts[(tid * 4 + i) * CSTRIDE]; cnt[tid * 4 + i] = c[i]; pc[i] = (c[i] + 127) / 128 * 128; }
        const int ssum = pc[0] + pc[1] + pc[2] + pc[3];
        int inc = ssum;
#pragma unroll
        for (int off = 1; off < 64; off <<= 1) { const int v = shfl_lane_i(inc, tid - off); if (tid >= off) inc += v; }
        int run = inc - ssum;
#pragma unroll
        for (int i = 0; i < 4; ++i) { run += pc[i]; pend[tid * 4 + i] = run; }
    }
    __syncthreads();
}

__device__ __forceinline__ int expert_of_row(const int* pend, int row) {
    int lo = 0, hi = NE - 1;
    while (lo < hi) { const int mid = (lo + hi) >> 1; if (pend[mid] > row) hi = mid; else lo = mid + 1; }
    return lo;
}

__device__ __forceinline__ void phase_routed(const Params& p, int* pend, int* cnt, unsigned char* lds) {
    typedef GemmCfg<128, 256, 2, 4> CFG;
    compute_pend(p, pend, cnt);
    int* prs = (int*)(lds + 131072); float* gts = (float*)(lds + 131072 + 512);
    const bool grouped = (gridDim.x % 8) == 0;
    const int vb = vblock();
    const int xg = grouped ? (vb & 7) : 0, estep = grouped ? 8 : 1;
    const int nslots = grouped ? (gridDim.x >> 3) : gridDim.x;
    int widx = grouped ? (vb >> 3) : vb, tbase = 0;
    for (int e = xg; e < NE; e += estep) {
      const int ce = cnt[e], ntile = (ce + 127) >> 7;
      for (; widx < tbase + ntile; widx += nslots) {
        const int q0 = (widx - tbase) * 128;
        {
            const int tid = opaque_tid();
            if (tid < 128) {
                const int pr = (q0 + tid < ce) ? p.explist[(size_t)e * ECAP + q0 + tid] : -1;
                prs[tid] = pr; gts[tid] = pr >= 0 ? p.gate[pr] : 0.f;
            }
        }
        __syncthreads();
#pragma unroll 1
        for (int tn_ = 0; tn_ < 2 * RU; ++tn_) {
            const int tn = tn_ & 1;
            LoadRowsBf16N<128, 3> al; LoadKNF32N<3> bl;
            al.init(p.hb, D, [&](int r) { const int pr = prs[r]; return (long long)(pr >= 0 ? (pr >> 3) : 0); });
            bl.init(p.w_eu + (size_t)e * D * (2 * EFF), 2 * EFF, [&](int r) { return ((r >> 5) & 1) * EFF + tn * 128 + (r >> 6) * 32 + (r & 31); });
            f32x16 acc[CFG::MI][CFG::NI];
            acc_zero<CFG>(acc);
            gemm_mainloop_d3<CFG, false>(al, bl, D / 64, acc, lds);
            const int tid = opaque_tid(), lane = tid & 63, wid = tid >> 6, wm = wid / CFG::WN, wn = wid % CFG::WN;
            const int j = tn * 128 + wn * 32 + (lane & 31);
            unsigned char* img = lds + 65536 + (((j >> 6) + 2) & 3) * 16384 + (j & 7) * 2;
            const int jc = (j & 63) >> 3;
#pragma unroll
            for (int mi = 0; mi < CFG::MI; ++mi)
#pragma unroll
                for (int r = 0; r < 16; ++r) {
                    const int row = wm * CFG::TM + mi * 32 + (r & 3) + 8 * (r >> 2) + 4 * (lane >> 5);
                    *(bf16_t*)(img + row * 128 + ((jc ^ swz(row)) << 4)) = to_bf16(siluf_(acc[mi][0][r]) * acc[mi][1][r]);
                }
        }
        __syncthreads();
#pragma unroll 1
        for (int tn_ = 0; tn_ < 4 * RD; ++tn_) {
            const int tn = tn_ & 3;
            LoadRowsBf16<128> aldummy[2]; LoadKNF32 bl[2];
#pragma unroll
            for (int u = 0; u < 2; ++u) bl[u].init(p.w_ed + (size_t)e * EFF * D, D, [&](int r) { return tn * 256 + r; });
            f32x16 acc[CFG::MI][CFG::NI];
            acc_zero<CFG>(acc);
            gemm_mainloop2<CFG, true, 2, true>(aldummy, bl, EFF / 64, acc, lds, lds + 65536);
            {
                const int tid = opaque_tid(), lane = tid & 63, wid = tid >> 6, wm = wid / CFG::WN, wn = wid % CFG::WN;
#pragma unroll
                for (int mi = 0; mi < CFG::MI; ++mi) {
                    const int row = wm * CFG::TM + mi * 32 + (lane & 31);
                    const int pr = prs[row]; const float g = gts[row];
                    if (pr >= 0) {
#pragma unroll
                        for (int ni = 0; ni < CFG::NI; ++ni) {
                            bf16_t* dst = p.ypairb + (size_t)pr * D + tn * 256 + wn * CFG::TN + ni * 32 + 4 * (lane >> 5);
#pragma unroll
                            for (int gq = 0; gq < 4; ++gq) {
                                uint2 w; w.x = pk_bf16(acc[mi][ni][4 * gq] * g, acc[mi][ni][4 * gq + 1] * g); w.y = pk_bf16(acc[mi][ni][4 * gq + 2] * g, acc[mi][ni][4 * gq + 3] * g);
                                *(uint2*)(dst + 8 * gq) = w;
                            }
                        }
                    }
                }
            }
        }
        __syncthreads();
      }
      tbase += ntile;
    }
}

#define RW_BAR() do { __builtin_amdgcn_s_waitcnt(0xc07f); __builtin_amdgcn_s_barrier(); } while (0)
__device__ __forceinline__ void phase_routed_ws(const Params& p, int* pend, int* cnt, unsigned char* lds) {
    compute_pend(p, pend, cnt);
    const int tid = opaque_tid(), lane = tid & 63, wid = tid >> 6;
    const bool grouped = (gridDim.x % 8) == 0;
    const int vb = vblock();
    const int xg = grouped ? (vb & 7) : 0, estep = grouped ? 8 : 1;
    const int nslots = grouped ? (gridDim.x >> 3) : gridDim.x;
    const int widx0 = grouped ? (vb >> 3) : vb;
    typedef unsigned u32x4v __attribute__((ext_vector_type(4)));
    if (wid >= 4) {
        const int lt = tid - 256, kq = lt >> 6, nq = lt & 63, arow = lt >> 3, ach = lt & 7;
        u32x4v ra[2][4]; f32x4 rb[2][16];
        const int r4 = nq * 4, upcol = ((r4 >> 6) & 1) * EFF + (r4 >> 7) * 64 + ((r4 >> 5) & 1) * 32 + (r4 & 31);
#define RW_LOAD(S, u_) do { const int uu = (u_); \
            if (uu < 32) { const int tn = uu >> 4, k0 = (uu & 15) * 64; \
                _Pragma("unroll") for (int i = 0; i < 4; ++i) ra[S][i] = *(const u32x4v*)(p.hb + (size_t)aoff[i] + k0); \
                const float* q_ = wu + (size_t)(k0 + kq * 8) * (2 * EFF) + upcol + tn * 128; \
                _Pragma("unroll") for (int h = 0; h < 2; ++h) { _Pragma("unroll") for (int j = 0; j < 8; ++j) { \
                    rb[S][h * 8 + j] = *(const f32x4*)q_; q_ += (j == 7 ? 25 : 1) * (2 * EFF); asm volatile("" : "+v"(q_)); } } \
            } else { const int dd = uu - 32, tn = dd >> 2, k0 = (dd & 3) * 64; \
                const float* q_ = wd + (size_t)(k0 + kq * 8) * D + tn * 256 + r4; \
                _Pragma("unroll") for (int h = 0; h < 2; ++h) { _Pragma("unroll") for (int j = 0; j < 8; ++j) { \
                    rb[S][h * 8 + j] = *(const f32x4*)q_; q_ += (j == 7 ? 25 : 1) * D; asm volatile("" : "+v"(q_)); } } \
            } } while (0)
#define RW_STORE(S, u_) do { const int uu = (u_); \
            unsigned char* sb_ = (uu < 32) ? lds + (uu & 1) * 49152 + 16384 : lds + ((uu - 32) & 1) * 32768; \
            if (uu < 32) { unsigned char* sa_ = lds + (uu & 1) * 49152; \
                _Pragma("unroll") for (int i = 0; i < 4; ++i) { const int row = arow + 32 * i; *(u32x4v*)(sa_ + row * 128 + ((ach ^ swz(row)) << 4)) = ra[S][i]; } } \
            _Pragma("unroll") for (int h = 0; h < 2; ++h) _Pragma("unroll") for (int nn = 0; nn < 4; ++nn) { \
                const int row = r4 + nn; \
                const u32x4v o = {pk_bf16(rb[S][h * 8][nn], rb[S][h * 8 + 1][nn]), pk_bf16(rb[S][h * 8 + 2][nn], rb[S][h * 8 + 3][nn]), \
                                  pk_bf16(rb[S][h * 8 + 4][nn], rb[S][h * 8 + 5][nn]), pk_bf16(rb[S][h * 8 + 6][nn], rb[S][h * 8 + 7][nn])}; \
                *(u32x4v*)(sb_ + row * 128 + (((kq + 4 * h) ^ swz(row)) << 4)) = o; } } while (0)
        int widx = widx0, tbase = 0;
        for (int e = xg; e < NE; e += estep) {
            const int ce = cnt[e], ntile = (ce + 127) >> 7;
            for (; widx < tbase + ntile; widx += nslots) {
                const int q0 = (widx - tbase) * 128;
                unsigned aoff[4];
#pragma unroll
                for (int i = 0; i < 4; ++i) {
                    const int row = arow + 32 * i;
                    const int pr = (q0 + row < ce) ? p.explist[(size_t)e * ECAP + q0 + row] : -1;
                    aoff[i] = (unsigned)((pr >= 0 ? (pr >> 3) : 0) * D + ach * 8);
                }
                const float* wu = p.w_eu + (size_t)e * D * (2 * EFF);
                const float* wd = p.w_ed + (size_t)e * EFF * D;
                RW_LOAD(0, 0); RW_STORE(0, 0); RW_LOAD(1, 1); RW_LOAD(0, 2);
                RW_BAR();
#pragma unroll 1
                for (int u = 0; u < 48; u += 2) {
                    if (u == 32) RW_BAR();
                    RW_STORE(1, u + 1); if (u + 3 < 48) RW_LOAD(1, u + 3);
                    RW_BAR();
                    if (u + 2 < 48) { RW_STORE(0, u + 2); if (u + 4 < 48) RW_LOAD(0, u + 4); }
                    RW_BAR();
                }
            }
            tbase += ntile;
        }
#undef RW_LOAD
#undef RW_STORE
        return;
    }
    const int wm = wid >> 1, wn = wid & 1, l31 = lane & 31, lh = lane >> 5, fsw = swz(l31);
    const int a_off = (wm * 64 + l31) * LROW, b_off = (wn * 128 + l31) * LROW;
    int widx = widx0, tbase = 0, tcount = 0;
    for (int e = xg; e < NE; e += estep) {
        const int ce = cnt[e], ntile = (ce + 127) >> 7;
        for (; widx < tbase + ntile; widx += nslots, ++tcount) {
            const int q0 = (widx - tbase) * 128;
            int* prs = (int*)(lds + 131072 + (tcount & 1) * 1024); float* gts = (float*)(prs + 128);
            if (tid < 128) {
                const int pr = (q0 + tid < ce) ? p.explist[(size_t)e * ECAP + q0 + tid] : -1;
                prs[tid] = pr; gts[tid] = pr >= 0 ? p.gate[pr] : 0.f;
            }
            RW_BAR();
            f32x16 acc[2][4];
#pragma unroll 1
            for (int tn = 0; tn < 2; ++tn) {
#pragma unroll
                for (int mi = 0; mi < 2; ++mi)
#pragma unroll
                    for (int ni = 0; ni < 4; ++ni)
#pragma unroll
                        for (int r = 0; r < 16; ++r) acc[mi][ni][r] = 0.f;
#pragma unroll 1
                for (int kt = 0; kt < 16; ++kt) {
                    const unsigned char* st = lds + (kt & 1) * 49152;
#pragma unroll
                    for (int kk = 0; kk < 4; ++kk) {
                        bf16x8 a[2], b[4];
                        const int co = (((kk * 2 + lh) ^ fsw) << 4);
#pragma unroll
                        for (int mi = 0; mi < 2; ++mi) a[mi] = *(const bf16x8*)(st + a_off + mi * 32 * LROW + co);
#pragma unroll
                        for (int ni = 0; ni < 4; ++ni) b[ni] = *(const bf16x8*)(st + 16384 + b_off + ni * 32 * LROW + co);
#pragma unroll
                        for (int mi = 0; mi < 2; ++mi)
#pragma unroll
                            for (int ni = 0; ni < 4; ++ni) acc[mi][ni] = __builtin_amdgcn_mfma_f32_32x32x16_bf16(a[mi], b[ni], acc[mi][ni], 0, 0, 0);
                    }
                    RW_BAR();
                }
#pragma unroll
                for (int hh = 0; hh < 2; ++hh) {
                    const int j = tn * 128 + wn * 64 + hh * 32 + l31;
                    unsigned char* img = lds + 65536 + (((j >> 6) + 2) & 3) * 16384 + (j & 7) * 2;
                    const int jc = (j & 63) >> 3;
#pragma unroll
                    for (int mi = 0; mi < 2; ++mi)
#pragma unroll
                        for (int r = 0; r < 16; ++r) {
                            const int row = wm * 64 + mi * 32 + (r & 3) + 8 * (r >> 2) + 4 * lh;
                            *(bf16_t*)(img + row * 128 + ((jc ^ swz(row)) << 4)) = to_bf16(siluf_(acc[mi][hh][r]) * acc[mi][hh + 2][r]);
                        }
                }
            }
            RW_BAR();
#pragma unroll 1
            for (int tn = 0; tn < 4; ++tn) {
#pragma unroll
                for (int mi = 0; mi < 2; ++mi)
#pragma unroll
                    for (int ni = 0; ni < 4; ++ni)
#pragma unroll
                        for (int r = 0; r < 16; ++r) acc[mi][ni][r] = 0.f;
#pragma unroll 1
                for (int kt = 0; kt < 4; ++kt) {
                    const unsigned char* st = lds + (kt & 1) * 32768;
                    const unsigned char* ai = lds + 65536 + ((kt + 2) & 3) * 16384;
#pragma unroll
                    for (int kk = 0; kk < 4; ++kk) {
                        bf16x8 a[2], b[4];
                        const int co = (((kk * 2 + lh) ^ fsw) << 4);
#pragma unroll
                        for (int mi = 0; mi < 2; ++mi) a[mi] = *(const bf16x8*)(ai + a_off + mi * 32 * LROW + co);
#pragma unroll
                        for (int ni = 0; ni < 4; ++ni) b[ni] = *(const bf16x8*)(st + b_off + ni * 32 * LROW + co);
#pragma unroll
                        for (int mi = 0; mi < 2; ++mi)
#pragma unroll
                            for (int ni = 0; ni < 4; ++ni) acc[mi][ni] = __builtin_amdgcn_mfma_f32_32x32x16_bf16(b[ni], a[mi], acc[mi][ni], 0, 0, 0);
                    }
                    RW_BAR();
                }
#pragma unroll
                for (int mi = 0; mi < 2; ++mi) {
                    const int row = wm * 64 + mi * 32 + l31;
                    const int pr = prs[row]; const float g = gts[row];
                    if (pr >= 0) {
#pragma unroll
                        for (int ni = 0; ni < 4; ++ni) {
                            bf16_t* dst = p.ypairb + (size_t)pr * D + tn * 256 + wn * 128 + ni * 32 + 4 * lh;
#pragma unroll
                            for (int gq = 0; gq < 4; ++gq) {
                                uint2 w; w.x = pk_bf16(acc[mi][ni][4 * gq] * g, acc[mi][ni][4 * gq + 1] * g); w.y = pk_bf16(acc[mi][ni][4 * gq + 2] * g, acc[mi][ni][4 * gq + 3] * g);
                                *(uint2*)(dst + 8 * gq) = w;
                            }
                        }
                    }
                }
            }
        }
        tbase += ntile;
    }
}

#ifndef R0
#define R0 1
#define R1 1
#define R2 1
#define R3 1
#define R4 1
#define R5 1
#define R6 1
#define R7 1
#define R8 1
#define R10 1
#define R11 1
#define R12 1
#endif

constexpr int LDS_MAIN = 133120;
__global__ void __launch_bounds__(NT) fwd_megakernel(KArgs ka) {
    __shared__ __attribute__((aligned(16))) unsigned char lds[LDS_MAIN + 2 * NE * 4 + 16];
    float* smem = (float*)lds;
    int* pend = (int*)(lds + LDS_MAIN);
    int* cnt = pend + NE;
    volatile LAS3 unsigned* xbst = (volatile LAS3 unsigned*)(lds + LDS_MAIN + 2 * NE * 4);
    if (threadIdx.x == 0) { xbst[0] = 0u; xbst[1] = 0u; }
    __syncthreads();
    const XcdBarrier xb = xcd_barrier_post((unsigned*)(ka.ws + OFF_BAR), xbst);

#define REPEAT(N, ...) { int reps_ = (N); asm volatile("" : "+s"(reps_)); for (int rep_ = 0; rep_ < reps_; ++rep_) { { const Params p(ka); __VA_ARGS__; } xcd_barrier(xb); } }
    if (threadIdx.x == 0) xbst[3] = blockIdx.x;
    { const Params p(ka); phase_init(p); }
    REPEAT(R0,
        convert_bf16(p.x, p.xb, (size_t)T * D);
        transpose_convert(p.w_in, D, PW, PWP, p.w_in_t, smem, [](int n) { return n < 2048 ? n : n < 5632 ? n + 8 : n < 5640 ? n - 5632 + 2048 : -1; });
        transpose_convert(p.w_pa, DNW, D, D, p.w_pa_t, smem, [](int n) { return n; });
        transpose_convert(p.w_pb, SBW, D, D, p.w_pb_t, smem, [](int n) { return n; });
        transpose_convert(p.w_out, D, D, D, p.w_out_t, smem, [](int n) { return n; });
        transpose_convert(p.w_router, D, NE, NE, p.w_router_t, smem, [](int n) { return n; });
        transpose_convert(p.w_su, D, 2 * SFF, 2 * SFF, p.w_su_t, smem, [](int n) { return n; });
        transpose_convert(p.w_sd, SFF, D, D, p.w_sd_t, smem, [](int n) { return n; }))
    REPEAT(R1, phase_inproj(p, lds))
    REPEAT(R2, phase_dn_chunks(p, lds))
    REPEAT(R3, phase_mixers(p, smem))
    REPEAT(R4, phase_gated_norm(p))
    REPEAT(R5, phase_merge(p, lds))
    REPEAT(R6, phase_outproj(p, lds))
    REPEAT(R7, layer_norm_rows([&](int t, int c0, float (&v)[16]) {
            _Pragma("unroll") for (int i = 0; i < 4; ++i) { const f32x4 x = *(const f32x4*)(p.pre1 + (size_t)t * D + c0 + 4 * i); v[4 * i] = x[0]; v[4 * i + 1] = x[1]; v[4 * i + 2] = x[2]; v[4 * i + 3] = x[3]; } },
        p.ln1_g, p.ln1_b, nullptr, p.hb))
    REPEAT(R8, phase_router_shared_up(p, lds))
    { const Params p(ka); phase_route(p, p.counts, p.explist, (int*)lds); }
    xcd_barrier(xb);
    { int reps9 = R9 - 1; asm volatile("" : "+s"(reps9)); for (int r9 = 0; r9 < reps9; ++r9) { const Params p(ka); phase_route(p, p.counts + NE * CSTRIDE, (int*)p.ypairb, (int*)lds); xcd_barrier(xb); } }
    { int repsb = RB; asm volatile("" : "+s"(repsb)); for (int rb = 0; rb < repsb; ++rb) xcd_barrier(xb); }
    REPEAT(R10, phase_routed_ws(p, pend, cnt, lds); __syncthreads(); phase_shared_down(p, lds))
    int reps12 = R12; asm volatile("" : "+s"(reps12));
    for (int rep = 0; rep < reps12; ++rep) {
        const Params p(ka);
        layer_norm_rows([&](int t, int c0, float (&v)[16]) {
#pragma unroll
                for (int i = 0; i < 16; ++i) v[i] = 0.f;
                add_bf16x16(p.hb + (size_t)t * D + c0, ALPHA, v);
                add_bf16x16(p.yshb + (size_t)t * D + c0, 1.f, v);
#pragma unroll
                for (int k = 0; k < TOPK; ++k) add_bf16x16(p.ypairb + ((size_t)t * TOPK + k) * D + c0, 1.f, v); },
            p.ln2_g, p.ln2_b, p.out, nullptr);
    }
}

extern "C" void kernel_launch(void* const* d_in, const int* in_sizes, int n_in, void* d_out, int out_size, void* d_ws,
                              size_t ws_size, hipStream_t stream) {
    static int grid_blocks = 0;
    if (!grid_blocks) {
        int dev = 0, cus = 0, per_cu = 0;
        hipGetDevice(&dev);
        hipDeviceGetAttribute(&cus, hipDeviceAttributeMultiprocessorCount, dev);
        hipOccupancyMaxActiveBlocksPerMultiprocessor(&per_cu, fwd_megakernel, NT, 0);
        if (per_cu > 1) per_cu = 1;
        grid_blocks = cus * per_cu;
    }
    KArgs p{};
    const float* const* in = (const float* const*)d_in;
    p.x = in[0]; p.w_in = in[1]; p.conv_w = in[2]; p.a_log = in[3]; p.dt_bias = in[4]; p.norm_g = in[5]; p.w_pa = in[6];
    p.w_pb = in[7]; p.w_out = in[8]; p.ln1_g = in[9]; p.ln1_b = in[10]; p.w_router = in[11]; p.router_bias = in[12];
    p.w_su = in[13]; p.w_sd = in[14]; p.w_eu = in[15]; p.w_ed = in[16]; p.ln2_g = in[17]; p.ln2_b = in[18];
    p.out = (float*)d_out; p.ws = (unsigned char*)d_ws;
    if (WS_BYTES > ws_size) { fprintf(stderr, "workspace too small: need %zu have %zu\n", (size_t)WS_BYTES, ws_size); return; }
    hipMemsetAsync(p.ws + OFF_BAR, 0, XCD_BAR_WORDS * 4, stream);
    void* args[] = {&p};
    hipError_t e = hipLaunchCooperativeKernel((void*)fwd_megakernel, dim3(grid_blocks), dim3(NT), args, 0, stream);
    if (e != hipSuccess) fprintf(stderr, "cooperative launch failed: %s (grid %d)\n", hipGetErrorString(e), grid_blocks);
}
```

```cpp
#include <hip/hip_runtime.h>
#include <hip/hip_cooperative_groups.h>
#include <cstdio>
#include <cstdint>
namespace cg = cooperative_groups;

constexpr int D = 1024, NB = 8, SEQ = 2048, T = NB * SEQ;
constexpr int DNH = 4, DND = 128, DNW = 512;
constexpr int SBH = 8, SBD = 64, SBW = 512;
constexpr int NE = 256, TOPK = 8, NG = 8, TOPG = 4, EFF = 256, SFF = 256;
constexpr int PW = 5640;
constexpr int NPAIR = T * TOPK;
constexpr int NBLK = (NPAIR + NE * 127 + 127) / 128;
constexpr int PROWS = NBLK * 128;
constexpr float ALPHA = 1.189207115002721f;
constexpr float LN_EPS = 1e-5f, NORM_EPS = 1e-6f;
constexpr int NT = 512;
#ifndef RU
#define RU 1
#define RD 1
#define R9 1
#define RB 0
#endif

typedef unsigned short bf16_t;
constexpr int PWP = 5888;
constexpr int DN_ROWS = 448, DN_BLOB = DN_ROWS * 64;
constexpr int ECAP = T;
#define XCD_BAR_WORDS 3456
constexpr int CSTRIDE = 64;
constexpr size_t al256(size_t x) { return (x + 255) & ~(size_t)255; }
constexpr size_t OFF_XB = 0;
constexpr size_t OFF_WINT = OFF_XB + al256((size_t)T * D * 2);
constexpr size_t OFF_QKVRAW = OFF_WINT + al256((size_t)PWP * D * 2);
constexpr size_t OFF_DZB = OFF_QKVRAW + al256((size_t)T * 1536 * 2);
constexpr size_t OFF_SQ = OFF_DZB + al256((size_t)T * 512 * 2);
constexpr size_t OFF_SK = OFF_SQ + al256((size_t)T * 512 * 2);
constexpr size_t OFF_VT = OFF_SK + al256((size_t)T * 512 * 2);
constexpr size_t OFF_DNBLOB = OFF_VT + al256((size_t)T * 512 * 2);
constexpr size_t OFF_DNU = OFF_DNBLOB + al256((size_t)1024 * DN_BLOB * 2);
constexpr size_t OFF_DNLAST = OFF_DNU + al256((size_t)1024 * 64 * 128 * 4);
constexpr size_t OFF_GAB = OFF_DNLAST + al256(1024 * 4);
constexpr size_t OFF_GBB = OFF_GAB + al256((size_t)T * D * 2);
constexpr size_t OFF_SMALL = OFF_GBB + al256((size_t)T * D * 2);
constexpr size_t OFF_WPAT = OFF_SMALL + al256((size_t)T * 8 * 4);
constexpr size_t OFF_WPBT = OFF_WPAT + al256((size_t)D * DNW * 2);
constexpr size_t OFF_WOUTT = OFF_WPBT + al256((size_t)D * SBW * 2);
constexpr size_t OFF_WROUTT = OFF_WOUTT + al256((size_t)D * D * 2);
constexpr size_t OFF_WSUT = OFF_WROUTT + al256((size_t)NE * D * 2);
constexpr size_t OFF_WSDT = OFF_WSUT + al256((size_t)2 * SFF * D * 2);
constexpr size_t OFF_OAB = OFF_WSDT + al256((size_t)D * SFF * 2);
constexpr size_t OFF_OBB = OFF_OAB + al256((size_t)T * DNW * 2);
constexpr size_t OFF_MERGED = OFF_OBB + al256((size_t)T * SBW * 2);
constexpr size_t OFF_HB = OFF_MERGED + al256((size_t)T * D * 2);
constexpr size_t OFF_ACTSH = OFF_HB + al256((size_t)T * D * 2);
constexpr size_t OFF_YPAIRB = OFF_ACTSH + al256((size_t)T * SFF * 2);
constexpr size_t OFF_ORAW = OFF_YPAIRB + al256((size_t)NPAIR * D * 2);
constexpr size_t OFF_PRE1 = OFF_ORAW + al256((size_t)T * DNW * 4);
constexpr size_t OFF_H = OFF_PRE1 + al256((size_t)T * D * 4);
constexpr size_t OFF_SCORES = OFF_H + al256((size_t)T * D * 4);
constexpr size_t OFF_GATE = OFF_SCORES + al256((size_t)T * NE * 4);
constexpr size_t OFF_YSH = OFF_GATE + al256((size_t)NPAIR * 4);
constexpr size_t OFF_IDX = OFF_YSH + al256((size_t)T * D * 4);
constexpr size_t OFF_COUNTS = OFF_IDX + al256((size_t)NPAIR * 4);
constexpr size_t OFF_EXPLIST = OFF_COUNTS + al256(2 * NE * CSTRIDE * 4);
constexpr size_t OFF_WEUT = OFF_EXPLIST + al256((size_t)NE * ECAP * 4);
constexpr size_t OFF_M1 = OFF_WEUT + al256((size_t)NE * 2 * EFF * D * 2);
constexpr size_t OFF_BAR = OFF_M1 + al256((size_t)T * D * 4);
constexpr size_t WS_BYTES = OFF_BAR + al256(XCD_BAR_WORDS * 4);

struct KArgs {
    const float *x, *w_in, *conv_w, *a_log, *dt_bias, *norm_g, *w_pa, *w_pb, *w_out, *ln1_g, *ln1_b, *w_router,
        *router_bias, *w_su, *w_sd, *w_eu, *w_ed, *ln2_g, *ln2_b;
    float* out; unsigned char* ws;
};
struct Params {
    const float *x, *w_in, *conv_w, *a_log, *dt_bias, *norm_g, *w_pa, *w_pb, *w_out, *ln1_g, *ln1_b, *w_router,
        *router_bias, *w_su, *w_sd, *w_eu, *w_ed, *ln2_g, *ln2_b;
    float* out;
    float *oraw, *pre1, *h, *scores, *gate, *ysh, *small, *dnu, *dnlast, *m1;
    int *idx, *counts, *explist;
    bf16_t *xb, *w_in_t, *w_pa_t, *w_pb_t, *w_out_t, *w_router_t, *w_su_t, *w_sd_t, *oab, *obb, *mergedb, *hb, *actsh, *ypairb, *yshb;
    bf16_t *qkvraw, *dzb, *sq, *sk, *vT, *gab, *gbb, *dnblob, *w_eu_t;
    unsigned* bar;
    __device__ __forceinline__ explicit Params(const KArgs& k) {
        x = k.x; w_in = k.w_in; conv_w = k.conv_w; a_log = k.a_log; dt_bias = k.dt_bias; norm_g = k.norm_g; w_pa = k.w_pa; w_pb = k.w_pb;
        w_out = k.w_out; ln1_g = k.ln1_g; ln1_b = k.ln1_b; w_router = k.w_router; router_bias = k.router_bias; w_su = k.w_su; w_sd = k.w_sd;
        w_eu = k.w_eu; w_ed = k.w_ed; ln2_g = k.ln2_g; ln2_b = k.ln2_b; out = k.out;
        __attribute__((address_space(1))) unsigned char* wg = (__attribute__((address_space(1))) unsigned char*)k.ws; asm volatile("" : "+s"(wg));
        unsigned char* w = (unsigned char*)wg;
        xb = (bf16_t*)(w + OFF_XB); w_in_t = (bf16_t*)(w + OFF_WINT); qkvraw = (bf16_t*)(w + OFF_QKVRAW); dzb = (bf16_t*)(w + OFF_DZB);
        sq = (bf16_t*)(w + OFF_SQ); sk = (bf16_t*)(w + OFF_SK); vT = (bf16_t*)(w + OFF_VT); dnblob = (bf16_t*)(w + OFF_DNBLOB);
        dnu = (float*)(w + OFF_DNU); dnlast = (float*)(w + OFF_DNLAST); gab = (bf16_t*)(w + OFF_GAB); gbb = (bf16_t*)(w + OFF_GBB);
        small = (float*)(w + OFF_SMALL); w_pa_t = (bf16_t*)(w + OFF_WPAT); w_pb_t = (bf16_t*)(w + OFF_WPBT); w_out_t = (bf16_t*)(w + OFF_WOUTT);
        w_router_t = (bf16_t*)(w + OFF_WROUTT); w_su_t = (bf16_t*)(w + OFF_WSUT); w_sd_t = (bf16_t*)(w + OFF_WSDT);
        oab = (bf16_t*)(w + OFF_OAB); obb = (bf16_t*)(w + OFF_OBB); mergedb = (bf16_t*)(w + OFF_MERGED); hb = (bf16_t*)(w + OFF_HB);
        actsh = (bf16_t*)(w + OFF_ACTSH); ypairb = (bf16_t*)(w + OFF_YPAIRB); oraw = (float*)(w + OFF_ORAW); pre1 = (float*)(w + OFF_PRE1);
        h = (float*)(w + OFF_H); scores = (float*)(w + OFF_SCORES); gate = (float*)(w + OFF_GATE); ysh = (float*)(w + OFF_YSH); yshb = (bf16_t*)(w + OFF_YSH);
        idx = (int*)(w + OFF_IDX); counts = (int*)(w + OFF_COUNTS); explist = (int*)(w + OFF_EXPLIST); bar = (unsigned*)(w + OFF_BAR); w_eu_t = (bf16_t*)(w + OFF_WEUT); m1 = (float*)(w + OFF_M1);
    }
};

__device__ __forceinline__ float sigmoidf_(float v) { return __builtin_amdgcn_rcpf(1.f + __builtin_amdgcn_exp2f(-1.44269504088896f * v)); }
__device__ __forceinline__ float siluf_(float v) { return v * sigmoidf_(v); }
__device__ __forceinline__ float shfl_lane(float v, int src) { return __int_as_float(__builtin_amdgcn_ds_bpermute(src << 2, __float_as_int(v))); }
__device__ __forceinline__ int shfl_lane_i(int v, int src) { return __builtin_amdgcn_ds_bpermute(src << 2, v); }
__device__ __forceinline__ float wave_sum(float v, int lane) {
#pragma unroll
    for (int o = 32; o > 0; o >>= 1) v += shfl_lane(v, lane ^ o);
    return v;
}


#define XB_TMO      128
#define XB_XCNT(j)  (256  + 64 * (j))
#define XB_XSUB(j)  (1280 + 64 * (j))
#define XB_XGEN(j)  (2304 + 64 * (j))
#define XB_TOP      3328
#define XB_TOPGEN   3392
#define XB_SPIN_CAP (1u << 24)
#define LAS3 __attribute__((address_space(3)))
__device__ __forceinline__ unsigned xb_ld(unsigned* p)              { return __hip_atomic_load(p, __ATOMIC_RELAXED, __HIP_MEMORY_SCOPE_AGENT); }
__device__ __forceinline__ unsigned xb_add(unsigned* p, unsigned v) { return __hip_atomic_fetch_add(p, v, __ATOMIC_RELAXED, __HIP_MEMORY_SCOPE_AGENT); }
__device__ __forceinline__ unsigned xb_xcc_id() { return (unsigned)__builtin_amdgcn_s_getreg((3 << 11) | 20) & 0xFu; }
#define XB_SPIN(cond, bar) do { unsigned _sp = 0; while (cond) { __builtin_amdgcn_s_sleep(1); \
    if ((++_sp & 255u) == 0u) { if (xb_ld(&(bar)[XB_TMO])) break; if (_sp > XB_SPIN_CAP) { atomicAdd(&(bar)[XB_TMO], 1u); break; } } } } while (0)
constexpr int WIDTAB_OFF = 133120 + 2 * 256 * 4 + 16;
__device__ __forceinline__ unsigned hw_wave_slot() { return (unsigned)__builtin_amdgcn_s_getreg((5 << 11) | 4) & 63u; }
__device__ __forceinline__ int opaque_tid() {
    const int w = __builtin_amdgcn_readfirstlane(*(const volatile LAS3 int*)(unsigned long)(WIDTAB_OFF + 4 * hw_wave_slot()));
    int t = w * 64 + (int)__builtin_amdgcn_mbcnt_hi(~0u, __builtin_amdgcn_mbcnt_lo(~0u, 0u));
    asm volatile("" : "+v"(t)); return t;
}
struct XcdBarrier { unsigned* bar; unsigned x; volatile LAS3 unsigned* st; };
__device__ __forceinline__ XcdBarrier xcd_barrier_post(unsigned* bar, volatile LAS3 unsigned* st) {
    XcdBarrier b; b.bar = bar; b.x = xb_xcc_id(); b.st = st;
    if (threadIdx.x == 0) st[2] = xb_add(&bar[XB_XCNT(b.x)], 1u);
    return b;
}
__device__ __forceinline__ void xcd_barrier_complete(unsigned* bar, unsigned x, unsigned& nloc, unsigned& nx, int& vbx) {
    const unsigned G = gridDim.x * gridDim.y * gridDim.z;
    unsigned sum, cnt, mine, sp = 0u, xlow = 0u; bool uni = true;
    asm volatile("" : "+s"(x));
    for (;;) {
        sum = 0u; cnt = 0u; mine = 0u;
        xlow = 0u; uni = true; unsigned first = 0u;
#pragma unroll 1
        for (unsigned j = 0; j < 16; ++j) { const unsigned c = xb_ld(&bar[XB_XCNT(j)]); sum += c; cnt += (c > 0u) ? 1u : 0u; mine = (j == x) ? c : mine;
            xlow += (c > 0u && j < x) ? 1u : 0u; if (c) { if (first == 0u) first = c; else if (c != first) uni = false; } }
        if (sum == G) break;
        __builtin_amdgcn_s_sleep(1);
        if ((++sp & 255u) == 0u) { if (xb_ld(&bar[XB_TMO])) break; if (sp > XB_SPIN_CAP) { atomicAdd(&bar[XB_TMO], 1u); break; } }
    }
    nloc = mine > 0u ? mine : 1u; nx = cnt > 0u ? cnt : 1u;
    vbx = (uni && cnt == 8u && mine * 8u == G) ? (int)xlow : -1;
}
__device__ __forceinline__ void xcd_barrier(const XcdBarrier& b) {
    asm volatile("s_waitcnt vmcnt(0)" ::: "memory");
    __syncthreads();
    if (opaque_tid() == 0) {
        unsigned* bar = b.bar;
        __builtin_amdgcn_s_waitcnt(0);
        unsigned nloc = b.st[0], nx = b.st[1];
        if (nloc == 0u) { int vbx; xcd_barrier_complete(bar, b.x, nloc, nx, vbx); b.st[0] = nloc; b.st[1] = nx; if (vbx >= 0) b.st[3] = b.st[2] * 8u + (unsigned)vbx; }
        const unsigned old = xb_add(&bar[XB_XSUB(b.x)], 1u);
        const unsigned gen = old / nloc;
        if (old + 1u == (gen + 1u) * nloc) {
            __builtin_amdgcn_fence(__ATOMIC_RELEASE, "agent");
            asm volatile("s_waitcnt vmcnt(0)" ::: "memory");
            const unsigned og = xb_add(&bar[XB_TOP], 1u);
            const unsigned tg = og / nx;
            if (og + 1u == (tg + 1u) * nx) xb_add(&bar[XB_TOPGEN], 1u);
            else XB_SPIN(xb_ld(&bar[XB_TOPGEN]) == tg, bar);
            __builtin_amdgcn_fence(__ATOMIC_ACQUIRE, "agent");
            xb_add(&bar[XB_XGEN(b.x)], 1u);
            asm volatile("s_waitcnt vmcnt(0)" ::: "memory");
        } else {
            XB_SPIN(xb_ld(&bar[XB_XGEN(b.x)]) == gen, bar);
            __builtin_amdgcn_fence(__ATOMIC_ACQUIRE, "agent");
            asm volatile("s_waitcnt vmcnt(0)" ::: "memory");
        }
    }
    __syncthreads();
}

constexpr int VB_LDS_OFF = 133120 + 2 * 256 * 4 + 12;
__device__ __forceinline__ int vblock() { return *(const volatile LAS3 int*)(unsigned long)(VB_LDS_OFF); }
typedef short bf16x8 __attribute__((ext_vector_type(8)));
typedef float f32x16 __attribute__((ext_vector_type(16)));
typedef float f32x4 __attribute__((ext_vector_type(4)));
__device__ __forceinline__ unsigned pk_bf16(float a, float b) {
    typedef __bf16 bf2 __attribute__((ext_vector_type(2)));
    typedef float f2 __attribute__((ext_vector_type(2)));
    f2 v = {a, b};
    bf2 r = __builtin_convertvector(v, bf2);
    return __builtin_bit_cast(unsigned, r);
}
__device__ __forceinline__ bf16_t to_bf16(float a) { return (bf16_t)(pk_bf16(a, 0.f) & 0xffffu); }
__device__ __forceinline__ float bf2f(bf16_t v) { return __uint_as_float((unsigned)v << 16); }

__device__ __forceinline__ int opaque_bid() { int b = *(const volatile LAS3 int*)(unsigned long)(WIDTAB_OFF + 256); asm volatile("" : "+v"(b)); return b; }
constexpr int LROW = 128;
__device__ __forceinline__ int swz(int r) { return ((r >> 2) & 7) ^ ((r >> 1) & 1); }

template <int ROWS, bool MAYBE_NULL = false> struct LoadRowsBf16 {
    static constexpr int NCH = ROWS * 8 / NT;
    const bf16_t* base; int tid;
    unsigned off[NCH];
    typedef unsigned u32x4r __attribute__((ext_vector_type(4)));
    u32x4r regs[NCH];
    template <class RF> __device__ __forceinline__ void init(const bf16_t* base_, int ld, RF rowfn) {
        base = base_; tid = opaque_tid();
#pragma unroll
        for (int i = 0; i < NCH; ++i) {
            const int c = tid + i * NT, r = c >> 3, ch = c & 7;
            const long long src = rowfn(r);
            off[i] = (!MAYBE_NULL || src >= 0) ? (unsigned)(src * ld + ch * 8) : 0xffffffffu;
        }
    }
    __device__ __forceinline__ void load(int k0) {
#pragma unroll
        for (int i = 0; i < NCH; ++i)
            regs[i] = (!MAYBE_NULL || off[i] != 0xffffffffu) ? *(const u32x4r*)(base + (size_t)off[i] + k0) : (u32x4r){0u, 0u, 0u, 0u};
    }
    __device__ __forceinline__ void store(unsigned char* lds) const {
#pragma unroll
        for (int i = 0; i < NCH; ++i) {
            const int c = tid + i * NT, r = c >> 3, ch = c & 7;
            *(u32x4r*)(lds + r * LROW + ((ch ^ swz(r)) << 4)) = regs[i];
        }
    }
};

__device__ __forceinline__ int pi16(int x) { return (x & ~12) | ((x & 4) << 1) | ((x & 8) >> 1); }
namespace pg8 {
#define PG8_LAS __attribute__((address_space(3)))
typedef unsigned short bf16_t;
typedef short bf16x8 __attribute__((ext_vector_type(8)));
typedef float f32x4 __attribute__((ext_vector_type(4)));
typedef unsigned u32x4 __attribute__((ext_vector_type(4)));
constexpr int BM = 256, BK = 64, HALF = 128, HTB = HALF * BK * 2  , STAGE_BYTES = 8 * HTB, NXCD = 8, WGM = 8;

__host__ __device__ __forceinline__ int lds_byte(int r, int c) { const int st = (r >> 4) * 2 + (c >> 5), rr = r & 15, cc = c & 31, ob = rr * 64 + cc * 2; return st * 1024 + (ob ^ (((ob >> 9) & 1) << 5)); }
__host__ __device__ __forceinline__ void stage_rc(int b, int& R, int& C) { const int st = b / 1024, sb = b % 1024, swz = sb ^ (((sb >> 9) & 1) << 5); R = (st >> 1) * 16 + swz / 64; C = (st & 1) * 32 + (swz % 64) / 2; }
__host__ __device__ __forceinline__ int perm32(int rho) { const int n = rho >> 4, i = rho & 15; return 8 * (i >> 2) + 4 * n + (i & 3); }

struct Unit { int pm, pn; };
struct Gemm { const bf16_t* A; const bf16_t* Bt; int M, N, K; };

struct StaticOrder {
    int nM, nN, nwg, G, c;
    __host__ __device__ void init(int M, int N, int G_, int c_) { nM = M / BM; nN = N / BM; nwg = nM * nN; G = G_; c = c_; }
    __host__ __device__ bool next(int i, Unit& u) const {
        const long L = (long)i * G + c; if (L >= nwg) return false;
        int wgid = (int)L; { const int q = nwg / NXCD, r = nwg % NXCD, xcd = wgid % NXCD, off = wgid / NXCD; wgid = (xcd < r ? xcd * (q + 1) : r * (q + 1) + (xcd - r) * q) + off; }
        const int nig = WGM * nN, gid = wgid / nig, fm = gid * WGM, gsz = (nM - fm) < WGM ? (nM - fm) : WGM;
        u.pm = fm + ((wgid % nig) % gsz); u.pn = (wgid % nig) / gsz; return true;
    }
    __device__ __forceinline__ void a_ready(const Unit&) const {}
    __device__ __forceinline__ void done(const Unit&) const {}
};


__device__ __forceinline__ unsigned cvt_pk_bf16(float lo, float hi) { unsigned r; asm volatile("v_cvt_pk_bf16_f32 %0, %1, %2" : "=v"(r) : "v"(lo), "v"(hi)); return r; }

template <class Epi, class Sched, bool ALIGN_EPI = false, bool SP2 = false>
__device__ __forceinline__ void gemm_phase(PG8_LAS unsigned char* lds, const Gemm g, const Sched& S, const Epi& E) {
    const int tid = opaque_tid(), wid = __builtin_amdgcn_readfirstlane(tid >> 6), lane = tid & 63, wr = wid >> 2, wc = wid & 3, fr = lane & 15, fq = lane >> 4;
    const int K = g.K, nt = K / BK;
    unsigned voffA[2], voffB[2];
#pragma unroll
    for (int i = 0; i < 2; ++i) { int R, C; stage_rc(tid * 16 + i * 8192, R, C); const int Rb = Epi::PERM ? ((R & ~31) + perm32(R & 31)) : R;
        voffA[i] = (unsigned)(R * K + C) * 2u; voffB[i] = (unsigned)(Rb * K + C) * 2u; }
    const size_t rstep64 = (size_t)64 * K * 2;
    const size_t kstep = (size_t)(BK * 2);
    const size_t hstep = (size_t)HALF * K * 2;
    const size_t tstep = 2 * hstep;
    const unsigned ldsw = (unsigned)wid * 1024u;
    const int aoff = lds_byte(wr * 64 + fr, fq * 8), boff = lds_byte(wc * 32 + fr, fq * 8);
#define PG8_SA(b, h) (((b) * 2 + (h)) * HTB)
#define PG8_SB(b, h) ((4 + (b) * 2 + (h)) * HTB)
#define PG8_STAGE(bufoff, gbase, voff) do { _Pragma("unroll") for (int _i = 0; _i < 2; ++_i) \
        __builtin_amdgcn_global_load_lds((const unsigned*)((const char*)(gbase) + (size_t)_i * rstep64 + (voff)[0]), (PG8_LAS unsigned*)(lds + (bufoff) + ldsw + _i * 8192), 16, 0, 0); } while (0)
#define PG8_LDA(dst, b, h) do { _Pragma("unroll") for (int m = 0; m < 4; ++m) _Pragma("unroll") for (int k = 0; k < 2; ++k) dst[m][k] = *(const PG8_LAS bf16x8*)(lds + PG8_SA(b, h) + aoff + m * 2048 + k * 1024); } while (0)
#define PG8_LDB(dst, b, h) do { _Pragma("unroll") for (int n = 0; n < 2; ++n) _Pragma("unroll") for (int k = 0; k < 2; ++k) dst[n][k] = *(const PG8_LAS bf16x8*)(lds + PG8_SB(b, h) + boff + n * 2048 + k * 1024); } while (0)
#define PG8_MMA(ai, bj, At, Bt) do { __builtin_amdgcn_s_setprio(1); _Pragma("unroll") for (int m = 0; m < 4; ++m) _Pragma("unroll") for (int n = 0; n < 2; ++n) _Pragma("unroll") for (int k = 0; k < 2; ++k) \
        acc[ai][bj][m][n] = __builtin_amdgcn_mfma_f32_16x16x32_bf16(Bt[n][k], At[m][k], acc[ai][bj][m][n], 0, 0, 0); __builtin_amdgcn_s_setprio(0); } while (0)
#define PG8_WAIT_V(n) asm volatile("s_waitcnt vmcnt(" #n ")" ::: "memory")
#define PG8_WAIT_L(n) asm volatile("s_waitcnt lgkmcnt(" #n ")" ::: "memory")
#define PG8_BAR __builtin_amdgcn_s_barrier()
#define PG8_SCHED __builtin_amdgcn_sched_barrier(0)
    Unit cur, nxt; int ui = 0;
    if (!S.next(0, cur)) return;
    f32x4 acc[2][2][4][2];
#pragma unroll
    for (int a = 0; a < 2; ++a)
#pragma unroll
        for (int b = 0; b < 2; ++b)
#pragma unroll
            for (int m = 0; m < 4; ++m)
#pragma unroll
                for (int n = 0; n < 2; ++n) acc[a][b][m][n] = (f32x4){0.f, 0.f, 0.f, 0.f};
    bf16x8 At[4][2], B0[2][2], B1[2][2];
    const char* cA = (const char*)g.A + (size_t)cur.pm * tstep; const char* cB = (const char*)g.Bt + (size_t)cur.pn * tstep;
    S.a_ready(cur);
    if constexpr (SP2) {
        PG8_STAGE(PG8_SB(0, 0), cB, voffB); PG8_STAGE(PG8_SB(0, 1), cB + hstep, voffB); PG8_STAGE(PG8_SA(0, 0), cA, voffA); PG8_STAGE(PG8_SA(0, 1), cA + hstep, voffA);
        if (wr == 1) PG8_BAR;
        PG8_WAIT_V(2); PG8_BAR;
        PG8_STAGE(PG8_SB(1, 0), cB + kstep, voffB); PG8_STAGE(PG8_SA(1, 0), cA + kstep, voffA); PG8_STAGE(PG8_SB(1, 1), cB + hstep + kstep, voffB);
        PG8_WAIT_V(6); PG8_BAR;
    } else {
        PG8_STAGE(PG8_SB(0, 0), cB, voffB); PG8_STAGE(PG8_SA(0, 0), cA, voffA); PG8_STAGE(PG8_SB(0, 1), cB + hstep, voffB); PG8_STAGE(PG8_SA(0, 1), cA + hstep, voffA);
        if (wr == 1) PG8_BAR;
        PG8_WAIT_V(4); PG8_BAR;
        PG8_STAGE(PG8_SB(1, 0), cB + kstep, voffB); PG8_STAGE(PG8_SA(1, 0), cA + kstep, voffA); PG8_STAGE(PG8_SB(1, 1), cB + hstep + kstep, voffB);
        PG8_WAIT_V(6); PG8_BAR;
    }
    for (;;) {
        const bool has_next = S.next(ui + 1, nxt);
        const char* nA = has_next ? (const char*)g.A + (size_t)nxt.pm * tstep : cA; const char* nB = has_next ? (const char*)g.Bt + (size_t)nxt.pn * tstep : cB;
        for (int t = 0; t < nt; t += 2) {
            const bool last = (t == nt - 2);
            const char* a1 = cA + (size_t)(t + 1) * kstep;
            const char* a2 = last ? nA : cA + (size_t)(t + 2) * kstep; const char* b2 = last ? nB : cB + (size_t)(t + 2) * kstep;
            const char* a3 = a2 + kstep; const char* b3 = b2 + kstep;
            if (last && has_next) S.a_ready(nxt);
            if constexpr (SP2) {
            PG8_LDB(B0, 0, 0); PG8_LDB(B1, 0, 1); PG8_SCHED; PG8_LDA(At, 0, 0); PG8_STAGE(PG8_SA(1, 1), a1 + hstep, voffA);
            PG8_WAIT_V(8); PG8_WAIT_L(0); PG8_BAR; PG8_MMA(0, 0, At, B0); PG8_MMA(0, 1, At, B1); PG8_BAR; PG8_SCHED;
            PG8_LDA(At, 0, 1); PG8_STAGE(PG8_SB(0, 0), b2, voffB); PG8_STAGE(PG8_SB(0, 1), b2 + hstep, voffB); PG8_STAGE(PG8_SA(0, 0), a2, voffA);
            PG8_WAIT_V(8); PG8_WAIT_L(0); PG8_BAR; PG8_MMA(1, 0, At, B0); PG8_MMA(1, 1, At, B1); PG8_BAR; PG8_SCHED;
            PG8_LDB(B0, 1, 0); PG8_LDB(B1, 1, 1); PG8_SCHED; PG8_LDA(At, 1, 0); PG8_STAGE(PG8_SA(0, 1), a2 + hstep, voffA);
            PG8_WAIT_V(8); PG8_WAIT_L(0); PG8_BAR; PG8_MMA(0, 0, At, B0); PG8_MMA(0, 1, At, B1); PG8_BAR; PG8_SCHED;
            PG8_LDA(At, 1, 1); PG8_STAGE(PG8_SB(1, 0), b3, voffB); PG8_STAGE(PG8_SB(1, 1), b3 + hstep, voffB); PG8_STAGE(PG8_SA(1, 0), a3, voffA);
            PG8_WAIT_V(8); PG8_WAIT_L(0); PG8_BAR; PG8_MMA(1, 0, At, B0); PG8_MMA(1, 1, At, B1); PG8_BAR; PG8_SCHED;
            } else {
            PG8_LDB(B0, 0, 0); PG8_SCHED; PG8_LDA(At, 0, 0); PG8_STAGE(PG8_SA(1, 1), a1 + hstep, voffA);
            PG8_WAIT_L(8); PG8_BAR; PG8_WAIT_L(0); PG8_MMA(0, 0, At, B0); PG8_BAR; PG8_SCHED;
            PG8_LDB(B1, 0, 1); PG8_STAGE(PG8_SB(0, 0), b2, voffB);
            PG8_BAR; PG8_WAIT_L(0); PG8_MMA(0, 1, At, B1); PG8_BAR;
            PG8_LDA(At, 0, 1); PG8_STAGE(PG8_SA(0, 0), a2, voffA);
            PG8_BAR; PG8_WAIT_L(0); PG8_MMA(1, 0, At, B0); PG8_BAR; PG8_SCHED;
            PG8_STAGE(PG8_SB(0, 1), b2 + hstep, voffB);
            PG8_WAIT_V(6); PG8_BAR; PG8_MMA(1, 1, At, B1); PG8_BAR;
            PG8_LDB(B0, 1, 0); PG8_SCHED; PG8_LDA(At, 1, 0); PG8_STAGE(PG8_SA(0, 1), a2 + hstep, voffA);
            PG8_WAIT_L(8); PG8_BAR; PG8_WAIT_L(0); PG8_MMA(0, 0, At, B0); PG8_BAR; PG8_SCHED;
            PG8_LDB(B1, 1, 1); PG8_STAGE(PG8_SB(1, 0), b3, voffB);
            PG8_BAR; PG8_WAIT_L(0); PG8_MMA(0, 1, At, B1); PG8_BAR;
            PG8_LDA(At, 1, 1); PG8_STAGE(PG8_SA(1, 0), a3, voffA);
            PG8_BAR; PG8_WAIT_L(0); PG8_MMA(1, 0, At, B0); PG8_BAR; PG8_SCHED;
            PG8_STAGE(PG8_SB(1, 1), b3 + hstep, voffB);
            PG8_WAIT_V(6); PG8_BAR; PG8_MMA(1, 1, At, B1); PG8_BAR;
            }
        }
        if constexpr (ALIGN_EPI) { if (wr == 0) PG8_BAR; }
        if constexpr (!Epi::AFTER_DRAIN) { E(acc, cur, wr, wc, fr, fq); S.done(cur); }
        if (!has_next) break;
#pragma unroll
        for (int a = 0; a < 2; ++a)
#pragma unroll
            for (int b = 0; b < 2; ++b)
#pragma unroll
                for (int m = 0; m < 4; ++m)
#pragma unroll
                    for (int n = 0; n < 2; ++n) acc[a][b][m][n] = (f32x4){0.f, 0.f, 0.f, 0.f};
        cur = nxt; cA = nA; cB = nB; ++ui;
        if constexpr (ALIGN_EPI) { if (wr == 1) PG8_BAR; }
    }
    PG8_WAIT_V(0);
    if constexpr (!ALIGN_EPI) { if (wr == 0) PG8_BAR; }
    PG8_BAR;
    if constexpr (Epi::AFTER_DRAIN) { E.fused(acc, cur, wr, wc, fr, fq, lds, wid, lane); S.done(cur); }
#undef PG8_SA
#undef PG8_SB
#undef PG8_STAGE
#undef PG8_LDA
#undef PG8_LDB
#undef PG8_MMA
#undef PG8_WAIT_V
#undef PG8_WAIT_L
#undef PG8_BAR
#undef PG8_SCHED
}
}

struct EpiInproj {
    static constexpr bool PERM = true, AFTER_DRAIN = false;
    bf16_t *qkvraw, *dzb, *sq, *sk, *vT, *gab, *gbb; float* small;
    __device__ __forceinline__ void operator()(const pg8::f32x4 (&acc)[2][2][4][2], const pg8::Unit& u, int wr, int wc, int fr, int fq) const {
        const int pn = u.pn, row0 = u.pm * 256 + wr * 64 + fr;
        if (pn == 12 || pn == 13) {
#pragma unroll
            for (int ai = 0; ai < 2; ++ai)
#pragma unroll
                for (int m = 0; m < 4; ++m) {
                    const int tok = row0 + ai * 128 + m * 16, bb = tok >> 11, key = tok & (SEQ - 1), pos = (key & ~15) | pi16(key & 15);
#pragma unroll
                    for (int bj = 0; bj < 2; ++bj)
#pragma unroll
                        for (int n = 0; n < 2; ++n)
#pragma unroll
                            for (int j = 0; j < 4; ++j) {
                                const int svcol = (pn - 12) * 256 + bj * 128 + wc * 32 + fq * 8 + n * 4 + j;
                                vT[((size_t)((bb * 8 + (svcol >> 6)) * 64 + (svcol & 63))) * SEQ + pos] = to_bf16(acc[ai][bj][m][n][j]);
                            }
                }
        } else if (pn == 22) {
            if (wc == 0 && fq == 0) {
#pragma unroll
                for (int ai = 0; ai < 2; ++ai)
#pragma unroll
                    for (int m = 0; m < 4; ++m) {
                        pg8::f32x4* d = (pg8::f32x4*)(small + (size_t)(row0 + ai * 128 + m * 16) * 8);
                        d[0] = acc[ai][0][m][0]; d[1] = acc[ai][0][m][1];
                    }
            }
        } else {
            bf16_t* dst; int ld, c0; float sc = 1.f; bool gate = false;
            if (pn < 6) { dst = qkvraw; ld = 1536; c0 = pn * 256; }
            else if (pn < 8) { dst = dzb; ld = 512; c0 = (pn - 6) * 256; }
            else if (pn < 10) { dst = sq; ld = 512; c0 = (pn - 8) * 256; sc = 0.125f * 1.4426950408889634f; }
            else if (pn < 12) { dst = sk; ld = 512; c0 = (pn - 10) * 256; }
            else if (pn < 18) { dst = gab; ld = 1024; c0 = (pn - 14) * 256; gate = true; }
            else { dst = gbb; ld = 1024; c0 = (pn - 18) * 256; gate = true; }
#pragma unroll
            for (int ai = 0; ai < 2; ++ai)
#pragma unroll
                for (int m = 0; m < 4; ++m) {
                    bf16_t* rowp = dst + (size_t)(row0 + ai * 128 + m * 16) * ld + c0 + wc * 32 + fq * 8;
#pragma unroll
                    for (int bj = 0; bj < 2; ++bj) {
                        pg8::f32x4 v0 = acc[ai][bj][m][0] * sc, v1 = acc[ai][bj][m][1] * sc;
                        if (gate) {
#pragma unroll
                            for (int j = 0; j < 4; ++j) { v0[j] = sigmoidf_(v0[j]); v1[j] = sigmoidf_(v1[j]); }
                        }
                        pg8::u32x4 w; w.x = pk_bf16(v0[0], v0[1]); w.y = pk_bf16(v0[2], v0[3]); w.z = pk_bf16(v1[0], v1[1]); w.w = pk_bf16(v1[2], v1[3]);
                        *(pg8::u32x4*)(rowp + bj * 128) = w;
                    }
                }
        }
    }
};
template <class F> struct EpiF4 {
    static constexpr bool PERM = false, AFTER_DRAIN = false;
    F f;
    __device__ __forceinline__ void operator()(const pg8::f32x4 (&acc)[2][2][4][2], const pg8::Unit& u, int wr, int wc, int fr, int fq) const {
#pragma unroll
        for (int ai = 0; ai < 2; ++ai)
#pragma unroll
            for (int m = 0; m < 4; ++m) {
                const int row = u.pm * 256 + ai * 128 + wr * 64 + m * 16 + fr;
#pragma unroll
                for (int bj = 0; bj < 2; ++bj)
#pragma unroll
                    for (int n = 0; n < 2; ++n) f(row, u.pn * 256 + bj * 128 + wc * 32 + n * 16 + fq * 4, acc[ai][bj][m][n]);
            }
    }
};
template <class F> __device__ __forceinline__ void run_pg8(const bf16_t* A, const bf16_t* Bt, int M, int N, int K, unsigned char* lds, F f) {
    pg8::Gemm g{A, Bt, M, N, K};
    pg8::StaticOrder S; S.init(M, N, gridDim.x, vblock());
    EpiF4<F> E{f};
    pg8::gemm_phase<EpiF4<F>, pg8::StaticOrder, true, true>((PG8_LAS unsigned char*)lds, g, S, E);
}
__device__ __forceinline__ void unpack4(uint2 w, float (&g)[4]) {
    g[0] = __uint_as_float(w.x << 16); g[1] = __uint_as_float(w.x & 0xffff0000u); g[2] = __uint_as_float(w.y << 16); g[3] = __uint_as_float(w.y & 0xffff0000u);
}

struct LoadKNF32 {
    const float* base; int ld, kq, nq;
    f32x4 regs[8];
    template <class CF> __device__ __forceinline__ void init(const float* w, int ld_, CF colfn) {
        const int tid = opaque_tid(); kq = tid >> 6; nq = tid & 63; ld = ld_;
        base = w + (size_t)(kq * 8) * ld_ + colfn(nq * 4);
    }
    __device__ __forceinline__ void load(int k0) {
#pragma unroll
        for (int j = 0; j < 8; ++j) regs[j] = *(const f32x4*)(base + (size_t)(k0 + j) * ld);
    }
    __device__ __forceinline__ void store1(unsigned char* lds, int nn, float a0, float a1, float a2, float a3, float a4, float a5, float a6, float a7) const {
        uint4 o; o.x = pk_bf16(a0, a1); o.y = pk_bf16(a2, a3); o.z = pk_bf16(a4, a5); o.w = pk_bf16(a6, a7);
        const int row = nq * 4 + nn;
        *(uint4*)(lds + row * LROW + ((kq ^ swz(row)) << 4)) = o;
    }
    __device__ __forceinline__ void store(unsigned char* lds) const {
        store1(lds, 0, regs[0].x, regs[1].x, regs[2].x, regs[3].x, regs[4].x, regs[5].x, regs[6].x, regs[7].x);
        store1(lds, 1, regs[0].y, regs[1].y, regs[2].y, regs[3].y, regs[4].y, regs[5].y, regs[6].y, regs[7].y);
        store1(lds, 2, regs[0].z, regs[1].z, regs[2].z, regs[3].z, regs[4].z, regs[5].z, regs[6].z, regs[7].z);
        store1(lds, 3, regs[0].w, regs[1].w, regs[2].w, regs[3].w, regs[4].w, regs[5].w, regs[6].w, regs[7].w);
    }
};

template <int BM_, int BN_, int WM_, int WN_> struct GemmCfg {
    static constexpr int BM = BM_, BN = BN_, WM = WM_, WN = WN_;
    static constexpr int TM = BM / WM, TN = BN / WN, MI = TM / 32, NI = TN / 32;
    static constexpr int A_BYTES = BM * LROW, B_BYTES = BN * LROW, STAGE = A_BYTES + B_BYTES;
    static_assert(WM * WN == 8, "8 waves");
};

template <class CFG, class AL, class BL>
__device__ __forceinline__ void gemm_mainloop(AL& al, BL& bl, int nk, f32x16 (&acc)[CFG::MI][CFG::NI], unsigned char* lds) {
    constexpr int MI = CFG::MI, NI = CFG::NI;
    const int tid = opaque_tid(), lane = tid & 63, wid = tid >> 6;
    const int wm = wid / CFG::WN, wn = wid % CFG::WN;
    const int l31 = lane & 31, lh = lane >> 5;
    al.load(0); bl.load(0);
    const int a_off = (wm * CFG::TM + l31) * LROW;
    const int b_off = CFG::A_BYTES + (wn * CFG::TN + l31) * LROW;
    const int fsw = swz(l31);
    for (int kt = 0; kt < nk; ++kt) {
        unsigned char* st = lds + (kt & 1) * CFG::STAGE;
        al.store(st); bl.store(st + CFG::A_BYTES);
        __syncthreads();
        if (kt + 1 < nk) { al.load((kt + 1) * 64); bl.load((kt + 1) * 64); }
#pragma unroll
        for (int kk = 0; kk < 4; ++kk) {
            bf16x8 a[MI], b[NI];
#pragma unroll
            for (int mi = 0; mi < MI; ++mi) a[mi] = *(const bf16x8*)(st + a_off + mi * 32 * LROW + (((kk * 2 + lh) ^ fsw) << 4));
#pragma unroll
            for (int ni = 0; ni < NI; ++ni) b[ni] = *(const bf16x8*)(st + b_off + ni * 32 * LROW + (((kk * 2 + lh) ^ fsw) << 4));
#pragma unroll
            for (int mi = 0; mi < MI; ++mi)
#pragma unroll
                for (int ni = 0; ni < NI; ++ni)
                    acc[mi][ni] = __builtin_amdgcn_mfma_f32_32x32x16_bf16(a[mi], b[ni], acc[mi][ni], 0, 0, 0);
        }
    }
    __syncthreads();
}
template <class CFG, bool A_RES, int ARES_ROT, bool TRANS, class AL, class BL>
__device__ __forceinline__ void gemm_mainloop2(AL (&al)[2], BL (&bl)[2], int nk, f32x16 (&acc)[CFG::MI][CFG::NI], unsigned char* stages, const unsigned char* ares) {
    constexpr int MI = CFG::MI, NI = CFG::NI;
    constexpr int STG = A_RES ? CFG::B_BYTES : CFG::STAGE, BOFF = A_RES ? 0 : CFG::A_BYTES;
    const int tid = opaque_tid(), lane = tid & 63, wid = tid >> 6;
    const int wm = wid / CFG::WN, wn = wid % CFG::WN;
    const int l31 = lane & 31, lh = lane >> 5;
    if (!A_RES) { al[0].load(0); } bl[0].load(0);
    if (!A_RES) { al[1].load(64); } bl[1].load(64);
    const int a_off = (wm * CFG::TM + l31) * LROW;
    const int b_off = BOFF + (wn * CFG::TN + l31) * LROW;
    const int fsw = swz(l31);
    for (int kt = 0; kt < nk; kt += 2) {
#pragma unroll
        for (int u = 0; u < 2; ++u) {
            unsigned char* st = stages + u * STG;
            if (!A_RES) al[u].store(st);
            bl[u].store(st + BOFF);
            __syncthreads();
            if (kt + u + 2 < nk) { if (!A_RES) al[u].load((kt + u + 2) * 64); bl[u].load((kt + u + 2) * 64); }
            const unsigned char* ab = A_RES ? ares + (size_t)((kt + u + ARES_ROT) & 3) * (CFG::BM * LROW) : st;
#pragma unroll
            for (int kk = 0; kk < 4; ++kk) {
                bf16x8 a[MI], b[NI];
#pragma unroll
                for (int mi = 0; mi < MI; ++mi) a[mi] = *(const bf16x8*)(ab + a_off + mi * 32 * LROW + (((kk * 2 + lh) ^ fsw) << 4));
#pragma unroll
                for (int ni = 0; ni < NI; ++ni) b[ni] = *(const bf16x8*)(st + b_off + ni * 32 * LROW + (((kk * 2 + lh) ^ fsw) << 4));
#pragma unroll
                for (int mi = 0; mi < MI; ++mi)
#pragma unroll
                    for (int ni = 0; ni < NI; ++ni)
                        acc[mi][ni] = TRANS ? __builtin_amdgcn_mfma_f32_32x32x16_bf16(b[ni], a[mi], acc[mi][ni], 0, 0, 0)
                                            : __builtin_amdgcn_mfma_f32_32x32x16_bf16(a[mi], b[ni], acc[mi][ni], 0, 0, 0);
            }
        }
    }
    __syncthreads();
}
template <int ROWS, int NSET> struct LoadRowsBf16N {
    static constexpr int NCH = ROWS * 8 / NT;
    typedef unsigned u32x4r __attribute__((ext_vector_type(4)));
    const bf16_t* base; int tid;
    unsigned off[NCH];
    u32x4r regs[NSET][NCH];
    template <class RF> __device__ __forceinline__ void init(const bf16_t* base_, int ld, RF rowfn) {
        base = base_; tid = opaque_tid();
#pragma unroll
        for (int i = 0; i < NCH; ++i) { const int c = tid + i * NT, r = c >> 3, ch = c & 7; off[i] = (unsigned)(rowfn(r) * ld + ch * 8); }
    }
    template <int U> __device__ __forceinline__ void load(int k0) {
#pragma unroll
        for (int i = 0; i < NCH; ++i) regs[U][i] = *(const u32x4r*)(base + (size_t)off[i] + k0);
    }
    template <int U> __device__ __forceinline__ void store(unsigned char* lds) const {
#pragma unroll
        for (int i = 0; i < NCH; ++i) { const int c = tid + i * NT, r = c >> 3, ch = c & 7; *(u32x4r*)(lds + r * LROW + ((ch ^ swz(r)) << 4)) = regs[U][i]; }
    }
};
template <int NSET> struct LoadKNF32N {
    const float* base; int ld, kq, nq;
    f32x4 regs[NSET][8];
    template <class CF> __device__ __forceinline__ void init(const float* w, int ld_, CF colfn) {
        const int tid = opaque_tid(); kq = tid >> 6; nq = tid & 63; ld = ld_;
        base = w + (size_t)(kq * 8) * ld_ + colfn(nq * 4);
    }
    template <int U> __device__ __forceinline__ void load(int k0) {
#pragma unroll
        for (int j = 0; j < 8; ++j) regs[U][j] = *(const f32x4*)(base + (size_t)(k0 + j) * ld);
    }
    template <int U> __device__ __forceinline__ void store(unsigned char* lds) const {
#pragma unroll
        for (int nn = 0; nn < 4; ++nn) {
            uint4 o; o.x = pk_bf16(regs[U][0][nn], regs[U][1][nn]); o.y = pk_bf16(regs[U][2][nn], regs[U][3][nn]);
            o.z = pk_bf16(regs[U][4][nn], regs[U][5][nn]); o.w = pk_bf16(regs[U][6][nn], regs[U][7][nn]);
            const int row = nq * 4 + nn;
            *(uint4*)(lds + row * LROW + ((kq ^ swz(row)) << 4)) = o;
        }
    }
};
template <class CFG, bool TRANS, int U, class AL, class BL>
__device__ __forceinline__ void d3_step(AL& al, BL& bl, int t, int nk, f32x16 (&acc)[CFG::MI][CFG::NI], unsigned char* stages, int a_off, int b_off, int fsw, int lh) {
    constexpr int MI = CFG::MI, NI = CFG::NI, UN = (U + 1) % 3;
    if (t < nk) {
        unsigned char* st = stages + (t & 1) * CFG::STAGE;
        unsigned char* nx = stages + ((t + 1) & 1) * CFG::STAGE;
#pragma unroll
        for (int kk = 0; kk < 4; ++kk) {
            if (kk == 2 && t + 1 < nk) {
                al.template store<UN>(nx); bl.template store<UN>(nx + CFG::A_BYTES);
                if (t + 4 < nk) { al.template load<UN>((t + 4) * 64); bl.template load<UN>((t + 4) * 64); }
            }
            bf16x8 a[MI], b[NI];
#pragma unroll
            for (int mi = 0; mi < MI; ++mi) a[mi] = *(const bf16x8*)(st + a_off + mi * 32 * LROW + (((kk * 2 + lh) ^ fsw) << 4));
#pragma unroll
            for (int ni = 0; ni < NI; ++ni) b[ni] = *(const bf16x8*)(st + b_off + ni * 32 * LROW + (((kk * 2 + lh) ^ fsw) << 4));
#pragma unroll
            for (int mi = 0; mi < MI; ++mi)
#pragma unroll
                for (int ni = 0; ni < NI; ++ni)
                    acc[mi][ni] = TRANS ? __builtin_amdgcn_mfma_f32_32x32x16_bf16(b[ni], a[mi], acc[mi][ni], 0, 0, 0)
                                        : __builtin_amdgcn_mfma_f32_32x32x16_bf16(a[mi], b[ni], acc[mi][ni], 0, 0, 0);
        }
        __syncthreads();
    }
}
template <class CFG, bool TRANS, class AL, class BL>
__device__ __forceinline__ void gemm_mainloop_d3(AL& al, BL& bl, int nk, f32x16 (&acc)[CFG::MI][CFG::NI], unsigned char* stages) {
    const int tid = opaque_tid(), lane = tid & 63, wid = tid >> 6;
    const int wm = wid / CFG::WN, wn = wid % CFG::WN;
    const int l31 = lane & 31, lh = lane >> 5;
    al.template load<0>(0); bl.template load<0>(0);
    al.template load<1>(64); bl.template load<1>(64);
    al.template load<2>(128); bl.template load<2>(128);
    const int a_off = (wm * CFG::TM + l31) * LROW;
    const int b_off = CFG::A_BYTES + (wn * CFG::TN + l31) * LROW;
    const int fsw = swz(l31);
    al.template store<0>(stages); bl.template store<0>(stages + CFG::A_BYTES);
    __syncthreads();
    if (3 < nk) { al.template load<0>(192); bl.template load<0>(192); }
    for (int kt = 0; kt < nk; kt += 3) {
        d3_step<CFG, TRANS, 0>(al, bl, kt, nk, acc, stages, a_off, b_off, fsw, lh);
        d3_step<CFG, TRANS, 1>(al, bl, kt + 1, nk, acc, stages, a_off, b_off, fsw, lh);
        d3_step<CFG, TRANS, 2>(al, bl, kt + 2, nk, acc, stages, a_off, b_off, fsw, lh);
    }
}
template <class CFG> __device__ __forceinline__ void acc_zero(f32x16 (&acc)[CFG::MI][CFG::NI]) {
#pragma unroll
    for (int mi = 0; mi < CFG::MI; ++mi)
#pragma unroll
        for (int ni = 0; ni < CFG::NI; ++ni)
#pragma unroll
            for (int r = 0; r < 16; ++r) acc[mi][ni][r] = 0.f;
}
template <class CFG, class F> __device__ __forceinline__ void acc_foreach(f32x16 (&acc)[CFG::MI][CFG::NI], F f) {
    const int tid = opaque_tid(), lane = tid & 63, wid = tid >> 6;
    const int wm = wid / CFG::WN, wn = wid % CFG::WN;
#pragma unroll
    for (int mi = 0; mi < CFG::MI; ++mi)
#pragma unroll
        for (int ni = 0; ni < CFG::NI; ++ni) {
            asm volatile("" ::: "memory");
#pragma unroll
            for (int r = 0; r < 16; ++r)
                acc[mi][ni][r] = f(wm * CFG::TM + mi * 32 + (r & 3) + 8 * (r >> 2) + 4 * (lane >> 5), wn * CFG::TN + ni * 32 + (lane & 31), acc[mi][ni][r], mi, ni, r);
        }
}

struct TileMap {
    int ntm, ntn, npm, npn, rounds; bool patched;
    int pm, pn;
    __device__ __forceinline__ void init(int ntm_, int ntn_) {
        ntm = ntm_; ntn = ntn_; patched = (gridDim.x == 256);
        pn = ntn >= 8 ? 8 : ntn >= 4 ? 4 : ntn >= 2 ? 2 : 1; pm = 32 / pn;
        if (patched) { npm = (ntm + pm - 1) / pm; npn = (ntn + pn - 1) / pn; rounds = (npm * npn + 7) / 8; }
        else { int G = gridDim.x; asm volatile("" : "+s"(G)); npm = npn = 0; rounds = (ntm * ntn + G - 1) / G; }
    }
    __device__ __forceinline__ bool get(int round, int& tm, int& tn) const {
        const int b = vblock();
        if (patched) {
            const int patch = round * 8 + (b & 7), slot = b >> 3;
            if (patch >= npm * npn) return false;
            tm = (patch / npn) * pm + slot / pn; tn = (patch % npn) * pn + slot % pn;
            return tm < ntm && tn < ntn;
        }
        const int t = round * gridDim.x + b;
        if (t >= ntm * ntn) return false;
        tm = t / ntn; tn = t % ntn; return true;
    }
};

template <class CM>
__device__ __forceinline__ void transpose_convert(const float* W, int K, int N, int NP, bf16_t* Wt, float* sm, int& shift, CM cmap) {
    const int tid = opaque_tid(), ntk = K / 64, ntn = NP / 64, G = gridDim.x, nt = ntk * ntn;
    int tile = (opaque_bid() + G - shift % G) % G;
    shift += nt;
    float v[8];
#define TC_LOAD(TILE) do { const int tk_ = (TILE) % ntk, tn_ = (TILE) / ntk; \
        _Pragma("unroll") for (int i = 0; i < 8; ++i) { const int e = tid + i * NT, kk = e >> 6, nn = e & 63, col = cmap(tn_ * 64 + nn); \
            v[i] = col >= 0 ? W[(size_t)(tk_ * 64 + kk) * N + col] : 0.f; } } while (0)
    if (tile < nt) TC_LOAD(tile);
    for (; tile < nt; tile += G) {
        const int tk = tile % ntk, tn = tile / ntk;
#pragma unroll
        for (int i = 0; i < 8; ++i) { const int e = tid + i * NT, kk = e >> 6, nn = e & 63; sm[nn * 65 + kk] = v[i]; }
        __syncthreads();
        if (tile + G < nt) TC_LOAD(tile + G);
        const int n = tid >> 3, kc = tid & 7;
        const float* r = sm + n * 65 + kc * 8;
        uint4 o; o.x = pk_bf16(r[0], r[1]); o.y = pk_bf16(r[2], r[3]); o.z = pk_bf16(r[4], r[5]); o.w = pk_bf16(r[6], r[7]);
        *(uint4*)(Wt + (size_t)(tn * 64 + n) * K + tk * 64 + kc * 8) = o;
        __syncthreads();
    }
#undef TC_LOAD
}
__device__ __forceinline__ void transpose_tile_f4(const float* W, int K, int N, bf16_t* Wt, int k0, int n0, float* sm) {
    const int tid = opaque_tid(), kk = tid >> 4, n4 = tid & 15;
#pragma unroll
    for (int h = 0; h < 2; ++h) {
        const int k = kk + 32 * h;
        const f32x4 v = *(const f32x4*)(W + (size_t)(k0 + k) * N + n0 + n4 * 4);
#pragma unroll
        for (int j = 0; j < 4; ++j) sm[(n4 * 4 + j) * 65 + k] = v[j];
    }
    __syncthreads();
    const int n = tid >> 3, kc = tid & 7;
    const float* r = sm + n * 65 + kc * 8;
    uint4 o; o.x = pk_bf16(r[0], r[1]); o.y = pk_bf16(r[2], r[3]); o.z = pk_bf16(r[4], r[5]); o.w = pk_bf16(r[6], r[7]);
    *(uint4*)(Wt + (size_t)(n0 + n) * K + k0 + kc * 8) = o;
    __syncthreads();
}
__device__ __forceinline__ void convert_bf16(const float* src, bf16_t* dst, size_t n) {
    const size_t gtid = (size_t)opaque_bid() * NT + opaque_tid(), gsz = (size_t)gridDim.x * NT;
    for (size_t i = gtid; i < n / 8; i += gsz) {
        const float4 a = ((const float4*)src)[2 * i], b = ((const float4*)src)[2 * i + 1];
        uint4 o; o.x = pk_bf16(a.x, a.y); o.y = pk_bf16(a.z, a.w); o.z = pk_bf16(b.x, b.y); o.w = pk_bf16(b.z, b.w);
        ((uint4*)dst)[i] = o;
    }
}

__device__ __forceinline__ void phase_inproj(const Params& p, unsigned char* lds) {
    pg8::Gemm g{p.xb, p.w_in_t, T, PWP, D};
    pg8::StaticOrder S; S.init(T, PWP, gridDim.x, vblock());
    EpiInproj E{p.qkvraw, p.dzb, p.sq, p.sk, p.vT, p.gab, p.gbb, p.small};
    pg8::gemm_phase<EpiInproj, pg8::StaticOrder, true, true>((PG8_LAS unsigned char*)lds, g, S, E);
}

__device__ __forceinline__ void load_gate16(const bf16_t* gbuf, int rb, int cb, int lane, float (&g)[16]) {
    const uint4* src = (const uint4*)(gbuf + ((size_t)(rb * 32 + cb) * 64 + lane) * 16);
    const uint4 a = src[0], b = src[1];
    const unsigned u[8] = {a.x, a.y, a.z, a.w, b.x, b.y, b.z, b.w};
#pragma unroll
    for (int i = 0; i < 8; ++i) { g[2 * i] = __uint_as_float(u[i] << 16); g[2 * i + 1] = __uint_as_float(u[i] & 0xffff0000u); }
}
__device__ __forceinline__ void phase_merge(const Params& p, unsigned char* lds) {
    run_pg8(p.oab, p.w_pa_t, T, D, DNW, lds, [&](int row, int col, pg8::f32x4 v) {
        float g[4]; unpack4(*(const uint2*)(p.gab + (size_t)row * D + col), g);
        *(pg8::f32x4*)(p.m1 + (size_t)row * D + col) = (pg8::f32x4){v[0] * g[0], v[1] * g[1], v[2] * g[2], v[3] * g[3]};
    });
    run_pg8(p.obb, p.w_pb_t, T, D, SBW, lds, [&](int row, int col, pg8::f32x4 v) {
        float g[4]; unpack4(*(const uint2*)(p.gbb + (size_t)row * D + col), g);
        const pg8::f32x4 m = *(const pg8::f32x4*)(p.m1 + (size_t)row * D + col);
        uint2 w; w.x = pk_bf16(m[0] + v[0] * g[0], m[1] + v[1] * g[1]); w.y = pk_bf16(m[2] + v[2] * g[2], m[3] + v[3] * g[3]);
        *(uint2*)(p.mergedb + (size_t)row * D + col) = w;
    });
}

__device__ __forceinline__ void phase_outproj(const Params& p, unsigned char* lds) {
    run_pg8(p.mergedb, p.w_out_t, T, D, D, lds, [&](int row, int col, pg8::f32x4 v) {
        const size_t o = (size_t)row * D + col;
        const pg8::f32x4 x = *(const pg8::f32x4*)(p.x + o);
        *(pg8::f32x4*)(p.pre1 + o) = v + x * ALPHA;
    });
}

struct EpiRouterSU {
    static constexpr bool PERM = false, AFTER_DRAIN = false;
    float* scores; bf16_t* actsh;
    __device__ __forceinline__ void operator()(const pg8::f32x4 (&acc)[2][2][4][2], const pg8::Unit& u, int wr, int wc, int fr, int fq) const {
#pragma unroll
        for (int ai = 0; ai < 2; ++ai)
#pragma unroll
            for (int m = 0; m < 4; ++m) {
                const int row = u.pm * 256 + ai * 128 + wr * 64 + m * 16 + fr;
                if (u.pn == 0) {
#pragma unroll
                    for (int bj = 0; bj < 2; ++bj)
#pragma unroll
                        for (int n = 0; n < 2; ++n) {
                            const pg8::f32x4 v = acc[ai][bj][m][n];
                            *(pg8::f32x4*)(scores + (size_t)row * NE + bj * 128 + wc * 32 + n * 16 + fq * 4) =
                                (pg8::f32x4){sigmoidf_(v[0]), sigmoidf_(v[1]), sigmoidf_(v[2]), sigmoidf_(v[3])};
                        }
                } else {
#pragma unroll
                    for (int n = 0; n < 2; ++n) {
                        const pg8::f32x4 g = acc[ai][0][m][n], up = acc[ai][1][m][n];
                        uint2 w; w.x = pk_bf16(siluf_(g[0]) * up[0], siluf_(g[1]) * up[1]); w.y = pk_bf16(siluf_(g[2]) * up[2], siluf_(g[3]) * up[3]);
                        *(uint2*)(actsh + (size_t)row * SFF + (u.pn - 1) * 128 + wc * 32 + n * 16 + fq * 4) = w;
                    }
                }
            }
    }
};
__device__ __forceinline__ void phase_router_shared_up(const Params& p, unsigned char* lds) {
    static_assert(OFF_WSUT == OFF_WROUTT + (size_t)NE * D * 2, "router and shared-up transposed weights are contiguous");
    pg8::Gemm g{p.hb, p.w_router_t, T, NE + 2 * SFF, D};
    pg8::StaticOrder S; S.init(T, NE + 2 * SFF, gridDim.x, vblock());
    EpiRouterSU E{p.scores, p.actsh};
    pg8::gemm_phase<EpiRouterSU, pg8::StaticOrder, true, true>((PG8_LAS unsigned char*)lds, g, S, E);
}

__device__ __forceinline__ void phase_shared_down(const Params& p, unsigned char* lds) {
    run_pg8(p.actsh, p.w_sd_t, T, D, SFF, lds, [&](int row, int col, pg8::f32x4 v) {
        uint2 w; w.x = pk_bf16(v[0], v[1]); w.y = pk_bf16(v[2], v[3]);
        *(uint2*)(p.yshb + (size_t)row * D + col) = w;
    });
}

__device__ __forceinline__ void phase_init(const Params& p) {
    const int gtid = opaque_bid() * NT + opaque_tid(), gsz = gridDim.x * NT;
    for (int i = gtid; i < 2 * NE * CSTRIDE; i += gsz) p.counts[i] = 0;
}

__device__ __forceinline__ void sb_attn_wave(const Params& p, int bh, int qt) {
    const int lane = opaque_tid() & 63, l31 = lane & 31, lh = lane >> 5;
    const int b = bh >> 3, hh = bh & 7;
    bf16x8 qf[4];
    {
        const bf16_t* qrow = p.sq + (size_t)(b * SEQ + qt * 32 + l31) * SBW + hh * 64 + lh * 8;
#pragma unroll
        for (int ks = 0; ks < 4; ++ks) qf[ks] = *(const bf16x8*)(qrow + ks * 16);
    }
    f32x16 o0, o1;
#pragma unroll
    for (int r = 0; r < 16; ++r) { o0[r] = 0.f; o1[r] = 0.f; }
    float run = 0.f;
    const bf16_t* vbase = p.vT + ((size_t)(bh * 64 + l31)) * SEQ + lh * 8;
    for (int kt = qt; kt >= 0; --kt) {
        const bf16_t* krow = p.sk + (size_t)(b * SEQ + kt * 32 + l31) * SBW + hh * 64 + lh * 8;
        bf16x8 kf[4];
#pragma unroll
        for (int ks = 0; ks < 4; ++ks) kf[ks] = *(const bf16x8*)(krow + ks * 16);
        bf16x8 vf[2][2];
#pragma unroll
        for (int md = 0; md < 2; ++md)
#pragma unroll
            for (int ss = 0; ss < 2; ++ss) vf[md][ss] = *(const bf16x8*)(vbase + (size_t)md * 32 * SEQ + kt * 32 + ss * 16);
        f32x16 sc;
#pragma unroll
        for (int r = 0; r < 16; ++r) sc[r] = 0.f;
#pragma unroll
        for (int ks = 0; ks < 4; ++ks) sc = __builtin_amdgcn_mfma_f32_32x32x16_bf16(kf[ks], qf[ks], sc, 0, 0, 0);
        float lb[16], lr[16];
        const bool diag = (kt == qt);
#pragma unroll
        for (int r = 0; r < 16; ++r) {
            const float z = sc[r];
            const float l = __builtin_amdgcn_logf(1.f + __builtin_amdgcn_exp2f(-fabsf(z)));
            float b_ = fminf(z, 0.f) - l, r_ = b_ - z;
            if (diag) { const bool valid = ((r & 3) + 8 * (r >> 2) + 4 * lh) < l31; r_ = valid ? r_ : 0.f; b_ = valid ? b_ : -INFINITY; }
            lb[r] = b_; lr[r] = r_;
        }
        float ex[16], B[4];
#pragma unroll
        for (int g = 0; g < 4; ++g) {
            ex[4 * g + 3] = 0.f;
            ex[4 * g + 2] = lr[4 * g + 3];
            ex[4 * g + 1] = ex[4 * g + 2] + lr[4 * g + 2];
            ex[4 * g + 0] = ex[4 * g + 1] + lr[4 * g + 1];
            B[g] = ex[4 * g + 0] + lr[4 * g + 0];
        }
        float P[4];
#pragma unroll
        for (int g = 0; g < 4; ++g) P[g] = shfl_lane(B[g], lane ^ 32);
        float off[4];
        {
            const float p3 = P[3], p2 = P[2] + p3, p1 = P[1] + p2, p0 = P[0] + p1;
            const float b3 = 0.f, b2 = B[3], b1 = B[2] + b2, b0 = B[1] + b1;
            off[0] = b0 + (lh ? p1 : p0);
            off[1] = b1 + (lh ? p2 : p1);
            off[2] = b2 + (lh ? p3 : p2);
            off[3] = b3 + (lh ? 0.f : p3);
            const float total = (B[0] + b0) + p0;
#pragma unroll
            for (int g = 0; g < 4; ++g) off[g] += run;
            run += total;
        }
        float a[16];
#pragma unroll
        for (int r = 0; r < 16; ++r) a[r] = __builtin_amdgcn_exp2f(lb[r] + ex[r] + off[r >> 2]);
        bf16x8 pf[2];
#pragma unroll
        for (int ss = 0; ss < 2; ++ss) {
            typedef unsigned u32x4 __attribute__((ext_vector_type(4)));
            u32x4 w;
            w[0] = pk_bf16(a[8 * ss + 0], a[8 * ss + 1]); w[1] = pk_bf16(a[8 * ss + 2], a[8 * ss + 3]);
            w[2] = pk_bf16(a[8 * ss + 4], a[8 * ss + 5]); w[3] = pk_bf16(a[8 * ss + 6], a[8 * ss + 7]);
            pf[ss] = __builtin_bit_cast(bf16x8, w);
        }
#pragma unroll
        for (int ss = 0; ss < 2; ++ss) {
            o0 = __builtin_amdgcn_mfma_f32_32x32x16_bf16(vf[0][ss], pf[ss], o0, 0, 0, 0);
            o1 = __builtin_amdgcn_mfma_f32_32x32x16_bf16(vf[1][ss], pf[ss], o1, 0, 0, 0);
        }
        if (__all(run < -160.f)) break;
    }
    bf16_t* orow = p.obb + (size_t)(b * SEQ + qt * 32 + l31) * SBW + hh * 64 + 4 * lh;
#pragma unroll
    for (int g = 0; g < 4; ++g) {
        uint2 w0, w1;
        w0.x = pk_bf16(o0[4 * g], o0[4 * g + 1]); w0.y = pk_bf16(o0[4 * g + 2], o0[4 * g + 3]);
        w1.x = pk_bf16(o1[4 * g], o1[4 * g + 1]); w1.y = pk_bf16(o1[4 * g + 2], o1[4 * g + 3]);
        *(uint2*)(orow + 8 * g) = w0;
        *(uint2*)(orow + 32 + 8 * g) = w1;
    }
}


constexpr int DN_RW = 0, DN_RQ = 128, DN_RAT = 256, DN_RKD = 320;
constexpr float LOG2E = 1.4426950408889634f;
__device__ __forceinline__ uint4 pack8(const float* v) { uint4 o; o.x = pk_bf16(v[0], v[1]); o.y = pk_bf16(v[2], v[3]); o.z = pk_bf16(v[4], v[5]); o.w = pk_bf16(v[6], v[7]); return o; }

__device__ __forceinline__ void dn_chunk_item(const Params& p, int item, unsigned char* lds) {
    const int tid = opaque_tid(), lane = tid & 63, wid = tid >> 6;
    const int bh = item >> 5, n = item & 31, b = bh >> 2, hh = bh & 3;
    const int t0 = b * SEQ + n * 64;
    unsigned char* Kimg = lds; unsigned char* KBimg = lds + 16384; unsigned char* Qimg = lds + 32768;
    float* Vf = (float*)(lds + 49152); float* KBGf = (float*)(lds + 81920); float* MT = (float*)(lds + 114688);
    float* G2s = (float*)(lds + 114688 + 17408); float* betas = G2s + 64;
    bf16_t* blob = p.dnblob + (size_t)item * DN_BLOB;
    if (wid == 0) {
        const int t = t0 + lane;
        const float da = p.small[(size_t)t * 8 + 4 + hh] + p.dt_bias[hh];
        const float sp = da > 20.f ? da : log1pf(expf(da));
        float g2 = -expf(p.a_log[hh]) * sp * LOG2E;
#pragma unroll
        for (int off = 1; off < 64; off <<= 1) { const float v = shfl_lane(g2, lane - off); if (lane >= off) g2 += v; }
        G2s[lane] = g2; betas[lane] = sigmoidf_(p.small[(size_t)t * 8 + hh]);
        if (lane == 63) p.dnlast[item] = exp2f(g2);
    }
    __syncthreads();
    {
        const int c8 = tid & 15, tq = tid >> 4, j0 = tq * 2;
        const float G0 = G2s[j0], G1 = G2s[j0 + 1], GL = G2s[63];
        const float be[2] = {betas[j0], betas[j0 + 1]};
        const float eg[2] = {exp2f(G0), exp2f(G1)}, el[2] = {exp2f(GL - G0), exp2f(GL - G1)};
        const int half = c8 >> 3, ch = c8 & 7;
#pragma unroll
        for (int type = 0; type < 3; ++type) {
            float o[2][8];
            {
                const bf16_t* src = p.qkvraw + (size_t)(t0 + j0 - 3) * 1536 + type * 512 + hh * 128 + c8 * 8;
                float x[5][8];
#pragma unroll
                for (int r = 0; r < 5; ++r) {
                    uint4 raw = make_uint4(0, 0, 0, 0);
                    if (n > 0 || j0 - 3 + r >= 0) raw = *(const uint4*)(src + (size_t)r * 1536);
                    const unsigned u[4] = {raw.x, raw.y, raw.z, raw.w};
#pragma unroll
                    for (int i = 0; i < 4; ++i) { x[r][2 * i] = __uint_as_float(u[i] << 16); x[r][2 * i + 1] = __uint_as_float(u[i] & 0xffff0000u); }
                }
                const float* wp = p.conv_w + type * 512 + hh * 128 + c8 * 8;
#pragma unroll
                for (int i = 0; i < 8; ++i) {
                    float a0 = 0.f, a1 = 0.f;
#pragma unroll
                    for (int tap = 0; tap < 4; ++tap) { const float w = wp[tap * 1536 + i]; a0 = fmaf(x[tap][i], w, a0); a1 = fmaf(x[tap + 1][i], w, a1); }
                    o[0][i] = siluf_(a0); o[1][i] = siluf_(a1);
                }
            }
            if (type < 2) {
#pragma unroll
                for (int tk = 0; tk < 2; ++tk) {
                    float ss = 0.f;
#pragma unroll
                    for (int i = 0; i < 8; ++i) ss = fmaf(o[tk][i], o[tk][i], ss);
                    ss += shfl_lane(ss, lane ^ 1); ss += shfl_lane(ss, lane ^ 2); ss += shfl_lane(ss, lane ^ 4); ss += shfl_lane(ss, lane ^ 8);
                    float r = rsqrtf(ss + NORM_EPS);
                    if (type == 0) r *= 0.08838834764831845f;
#pragma unroll
                    for (int i = 0; i < 8; ++i) o[tk][i] *= r;
                }
            }
#pragma unroll
            for (int tk = 0; tk < 2; ++tk) {
                const int j = j0 + tk;
                const int ioff = half * 8192 + j * 128 + ((ch ^ swz(j)) << 4);
                if (type == 0) {
                    *(uint4*)(Qimg + ioff) = pack8(o[tk]);
                    float qd[8];
#pragma unroll
                    for (int i = 0; i < 8; ++i) qd[i] = o[tk][i] * eg[tk];
                    bf16_t* qrow = blob + (size_t)(DN_RQ + half * 64 + j) * 64 + ((c8 >> 1) & 3) * 16 + 4 * (c8 & 1);
                    uint2 w0, w1; w0.x = pk_bf16(qd[0], qd[1]); w0.y = pk_bf16(qd[2], qd[3]); w1.x = pk_bf16(qd[4], qd[5]); w1.y = pk_bf16(qd[6], qd[7]);
                    *(uint2*)qrow = w0; *(uint2*)(qrow + 8) = w1;
                } else if (type == 1) {
                    float kb[8], kbg[8];
#pragma unroll
                    for (int i = 0; i < 8; ++i) { kb[i] = o[tk][i] * be[tk]; kbg[i] = kb[i] * eg[tk]; }
                    *(uint4*)(Kimg + ioff) = pack8(o[tk]);
                    *(uint4*)(KBimg + ioff) = pack8(kb);
                    f32x4* kd = (f32x4*)(KBGf + j * 128 + c8 * 8); kd[0] = (f32x4){kbg[0], kbg[1], kbg[2], kbg[3]}; kd[1] = (f32x4){kbg[4], kbg[5], kbg[6], kbg[7]};
                } else {
                    float vb[8];
#pragma unroll
                    for (int i = 0; i < 8; ++i) vb[i] = o[tk][i] * be[tk];
                    f32x4* vd = (f32x4*)(Vf + j * 128 + c8 * 8); vd[0] = (f32x4){vb[0], vb[1], vb[2], vb[3]}; vd[1] = (f32x4){vb[4], vb[5], vb[6], vb[7]};
                }
            }
            if (type == 1) {
                const int jp = (j0 & 48) | pi16(j0 & 15);
#pragma unroll
                for (int i = 0; i < 8; ++i)
                    *(unsigned*)(blob + (size_t)(DN_RKD + c8 * 8 + i) * 64 + jp) = pk_bf16(o[0][i] * el[0], o[1][i] * el[1]);
            }
        }
    }
    __syncthreads();
    {
        const int which = wid >> 2, ti = (wid >> 1) & 1, tj = wid & 1, l31 = lane & 31, lh = lane >> 5;
        if (!(ti == 0 && tj == 1)) {
            const unsigned char* Ab = (which == 0 ? KBimg : Qimg) + (ti * 32 + l31) * 128;
            const unsigned char* Bb = Kimg + (tj * 32 + l31) * 128;
            const int fsw = swz(l31);
            f32x16 acc;
#pragma unroll
            for (int r = 0; r < 16; ++r) acc[r] = 0.f;
#pragma unroll
            for (int ks = 0; ks < 8; ++ks) {
                const int off = (ks >> 2) * 8192 + ((((ks & 3) * 2 + lh) ^ fsw) << 4);
                acc = __builtin_amdgcn_mfma_f32_32x32x16_bf16(*(const bf16x8*)(Ab + off), *(const bf16x8*)(Bb + off), acc, 0, 0, 0);
            }
            const int j = tj * 32 + l31;
            const float Gj = G2s[j];
#pragma unroll
            for (int r = 0; r < 16; ++r) {
                const int i = ti * 32 + (r & 3) + 8 * (r >> 2) + 4 * lh;
                const float v = acc[r] * exp2f(G2s[i] - Gj);
                if (which == 0) MT[j * 68 + i] = (i > j) ? v : 0.f;
                else blob[(size_t)(DN_RAT + i) * 64 + ((j & 48) | pi16(j & 15))] = to_bf16((i >= j) ? v : 0.f);
            }
        }
    }
    __syncthreads();
#ifndef NO_SOLVE
    if (tid < 256) {
        const int c = tid & 127;
        const float* rhs = (tid < 128 ? Vf : KBGf) + c;
        typedef float f32x2 __attribute__((ext_vector_type(2)));
        f32x2 y2[32];
#pragma unroll
        for (int j = 0; j < 32; ++j) y2[j] = (f32x2){rhs[(2 * j) * 128], rhs[(2 * j + 1) * 128]};
#pragma unroll
        for (int j = 0; j < 63; ++j) {
            const float yj = y2[j >> 1][j & 1];
            const f32x2 nyj = {-yj, -yj};
#pragma unroll
            for (int i4 = (j + 1) & ~3; i4 < 64; i4 += 4) {
                const f32x4 m = *(const f32x4*)(MT + j * 68 + i4);
                y2[i4 >> 1] = __builtin_elementwise_fma((f32x2){m[0], m[1]}, nyj, y2[i4 >> 1]);
                y2[(i4 >> 1) + 1] = __builtin_elementwise_fma((f32x2){m[2], m[3]}, nyj, y2[(i4 >> 1) + 1]);
            }
            asm volatile("" ::: "memory");
        }
        float y[64];
#pragma unroll
        for (int j = 0; j < 32; ++j) { y[2 * j] = y2[j][0]; y[2 * j + 1] = y2[j][1]; }
        if (tid < 128) {
#pragma unroll
            for (int mi = 0; mi < 2; ++mi)
#pragma unroll
                for (int h = 0; h < 2; ++h) {
                    f32x4* dst = (f32x4*)(p.dnu + ((((size_t)item * 2 + mi) * 4 + (c >> 5)) * 64 + h * 32 + (c & 31)) * 16);
#pragma unroll
                    for (int g = 0; g < 4; ++g)
                        dst[g] = (f32x4){y[mi * 32 + 8 * g + 4 * h], y[mi * 32 + 8 * g + 4 * h + 1], y[mi * 32 + 8 * g + 4 * h + 2], y[mi * 32 + 8 * g + 4 * h + 3]};
                }
        } else {
            bf16_t* dst = blob + (size_t)(DN_RW + (c >> 6) * 64) * 64 + ((c & 48) | pi16(c & 15));
#pragma unroll
            for (int i = 0; i < 64; ++i) dst[(size_t)i * 64] = to_bf16(-y[i]);
        }
    }
#endif
    __syncthreads();
}

__device__ __forceinline__ void phase_dn_chunks(const Params& p, unsigned char* lds) {
    for (int item = blockIdx.x; item < NB * DNH * 32; item += gridDim.x) dn_chunk_item(p, item, lds);
}

__device__ __forceinline__ void dn_scan(const Params& p, int bh, unsigned char* lds) {
    const int tid = opaque_tid(), lane = tid & 63, wid = tid >> 6, l31 = lane & 31, lh = lane >> 5;
    const int b = bh >> 2, hh = bh & 3;
    const int fsw = swz(l31);
    if (wid >= 4) {
        const int lt = tid - 256;
        typedef unsigned u32x4v __attribute__((ext_vector_type(4)));
        const u32x4v* src = (const u32x4v*)(p.dnblob + (size_t)(bh * 32) * DN_BLOB) + lt;
        u32x4v lr[14];
#define DN_LOAD(n_) { _Pragma("unroll") for (int k = 0; k < 14; ++k) lr[k] = src[(size_t)(n_) * (DN_BLOB / 8) + k * 256]; }
#define DN_STORE(dst_) { _Pragma("unroll") for (int k = 0; k < 14; ++k) { const int c = lt + k * 256, row = c >> 3, ch = c & 7; \
            *(u32x4v*)((dst_) + row * 128 + ((ch ^ swz(row)) << 4)) = lr[k]; } }
        DN_LOAD(0); DN_STORE(lds); DN_LOAD(1);
        __builtin_amdgcn_s_waitcnt(0xc07f);
        __builtin_amdgcn_s_barrier();
        for (int n = 0; n < 32; ++n) {
            if (n + 1 < 32) { DN_STORE(lds + ((n + 1) & 1) * (DN_ROWS * 128)); if (n + 2 < 32) DN_LOAD(n + 2); }
            __builtin_amdgcn_s_waitcnt(0xc07f);
            __builtin_amdgcn_s_barrier();
        }
#undef DN_LOAD
#undef DN_STORE
        return;
    }
    __builtin_amdgcn_s_barrier();
    f32x16 S[4];
#pragma unroll
    for (int t = 0; t < 4; ++t)
#pragma unroll
        for (int r = 0; r < 16; ++r) S[t][r] = 0.f;
    typedef const __attribute__((address_space(1))) f32x16* gf16p;
    typedef __attribute__((address_space(1))) float* gfp;
    f32x16 vn[2];
#pragma unroll
    for (int mi = 0; mi < 2; ++mi) vn[mi] = *(gf16p)(unsigned long long)(p.dnu + ((((size_t)(bh * 32) * 2 + mi) * 4 + wid) * 64 + lane) * 16);
    const int lastv = __float_as_int(*(const __attribute__((address_space(1))) float*)(unsigned long long)(p.dnlast + bh * 32 + (lane & 31)));
    for (int n = 0; n < 32; ++n) {
        {
            const unsigned char* buf = lds + (n & 1) * (DN_ROWS * 128);
            const int item = bh * 32 + n;
            f32x16 oa[2];
#pragma unroll
            for (int mi = 0; mi < 2; ++mi)
#pragma unroll
                for (int r = 0; r < 16; ++r) oa[mi][r] = 0.f;
            const float last = __int_as_float(__builtin_amdgcn_readlane(lastv, n));
            typedef unsigned u32x4 __attribute__((ext_vector_type(4)));
            bf16x8 sb[4][2];
#pragma unroll
            for (int t = 0; t < 4; ++t)
#pragma unroll
                for (int ss = 0; ss < 2; ++ss) {
                    u32x4 w;
#pragma unroll
                    for (int q = 0; q < 4; ++q) w[q] = pk_bf16(S[t][8 * ss + 2 * q], S[t][8 * ss + 2 * q + 1]);
                    sb[t][ss] = __builtin_bit_cast(bf16x8, w);
                }
#pragma unroll
            for (int g = 0; g < 4; ++g) {
                bf16x8 fw[2][2], fq[2][2];
#pragma unroll
                for (int mi = 0; mi < 2; ++mi)
#pragma unroll
                    for (int kk = 0; kk < 2; ++kk) {
                        const int ks = 2 * g + kk;
                        const int off = ((ks >> 2) * 64 + mi * 32 + l31) * 128 + ((((ks & 3) * 2 + lh) ^ fsw) << 4);
                        fw[mi][kk] = *(const bf16x8*)(buf + DN_RW * 128 + off);
                        fq[mi][kk] = *(const bf16x8*)(buf + DN_RQ * 128 + off);
                    }
                __builtin_amdgcn_sched_barrier(0);
#pragma unroll
                for (int kk = 0; kk < 2; ++kk)
#pragma unroll
                    for (int mi = 0; mi < 2; ++mi) {
                        vn[mi] = __builtin_amdgcn_mfma_f32_32x32x16_bf16(fw[mi][kk], sb[g][kk], vn[mi], 0, 0, 0);
                        oa[mi] = __builtin_amdgcn_mfma_f32_32x32x16_bf16(sb[g][kk], fq[mi][kk], oa[mi], 0, 0, 0);
                    }
                __builtin_amdgcn_sched_barrier(0);
            }
            bf16x8 vb[2][2];
#pragma unroll
            for (int mj = 0; mj < 2; ++mj)
#pragma unroll
                for (int ss = 0; ss < 2; ++ss) {
                    u32x4 w;
#pragma unroll
                    for (int q = 0; q < 4; ++q) w[q] = pk_bf16(vn[mj][8 * ss + 2 * q], vn[mj][8 * ss + 2 * q + 1]);
                    vb[mj][ss] = __builtin_bit_cast(bf16x8, w);
                }
            {
                const int nx = (n + 1 < 32) ? item + 1 : item;
#pragma unroll
                for (int mi = 0; mi < 2; ++mi) vn[mi] = *(gf16p)(unsigned long long)(p.dnu + ((((size_t)nx * 2 + mi) * 4 + wid) * 64 + lane) * 16);
            }
#pragma unroll
            for (int t = 0; t < 4; ++t)
#pragma unroll
                for (int r = 0; r < 16; ++r) S[t][r] *= last;
            {
                bf16x8 fa[6];
#pragma unroll
                for (int i = 0; i < 6; ++i) {
                    const int mi = i < 2 ? 0 : 1, kj = i < 2 ? i : i - 2;
                    fa[i] = *(const bf16x8*)(buf + (DN_RAT + mi * 32 + l31) * 128 + (((kj * 2 + lh) ^ fsw) << 4));
                }
                __builtin_amdgcn_sched_barrier(0);
#pragma unroll
                for (int i = 0; i < 6; ++i) {
                    const int mi = i < 2 ? 0 : 1, kj = i < 2 ? i : i - 2;
                    oa[mi] = __builtin_amdgcn_mfma_f32_32x32x16_bf16(vb[kj >> 1][kj & 1], fa[i], oa[mi], 0, 0, 0);
                }
                __builtin_amdgcn_sched_barrier(0);
            }
#pragma unroll
            for (int tp = 0; tp < 2; ++tp) {
                bf16x8 fk[2][4];
#pragma unroll
                for (int tt = 0; tt < 2; ++tt)
#pragma unroll
                    for (int kj = 0; kj < 4; ++kj)
                        fk[tt][kj] = *(const bf16x8*)(buf + (DN_RKD + (2 * tp + tt) * 32 + l31) * 128 + (((kj * 2 + lh) ^ fsw) << 4));
                __builtin_amdgcn_sched_barrier(0);
#pragma unroll
                for (int kj = 0; kj < 4; ++kj)
#pragma unroll
                    for (int tt = 0; tt < 2; ++tt)
                        S[2 * tp + tt] = __builtin_amdgcn_mfma_f32_32x32x16_bf16(fk[tt][kj], vb[kj >> 1][kj & 1], S[2 * tp + tt], 0, 0, 0);
                __builtin_amdgcn_sched_barrier(0);
            }
            typedef __attribute__((address_space(1))) f32x4* gf4p;
#pragma unroll
            for (int mi = 0; mi < 2; ++mi) {
                float* orow = p.oraw + (size_t)(b * SEQ + n * 64 + mi * 32 + l31) * DNW + hh * 128 + wid * 32 + 4 * lh;
#pragma unroll
                for (int g4 = 0; g4 < 4; ++g4)
                    *(gf4p)(unsigned long long)(orow + 8 * g4) = (f32x4){oa[mi][4 * g4], oa[mi][4 * g4 + 1], oa[mi][4 * g4 + 2], oa[mi][4 * g4 + 3]};
            }
        }
        __builtin_amdgcn_s_waitcnt(0xc07f);
        __builtin_amdgcn_s_barrier();
    }
}

__device__ __forceinline__ void phase_mixers(const Params& p, float* smem) {
    const int nscan = NB * DNH;
    if (gridDim.x >= 2 * nscan) {
#ifndef SKIP_SCAN
#ifndef RSCAN
#define RSCAN 1
#define RATT 1
#endif
        if ((int)blockIdx.x < nscan) { int rs_ = RSCAN; asm volatile("" : "+s"(rs_)); for (int r_ = 0; r_ < rs_; ++r_) dn_scan(p, blockIdx.x, (unsigned char*)smem); }
#endif
        if ((int)blockIdx.x < nscan) {}
        else {
            int ra_ = RATT; asm volatile("" : "+s"(ra_));
            const int stride_ = gridDim.x - nscan; const bool flip_ok = (stride_ & 7) == 0;
            for (int r_ = 0; r_ < ra_; ++r_) {
                int rnd = 0;
                for (int it = blockIdx.x - nscan; it < 512; it += stride_, ++rnd) {
                    int g = it & 7; if (flip_ok && (rnd & 1)) g = 7 - g;
                    sb_attn_wave(p, it >> 3, g * 8 + (opaque_tid() >> 6));
                }
            }
        }
    } else {
#ifndef SKIP_SCAN
        for (int bh = blockIdx.x; bh < nscan; bh += gridDim.x) dn_scan(p, bh, (unsigned char*)smem);
#endif
        for (int it = blockIdx.x; it < 512; it += gridDim.x) sb_attn_wave(p, it >> 3, (it & 7) * 8 + (opaque_tid() >> 6));
    }
}

__device__ __forceinline__ void phase_gated_norm(const Params& p) {
    typedef unsigned u32x4r __attribute__((ext_vector_type(4)));
    const int lane = opaque_tid() & 63, wave = (opaque_bid() * NT + opaque_tid()) >> 6, nw = (gridDim.x * NT) >> 6;
    const int c0 = lane * 8, cg = (lane & 15) * 8;
    float gg[8];
    { const f32x4 g0 = *(const f32x4*)(p.norm_g + cg), g1 = *(const f32x4*)(p.norm_g + cg + 4);
#pragma unroll
      for (int i = 0; i < 4; ++i) { gg[i] = g0[i]; gg[4 + i] = g1[i]; } }
    for (int t0 = wave * 2; t0 < T; t0 += nw * 2) {
        f32x4 va[2], vb[2]; u32x4r z[2];
#pragma unroll
        for (int q = 0; q < 2; ++q) {
            const size_t off = (size_t)(t0 + q) * DNW + c0;
            va[q] = *(const f32x4*)(p.oraw + off); vb[q] = *(const f32x4*)(p.oraw + off + 4);
            z[q] = *(const u32x4r*)(p.dzb + off);
        }
#pragma unroll
        for (int q = 0; q < 2; ++q) {
            float v[8];
#pragma unroll
            for (int i = 0; i < 4; ++i) { v[i] = va[q][i]; v[4 + i] = vb[q][i]; }
            float ss = 0.f;
#pragma unroll
            for (int i = 0; i < 8; ++i) ss += v[i] * v[i];
            ss += shfl_lane(ss, lane ^ 1); ss += shfl_lane(ss, lane ^ 2); ss += shfl_lane(ss, lane ^ 4); ss += shfl_lane(ss, lane ^ 8);
            const float r = rsqrtf(ss * (1.f / 128.f) + NORM_EPS);
            u32x4r o;
#pragma unroll
            for (int i = 0; i < 4; ++i) {
                const float z0 = __uint_as_float(z[q][i] << 16), z1 = __uint_as_float(z[q][i] & 0xffff0000u);
                o[i] = pk_bf16(v[2 * i] * r * gg[2 * i] * siluf_(z0), v[2 * i + 1] * r * gg[2 * i + 1] * siluf_(z1));
            }
            *(u32x4r*)(p.oab + (size_t)(t0 + q) * DNW + c0) = o;
        }
    }
}

__device__ __forceinline__ void add_bf16x16(const bf16_t* src, float sc, float (&v)[16]) {
    typedef unsigned u32x4r __attribute__((ext_vector_type(4)));
    const u32x4r a = ((const u32x4r*)src)[0], b = ((const u32x4r*)src)[1];
#pragma unroll
    for (int i = 0; i < 4; ++i) {
        v[2 * i] += sc * __uint_as_float(a[i] << 16); v[2 * i + 1] += sc * __uint_as_float(a[i] & 0xffff0000u);
        v[8 + 2 * i] += sc * __uint_as_float(b[i] << 16); v[8 + 2 * i + 1] += sc * __uint_as_float(b[i] & 0xffff0000u);
    }
}
template <class SF>
__device__ __forceinline__ void layer_norm_rows(SF sf, const float* g, const float* bb, float* dst, bf16_t* dstb) {
    const int lane = opaque_tid() & 63, wave = (opaque_bid() * NT + opaque_tid()) >> 6, nw = (gridDim.x * NT) >> 6;
    const int c0 = lane * 16;
    float gg[16], be[16];
#pragma unroll
    for (int i = 0; i < 4; ++i) {
        const f32x4 x = *(const f32x4*)(g + c0 + 4 * i), y = *(const f32x4*)(bb + c0 + 4 * i);
#pragma unroll
        for (int j = 0; j < 4; ++j) { gg[4 * i + j] = x[j]; be[4 * i + j] = y[j]; }
    }
    for (int t = wave; t < T; t += nw) {
        float v[16];
        sf(t, c0, v);
        float s = 0.f;
#pragma unroll
        for (int i = 0; i < 16; ++i) s += v[i];
        const float mu = wave_sum(s, lane) * (1.f / 1024.f);
        float q = 0.f;
#pragma unroll
        for (int i = 0; i < 16; ++i) { const float d = v[i] - mu; q += d * d; }
        const float rstd = rsqrtf(wave_sum(q, lane) * (1.f / 1024.f) + LN_EPS);
        float y[16];
#pragma unroll
        for (int i = 0; i < 16; ++i) y[i] = (v[i] - mu) * rstd * gg[i] + be[i];
        if (dst) {
#pragma unroll
            for (int i = 0; i < 4; ++i) *(f32x4*)(dst + (size_t)t * D + c0 + 4 * i) = (f32x4){y[4 * i], y[4 * i + 1], y[4 * i + 2], y[4 * i + 3]};
        }
        if (dstb) {
            typedef unsigned u32x4r __attribute__((ext_vector_type(4)));
#pragma unroll
            for (int i = 0; i < 2; ++i)
                *(u32x4r*)(dstb + (size_t)t * D + c0 + 8 * i) = (u32x4r){pk_bf16(y[8 * i], y[8 * i + 1]), pk_bf16(y[8 * i + 2], y[8 * i + 3]), pk_bf16(y[8 * i + 4], y[8 * i + 5]), pk_bf16(y[8 * i + 6], y[8 * i + 7])};
        }
    }
}

__device__ __forceinline__ void phase_route(const Params& p, int* counts, int* explist, int* ldsw) {
    const int tid = opaque_tid(), lane = tid & 63;
    const int wave = (opaque_bid() * NT + tid) >> 6, nw = (gridDim.x * NT) >> 6;
    int* mye = ldsw + (tid >> 6) * 64;
    const f32x4 bias = *(const f32x4*)(p.router_bias + lane * 4);
    for (int t0 = wave; t0 < T; t0 += nw * 8) {
        f32x4 scs[8];
#pragma unroll
        for (int k = 0; k < 8; ++k) { const int t = t0 + k * nw; scs[k] = t < T ? *(const f32x4*)(p.scores + (size_t)t * NE + lane * 4) : (f32x4){0.f, 0.f, 0.f, 0.f}; }
#pragma unroll 1
        for (int kb = 0; kb < 8; kb += 4) {
            f32x4 sc4[4]; unsigned ku[4][4]; unsigned v8[4];
#pragma unroll
            for (int q = 0; q < 4; ++q) {
                f32x4 sc = scs[0];
#pragma unroll
                for (int kk = 1; kk < 8; ++kk) sc = (kb + q == kk) ? scs[kk] : sc;
                sc4[q] = sc;
                const float sel[4] = {sc[0] + bias[0], sc[1] + bias[1], sc[2] + bias[2], sc[3] + bias[3]};
                float m1 = fmaxf(sel[0], sel[1]), m2 = fminf(sel[0], sel[1]);
                m2 = fmaxf(m2, fminf(m1, sel[2])); m1 = fmaxf(m1, sel[2]);
                m2 = fmaxf(m2, fminf(m1, sel[3])); m1 = fmaxf(m1, sel[3]);
#pragma unroll
                for (int off = 1; off < 8; off <<= 1) {
                    const float o1 = shfl_lane(m1, lane ^ off), o2 = shfl_lane(m2, lane ^ off);
                    const float n2 = fmaxf(fminf(m1, o1), fmaxf(m2, o2));
                    m1 = fmaxf(m1, o1); m2 = n2;
                }
                const float gs = m1 + m2;
                const int g = lane >> 3;
                int rank = 0;
#pragma unroll
                for (int gg = 0; gg < NG; ++gg) { const float og = __int_as_float(__builtin_amdgcn_readlane(__float_as_int(gs), gg * 8)); rank += (og > gs || (og == gs && gg < g)) ? 1 : 0; }
                const bool gsel = rank < TOPG;
#pragma unroll
                for (int i = 0; i < 4; ++i) {
                    const unsigned u = __float_as_uint(sel[i]);
                    ku[q][i] = gsel ? ((u & 0x80000000u) ? ~u : (u | 0x80000000u)) : 0u;
                }
                v8[q] = 0u;
            }
#pragma unroll 1
            for (int bit = 31; bit >= 0; --bit) {
#pragma unroll
                for (int q = 0; q < 4; ++q) {
                    const unsigned cand = v8[q] | (1u << bit);
                    const int c = __popcll(__ballot(ku[q][0] >= cand)) + __popcll(__ballot(ku[q][1] >= cand)) + __popcll(__ballot(ku[q][2] >= cand)) + __popcll(__ballot(ku[q][3] >= cand));
                    if (c >= TOPK) v8[q] = cand;
                }
            }
#pragma unroll
            for (int q = 0; q < 4; ++q) {
                const int k = kb + q, t = t0 + k * nw;
                const f32x4 sc = sc4[q];
                int ngt = 0, eqlow = 0, sellow = 0;
                unsigned long long eqm[4];
#pragma unroll
                for (int i = 0; i < 4; ++i) { ngt += __popcll(__ballot(ku[q][i] > v8[q])); eqm[i] = __ballot(ku[q][i] == v8[q]); }
                const int need = TOPK - ngt;
#pragma unroll
                for (int i = 0; i < 4; ++i) eqlow += __builtin_amdgcn_mbcnt_hi((unsigned)(eqm[i] >> 32), __builtin_amdgcn_mbcnt_lo((unsigned)eqm[i], 0u));
                bool selc[4]; int eqrank = eqlow;
#pragma unroll
                for (int i = 0; i < 4; ++i) {
                    const bool eq = ku[q][i] == v8[q];
                    selc[i] = (ku[q][i] > v8[q]) || (eq && eqrank < need);
                    eqrank += eq ? 1 : 0;
                }
                float part = 0.f;
#pragma unroll
                for (int i = 0; i < 4; ++i) {
                    const unsigned long long sm = __ballot(selc[i]);
                    part += selc[i] ? sc[i] : 0.f;
                    sellow += __builtin_amdgcn_mbcnt_hi((unsigned)(sm >> 32), __builtin_amdgcn_mbcnt_lo((unsigned)sm, 0u));
                }
                const float wsum = wave_sum(part, lane);
                int slot = sellow;
                if (t < T) {
#pragma unroll
                    for (int i = 0; i < 4; ++i)
                        if (selc[i]) {
                            const int e = lane * 4 + i, pr = t * TOPK + slot;
                            p.gate[pr] = sc[i] / wsum * 2.5f;
                            mye[k * 8 + slot] = e;
                            ++slot;
                        }
                }
            }
        }
        {
            const int k = lane >> 3, t = t0 + k * nw;
            if (t < T) {
                const int e = mye[lane], pos = atomicAdd(&counts[e * CSTRIDE], 1);
                explist[(size_t)e * ECAP + pos] = t * TOPK + (lane & 7);
            }
        }
    }
}

__device__ __forceinline__ void compute_pend(const Params& p, int* pend, int* cnt) {
    const int tid = opaque_tid();
    if (tid < 64) {
        int c[4], pc[4];
#pragma unroll
        for (int i = 0; i < 4; ++i) { c[i] = p.counts[(tid * 4 + i) * CSTRIDE]; cnt[tid * 4 + i] = c[i]; pc[i] = (c[i] + 127) / 128 * 128; }
        const int ssum = pc[0] + pc[1] + pc[2] + pc[3];
        int inc = ssum;
#pragma unroll
        for (int off = 1; off < 64; off <<= 1) { const int v = shfl_lane_i(inc, tid - off); if (tid >= off) inc += v; }
        int run = inc - ssum;
#pragma unroll
        for (int i = 0; i < 4; ++i) { run += pc[i]; pend[tid * 4 + i] = run; }
    }
    __syncthreads();
}

__device__ __forceinline__ int expert_of_row(const int* pend, int row) {
    int lo = 0, hi = NE - 1;
    while (lo < hi) { const int mid = (lo + hi) >> 1; if (pend[mid] > row) hi = mid; else lo = mid + 1; }
    return lo;
}

__device__ __forceinline__ void phase_routed(const Params& p, int* pend, int* cnt, unsigned char* lds) {
    typedef GemmCfg<128, 256, 2, 4> CFG;
    compute_pend(p, pend, cnt);
    int* prs = (int*)(lds + 131072); float* gts = (float*)(lds + 131072 + 512);
    const bool grouped = (gridDim.x % 8) == 0;
    const int vb = vblock();
    const int xg = grouped ? (vb & 7) : 0, estep = grouped ? 8 : 1;
    const int nslots = grouped ? (gridDim.x >> 3) : gridDim.x;
    int widx = grouped ? (vb >> 3) : vb, tbase = 0;
    for (int e = xg; e < NE; e += estep) {
      const int ce = cnt[e], ntile = (ce + 127) >> 7;
      for (; widx < tbase + ntile; widx += nslots) {
        const int q0 = (widx - tbase) * 128;
        {
            const int tid = opaque_tid();
            if (tid < 128) {
                const int pr = (q0 + tid < ce) ? p.explist[(size_t)e * ECAP + q0 + tid] : -1;
                prs[tid] = pr; gts[tid] = pr >= 0 ? p.gate[pr] : 0.f;
            }
        }
        __syncthreads();
#pragma unroll 1
        for (int tn_ = 0; tn_ < 2 * RU; ++tn_) {
            const int tn = tn_ & 1;
            LoadRowsBf16N<128, 3> al; LoadKNF32N<3> bl;
            al.init(p.hb, D, [&](int r) { const int pr = prs[r]; return (long long)(pr >= 0 ? (pr >> 3) : 0); });
            bl.init(p.w_eu + (size_t)e * D * (2 * EFF), 2 * EFF, [&](int r) { return ((r >> 5) & 1) * EFF + tn * 128 + (r >> 6) * 32 + (r & 31); });
            f32x16 acc[CFG::MI][CFG::NI];
            acc_zero<CFG>(acc);
            gemm_mainloop_d3<CFG, false>(al, bl, D / 64, acc, lds);
            const int tid = opaque_tid(), lane = tid & 63, wid = tid >> 6, wm = wid / CFG::WN, wn = wid % CFG::WN;
            const int j = tn * 128 + wn * 32 + (lane & 31);
            unsigned char* img = lds + 65536 + (((j >> 6) + 2) & 3) * 16384 + (j & 7) * 2;
            const int jc = (j & 63) >> 3;
#pragma unroll
            for (int mi = 0; mi < CFG::MI; ++mi)
#pragma unroll
                for (int r = 0; r < 16; ++r) {
                    const int row = wm * CFG::TM + mi * 32 + (r & 3) + 8 * (r >> 2) + 4 * (lane >> 5);
                    *(bf16_t*)(img + row * 128 + ((jc ^ swz(row)) << 4)) = to_bf16(siluf_(acc[mi][0][r]) * acc[mi][1][r]);
                }
        }
        __syncthreads();
#pragma unroll 1
        for (int tn_ = 0; tn_ < 4 * RD; ++tn_) {
            const int tn = tn_ & 3;
            LoadRowsBf16<128> aldummy[2]; LoadKNF32 bl[2];
#pragma unroll
            for (int u = 0; u < 2; ++u) bl[u].init(p.w_ed + (size_t)e * EFF * D, D, [&](int r) { return tn * 256 + r; });
            f32x16 acc[CFG::MI][CFG::NI];
            acc_zero<CFG>(acc);
            gemm_mainloop2<CFG, true, 2, true>(aldummy, bl, EFF / 64, acc, lds, lds + 65536);
            {
                const int tid = opaque_tid(), lane = tid & 63, wid = tid >> 6, wm = wid / CFG::WN, wn = wid % CFG::WN;
#pragma unroll
                for (int mi = 0; mi < CFG::MI; ++mi) {
                    const int row = wm * CFG::TM + mi * 32 + (lane & 31);
                    const int pr = prs[row]; const float g = gts[row];
                    if (pr >= 0) {
#pragma unroll
                        for (int ni = 0; ni < CFG::NI; ++ni) {
                            bf16_t* dst = p.ypairb + (size_t)pr * D + tn * 256 + wn * CFG::TN + ni * 32 + 4 * (lane >> 5);
#pragma unroll
                            for (int gq = 0; gq < 4; ++gq) {
                                uint2 w; w.x = pk_bf16(acc[mi][ni][4 * gq] * g, acc[mi][ni][4 * gq + 1] * g); w.y = pk_bf16(acc[mi][ni][4 * gq + 2] * g, acc[mi][ni][4 * gq + 3] * g);
                                *(uint2*)(dst + 8 * gq) = w;
                            }
                        }
                    }
                }
            }
        }
        __syncthreads();
      }
      tbase += ntile;
    }
}

#define RW_BAR() do { __builtin_amdgcn_s_waitcnt(0xc07f); __builtin_amdgcn_s_barrier(); } while (0)
__device__ __forceinline__ void phase_routed_ws(const Params& p, int* pend, int* cnt, unsigned char* lds) {
    compute_pend(p, pend, cnt);
    const int tid = opaque_tid(), lane = tid & 63, wid = tid >> 6;
    const bool grouped = (gridDim.x % 8) == 0;
    const int vb = __builtin_amdgcn_readfirstlane(vblock());
    const int xg = grouped ? (vb & 7) : 0, estep = grouped ? 8 : 1;
    const int nslots = grouped ? (gridDim.x >> 3) : gridDim.x;
    const int widx0 = grouped ? (vb >> 3) : vb;
    typedef unsigned u32x4v __attribute__((ext_vector_type(4)));
    if (wid >= 4) {
        const int lt = tid - 256, kq = lt >> 6, nq = lt & 63, arow = lt >> 3, ach = lt & 7;
        u32x4v ra[2][4]; f32x4 rb[2][16];
        const int r4 = nq * 4, upcol = ((r4 >> 6) & 1) * EFF + (r4 >> 7) * 64 + ((r4 >> 5) & 1) * 32 + (r4 & 31);
#define RW_GLD(DST, VOFF, SBASE) asm volatile("global_load_dwordx4 %0, %1, %2" : "=v"(DST) : "v"(VOFF), "s"(SBASE))
#define RW_WAIT_A(S, N) asm volatile("s_waitcnt vmcnt(" #N ")" : "+v"(ra[S][0]), "+v"(ra[S][1]), "+v"(ra[S][2]), "+v"(ra[S][3]))
#define RW_WAIT_B(S, H, N) asm volatile("s_waitcnt vmcnt(" #N ")" \
            : "+v"(rb[S][H * 8 + 0]), "+v"(rb[S][H * 8 + 1]), "+v"(rb[S][H * 8 + 2]), "+v"(rb[S][H * 8 + 3]), \
              "+v"(rb[S][H * 8 + 4]), "+v"(rb[S][H * 8 + 5]), "+v"(rb[S][H * 8 + 6]), "+v"(rb[S][H * 8 + 7]))
#define RW_UNIT(u_) const int uu = (u_); const bool up_ = uu < 32; const int dd_ = uu - 32; \
            const int tn = up_ ? (uu >> 4) : (dd_ >> 2), k0 = (up_ ? (uu & 15) : (dd_ & 3)) * 64; \
            const float* wb_ = up_ ? wu : wd; \
            const unsigned step_ = up_ ? (unsigned)(2 * EFF * 4) : (unsigned)(D * 4); \
            const unsigned q0_ = up_ ? (unsigned)(((k0 + kq * 8) * (2 * EFF) + upcol + tn * 128) * 4) : (unsigned)(((k0 + kq * 8) * D + tn * 256 + r4) * 4)
#define RW_LD_A(S, u_) do { RW_UNIT(u_); (void)wb_; (void)step_; (void)q0_; \
            _Pragma("unroll") for (int i = 0; i < 4; ++i) { const unsigned a_ = up_ ? aoff[i] + k0 * 2 : 0u; RW_GLD(ra[S][i], a_, hbb); } } while (0)
#define RW_LD_B(S, H, u_) do { RW_UNIT(u_); \
            unsigned q_ = q0_ + (unsigned)(32 * H) * step_; asm volatile("" : "+v"(q_)); \
            _Pragma("unroll") for (int j = 0; j < 8; ++j) { RW_GLD(rb[S][H * 8 + j], q_, wb_); q_ += step_; asm volatile("" : "+v"(q_)); } } while (0)
#define RW_LOAD(S, u_) do { RW_LD_A(S, u_); RW_LD_B(S, 0, u_); RW_LD_B(S, 1, u_); } while (0)
#define RW_ST_A(S, u_) do { const int uu = (u_); \
            if (uu < 32) { unsigned char* sa_ = lds + (uu & 1) * 49152 + ast0;     \
                _Pragma("unroll") for (int i = 0; i < 4; ++i) *(u32x4v*)(sa_ + i * 4096) = ra[S][i]; } } while (0)
#define RW_ST_B(S, H, u_) do { const int uu = (u_); \
            unsigned char* sb_ = (uu < 32) ? lds + (uu & 1) * 49152 + 16384 : lds + ((uu - 32) & 1) * 32768; \
            unsigned t_ = bst0; asm volatile("" : "+v"(t_));     \
            _Pragma("unroll") for (int nn = 0; nn < 4; ++nn) { \
                const u32x4v o = {pk_bf16(rb[S][H * 8][nn], rb[S][H * 8 + 1][nn]), pk_bf16(rb[S][H * 8 + 2][nn], rb[S][H * 8 + 3][nn]), \
                                  pk_bf16(rb[S][H * 8 + 4][nn], rb[S][H * 8 + 5][nn]), pk_bf16(rb[S][H * 8 + 6][nn], rb[S][H * 8 + 7][nn])}; \
                *(u32x4v*)(sb_ + (t_ ^ (unsigned)(H * 64 + (nn >> 1) * 16)) + nn * 128) = o; } } while (0)
#define RW_SLOT(S, X, NA, NB0, NB1, NEXT) do { \
            RW_WAIT_A(S, NA); RW_ST_A(S, X); if (NEXT) RW_LD_A(S, (X) + 2); \
            RW_WAIT_B(S, 0, NB0); RW_ST_B(S, 0, X); if (NEXT) RW_LD_B(S, 0, (X) + 2); \
            RW_WAIT_B(S, 1, NB1); RW_ST_B(S, 1, X); if (NEXT) RW_LD_B(S, 1, (X) + 2); } while (0)
#define RW_SLOTX(S, X, XR) do { \
            RW_WAIT_A(S, 36); RW_ST_A(S, X); RW_LD_A(S, XR); \
            RW_WAIT_B(S, 0, 32); RW_ST_B(S, 0, X); RW_LD_B(S, 0, XR); \
            RW_WAIT_B(S, 1, 32); RW_ST_B(S, 1, X); RW_LD_B(S, 1, XR); } while (0)
        const unsigned ast0 = (unsigned)(arow * 128 + ((ach ^ swz(arow)) << 4)), bst0 = (unsigned)(r4 * 128 + ((kq ^ (nq & 7)) << 4));
#define TW_SEEK(e_, tb_, w_) while (e_ < NE) { const int nt_ = (__builtin_amdgcn_readfirstlane(cnt[e_]) + 127) >> 7; if (w_ < tb_ + nt_) break; tb_ += nt_; e_ += estep; }
        int e = xg, tbase = 0, widx = widx0;
        TW_SEEK(e, tbase, widx);
        if (e < NE) {
            unsigned aoff[4];
            const float *wu, *wd;
            const bf16_t* hbb = p.hb;
            {
                const int ce = __builtin_amdgcn_readfirstlane(cnt[e]), q0 = (widx - tbase) * 128;
#pragma unroll
                for (int i = 0; i < 4; ++i) {
                    const int row = arow + 32 * i;
                    const int pr = (q0 + row < ce) ? p.explist[(size_t)e * ECAP + q0 + row] : -1;
                    aoff[i] = (unsigned)((pr >= 0 ? (pr >> 3) : 0) * D + ach * 8) * 2u;
                }
                const int eu_ = __builtin_amdgcn_readfirstlane(e);
                wu = p.w_eu + (size_t)eu_ * D * (2 * EFF);
                wd = p.w_ed + (size_t)eu_ * EFF * D;
            }
            RW_LOAD(0, 0); RW_LOAD(1, 1);
            for (;;) {
                int e2 = e, tb2 = tbase, w2 = widx + nslots;
                TW_SEEK(e2, tb2, w2);
                const bool has_next = e2 < NE;
                const int ce2 = has_next ? __builtin_amdgcn_readfirstlane(cnt[e2]) : 0, q02 = (w2 - tb2) * 128;
                RW_SLOT(0, 0, 36, 32, 32, true);
                RW_BAR();
#pragma unroll 1
                for (int u = 0; u < 44; u += 2) {
                    if (u == 32) RW_BAR();
                    RW_SLOT(1, u + 1, 36, 32, 32, true);
                    RW_BAR();
                    RW_SLOT(0, u + 2, 36, 32, 32, true);
                    RW_BAR();
                }
                int prn[4];
                const int* exb = p.explist;
#pragma unroll
                for (int i = 0; i < 4; ++i) {
                    const int row = arow + 32 * i;
                    const unsigned off_ = (has_next && q02 + row < ce2) ? (unsigned)(e2 * ECAP + q02 + row) * 4u : 0u;
                    asm volatile("global_load_dword %0, %1, %2" : "=v"(prn[i]) : "v"(off_), "s"(exb));
                }
                RW_SLOT(1, 45, 36, 32, 32, true);
                RW_BAR();
                asm volatile("s_waitcnt vmcnt(20)" : "+v"(prn[0]), "+v"(prn[1]), "+v"(prn[2]), "+v"(prn[3]));
                if (has_next) {
#pragma unroll
                    for (int i = 0; i < 4; ++i) {
                        const int row = arow + 32 * i;
                        const int pr = (q02 + row < ce2) ? prn[i] : -1;
                        aoff[i] = (unsigned)((pr >= 0 ? (pr >> 3) : 0) * D + ach * 8) * 2u;
                    }
                    const int eu_ = __builtin_amdgcn_readfirstlane(e2);
                    wu = p.w_eu + (size_t)eu_ * D * (2 * EFF);
                    wd = p.w_ed + (size_t)eu_ * EFF * D;
                }
                RW_SLOTX(0, 46, 0);
                RW_BAR();
                RW_SLOTX(1, 47, 1);
                RW_BAR();
                RW_BAR();
                if (!has_next) break;
                e = e2; tbase = tb2; widx = w2;
            }
            asm volatile("s_waitcnt vmcnt(0)" ::: "memory");
        }
#undef TW_SEEK
#undef RW_LOAD
        return;
    }
#define CU_ASM_UP_FIRST \
        "ds_read_b128 %[qx0], %[xa0]\n" \
        "ds_read_b128 %[qy0], %[ya0]\n" \
        "ds_read_b128 %[qy1], %[ya0] offset:4096\n" \
        "ds_read_b128 %[qy2], %[ya0] offset:8192\n" \
        "ds_read_b128 %[qy3], %[ya0] offset:12288\n" \
        "ds_read_b128 %[qx1], %[xa0] offset:4096\n" \
        "ds_read_b128 %[px0], %[xa1]\n" \
        "ds_read_b128 %[py0], %[ya1]\n" \
        "ds_read_b128 %[py1], %[ya1] offset:4096\n" \
        "ds_read_b128 %[py2], %[ya1] offset:8192\n" \
        "ds_read_b128 %[py3], %[ya1] offset:12288\n" \
        "ds_read_b128 %[px1], %[xa1] offset:4096\n" \
        "s_waitcnt lgkmcnt(6)\n" \
        "v_mfma_f32_32x32x16_bf16 %[c00], %[qx0], %[qy0], %[c00]\n" \
        "v_mfma_f32_32x32x16_bf16 %[c01], %[qx0], %[qy1], %[c01]\n" \
        "v_mfma_f32_32x32x16_bf16 %[c02], %[qx0], %[qy2], %[c02]\n" \
        "v_mfma_f32_32x32x16_bf16 %[c03], %[qx0], %[qy3], %[c03]\n" \
        "ds_read_b128 %[qx0], %[xa2]\n" \
        "v_mfma_f32_32x32x16_bf16 %[c10], %[qx1], %[qy0], %[c10]\n" \
        "ds_read_b128 %[qy0], %[ya2]\n" \
        "v_mfma_f32_32x32x16_bf16 %[c11], %[qx1], %[qy1], %[c11]\n" \
        "ds_read_b128 %[qy1], %[ya2] offset:4096\n" \
        "v_mfma_f32_32x32x16_bf16 %[c12], %[qx1], %[qy2], %[c12]\n" \
        "ds_read_b128 %[qy2], %[ya2] offset:8192\n" \
        "v_mfma_f32_32x32x16_bf16 %[c13], %[qx1], %[qy3], %[c13]\n" \
        "ds_read_b128 %[qy3], %[ya2] offset:12288\n" \
        "ds_read_b128 %[qx1], %[xa2] offset:4096\n" \
        "s_waitcnt lgkmcnt(6)\n" \
        "v_mfma_f32_32x32x16_bf16 %[c00], %[px0], %[py0], %[c00]\n" \
        "v_mfma_f32_32x32x16_bf16 %[c01], %[px0], %[py1], %[c01]\n" \
        "v_mfma_f32_32x32x16_bf16 %[c02], %[px0], %[py2], %[c02]\n" \
        "v_mfma_f32_32x32x16_bf16 %[c03], %[px0], %[py3], %[c03]\n" \
        "ds_read_b128 %[px0], %[xa3]\n" \
        "v_mfma_f32_32x32x16_bf16 %[c10], %[px1], %[py0], %[c10]\n" \
        "ds_read_b128 %[py0], %[ya3]\n" \
        "v_mfma_f32_32x32x16_bf16 %[c11], %[px1], %[py1], %[c11]\n" \
        "ds_read_b128 %[py1], %[ya3] offset:4096\n" \
        "v_mfma_f32_32x32x16_bf16 %[c12], %[px1], %[py2], %[c12]\n" \
        "ds_read_b128 %[py2], %[ya3] offset:8192\n" \
        "v_mfma_f32_32x32x16_bf16 %[c13], %[px1], %[py3], %[c13]\n" \
        "ds_read_b128 %[py3], %[ya3] offset:12288\n" \
        "ds_read_b128 %[px1], %[xa3] offset:4096\n" \
        "s_waitcnt lgkmcnt(6)\n" \
        "v_mfma_f32_32x32x16_bf16 %[c00], %[qx0], %[qy0], %[c00]\n" \
        "v_mfma_f32_32x32x16_bf16 %[c01], %[qx0], %[qy1], %[c01]\n" \
        "v_mfma_f32_32x32x16_bf16 %[c02], %[qx0], %[qy2], %[c02]\n" \
        "v_mfma_f32_32x32x16_bf16 %[c03], %[qx0], %[qy3], %[c03]\n" \
        "v_mfma_f32_32x32x16_bf16 %[c10], %[qx1], %[qy0], %[c10]\n" \
        "v_mfma_f32_32x32x16_bf16 %[c11], %[qx1], %[qy1], %[c11]\n" \
        "v_mfma_f32_32x32x16_bf16 %[c12], %[qx1], %[qy2], %[c12]\n" \
        "v_mfma_f32_32x32x16_bf16 %[c13], %[qx1], %[qy3], %[c13]\n" \
        "s_waitcnt lgkmcnt(0)\n" \
        "s_barrier\n"
#define CU_ASM_UP \
        "v_mfma_f32_32x32x16_bf16 %[c00], %[px0], %[py0], %[c00]\n" \
        "ds_read_b128 %[qx0], %[xa0]\n" \
        "ds_read_b128 %[qy0], %[ya0]\n" \
        "v_mfma_f32_32x32x16_bf16 %[c01], %[px0], %[py1], %[c01]\n" \
        "ds_read_b128 %[qy1], %[ya0] offset:4096\n" \
        "ds_read_b128 %[qy2], %[ya0] offset:8192\n" \
        "v_mfma_f32_32x32x16_bf16 %[c02], %[px0], %[py2], %[c02]\n" \
        "ds_read_b128 %[qy3], %[ya0] offset:12288\n" \
        "ds_read_b128 %[qx1], %[xa0] offset:4096\n" \
        "v_mfma_f32_32x32x16_bf16 %[c03], %[px0], %[py3], %[c03]\n" \
        "ds_read_b128 %[px0], %[xa1]\n" \
        "v_mfma_f32_32x32x16_bf16 %[c10], %[px1], %[py0], %[c10]\n" \
        "ds_read_b128 %[py0], %[ya1]\n" \
        "v_mfma_f32_32x32x16_bf16 %[c11], %[px1], %[py1], %[c11]\n" \
        "ds_read_b128 %[py1], %[ya1] offset:4096\n" \
        "v_mfma_f32_32x32x16_bf16 %[c12], %[px1], %[py2], %[c12]\n" \
        "ds_read_b128 %[py2], %[ya1] offset:8192\n" \
        "v_mfma_f32_32x32x16_bf16 %[c13], %[px1], %[py3], %[c13]\n" \
        "ds_read_b128 %[py3], %[ya1] offset:12288\n" \
        "ds_read_b128 %[px1], %[xa1] offset:4096\n" \
        "s_waitcnt lgkmcnt(6)\n" \
        "v_mfma_f32_32x32x16_bf16 %[c00], %[qx0], %[qy0], %[c00]\n" \
        "v_mfma_f32_32x32x16_bf16 %[c01], %[qx0], %[qy1], %[c01]\n" \
        "v_mfma_f32_32x32x16_bf16 %[c02], %[qx0], %[qy2], %[c02]\n" \
        "v_mfma_f32_32x32x16_bf16 %[c03], %[qx0], %[qy3], %[c03]\n" \
        "ds_read_b128 %[qx0], %[xa2]\n" \
        "v_mfma_f32_32x32x16_bf16 %[c10], %[qx1], %[qy0], %[c10]\n" \
        "ds_read_b128 %[qy0], %[ya2]\n" \
        "v_mfma_f32_32x32x16_bf16 %[c11], %[qx1], %[qy1], %[c11]\n" \
        "ds_read_b128 %[qy1], %[ya2] offset:4096\n" \
        "v_mfma_f32_32x32x16_bf16 %[c12], %[qx1], %[qy2], %[c12]\n" \
        "ds_read_b128 %[qy2], %[ya2] offset:8192\n" \
        "v_mfma_f32_32x32x16_bf16 %[c13], %[qx1], %[qy3], %[c13]\n" \
        "ds_read_b128 %[qy3], %[ya2] offset:12288\n" \
        "ds_read_b128 %[qx1], %[xa2] offset:4096\n" \
        "s_waitcnt lgkmcnt(6)\n" \
        "v_mfma_f32_32x32x16_bf16 %[c00], %[px0], %[py0], %[c00]\n" \
        "v_mfma_f32_32x32x16_bf16 %[c01], %[px0], %[py1], %[c01]\n" \
        "v_mfma_f32_32x32x16_bf16 %[c02], %[px0], %[py2], %[c02]\n" \
        "v_mfma_f32_32x32x16_bf16 %[c03], %[px0], %[py3], %[c03]\n" \
        "ds_read_b128 %[px0], %[xa3]\n" \
        "v_mfma_f32_32x32x16_bf16 %[c10], %[px1], %[py0], %[c10]\n" \
        "ds_read_b128 %[py0], %[ya3]\n" \
        "v_mfma_f32_32x32x16_bf16 %[c11], %[px1], %[py1], %[c11]\n" \
        "ds_read_b128 %[py1], %[ya3] offset:4096\n" \
        "v_mfma_f32_32x32x16_bf16 %[c12], %[px1], %[py2], %[c12]\n" \
        "ds_read_b128 %[py2], %[ya3] offset:8192\n" \
        "v_mfma_f32_32x32x16_bf16 %[c13], %[px1], %[py3], %[c13]\n" \
        "ds_read_b128 %[py3], %[ya3] offset:12288\n" \
        "ds_read_b128 %[px1], %[xa3] offset:4096\n" \
        "s_waitcnt lgkmcnt(6)\n" \
        "v_mfma_f32_32x32x16_bf16 %[c00], %[qx0], %[qy0], %[c00]\n" \
        "v_mfma_f32_32x32x16_bf16 %[c01], %[qx0], %[qy1], %[c01]\n" \
        "v_mfma_f32_32x32x16_bf16 %[c02], %[qx0], %[qy2], %[c02]\n" \
        "v_mfma_f32_32x32x16_bf16 %[c03], %[qx0], %[qy3], %[c03]\n" \
        "v_mfma_f32_32x32x16_bf16 %[c10], %[qx1], %[qy0], %[c10]\n" \
        "v_mfma_f32_32x32x16_bf16 %[c11], %[qx1], %[qy1], %[c11]\n" \
        "v_mfma_f32_32x32x16_bf16 %[c12], %[qx1], %[qy2], %[c12]\n" \
        "v_mfma_f32_32x32x16_bf16 %[c13], %[qx1], %[qy3], %[c13]\n" \
        "s_waitcnt lgkmcnt(0)\n" \
        "s_barrier\n"
#define CU_ASM_DN_FIRST \
        "ds_read_b128 %[qx0], %[xa0]\n" \
        "ds_read_b128 %[qy0], %[ya0]\n" \
        "ds_read_b128 %[qy1], %[ya0] offset:4096\n" \
        "ds_read_b128 %[qy2], %[ya0] offset:8192\n" \
        "ds_read_b128 %[qy3], %[ya0] offset:12288\n" \
        "ds_read_b128 %[qx1], %[xa0] offset:4096\n" \
        "ds_read_b128 %[px0], %[xa1]\n" \
        "ds_read_b128 %[py0], %[ya1]\n" \
        "ds_read_b128 %[py1], %[ya1] offset:4096\n" \
        "ds_read_b128 %[py2], %[ya1] offset:8192\n" \
        "ds_read_b128 %[py3], %[ya1] offset:12288\n" \
        "ds_read_b128 %[px1], %[xa1] offset:4096\n" \
        "s_waitcnt lgkmcnt(6)\n" \
        "v_mfma_f32_32x32x16_bf16 %[c00], %[qy0], %[qx0], %[c00]\n" \
        "v_mfma_f32_32x32x16_bf16 %[c01], %[qy1], %[qx0], %[c01]\n" \
        "v_mfma_f32_32x32x16_bf16 %[c02], %[qy2], %[qx0], %[c02]\n" \
        "v_mfma_f32_32x32x16_bf16 %[c03], %[qy3], %[qx0], %[c03]\n" \
        "ds_read_b128 %[qx0], %[xa2]\n" \
        "v_mfma_f32_32x32x16_bf16 %[c10], %[qy0], %[qx1], %[c10]\n" \
        "ds_read_b128 %[qy0], %[ya2]\n" \
        "v_mfma_f32_32x32x16_bf16 %[c11], %[qy1], %[qx1], %[c11]\n" \
        "ds_read_b128 %[qy1], %[ya2] offset:4096\n" \
        "v_mfma_f32_32x32x16_bf16 %[c12], %[qy2], %[qx1], %[c12]\n" \
        "ds_read_b128 %[qy2], %[ya2] offset:8192\n" \
        "v_mfma_f32_32x32x16_bf16 %[c13], %[qy3], %[qx1], %[c13]\n" \
        "ds_read_b128 %[qy3], %[ya2] offset:12288\n" \
        "ds_read_b128 %[qx1], %[xa2] offset:4096\n" \
        "s_waitcnt lgkmcnt(6)\n" \
        "v_mfma_f32_32x32x16_bf16 %[c00], %[py0], %[px0], %[c00]\n" \
        "v_mfma_f32_32x32x16_bf16 %[c01], %[py1], %[px0], %[c01]\n" \
        "v_mfma_f32_32x32x16_bf16 %[c02], %[py2], %[px0], %[c02]\n" \
        "v_mfma_f32_32x32x16_bf16 %[c03], %[py3], %[px0], %[c03]\n" \
        "ds_read_b128 %[px0], %[xa3]\n" \
        "v_mfma_f32_32x32x16_bf16 %[c10], %[py0], %[px1], %[c10]\n" \
        "ds_read_b128 %[py0], %[ya3]\n" \
        "v_mfma_f32_32x32x16_bf16 %[c11], %[py1], %[px1], %[c11]\n" \
        "ds_read_b128 %[py1], %[ya3] offset:4096\n" \
        "v_mfma_f32_32x32x16_bf16 %[c12], %[py2], %[px1], %[c12]\n" \
        "ds_read_b128 %[py2], %[ya3] offset:8192\n" \
        "v_mfma_f32_32x32x16_bf16 %[c13], %[py3], %[px1], %[c13]\n" \
        "ds_read_b128 %[py3], %[ya3] offset:12288\n" \
        "ds_read_b128 %[px1], %[xa3] offset:4096\n" \
        "s_waitcnt lgkmcnt(6)\n" \
        "v_mfma_f32_32x32x16_bf16 %[c00], %[qy0], %[qx0], %[c00]\n" \
        "v_mfma_f32_32x32x16_bf16 %[c01], %[qy1], %[qx0], %[c01]\n" \
        "v_mfma_f32_32x32x16_bf16 %[c02], %[qy2], %[qx0], %[c02]\n" \
        "v_mfma_f32_32x32x16_bf16 %[c03], %[qy3], %[qx0], %[c03]\n" \
        "v_mfma_f32_32x32x16_bf16 %[c10], %[qy0], %[qx1], %[c10]\n" \
        "v_mfma_f32_32x32x16_bf16 %[c11], %[qy1], %[qx1], %[c11]\n" \
        "v_mfma_f32_32x32x16_bf16 %[c12], %[qy2], %[qx1], %[c12]\n" \
        "v_mfma_f32_32x32x16_bf16 %[c13], %[qy3], %[qx1], %[c13]\n" \
        "s_waitcnt lgkmcnt(0)\n" \
        "s_barrier\n"
#define CU_ASM_DN \
        "v_mfma_f32_32x32x16_bf16 %[c00], %[py0], %[px0], %[c00]\n" \
        "ds_read_b128 %[qx0], %[xa0]\n" \
        "ds_read_b128 %[qy0], %[ya0]\n" \
        "v_mfma_f32_32x32x16_bf16 %[c01], %[py1], %[px0], %[c01]\n" \
        "ds_read_b128 %[qy1], %[ya0] offset:4096\n" \
        "ds_read_b128 %[qy2], %[ya0] offset:8192\n" \
        "v_mfma_f32_32x32x16_bf16 %[c02], %[py2], %[px0], %[c02]\n" \
        "ds_read_b128 %[qy3], %[ya0] offset:12288\n" \
        "ds_read_b128 %[qx1], %[xa0] offset:4096\n" \
        "v_mfma_f32_32x32x16_bf16 %[c03], %[py3], %[px0], %[c03]\n" \
        "ds_read_b128 %[px0], %[xa1]\n" \
        "v_mfma_f32_32x32x16_bf16 %[c10], %[py0], %[px1], %[c10]\n" \
        "ds_read_b128 %[py0], %[ya1]\n" \
        "v_mfma_f32_32x32x16_bf16 %[c11], %[py1], %[px1], %[c11]\n" \
        "ds_read_b128 %[py1], %[ya1] offset:4096\n" \
        "v_mfma_f32_32x32x16_bf16 %[c12], %[py2], %[px1], %[c12]\n" \
        "ds_read_b128 %[py2], %[ya1] offset:8192\n" \
        "v_mfma_f32_32x32x16_bf16 %[c13], %[py3], %[px1], %[c13]\n" \
        "ds_read_b128 %[py3], %[ya1] offset:12288\n" \
        "ds_read_b128 %[px1], %[xa1] offset:4096\n" \
        "s_waitcnt lgkmcnt(6)\n" \
        "v_mfma_f32_32x32x16_bf16 %[c00], %[qy0], %[qx0], %[c00]\n" \
        "v_mfma_f32_32x32x16_bf16 %[c01], %[qy1], %[qx0], %[c01]\n" \
        "v_mfma_f32_32x32x16_bf16 %[c02], %[qy2], %[qx0], %[c02]\n" \
        "v_mfma_f32_32x32x16_bf16 %[c03], %[qy3], %[qx0], %[c03]\n" \
        "ds_read_b128 %[qx0], %[xa2]\n" \
        "v_mfma_f32_32x32x16_bf16 %[c10], %[qy0], %[qx1], %[c10]\n" \
        "ds_read_b128 %[qy0], %[ya2]\n" \
        "v_mfma_f32_32x32x16_bf16 %[c11], %[qy1], %[qx1], %[c11]\n" \
        "ds_read_b128 %[qy1], %[ya2] offset:4096\n" \
        "v_mfma_f32_32x32x16_bf16 %[c12], %[qy2], %[qx1], %[c12]\n" \
        "ds_read_b128 %[qy2], %[ya2] offset:8192\n" \
        "v_mfma_f32_32x32x16_bf16 %[c13], %[qy3], %[qx1], %[c13]\n" \
        "ds_read_b128 %[qy3], %[ya2] offset:12288\n" \
        "ds_read_b128 %[qx1], %[xa2] offset:4096\n" \
        "s_waitcnt lgkmcnt(6)\n" \
        "v_mfma_f32_32x32x16_bf16 %[c00], %[py0], %[px0], %[c00]\n" \
        "v_mfma_f32_32x32x16_bf16 %[c01], %[py1], %[px0], %[c01]\n" \
        "v_mfma_f32_32x32x16_bf16 %[c02], %[py2], %[px0], %[c02]\n" \
        "v_mfma_f32_32x32x16_bf16 %[c03], %[py3], %[px0], %[c03]\n" \
        "ds_read_b128 %[px0], %[xa3]\n" \
        "v_mfma_f32_32x32x16_bf16 %[c10], %[py0], %[px1], %[c10]\n" \
        "ds_read_b128 %[py0], %[ya3]\n" \
        "v_mfma_f32_32x32x16_bf16 %[c11], %[py1], %[px1], %[c11]\n" \
        "ds_read_b128 %[py1], %[ya3] offset:4096\n" \
        "v_mfma_f32_32x32x16_bf16 %[c12], %[py2], %[px1], %[c12]\n" \
        "ds_read_b128 %[py2], %[ya3] offset:8192\n" \
        "v_mfma_f32_32x32x16_bf16 %[c13], %[py3], %[px1], %[c13]\n" \
        "ds_read_b128 %[py3], %[ya3] offset:12288\n" \
        "ds_read_b128 %[px1], %[xa3] offset:4096\n" \
        "s_waitcnt lgkmcnt(6)\n" \
        "v_mfma_f32_32x32x16_bf16 %[c00], %[qy0], %[qx0], %[c00]\n" \
        "v_mfma_f32_32x32x16_bf16 %[c01], %[qy1], %[qx0], %[c01]\n" \
        "v_mfma_f32_32x32x16_bf16 %[c02], %[qy2], %[qx0], %[c02]\n" \
        "v_mfma_f32_32x32x16_bf16 %[c03], %[qy3], %[qx0], %[c03]\n" \
        "v_mfma_f32_32x32x16_bf16 %[c10], %[qy0], %[qx1], %[c10]\n" \
        "v_mfma_f32_32x32x16_bf16 %[c11], %[qy1], %[qx1], %[c11]\n" \
        "v_mfma_f32_32x32x16_bf16 %[c12], %[qy2], %[qx1], %[c12]\n" \
        "v_mfma_f32_32x32x16_bf16 %[c13], %[qy3], %[qx1], %[c13]\n" \
        "s_waitcnt lgkmcnt(0)\n" \
        "s_barrier\n"

#define CU_UNIT_ASM(BODY, PC, XB, YB) do { \
        const unsigned xa0_ = (XB) + co0, xa1_ = (XB) + co1, xa2_ = (XB) + co2, xa3_ = (XB) + co3; \
        const unsigned ya0_ = (YB) + co0, ya1_ = (YB) + co1, ya2_ = (YB) + co2, ya3_ = (YB) + co3; \
        asm volatile(BODY \
            : [c00] "+v"(acc[0][0]), [c01] "+v"(acc[0][1]), [c02] "+v"(acc[0][2]), [c03] "+v"(acc[0][3]), \
              [c10] "+v"(acc[1][0]), [c11] "+v"(acc[1][1]), [c12] "+v"(acc[1][2]), [c13] "+v"(acc[1][3]), \
              [px0] PC(fpx[0]), [px1] PC(fpx[1]), [py0] PC(fpy[0]), [py1] PC(fpy[1]), [py2] PC(fpy[2]), [py3] PC(fpy[3]), \
              [qx0] "=&v"(fqx[0]), [qx1] "=&v"(fqx[1]), [qy0] "=&v"(fqy[0]), [qy1] "=&v"(fqy[1]), [qy2] "=&v"(fqy[2]), [qy3] "=&v"(fqy[3]) \
            : [xa0] "v"(xa0_), [xa1] "v"(xa1_), [xa2] "v"(xa2_), [xa3] "v"(xa3_), [ya0] "v"(ya0_), [ya1] "v"(ya1_), [ya2] "v"(ya2_), [ya3] "v"(ya3_) \
            : "memory"); } while (0)
    const int wm = wid >> 1, wn = wid & 1, l31 = lane & 31, lh = lane >> 5, fsw = swz(l31);
    const int a_off = (wm * 64 + l31) * LROW, b_off = (wn * 128 + l31) * LROW;
    const unsigned lds0 = (unsigned)(size_t)lds;
    const unsigned co0 = (((0 + lh) ^ fsw) << 4), co1 = (((2 + lh) ^ fsw) << 4), co2 = (((4 + lh) ^ fsw) << 4), co3 = (((6 + lh) ^ fsw) << 4);
#define TW_SEEK(e_, tb_, w_) while (e_ < NE) { const int nt_ = (__builtin_amdgcn_readfirstlane(cnt[e_]) + 127) >> 7; if (w_ < tb_ + nt_) break; tb_ += nt_; e_ += estep; }
    int e = xg, tbase = 0, widx = widx0, tcount = 0;
    TW_SEEK(e, tbase, widx);
    int pr_c = -1; float g_c = 0.f;
    if (e < NE && tid < 128) {
        const int ce = __builtin_amdgcn_readfirstlane(cnt[e]), q0 = (widx - tbase) * 128;
        pr_c = (q0 + tid < ce) ? p.explist[(size_t)e * ECAP + q0 + tid] : -1;
        g_c = pr_c >= 0 ? p.gate[pr_c] : 0.f;
    }
    while (e < NE) {
        {
            int e2 = e, tb2 = tbase, w2 = widx + nslots;
            TW_SEEK(e2, tb2, w2);
            const bool has_next = e2 < NE;
            int* prs = (int*)(lds + 131072 + (tcount & 1) * 1024); float* gts = (float*)(prs + 128);
            int pr_n = -1; float g_n = 0.f;
            if (tid < 128) {
                prs[tid] = pr_c; gts[tid] = g_c;
                if (has_next) {
                    const int ce2 = __builtin_amdgcn_readfirstlane(cnt[e2]), q02 = (w2 - tb2) * 128;
                    if (q02 + tid < ce2) pr_n = p.explist[(size_t)e2 * ECAP + q02 + tid];
                }
            }
            RW_BAR();
            f32x16 acc[2][4];
            u32x4v fpx[2], fpy[4], fqx[2], fqy[4];
#pragma unroll 1
            for (int tn = 0; tn < 2; ++tn) {
#pragma unroll
                for (int mi = 0; mi < 2; ++mi)
#pragma unroll
                    for (int ni = 0; ni < 4; ++ni)
#pragma unroll
                        for (int r = 0; r < 16; ++r) acc[mi][ni][r] = 0.f;
#pragma unroll
                for (int i = 0; i < 2; ++i) fpx[i] = u32x4v{0u, 0u, 0u, 0u};
#pragma unroll
                for (int i = 0; i < 4; ++i) fpy[i] = u32x4v{0u, 0u, 0u, 0u};
#pragma unroll 1
                for (int kt = 0; kt < 16; ++kt) {
                    const unsigned xb_ = lds0 + (kt & 1) * 49152 + a_off, yb_ = lds0 + (kt & 1) * 49152 + 16384 + b_off;
                    CU_UNIT_ASM(CU_ASM_UP, "+v", xb_, yb_);
                }
#pragma unroll
                for (int mi = 0; mi < 2; ++mi)
#pragma unroll
                    for (int ni = 0; ni < 4; ++ni)
                        acc[mi][ni] = __builtin_amdgcn_mfma_f32_32x32x16_bf16(__builtin_bit_cast(bf16x8, fpx[mi]), __builtin_bit_cast(bf16x8, fpy[ni]), acc[mi][ni], 0, 0, 0);
#pragma unroll
                for (int hh = 0; hh < 2; ++hh) {
                    const int j = tn * 128 + wn * 64 + hh * 32 + l31;
                    unsigned char* img = lds + 65536 + (((j >> 6) + 2) & 3) * 16384 + (j & 7) * 2;
                    const int jc = (j & 63) >> 3;
#pragma unroll
                    for (int mi = 0; mi < 2; ++mi)
#pragma unroll
                        for (int r = 0; r < 16; ++r) {
                            const int row = wm * 64 + mi * 32 + (r & 3) + 8 * (r >> 2) + 4 * lh;
                            *(bf16_t*)(img + row * 128 + ((jc ^ swz(row)) << 4)) = to_bf16(siluf_(acc[mi][hh][r]) * acc[mi][hh + 2][r]);
                        }
                }
            }
            if (tid < 128 && pr_n >= 0) g_n = p.gate[pr_n];
            RW_BAR();
#pragma unroll 1
            for (int tn = 0; tn < 4; ++tn) {
#pragma unroll
                for (int mi = 0; mi < 2; ++mi)
#pragma unroll
                    for (int ni = 0; ni < 4; ++ni)
#pragma unroll
                        for (int r = 0; r < 16; ++r) acc[mi][ni][r] = 0.f;
#pragma unroll
                for (int i = 0; i < 2; ++i) fpx[i] = u32x4v{0u, 0u, 0u, 0u};
#pragma unroll
                for (int i = 0; i < 4; ++i) fpy[i] = u32x4v{0u, 0u, 0u, 0u};
#pragma unroll 1
                for (int kt = 0; kt < 4; ++kt) {
                    const unsigned xb_ = lds0 + 65536 + ((kt + 2) & 3) * 16384 + a_off, yb_ = lds0 + (kt & 1) * 32768 + b_off;
                    CU_UNIT_ASM(CU_ASM_DN, "+v", xb_, yb_);
                }
#pragma unroll
                for (int mi = 0; mi < 2; ++mi)
#pragma unroll
                    for (int ni = 0; ni < 4; ++ni)
                        acc[mi][ni] = __builtin_amdgcn_mfma_f32_32x32x16_bf16(__builtin_bit_cast(bf16x8, fpy[ni]), __builtin_bit_cast(bf16x8, fpx[mi]), acc[mi][ni], 0, 0, 0);
#pragma unroll
                for (int mi = 0; mi < 2; ++mi) {
                    const int row = wm * 64 + mi * 32 + l31;
                    const int pr = prs[row]; const float g = gts[row];
                    if (pr >= 0) {
#pragma unroll
                        for (int ni = 0; ni < 4; ++ni) {
                            bf16_t* dst = p.ypairb + (size_t)pr * D + tn * 256 + wn * 128 + ni * 32 + 4 * lh;
#pragma unroll
                            for (int gq = 0; gq < 4; ++gq) {
                                uint2 w; w.x = pk_bf16(acc[mi][ni][4 * gq] * g, acc[mi][ni][4 * gq + 1] * g); w.y = pk_bf16(acc[mi][ni][4 * gq + 2] * g, acc[mi][ni][4 * gq + 3] * g);
                                *(uint2*)(dst + 8 * gq) = w;
                            }
                        }
                    }
                }
            }
            pr_c = pr_n; g_c = g_n; e = e2; tbase = tb2; widx = w2; ++tcount;
        }
    }
#undef TW_SEEK
}

#ifndef R0
#define R0 1
#define R1 1
#define R2 1
#define R3 1
#define R4 1
#define R5 1
#define R6 1
#define R7 1
#define R8 1
#define R10 1
#define R11 1
#define R12 1
#endif

constexpr int LDS_MAIN = 133120;
__global__ void __launch_bounds__(NT) fwd_megakernel(KArgs ka) {
    __shared__ __attribute__((aligned(16))) unsigned char lds[LDS_MAIN + 2 * NE * 4 + 16 + 256 + 16];
    if (threadIdx.x == 0) *(volatile LAS3 int*)(unsigned long)(WIDTAB_OFF + 256) = blockIdx.x;
    static_assert(WIDTAB_OFF == LDS_MAIN + 2 * NE * 4 + 16, "wave-index table offset");
    if ((threadIdx.x & 63) == 0) *(volatile LAS3 int*)(unsigned long)(WIDTAB_OFF + 4 * hw_wave_slot()) = threadIdx.x >> 6;
    float* smem = (float*)lds;
    int* pend = (int*)(lds + LDS_MAIN);
    int* cnt = pend + NE;
    volatile LAS3 unsigned* xbst = (volatile LAS3 unsigned*)(lds + LDS_MAIN + 2 * NE * 4);
    if (threadIdx.x == 0) { xbst[0] = 0u; xbst[1] = 0u; }
    __syncthreads();
    const XcdBarrier xb = xcd_barrier_post((unsigned*)(ka.ws + OFF_BAR), xbst);

#define REPEAT(N, ...) { int reps_ = (N); asm volatile("" : "+s"(reps_)); for (int rep_ = 0; rep_ < reps_; ++rep_) { { const Params p(ka); __VA_ARGS__; } xcd_barrier(xb); } }
    if (threadIdx.x == 0) xbst[3] = blockIdx.x;
    { const Params p(ka); phase_init(p); }
    REPEAT(R0,
        int tshift = 0;
        transpose_convert(p.w_in, D, PW, PWP, p.w_in_t, smem, tshift, [](int n) { return n < 2048 ? n : n < 5632 ? n + 8 : n < 5640 ? n - 5632 + 2048 : -1; });
        transpose_convert(p.w_pa, DNW, D, D, p.w_pa_t, smem, tshift, [](int n) { return n; });
        transpose_convert(p.w_pb, SBW, D, D, p.w_pb_t, smem, tshift, [](int n) { return n; });
        transpose_convert(p.w_out, D, D, D, p.w_out_t, smem, tshift, [](int n) { return n; });
        transpose_convert(p.w_router, D, NE, NE, p.w_router_t, smem, tshift, [](int n) { return n; });
        transpose_convert(p.w_su, D, 2 * SFF, 2 * SFF, p.w_su_t, smem, tshift, [](int n) { return (n & 128) ? SFF + (n >> 8) * 128 + (n & 127) : (n >> 8) * 128 + (n & 127); });
        transpose_convert(p.w_sd, SFF, D, D, p.w_sd_t, smem, tshift, [](int n) { return n; });
        convert_bf16(p.x, p.xb, (size_t)T * D))
    REPEAT(R1, phase_inproj(p, lds))
    REPEAT(R2, phase_dn_chunks(p, lds))
    REPEAT(R3, phase_mixers(p, smem))
    REPEAT(R4, phase_gated_norm(p))
    REPEAT(R5, phase_merge(p, lds))
    REPEAT(R6, phase_outproj(p, lds))
    REPEAT(R7, layer_norm_rows([&](int t, int c0, float (&v)[16]) {
            _Pragma("unroll") for (int i = 0; i < 4; ++i) { const f32x4 x = *(const f32x4*)(p.pre1 + (size_t)t * D + c0 + 4 * i); v[4 * i] = x[0]; v[4 * i + 1] = x[1]; v[4 * i + 2] = x[2]; v[4 * i + 3] = x[3]; } },
        p.ln1_g, p.ln1_b, nullptr, p.hb))
    REPEAT(R8, phase_router_shared_up(p, lds))
    { const Params p(ka); phase_route(p, p.counts, p.explist, (int*)lds); }
    xcd_barrier(xb);
    { int reps9 = R9 - 1; asm volatile("" : "+s"(reps9)); for (int r9 = 0; r9 < reps9; ++r9) { const Params p(ka); phase_route(p, p.counts + NE * CSTRIDE, (int*)p.ypairb, (int*)lds); xcd_barrier(xb); } }
    { int repsb = RB; asm volatile("" : "+s"(repsb)); for (int rb = 0; rb < repsb; ++rb) xcd_barrier(xb); }
    REPEAT(R10, phase_routed_ws(p, pend, cnt, lds); __syncthreads(); phase_shared_down(p, lds))
    int reps12 = R12; asm volatile("" : "+s"(reps12));
    for (int rep = 0; rep < reps12; ++rep) {
        const Params p(ka);
        layer_norm_rows([&](int t, int c0, float (&v)[16]) {
#pragma unroll
                for (int i = 0; i < 16; ++i) v[i] = 0.f;
                add_bf16x16(p.hb + (size_t)t * D + c0, ALPHA, v);
                add_bf16x16(p.yshb + (size_t)t * D + c0, 1.f, v);
#pragma unroll
                for (int k = 0; k < TOPK; ++k) add_bf16x16(p.ypairb + ((size_t)t * TOPK + k) * D + c0, 1.f, v); },
            p.ln2_g, p.ln2_b, p.out, nullptr);
    }
}

extern "C" void kernel_launch(void* const* d_in, const int* in_sizes, int n_in, void* d_out, int out_size, void* d_ws,
                              size_t ws_size, hipStream_t stream) {
    static int grid_blocks = 0;
    if (!grid_blocks) {
        int dev = 0, cus = 0, per_cu = 0;
        hipGetDevice(&dev);
        hipDeviceGetAttribute(&cus, hipDeviceAttributeMultiprocessorCount, dev);
        hipOccupancyMaxActiveBlocksPerMultiprocessor(&per_cu, fwd_megakernel, NT, 0);
        if (per_cu > 1) per_cu = 1;
        grid_blocks = cus * per_cu;
    }
    KArgs p{};
    const float* const* in = (const float* const*)d_in;
    p.x = in[0]; p.w_in = in[1]; p.conv_w = in[2]; p.a_log = in[3]; p.dt_bias = in[4]; p.norm_g = in[5]; p.w_pa = in[6];
    p.w_pb = in[7]; p.w_out = in[8]; p.ln1_g = in[9]; p.ln1_b = in[10]; p.w_router = in[11]; p.router_bias = in[12];
    p.w_su = in[13]; p.w_sd = in[14]; p.w_eu = in[15]; p.w_ed = in[16]; p.ln2_g = in[17]; p.ln2_b = in[18];
    p.out = (float*)d_out; p.ws = (unsigned char*)d_ws;
    if (WS_BYTES > ws_size) { fprintf(stderr, "workspace too small: need %zu have %zu\n", (size_t)WS_BYTES, ws_size); return; }
    hipMemsetAsync(p.ws + OFF_BAR, 0, XCD_BAR_WORDS * 4, stream);
    void* args[] = {&p};
    hipError_t e = hipLaunchCooperativeKernel((void*)fwd_megakernel, dim3(grid_blocks), dim3(NT), args, 0, stream);
    if (e != hipSuccess) fprintf(stderr, "cooperative launch failed: %s (grid %d)\n", hipGetErrorString(e), grid_blocks);
}
```

```cpp
#include <hip/hip_runtime.h>
#include <hip/hip_cooperative_groups.h>
#include <cstdio>
#include <cstdint>
namespace cg = cooperative_groups;

constexpr int D = 1024, NB = 8, SEQ = 2048, T = NB * SEQ;
constexpr int DNH = 4, DND = 128, DNW = 512;
constexpr int SBH = 8, SBD = 64, SBW = 512;
constexpr int NE = 256, TOPK = 8, NG = 8, TOPG = 4, EFF = 256, SFF = 256;
constexpr int PW = 5640;
constexpr int NPAIR = T * TOPK;
constexpr int NBLK = (NPAIR + NE * 127 + 127) / 128;
constexpr int PROWS = NBLK * 128;
constexpr float ALPHA = 1.189207115002721f;
constexpr float LN_EPS = 1e-5f, NORM_EPS = 1e-6f;
constexpr int NT = 512;
#ifndef RU
#define RU 1
#define RD 1
#define R9 1
#define RB 0
#endif

typedef unsigned short bf16_t;
constexpr int PWP = 5888;
constexpr int DN_ROWS = 448, DN_BLOB = DN_ROWS * 64;
constexpr int ECAP = T;
#define XCD_BAR_WORDS 3456
constexpr int CSTRIDE = 64;
constexpr size_t al256(size_t x) { return (x + 255) & ~(size_t)255; }
constexpr size_t OFF_XB = 0;
constexpr size_t OFF_WINT = OFF_XB + al256((size_t)T * D * 2);
constexpr size_t OFF_QKVRAW = OFF_WINT + al256((size_t)PWP * D * 2);
constexpr size_t OFF_DZB = OFF_QKVRAW + al256((size_t)T * 1536 * 2);
constexpr size_t OFF_SQ = OFF_DZB + al256((size_t)T * 512 * 2);
constexpr size_t OFF_SK = OFF_SQ + al256((size_t)T * 512 * 2);
constexpr size_t OFF_VT = OFF_SK + al256((size_t)T * 512 * 2);
constexpr size_t OFF_DNBLOB = OFF_VT + al256((size_t)T * 512 * 2);
constexpr size_t OFF_DNU = OFF_DNBLOB + al256((size_t)1024 * DN_BLOB * 2);
constexpr size_t OFF_DNLAST = OFF_DNU + al256((size_t)1024 * 64 * 128 * 4);
constexpr size_t OFF_GAB = OFF_DNLAST + al256(1024 * 4);
constexpr size_t OFF_GBB = OFF_GAB + al256((size_t)T * D * 2);
constexpr size_t OFF_SMALL = OFF_GBB + al256((size_t)T * D * 2);
constexpr size_t OFF_WPAT = OFF_SMALL + al256((size_t)T * 8 * 4);
constexpr size_t OFF_WPBT = OFF_WPAT + al256((size_t)D * DNW * 2);
constexpr size_t OFF_WOUTT = OFF_WPBT + al256((size_t)D * SBW * 2);
constexpr size_t OFF_WROUTT = OFF_WOUTT + al256((size_t)D * D * 2);
constexpr size_t OFF_WSUT = OFF_WROUTT + al256((size_t)NE * D * 2);
constexpr size_t OFF_WSDT = OFF_WSUT + al256((size_t)2 * SFF * D * 2);
constexpr size_t OFF_OAB = OFF_WSDT + al256((size_t)D * SFF * 2);
constexpr size_t OFF_OBB = OFF_OAB + al256((size_t)T * DNW * 2);
constexpr size_t OFF_MERGED = OFF_OBB + al256((size_t)T * SBW * 2);
constexpr size_t OFF_HB = OFF_MERGED + al256((size_t)T * D * 2);
constexpr size_t OFF_ACTSH = OFF_HB + al256((size_t)T * D * 2);
constexpr size_t OFF_YPAIRB = OFF_ACTSH + al256((size_t)T * SFF * 2);
constexpr size_t OFF_ORAW = OFF_YPAIRB + al256((size_t)NPAIR * D * 2);
constexpr size_t OFF_PRE1 = OFF_ORAW + al256((size_t)T * DNW * 4);
constexpr size_t OFF_H = OFF_PRE1 + al256((size_t)T * D * 4);
constexpr size_t OFF_SCORES = OFF_H + al256((size_t)T * D * 4);
constexpr size_t OFF_GATE = OFF_SCORES + al256((size_t)T * NE * 4);
constexpr size_t OFF_YSH = OFF_GATE + al256((size_t)NPAIR * 4);
constexpr size_t OFF_IDX = OFF_YSH + al256((size_t)T * D * 4);
constexpr size_t OFF_COUNTS = OFF_IDX + al256((size_t)NPAIR * 4);
constexpr size_t OFF_EXPLIST = OFF_COUNTS + al256(2 * NE * CSTRIDE * 4);
constexpr size_t OFF_WEUT = OFF_EXPLIST + al256((size_t)NE * ECAP * 4);
constexpr size_t OFF_M1 = OFF_WEUT + al256((size_t)NE * 2 * EFF * D * 2);
constexpr size_t OFF_BAR = OFF_M1 + al256((size_t)T * D * 4);
constexpr size_t WS_BYTES = OFF_BAR + al256(XCD_BAR_WORDS * 4);

struct KArgs {
    const float *x, *w_in, *conv_w, *a_log, *dt_bias, *norm_g, *w_pa, *w_pb, *w_out, *ln1_g, *ln1_b, *w_router,
        *router_bias, *w_su, *w_sd, *w_eu, *w_ed, *ln2_g, *ln2_b;
    float* out; unsigned char* ws;
};
struct Params {
    const float *x, *w_in, *conv_w, *a_log, *dt_bias, *norm_g, *w_pa, *w_pb, *w_out, *ln1_g, *ln1_b, *w_router,
        *router_bias, *w_su, *w_sd, *w_eu, *w_ed, *ln2_g, *ln2_b;
    float* out;
    float *oraw, *pre1, *h, *scores, *gate, *ysh, *small, *dnu, *dnlast, *m1;
    int *idx, *counts, *explist;
    bf16_t *xb, *w_in_t, *w_pa_t, *w_pb_t, *w_out_t, *w_router_t, *w_su_t, *w_sd_t, *oab, *obb, *mergedb, *hb, *actsh, *ypairb, *yshb;
    bf16_t *qkvraw, *dzb, *sq, *sk, *vT, *gab, *gbb, *dnblob, *w_eu_t;
    unsigned* bar;
    __device__ __forceinline__ explicit Params(const KArgs& k) {
        x = k.x; w_in = k.w_in; conv_w = k.conv_w; a_log = k.a_log; dt_bias = k.dt_bias; norm_g = k.norm_g; w_pa = k.w_pa; w_pb = k.w_pb;
        w_out = k.w_out; ln1_g = k.ln1_g; ln1_b = k.ln1_b; w_router = k.w_router; router_bias = k.router_bias; w_su = k.w_su; w_sd = k.w_sd;
        w_eu = k.w_eu; w_ed = k.w_ed; ln2_g = k.ln2_g; ln2_b = k.ln2_b; out = k.out;
        __attribute__((address_space(1))) unsigned char* wg = (__attribute__((address_space(1))) unsigned char*)k.ws; asm volatile("" : "+s"(wg));
        unsigned char* w = (unsigned char*)wg;
        xb = (bf16_t*)(w + OFF_XB); w_in_t = (bf16_t*)(w + OFF_WINT); qkvraw = (bf16_t*)(w + OFF_QKVRAW); dzb = (bf16_t*)(w + OFF_DZB);
        sq = (bf16_t*)(w + OFF_SQ); sk = (bf16_t*)(w + OFF_SK); vT = (bf16_t*)(w + OFF_VT); dnblob = (bf16_t*)(w + OFF_DNBLOB);
        dnu = (float*)(w + OFF_DNU); dnlast = (float*)(w + OFF_DNLAST); gab = (bf16_t*)(w + OFF_GAB); gbb = (bf16_t*)(w + OFF_GBB);
        small = (float*)(w + OFF_SMALL); w_pa_t = (bf16_t*)(w + OFF_WPAT); w_pb_t = (bf16_t*)(w + OFF_WPBT); w_out_t = (bf16_t*)(w + OFF_WOUTT);
        w_router_t = (bf16_t*)(w + OFF_WROUTT); w_su_t = (bf16_t*)(w + OFF_WSUT); w_sd_t = (bf16_t*)(w + OFF_WSDT);
        oab = (bf16_t*)(w + OFF_OAB); obb = (bf16_t*)(w + OFF_OBB); mergedb = (bf16_t*)(w + OFF_MERGED); hb = (bf16_t*)(w + OFF_HB);
        actsh = (bf16_t*)(w + OFF_ACTSH); ypairb = (bf16_t*)(w + OFF_YPAIRB); oraw = (float*)(w + OFF_ORAW); pre1 = (float*)(w + OFF_PRE1);
        h = (float*)(w + OFF_H); scores = (float*)(w + OFF_SCORES); gate = (float*)(w + OFF_GATE); ysh = (float*)(w + OFF_YSH); yshb = (bf16_t*)(w + OFF_YSH);
        idx = (int*)(w + OFF_IDX); counts = (int*)(w + OFF_COUNTS); explist = (int*)(w + OFF_EXPLIST); bar = (unsigned*)(w + OFF_BAR); w_eu_t = (bf16_t*)(w + OFF_WEUT); m1 = (float*)(w + OFF_M1);
    }
};

__device__ __forceinline__ float sigmoidf_(float v) { return __builtin_amdgcn_rcpf(1.f + __builtin_amdgcn_exp2f(-1.44269504088896f * v)); }
__device__ __forceinline__ float siluf_(float v) { return v * sigmoidf_(v); }
__device__ __forceinline__ float shfl_lane(float v, int src) { return __int_as_float(__builtin_amdgcn_ds_bpermute(src << 2, __float_as_int(v))); }
__device__ __forceinline__ int shfl_lane_i(int v, int src) { return __builtin_amdgcn_ds_bpermute(src << 2, v); }
__device__ __forceinline__ float wave_sum(float v, int lane) {
#pragma unroll
    for (int o = 32; o > 0; o >>= 1) v += shfl_lane(v, lane ^ o);
    return v;
}


#define XB_TMO      128
#define XB_XCNT(j)  (256  + 64 * (j))
#define XB_XSUB(j)  (1280 + 64 * (j))
#define XB_XGEN(j)  (2304 + 64 * (j))
#define XB_TOP      3328
#define XB_TOPGEN   3392
#define XB_SPIN_CAP (1u << 24)
#define LAS3 __attribute__((address_space(3)))
__device__ __forceinline__ unsigned xb_ld(unsigned* p)              { return __hip_atomic_load(p, __ATOMIC_RELAXED, __HIP_MEMORY_SCOPE_AGENT); }
__device__ __forceinline__ unsigned xb_add(unsigned* p, unsigned v) { return __hip_atomic_fetch_add(p, v, __ATOMIC_RELAXED, __HIP_MEMORY_SCOPE_AGENT); }
__device__ __forceinline__ unsigned xb_xcc_id() { return (unsigned)__builtin_amdgcn_s_getreg((3 << 11) | 20) & 0xFu; }
#define XB_SPIN(cond, bar) do { unsigned _sp = 0; while (cond) { __builtin_amdgcn_s_sleep(1); \
    if ((++_sp & 255u) == 0u) { if (xb_ld(&(bar)[XB_TMO])) break; if (_sp > XB_SPIN_CAP) { atomicAdd(&(bar)[XB_TMO], 1u); break; } } } } while (0)
constexpr int WIDTAB_OFF = 133120 + 2 * 256 * 4 + 16;
__device__ __forceinline__ unsigned hw_wave_slot() { return (unsigned)__builtin_amdgcn_s_getreg((5 << 11) | 4) & 63u; }
__device__ __forceinline__ int opaque_tid() {
    const int w = __builtin_amdgcn_readfirstlane(*(const volatile LAS3 int*)(unsigned long)(WIDTAB_OFF + 4 * hw_wave_slot()));
    int t = w * 64 + (int)__builtin_amdgcn_mbcnt_hi(~0u, __builtin_amdgcn_mbcnt_lo(~0u, 0u));
    asm volatile("" : "+v"(t)); return t;
}
struct XcdBarrier { unsigned* bar; unsigned x; volatile LAS3 unsigned* st; };
__device__ __forceinline__ XcdBarrier xcd_barrier_post(unsigned* bar, volatile LAS3 unsigned* st) {
    XcdBarrier b; b.bar = bar; b.x = xb_xcc_id(); b.st = st;
    if (threadIdx.x == 0) st[2] = xb_add(&bar[XB_XCNT(b.x)], 1u);
    return b;
}
__device__ __forceinline__ void xcd_barrier_complete(unsigned* bar, unsigned x, unsigned& nloc, unsigned& nx, int& vbx) {
    const unsigned G = gridDim.x * gridDim.y * gridDim.z;
    unsigned sum, cnt, mine, sp = 0u, xlow = 0u; bool uni = true;
    asm volatile("" : "+s"(x));
    for (;;) {
        sum = 0u; cnt = 0u; mine = 0u;
        xlow = 0u; uni = true; unsigned first = 0u;
#pragma unroll 1
        for (unsigned j = 0; j < 16; ++j) { const unsigned c = xb_ld(&bar[XB_XCNT(j)]); sum += c; cnt += (c > 0u) ? 1u : 0u; mine = (j == x) ? c : mine;
            xlow += (c > 0u && j < x) ? 1u : 0u; if (c) { if (first == 0u) first = c; else if (c != first) uni = false; } }
        if (sum == G) break;
        __builtin_amdgcn_s_sleep(1);
        if ((++sp & 255u) == 0u) { if (xb_ld(&bar[XB_TMO])) break; if (sp > XB_SPIN_CAP) { atomicAdd(&bar[XB_TMO], 1u); break; } }
    }
    nloc = mine > 0u ? mine : 1u; nx = cnt > 0u ? cnt : 1u;
    vbx = (uni && cnt == 8u && mine * 8u == G) ? (int)xlow : -1;
}
__device__ __forceinline__ void xcd_barrier(const XcdBarrier& b) {
    asm volatile("s_waitcnt vmcnt(0)" ::: "memory");
    __syncthreads();
    if (opaque_tid() == 0) {
        unsigned* bar = b.bar;
        __builtin_amdgcn_s_waitcnt(0);
        unsigned nloc = b.st[0], nx = b.st[1];
        if (nloc == 0u) { int vbx; xcd_barrier_complete(bar, b.x, nloc, nx, vbx); b.st[0] = nloc; b.st[1] = nx; if (vbx >= 0) b.st[3] = b.st[2] * 8u + (unsigned)vbx; }
        const unsigned old = xb_add(&bar[XB_XSUB(b.x)], 1u);
        const unsigned gen = old / nloc;
        if (old + 1u == (gen + 1u) * nloc) {
            __builtin_amdgcn_fence(__ATOMIC_RELEASE, "agent");
            asm volatile("s_waitcnt vmcnt(0)" ::: "memory");
            const unsigned og = xb_add(&bar[XB_TOP], 1u);
            const unsigned tg = og / nx;
            if (og + 1u == (tg + 1u) * nx) xb_add(&bar[XB_TOPGEN], 1u);
            else XB_SPIN(xb_ld(&bar[XB_TOPGEN]) == tg, bar);
            __builtin_amdgcn_fence(__ATOMIC_ACQUIRE, "agent");
            xb_add(&bar[XB_XGEN(b.x)], 1u);
            asm volatile("s_waitcnt vmcnt(0)" ::: "memory");
        } else {
            XB_SPIN(xb_ld(&bar[XB_XGEN(b.x)]) == gen, bar);
            __builtin_amdgcn_fence(__ATOMIC_ACQUIRE, "agent");
            asm volatile("s_waitcnt vmcnt(0)" ::: "memory");
        }
    }
    __syncthreads();
}

constexpr int VB_LDS_OFF = 133120 + 2 * 256 * 4 + 12;
__device__ __forceinline__ int vblock() { return *(const volatile LAS3 int*)(unsigned long)(VB_LDS_OFF); }
typedef short bf16x8 __attribute__((ext_vector_type(8)));
typedef float f32x16 __attribute__((ext_vector_type(16)));
typedef float f32x4 __attribute__((ext_vector_type(4)));
__device__ __forceinline__ unsigned pk_bf16(float a, float b) {
    typedef __bf16 bf2 __attribute__((ext_vector_type(2)));
    typedef float f2 __attribute__((ext_vector_type(2)));
    f2 v = {a, b};
    bf2 r = __builtin_convertvector(v, bf2);
    return __builtin_bit_cast(unsigned, r);
}
__device__ __forceinline__ bf16_t to_bf16(float a) { return (bf16_t)(pk_bf16(a, 0.f) & 0xffffu); }
__device__ __forceinline__ float bf2f(bf16_t v) { return __uint_as_float((unsigned)v << 16); }

__device__ __forceinline__ int opaque_bid() { int b = *(const volatile LAS3 int*)(unsigned long)(WIDTAB_OFF + 256); asm volatile("" : "+v"(b)); return b; }
constexpr int LROW = 128;
__device__ __forceinline__ int swz(int r) { return ((r >> 2) & 7) ^ ((r >> 1) & 1); }

template <int ROWS, bool MAYBE_NULL = false> struct LoadRowsBf16 {
    static constexpr int NCH = ROWS * 8 / NT;
    const bf16_t* base; int tid;
    unsigned off[NCH];
    typedef unsigned u32x4r __attribute__((ext_vector_type(4)));
    u32x4r regs[NCH];
    template <class RF> __device__ __forceinline__ void init(const bf16_t* base_, int ld, RF rowfn) {
        base = base_; tid = opaque_tid();
#pragma unroll
        for (int i = 0; i < NCH; ++i) {
            const int c = tid + i * NT, r = c >> 3, ch = c & 7;
            const long long src = rowfn(r);
            off[i] = (!MAYBE_NULL || src >= 0) ? (unsigned)(src * ld + ch * 8) : 0xffffffffu;
        }
    }
    __device__ __forceinline__ void load(int k0) {
#pragma unroll
        for (int i = 0; i < NCH; ++i)
            regs[i] = (!MAYBE_NULL || off[i] != 0xffffffffu) ? *(const u32x4r*)(base + (size_t)off[i] + k0) : (u32x4r){0u, 0u, 0u, 0u};
    }
    __device__ __forceinline__ void store(unsigned char* lds) const {
#pragma unroll
        for (int i = 0; i < NCH; ++i) {
            const int c = tid + i * NT, r = c >> 3, ch = c & 7;
            *(u32x4r*)(lds + r * LROW + ((ch ^ swz(r)) << 4)) = regs[i];
        }
    }
};

__device__ __forceinline__ int pi16(int x) { return (x & ~12) | ((x & 4) << 1) | ((x & 8) >> 1); }
namespace pg8 {
#define PG8_LAS __attribute__((address_space(3)))
typedef unsigned short bf16_t;
typedef short bf16x8 __attribute__((ext_vector_type(8)));
typedef float f32x4 __attribute__((ext_vector_type(4)));
typedef unsigned u32x4 __attribute__((ext_vector_type(4)));
constexpr int BM = 256, BK = 64, HALF = 128, HTB = HALF * BK * 2  , STAGE_BYTES = 8 * HTB, NXCD = 8, WGM = 8;

__host__ __device__ __forceinline__ int lds_byte(int r, int c) { const int st = (r >> 4) * 2 + (c >> 5), rr = r & 15, cc = c & 31, ob = rr * 64 + cc * 2; return st * 1024 + (ob ^ (((ob >> 9) & 1) << 5)); }
__host__ __device__ __forceinline__ void stage_rc(int b, int& R, int& C) { const int st = b / 1024, sb = b % 1024, swz = sb ^ (((sb >> 9) & 1) << 5); R = (st >> 1) * 16 + swz / 64; C = (st & 1) * 32 + (swz % 64) / 2; }
__host__ __device__ __forceinline__ int perm32(int rho) { const int n = rho >> 4, i = rho & 15; return 8 * (i >> 2) + 4 * n + (i & 3); }

struct Unit { int pm, pn; };
struct Gemm { const bf16_t* A; const bf16_t* Bt; int M, N, K; };

struct StaticOrder {
    int nM, nN, nwg, G, c;
    __host__ __device__ void init(int M, int N, int G_, int c_) { nM = M / BM; nN = N / BM; nwg = nM * nN; G = G_; c = c_; }
    __host__ __device__ bool next(int i, Unit& u) const {
        const long L = (long)i * G + c; if (L >= nwg) return false;
        int wgid = (int)L; { const int q = nwg / NXCD, r = nwg % NXCD, xcd = wgid % NXCD, off = wgid / NXCD; wgid = (xcd < r ? xcd * (q + 1) : r * (q + 1) + (xcd - r) * q) + off; }
        const int nig = WGM * nN, gid = wgid / nig, fm = gid * WGM, gsz = (nM - fm) < WGM ? (nM - fm) : WGM;
        u.pm = fm + ((wgid % nig) % gsz); u.pn = (wgid % nig) / gsz; return true;
    }
    __device__ __forceinline__ void a_ready(const Unit&) const {}
    __device__ __forceinline__ void done(const Unit&) const {}
};


__device__ __forceinline__ unsigned cvt_pk_bf16(float lo, float hi) { unsigned r; asm volatile("v_cvt_pk_bf16_f32 %0, %1, %2" : "=v"(r) : "v"(lo), "v"(hi)); return r; }

template <class Epi, class Sched, bool ALIGN_EPI = false, bool SP2 = false>
__device__ __forceinline__ void gemm_phase(PG8_LAS unsigned char* lds, const Gemm g, const Sched& S, const Epi& E) {
    const int tid = opaque_tid(), wid = __builtin_amdgcn_readfirstlane(tid >> 6), lane = tid & 63, wr = wid >> 2, wc = wid & 3, fr = lane & 15, fq = lane >> 4;
    const int K = g.K, nt = K / BK;
    unsigned voffA[2], voffB[2];
#pragma unroll
    for (int i = 0; i < 2; ++i) { int R, C; stage_rc(tid * 16 + i * 8192, R, C); const int Rb = Epi::PERM ? ((R & ~31) + perm32(R & 31)) : R;
        voffA[i] = (unsigned)(R * K + C) * 2u; voffB[i] = (unsigned)(Rb * K + C) * 2u; }
    const size_t rstep64 = (size_t)64 * K * 2;
    const size_t kstep = (size_t)(BK * 2);
    const size_t hstep = (size_t)HALF * K * 2;
    const size_t tstep = 2 * hstep;
    const unsigned ldsw = (unsigned)wid * 1024u;
    const int aoff = lds_byte(wr * 64 + fr, fq * 8), boff = lds_byte(wc * 32 + fr, fq * 8);
#define PG8_SA(b, h) (((b) * 2 + (h)) * HTB)
#define PG8_SB(b, h) ((4 + (b) * 2 + (h)) * HTB)
#define PG8_STAGE(bufoff, gbase, voff) do { _Pragma("unroll") for (int _i = 0; _i < 2; ++_i) \
        __builtin_amdgcn_global_load_lds((const unsigned*)((const char*)(gbase) + (size_t)_i * rstep64 + (voff)[0]), (PG8_LAS unsigned*)(lds + (bufoff) + ldsw + _i * 8192), 16, 0, 0); } while (0)
#define PG8_LDA(dst, b, h) do { _Pragma("unroll") for (int m = 0; m < 4; ++m) _Pragma("unroll") for (int k = 0; k < 2; ++k) dst[m][k] = *(const PG8_LAS bf16x8*)(lds + PG8_SA(b, h) + aoff + m * 2048 + k * 1024); } while (0)
#define PG8_LDB(dst, b, h) do { _Pragma("unroll") for (int n = 0; n < 2; ++n) _Pragma("unroll") for (int k = 0; k < 2; ++k) dst[n][k] = *(const PG8_LAS bf16x8*)(lds + PG8_SB(b, h) + boff + n * 2048 + k * 1024); } while (0)
#define PG8_MMA(ai, bj, At, Bt) do { __builtin_amdgcn_s_setprio(1); _Pragma("unroll") for (int m = 0; m < 4; ++m) _Pragma("unroll") for (int n = 0; n < 2; ++n) _Pragma("unroll") for (int k = 0; k < 2; ++k) \
        acc[ai][bj][m][n] = __builtin_amdgcn_mfma_f32_16x16x32_bf16(Bt[n][k], At[m][k], acc[ai][bj][m][n], 0, 0, 0); __builtin_amdgcn_s_setprio(0); } while (0)
#define PG8_WAIT_V(n) asm volatile("s_waitcnt vmcnt(" #n ")" ::: "memory")
#define PG8_WAIT_L(n) asm volatile("s_waitcnt lgkmcnt(" #n ")" ::: "memory")
#define PG8_BAR __builtin_amdgcn_s_barrier()
#define PG8_SCHED __builtin_amdgcn_sched_barrier(0)
    Unit cur, nxt; int ui = 0;
    if (!S.next(0, cur)) return;
    f32x4 acc[2][2][4][2];
#pragma unroll
    for (int a = 0; a < 2; ++a)
#pragma unroll
        for (int b = 0; b < 2; ++b)
#pragma unroll
            for (int m = 0; m < 4; ++m)
#pragma unroll
                for (int n = 0; n < 2; ++n) acc[a][b][m][n] = (f32x4){0.f, 0.f, 0.f, 0.f};
    bf16x8 At[4][2], B0[2][2], B1[2][2];
    const char* cA = (const char*)g.A + (size_t)cur.pm * tstep; const char* cB = (const char*)g.Bt + (size_t)cur.pn * tstep;
    S.a_ready(cur);
    if constexpr (SP2) {
        PG8_STAGE(PG8_SB(0, 0), cB, voffB); PG8_STAGE(PG8_SB(0, 1), cB + hstep, voffB); PG8_STAGE(PG8_SA(0, 0), cA, voffA); PG8_STAGE(PG8_SA(0, 1), cA + hstep, voffA);
        if (wr == 1) PG8_BAR;
        PG8_WAIT_V(2); PG8_BAR;
        PG8_STAGE(PG8_SB(1, 0), cB + kstep, voffB); PG8_STAGE(PG8_SA(1, 0), cA + kstep, voffA); PG8_STAGE(PG8_SB(1, 1), cB + hstep + kstep, voffB);
        PG8_WAIT_V(6); PG8_BAR;
    } else {
        PG8_STAGE(PG8_SB(0, 0), cB, voffB); PG8_STAGE(PG8_SA(0, 0), cA, voffA); PG8_STAGE(PG8_SB(0, 1), cB + hstep, voffB); PG8_STAGE(PG8_SA(0, 1), cA + hstep, voffA);
        if (wr == 1) PG8_BAR;
        PG8_WAIT_V(4); PG8_BAR;
        PG8_STAGE(PG8_SB(1, 0), cB + kstep, voffB); PG8_STAGE(PG8_SA(1, 0), cA + kstep, voffA); PG8_STAGE(PG8_SB(1, 1), cB + hstep + kstep, voffB);
        PG8_WAIT_V(6); PG8_BAR;
    }
    for (;;) {
        const bool has_next = S.next(ui + 1, nxt);
        const char* nA = has_next ? (const char*)g.A + (size_t)nxt.pm * tstep : cA; const char* nB = has_next ? (const char*)g.Bt + (size_t)nxt.pn * tstep : cB;
        for (int t = 0; t < nt; t += 2) {
            const bool last = (t == nt - 2);
            const char* a1 = cA + (size_t)(t + 1) * kstep;
            const char* a2 = last ? nA : cA + (size_t)(t + 2) * kstep; const char* b2 = last ? nB : cB + (size_t)(t + 2) * kstep;
            const char* a3 = a2 + kstep; const char* b3 = b2 + kstep;
            if (last && has_next) S.a_ready(nxt);
            if constexpr (SP2) {
            PG8_LDB(B0, 0, 0); PG8_LDB(B1, 0, 1); PG8_SCHED; PG8_LDA(At, 0, 0); PG8_STAGE(PG8_SA(1, 1), a1 + hstep, voffA);
            PG8_WAIT_V(8); PG8_WAIT_L(0); PG8_BAR; PG8_MMA(0, 0, At, B0); PG8_MMA(0, 1, At, B1); PG8_BAR; PG8_SCHED;
            PG8_LDA(At, 0, 1); PG8_STAGE(PG8_SB(0, 0), b2, voffB); PG8_STAGE(PG8_SB(0, 1), b2 + hstep, voffB); PG8_STAGE(PG8_SA(0, 0), a2, voffA);
            PG8_WAIT_V(8); PG8_WAIT_L(0); PG8_BAR; PG8_MMA(1, 0, At, B0); PG8_MMA(1, 1, At, B1); PG8_BAR; PG8_SCHED;
            PG8_LDB(B0, 1, 0); PG8_LDB(B1, 1, 1); PG8_SCHED; PG8_LDA(At, 1, 0); PG8_STAGE(PG8_SA(0, 1), a2 + hstep, voffA);
            PG8_WAIT_V(8); PG8_WAIT_L(0); PG8_BAR; PG8_MMA(0, 0, At, B0); PG8_MMA(0, 1, At, B1); PG8_BAR; PG8_SCHED;
            PG8_LDA(At, 1, 1); PG8_STAGE(PG8_SB(1, 0), b3, voffB); PG8_STAGE(PG8_SB(1, 1), b3 + hstep, voffB); PG8_STAGE(PG8_SA(1, 0), a3, voffA);
            PG8_WAIT_V(8); PG8_WAIT_L(0); PG8_BAR; PG8_MMA(1, 0, At, B0); PG8_MMA(1, 1, At, B1); PG8_BAR; PG8_SCHED;
            } else {
            PG8_LDB(B0, 0, 0); PG8_SCHED; PG8_LDA(At, 0, 0); PG8_STAGE(PG8_SA(1, 1), a1 + hstep, voffA);
            PG8_WAIT_L(8); PG8_BAR; PG8_WAIT_L(0); PG8_MMA(0, 0, At, B0); PG8_BAR; PG8_SCHED;
            PG8_LDB(B1, 0, 1); PG8_STAGE(PG8_SB(0, 0), b2, voffB);
            PG8_BAR; PG8_WAIT_L(0); PG8_MMA(0, 1, At, B1); PG8_BAR;
            PG8_LDA(At, 0, 1); PG8_STAGE(PG8_SA(0, 0), a2, voffA);
            PG8_BAR; PG8_WAIT_L(0); PG8_MMA(1, 0, At, B0); PG8_BAR; PG8_SCHED;
            PG8_STAGE(PG8_SB(0, 1), b2 + hstep, voffB);
            PG8_WAIT_V(6); PG8_BAR; PG8_MMA(1, 1, At, B1); PG8_BAR;
            PG8_LDB(B0, 1, 0); PG8_SCHED; PG8_LDA(At, 1, 0); PG8_STAGE(PG8_SA(0, 1), a2 + hstep, voffA);
            PG8_WAIT_L(8); PG8_BAR; PG8_WAIT_L(0); PG8_MMA(0, 0, At, B0); PG8_BAR; PG8_SCHED;
            PG8_LDB(B1, 1, 1); PG8_STAGE(PG8_SB(1, 0), b3, voffB);
            PG8_BAR; PG8_WAIT_L(0); PG8_MMA(0, 1, At, B1); PG8_BAR;
            PG8_LDA(At, 1, 1); PG8_STAGE(PG8_SA(1, 0), a3, voffA);
            PG8_BAR; PG8_WAIT_L(0); PG8_MMA(1, 0, At, B0); PG8_BAR; PG8_SCHED;
            PG8_STAGE(PG8_SB(1, 1), b3 + hstep, voffB);
            PG8_WAIT_V(6); PG8_BAR; PG8_MMA(1, 1, At, B1); PG8_BAR;
            }
        }
        if constexpr (ALIGN_EPI) { if (wr == 0) PG8_BAR; }
        if constexpr (!Epi::AFTER_DRAIN) { E(acc, cur, wr, wc, fr, fq); S.done(cur); }
        if (!has_next) break;
#pragma unroll
        for (int a = 0; a < 2; ++a)
#pragma unroll
            for (int b = 0; b < 2; ++b)
#pragma unroll
                for (int m = 0; m < 4; ++m)
#pragma unroll
                    for (int n = 0; n < 2; ++n) acc[a][b][m][n] = (f32x4){0.f, 0.f, 0.f, 0.f};
        cur = nxt; cA = nA; cB = nB; ++ui;
        if constexpr (ALIGN_EPI) { if (wr == 1) PG8_BAR; }
    }
    PG8_WAIT_V(0);
    if constexpr (!ALIGN_EPI) { if (wr == 0) PG8_BAR; }
    PG8_BAR;
    if constexpr (Epi::AFTER_DRAIN) { E.fused(acc, cur, wr, wc, fr, fq, lds, wid, lane); S.done(cur); }
#undef PG8_SA
#undef PG8_SB
#undef PG8_STAGE
#undef PG8_LDA
#undef PG8_LDB
#undef PG8_MMA
#undef PG8_WAIT_V
#undef PG8_WAIT_L
#undef PG8_BAR
#undef PG8_SCHED
}
}

struct EpiInproj {
    static constexpr bool PERM = true, AFTER_DRAIN = false;
    bf16_t *qkvraw, *dzb, *sq, *sk, *vT, *gab, *gbb; float* small;
    __device__ __forceinline__ void operator()(const pg8::f32x4 (&acc)[2][2][4][2], const pg8::Unit& u, int wr, int wc, int fr, int fq) const {
        const int pn = u.pn, row0 = u.pm * 256 + wr * 64 + fr;
        if (pn == 12 || pn == 13) {
#pragma unroll
            for (int ai = 0; ai < 2; ++ai)
#pragma unroll
                for (int m = 0; m < 4; ++m) {
                    const int tok = row0 + ai * 128 + m * 16, bb = tok >> 11, key = tok & (SEQ - 1), pos = (key & ~15) | pi16(key & 15);
#pragma unroll
                    for (int bj = 0; bj < 2; ++bj)
#pragma unroll
                        for (int n = 0; n < 2; ++n)
#pragma unroll
                            for (int j = 0; j < 4; ++j) {
                                const int svcol = (pn - 12) * 256 + bj * 128 + wc * 32 + fq * 8 + n * 4 + j;
                                vT[((size_t)((bb * 8 + (svcol >> 6)) * 64 + (svcol & 63))) * SEQ + pos] = to_bf16(acc[ai][bj][m][n][j]);
                            }
                }
        } else if (pn == 22) {
            if (wc == 0 && fq == 0) {
#pragma unroll
                for (int ai = 0; ai < 2; ++ai)
#pragma unroll
                    for (int m = 0; m < 4; ++m) {
                        pg8::f32x4* d = (pg8::f32x4*)(small + (size_t)(row0 + ai * 128 + m * 16) * 8);
                        d[0] = acc[ai][0][m][0]; d[1] = acc[ai][0][m][1];
                    }
            }
        } else {
            bf16_t* dst; int ld, c0; float sc = 1.f; bool gate = false;
            if (pn < 6) { dst = qkvraw; ld = 1536; c0 = pn * 256; }
            else if (pn < 8) { dst = dzb; ld = 512; c0 = (pn - 6) * 256; }
            else if (pn < 10) { dst = sq; ld = 512; c0 = (pn - 8) * 256; sc = 0.125f * 1.4426950408889634f; }
            else if (pn < 12) { dst = sk; ld = 512; c0 = (pn - 10) * 256; }
            else if (pn < 18) { dst = gab; ld = 1024; c0 = (pn - 14) * 256; gate = true; }
            else { dst = gbb; ld = 1024; c0 = (pn - 18) * 256; gate = true; }
#pragma unroll
            for (int ai = 0; ai < 2; ++ai)
#pragma unroll
                for (int m = 0; m < 4; ++m) {
                    bf16_t* rowp = dst + (size_t)(row0 + ai * 128 + m * 16) * ld + c0 + wc * 32 + fq * 8;
#pragma unroll
                    for (int bj = 0; bj < 2; ++bj) {
                        pg8::f32x4 v0 = acc[ai][bj][m][0] * sc, v1 = acc[ai][bj][m][1] * sc;
                        if (gate) {
#pragma unroll
                            for (int j = 0; j < 4; ++j) { v0[j] = sigmoidf_(v0[j]); v1[j] = sigmoidf_(v1[j]); }
                        }
                        pg8::u32x4 w; w.x = pk_bf16(v0[0], v0[1]); w.y = pk_bf16(v0[2], v0[3]); w.z = pk_bf16(v1[0], v1[1]); w.w = pk_bf16(v1[2], v1[3]);
                        *(pg8::u32x4*)(rowp + bj * 128) = w;
                    }
                }
        }
    }
};
template <class F> struct EpiF4 {
    static constexpr bool PERM = false, AFTER_DRAIN = false;
    F f;
    __device__ __forceinline__ void operator()(const pg8::f32x4 (&acc)[2][2][4][2], const pg8::Unit& u, int wr, int wc, int fr, int fq) const {
#pragma unroll
        for (int ai = 0; ai < 2; ++ai)
#pragma unroll
            for (int m = 0; m < 4; ++m) {
                const int row = u.pm * 256 + ai * 128 + wr * 64 + m * 16 + fr;
#pragma unroll
                for (int bj = 0; bj < 2; ++bj)
#pragma unroll
                    for (int n = 0; n < 2; ++n) f(row, u.pn * 256 + bj * 128 + wc * 32 + n * 16 + fq * 4, acc[ai][bj][m][n]);
            }
    }
};
template <class F> struct EpiF8 {
    static constexpr bool PERM = true, AFTER_DRAIN = false;
    F f;
    __device__ __forceinline__ void operator()(const pg8::f32x4 (&acc)[2][2][4][2], const pg8::Unit& u, int wr, int wc, int fr, int fq) const {
#pragma unroll
        for (int ai = 0; ai < 2; ++ai)
#pragma unroll
            for (int m = 0; m < 4; ++m) {
                const int row = u.pm * 256 + ai * 128 + wr * 64 + m * 16 + fr;
#pragma unroll
                for (int bj = 0; bj < 2; ++bj) f(row, u.pn * 256 + bj * 128 + wc * 32 + fq * 8, acc[ai][bj][m][0], acc[ai][bj][m][1]);
            }
    }
};
template <class F> __device__ __forceinline__ void run_pg8x8(const bf16_t* A, const bf16_t* Bt, int M, int N, int K, unsigned char* lds, F f) {
    pg8::Gemm g{A, Bt, M, N, K};
    pg8::StaticOrder S; S.init(M, N, gridDim.x, vblock());
    EpiF8<F> E{f};
    pg8::gemm_phase<EpiF8<F>, pg8::StaticOrder, true, true>((PG8_LAS unsigned char*)lds, g, S, E);
}
template <class F> __device__ __forceinline__ void run_pg8(const bf16_t* A, const bf16_t* Bt, int M, int N, int K, unsigned char* lds, F f) {
    pg8::Gemm g{A, Bt, M, N, K};
    pg8::StaticOrder S; S.init(M, N, gridDim.x, vblock());
    EpiF4<F> E{f};
    pg8::gemm_phase<EpiF4<F>, pg8::StaticOrder, true, true>((PG8_LAS unsigned char*)lds, g, S, E);
}
__device__ __forceinline__ void unpack4(uint2 w, float (&g)[4]) {
    g[0] = __uint_as_float(w.x << 16); g[1] = __uint_as_float(w.x & 0xffff0000u); g[2] = __uint_as_float(w.y << 16); g[3] = __uint_as_float(w.y & 0xffff0000u);
}

struct LoadKNF32 {
    const float* base; int ld, kq, nq;
    f32x4 regs[8];
    template <class CF> __device__ __forceinline__ void init(const float* w, int ld_, CF colfn) {
        const int tid = opaque_tid(); kq = tid >> 6; nq = tid & 63; ld = ld_;
        base = w + (size_t)(kq * 8) * ld_ + colfn(nq * 4);
    }
    __device__ __forceinline__ void load(int k0) {
#pragma unroll
        for (int j = 0; j < 8; ++j) regs[j] = *(const f32x4*)(base + (size_t)(k0 + j) * ld);
    }
    __device__ __forceinline__ void store1(unsigned char* lds, int nn, float a0, float a1, float a2, float a3, float a4, float a5, float a6, float a7) const {
        uint4 o; o.x = pk_bf16(a0, a1); o.y = pk_bf16(a2, a3); o.z = pk_bf16(a4, a5); o.w = pk_bf16(a6, a7);
        const int row = nq * 4 + nn;
        *(uint4*)(lds + row * LROW + ((kq ^ swz(row)) << 4)) = o;
    }
    __device__ __forceinline__ void store(unsigned char* lds) const {
        store1(lds, 0, regs[0].x, regs[1].x, regs[2].x, regs[3].x, regs[4].x, regs[5].x, regs[6].x, regs[7].x);
        store1(lds, 1, regs[0].y, regs[1].y, regs[2].y, regs[3].y, regs[4].y, regs[5].y, regs[6].y, regs[7].y);
        store1(lds, 2, regs[0].z, regs[1].z, regs[2].z, regs[3].z, regs[4].z, regs[5].z, regs[6].z, regs[7].z);
        store1(lds, 3, regs[0].w, regs[1].w, regs[2].w, regs[3].w, regs[4].w, regs[5].w, regs[6].w, regs[7].w);
    }
};

template <int BM_, int BN_, int WM_, int WN_> struct GemmCfg {
    static constexpr int BM = BM_, BN = BN_, WM = WM_, WN = WN_;
    static constexpr int TM = BM / WM, TN = BN / WN, MI = TM / 32, NI = TN / 32;
    static constexpr int A_BYTES = BM * LROW, B_BYTES = BN * LROW, STAGE = A_BYTES + B_BYTES;
    static_assert(WM * WN == 8, "8 waves");
};

template <class CFG, class AL, class BL>
__device__ __forceinline__ void gemm_mainloop(AL& al, BL& bl, int nk, f32x16 (&acc)[CFG::MI][CFG::NI], unsigned char* lds) {
    constexpr int MI = CFG::MI, NI = CFG::NI;
    const int tid = opaque_tid(), lane = tid & 63, wid = tid >> 6;
    const int wm = wid / CFG::WN, wn = wid % CFG::WN;
    const int l31 = lane & 31, lh = lane >> 5;
    al.load(0); bl.load(0);
    const int a_off = (wm * CFG::TM + l31) * LROW;
    const int b_off = CFG::A_BYTES + (wn * CFG::TN + l31) * LROW;
    const int fsw = swz(l31);
    for (int kt = 0; kt < nk; ++kt) {
        unsigned char* st = lds + (kt & 1) * CFG::STAGE;
        al.store(st); bl.store(st + CFG::A_BYTES);
        __syncthreads();
        if (kt + 1 < nk) { al.load((kt + 1) * 64); bl.load((kt + 1) * 64); }
#pragma unroll
        for (int kk = 0; kk < 4; ++kk) {
            bf16x8 a[MI], b[NI];
#pragma unroll
            for (int mi = 0; mi < MI; ++mi) a[mi] = *(const bf16x8*)(st + a_off + mi * 32 * LROW + (((kk * 2 + lh) ^ fsw) << 4));
#pragma unroll
            for (int ni = 0; ni < NI; ++ni) b[ni] = *(const bf16x8*)(st + b_off + ni * 32 * LROW + (((kk * 2 + lh) ^ fsw) << 4));
#pragma unroll
            for (int mi = 0; mi < MI; ++mi)
#pragma unroll
                for (int ni = 0; ni < NI; ++ni)
                    acc[mi][ni] = __builtin_amdgcn_mfma_f32_32x32x16_bf16(a[mi], b[ni], acc[mi][ni], 0, 0, 0);
        }
    }
    __syncthreads();
}
template <class CFG, bool A_RES, int ARES_ROT, bool TRANS, class AL, class BL>
__device__ __forceinline__ void gemm_mainloop2(AL (&al)[2], BL (&bl)[2], int nk, f32x16 (&acc)[CFG::MI][CFG::NI], unsigned char* stages, const unsigned char* ares) {
    constexpr int MI = CFG::MI, NI = CFG::NI;
    constexpr int STG = A_RES ? CFG::B_BYTES : CFG::STAGE, BOFF = A_RES ? 0 : CFG::A_BYTES;
    const int tid = opaque_tid(), lane = tid & 63, wid = tid >> 6;
    const int wm = wid / CFG::WN, wn = wid % CFG::WN;
    const int l31 = lane & 31, lh = lane >> 5;
    if (!A_RES) { al[0].load(0); } bl[0].load(0);
    if (!A_RES) { al[1].load(64); } bl[1].load(64);
    const int a_off = (wm * CFG::TM + l31) * LROW;
    const int b_off = BOFF + (wn * CFG::TN + l31) * LROW;
    const int fsw = swz(l31);
    for (int kt = 0; kt < nk; kt += 2) {
#pragma unroll
        for (int u = 0; u < 2; ++u) {
            unsigned char* st = stages + u * STG;
            if (!A_RES) al[u].store(st);
            bl[u].store(st + BOFF);
            __syncthreads();
            if (kt + u + 2 < nk) { if (!A_RES) al[u].load((kt + u + 2) * 64); bl[u].load((kt + u + 2) * 64); }
            const unsigned char* ab = A_RES ? ares + (size_t)((kt + u + ARES_ROT) & 3) * (CFG::BM * LROW) : st;
#pragma unroll
            for (int kk = 0; kk < 4; ++kk) {
                bf16x8 a[MI], b[NI];
#pragma unroll
                for (int mi = 0; mi < MI; ++mi) a[mi] = *(const bf16x8*)(ab + a_off + mi * 32 * LROW + (((kk * 2 + lh) ^ fsw) << 4));
#pragma unroll
                for (int ni = 0; ni < NI; ++ni) b[ni] = *(const bf16x8*)(st + b_off + ni * 32 * LROW + (((kk * 2 + lh) ^ fsw) << 4));
#pragma unroll
                for (int mi = 0; mi < MI; ++mi)
#pragma unroll
                    for (int ni = 0; ni < NI; ++ni)
                        acc[mi][ni] = TRANS ? __builtin_amdgcn_mfma_f32_32x32x16_bf16(b[ni], a[mi], acc[mi][ni], 0, 0, 0)
                                            : __builtin_amdgcn_mfma_f32_32x32x16_bf16(a[mi], b[ni], acc[mi][ni], 0, 0, 0);
            }
        }
    }
    __syncthreads();
}
template <int ROWS, int NSET> struct LoadRowsBf16N {
    static constexpr int NCH = ROWS * 8 / NT;
    typedef unsigned u32x4r __attribute__((ext_vector_type(4)));
    const bf16_t* base; int tid;
    unsigned off[NCH];
    u32x4r regs[NSET][NCH];
    template <class RF> __device__ __forceinline__ void init(const bf16_t* base_, int ld, RF rowfn) {
        base = base_; tid = opaque_tid();
#pragma unroll
        for (int i = 0; i < NCH; ++i) { const int c = tid + i * NT, r = c >> 3, ch = c & 7; off[i] = (unsigned)(rowfn(r) * ld + ch * 8); }
    }
    template <int U> __device__ __forceinline__ void load(int k0) {
#pragma unroll
        for (int i = 0; i < NCH; ++i) regs[U][i] = *(const u32x4r*)(base + (size_t)off[i] + k0);
    }
    template <int U> __device__ __forceinline__ void store(unsigned char* lds) const {
#pragma unroll
        for (int i = 0; i < NCH; ++i) { const int c = tid + i * NT, r = c >> 3, ch = c & 7; *(u32x4r*)(lds + r * LROW + ((ch ^ swz(r)) << 4)) = regs[U][i]; }
    }
};
template <int NSET> struct LoadKNF32N {
    const float* base; int ld, kq, nq;
    f32x4 regs[NSET][8];
    template <class CF> __device__ __forceinline__ void init(const float* w, int ld_, CF colfn) {
        const int tid = opaque_tid(); kq = tid >> 6; nq = tid & 63; ld = ld_;
        base = w + (size_t)(kq * 8) * ld_ + colfn(nq * 4);
    }
    template <int U> __device__ __forceinline__ void load(int k0) {
#pragma unroll
        for (int j = 0; j < 8; ++j) regs[U][j] = *(const f32x4*)(base + (size_t)(k0 + j) * ld);
    }
    template <int U> __device__ __forceinline__ void store(unsigned char* lds) const {
#pragma unroll
        for (int nn = 0; nn < 4; ++nn) {
            uint4 o; o.x = pk_bf16(regs[U][0][nn], regs[U][1][nn]); o.y = pk_bf16(regs[U][2][nn], regs[U][3][nn]);
            o.z = pk_bf16(regs[U][4][nn], regs[U][5][nn]); o.w = pk_bf16(regs[U][6][nn], regs[U][7][nn]);
            const int row = nq * 4 + nn;
            *(uint4*)(lds + row * LROW + ((kq ^ swz(row)) << 4)) = o;
        }
    }
};
template <class CFG, bool TRANS, int U, class AL, class BL>
__device__ __forceinline__ void d3_step(AL& al, BL& bl, int t, int nk, f32x16 (&acc)[CFG::MI][CFG::NI], unsigned char* stages, int a_off, int b_off, int fsw, int lh) {
    constexpr int MI = CFG::MI, NI = CFG::NI, UN = (U + 1) % 3;
    if (t < nk) {
        unsigned char* st = stages + (t & 1) * CFG::STAGE;
        unsigned char* nx = stages + ((t + 1) & 1) * CFG::STAGE;
#pragma unroll
        for (int kk = 0; kk < 4; ++kk) {
            if (kk == 2 && t + 1 < nk) {
                al.template store<UN>(nx); bl.template store<UN>(nx + CFG::A_BYTES);
                if (t + 4 < nk) { al.template load<UN>((t + 4) * 64); bl.template load<UN>((t + 4) * 64); }
            }
            bf16x8 a[MI], b[NI];
#pragma unroll
            for (int mi = 0; mi < MI; ++mi) a[mi] = *(const bf16x8*)(st + a_off + mi * 32 * LROW + (((kk * 2 + lh) ^ fsw) << 4));
#pragma unroll
            for (int ni = 0; ni < NI; ++ni) b[ni] = *(const bf16x8*)(st + b_off + ni * 32 * LROW + (((kk * 2 + lh) ^ fsw) << 4));
#pragma unroll
            for (int mi = 0; mi < MI; ++mi)
#pragma unroll
                for (int ni = 0; ni < NI; ++ni)
                    acc[mi][ni] = TRANS ? __builtin_amdgcn_mfma_f32_32x32x16_bf16(b[ni], a[mi], acc[mi][ni], 0, 0, 0)
                                        : __builtin_amdgcn_mfma_f32_32x32x16_bf16(a[mi], b[ni], acc[mi][ni], 0, 0, 0);
        }
        __syncthreads();
    }
}
template <class CFG, bool TRANS, class AL, class BL>
__device__ __forceinline__ void gemm_mainloop_d3(AL& al, BL& bl, int nk, f32x16 (&acc)[CFG::MI][CFG::NI], unsigned char* stages) {
    const int tid = opaque_tid(), lane = tid & 63, wid = tid >> 6;
    const int wm = wid / CFG::WN, wn = wid % CFG::WN;
    const int l31 = lane & 31, lh = lane >> 5;
    al.template load<0>(0); bl.template load<0>(0);
    al.template load<1>(64); bl.template load<1>(64);
    al.template load<2>(128); bl.template load<2>(128);
    const int a_off = (wm * CFG::TM + l31) * LROW;
    const int b_off = CFG::A_BYTES + (wn * CFG::TN + l31) * LROW;
    const int fsw = swz(l31);
    al.template store<0>(stages); bl.template store<0>(stages + CFG::A_BYTES);
    __syncthreads();
    if (3 < nk) { al.template load<0>(192); bl.template load<0>(192); }
    for (int kt = 0; kt < nk; kt += 3) {
        d3_step<CFG, TRANS, 0>(al, bl, kt, nk, acc, stages, a_off, b_off, fsw, lh);
        d3_step<CFG, TRANS, 1>(al, bl, kt + 1, nk, acc, stages, a_off, b_off, fsw, lh);
        d3_step<CFG, TRANS, 2>(al, bl, kt + 2, nk, acc, stages, a_off, b_off, fsw, lh);
    }
}
template <class CFG> __device__ __forceinline__ void acc_zero(f32x16 (&acc)[CFG::MI][CFG::NI]) {
#pragma unroll
    for (int mi = 0; mi < CFG::MI; ++mi)
#pragma unroll
        for (int ni = 0; ni < CFG::NI; ++ni)
#pragma unroll
            for (int r = 0; r < 16; ++r) acc[mi][ni][r] = 0.f;
}
template <class CFG, class F> __device__ __forceinline__ void acc_foreach(f32x16 (&acc)[CFG::MI][CFG::NI], F f) {
    const int tid = opaque_tid(), lane = tid & 63, wid = tid >> 6;
    const int wm = wid / CFG::WN, wn = wid % CFG::WN;
#pragma unroll
    for (int mi = 0; mi < CFG::MI; ++mi)
#pragma unroll
        for (int ni = 0; ni < CFG::NI; ++ni) {
            asm volatile("" ::: "memory");
#pragma unroll
            for (int r = 0; r < 16; ++r)
                acc[mi][ni][r] = f(wm * CFG::TM + mi * 32 + (r & 3) + 8 * (r >> 2) + 4 * (lane >> 5), wn * CFG::TN + ni * 32 + (lane & 31), acc[mi][ni][r], mi, ni, r);
        }
}

struct TileMap {
    int ntm, ntn, npm, npn, rounds; bool patched;
    int pm, pn;
    __device__ __forceinline__ void init(int ntm_, int ntn_) {
        ntm = ntm_; ntn = ntn_; patched = (gridDim.x == 256);
        pn = ntn >= 8 ? 8 : ntn >= 4 ? 4 : ntn >= 2 ? 2 : 1; pm = 32 / pn;
        if (patched) { npm = (ntm + pm - 1) / pm; npn = (ntn + pn - 1) / pn; rounds = (npm * npn + 7) / 8; }
        else { int G = gridDim.x; asm volatile("" : "+s"(G)); npm = npn = 0; rounds = (ntm * ntn + G - 1) / G; }
    }
    __device__ __forceinline__ bool get(int round, int& tm, int& tn) const {
        const int b = vblock();
        if (patched) {
            const int patch = round * 8 + (b & 7), slot = b >> 3;
            if (patch >= npm * npn) return false;
            tm = (patch / npn) * pm + slot / pn; tn = (patch % npn) * pn + slot % pn;
            return tm < ntm && tn < ntn;
        }
        const int t = round * gridDim.x + b;
        if (t >= ntm * ntn) return false;
        tm = t / ntn; tn = t % ntn; return true;
    }
};

struct ConvJob {
    const f32x4* src; uint4* dst; size_t i, n8, gsz;
    f32x4 a[2][2]; size_t at[2];
    __device__ __forceinline__ void init(const float* s, bf16_t* d, size_t n) {
        src = (const f32x4*)s; dst = (uint4*)d; n8 = n / 8; gsz = (size_t)gridDim.x * NT; i = (size_t)opaque_bid() * NT + opaque_tid(); at[0] = at[1] = n8;
    }
    __device__ __forceinline__ void issue() {
#pragma unroll
        for (int q = 0; q < 2; ++q) { at[q] = i; if (i < n8) { a[q][0] = __builtin_nontemporal_load(src + 2 * i); a[q][1] = __builtin_nontemporal_load(src + 2 * i + 1); i += gsz; } }
    }
    __device__ __forceinline__ void finish() {
#pragma unroll
        for (int q = 0; q < 2; ++q)
            if (at[q] < n8) {
                uint4 o; o.x = pk_bf16(a[q][0][0], a[q][0][1]); o.y = pk_bf16(a[q][0][2], a[q][0][3]); o.z = pk_bf16(a[q][1][0], a[q][1][1]); o.w = pk_bf16(a[q][1][2], a[q][1][3]);
                dst[at[q]] = o; at[q] = n8;
            }
    }
    __device__ __forceinline__ void drain() { while (i < n8) { issue(); finish(); } }
};
template <class CM>
__device__ __forceinline__ void transpose_convert(const float* W, int K, int N, int NP, bf16_t* Wt, float* sm, int& shift, ConvJob& job, CM cmap) {
    const int tid = opaque_tid(), ntk = K / 64, ntn = NP / 64, G = gridDim.x, nt = ntk * ntn;
    int tile = (opaque_bid() + G - shift % G) % G;
    shift += nt;
    float v[8];
#define TC_LOAD(TILE) do { const int tk_ = (TILE) % ntk, tn_ = (TILE) / ntk; \
        _Pragma("unroll") for (int i = 0; i < 8; ++i) { const int e = tid + i * NT, kk = e >> 6, nn = e & 63, col = cmap(tn_ * 64 + nn); \
            v[i] = col >= 0 ? __builtin_nontemporal_load(W + (size_t)(tk_ * 64 + kk) * N + col) : 0.f; } } while (0)
    if (tile < nt) TC_LOAD(tile);
    for (; tile < nt; tile += G) {
        const int tk = tile % ntk, tn = tile / ntk;
        job.issue();
#pragma unroll
        for (int i = 0; i < 8; ++i) { const int e = tid + i * NT, kk = e >> 6, nn = e & 63; sm[nn * 65 + kk] = v[i]; }
        __syncthreads();
        if (tile + G < nt) TC_LOAD(tile + G);
        const int n = tid >> 3, kc = tid & 7;
        const float* r = sm + n * 65 + kc * 8;
        uint4 o; o.x = pk_bf16(r[0], r[1]); o.y = pk_bf16(r[2], r[3]); o.z = pk_bf16(r[4], r[5]); o.w = pk_bf16(r[6], r[7]);
        *(uint4*)(Wt + (size_t)(tn * 64 + n) * K + tk * 64 + kc * 8) = o;
        job.finish();
        __syncthreads();
    }
#undef TC_LOAD
}
__device__ __forceinline__ void transpose_tile_f4(const float* W, int K, int N, bf16_t* Wt, int k0, int n0, float* sm) {
    const int tid = opaque_tid(), kk = tid >> 4, n4 = tid & 15;
#pragma unroll
    for (int h = 0; h < 2; ++h) {
        const int k = kk + 32 * h;
        const f32x4 v = *(const f32x4*)(W + (size_t)(k0 + k) * N + n0 + n4 * 4);
#pragma unroll
        for (int j = 0; j < 4; ++j) sm[(n4 * 4 + j) * 65 + k] = v[j];
    }
    __syncthreads();
    const int n = tid >> 3, kc = tid & 7;
    const float* r = sm + n * 65 + kc * 8;
    uint4 o; o.x = pk_bf16(r[0], r[1]); o.y = pk_bf16(r[2], r[3]); o.z = pk_bf16(r[4], r[5]); o.w = pk_bf16(r[6], r[7]);
    *(uint4*)(Wt + (size_t)(n0 + n) * K + k0 + kc * 8) = o;
    __syncthreads();
}
__device__ __forceinline__ void convert_bf16(const float* src, bf16_t* dst, size_t n) {
    const size_t gtid = (size_t)opaque_bid() * NT + opaque_tid(), gsz = (size_t)gridDim.x * NT;
    for (size_t i = gtid; i < n / 8; i += gsz) {
        const float4 a = ((const float4*)src)[2 * i], b = ((const float4*)src)[2 * i + 1];
        uint4 o; o.x = pk_bf16(a.x, a.y); o.y = pk_bf16(a.z, a.w); o.z = pk_bf16(b.x, b.y); o.w = pk_bf16(b.z, b.w);
        ((uint4*)dst)[i] = o;
    }
}

__device__ __forceinline__ void phase_inproj(const Params& p, unsigned char* lds) {
    pg8::Gemm g{p.xb, p.w_in_t, T, PWP, D};
    pg8::StaticOrder S; S.init(T, PWP, gridDim.x, vblock());
    EpiInproj E{p.qkvraw, p.dzb, p.sq, p.sk, p.vT, p.gab, p.gbb, p.small};
    pg8::gemm_phase<EpiInproj, pg8::StaticOrder, true, true>((PG8_LAS unsigned char*)lds, g, S, E);
}

__device__ __forceinline__ void load_gate16(const bf16_t* gbuf, int rb, int cb, int lane, float (&g)[16]) {
    const uint4* src = (const uint4*)(gbuf + ((size_t)(rb * 32 + cb) * 64 + lane) * 16);
    const uint4 a = src[0], b = src[1];
    const unsigned u[8] = {a.x, a.y, a.z, a.w, b.x, b.y, b.z, b.w};
#pragma unroll
    for (int i = 0; i < 8; ++i) { g[2 * i] = __uint_as_float(u[i] << 16); g[2 * i + 1] = __uint_as_float(u[i] & 0xffff0000u); }
}
__device__ __forceinline__ void phase_merge(const Params& p, unsigned char* lds) {
    typedef unsigned u32x4m __attribute__((ext_vector_type(4)));
    run_pg8x8(p.oab, p.w_pa_t, T, D, DNW, lds, [&](int row, int col, pg8::f32x4 v0, pg8::f32x4 v1) {
        const u32x4m gw = *(const u32x4m*)(p.gab + (size_t)row * D + col);
        float g[8];
#pragma unroll
        for (int i = 0; i < 4; ++i) { g[2 * i] = __uint_as_float(gw[i] << 16); g[2 * i + 1] = __uint_as_float(gw[i] & 0xffff0000u); }
        const u32x4m w = {pk_bf16(v0[0] * g[0], v0[1] * g[1]), pk_bf16(v0[2] * g[2], v0[3] * g[3]), pk_bf16(v1[0] * g[4], v1[1] * g[5]), pk_bf16(v1[2] * g[6], v1[3] * g[7])};
        *(u32x4m*)((bf16_t*)p.m1 + (size_t)row * D + col) = w;
    });
    run_pg8x8(p.obb, p.w_pb_t, T, D, SBW, lds, [&](int row, int col, pg8::f32x4 v0, pg8::f32x4 v1) {
        const u32x4m gw = *(const u32x4m*)(p.gbb + (size_t)row * D + col);
        float g[8];
#pragma unroll
        for (int i = 0; i < 4; ++i) { g[2 * i] = __uint_as_float(gw[i] << 16); g[2 * i + 1] = __uint_as_float(gw[i] & 0xffff0000u); }
        const u32x4m mw = *(const u32x4m*)((const bf16_t*)p.m1 + (size_t)row * D + col);
        const pg8::f32x4 m0 = {__uint_as_float(mw[0] << 16), __uint_as_float(mw[0] & 0xffff0000u), __uint_as_float(mw[1] << 16), __uint_as_float(mw[1] & 0xffff0000u)};
        const pg8::f32x4 m1v = {__uint_as_float(mw[2] << 16), __uint_as_float(mw[2] & 0xffff0000u), __uint_as_float(mw[3] << 16), __uint_as_float(mw[3] & 0xffff0000u)};
        u32x4m w;
        w[0] = pk_bf16(m0[0] + v0[0] * g[0], m0[1] + v0[1] * g[1]); w[1] = pk_bf16(m0[2] + v0[2] * g[2], m0[3] + v0[3] * g[3]);
        w[2] = pk_bf16(m1v[0] + v1[0] * g[4], m1v[1] + v1[1] * g[5]); w[3] = pk_bf16(m1v[2] + v1[2] * g[6], m1v[3] + v1[3] * g[7]);
        *(u32x4m*)(p.mergedb + (size_t)row * D + col) = w;
    });
}

__device__ __forceinline__ void phase_outproj(const Params& p, unsigned char* lds) {
    typedef unsigned u32x4m __attribute__((ext_vector_type(4)));
    run_pg8x8(p.mergedb, p.w_out_t, T, D, D, lds, [&](int row, int col, pg8::f32x4 v0, pg8::f32x4 v1) {
        const size_t o = (size_t)row * D + col;
        const u32x4m w = {pk_bf16(v0[0], v0[1]), pk_bf16(v0[2], v0[3]), pk_bf16(v1[0], v1[1]), pk_bf16(v1[2], v1[3])};
        *(u32x4m*)((bf16_t*)p.pre1 + o) = w;
    });
}

struct EpiRouterSU {
    static constexpr bool PERM = true, AFTER_DRAIN = false;
    float* scores; bf16_t* actsh;
    __device__ __forceinline__ void operator()(const pg8::f32x4 (&acc)[2][2][4][2], const pg8::Unit& u, int wr, int wc, int fr, int fq) const {
        typedef unsigned u32x4m __attribute__((ext_vector_type(4)));
#pragma unroll
        for (int ai = 0; ai < 2; ++ai)
#pragma unroll
            for (int m = 0; m < 4; ++m) {
                const int row = u.pm * 256 + ai * 128 + wr * 64 + m * 16 + fr;
                if (u.pn == 0) {
#pragma unroll
                    for (int bj = 0; bj < 2; ++bj) {
                        pg8::f32x4* d = (pg8::f32x4*)(scores + (size_t)row * NE + bj * 128 + wc * 32 + fq * 8);
#pragma unroll
                        for (int n = 0; n < 2; ++n) {
                            const pg8::f32x4 v = acc[ai][bj][m][n];
                            d[n] = (pg8::f32x4){sigmoidf_(v[0]), sigmoidf_(v[1]), sigmoidf_(v[2]), sigmoidf_(v[3])};
                        }
                    }
                } else {
                    u32x4m w;
#pragma unroll
                    for (int n = 0; n < 2; ++n) {
                        const pg8::f32x4 g = acc[ai][0][m][n], up = acc[ai][1][m][n];
                        w[2 * n] = pk_bf16(siluf_(g[0]) * up[0], siluf_(g[1]) * up[1]); w[2 * n + 1] = pk_bf16(siluf_(g[2]) * up[2], siluf_(g[3]) * up[3]);
                    }
                    *(u32x4m*)(actsh + (size_t)row * SFF + (u.pn - 1) * 128 + wc * 32 + fq * 8) = w;
                }
            }
    }
};
__device__ __forceinline__ void phase_router_shared_up(const Params& p, unsigned char* lds) {
    static_assert(OFF_WSUT == OFF_WROUTT + (size_t)NE * D * 2, "router and shared-up transposed weights are contiguous");
    pg8::Gemm g{p.hb, p.w_router_t, T, NE + 2 * SFF, D};
    pg8::StaticOrder S; S.init(T, NE + 2 * SFF, gridDim.x, vblock());
    EpiRouterSU E{p.scores, p.actsh};
    pg8::gemm_phase<EpiRouterSU, pg8::StaticOrder, true, true>((PG8_LAS unsigned char*)lds, g, S, E);
}

__device__ __forceinline__ void phase_shared_down(const Params& p, unsigned char* lds) {
    typedef unsigned u32x4m __attribute__((ext_vector_type(4)));
    run_pg8x8(p.actsh, p.w_sd_t, T, D, SFF, lds, [&](int row, int col, pg8::f32x4 v0, pg8::f32x4 v1) {
        const u32x4m w = {pk_bf16(v0[0], v0[1]), pk_bf16(v0[2], v0[3]), pk_bf16(v1[0], v1[1]), pk_bf16(v1[2], v1[3])};
        *(u32x4m*)(p.yshb + (size_t)row * D + col) = w;
    });
}

__device__ __forceinline__ void phase_init(const Params& p) {
    const int gtid = opaque_bid() * NT + opaque_tid(), gsz = gridDim.x * NT;
    for (int i = gtid; i < 2 * NE * CSTRIDE; i += gsz) p.counts[i] = 0;
}

__device__ __forceinline__ void sb_attn_wave(const Params& p, int bh, int qt) {
    const int lane = opaque_tid() & 63, l31 = lane & 31, lh = lane >> 5;
    const int b = bh >> 3, hh = bh & 7;
    bf16x8 qf[4];
    {
        const bf16_t* qrow = p.sq + (size_t)(b * SEQ + qt * 32 + l31) * SBW + hh * 64 + lh * 8;
#pragma unroll
        for (int ks = 0; ks < 4; ++ks) qf[ks] = *(const bf16x8*)(qrow + ks * 16);
    }
    f32x16 o0, o1;
#pragma unroll
    for (int r = 0; r < 16; ++r) { o0[r] = 0.f; o1[r] = 0.f; }
    float run = 0.f;
    const bf16_t* vbase = p.vT + ((size_t)(bh * 64 + l31)) * SEQ + lh * 8;
    for (int kt = qt; kt >= 0; --kt) {
        const bf16_t* krow = p.sk + (size_t)(b * SEQ + kt * 32 + l31) * SBW + hh * 64 + lh * 8;
        bf16x8 kf[4];
#pragma unroll
        for (int ks = 0; ks < 4; ++ks) kf[ks] = *(const bf16x8*)(krow + ks * 16);
        bf16x8 vf[2][2];
#pragma unroll
        for (int md = 0; md < 2; ++md)
#pragma unroll
            for (int ss = 0; ss < 2; ++ss) vf[md][ss] = *(const bf16x8*)(vbase + (size_t)md * 32 * SEQ + kt * 32 + ss * 16);
        f32x16 sc;
#pragma unroll
        for (int r = 0; r < 16; ++r) sc[r] = 0.f;
#pragma unroll
        for (int ks = 0; ks < 4; ++ks) sc = __builtin_amdgcn_mfma_f32_32x32x16_bf16(kf[ks], qf[ks], sc, 0, 0, 0);
        float lb[16], lr[16];
        const bool diag = (kt == qt);
#pragma unroll
        for (int r = 0; r < 16; ++r) {
            const float z = sc[r];
            const float l = __builtin_amdgcn_logf(1.f + __builtin_amdgcn_exp2f(-fabsf(z)));
            float b_ = fminf(z, 0.f) - l, r_ = b_ - z;
            if (diag) { const bool valid = ((r & 3) + 8 * (r >> 2) + 4 * lh) < l31; r_ = valid ? r_ : 0.f; b_ = valid ? b_ : -INFINITY; }
            lb[r] = b_; lr[r] = r_;
        }
        float ex[16], B[4];
#pragma unroll
        for (int g = 0; g < 4; ++g) {
            ex[4 * g + 3] = 0.f;
            ex[4 * g + 2] = lr[4 * g + 3];
            ex[4 * g + 1] = ex[4 * g + 2] + lr[4 * g + 2];
            ex[4 * g + 0] = ex[4 * g + 1] + lr[4 * g + 1];
            B[g] = ex[4 * g + 0] + lr[4 * g + 0];
        }
        float P[4];
#pragma unroll
        for (int g = 0; g < 4; ++g) P[g] = shfl_lane(B[g], lane ^ 32);
        float off[4];
        {
            const float p3 = P[3], p2 = P[2] + p3, p1 = P[1] + p2, p0 = P[0] + p1;
            const float b3 = 0.f, b2 = B[3], b1 = B[2] + b2, b0 = B[1] + b1;
            off[0] = b0 + (lh ? p1 : p0);
            off[1] = b1 + (lh ? p2 : p1);
            off[2] = b2 + (lh ? p3 : p2);
            off[3] = b3 + (lh ? 0.f : p3);
            const float total = (B[0] + b0) + p0;
#pragma unroll
            for (int g = 0; g < 4; ++g) off[g] += run;
            run += total;
        }
        float a[16];
#pragma unroll
        for (int r = 0; r < 16; ++r) a[r] = __builtin_amdgcn_exp2f(lb[r] + ex[r] + off[r >> 2]);
        bf16x8 pf[2];
#pragma unroll
        for (int ss = 0; ss < 2; ++ss) {
            typedef unsigned u32x4 __attribute__((ext_vector_type(4)));
            u32x4 w;
            w[0] = pk_bf16(a[8 * ss + 0], a[8 * ss + 1]); w[1] = pk_bf16(a[8 * ss + 2], a[8 * ss + 3]);
            w[2] = pk_bf16(a[8 * ss + 4], a[8 * ss + 5]); w[3] = pk_bf16(a[8 * ss + 6], a[8 * ss + 7]);
            pf[ss] = __builtin_bit_cast(bf16x8, w);
        }
#pragma unroll
        for (int ss = 0; ss < 2; ++ss) {
            o0 = __builtin_amdgcn_mfma_f32_32x32x16_bf16(vf[0][ss], pf[ss], o0, 0, 0, 0);
            o1 = __builtin_amdgcn_mfma_f32_32x32x16_bf16(vf[1][ss], pf[ss], o1, 0, 0, 0);
        }
        if (__all(run < -160.f)) break;
    }
#pragma unroll
    for (int k = 0; k < 8; ++k) {
        auto s0 = __builtin_amdgcn_permlane32_swap(__float_as_uint(o0[k]), __float_as_uint(o0[k + 8]), false, false);
        o0[k] = __uint_as_float(s0[0]); o0[k + 8] = __uint_as_float(s0[1]);
        auto s1 = __builtin_amdgcn_permlane32_swap(__float_as_uint(o1[k]), __float_as_uint(o1[k + 8]), false, false);
        o1[k] = __uint_as_float(s1[0]); o1[k + 8] = __uint_as_float(s1[1]);
    }
    typedef unsigned u32x4o __attribute__((ext_vector_type(4)));
    bf16_t* orow = p.obb + (size_t)(b * SEQ + qt * 32 + l31) * SBW + hh * 64 + 16 * lh;
    {
        u32x4o w;
        w[0] = pk_bf16(o0[0], o0[1]); w[1] = pk_bf16(o0[2], o0[3]); w[2] = pk_bf16(o0[8], o0[9]); w[3] = pk_bf16(o0[10], o0[11]);
        *(u32x4o*)orow = w;
        w[0] = pk_bf16(o0[4], o0[5]); w[1] = pk_bf16(o0[6], o0[7]); w[2] = pk_bf16(o0[12], o0[13]); w[3] = pk_bf16(o0[14], o0[15]);
        *(u32x4o*)(orow + 8) = w;
        w[0] = pk_bf16(o1[0], o1[1]); w[1] = pk_bf16(o1[2], o1[3]); w[2] = pk_bf16(o1[8], o1[9]); w[3] = pk_bf16(o1[10], o1[11]);
        *(u32x4o*)(orow + 32) = w;
        w[0] = pk_bf16(o1[4], o1[5]); w[1] = pk_bf16(o1[6], o1[7]); w[2] = pk_bf16(o1[12], o1[13]); w[3] = pk_bf16(o1[14], o1[15]);
        *(u32x4o*)(orow + 40) = w;
    }
}


constexpr int DN_RW = 0, DN_RQ = 128, DN_RAT = 256, DN_RKD = 320;
constexpr float LOG2E = 1.4426950408889634f;
__device__ __forceinline__ uint4 pack8(const float* v) { uint4 o; o.x = pk_bf16(v[0], v[1]); o.y = pk_bf16(v[2], v[3]); o.z = pk_bf16(v[4], v[5]); o.w = pk_bf16(v[6], v[7]); return o; }

__device__ __forceinline__ void dn_chunk_item(const Params& p, int item, unsigned char* lds) {
    const int tid = opaque_tid(), lane = tid & 63, wid = tid >> 6;
    const int bh = item >> 5, n = item & 31, b = bh >> 2, hh = bh & 3;
    const int t0 = b * SEQ + n * 64;
    unsigned char* Kimg = lds; unsigned char* KBimg = lds + 16384; unsigned char* Qimg = lds + 32768;
    float* Vf = (float*)(lds + 49152); float* KBGf = (float*)(lds + 81920); float* MT = (float*)(lds + 114688);
    float* G2s = (float*)(lds + 114688 + 17408); float* betas = G2s + 64;
    bf16_t* blob = p.dnblob + (size_t)item * DN_BLOB;
    if (wid == 0) {
        const int t = t0 + lane;
        const float da = p.small[(size_t)t * 8 + 4 + hh] + p.dt_bias[hh];
        const float sp = da > 20.f ? da : log1pf(expf(da));
        float g2 = -expf(p.a_log[hh]) * sp * LOG2E;
#pragma unroll
        for (int off = 1; off < 64; off <<= 1) { const float v = shfl_lane(g2, lane - off); if (lane >= off) g2 += v; }
        G2s[lane] = g2; betas[lane] = sigmoidf_(p.small[(size_t)t * 8 + hh]);
        if (lane == 63) p.dnlast[item] = exp2f(g2);
    }
    __syncthreads();
    {
        const int c8 = tid & 15, tq = tid >> 4, j0 = tq * 2;
        const float G0 = G2s[j0], G1 = G2s[j0 + 1], GL = G2s[63];
        const float be[2] = {betas[j0], betas[j0 + 1]};
        const float eg[2] = {exp2f(G0), exp2f(G1)}, el[2] = {exp2f(GL - G0), exp2f(GL - G1)};
        const int half = c8 >> 3, ch = c8 & 7;
#pragma unroll
        for (int type = 0; type < 3; ++type) {
            float o[2][8];
            {
                const bf16_t* src = p.qkvraw + (size_t)(t0 + j0 - 3) * 1536 + type * 512 + hh * 128 + c8 * 8;
                float x[5][8];
#pragma unroll
                for (int r = 0; r < 5; ++r) {
                    uint4 raw = make_uint4(0, 0, 0, 0);
                    if (n > 0 || j0 - 3 + r >= 0) raw = *(const uint4*)(src + (size_t)r * 1536);
                    const unsigned u[4] = {raw.x, raw.y, raw.z, raw.w};
#pragma unroll
                    for (int i = 0; i < 4; ++i) { x[r][2 * i] = __uint_as_float(u[i] << 16); x[r][2 * i + 1] = __uint_as_float(u[i] & 0xffff0000u); }
                }
                const float* wp = p.conv_w + type * 512 + hh * 128 + c8 * 8;
#pragma unroll
                for (int i = 0; i < 8; ++i) {
                    float a0 = 0.f, a1 = 0.f;
#pragma unroll
                    for (int tap = 0; tap < 4; ++tap) { const float w = wp[tap * 1536 + i]; a0 = fmaf(x[tap][i], w, a0); a1 = fmaf(x[tap + 1][i], w, a1); }
                    o[0][i] = siluf_(a0); o[1][i] = siluf_(a1);
                }
            }
            if (type < 2) {
#pragma unroll
                for (int tk = 0; tk < 2; ++tk) {
                    float ss = 0.f;
#pragma unroll
                    for (int i = 0; i < 8; ++i) ss = fmaf(o[tk][i], o[tk][i], ss);
                    ss += shfl_lane(ss, lane ^ 1); ss += shfl_lane(ss, lane ^ 2); ss += shfl_lane(ss, lane ^ 4); ss += shfl_lane(ss, lane ^ 8);
                    float r = rsqrtf(ss + NORM_EPS);
                    if (type == 0) r *= 0.08838834764831845f;
#pragma unroll
                    for (int i = 0; i < 8; ++i) o[tk][i] *= r;
                }
            }
#pragma unroll
            for (int tk = 0; tk < 2; ++tk) {
                const int j = j0 + tk;
                const int ioff = half * 8192 + j * 128 + ((ch ^ swz(j)) << 4);
                if (type == 0) {
                    *(uint4*)(Qimg + ioff) = pack8(o[tk]);
                    float qd[8];
#pragma unroll
                    for (int i = 0; i < 8; ++i) qd[i] = o[tk][i] * eg[tk];
                    bf16_t* qrow = blob + (size_t)(DN_RQ + half * 64 + j) * 64 + ((c8 >> 1) & 3) * 16 + 4 * (c8 & 1);
                    uint2 w0, w1; w0.x = pk_bf16(qd[0], qd[1]); w0.y = pk_bf16(qd[2], qd[3]); w1.x = pk_bf16(qd[4], qd[5]); w1.y = pk_bf16(qd[6], qd[7]);
                    *(uint2*)qrow = w0; *(uint2*)(qrow + 8) = w1;
                } else if (type == 1) {
                    float kb[8], kbg[8];
#pragma unroll
                    for (int i = 0; i < 8; ++i) { kb[i] = o[tk][i] * be[tk]; kbg[i] = kb[i] * eg[tk]; }
                    *(uint4*)(Kimg + ioff) = pack8(o[tk]);
                    *(uint4*)(KBimg + ioff) = pack8(kb);
                    f32x4* kd = (f32x4*)(KBGf + j * 128 + c8 * 8); kd[0] = (f32x4){kbg[0], kbg[1], kbg[2], kbg[3]}; kd[1] = (f32x4){kbg[4], kbg[5], kbg[6], kbg[7]};
                } else {
                    float vb[8];
#pragma unroll
                    for (int i = 0; i < 8; ++i) vb[i] = o[tk][i] * be[tk];
                    f32x4* vd = (f32x4*)(Vf + j * 128 + c8 * 8); vd[0] = (f32x4){vb[0], vb[1], vb[2], vb[3]}; vd[1] = (f32x4){vb[4], vb[5], vb[6], vb[7]};
                }
            }
            if (type == 1) {
                const int jp = (j0 & 48) | pi16(j0 & 15);
#pragma unroll
                for (int i = 0; i < 8; ++i)
                    *(unsigned*)(blob + (size_t)(DN_RKD + c8 * 8 + i) * 64 + jp) = pk_bf16(o[0][i] * el[0], o[1][i] * el[1]);
            }
        }
    }
    __syncthreads();
    {
        const int which = wid >> 2, ti = (wid >> 1) & 1, tj = wid & 1, l31 = lane & 31, lh = lane >> 5;
        if (!(ti == 0 && tj == 1)) {
            const unsigned char* Ab = (which == 0 ? KBimg : Qimg) + (ti * 32 + l31) * 128;
            const unsigned char* Bb = Kimg + (tj * 32 + l31) * 128;
            const int fsw = swz(l31);
            f32x16 acc;
#pragma unroll
            for (int r = 0; r < 16; ++r) acc[r] = 0.f;
#pragma unroll
            for (int ks = 0; ks < 8; ++ks) {
                const int off = (ks >> 2) * 8192 + ((((ks & 3) * 2 + lh) ^ fsw) << 4);
                acc = __builtin_amdgcn_mfma_f32_32x32x16_bf16(*(const bf16x8*)(Ab + off), *(const bf16x8*)(Bb + off), acc, 0, 0, 0);
            }
            const int j = tj * 32 + l31;
            const float Gj = G2s[j];
#pragma unroll
            for (int r = 0; r < 16; ++r) {
                const int i = ti * 32 + (r & 3) + 8 * (r >> 2) + 4 * lh;
                const float v = acc[r] * exp2f(G2s[i] - Gj);
                if (which == 0) MT[j * 68 + i] = (i > j) ? v : 0.f;
                else blob[(size_t)(DN_RAT + i) * 64 + ((j & 48) | pi16(j & 15))] = to_bf16((i >= j) ? v : 0.f);
            }
        }
    }
    __syncthreads();
#ifndef NO_SOLVE
    if (tid < 256) {
        const int c = tid & 127;
        const float* rhs = (tid < 128 ? Vf : KBGf) + c;
        typedef float f32x2 __attribute__((ext_vector_type(2)));
        f32x2 y2[32];
#pragma unroll
        for (int j = 0; j < 32; ++j) y2[j] = (f32x2){rhs[(2 * j) * 128], rhs[(2 * j + 1) * 128]};
#pragma unroll
        for (int j = 0; j < 63; ++j) {
            const float yj = y2[j >> 1][j & 1];
            const f32x2 nyj = {-yj, -yj};
#pragma unroll
            for (int i4 = (j + 1) & ~3; i4 < 64; i4 += 4) {
                const f32x4 m = *(const f32x4*)(MT + j * 68 + i4);
                y2[i4 >> 1] = __builtin_elementwise_fma((f32x2){m[0], m[1]}, nyj, y2[i4 >> 1]);
                y2[(i4 >> 1) + 1] = __builtin_elementwise_fma((f32x2){m[2], m[3]}, nyj, y2[(i4 >> 1) + 1]);
            }
            asm volatile("" ::: "memory");
        }
        float y[64];
#pragma unroll
        for (int j = 0; j < 32; ++j) { y[2 * j] = y2[j][0]; y[2 * j + 1] = y2[j][1]; }
        if (tid < 128) {
#pragma unroll
            for (int mi = 0; mi < 2; ++mi)
#pragma unroll
                for (int h = 0; h < 2; ++h) {
                    f32x4* dst = (f32x4*)(p.dnu + ((((size_t)item * 2 + mi) * 4 + (c >> 5)) * 64 + h * 32 + (c & 31)) * 16);
#pragma unroll
                    for (int g = 0; g < 4; ++g)
                        dst[g] = (f32x4){y[mi * 32 + 8 * g + 4 * h], y[mi * 32 + 8 * g + 4 * h + 1], y[mi * 32 + 8 * g + 4 * h + 2], y[mi * 32 + 8 * g + 4 * h + 3]};
                }
        } else {
            bf16_t* dst = blob + (size_t)(DN_RW + (c >> 6) * 64) * 64 + ((c & 48) | pi16(c & 15));
#pragma unroll
            for (int i = 0; i < 64; ++i) dst[(size_t)i * 64] = to_bf16(-y[i]);
        }
    }
#endif
    __syncthreads();
}

__device__ __forceinline__ void phase_dn_chunks(const Params& p, unsigned char* lds) {
    for (int item = blockIdx.x; item < NB * DNH * 32; item += gridDim.x) dn_chunk_item(p, item, lds);
}

__device__ __forceinline__ void dn_scan(const Params& p, int bh, unsigned char* lds) {
    const int tid = opaque_tid(), lane = tid & 63, wid = tid >> 6, l31 = lane & 31, lh = lane >> 5;
    const int b = bh >> 2, hh = bh & 3;
    const int fsw = swz(l31);
    if (wid >= 4) {
        const int lt = tid - 256;
        typedef unsigned u32x4v __attribute__((ext_vector_type(4)));
        const u32x4v* src = (const u32x4v*)(p.dnblob + (size_t)(bh * 32) * DN_BLOB) + lt;
        u32x4v lr[14];
#define DN_LOAD(n_) { _Pragma("unroll") for (int k = 0; k < 14; ++k) lr[k] = src[(size_t)(n_) * (DN_BLOB / 8) + k * 256]; }
#define DN_STORE(dst_) { _Pragma("unroll") for (int k = 0; k < 14; ++k) { const int c = lt + k * 256, row = c >> 3, ch = c & 7; \
            *(u32x4v*)((dst_) + row * 128 + ((ch ^ swz(row)) << 4)) = lr[k]; } }
        DN_LOAD(0); DN_STORE(lds); DN_LOAD(1);
        __builtin_amdgcn_s_waitcnt(0xc07f);
        __builtin_amdgcn_s_barrier();
        for (int n = 0; n < 32; ++n) {
            if (n + 1 < 32) { DN_STORE(lds + ((n + 1) & 1) * (DN_ROWS * 128)); if (n + 2 < 32) DN_LOAD(n + 2); }
            __builtin_amdgcn_s_waitcnt(0xc07f);
            __builtin_amdgcn_s_barrier();
        }
#undef DN_LOAD
#undef DN_STORE
        return;
    }
    __builtin_amdgcn_s_barrier();
    f32x16 S[4];
#pragma unroll
    for (int t = 0; t < 4; ++t)
#pragma unroll
        for (int r = 0; r < 16; ++r) S[t][r] = 0.f;
    typedef const __attribute__((address_space(1))) f32x16* gf16p;
    typedef __attribute__((address_space(1))) float* gfp;
    f32x16 vn[2];
#pragma unroll
    for (int mi = 0; mi < 2; ++mi) vn[mi] = *(gf16p)(unsigned long long)(p.dnu + ((((size_t)(bh * 32) * 2 + mi) * 4 + wid) * 64 + lane) * 16);
    const int lastv = __float_as_int(*(const __attribute__((address_space(1))) float*)(unsigned long long)(p.dnlast + bh * 32 + (lane & 31)));
    for (int n = 0; n < 32; ++n) {
        {
            const unsigned char* buf = lds + (n & 1) * (DN_ROWS * 128);
            const int item = bh * 32 + n;
            f32x16 oa[2];
#pragma unroll
            for (int mi = 0; mi < 2; ++mi)
#pragma unroll
                for (int r = 0; r < 16; ++r) oa[mi][r] = 0.f;
            const float last = __int_as_float(__builtin_amdgcn_readlane(lastv, n));
            typedef unsigned u32x4 __attribute__((ext_vector_type(4)));
            bf16x8 sb[4][2];
#pragma unroll
            for (int t = 0; t < 4; ++t)
#pragma unroll
                for (int ss = 0; ss < 2; ++ss) {
                    u32x4 w;
#pragma unroll
                    for (int q = 0; q < 4; ++q) w[q] = pk_bf16(S[t][8 * ss + 2 * q], S[t][8 * ss + 2 * q + 1]);
                    sb[t][ss] = __builtin_bit_cast(bf16x8, w);
                }
            bf16x8 fw[2][2][2], fq[2][2][2];
#define DN_RD1(BUF, G) { _Pragma("unroll") for (int mi = 0; mi < 2; ++mi) { _Pragma("unroll") for (int kk = 0; kk < 2; ++kk) { \
                    const int ks = 2 * (G) + kk; \
                    const int off = ((ks >> 2) * 64 + mi * 32 + l31) * 128 + ((((ks & 3) * 2 + lh) ^ fsw) << 4); \
                    fw[BUF][mi][kk] = *(const bf16x8*)(buf + DN_RW * 128 + off); \
                    fq[BUF][mi][kk] = *(const bf16x8*)(buf + DN_RQ * 128 + off); } } }
            DN_RD1(0, 0);
#pragma unroll
            for (int g = 0; g < 4; ++g) {
                if (g + 1 < 4) { if ((g & 1) == 0) { DN_RD1(1, g + 1); } else { DN_RD1(0, g + 1); } }
                __builtin_amdgcn_sched_barrier(0);
#pragma unroll
                for (int kk = 0; kk < 2; ++kk)
#pragma unroll
                    for (int mi = 0; mi < 2; ++mi) {
                        vn[mi] = __builtin_amdgcn_mfma_f32_32x32x16_bf16(fw[g & 1][mi][kk], sb[g][kk], vn[mi], 0, 0, 0);
                        oa[mi] = __builtin_amdgcn_mfma_f32_32x32x16_bf16(fq[g & 1][mi][kk], sb[g][kk], oa[mi], 0, 0, 0);
                    }
                __builtin_amdgcn_sched_barrier(0);
            }
#undef DN_RD1
            bf16x8 vb[2][2];
#pragma unroll
            for (int mj = 0; mj < 2; ++mj)
#pragma unroll
                for (int ss = 0; ss < 2; ++ss) {
                    u32x4 w;
#pragma unroll
                    for (int q = 0; q < 4; ++q) w[q] = pk_bf16(vn[mj][8 * ss + 2 * q], vn[mj][8 * ss + 2 * q + 1]);
                    vb[mj][ss] = __builtin_bit_cast(bf16x8, w);
                }
            {
                const int nx = (n + 1 < 32) ? item + 1 : item;
#pragma unroll
                for (int mi = 0; mi < 2; ++mi) vn[mi] = *(gf16p)(unsigned long long)(p.dnu + ((((size_t)nx * 2 + mi) * 4 + wid) * 64 + lane) * 16);
            }
#pragma unroll
            for (int t = 0; t < 4; ++t)
#pragma unroll
                for (int r = 0; r < 16; ++r) S[t][r] *= last;
            {
                bf16x8 fa[6];
#pragma unroll
                for (int i = 0; i < 6; ++i) {
                    const int mi = i < 2 ? 0 : 1, kj = i < 2 ? i : i - 2;
                    fa[i] = *(const bf16x8*)(buf + (DN_RAT + mi * 32 + l31) * 128 + (((kj * 2 + lh) ^ fsw) << 4));
                }
                __builtin_amdgcn_sched_barrier(0);
#pragma unroll
                for (int i = 0; i < 6; ++i) {
                    const int mi = i < 2 ? 0 : 1, kj = i < 2 ? i : i - 2;
                    oa[mi] = __builtin_amdgcn_mfma_f32_32x32x16_bf16(fa[i], vb[kj >> 1][kj & 1], oa[mi], 0, 0, 0);
                }
                __builtin_amdgcn_sched_barrier(0);
            }
#pragma unroll
            for (int tp = 0; tp < 2; ++tp) {
                bf16x8 fk[2][4];
#pragma unroll
                for (int tt = 0; tt < 2; ++tt)
#pragma unroll
                    for (int kj = 0; kj < 4; ++kj)
                        fk[tt][kj] = *(const bf16x8*)(buf + (DN_RKD + (2 * tp + tt) * 32 + l31) * 128 + (((kj * 2 + lh) ^ fsw) << 4));
                __builtin_amdgcn_sched_barrier(0);
#pragma unroll
                for (int kj = 0; kj < 4; ++kj)
#pragma unroll
                    for (int tt = 0; tt < 2; ++tt)
                        S[2 * tp + tt] = __builtin_amdgcn_mfma_f32_32x32x16_bf16(fk[tt][kj], vb[kj >> 1][kj & 1], S[2 * tp + tt], 0, 0, 0);
                __builtin_amdgcn_sched_barrier(0);
            }
            gfp orow = (gfp)(unsigned long long)(p.oraw + (size_t)(b * SEQ + n * 64) * DNW + hh * 128 + wid * 32 + l31);
#pragma unroll
            for (int mi = 0; mi < 2; ++mi)
#pragma unroll
                for (int r = 0; r < 16; ++r) orow[(size_t)(mi * 32 + (r & 3) + 8 * (r >> 2) + 4 * lh) * DNW] = oa[mi][r];
        }
        __builtin_amdgcn_s_waitcnt(0xc07f);
        __builtin_amdgcn_s_barrier();
    }
}

__device__ __forceinline__ void phase_mixers(const Params& p, float* smem) {
    const int nscan = NB * DNH;
    if (gridDim.x >= 2 * nscan) {
#ifndef SKIP_SCAN
#ifndef RSCAN
#define RSCAN 1
#define RATT 1
#endif
        if ((int)blockIdx.x < nscan) { int rs_ = RSCAN; asm volatile("" : "+s"(rs_)); for (int r_ = 0; r_ < rs_; ++r_) dn_scan(p, blockIdx.x, (unsigned char*)smem); }
#endif
        if ((int)blockIdx.x < nscan) {}
        else {
            int ra_ = RATT; asm volatile("" : "+s"(ra_));
            const int stride_ = gridDim.x - nscan; const bool flip_ok = (stride_ & 7) == 0;
            for (int r_ = 0; r_ < ra_; ++r_) {
                int rnd = 0;
                for (int it = blockIdx.x - nscan; it < 512; it += stride_, ++rnd) {
                    int g = it & 7; if (flip_ok && (rnd & 1)) g = 7 - g;
                    sb_attn_wave(p, it >> 3, g * 8 + (opaque_tid() >> 6));
                }
            }
        }
    } else {
#ifndef SKIP_SCAN
        for (int bh = blockIdx.x; bh < nscan; bh += gridDim.x) dn_scan(p, bh, (unsigned char*)smem);
#endif
        for (int it = blockIdx.x; it < 512; it += gridDim.x) sb_attn_wave(p, it >> 3, (it & 7) * 8 + (opaque_tid() >> 6));
    }
}

__device__ __forceinline__ void phase_gated_norm(const Params& p) {
    typedef unsigned u32x4r __attribute__((ext_vector_type(4)));
    const int lane = opaque_tid() & 63, wave = (opaque_bid() * NT + opaque_tid()) >> 6, nw = (gridDim.x * NT) >> 6;
    const int c0 = lane * 8, cg = (lane & 15) * 8;
    float gg[8];
    { const f32x4 g0 = *(const f32x4*)(p.norm_g + cg), g1 = *(const f32x4*)(p.norm_g + cg + 4);
#pragma unroll
      for (int i = 0; i < 4; ++i) { gg[i] = g0[i]; gg[4 + i] = g1[i]; } }
    for (int t0 = wave * 2; t0 < T; t0 += nw * 2) {
        f32x4 va[2], vb[2]; u32x4r z[2];
#pragma unroll
        for (int q = 0; q < 2; ++q) {
            const size_t off = (size_t)(t0 + q) * DNW + c0;
            va[q] = *(const f32x4*)(p.oraw + off); vb[q] = *(const f32x4*)(p.oraw + off + 4);
            z[q] = *(const u32x4r*)(p.dzb + off);
        }
#pragma unroll
        for (int q = 0; q < 2; ++q) {
            float v[8];
#pragma unroll
            for (int i = 0; i < 4; ++i) { v[i] = va[q][i]; v[4 + i] = vb[q][i]; }
            float ss = 0.f;
#pragma unroll
            for (int i = 0; i < 8; ++i) ss += v[i] * v[i];
            ss += shfl_lane(ss, lane ^ 1); ss += shfl_lane(ss, lane ^ 2); ss += shfl_lane(ss, lane ^ 4); ss += shfl_lane(ss, lane ^ 8);
            const float r = rsqrtf(ss * (1.f / 128.f) + NORM_EPS);
            u32x4r o;
#pragma unroll
            for (int i = 0; i < 4; ++i) {
                const float z0 = __uint_as_float(z[q][i] << 16), z1 = __uint_as_float(z[q][i] & 0xffff0000u);
                o[i] = pk_bf16(v[2 * i] * r * gg[2 * i] * siluf_(z0), v[2 * i + 1] * r * gg[2 * i + 1] * siluf_(z1));
            }
            *(u32x4r*)(p.oab + (size_t)(t0 + q) * DNW + c0) = o;
        }
    }
}

__device__ __forceinline__ void add_bf16x16(const bf16_t* src, float sc, float (&v)[16]) {
    typedef unsigned u32x4r __attribute__((ext_vector_type(4)));
    const u32x4r a = ((const u32x4r*)src)[0], b = ((const u32x4r*)src)[1];
#pragma unroll
    for (int i = 0; i < 4; ++i) {
        v[2 * i] += sc * __uint_as_float(a[i] << 16); v[2 * i + 1] += sc * __uint_as_float(a[i] & 0xffff0000u);
        v[8 + 2 * i] += sc * __uint_as_float(b[i] << 16); v[8 + 2 * i + 1] += sc * __uint_as_float(b[i] & 0xffff0000u);
    }
}
template <bool NT_LOAD = false>
__device__ __forceinline__ void add_bf16x8(const bf16_t* src, float sc, float* v) {
    typedef unsigned u32x4r __attribute__((ext_vector_type(4)));
    const u32x4r a = NT_LOAD ? __builtin_nontemporal_load((const u32x4r*)src) : *(const u32x4r*)src;
#pragma unroll
    for (int i = 0; i < 4; ++i) { v[2 * i] += sc * __uint_as_float(a[i] << 16); v[2 * i + 1] += sc * __uint_as_float(a[i] & 0xffff0000u); }
}
template <class SF>
__device__ __forceinline__ void layer_norm_rows(SF sf, const float* g, const float* bb, float* dst, bf16_t* dstb) {
    const int lane = opaque_tid() & 63, wave = (opaque_bid() * NT + opaque_tid()) >> 6, nw = (gridDim.x * NT) >> 6;
    float gg[16], be[16];
#pragma unroll
    for (int h = 0; h < 2; ++h)
#pragma unroll
        for (int i = 0; i < 2; ++i) {
            const f32x4 x = *(const f32x4*)(g + h * 512 + lane * 8 + 4 * i), y = *(const f32x4*)(bb + h * 512 + lane * 8 + 4 * i);
#pragma unroll
            for (int j = 0; j < 4; ++j) { gg[h * 8 + 4 * i + j] = x[j]; be[h * 8 + 4 * i + j] = y[j]; }
        }
    for (int t = wave; t < T; t += nw) {
        float v[16];
#pragma unroll
        for (int i = 0; i < 16; ++i) v[i] = 0.f;
        sf(t, lane * 8, v);
        sf(t, 512 + lane * 8, v + 8);
        float s = 0.f;
#pragma unroll
        for (int i = 0; i < 16; ++i) s += v[i];
        const float mu = wave_sum(s, lane) * (1.f / 1024.f);
        float q = 0.f;
#pragma unroll
        for (int i = 0; i < 16; ++i) { const float d = v[i] - mu; q += d * d; }
        const float rstd = rsqrtf(wave_sum(q, lane) * (1.f / 1024.f) + LN_EPS);
        float y[16];
#pragma unroll
        for (int i = 0; i < 16; ++i) y[i] = (v[i] - mu) * rstd * gg[i] + be[i];
#pragma unroll
        for (int h = 0; h < 2; ++h) {
            const size_t o = (size_t)t * D + h * 512 + lane * 8;
            if (dst) {
                *(f32x4*)(dst + o) = (f32x4){y[8 * h], y[8 * h + 1], y[8 * h + 2], y[8 * h + 3]};
                *(f32x4*)(dst + o + 4) = (f32x4){y[8 * h + 4], y[8 * h + 5], y[8 * h + 6], y[8 * h + 7]};
            }
            if (dstb) {
                typedef unsigned u32x4r __attribute__((ext_vector_type(4)));
                *(u32x4r*)(dstb + o) = (u32x4r){pk_bf16(y[8 * h], y[8 * h + 1]), pk_bf16(y[8 * h + 2], y[8 * h + 3]), pk_bf16(y[8 * h + 4], y[8 * h + 5]), pk_bf16(y[8 * h + 6], y[8 * h + 7])};
            }
        }
    }
}

__device__ __forceinline__ void phase_route(const Params& p, int* counts, int* explist, int* ldsw) {
    const int tid = opaque_tid(), lane = tid & 63;
    const int wave = (opaque_bid() * NT + tid) >> 6, nw = (gridDim.x * NT) >> 6;
    int* mye = ldsw + (tid >> 6) * 64;
    const f32x4 bias = *(const f32x4*)(p.router_bias + lane * 4);
    for (int t0 = wave; t0 < T; t0 += nw * 8) {
        f32x4 scs[8];
#pragma unroll
        for (int k = 0; k < 8; ++k) { const int t = t0 + k * nw; scs[k] = t < T ? *(const f32x4*)(p.scores + (size_t)t * NE + lane * 4) : (f32x4){0.f, 0.f, 0.f, 0.f}; }
#pragma unroll 1
        for (int kb = 0; kb < 8; kb += 4) {
            f32x4 sc4[4]; unsigned ku[4][4]; unsigned v8[4];
#pragma unroll
            for (int q = 0; q < 4; ++q) {
                f32x4 sc = scs[0];
#pragma unroll
                for (int kk = 1; kk < 8; ++kk) sc = (kb + q == kk) ? scs[kk] : sc;
                sc4[q] = sc;
                const float sel[4] = {sc[0] + bias[0], sc[1] + bias[1], sc[2] + bias[2], sc[3] + bias[3]};
                float m1 = fmaxf(sel[0], sel[1]), m2 = fminf(sel[0], sel[1]);
                m2 = fmaxf(m2, fminf(m1, sel[2])); m1 = fmaxf(m1, sel[2]);
                m2 = fmaxf(m2, fminf(m1, sel[3])); m1 = fmaxf(m1, sel[3]);
#pragma unroll
                for (int off = 1; off < 8; off <<= 1) {
                    const float o1 = shfl_lane(m1, lane ^ off), o2 = shfl_lane(m2, lane ^ off);
                    const float n2 = fmaxf(fminf(m1, o1), fmaxf(m2, o2));
                    m1 = fmaxf(m1, o1); m2 = n2;
                }
                const float gs = m1 + m2;
                const int g = lane >> 3;
                int rank = 0;
#pragma unroll
                for (int gg = 0; gg < NG; ++gg) { const float og = __int_as_float(__builtin_amdgcn_readlane(__float_as_int(gs), gg * 8)); rank += (og > gs || (og == gs && gg < g)) ? 1 : 0; }
                const bool gsel = rank < TOPG;
#pragma unroll
                for (int i = 0; i < 4; ++i) {
                    const unsigned u = __float_as_uint(sel[i]);
                    ku[q][i] = gsel ? ((u & 0x80000000u) ? ~u : (u | 0x80000000u)) : 0u;
                }
                v8[q] = 0u;
            }
#pragma unroll 1
            for (int bit = 31; bit >= 0; --bit) {
#pragma unroll
                for (int q = 0; q < 4; ++q) {
                    const unsigned cand = v8[q] | (1u << bit);
                    const int c = __popcll(__ballot(ku[q][0] >= cand)) + __popcll(__ballot(ku[q][1] >= cand)) + __popcll(__ballot(ku[q][2] >= cand)) + __popcll(__ballot(ku[q][3] >= cand));
                    if (c >= TOPK) v8[q] = cand;
                }
            }
#pragma unroll
            for (int q = 0; q < 4; ++q) {
                const int k = kb + q, t = t0 + k * nw;
                const f32x4 sc = sc4[q];
                int ngt = 0, eqlow = 0, sellow = 0;
                unsigned long long eqm[4];
#pragma unroll
                for (int i = 0; i < 4; ++i) { ngt += __popcll(__ballot(ku[q][i] > v8[q])); eqm[i] = __ballot(ku[q][i] == v8[q]); }
                const int need = TOPK - ngt;
#pragma unroll
                for (int i = 0; i < 4; ++i) eqlow += __builtin_amdgcn_mbcnt_hi((unsigned)(eqm[i] >> 32), __builtin_amdgcn_mbcnt_lo((unsigned)eqm[i], 0u));
                bool selc[4]; int eqrank = eqlow;
#pragma unroll
                for (int i = 0; i < 4; ++i) {
                    const bool eq = ku[q][i] == v8[q];
                    selc[i] = (ku[q][i] > v8[q]) || (eq && eqrank < need);
                    eqrank += eq ? 1 : 0;
                }
                float part = 0.f;
#pragma unroll
                for (int i = 0; i < 4; ++i) {
                    const unsigned long long sm = __ballot(selc[i]);
                    part += selc[i] ? sc[i] : 0.f;
                    sellow += __builtin_amdgcn_mbcnt_hi((unsigned)(sm >> 32), __builtin_amdgcn_mbcnt_lo((unsigned)sm, 0u));
                }
                const float wsum = wave_sum(part, lane);
                int slot = sellow;
                if (t < T) {
#pragma unroll
                    for (int i = 0; i < 4; ++i)
                        if (selc[i]) {
                            const int e = lane * 4 + i, pr = t * TOPK + slot;
                            p.gate[pr] = sc[i] / wsum * 2.5f;
                            mye[k * 8 + slot] = e;
                            ++slot;
                        }
                }
            }
        }
        {
            const int k = lane >> 3, t = t0 + k * nw;
            if (t < T) {
                const int e = mye[lane], pos = atomicAdd(&counts[e * CSTRIDE], 1);
                explist[(size_t)e * ECAP + pos] = t * TOPK + (lane & 7);
            }
        }
    }
}

__device__ __forceinline__ void compute_pend(const Params& p, int* pend, int* cnt) {
    const int tid = opaque_tid();
    if (tid < 64) {
        int c[4], pc[4];
#pragma unroll
        for (int i = 0; i < 4; ++i) { c[i] = p.counts[(tid * 4 + i) * CSTRIDE]; cnt[tid * 4 + i] = c[i]; pc[i] = (c[i] + 127) / 128 * 128; }
        const int ssum = pc[0] + pc[1] + pc[2] + pc[3];
        int inc = ssum;
#pragma unroll
        for (int off = 1; off < 64; off <<= 1) { const int v = shfl_lane_i(inc, tid - off); if (tid >= off) inc += v; }
        int run = inc - ssum;
#pragma unroll
        for (int i = 0; i < 4; ++i) { run += pc[i]; pend[tid * 4 + i] = run; }
    }
    __syncthreads();
}

__device__ __forceinline__ int expert_of_row(const int* pend, int row) {
    int lo = 0, hi = NE - 1;
    while (lo < hi) { const int mid = (lo + hi) >> 1; if (pend[mid] > row) hi = mid; else lo = mid + 1; }
    return lo;
}

__device__ __forceinline__ void phase_routed(const Params& p, int* pend, int* cnt, unsigned char* lds) {
    typedef GemmCfg<128, 256, 2, 4> CFG;
    compute_pend(p, pend, cnt);
    int* prs = (int*)(lds + 131072); float* gts = (float*)(lds + 131072 + 512);
    const bool grouped = (gridDim.x % 8) == 0;
    const int vb = vblock();
    const int xg = grouped ? (vb & 7) : 0, estep = grouped ? 8 : 1;
    const int nslots = grouped ? (gridDim.x >> 3) : gridDim.x;
    int widx = grouped ? (vb >> 3) : vb, tbase = 0;
    for (int e = xg; e < NE; e += estep) {
      const int ce = cnt[e], ntile = (ce + 127) >> 7;
      for (; widx < tbase + ntile; widx += nslots) {
        const int q0 = (widx - tbase) * 128;
        {
            const int tid = opaque_tid();
            if (tid < 128) {
                const int pr = (q0 + tid < ce) ? p.explist[(size_t)e * ECAP + q0 + tid] : -1;
                prs[tid] = pr; gts[tid] = pr >= 0 ? p.gate[pr] : 0.f;
            }
        }
        __syncthreads();
#pragma unroll 1
        for (int tn_ = 0; tn_ < 2 * RU; ++tn_) {
            const int tn = tn_ & 1;
            LoadRowsBf16N<128, 3> al; LoadKNF32N<3> bl;
            al.init(p.hb, D, [&](int r) { const int pr = prs[r]; return (long long)(pr >= 0 ? (pr >> 3) : 0); });
            bl.init(p.w_eu + (size_t)e * D * (2 * EFF), 2 * EFF, [&](int r) { return ((r >> 5) & 1) * EFF + tn * 128 + (r >> 6) * 32 + (r & 31); });
            f32x16 acc[CFG::MI][CFG::NI];
            acc_zero<CFG>(acc);
            gemm_mainloop_d3<CFG, false>(al, bl, D / 64, acc, lds);
            const int tid = opaque_tid(), lane = tid & 63, wid = tid >> 6, wm = wid / CFG::WN, wn = wid % CFG::WN;
            const int j = tn * 128 + wn * 32 + (lane & 31);
            unsigned char* img = lds + 65536 + (((j >> 6) + 2) & 3) * 16384 + (j & 7) * 2;
            const int jc = (j & 63) >> 3;
#pragma unroll
            for (int mi = 0; mi < CFG::MI; ++mi)
#pragma unroll
                for (int r = 0; r < 16; ++r) {
                    const int row = wm * CFG::TM + mi * 32 + (r & 3) + 8 * (r >> 2) + 4 * (lane >> 5);
                    *(bf16_t*)(img + row * 128 + ((jc ^ swz(row)) << 4)) = to_bf16(siluf_(acc[mi][0][r]) * acc[mi][1][r]);
                }
        }
        __syncthreads();
#pragma unroll 1
        for (int tn_ = 0; tn_ < 4 * RD; ++tn_) {
            const int tn = tn_ & 3;
            LoadRowsBf16<128> aldummy[2]; LoadKNF32 bl[2];
#pragma unroll
            for (int u = 0; u < 2; ++u) bl[u].init(p.w_ed + (size_t)e * EFF * D, D, [&](int r) { return tn * 256 + r; });
            f32x16 acc[CFG::MI][CFG::NI];
            acc_zero<CFG>(acc);
            gemm_mainloop2<CFG, true, 2, true>(aldummy, bl, EFF / 64, acc, lds, lds + 65536);
            {
                const int tid = opaque_tid(), lane = tid & 63, wid = tid >> 6, wm = wid / CFG::WN, wn = wid % CFG::WN;
#pragma unroll
                for (int mi = 0; mi < CFG::MI; ++mi) {
                    const int row = wm * CFG::TM + mi * 32 + (lane & 31);
                    const int pr = prs[row]; const float g = gts[row];
                    if (pr >= 0) {
#pragma unroll
                        for (int ni = 0; ni < CFG::NI; ++ni) {
                            bf16_t* dst = p.ypairb + (size_t)pr * D + tn * 256 + wn * CFG::TN + ni * 32 + 4 * (lane >> 5);
#pragma unroll
                            for (int gq = 0; gq < 4; ++gq) {
                                uint2 w; w.x = pk_bf16(acc[mi][ni][4 * gq] * g, acc[mi][ni][4 * gq + 1] * g); w.y = pk_bf16(acc[mi][ni][4 * gq + 2] * g, acc[mi][ni][4 * gq + 3] * g);
                                *(uint2*)(dst + 8 * gq) = w;
                            }
                        }
                    }
                }
            }
        }
        __syncthreads();
      }
      tbase += ntile;
    }
}

#define RW_BAR() do { __builtin_amdgcn_s_waitcnt(0xc07f); __builtin_amdgcn_s_barrier(); } while (0)
__device__ __forceinline__ void phase_routed_ws(const Params& p, int* pend, int* cnt, unsigned char* lds) {
    compute_pend(p, pend, cnt);
    const int tid = opaque_tid(), lane = tid & 63, wid = tid >> 6;
    const bool grouped = (gridDim.x % 8) == 0;
    const int vb = __builtin_amdgcn_readfirstlane(vblock());
    const int xg = grouped ? (vb & 7) : 0, estep = grouped ? 8 : 1;
    const int nslots = grouped ? (gridDim.x >> 3) : gridDim.x;
    const int widx0 = grouped ? (vb >> 3) : vb;
    typedef unsigned u32x4v __attribute__((ext_vector_type(4)));
    if (wid >= 4) {
        const int lt = tid - 256, kq = lt >> 6, nq = lt & 63, arow = lt >> 3, ach = lt & 7;
        u32x4v ra[2][4]; f32x4 rb[2][16];
        const int r4 = nq * 4, upcol = ((r4 >> 6) & 1) * EFF + (r4 >> 7) * 64 + ((r4 >> 5) & 1) * 32 + (r4 & 31);
#define RW_GLD(DST, VOFF, SBASE) asm volatile("global_load_dwordx4 %0, %1, %2" : "=v"(DST) : "v"(VOFF), "s"(SBASE))
#define RW_WAIT_A(S, N) asm volatile("s_waitcnt vmcnt(" #N ")" : "+v"(ra[S][0]), "+v"(ra[S][1]), "+v"(ra[S][2]), "+v"(ra[S][3]))
#define RW_WAIT_B(S, H, N) asm volatile("s_waitcnt vmcnt(" #N ")" \
            : "+v"(rb[S][H * 8 + 0]), "+v"(rb[S][H * 8 + 1]), "+v"(rb[S][H * 8 + 2]), "+v"(rb[S][H * 8 + 3]), \
              "+v"(rb[S][H * 8 + 4]), "+v"(rb[S][H * 8 + 5]), "+v"(rb[S][H * 8 + 6]), "+v"(rb[S][H * 8 + 7]))
#define RW_UNIT(u_) const int uu = (u_); const bool up_ = uu < 32; const int dd_ = uu - 32; \
            const int tn = up_ ? (uu >> 4) : (dd_ >> 2), k0 = (up_ ? (uu & 15) : (dd_ & 3)) * 64; \
            const float* wb_ = up_ ? wu : wd; \
            const unsigned step_ = up_ ? (unsigned)(2 * EFF * 4) : (unsigned)(D * 4); \
            const unsigned q0_ = up_ ? (unsigned)(((k0 + kq * 8) * (2 * EFF) + upcol + tn * 128) * 4) : (unsigned)(((k0 + kq * 8) * D + tn * 256 + r4) * 4)
#define RW_LD_A(S, u_) do { RW_UNIT(u_); (void)wb_; (void)step_; (void)q0_; \
            _Pragma("unroll") for (int i = 0; i < 4; ++i) { const unsigned a_ = up_ ? aoff[i] + k0 * 2 : 0u; RW_GLD(ra[S][i], a_, hbb); } } while (0)
#define RW_LD_B(S, H, u_) do { RW_UNIT(u_); \
            unsigned q_ = q0_ + (unsigned)(32 * H) * step_; asm volatile("" : "+v"(q_)); \
            _Pragma("unroll") for (int j = 0; j < 8; ++j) { RW_GLD(rb[S][H * 8 + j], q_, wb_); q_ += step_; asm volatile("" : "+v"(q_)); } } while (0)
#define RW_LOAD(S, u_) do { RW_LD_A(S, u_); RW_LD_B(S, 0, u_); RW_LD_B(S, 1, u_); } while (0)
#define RW_ST_A(S, u_) do { const int uu = (u_); \
            if (uu < 32) { unsigned char* sa_ = lds + (uu & 1) * 49152 + ast0;     \
                _Pragma("unroll") for (int i = 0; i < 4; ++i) *(u32x4v*)(sa_ + i * 4096) = ra[S][i]; } } while (0)
#define RW_ST_B(S, H, u_) do { const int uu = (u_); \
            unsigned char* sb_ = (uu < 32) ? lds + (uu & 1) * 49152 + 16384 : lds + ((uu - 32) & 1) * 32768; \
            unsigned t_ = bst0; asm volatile("" : "+v"(t_));     \
            _Pragma("unroll") for (int nn = 0; nn < 4; ++nn) { \
                const u32x4v o = {pk_bf16(rb[S][H * 8][nn], rb[S][H * 8 + 1][nn]), pk_bf16(rb[S][H * 8 + 2][nn], rb[S][H * 8 + 3][nn]), \
                                  pk_bf16(rb[S][H * 8 + 4][nn], rb[S][H * 8 + 5][nn]), pk_bf16(rb[S][H * 8 + 6][nn], rb[S][H * 8 + 7][nn])}; \
                *(u32x4v*)(sb_ + (t_ ^ (unsigned)(H * 64 + (nn >> 1) * 16)) + nn * 128) = o; } } while (0)
#define RW_SLOT(S, X, NA, NB0, NB1, NEXT) do { \
            RW_WAIT_A(S, NA); RW_ST_A(S, X); if (NEXT) RW_LD_A(S, (X) + 2); \
            RW_WAIT_B(S, 0, NB0); RW_ST_B(S, 0, X); if (NEXT) RW_LD_B(S, 0, (X) + 2); \
            RW_WAIT_B(S, 1, NB1); RW_ST_B(S, 1, X); if (NEXT) RW_LD_B(S, 1, (X) + 2); } while (0)
#define RW_SLOTX(S, X, XR) do { \
            RW_WAIT_A(S, 36); RW_ST_A(S, X); RW_LD_A(S, XR); \
            RW_WAIT_B(S, 0, 32); RW_ST_B(S, 0, X); RW_LD_B(S, 0, XR); \
            RW_WAIT_B(S, 1, 32); RW_ST_B(S, 1, X); RW_LD_B(S, 1, XR); } while (0)
        const unsigned ast0 = (unsigned)(arow * 128 + ((ach ^ swz(arow)) << 4)), bst0 = (unsigned)(r4 * 128 + ((kq ^ (nq & 7)) << 4));
#define TW_SEEK(e_, tb_, w_) while (e_ < NE) { const int nt_ = (__builtin_amdgcn_readfirstlane(cnt[e_]) + 127) >> 7; if (w_ < tb_ + nt_) break; tb_ += nt_; e_ += estep; }
        int e = xg, tbase = 0, widx = widx0;
        TW_SEEK(e, tbase, widx);
        if (e < NE) {
            unsigned aoff[4];
            const float *wu, *wd;
            const bf16_t* hbb = p.hb;
            {
                const int ce = __builtin_amdgcn_readfirstlane(cnt[e]), q0 = (widx - tbase) * 128;
#pragma unroll
                for (int i = 0; i < 4; ++i) {
                    const int row = arow + 32 * i;
                    const int pr = (q0 + row < ce) ? p.explist[(size_t)e * ECAP + q0 + row] : -1;
                    aoff[i] = (unsigned)((pr >= 0 ? (pr >> 3) : 0) * D + ach * 8) * 2u;
                }
                const int eu_ = __builtin_amdgcn_readfirstlane(e);
                wu = p.w_eu + (size_t)eu_ * D * (2 * EFF);
                wd = p.w_ed + (size_t)eu_ * EFF * D;
            }
            RW_LOAD(0, 0); RW_LOAD(1, 1);
            for (;;) {
                int e2 = e, tb2 = tbase, w2 = widx + nslots;
                TW_SEEK(e2, tb2, w2);
                const bool has_next = e2 < NE;
                const int ce2 = has_next ? __builtin_amdgcn_readfirstlane(cnt[e2]) : 0, q02 = (w2 - tb2) * 128;
                RW_SLOT(0, 0, 36, 32, 32, true);
                RW_BAR();
#pragma unroll 1
                for (int u = 0; u < 44; u += 2) {
                    if (u == 32) RW_BAR();
                    RW_SLOT(1, u + 1, 36, 32, 32, true);
                    RW_BAR();
                    RW_SLOT(0, u + 2, 36, 32, 32, true);
                    RW_BAR();
                }
                int prn[4];
                const int* exb = p.explist;
#pragma unroll
                for (int i = 0; i < 4; ++i) {
                    const int row = arow + 32 * i;
                    const unsigned off_ = (has_next && q02 + row < ce2) ? (unsigned)(e2 * ECAP + q02 + row) * 4u : 0u;
                    asm volatile("global_load_dword %0, %1, %2" : "=v"(prn[i]) : "v"(off_), "s"(exb));
                }
                RW_SLOT(1, 45, 36, 32, 32, true);
                RW_BAR();
                asm volatile("s_waitcnt vmcnt(20)" : "+v"(prn[0]), "+v"(prn[1]), "+v"(prn[2]), "+v"(prn[3]));
                if (has_next) {
#pragma unroll
                    for (int i = 0; i < 4; ++i) {
                        const int row = arow + 32 * i;
                        const int pr = (q02 + row < ce2) ? prn[i] : -1;
                        aoff[i] = (unsigned)((pr >= 0 ? (pr >> 3) : 0) * D + ach * 8) * 2u;
                    }
                    const int eu_ = __builtin_amdgcn_readfirstlane(e2);
                    wu = p.w_eu + (size_t)eu_ * D * (2 * EFF);
                    wd = p.w_ed + (size_t)eu_ * EFF * D;
                }
                RW_SLOTX(0, 46, 0);
                RW_BAR();
                RW_SLOTX(1, 47, 1);
                RW_BAR();
                RW_BAR();
                if (!has_next) break;
                e = e2; tbase = tb2; widx = w2;
            }
            asm volatile("s_waitcnt vmcnt(0)" ::: "memory");
        }
#undef TW_SEEK
#undef RW_LOAD
        return;
    }
#define CU_ASM_UP_FIRST \
        "ds_read_b128 %[qx0], %[xa0]\n" \
        "ds_read_b128 %[qy0], %[ya0]\n" \
        "ds_read_b128 %[qy1], %[ya0] offset:4096\n" \
        "ds_read_b128 %[qy2], %[ya0] offset:8192\n" \
        "ds_read_b128 %[qy3], %[ya0] offset:12288\n" \
        "ds_read_b128 %[qx1], %[xa0] offset:4096\n" \
        "ds_read_b128 %[px0], %[xa1]\n" \
        "ds_read_b128 %[py0], %[ya1]\n" \
        "ds_read_b128 %[py1], %[ya1] offset:4096\n" \
        "ds_read_b128 %[py2], %[ya1] offset:8192\n" \
        "ds_read_b128 %[py3], %[ya1] offset:12288\n" \
        "ds_read_b128 %[px1], %[xa1] offset:4096\n" \
        "s_waitcnt lgkmcnt(6)\n" \
        "v_mfma_f32_32x32x16_bf16 %[c00], %[qx0], %[qy0], %[c00]\n" \
        "v_mfma_f32_32x32x16_bf16 %[c01], %[qx0], %[qy1], %[c01]\n" \
        "v_mfma_f32_32x32x16_bf16 %[c02], %[qx0], %[qy2], %[c02]\n" \
        "v_mfma_f32_32x32x16_bf16 %[c03], %[qx0], %[qy3], %[c03]\n" \
        "ds_read_b128 %[qx0], %[xa2]\n" \
        "v_mfma_f32_32x32x16_bf16 %[c10], %[qx1], %[qy0], %[c10]\n" \
        "ds_read_b128 %[qy0], %[ya2]\n" \
        "v_mfma_f32_32x32x16_bf16 %[c11], %[qx1], %[qy1], %[c11]\n" \
        "ds_read_b128 %[qy1], %[ya2] offset:4096\n" \
        "v_mfma_f32_32x32x16_bf16 %[c12], %[qx1], %[qy2], %[c12]\n" \
        "ds_read_b128 %[qy2], %[ya2] offset:8192\n" \
        "v_mfma_f32_32x32x16_bf16 %[c13], %[qx1], %[qy3], %[c13]\n" \
        "ds_read_b128 %[qy3], %[ya2] offset:12288\n" \
        "ds_read_b128 %[qx1], %[xa2] offset:4096\n" \
        "s_waitcnt lgkmcnt(6)\n" \
        "v_mfma_f32_32x32x16_bf16 %[c00], %[px0], %[py0], %[c00]\n" \
        "v_mfma_f32_32x32x16_bf16 %[c01], %[px0], %[py1], %[c01]\n" \
        "v_mfma_f32_32x32x16_bf16 %[c02], %[px0], %[py2], %[c02]\n" \
        "v_mfma_f32_32x32x16_bf16 %[c03], %[px0], %[py3], %[c03]\n" \
        "ds_read_b128 %[px0], %[xa3]\n" \
        "v_mfma_f32_32x32x16_bf16 %[c10], %[px1], %[py0], %[c10]\n" \
        "ds_read_b128 %[py0], %[ya3]\n" \
        "v_mfma_f32_32x32x16_bf16 %[c11], %[px1], %[py1], %[c11]\n" \
        "ds_read_b128 %[py1], %[ya3] offset:4096\n" \
        "v_mfma_f32_32x32x16_bf16 %[c12], %[px1], %[py2], %[c12]\n" \
        "ds_read_b128 %[py2], %[ya3] offset:8192\n" \
        "v_mfma_f32_32x32x16_bf16 %[c13], %[px1], %[py3], %[c13]\n" \
        "ds_read_b128 %[py3], %[ya3] offset:12288\n" \
        "ds_read_b128 %[px1], %[xa3] offset:4096\n" \
        "s_waitcnt lgkmcnt(6)\n" \
        "v_mfma_f32_32x32x16_bf16 %[c00], %[qx0], %[qy0], %[c00]\n" \
        "v_mfma_f32_32x32x16_bf16 %[c01], %[qx0], %[qy1], %[c01]\n" \
        "v_mfma_f32_32x32x16_bf16 %[c02], %[qx0], %[qy2], %[c02]\n" \
        "v_mfma_f32_32x32x16_bf16 %[c03], %[qx0], %[qy3], %[c03]\n" \
        "v_mfma_f32_32x32x16_bf16 %[c10], %[qx1], %[qy0], %[c10]\n" \
        "v_mfma_f32_32x32x16_bf16 %[c11], %[qx1], %[qy1], %[c11]\n" \
        "v_mfma_f32_32x32x16_bf16 %[c12], %[qx1], %[qy2], %[c12]\n" \
        "v_mfma_f32_32x32x16_bf16 %[c13], %[qx1], %[qy3], %[c13]\n" \
        "s_waitcnt lgkmcnt(0)\n" \
        "s_barrier\n"
#define CU_ASM_UP \
        "v_mfma_f32_32x32x16_bf16 %[c00], %[px0], %[py0], %[c00]\n" \
        "ds_read_b128 %[qx0], %[xa0]\n" \
        "ds_read_b128 %[qy0], %[ya0]\n" \
        "v_mfma_f32_32x32x16_bf16 %[c01], %[px0], %[py1], %[c01]\n" \
        "ds_read_b128 %[qy1], %[ya0] offset:4096\n" \
        "ds_read_b128 %[qy2], %[ya0] offset:8192\n" \
        "v_mfma_f32_32x32x16_bf16 %[c02], %[px0], %[py2], %[c02]\n" \
        "ds_read_b128 %[qy3], %[ya0] offset:12288\n" \
        "ds_read_b128 %[qx1], %[xa0] offset:4096\n" \
        "v_mfma_f32_32x32x16_bf16 %[c03], %[px0], %[py3], %[c03]\n" \
        "ds_read_b128 %[px0], %[xa1]\n" \
        "v_mfma_f32_32x32x16_bf16 %[c10], %[px1], %[py0], %[c10]\n" \
        "ds_read_b128 %[py0], %[ya1]\n" \
        "v_mfma_f32_32x32x16_bf16 %[c11], %[px1], %[py1], %[c11]\n" \
        "ds_read_b128 %[py1], %[ya1] offset:4096\n" \
        "v_mfma_f32_32x32x16_bf16 %[c12], %[px1], %[py2], %[c12]\n" \
        "ds_read_b128 %[py2], %[ya1] offset:8192\n" \
        "v_mfma_f32_32x32x16_bf16 %[c13], %[px1], %[py3], %[c13]\n" \
        "ds_read_b128 %[py3], %[ya1] offset:12288\n" \
        "ds_read_b128 %[px1], %[xa1] offset:4096\n" \
        "s_waitcnt lgkmcnt(6)\n" \
        "v_mfma_f32_32x32x16_bf16 %[c00], %[qx0], %[qy0], %[c00]\n" \
        "v_mfma_f32_32x32x16_bf16 %[c01], %[qx0], %[qy1], %[c01]\n" \
        "v_mfma_f32_32x32x16_bf16 %[c02], %[qx0], %[qy2], %[c02]\n" \
        "v_mfma_f32_32x32x16_bf16 %[c03], %[qx0], %[qy3], %[c03]\n" \
        "ds_read_b128 %[qx0], %[xa2]\n" \
        "v_mfma_f32_32x32x16_bf16 %[c10], %[qx1], %[qy0], %[c10]\n" \
        "ds_read_b128 %[qy0], %[ya2]\n" \
        "v_mfma_f32_32x32x16_bf16 %[c11], %[qx1], %[qy1], %[c11]\n" \
        "ds_read_b128 %[qy1], %[ya2] offset:4096\n" \
        "v_mfma_f32_32x32x16_bf16 %[c12], %[qx1], %[qy2], %[c12]\n" \
        "ds_read_b128 %[qy2], %[ya2] offset:8192\n" \
        "v_mfma_f32_32x32x16_bf16 %[c13], %[qx1], %[qy3], %[c13]\n" \
        "ds_read_b128 %[qy3], %[ya2] offset:12288\n" \
        "ds_read_b128 %[qx1], %[xa2] offset:4096\n" \
        "s_waitcnt lgkmcnt(6)\n" \
        "v_mfma_f32_32x32x16_bf16 %[c00], %[px0], %[py0], %[c00]\n" \
        "v_mfma_f32_32x32x16_bf16 %[c01], %[px0], %[py1], %[c01]\n" \
        "v_mfma_f32_32x32x16_bf16 %[c02], %[px0], %[py2], %[c02]\n" \
        "v_mfma_f32_32x32x16_bf16 %[c03], %[px0], %[py3], %[c03]\n" \
        "ds_read_b128 %[px0], %[xa3]\n" \
        "v_mfma_f32_32x32x16_bf16 %[c10], %[px1], %[py0], %[c10]\n" \
        "ds_read_b128 %[py0], %[ya3]\n" \
        "v_mfma_f32_32x32x16_bf16 %[c11], %[px1], %[py1], %[c11]\n" \
        "ds_read_b128 %[py1], %[ya3] offset:4096\n" \
        "v_mfma_f32_32x32x16_bf16 %[c12], %[px1], %[py2], %[c12]\n" \
        "ds_read_b128 %[py2], %[ya3] offset:8192\n" \
        "v_mfma_f32_32x32x16_bf16 %[c13], %[px1], %[py3], %[c13]\n" \
        "ds_read_b128 %[py3], %[ya3] offset:12288\n" \
        "ds_read_b128 %[px1], %[xa3] offset:4096\n" \
        "s_waitcnt lgkmcnt(6)\n" \
        "v_mfma_f32_32x32x16_bf16 %[c00], %[qx0], %[qy0], %[c00]\n" \
        "v_mfma_f32_32x32x16_bf16 %[c01], %[qx0], %[qy1], %[c01]\n" \
        "v_mfma_f32_32x32x16_bf16 %[c02], %[qx0], %[qy2], %[c02]\n" \
        "v_mfma_f32_32x32x16_bf16 %[c03], %[qx0], %[qy3], %[c03]\n" \
        "v_mfma_f32_32x32x16_bf16 %[c10], %[qx1], %[qy0], %[c10]\n" \
        "v_mfma_f32_32x32x16_bf16 %[c11], %[qx1], %[qy1], %[c11]\n" \
        "v_mfma_f32_32x32x16_bf16 %[c12], %[qx1], %[qy2], %[c12]\n" \
        "v_mfma_f32_32x32x16_bf16 %[c13], %[qx1], %[qy3], %[c13]\n" \
        "s_waitcnt lgkmcnt(0)\n" \
        "s_barrier\n"
#define CU_ASM_DN_FIRST \
        "ds_read_b128 %[qx0], %[xa0]\n" \
        "ds_read_b128 %[qy0], %[ya0]\n" \
        "ds_read_b128 %[qy1], %[ya0] offset:4096\n" \
        "ds_read_b128 %[qy2], %[ya0] offset:8192\n" \
        "ds_read_b128 %[qy3], %[ya0] offset:12288\n" \
        "ds_read_b128 %[qx1], %[xa0] offset:4096\n" \
        "ds_read_b128 %[px0], %[xa1]\n" \
        "ds_read_b128 %[py0], %[ya1]\n" \
        "ds_read_b128 %[py1], %[ya1] offset:4096\n" \
        "ds_read_b128 %[py2], %[ya1] offset:8192\n" \
        "ds_read_b128 %[py3], %[ya1] offset:12288\n" \
        "ds_read_b128 %[px1], %[xa1] offset:4096\n" \
        "s_waitcnt lgkmcnt(6)\n" \
        "v_mfma_f32_32x32x16_bf16 %[c00], %[qy0], %[qx0], %[c00]\n" \
        "v_mfma_f32_32x32x16_bf16 %[c01], %[qy1], %[qx0], %[c01]\n" \
        "v_mfma_f32_32x32x16_bf16 %[c02], %[qy2], %[qx0], %[c02]\n" \
        "v_mfma_f32_32x32x16_bf16 %[c03], %[qy3], %[qx0], %[c03]\n" \
        "ds_read_b128 %[qx0], %[xa2]\n" \
        "v_mfma_f32_32x32x16_bf16 %[c10], %[qy0], %[qx1], %[c10]\n" \
        "ds_read_b128 %[qy0], %[ya2]\n" \
        "v_mfma_f32_32x32x16_bf16 %[c11], %[qy1], %[qx1], %[c11]\n" \
        "ds_read_b128 %[qy1], %[ya2] offset:4096\n" \
        "v_mfma_f32_32x32x16_bf16 %[c12], %[qy2], %[qx1], %[c12]\n" \
        "ds_read_b128 %[qy2], %[ya2] offset:8192\n" \
        "v_mfma_f32_32x32x16_bf16 %[c13], %[qy3], %[qx1], %[c13]\n" \
        "ds_read_b128 %[qy3], %[ya2] offset:12288\n" \
        "ds_read_b128 %[qx1], %[xa2] offset:4096\n" \
        "s_waitcnt lgkmcnt(6)\n" \
        "v_mfma_f32_32x32x16_bf16 %[c00], %[py0], %[px0], %[c00]\n" \
        "v_mfma_f32_32x32x16_bf16 %[c01], %[py1], %[px0], %[c01]\n" \
        "v_mfma_f32_32x32x16_bf16 %[c02], %[py2], %[px0], %[c02]\n" \
        "v_mfma_f32_32x32x16_bf16 %[c03], %[py3], %[px0], %[c03]\n" \
        "ds_read_b128 %[px0], %[xa3]\n" \
        "v_mfma_f32_32x32x16_bf16 %[c10], %[py0], %[px1], %[c10]\n" \
        "ds_read_b128 %[py0], %[ya3]\n" \
        "v_mfma_f32_32x32x16_bf16 %[c11], %[py1], %[px1], %[c11]\n" \
        "ds_read_b128 %[py1], %[ya3] offset:4096\n" \
        "v_mfma_f32_32x32x16_bf16 %[c12], %[py2], %[px1], %[c12]\n" \
        "ds_read_b128 %[py2], %[ya3] offset:8192\n" \
        "v_mfma_f32_32x32x16_bf16 %[c13], %[py3], %[px1], %[c13]\n" \
        "ds_read_b128 %[py3], %[ya3] offset:12288\n" \
        "ds_read_b128 %[px1], %[xa3] offset:4096\n" \
        "s_waitcnt lgkmcnt(6)\n" \
        "v_mfma_f32_32x32x16_bf16 %[c00], %[qy0], %[qx0], %[c00]\n" \
        "v_mfma_f32_32x32x16_bf16 %[c01], %[qy1], %[qx0], %[c01]\n" \
        "v_mfma_f32_32x32x16_bf16 %[c02], %[qy2], %[qx0], %[c02]\n" \
        "v_mfma_f32_32x32x16_bf16 %[c03], %[qy3], %[qx0], %[c03]\n" \
        "v_mfma_f32_32x32x16_bf16 %[c10], %[qy0], %[qx1], %[c10]\n" \
        "v_mfma_f32_32x32x16_bf16 %[c11], %[qy1], %[qx1], %[c11]\n" \
        "v_mfma_f32_32x32x16_bf16 %[c12], %[qy2], %[qx1], %[c12]\n" \
        "v_mfma_f32_32x32x16_bf16 %[c13], %[qy3], %[qx1], %[c13]\n" \
        "s_waitcnt lgkmcnt(0)\n" \
        "s_barrier\n"
#define CU_ASM_DN \
        "v_mfma_f32_32x32x16_bf16 %[c00], %[py0], %[px0], %[c00]\n" \
        "ds_read_b128 %[qx0], %[xa0]\n" \
        "ds_read_b128 %[qy0], %[ya0]\n" \
        "v_mfma_f32_32x32x16_bf16 %[c01], %[py1], %[px0], %[c01]\n" \
        "ds_read_b128 %[qy1], %[ya0] offset:4096\n" \
        "ds_read_b128 %[qy2], %[ya0] offset:8192\n" \
        "v_mfma_f32_32x32x16_bf16 %[c02], %[py2], %[px0], %[c02]\n" \
        "ds_read_b128 %[qy3], %[ya0] offset:12288\n" \
        "ds_read_b128 %[qx1], %[xa0] offset:4096\n" \
        "v_mfma_f32_32x32x16_bf16 %[c03], %[py3], %[px0], %[c03]\n" \
        "ds_read_b128 %[px0], %[xa1]\n" \
        "v_mfma_f32_32x32x16_bf16 %[c10], %[py0], %[px1], %[c10]\n" \
        "ds_read_b128 %[py0], %[ya1]\n" \
        "v_mfma_f32_32x32x16_bf16 %[c11], %[py1], %[px1], %[c11]\n" \
        "ds_read_b128 %[py1], %[ya1] offset:4096\n" \
        "v_mfma_f32_32x32x16_bf16 %[c12], %[py2], %[px1], %[c12]\n" \
        "ds_read_b128 %[py2], %[ya1] offset:8192\n" \
        "v_mfma_f32_32x32x16_bf16 %[c13], %[py3], %[px1], %[c13]\n" \
        "ds_read_b128 %[py3], %[ya1] offset:12288\n" \
        "ds_read_b128 %[px1], %[xa1] offset:4096\n" \
        "s_waitcnt lgkmcnt(6)\n" \
        "v_mfma_f32_32x32x16_bf16 %[c00], %[qy0], %[qx0], %[c00]\n" \
        "v_mfma_f32_32x32x16_bf16 %[c01], %[qy1], %[qx0], %[c01]\n" \
        "v_mfma_f32_32x32x16_bf16 %[c02], %[qy2], %[qx0], %[c02]\n" \
        "v_mfma_f32_32x32x16_bf16 %[c03], %[qy3], %[qx0], %[c03]\n" \
        "ds_read_b128 %[qx0], %[xa2]\n" \
        "v_mfma_f32_32x32x16_bf16 %[c10], %[qy0], %[qx1], %[c10]\n" \
        "ds_read_b128 %[qy0], %[ya2]\n" \
        "v_mfma_f32_32x32x16_bf16 %[c11], %[qy1], %[qx1], %[c11]\n" \
        "ds_read_b128 %[qy1], %[ya2] offset:4096\n" \
        "v_mfma_f32_32x32x16_bf16 %[c12], %[qy2], %[qx1], %[c12]\n" \
        "ds_read_b128 %[qy2], %[ya2] offset:8192\n" \
        "v_mfma_f32_32x32x16_bf16 %[c13], %[qy3], %[qx1], %[c13]\n" \
        "ds_read_b128 %[qy3], %[ya2] offset:12288\n" \
        "ds_read_b128 %[qx1], %[xa2] offset:4096\n" \
        "s_waitcnt lgkmcnt(6)\n" \
        "v_mfma_f32_32x32x16_bf16 %[c00], %[py0], %[px0], %[c00]\n" \
        "v_mfma_f32_32x32x16_bf16 %[c01], %[py1], %[px0], %[c01]\n" \
        "v_mfma_f32_32x32x16_bf16 %[c02], %[py2], %[px0], %[c02]\n" \
        "v_mfma_f32_32x32x16_bf16 %[c03], %[py3], %[px0], %[c03]\n" \
        "ds_read_b128 %[px0], %[xa3]\n" \
        "v_mfma_f32_32x32x16_bf16 %[c10], %[py0], %[px1], %[c10]\n" \
        "ds_read_b128 %[py0], %[ya3]\n" \
        "v_mfma_f32_32x32x16_bf16 %[c11], %[py1], %[px1], %[c11]\n" \
        "ds_read_b128 %[py1], %[ya3] offset:4096\n" \
        "v_mfma_f32_32x32x16_bf16 %[c12], %[py2], %[px1], %[c12]\n" \
        "ds_read_b128 %[py2], %[ya3] offset:8192\n" \
        "v_mfma_f32_32x32x16_bf16 %[c13], %[py3], %[px1], %[c13]\n" \
        "ds_read_b128 %[py3], %[ya3] offset:12288\n" \
        "ds_read_b128 %[px1], %[xa3] offset:4096\n" \
        "s_waitcnt lgkmcnt(6)\n" \
        "v_mfma_f32_32x32x16_bf16 %[c00], %[qy0], %[qx0], %[c00]\n" \
        "v_mfma_f32_32x32x16_bf16 %[c01], %[qy1], %[qx0], %[c01]\n" \
        "v_mfma_f32_32x32x16_bf16 %[c02], %[qy2], %[qx0], %[c02]\n" \
        "v_mfma_f32_32x32x16_bf16 %[c03], %[qy3], %[qx0], %[c03]\n" \
        "v_mfma_f32_32x32x16_bf16 %[c10], %[qy0], %[qx1], %[c10]\n" \
        "v_mfma_f32_32x32x16_bf16 %[c11], %[qy1], %[qx1], %[c11]\n" \
        "v_mfma_f32_32x32x16_bf16 %[c12], %[qy2], %[qx1], %[c12]\n" \
        "v_mfma_f32_32x32x16_bf16 %[c13], %[qy3], %[qx1], %[c13]\n" \
        "s_waitcnt lgkmcnt(0)\n" \
        "s_barrier\n"

#define CU_UNIT_ASM(BODY, PC, XB, YB) do { \
        const unsigned xa0_ = (XB) + co0, xa1_ = (XB) + co1, xa2_ = (XB) + co2, xa3_ = (XB) + co3; \
        const unsigned ya0_ = (YB) + co0, ya1_ = (YB) + co1, ya2_ = (YB) + co2, ya3_ = (YB) + co3; \
        asm volatile(BODY \
            : [c00] "+v"(acc[0][0]), [c01] "+v"(acc[0][1]), [c02] "+v"(acc[0][2]), [c03] "+v"(acc[0][3]), \
              [c10] "+v"(acc[1][0]), [c11] "+v"(acc[1][1]), [c12] "+v"(acc[1][2]), [c13] "+v"(acc[1][3]), \
              [px0] PC(fpx[0]), [px1] PC(fpx[1]), [py0] PC(fpy[0]), [py1] PC(fpy[1]), [py2] PC(fpy[2]), [py3] PC(fpy[3]), \
              [qx0] "=&v"(fqx[0]), [qx1] "=&v"(fqx[1]), [qy0] "=&v"(fqy[0]), [qy1] "=&v"(fqy[1]), [qy2] "=&v"(fqy[2]), [qy3] "=&v"(fqy[3]) \
            : [xa0] "v"(xa0_), [xa1] "v"(xa1_), [xa2] "v"(xa2_), [xa3] "v"(xa3_), [ya0] "v"(ya0_), [ya1] "v"(ya1_), [ya2] "v"(ya2_), [ya3] "v"(ya3_) \
            : "memory"); } while (0)
    const int wm = wid >> 1, wn = wid & 1, l31 = lane & 31, lh = lane >> 5, fsw = swz(l31);
    const int a_off = (wm * 64 + l31) * LROW, b_off = (wn * 128 + l31) * LROW;
    const unsigned lds0 = (unsigned)(size_t)lds;
    const unsigned co0 = (((0 + lh) ^ fsw) << 4), co1 = (((2 + lh) ^ fsw) << 4), co2 = (((4 + lh) ^ fsw) << 4), co3 = (((6 + lh) ^ fsw) << 4);
#define TW_SEEK(e_, tb_, w_) while (e_ < NE) { const int nt_ = (__builtin_amdgcn_readfirstlane(cnt[e_]) + 127) >> 7; if (w_ < tb_ + nt_) break; tb_ += nt_; e_ += estep; }
    int e = xg, tbase = 0, widx = widx0, tcount = 0;
    TW_SEEK(e, tbase, widx);
    int pr_c = -1; float g_c = 0.f;
    if (e < NE && tid < 128) {
        const int ce = __builtin_amdgcn_readfirstlane(cnt[e]), q0 = (widx - tbase) * 128;
        pr_c = (q0 + tid < ce) ? p.explist[(size_t)e * ECAP + q0 + tid] : -1;
        g_c = pr_c >= 0 ? p.gate[pr_c] : 0.f;
    }
    while (e < NE) {
        {
            int e2 = e, tb2 = tbase, w2 = widx + nslots;
            TW_SEEK(e2, tb2, w2);
            const bool has_next = e2 < NE;
            int* prs = (int*)(lds + 131072 + (tcount & 1) * 1024); float* gts = (float*)(prs + 128);
            int pr_n = -1; float g_n = 0.f;
            if (tid < 128) {
                prs[tid] = pr_c; gts[tid] = g_c;
                if (has_next) {
                    const int ce2 = __builtin_amdgcn_readfirstlane(cnt[e2]), q02 = (w2 - tb2) * 128;
                    if (q02 + tid < ce2) pr_n = p.explist[(size_t)e2 * ECAP + q02 + tid];
                }
            }
            RW_BAR();
            f32x16 acc[2][4];
            u32x4v fpx[2], fpy[4], fqx[2], fqy[4];
#pragma unroll 1
            for (int tn = 0; tn < 2; ++tn) {
#pragma unroll
                for (int mi = 0; mi < 2; ++mi)
#pragma unroll
                    for (int ni = 0; ni < 4; ++ni)
#pragma unroll
                        for (int r = 0; r < 16; ++r) acc[mi][ni][r] = 0.f;
#pragma unroll
                for (int i = 0; i < 2; ++i) fpx[i] = u32x4v{0u, 0u, 0u, 0u};
#pragma unroll
                for (int i = 0; i < 4; ++i) fpy[i] = u32x4v{0u, 0u, 0u, 0u};
#pragma unroll 1
                for (int kt = 0; kt < 16; ++kt) {
                    const unsigned xb_ = lds0 + (kt & 1) * 49152 + a_off, yb_ = lds0 + (kt & 1) * 49152 + 16384 + b_off;
                    CU_UNIT_ASM(CU_ASM_UP, "+v", xb_, yb_);
                }
#pragma unroll
                for (int mi = 0; mi < 2; ++mi)
#pragma unroll
                    for (int ni = 0; ni < 4; ++ni)
                        acc[mi][ni] = __builtin_amdgcn_mfma_f32_32x32x16_bf16(__builtin_bit_cast(bf16x8, fpx[mi]), __builtin_bit_cast(bf16x8, fpy[ni]), acc[mi][ni], 0, 0, 0);
#pragma unroll
                for (int hh = 0; hh < 2; ++hh) {
                    const int j = tn * 128 + wn * 64 + hh * 32 + l31;
                    unsigned char* img = lds + 65536 + (((j >> 6) + 2) & 3) * 16384 + (j & 7) * 2;
                    const int jc = (j & 63) >> 3;
#pragma unroll
                    for (int mi = 0; mi < 2; ++mi)
#pragma unroll
                        for (int r = 0; r < 16; ++r) {
                            const int row = wm * 64 + mi * 32 + (r & 3) + 8 * (r >> 2) + 4 * lh;
                            *(bf16_t*)(img + row * 128 + ((jc ^ swz(row)) << 4)) = to_bf16(siluf_(acc[mi][hh][r]) * acc[mi][hh + 2][r]);
                        }
                }
            }
            if (tid < 128 && pr_n >= 0) g_n = p.gate[pr_n];
            RW_BAR();
#pragma unroll 1
            for (int tn = 0; tn < 4; ++tn) {
#pragma unroll
                for (int mi = 0; mi < 2; ++mi)
#pragma unroll
                    for (int ni = 0; ni < 4; ++ni)
#pragma unroll
                        for (int r = 0; r < 16; ++r) acc[mi][ni][r] = 0.f;
#pragma unroll
                for (int i = 0; i < 2; ++i) fpx[i] = u32x4v{0u, 0u, 0u, 0u};
#pragma unroll
                for (int i = 0; i < 4; ++i) fpy[i] = u32x4v{0u, 0u, 0u, 0u};
#pragma unroll 1
                for (int kt = 0; kt < 4; ++kt) {
                    const unsigned xb_ = lds0 + 65536 + ((kt + 2) & 3) * 16384 + a_off, yb_ = lds0 + (kt & 1) * 32768 + b_off;
                    CU_UNIT_ASM(CU_ASM_DN, "+v", xb_, yb_);
                }
#pragma unroll
                for (int mi = 0; mi < 2; ++mi)
#pragma unroll
                    for (int ni = 0; ni < 4; ++ni)
                        acc[mi][ni] = __builtin_amdgcn_mfma_f32_32x32x16_bf16(__builtin_bit_cast(bf16x8, fpy[ni]), __builtin_bit_cast(bf16x8, fpx[mi]), acc[mi][ni], 0, 0, 0);
#pragma unroll
                for (int mi = 0; mi < 2; ++mi)
#pragma unroll
                    for (int ni = 0; ni < 4; ++ni)
#pragma unroll
                        for (int k = 0; k < 8; ++k) {
                            const int ra_ = (k < 4) ? k : k;
                            auto sw = __builtin_amdgcn_permlane32_swap(__float_as_uint(acc[mi][ni][ra_]), __float_as_uint(acc[mi][ni][ra_ + 8]), false, false);
                            acc[mi][ni][ra_] = __uint_as_float(sw[0]); acc[mi][ni][ra_ + 8] = __uint_as_float(sw[1]);
                        }
#pragma unroll
                for (int mi = 0; mi < 2; ++mi) {
                    const int row = wm * 64 + mi * 32 + l31;
                    const int pr = prs[row]; const float g = gts[row];
                    if (pr >= 0) {
#pragma unroll
                        for (int ni = 0; ni < 4; ++ni) {
                            bf16_t* dst = p.ypairb + (size_t)pr * D + tn * 256 + wn * 128 + ni * 32 + 16 * lh;
                            const f32x16 a = acc[mi][ni];
                            u32x4v w0, w1;
                            w0[0] = pk_bf16(a[0] * g, a[1] * g); w0[1] = pk_bf16(a[2] * g, a[3] * g); w0[2] = pk_bf16(a[8] * g, a[9] * g); w0[3] = pk_bf16(a[10] * g, a[11] * g);
                            w1[0] = pk_bf16(a[4] * g, a[5] * g); w1[1] = pk_bf16(a[6] * g, a[7] * g); w1[2] = pk_bf16(a[12] * g, a[13] * g); w1[3] = pk_bf16(a[14] * g, a[15] * g);
                            *(u32x4v*)dst = w0; *(u32x4v*)(dst + 8) = w1;
                        }
                    }
                }
            }
            pr_c = pr_n; g_c = g_n; e = e2; tbase = tb2; widx = w2; ++tcount;
        }
    }
#undef TW_SEEK
}

#ifndef R0
#define R0 1
#define R1 1
#define R2 1
#define R3 1
#define R4 1
#define R5 1
#define R6 1
#define R7 1
#define R8 1
#define R10 1
#define R11 1
#define R12 1
#endif

constexpr int LDS_MAIN = 133120;
__global__ void __launch_bounds__(NT) fwd_megakernel(KArgs ka) {
    __shared__ __attribute__((aligned(16))) unsigned char lds[LDS_MAIN + 2 * NE * 4 + 16 + 256 + 16];
    if (threadIdx.x == 0) *(volatile LAS3 int*)(unsigned long)(WIDTAB_OFF + 256) = blockIdx.x;
    static_assert(WIDTAB_OFF == LDS_MAIN + 2 * NE * 4 + 16, "wave-index table offset");
    if ((threadIdx.x & 63) == 0) *(volatile LAS3 int*)(unsigned long)(WIDTAB_OFF + 4 * hw_wave_slot()) = threadIdx.x >> 6;
    float* smem = (float*)lds;
    int* pend = (int*)(lds + LDS_MAIN);
    int* cnt = pend + NE;
    volatile LAS3 unsigned* xbst = (volatile LAS3 unsigned*)(lds + LDS_MAIN + 2 * NE * 4);
    if (threadIdx.x == 0) { xbst[0] = 0u; xbst[1] = 0u; }
    __syncthreads();
    const XcdBarrier xb = xcd_barrier_post((unsigned*)(ka.ws + OFF_BAR), xbst);

#define REPEAT(N, ...) { int reps_ = (N); asm volatile("" : "+s"(reps_)); for (int rep_ = 0; rep_ < reps_; ++rep_) { { const Params p(ka); __VA_ARGS__; } xcd_barrier(xb); } }
    if (threadIdx.x == 0) xbst[3] = blockIdx.x;
    { const Params p(ka); phase_init(p); }
    REPEAT(R0,
        int tshift = 0; ConvJob job; job.init(p.x, p.xb, (size_t)T * D);
        transpose_convert(p.w_in, D, PW, PWP, p.w_in_t, smem, tshift, job, [](int n) { return n < 2048 ? n : n < 5632 ? n + 8 : n < 5640 ? n - 5632 + 2048 : -1; });
        transpose_convert(p.w_pa, DNW, D, D, p.w_pa_t, smem, tshift, job, [](int n) { return n; });
        transpose_convert(p.w_pb, SBW, D, D, p.w_pb_t, smem, tshift, job, [](int n) { return n; });
        transpose_convert(p.w_out, D, D, D, p.w_out_t, smem, tshift, job, [](int n) { return n; });
        transpose_convert(p.w_router, D, NE, NE, p.w_router_t, smem, tshift, job, [](int n) { return n; });
        transpose_convert(p.w_su, D, 2 * SFF, 2 * SFF, p.w_su_t, smem, tshift, job, [](int n) { return (n & 128) ? SFF + (n >> 8) * 128 + (n & 127) : (n >> 8) * 128 + (n & 127); });
        transpose_convert(p.w_sd, SFF, D, D, p.w_sd_t, smem, tshift, job, [](int n) { return n; });
        job.drain())
    REPEAT(R1, phase_inproj(p, lds))
    REPEAT(R2, phase_dn_chunks(p, lds))
    REPEAT(R3, phase_mixers(p, smem))
    REPEAT(R4, phase_gated_norm(p))
    REPEAT(R5, phase_merge(p, lds))
    REPEAT(R6, phase_outproj(p, lds))
    REPEAT(R7, layer_norm_rows([&](int t, int c, float* v) {
            add_bf16x8((const bf16_t*)p.pre1 + (size_t)t * D + c, 1.f, v);
            _Pragma("unroll") for (int i = 0; i < 2; ++i) { const f32x4 x = __builtin_nontemporal_load((const f32x4*)(p.x + (size_t)t * D + c + 4 * i)); v[4 * i] += ALPHA * x[0]; v[4 * i + 1] += ALPHA * x[1]; v[4 * i + 2] += ALPHA * x[2]; v[4 * i + 3] += ALPHA * x[3]; } },
        p.ln1_g, p.ln1_b, nullptr, p.hb))
    REPEAT(R8, phase_router_shared_up(p, lds))
    { const Params p(ka); phase_route(p, p.counts, p.explist, (int*)lds); }
    xcd_barrier(xb);
    { int reps9 = R9 - 1; asm volatile("" : "+s"(reps9)); for (int r9 = 0; r9 < reps9; ++r9) { const Params p(ka); phase_route(p, p.counts + NE * CSTRIDE, (int*)p.ypairb, (int*)lds); xcd_barrier(xb); } }
    { int repsb = RB; asm volatile("" : "+s"(repsb)); for (int rb = 0; rb < repsb; ++rb) xcd_barrier(xb); }
    REPEAT(R10, phase_routed_ws(p, pend, cnt, lds); __syncthreads(); phase_shared_down(p, lds))
    int reps12 = R12; asm volatile("" : "+s"(reps12));
    for (int rep = 0; rep < reps12; ++rep) {
        const Params p(ka);
        layer_norm_rows([&](int t, int c, float* v) {
                add_bf16x8<true>(p.hb + (size_t)t * D + c, ALPHA, v);
                add_bf16x8<true>(p.yshb + (size_t)t * D + c, 1.f, v);
#pragma unroll
                for (int k = 0; k < TOPK; ++k) add_bf16x8<true>(p.ypairb + ((size_t)t * TOPK + k) * D + c, 1.f, v); },
            p.ln2_g, p.ln2_b, p.out, nullptr);
    }
}

extern "C" void kernel_launch(void* const* d_in, const int* in_sizes, int n_in, void* d_out, int out_size, void* d_ws,
                              size_t ws_size, hipStream_t stream) {
    static int grid_blocks = 0;
    if (!grid_blocks) {
        int dev = 0, cus = 0, per_cu = 0;
        hipGetDevice(&dev);
        hipDeviceGetAttribute(&cus, hipDeviceAttributeMultiprocessorCount, dev);
        hipOccupancyMaxActiveBlocksPerMultiprocessor(&per_cu, fwd_megakernel, NT, 0);
        if (per_cu > 1) per_cu = 1;
        grid_blocks = cus * per_cu;
    }
    KArgs p{};
    const float* const* in = (const float* const*)d_in;
    p.x = in[0]; p.w_in = in[1]; p.conv_w = in[2]; p.a_log = in[3]; p.dt_bias = in[4]; p.norm_g = in[5]; p.w_pa = in[6];
    p.w_pb = in[7]; p.w_out = in[8]; p.ln1_g = in[9]; p.ln1_b = in[10]; p.w_router = in[11]; p.router_bias = in[12];
    p.w_su = in[13]; p.w_sd = in[14]; p.w_eu = in[15]; p.w_ed = in[16]; p.ln2_g = in[17]; p.ln2_b = in[18];
    p.out = (float*)d_out; p.ws = (unsigned char*)d_ws;
    if (WS_BYTES > ws_size) { fprintf(stderr, "workspace too small: need %zu have %zu\n", (size_t)WS_BYTES, ws_size); return; }
    hipMemsetAsync(p.ws + OFF_BAR, 0, XCD_BAR_WORDS * 4, stream);
    void* args[] = {&p};
    hipError_t e = hipLaunchCooperativeKernel((void*)fwd_megakernel, dim3(grid_blocks), dim3(NT), args, 0, stream);
    if (e != hipSuccess) fprintf(stderr, "cooperative launch failed: %s (grid %d)\n", hipGetErrorString(e), grid_blocks);
}
```
